# Optimizing an MI355X kernel written in HIP

```python
import jax
import jax.numpy as jnp
from jax import lax
import numpy as np

D_MODEL = 1024
BATCH = 4
SEQ = 8192
DEPTH = 1

GMLP_WIDTH = D_MODEL // 2
GMLP_GROUPS = 4
GMLP_CH = GMLP_WIDTH // GMLP_GROUPS
GMLP_CHUNK = 128
ATT_HEADS = 8
HEAD_DIM = 64
ATT_WIDTH = ATT_HEADS * HEAD_DIM
ROPE_DIM = HEAD_DIM // 4
ROPE_THETA = 500000.0
MOBA_BLOCK = 256
MOBA_TOPK = 3
Q_BLOCK = 128
N_GROUPS = 4
EXPERTS_PER_GROUP = 8
N_EXPERTS = N_GROUPS * EXPERTS_PER_GROUP
TOP_K_EXPERT = 2
D_EXPERT = D_MODEL // 2
DISPATCH_BLOCK = 256
N_MOD = 6
PROJ_COLS = 2 * GMLP_WIDTH + 3 * ATT_WIDTH + 2 * D_MODEL
EPS = 1e-6

kernel_name = 'hybrid_gmlp_moba_hmoe_block'


def rmsnorm(x, g):
    xf = x.astype(jnp.float32)
    y = xf * lax.rsqrt(jnp.mean(xf * xf, axis=-1, keepdims=True) + EPS)
    return (y * g.astype(jnp.float32)).astype(x.dtype)


def layernorm(x, g, b):
    xf = x.astype(jnp.float32)
    mu = jnp.mean(xf, axis=-1, keepdims=True)
    var = jnp.mean(jnp.square(xf - mu), axis=-1, keepdims=True)
    y = (xf - mu) * lax.rsqrt(var + EPS) * g.astype(jnp.float32) + b.astype(jnp.float32)
    return y.astype(x.dtype)


def partial_rotary(t, pos):
    half = ROPE_DIM // 2
    inv_freq = jnp.power(ROPE_THETA, -jnp.arange(half, dtype=jnp.float32) * 2.0 / ROPE_DIM)
    ang = pos.astype(jnp.float32)[:, None] * inv_freq[None, :]
    cos = jnp.cos(ang)[None, :, None, :]
    sin = jnp.sin(ang)[None, :, None, :]
    t1 = t[..., :half].astype(jnp.float32)
    t2 = t[..., half:ROPE_DIM].astype(jnp.float32)
    rot = jnp.concatenate([t1 * cos - t2 * sin, t2 * cos + t1 * sin], axis=-1).astype(t.dtype)
    return jnp.concatenate([rot, t[..., ROPE_DIM:]], axis=-1)


def spatial_gating_mixer(p, ln_g, ln_b, w_spatial, b_spatial):
    B, S, _ = p.shape
    z = jax.nn.gelu(p)
    u, v = z[..., :GMLP_WIDTH], z[..., GMLP_WIDTH:]
    v = layernorm(v, ln_g, ln_b)
    v = v.reshape(B, S // GMLP_CHUNK, GMLP_CHUNK, GMLP_GROUPS, GMLP_CH)
    causal = jnp.tril(jnp.ones((GMLP_CHUNK, GMLP_CHUNK), dtype=bool))
    w = jnp.where(causal[None], w_spatial, 0)
    sv = jnp.einsum('gts,bnsgc->bntgc', w, v) + b_spatial.T[None, None, :, :, None]
    return u * sv.reshape(B, S, GMLP_WIDTH)


def moba_attention(q, k, v):
    B, S, H, Dh = q.shape
    S_pad = -(-S // MOBA_BLOCK) * MOBA_BLOCK
    if S_pad != S:
        padw = ((0, 0), (0, S_pad - S), (0, 0), (0, 0))
        q, k, v = jnp.pad(q, padw), jnp.pad(k, padw), jnp.pad(v, padw)
    nb = S_pad // MOBA_BLOCK
    nqb = S_pad // Q_BLOCK
    qpb = MOBA_BLOCK // Q_BLOCK
    ksel = min(MOBA_TOPK, nb)
    q = q.transpose(0, 2, 1, 3) * (Dh ** -0.5)
    k = k.transpose(0, 2, 1, 3)
    v = v.transpose(0, 2, 1, 3)
    k_blocks = k.reshape(B, H, nb, MOBA_BLOCK, Dh)
    v_blocks = v.reshape(B, H, nb, MOBA_BLOCK, Dh)
    k_mean = jnp.mean(k_blocks.astype(jnp.float32), axis=3)
    gate = jnp.einsum('bhtd,bhnd->bhtn', q.astype(jnp.float32), k_mean)
    own_blk = jnp.arange(S_pad) // MOBA_BLOCK
    past = jnp.arange(nb)[None, :] < own_blk[:, None]
    gate = jnp.where(past, gate, -jnp.inf)
    _, sel = lax.top_k(gate, ksel)

    q_steps = q.reshape(B, H, nqb, Q_BLOCK, Dh).transpose(0, 2, 1, 3, 4).reshape(B * nqb, H, Q_BLOCK, Dh)
    sel_steps = sel.reshape(B, H, nqb, Q_BLOCK, ksel).transpose(0, 2, 1, 3, 4).reshape(B * nqb, H, Q_BLOCK, ksel)
    b_ids = jnp.repeat(jnp.arange(B), nqb)
    qb_ids = jnp.tile(jnp.arange(nqb), B)

    def step(args):
        b, qi, q_blk, sel_blk = args
        kb = k_blocks[b]
        vb = v_blocks[b]
        k_sel = jax.vmap(lambda kh, ih: kh[ih])(kb, sel_blk)
        v_sel = jax.vmap(lambda vh, ih: vh[ih])(vb, sel_blk)
        j = qi // qpb
        k_own = lax.dynamic_index_in_dim(kb, j, axis=1, keepdims=False)
        v_own = lax.dynamic_index_in_dim(vb, j, axis=1, keepdims=False)
        q_pos = qi * Q_BLOCK + jnp.arange(Q_BLOCK)
        k_pos = j * MOBA_BLOCK + jnp.arange(MOBA_BLOCK)
        valid = jnp.arange(ksel) < j
        s_sel = jnp.einsum('hqd,hqnld->hqnl', q_blk, k_sel).astype(jnp.float32)
        s_sel = jnp.where(valid[None, None, :, None], s_sel, -jnp.inf).reshape(H, Q_BLOCK, ksel * MOBA_BLOCK)
        s_own = jnp.einsum('hqd,hld->hql', q_blk, k_own).astype(jnp.float32)
        s_own = jnp.where(k_pos[None, None, :] <= q_pos[None, :, None], s_own, -jnp.inf)
        prob = jax.nn.softmax(jnp.concatenate([s_sel, s_own], axis=-1), axis=-1).astype(v.dtype)
        p_sel = prob[..., :ksel * MOBA_BLOCK].reshape(H, Q_BLOCK, ksel, MOBA_BLOCK)
        p_own = prob[..., ksel * MOBA_BLOCK:]
        return jnp.einsum('hqnl,hqnld->hqd', p_sel, v_sel) + jnp.einsum('hql,hld->hqd', p_own, v_own)

    out = lax.map(step, (b_ids, qb_ids, q_steps, sel_steps))
    out = out.reshape(B, nqb, H, Q_BLOCK, Dh).transpose(0, 1, 3, 2, 4).reshape(B, S_pad, H * Dh)
    return out[:, :S]


def hierarchical_moe(h, w_rg, b_rg, w_re, b_re, w_gate, w_up, w_down):
    B, S, D = h.shape
    T = B * S
    xt = h.reshape(T, D)
    g_prob = jax.nn.softmax((xt @ w_rg + b_rg).astype(jnp.float32), axis=-1)
    g_p, g_idx = lax.top_k(g_prob, 1)
    e_logits = (jnp.einsum('td,dge->tge', xt, w_re) + b_re).astype(jnp.float32)
    e_logits = jnp.take_along_axis(e_logits, g_idx[:, :, None], axis=1)[:, 0]
    e_prob = jax.nn.softmax(e_logits, axis=-1)
    e_p, e_idx = lax.top_k(e_prob, TOP_K_EXPERT)
    weights = g_p * e_p / jnp.sum(e_p, axis=-1, keepdims=True)
    expert = g_idx * EXPERTS_PER_GROUP + e_idx

    A = T * TOP_K_EXPERT
    flat_e = expert.reshape(A)
    flat_tok = jnp.repeat(jnp.arange(T), TOP_K_EXPERT)
    flat_w = weights.reshape(A)
    order = jnp.argsort(flat_e)
    e_sorted = flat_e[order]
    tok_sorted = flat_tok[order]
    w_sorted = flat_w[order]
    counts = jnp.bincount(flat_e, length=N_EXPERTS)
    padded = (counts + DISPATCH_BLOCK - 1) // DISPATCH_BLOCK * DISPATCH_BLOCK
    start = jnp.cumsum(counts) - counts
    pend = jnp.cumsum(padded)
    pstart = pend - padded
    dest = pstart[e_sorted] + jnp.arange(A) - start[e_sorted]
    n_blocks = -(-A // DISPATCH_BLOCK) + N_EXPERTS
    P = n_blocks * DISPATCH_BLOCK
    x_buf = jnp.zeros((P, D), h.dtype).at[dest].set(xt[tok_sorted])
    block_expert = jnp.minimum(
        jnp.searchsorted(pend, jnp.arange(n_blocks) * DISPATCH_BLOCK, side='right'), N_EXPERTS - 1)

    def expert_block(args):
        xb, e = args
        hid = jax.nn.silu(xb @ w_gate[e]) * (xb @ w_up[e])
        return hid @ w_down[e]

    y_buf = lax.map(expert_block, (x_buf.reshape(n_blocks, DISPATCH_BLOCK, D), block_expert)).reshape(P, D)
    y = y_buf[dest] * w_sorted[:, None].astype(h.dtype)
    out = jnp.zeros((T, D), h.dtype).at[tok_sorted].add(y)
    return out.reshape(B, S, D)


def setup_inputs(seed: int = 0) -> dict:
    key = jax.random.key(seed)
    ks = jax.random.split(key, 22)
    L = DEPTH

    def nrm(k, shape, scale):
        return jax.random.normal(k, shape, jnp.float32) * scale

    return {
        'x': nrm(ks[0], (BATCH, SEQ, D_MODEL), 1.0),
        'c': nrm(ks[1], (BATCH, D_MODEL), 1.0),
        'ada_w': nrm(ks[2], (L, D_MODEL, N_MOD * D_MODEL), 0.5 * D_MODEL ** -0.5),
        'ada_b': nrm(ks[3], (L, N_MOD * D_MODEL), 0.01),
        'norm1_g': 1.0 + nrm(ks[4], (L, D_MODEL), 0.02),
        'norm2_g': 1.0 + nrm(ks[5], (L, D_MODEL), 0.02),
        'w_in': nrm(ks[6], (L, D_MODEL, PROJ_COLS), D_MODEL ** -0.5),
        'gmlp_ln_g': 1.0 + nrm(ks[7], (L, GMLP_WIDTH), 0.02),
        'gmlp_ln_b': nrm(ks[8], (L, GMLP_WIDTH), 0.02),
        'w_spatial': nrm(ks[9], (L, GMLP_GROUPS, GMLP_CHUNK, GMLP_CHUNK), GMLP_CHUNK ** -0.5),
        'b_spatial': 1.0 + nrm(ks[10], (L, GMLP_GROUPS, GMLP_CHUNK), 0.02),
        'w_branch_a': nrm(ks[11], (L, GMLP_WIDTH, D_MODEL), GMLP_WIDTH ** -0.5),
        'w_branch_b': nrm(ks[12], (L, ATT_WIDTH, D_MODEL), ATT_WIDTH ** -0.5),
        'w_out': nrm(ks[13], (L, D_MODEL, D_MODEL), D_MODEL ** -0.5),
        'w_router_group': nrm(ks[14], (L, D_MODEL, N_GROUPS), D_MODEL ** -0.5),
        'b_router_group': nrm(ks[15], (L, N_GROUPS), 0.01),
        'w_router_expert': nrm(ks[16], (L, D_MODEL, N_GROUPS, EXPERTS_PER_GROUP), D_MODEL ** -0.5),
        'b_router_expert': nrm(ks[17], (L, N_GROUPS, EXPERTS_PER_GROUP), 0.01),
        'w_gate': nrm(ks[18], (L, N_EXPERTS, D_MODEL, D_EXPERT), D_MODEL ** -0.5),
        'w_up': nrm(ks[19], (L, N_EXPERTS, D_MODEL, D_EXPERT), D_MODEL ** -0.5),
        'w_down': nrm(ks[20], (L, N_EXPERTS, D_EXPERT, D_MODEL), D_EXPERT ** -0.5),
        'final_norm_g': 1.0 + nrm(ks[21], (D_MODEL,), 0.02),
    }


def reference(x, c, ada_w, ada_b, norm1_g, norm2_g, w_in, gmlp_ln_g, gmlp_ln_b, w_spatial, b_spatial,
              w_branch_a, w_branch_b, w_out, w_router_group, b_router_group, w_router_expert,
              b_router_expert, w_gate, w_up, w_down, final_norm_g):
    B, S, _ = x.shape
    pos = jnp.arange(S)
    splits = [2 * GMLP_WIDTH, 2 * GMLP_WIDTH + ATT_WIDTH, 2 * GMLP_WIDTH + 2 * ATT_WIDTH,
              2 * GMLP_WIDTH + 3 * ATT_WIDTH, 2 * GMLP_WIDTH + 3 * ATT_WIDTH + D_MODEL]
    for l in range(DEPTH):
        mod = c @ ada_w[l] + ada_b[l]
        sh1, sc1, g1, sh2, sc2, g2 = jnp.split(mod, N_MOD, axis=-1)
        h = rmsnorm(x, norm1_g[l]) * (1.0 + sc1[:, None]) + sh1[:, None]
        proj = h @ w_in[l]
        p_a, q, k, v, gate_a, gate_b = jnp.split(proj, splits, axis=-1)
        y_a = spatial_gating_mixer(p_a, gmlp_ln_g[l], gmlp_ln_b[l], w_spatial[l], b_spatial[l]) @ w_branch_a[l]
        q = partial_rotary(q.reshape(B, S, ATT_HEADS, HEAD_DIM), pos)
        k = partial_rotary(k.reshape(B, S, ATT_HEADS, HEAD_DIM), pos)
        v = v.reshape(B, S, ATT_HEADS, HEAD_DIM)
        y_b = moba_attention(q, k, v) @ w_branch_b[l]
        merged = jax.nn.sigmoid(gate_a) * y_a + jax.nn.sigmoid(gate_b) * y_b
        x = x + g1[:, None] * (merged @ w_out[l])
        h = rmsnorm(x, norm2_g[l]) * (1.0 + sc2[:, None]) + sh2[:, None]
        x = x + g2[:, None] * hierarchical_moe(h, w_router_group[l], b_router_group[l], w_router_expert[l],
                                               b_router_expert[l], w_gate[l], w_up[l], w_down[l])
    return rmsnorm(x, final_norm_g)
```

```cpp
#include <hip/hip_runtime.h>
#include <hip/hip_bf16.h>
#include <cstdio>
#include <cstdint>
#include <cmath>

#ifndef MK_PER_PHASE
#define MK_PER_PHASE 0
#endif

#define LAS __attribute__((address_space(3)))
#define GAS __attribute__((address_space(1)))
typedef unsigned short bf16_t;
typedef short bf16x8 __attribute__((ext_vector_type(8)));
typedef short s16x4 __attribute__((ext_vector_type(4)));
typedef float f32x2 __attribute__((ext_vector_type(2)));
typedef float f32x4 __attribute__((ext_vector_type(4)));
typedef float f32x16 __attribute__((ext_vector_type(16)));
typedef unsigned u32x2 __attribute__((ext_vector_type(2)));
typedef unsigned u32x4 __attribute__((ext_vector_type(4)));
typedef GAS unsigned gu32;

constexpr int NB = 4, SEQ = 8192, DM = 1024, T = NB * SEQ;
constexpr int PC = 4608;
constexpr int C_U = 0, C_V = 512, C_Q = 1024, C_K = 1536, C_VV = 2048, C_GA = 2560, C_GB = 3584;
constexpr int NEXP = 32, DEXP = 512;
constexpr float EPS = 1e-6f;
constexpr float QSCALE = 0.125f * 1.4426950408889634f;

constexpr size_t MiB = 1u << 20;
constexpr size_t WS_CTL = 0, CTL_ZERO_BYTES = 2 * MiB;
constexpr size_t WS_KSUM = 1 * MiB;
constexpr size_t WS_MODP = 2 * MiB;
constexpr size_t WS_MOD = 3 * MiB + 512 * 1024;
constexpr size_t WS_ROPE = 4 * MiB;
constexpr size_t WS_WST = 4 * MiB + 512 * 1024;
constexpr size_t WS_WRT = 4 * MiB + 768 * 1024;
constexpr size_t WS_SSQ = 5 * MiB;
constexpr size_t WS_ROUTE = 8 * MiB;
constexpr size_t WS_WIN = 24 * MiB;
constexpr size_t WS_WA = 34 * MiB, WS_WB = 35 * MiB, WS_WOUT = 36 * MiB;
constexpr size_t WS_WGU = 40 * MiB;
constexpr size_t WS_WD = 104 * MiB;
constexpr size_t WS_XN = 136 * MiB;
constexpr size_t WS_PROJ = 200 * MiB;
constexpr size_t WS_HID = 200 * MiB;
constexpr size_t WS_Y = 272 * MiB;
constexpr size_t WS_END = 488 * MiB;
constexpr int CW_TMO = 0, CW_BAR = 4096, CW_CURSOR = 8192;

constexpr int RING_BYTES = 131072;
constexpr int LDS_BYTES = 147456;
constexpr int MISC_OFF = LDS_BYTES - 1024;
constexpr int NWAVES = 8;

#define LDS_WAIT() asm volatile("s_waitcnt lgkmcnt(0)" ::: "memory")
#define VM_WAIT() asm volatile("s_waitcnt vmcnt(0)" ::: "memory")
#define RLX_AGENT __ATOMIC_RELAXED, __HIP_MEMORY_SCOPE_AGENT

__device__ __forceinline__ unsigned cvt_pk_bf16(float lo, float hi) { unsigned r; asm volatile("v_cvt_pk_bf16_f32 %0, %1, %2" : "=v"(r) : "v"(lo), "v"(hi)); return r; }
__device__ __forceinline__ float bflo(unsigned u) { return __uint_as_float(u << 16); }
__device__ __forceinline__ float bfhi(unsigned u) { return __uint_as_float(u & 0xffff0000u); }
__device__ __forceinline__ float sigmoidf_(float x) { return __builtin_amdgcn_rcpf(1.0f + __builtin_amdgcn_exp2f(-1.4426950408889634f * x)); }
__device__ __forceinline__ float gelu_tanh(float x) { const float u = x + 0.044715f * x * x * x; return x * __builtin_amdgcn_rcpf(1.0f + __builtin_amdgcn_exp2f(-2.3022081985f * u)); }
__device__ __forceinline__ float wave_sum(float v) {
#pragma unroll
    for (int o = 1; o < 64; o <<= 1) v += __shfl_xor(v, o);
    return v;
}

namespace pg8 {
constexpr int BM = 256, BK = 64, HALF = 128, HTB = HALF * BK * 2, STAGE_BYTES = 8 * HTB, NXCD = 8, WGM = 8;
__host__ __device__ __forceinline__ int lds_byte(int r, int c) { const int st = (r >> 4) * 2 + (c >> 5), rr = r & 15, cc = c & 31, ob = rr * 64 + cc * 2; return st * 1024 + (ob ^ (((ob >> 9) & 1) << 5)); }
__host__ __device__ __forceinline__ void stage_rc(int b, int& R, int& C) { const int st = b / 1024, sb = b % 1024, swz = sb ^ (((sb >> 9) & 1) << 5); R = (st >> 1) * 16 + swz / 64; C = (st & 1) * 32 + (swz % 64) / 2; }
__host__ __device__ __forceinline__ int perm32(int rho) { const int n = rho >> 4, i = rho & 15; return 8 * (i >> 2) + 4 * n + (i & 3); }

struct Unit { int pm, pn, e, lt, nvalid; };

struct DenseSched {
    const char* A; const char* Bt; int lda, K; int nM, nN, nwg, G, c;
    __device__ void init(const void* A_, int lda_, const void* Bt_, int K_, int M, int N, int G_, int c_) { A = (const char*)A_; Bt = (const char*)Bt_; lda = lda_; K = K_; nM = M / BM; nN = N / BM; nwg = nM * nN; G = G_; c = c_; }
    __device__ __forceinline__ bool next(int i, Unit& u) const {
        const long L = (long)i * G + c; if (L >= nwg) return false;
        int wgid = (int)L; { const int q = nwg / NXCD, r = nwg % NXCD, xcd = wgid % NXCD, off = wgid / NXCD; wgid = (xcd < r ? xcd * (q + 1) : r * (q + 1) + (xcd - r) * q) + off; }
        const int nig = WGM * nN, gid = wgid / nig, fm = gid * WGM, gsz = (nM - fm) < WGM ? (nM - fm) : WGM;
        u.pm = fm + ((wgid % nig) % gsz); u.pn = (wgid % nig) / gsz; u.e = 0; u.lt = 0; u.nvalid = 256; return true;
    }
    __device__ __forceinline__ const char* a_base(const Unit& u) const { return A + (size_t)u.pm * BM * lda * 2; }
    __device__ __forceinline__ const char* b_base(const Unit& u) const { return Bt + (size_t)u.pn * BM * K * 2; }
    __device__ __forceinline__ unsigned gather_off(const Unit&, int, int) const { return 0u; }
};
struct MoeSched {
    const char* A; const char* Bt; int lda, K; size_t bstride;
    const unsigned long long* route; bool gather;
    const volatile LAS int* tab;
    int start, end, j;
    __device__ __forceinline__ bool next(int i, Unit& u) const {
        const int idx = start + i * 32 + j; if (idx >= end) return false;
        const int tile = idx >> 2; u.pn = idx & 3; u.pm = tile;
        int e = 0;
        for (int k = 1; k < 32; ++k) e += (__builtin_amdgcn_readfirstlane(tab[32 + k]) <= tile) ? 1 : 0;
        u.e = e; u.lt = tile - __builtin_amdgcn_readfirstlane(tab[32 + e]);
        const int rem = __builtin_amdgcn_readfirstlane(tab[e]) - 256 * u.lt; u.nvalid = rem < 256 ? rem : 256; return true;
    }
    __device__ __forceinline__ const char* a_base(const Unit& u) const { return gather ? A : A + (size_t)u.pm * BM * lda * 2; }
    __device__ __forceinline__ const char* b_base(const Unit& u) const { return Bt + (size_t)u.e * bstride + (size_t)u.pn * BM * K * 2; }
    __device__ __forceinline__ unsigned gather_off(const Unit& u, int r, int C) const {
        unsigned tok = 0u;
        if (r < u.nvalid) tok = (unsigned)(route[(size_t)u.e * 32768 + (size_t)u.lt * 256 + r] & 0xffffffffull) >> 1;
        return (tok * (unsigned)lda + (unsigned)C) * 2u;
    }
};

template <class Epi, class Sched, bool GATHER>
__device__ __forceinline__ void gemm_phase(LAS unsigned char* lds, const Sched& S, const Epi& E) {
    const int tid = threadIdx.x, wid = __builtin_amdgcn_readfirstlane(tid >> 6), lane = tid & 63, wr = wid >> 2, wc = wid & 3, fr = lane & 15, fq = lane >> 4;
    const int K = S.K, lda = S.lda, nt = K / BK;
    unsigned voffA[2], voffB[2]; int RA[2], CA[2];
#pragma unroll
    for (int i = 0; i < 2; ++i) { int R, C; stage_rc(tid * 16 + i * 8192, R, C); const int Rb = Epi::PERM ? ((R & ~31) + perm32(R & 31)) : R;
        RA[i] = R; CA[i] = C; voffA[i] = (unsigned)(R * lda + C) * 2u; voffB[i] = (unsigned)(Rb * K + C) * 2u; }
    const size_t kstep = (size_t)(BK * 2);
    const unsigned hstepA = (unsigned)HALF * (unsigned)lda * 2u;
    const size_t hstepB = (size_t)HALF * K * 2;
    const unsigned ldsw = (unsigned)wid * 1024u;
    const int aoff = lds_byte(wr * 64 + fr, fq * 8), boff = lds_byte(wc * 32 + fr, fq * 8);
    unsigned og[2][2] = {{0u, 0u}, {0u, 0u}}, ogn[2][2] = {{0u, 0u}, {0u, 0u}};
#define PG8_SA(b, h) (((b) * 2 + (h)) * HTB)
#define PG8_SB(b, h) ((4 + (b) * 2 + (h)) * HTB)
#define PG8_STAGE_B(bufoff, gbase) do { _Pragma("unroll") for (int _i = 0; _i < 2; ++_i) \
        __builtin_amdgcn_global_load_lds((const unsigned*)((const char*)(gbase) + voffB[_i]), (LAS unsigned*)(lds + (bufoff) + ldsw + _i * 8192), 16, 0, 0); } while (0)
#define PG8_STAGE_A(bufoff, gbase, h) do { _Pragma("unroll") for (int _i = 0; _i < 2; ++_i) \
        __builtin_amdgcn_global_load_lds((const unsigned*)((const char*)(gbase) + (GATHER ? og[h][_i] : voffA[_i] + (h) * hstepA)), (LAS unsigned*)(lds + (bufoff) + ldsw + _i * 8192), 16, 0, 0); } while (0)
#define PG8_LDA(dst, b, h) do { _Pragma("unroll") for (int m = 0; m < 4; ++m) _Pragma("unroll") for (int k = 0; k < 2; ++k) dst[m][k] = *(const LAS bf16x8*)(lds + PG8_SA(b, h) + aoff + m * 2048 + k * 1024); } while (0)
#define PG8_LDB(dst, b, h) do { _Pragma("unroll") for (int n = 0; n < 2; ++n) _Pragma("unroll") for (int k = 0; k < 2; ++k) dst[n][k] = *(const LAS bf16x8*)(lds + PG8_SB(b, h) + boff + n * 2048 + k * 1024); } while (0)
#define PG8_MMA(ai, bj, At, Bt) do { __builtin_amdgcn_s_setprio(1); _Pragma("unroll") for (int m = 0; m < 4; ++m) _Pragma("unroll") for (int n = 0; n < 2; ++n) _Pragma("unroll") for (int k = 0; k < 2; ++k) \
        acc[ai][bj][m][n] = __builtin_amdgcn_mfma_f32_16x16x32_bf16(Bt[n][k], At[m][k], acc[ai][bj][m][n], 0, 0, 0); __builtin_amdgcn_s_setprio(0); } while (0)
#define PG8_WAIT_V(n) asm volatile("s_waitcnt vmcnt(" #n ")" ::: "memory")
#define PG8_WAIT_L(n) asm volatile("s_waitcnt lgkmcnt(" #n ")" ::: "memory")
#define PG8_BAR __builtin_amdgcn_s_barrier()
#define PG8_SCHED __builtin_amdgcn_sched_barrier(0)
    Unit cur, nxt; int ui = 0;
    if (!S.next(0, cur)) return;
    f32x4 acc[2][2][4][2];
#pragma unroll
    for (int a = 0; a < 2; ++a)
#pragma unroll
        for (int b = 0; b < 2; ++b)
#pragma unroll
            for (int m = 0; m < 4; ++m)
#pragma unroll
                for (int n = 0; n < 2; ++n) acc[a][b][m][n] = (f32x4){0.f, 0.f, 0.f, 0.f};
    bf16x8 At[4][2], B0[2][2], B1[2][2];
    const char* cA = S.a_base(cur); const char* cB = S.b_base(cur);
    if constexpr (GATHER) {
#pragma unroll
        for (int h = 0; h < 2; ++h)
#pragma unroll
            for (int i = 0; i < 2; ++i) og[h][i] = S.gather_off(cur, h * HALF + RA[i], CA[i]);
    }
    PG8_STAGE_B(PG8_SB(0, 0), cB); PG8_STAGE_B(PG8_SB(0, 1), cB + hstepB); PG8_STAGE_A(PG8_SA(0, 0), cA, 0); PG8_STAGE_A(PG8_SA(0, 1), cA, 1);
    if (wr == 1) PG8_BAR;
    PG8_WAIT_V(2); PG8_BAR;
    PG8_STAGE_B(PG8_SB(1, 0), cB + kstep); PG8_STAGE_A(PG8_SA(1, 0), cA + kstep, 0); PG8_STAGE_B(PG8_SB(1, 1), cB + hstepB + kstep);
    PG8_WAIT_V(6); PG8_BAR;
    for (;;) {
        const bool has_next = S.next(ui + 1, nxt);
        const char* nA = has_next ? S.a_base(nxt) : cA; const char* nB = has_next ? S.b_base(nxt) : cB;
        if constexpr (GATHER) {
            if (has_next) {
#pragma unroll
                for (int h = 0; h < 2; ++h)
#pragma unroll
                    for (int i = 0; i < 2; ++i) ogn[h][i] = S.gather_off(nxt, h * HALF + RA[i], CA[i]);
            }
        }
        for (int t = 0; t < nt; t += 2) {
            const bool last = (t == nt - 2);
            const char* a1 = cA + (size_t)(t + 1) * kstep;
            const char* a2 = last ? nA : cA + (size_t)(t + 2) * kstep; const char* b2 = last ? nB : cB + (size_t)(t + 2) * kstep;
            const char* a3 = a2 + kstep; const char* b3 = b2 + kstep;
            PG8_LDB(B0, 0, 0); PG8_LDB(B1, 0, 1); PG8_SCHED; PG8_LDA(At, 0, 0); PG8_STAGE_A(PG8_SA(1, 1), a1, 1);
            if constexpr (GATHER) { if (last && has_next) {
#pragma unroll
                for (int h = 0; h < 2; ++h)
#pragma unroll
                    for (int i = 0; i < 2; ++i) og[h][i] = ogn[h][i]; } }
            PG8_WAIT_V(8); PG8_WAIT_L(0); PG8_BAR; PG8_MMA(0, 0, At, B0); PG8_MMA(0, 1, At, B1); PG8_BAR; PG8_SCHED;
            PG8_LDA(At, 0, 1); PG8_STAGE_B(PG8_SB(0, 0), b2); PG8_STAGE_B(PG8_SB(0, 1), b2 + hstepB); PG8_STAGE_A(PG8_SA(0, 0), a2, 0);
            PG8_WAIT_V(8); PG8_WAIT_L(0); PG8_BAR; PG8_MMA(1, 0, At, B0); PG8_MMA(1, 1, At, B1); PG8_BAR; PG8_SCHED;
            PG8_LDB(B0, 1, 0); PG8_LDB(B1, 1, 1); PG8_SCHED; PG8_LDA(At, 1, 0); PG8_STAGE_A(PG8_SA(0, 1), a2, 1);
            PG8_WAIT_V(8); PG8_WAIT_L(0); PG8_BAR; PG8_MMA(0, 0, At, B0); PG8_MMA(0, 1, At, B1); PG8_BAR; PG8_SCHED;
            PG8_LDA(At, 1, 1); PG8_STAGE_B(PG8_SB(1, 0), b3); PG8_STAGE_B(PG8_SB(1, 1), b3 + hstepB); PG8_STAGE_A(PG8_SA(1, 0), a3, 0);
            PG8_WAIT_V(8); PG8_WAIT_L(0); PG8_BAR; PG8_MMA(1, 0, At, B0); PG8_MMA(1, 1, At, B1); PG8_BAR; PG8_SCHED;
        }
        if (wr == 0) PG8_BAR;
        E(acc, cur, wr, wc, fr, fq);
        if (!has_next) break;
#pragma unroll
        for (int a = 0; a < 2; ++a)
#pragma unroll
            for (int b = 0; b < 2; ++b)
#pragma unroll
                for (int m = 0; m < 4; ++m)
#pragma unroll
                    for (int n = 0; n < 2; ++n) acc[a][b][m][n] = (f32x4){0.f, 0.f, 0.f, 0.f};
        cur = nxt; cA = nA; cB = nB; ++ui;
        if (wr == 1) PG8_BAR;
    }
    PG8_WAIT_V(0);
    PG8_BAR;
#undef PG8_SA
#undef PG8_SB
#undef PG8_STAGE_A
#undef PG8_STAGE_B
#undef PG8_LDA
#undef PG8_LDB
#undef PG8_MMA
#undef PG8_WAIT_V
#undef PG8_WAIT_L
#undef PG8_BAR
#undef PG8_SCHED
}

struct EpiProj {
    static constexpr bool PERM = true;
    bf16_t* P; const float* rope; float* ksum;
    __device__ __forceinline__ void operator()(const f32x4 (&acc)[2][2][4][2], const Unit& u, int wr, int wc, int fr_in, int fq) const {
        int fr = fr_in; asm volatile("" : "+v"(fr));
        const int pn = u.pn, row0 = u.pm * BM + wr * 64 + fr, cl = wc * 32 + 8 * fq;
        const int mode = pn < 4 ? 0 : pn < 6 ? 1 : pn < 8 ? 2 : pn < 10 ? 3 : 4;
        const bool rot = (mode == 1 || mode == 2) && ((wc & 1) == 0);
        float ks[2][8];
#pragma unroll
        for (int bj = 0; bj < 2; ++bj)
#pragma unroll
            for (int j = 0; j < 8; ++j) ks[bj][j] = 0.f;
#pragma unroll
        for (int ai = 0; ai < 2; ++ai)
#pragma unroll
            for (int m = 0; m < 4; ++m) {
                const int row = row0 + ai * HALF + m * 16;
                float cs[8], sn[8];
                if (rot) { const int pos = row & (SEQ - 1); const f32x4 c0 = *(const f32x4*)(rope + pos * 8), c1 = *(const f32x4*)(rope + pos * 8 + 4), s0 = *(const f32x4*)(rope + 65536 + pos * 8), s1 = *(const f32x4*)(rope + 65536 + pos * 8 + 4);
#pragma unroll
                    for (int j = 0; j < 4; ++j) { cs[j] = c0[j]; cs[4 + j] = c1[j]; sn[j] = s0[j]; sn[4 + j] = s1[j]; } }
#pragma unroll
                for (int bj = 0; bj < 2; ++bj) {
                    float v[8];
#pragma unroll
                    for (int j = 0; j < 4; ++j) { v[j] = acc[ai][bj][m][0][j]; v[4 + j] = acc[ai][bj][m][1][j]; }
                    if (mode == 0) {
#pragma unroll
                        for (int j = 0; j < 8; ++j) v[j] = gelu_tanh(v[j]);
                    } else if (mode == 4) {
#pragma unroll
                        for (int j = 0; j < 8; ++j) v[j] = sigmoidf_(v[j]);
                    } else if (mode != 3) {
                        if (rot) {
                            const float sg = (fq == 0) ? -1.f : 1.f; const bool ap = fq < 2;
#pragma unroll
                            for (int j = 0; j < 8; ++j) { const float o = __shfl_xor(v[j], 16); const float r = v[j] * cs[j] + sg * o * sn[j]; v[j] = ap ? r : v[j]; }
                        }
                        if (mode == 1) {
#pragma unroll
                            for (int j = 0; j < 8; ++j) v[j] *= QSCALE;
                        } else {
#pragma unroll
                            for (int j = 0; j < 8; ++j) ks[bj][j] += v[j];
                        }
                    }
                    u32x4 w; w.x = cvt_pk_bf16(v[0], v[1]); w.y = cvt_pk_bf16(v[2], v[3]); w.z = cvt_pk_bf16(v[4], v[5]); w.w = cvt_pk_bf16(v[6], v[7]);
                    *(u32x4*)(P + (size_t)row * PC + pn * BM + bj * HALF + cl) = w;
                }
            }
        if (mode == 2) {
#pragma unroll
            for (int bj = 0; bj < 2; ++bj)
#pragma unroll
                for (int j = 0; j < 8; ++j) { float s = ks[bj][j]; s += __shfl_xor(s, 1); s += __shfl_xor(s, 2); s += __shfl_xor(s, 4); s += __shfl_xor(s, 8); ks[bj][j] = s; }
            if (fr == 0) {
                const int b = u.pm >> 5, kb = u.pm & 31;
#pragma unroll
                for (int bj = 0; bj < 2; ++bj) { const int ck = (pn - 6) * BM + bj * HALF + cl; const int h = ck >> 6, d = ck & 63;
                    float* dst = ksum + ((size_t)((b * 8 + h) * 32 + kb)) * 64 + d;
#pragma unroll
                    for (int j = 0; j < 8; ++j) atomicAdd(dst + j, ks[bj][j]); }
            }
        }
    }
};
template <bool FIRST> struct EpiMerge {
    static constexpr bool PERM = true;
    const bf16_t* P; bf16_t* MG;
    __device__ __forceinline__ void operator()(const f32x4 (&acc)[2][2][4][2], const Unit& u, int wr, int wc, int fr_in, int fq) const {
        int fr = fr_in; asm volatile("" : "+v"(fr));
        const int row0 = u.pm * BM + wr * 64 + fr, col0 = u.pn * BM + wc * 32 + 8 * fq;
#pragma unroll
        for (int ai = 0; ai < 2; ++ai)
#pragma unroll
            for (int m = 0; m < 4; ++m) { const int row = row0 + ai * HALF + m * 16;
#pragma unroll
                for (int bj = 0; bj < 2; ++bj) { const int c = col0 + bj * HALF;
                    const u32x4 g = *(const u32x4*)(P + (size_t)row * PC + (FIRST ? C_GA : C_GB) + c);
                    bf16_t* dst = MG + (size_t)row * DM + c;
                    float v[8];
#pragma unroll
                    for (int j = 0; j < 4; ++j) { v[j] = acc[ai][bj][m][0][j]; v[4 + j] = acc[ai][bj][m][1][j]; }
                    v[0] *= bflo(g.x); v[1] *= bfhi(g.x); v[2] *= bflo(g.y); v[3] *= bfhi(g.y); v[4] *= bflo(g.z); v[5] *= bfhi(g.z); v[6] *= bflo(g.w); v[7] *= bfhi(g.w);
                    if (!FIRST) { const u32x4 p = *(const u32x4*)dst;
                        v[0] += bflo(p.x); v[1] += bfhi(p.x); v[2] += bflo(p.y); v[3] += bfhi(p.y); v[4] += bflo(p.z); v[5] += bfhi(p.z); v[6] += bflo(p.w); v[7] += bfhi(p.w); }
                    u32x4 w; w.x = cvt_pk_bf16(v[0], v[1]); w.y = cvt_pk_bf16(v[2], v[3]); w.z = cvt_pk_bf16(v[4], v[5]); w.w = cvt_pk_bf16(v[6], v[7]);
                    *(u32x4*)dst = w; } }
    }
};
struct EpiOut {
    static constexpr bool PERM = false;
    const float* x; float* out; const float* mod; float* ssq;
    __device__ __forceinline__ void operator()(const f32x4 (&acc)[2][2][4][2], const Unit& u, int wr, int wc, int fr_in, int fq) const {
        int fr = fr_in; asm volatile("" : "+v"(fr));
        const int row0 = u.pm * BM + wr * 64 + fr, col0 = u.pn * BM + wc * 32 + 4 * fq, b = u.pm >> 5;
        f32x4 g1[2][2];
#pragma unroll
        for (int bj = 0; bj < 2; ++bj)
#pragma unroll
            for (int n = 0; n < 2; ++n) g1[bj][n] = *(const f32x4*)(mod + b * 6144 + 2048 + col0 + bj * HALF + n * 16);
#pragma unroll
        for (int ai = 0; ai < 2; ++ai)
#pragma unroll
            for (int m = 0; m < 4; ++m) { const int row = row0 + ai * HALF + m * 16; const size_t off = (size_t)row * DM + col0; float s = 0.f;
#pragma unroll
                for (int bj = 0; bj < 2; ++bj)
#pragma unroll
                    for (int n = 0; n < 2; ++n) { const f32x4 xv = *(const f32x4*)(x + off + bj * HALF + n * 16); const f32x4 o = xv + g1[bj][n] * acc[ai][bj][m][n];
                        s += (o[0] * o[0] + o[1] * o[1]) + (o[2] * o[2] + o[3] * o[3]); *(f32x4*)(out + off + bj * HALF + n * 16) = o; }
                s += __shfl_xor(s, 16); s += __shfl_xor(s, 32);
                if (fq == 0) ssq[(size_t)row * 16 + u.pn * 4 + wc] = s; }
    }
};
struct EpiGU {
    static constexpr bool PERM = true;
    bf16_t* H;
    __device__ __forceinline__ void operator()(const f32x4 (&acc)[2][2][4][2], const Unit& u, int wr, int wc, int fr_in, int fq) const {
        int fr = fr_in; asm volatile("" : "+v"(fr));
        const int r0 = wr * 64 + fr, cl = wc * 32 + 8 * fq;
#pragma unroll
        for (int ai = 0; ai < 2; ++ai)
#pragma unroll
            for (int m = 0; m < 4; ++m) { const int r = r0 + ai * HALF + m * 16;
                float v[8];
#pragma unroll
                for (int j = 0; j < 4; ++j) { const float g0 = acc[ai][0][m][0][j], g1 = acc[ai][0][m][1][j]; v[j] = g0 * sigmoidf_(g0) * acc[ai][1][m][0][j]; v[4 + j] = g1 * sigmoidf_(g1) * acc[ai][1][m][1][j]; }
                u32x4 w; w.x = cvt_pk_bf16(v[0], v[1]); w.y = cvt_pk_bf16(v[2], v[3]); w.z = cvt_pk_bf16(v[4], v[5]); w.w = cvt_pk_bf16(v[6], v[7]);
                *(u32x4*)(H + ((size_t)u.pm * BM + r) * DEXP + u.pn * HALF + cl) = w; }
    }
};
struct EpiDown {
    static constexpr bool PERM = true;
    bf16_t* Y; const unsigned long long* route;
    __device__ __forceinline__ void operator()(const f32x4 (&acc)[2][2][4][2], const Unit& u, int wr, int wc, int fr_in, int fq) const {
        int fr = fr_in; asm volatile("" : "+v"(fr));
        const int r0 = wr * 64 + fr, col0 = u.pn * BM + wc * 32 + 8 * fq;
        const unsigned long long* rt = route + (size_t)u.e * 32768 + (size_t)u.lt * 256;
#pragma unroll
        for (int ai = 0; ai < 2; ++ai)
#pragma unroll
            for (int m = 0; m < 4; ++m) { const int r = r0 + ai * HALF + m * 16;
                if (r < u.nvalid) { const unsigned long long ent = rt[r]; const unsigned slot = (unsigned)(ent & 0xffffffffull); const float wt = __uint_as_float((unsigned)(ent >> 32));
#pragma unroll
                    for (int bj = 0; bj < 2; ++bj) { const f32x4 a0 = acc[ai][bj][m][0] * wt, a1 = acc[ai][bj][m][1] * wt;
                        u32x4 w; w.x = cvt_pk_bf16(a0[0], a0[1]); w.y = cvt_pk_bf16(a0[2], a0[3]); w.z = cvt_pk_bf16(a1[0], a1[1]); w.w = cvt_pk_bf16(a1[2], a1[3]);
                        *(u32x4*)(Y + (size_t)slot * DM + col0 + bj * HALF) = w; } } }
    }
};
}

namespace attn_body {
using bf16 = __hip_bfloat16;
constexpr int NHEAD = 8, D = 64, PITCH = PC;
constexpr int NW = 8, QBLK = 32, QB = QBLK * NW, KVBLK = 64;
__device__ __forceinline__ int crow(int r, int hi) { return (r & 3) + 8 * (r >> 2) + 4 * hi; }
#define SBAR() __builtin_amdgcn_sched_barrier(0)
__device__ __forceinline__ void cmask(f32x16& p0, f32x16& p1, int jb, int qrel, int hi) {
    const float NEG = -INFINITY; int kb = 64 * jb + 4 * hi;
#pragma unroll
    for (int r = 0; r < 16; ++r) { int kv = kb + (r & 3) + 8 * (r >> 2); if (kv > qrel) p0[r] = NEG; if (kv + 32 > qrel) p1[r] = NEG; }
}
__device__ __forceinline__ void selapply(f32x16& p0, f32x16& p1, bool ok) {
    const float NEG = -INFINITY;
#pragma unroll
    for (int r = 0; r < 16; ++r) { p0[r] = ok ? p0[r] : NEG; p1[r] = ok ? p1[r] : NEG; }
}
constexpr int NSLOT = 3, SLOTB = 8192;
constexpr int LDS_K = 0, LDS_V = NSLOT * SLOTB, LDS_WS = 2 * NSLOT * SLOTB, LDS_OST = LDS_WS + NW * 64 * 4, LDS_BYTES_A = LDS_OST + NW * 4096;
__device__ __forceinline__ void glds16(const void* gsrc, unsigned lds_dst) { unsigned keep;
    asm volatile("s_mov_b32 %0, m0\n\ts_mov_b32 m0, %2\n\ts_nop 0\n\tglobal_load_lds_dwordx4 %1, off\n\ts_mov_b32 m0, %0" : "=&s"(keep) : "v"(gsrc), "s"(lds_dst) : "memory"); }
__device__ __forceinline__ float max3f(float a, float b, float c) { float r; asm("v_max3_f32 %0, %1, %2, %3" : "=v"(r) : "v"(a), "v"(b), "v"(c)); return r; }
__device__ __forceinline__ float max2f(float a, float b) { float r; asm("v_max_f32_e32 %0, %1, %2" : "=v"(r) : "v"(a), "v"(b)); return r; }
__device__ __forceinline__ float fadd_s(float a, float b) { float r; asm("v_add_f32_e32 %0, %1, %2" : "=v"(r) : "v"(a), "v"(b)); return r; }
__device__ __forceinline__ float fsub_s(float a, float b) { float r; asm("v_sub_f32_e32 %0, %1, %2" : "=v"(r) : "v"(a), "v"(b)); return r; }
typedef __bf16 bf16x2_t __attribute__((ext_vector_type(2)));
__device__ __forceinline__ unsigned cvtpk_s(float lo, float hi) { f32x2 v = {lo, hi}; bf16x2_t b = __builtin_convertvector(v, bf16x2_t); return __builtin_bit_cast(unsigned, b); }
#define WAIT_BAR(N) asm volatile("s_waitcnt vmcnt(" #N ") lgkmcnt(0)\n\ts_barrier" ::: "memory")

__device__ __forceinline__ void qkt(f32x16& p0, f32x16& p1, const char* Kslot, const bf16x8* qr, const f32x16& negm, int r32, int hi) {
    const char* kb = Kslot + hi * 1024 + r32 * 16;
#pragma unroll
    for (int d0 = 0; d0 < 4; ++d0) {
        const bf16x8 b0 = *reinterpret_cast<const bf16x8*>(kb + d0 * 2048);
        const bf16x8 b1 = *reinterpret_cast<const bf16x8*>(kb + d0 * 2048 + 512);
        if (d0 == 0) { p0 = __builtin_amdgcn_mfma_f32_32x32x16_bf16(b0, qr[0], negm, 0, 0, 0); p1 = __builtin_amdgcn_mfma_f32_32x32x16_bf16(b1, qr[0], negm, 0, 0, 0); }
        else { p0 = __builtin_amdgcn_mfma_f32_32x32x16_bf16(b0, qr[d0], p0, 0, 0, 0); p1 = __builtin_amdgcn_mfma_f32_32x32x16_bf16(b1, qr[d0], p1, 0, 0, 0); } }
}
typedef LAS const char* lds_cptr;
typedef short v4i16_t __attribute__((ext_vector_type(4)));
__device__ __forceinline__ void kload8(bf16x8* kf, lds_cptr kp) {
    kf[0] = *(const LAS bf16x8*)(kp);        kf[1] = *(const LAS bf16x8*)(kp + 512);
    kf[2] = *(const LAS bf16x8*)(kp + 2048); kf[3] = *(const LAS bf16x8*)(kp + 2560);
    kf[4] = *(const LAS bf16x8*)(kp + 4096); kf[5] = *(const LAS bf16x8*)(kp + 4608);
    kf[6] = *(const LAS bf16x8*)(kp + 6144); kf[7] = *(const LAS bf16x8*)(kp + 6656);
}
__device__ __forceinline__ void kload2(bf16x8* kf, lds_cptr kp, int j) { kf[2 * j] = *(const LAS bf16x8*)(kp + j * 2048); kf[2 * j + 1] = *(const LAS bf16x8*)(kp + j * 2048 + 512); }
__device__ __forceinline__ s16x4 vtr(lds_cptr p) { return __builtin_bit_cast(s16x4, __builtin_amdgcn_ds_read_tr16_b64_v4i16((LAS v4i16_t*)p)); }
__device__ __forceinline__ float rowmax(const f32x16& p0, const f32x16& p1) {
    float a = max3f(p0[0], p0[1], p1[0]), b = max3f(p0[2], p0[3], p1[1]); a = max3f(a, p1[2], p1[3]);
#pragma unroll
    for (int r = 4; r < 16; r += 4) { a = max3f(a, p0[r], p0[r + 1]); b = max3f(b, p0[r + 2], p0[r + 3]); a = max3f(a, p1[r], p1[r + 1]); b = max3f(b, p1[r + 2], p1[r + 3]); }
    const float m = max2f(a, b);
    auto rr = __builtin_amdgcn_permlane32_swap(__float_as_uint(m), __float_as_uint(m), false, false);
    return max2f(__uint_as_float(rr[0]), __uint_as_float(rr[1]));
}
__device__ __forceinline__ void pv(f32x16* o, int vb, bf16x8 pa0, bf16x8 pa1, bf16x8 pa2, bf16x8 pa3) {
#pragma unroll
    for (int d0 = 0; d0 < 2; ++d0) { s16x4 lo[4], hi[4];
#pragma unroll
        for (int ks = 0; ks < 4; ++ks) {
            asm volatile("ds_read_b64_tr_b16 %0,%1 offset:%c2" : "=&v"(lo[ks]) : "v"(vb), "i"(d0 * 4096 + ks * 1024) : "memory");
            asm volatile("ds_read_b64_tr_b16 %0,%1 offset:%c2" : "=&v"(hi[ks]) : "v"(vb), "i"(d0 * 4096 + ks * 1024 + 512) : "memory"); }
        asm volatile("s_waitcnt lgkmcnt(0)" ::: "memory"); SBAR();
#define PK(k) (bf16x8){lo[k][0], lo[k][1], lo[k][2], lo[k][3], hi[k][0], hi[k][1], hi[k][2], hi[k][3]}
        o[d0] = __builtin_amdgcn_mfma_f32_32x32x16_bf16(pa0, PK(0), o[d0], 0, 0, 0);
        o[d0] = __builtin_amdgcn_mfma_f32_32x32x16_bf16(pa1, PK(1), o[d0], 0, 0, 0);
        o[d0] = __builtin_amdgcn_mfma_f32_32x32x16_bf16(pa2, PK(2), o[d0], 0, 0, 0);
        o[d0] = __builtin_amdgcn_mfma_f32_32x32x16_bf16(pa3, PK(3), o[d0], 0, 0, 0);
#undef PK
    }
}

template <int THRL> __device__ __forceinline__ void attn_unit(int b, int h, int qb, const bf16* Q, const bf16* __restrict__ K, const bf16* __restrict__ V, bf16* O, const float* ksum, char* shm) {
    const int tid = threadIdx.x, lane = tid & 63, r32 = lane & 31, hi = lane >> 5; const int wid = __builtin_amdgcn_readfirstlane(tid >> 6);
    const long rowbase = (long)b * SEQ; const int q0 = qb * QB;
    const bf16* Qw = Q + (rowbase + q0 + wid * QBLK) * PITCH + h * D;
    const bf16* Kh = K + rowbase * PITCH + h * D, *Vh = V + rowbase * PITCH + h * D;
    const unsigned lds0 = (unsigned)(uintptr_t)shm;
    float* wsf = (float*)(shm + LDS_WS) + wid * 64;
    const bf16* ksrc = Kh + (long)lane * PITCH + wid * 8;
    const bf16* vsrc = Vh + (long)(16 * (wid & 3) + (lane >> 2)) * PITCH + (wid >> 2) * 32 + (lane & 3) * 8;
    const unsigned kdst = lds0 + LDS_K + wid * 1024, vdst = lds0 + LDS_V + wid * 1024;
    const int NT = (q0 + QB) / KVBLK;
#define TM(t) (((t) == 0) ? (NT - 4) : (((t) <= NT - 4) ? ((t) - 1) : (t)))
#define DMA_K(t, slot) glds16(ksrc + (long)TM(t) * KVBLK * PITCH, (unsigned)__builtin_amdgcn_readfirstlane(kdst + (slot)))
#define DMA_V(t, slot) glds16(vsrc + (long)TM(t) * KVBLK * PITCH, (unsigned)__builtin_amdgcn_readfirstlane(vdst + (slot)))
    const int vb0 = (int)(lds0 + LDS_V) + ((lane >> 4) & 1) * 32 + (lane & 3) * 8 + (4 * hi + ((lane & 15) >> 2)) * 64;
    const char* Kbase = shm + LDS_K; bf16x8 kf[8];
    const lds_cptr shm3 = (lds_cptr)shm; const lds_cptr kp0 = shm3 + LDS_K + hi * 1024 + r32 * 16; const lds_cptr vp0 = shm3 + LDS_V + ((lane >> 4) & 1) * 32 + (lane & 3) * 8 + (4 * hi + ((lane & 15) >> 2)) * 64;
    DMA_K(0, 0); DMA_V(0, 0); DMA_K(1, SLOTB);
    bf16x8 qr[4];
#pragma unroll
    for (int d0 = 0; d0 < 4; ++d0) qr[d0] = *reinterpret_cast<const bf16x8*>(&Qw[(long)r32 * PITCH + d0 * 16 + hi * 8]);
    unsigned selmask = 0u;
    if (qb > 0) {
        if (qb <= 3) selmask = (1u << qb) - 1u;
        else {
            const float* km = ksum + ((size_t)(b * NHEAD + h) * 32 + r32) * 64 + hi * 8;
            f32x16 g = f32x16{};
#pragma unroll
            for (int d0 = 0; d0 < 4; ++d0) { const f32x4 a = *(const f32x4*)(km + d0 * 16), c = *(const f32x4*)(km + d0 * 16 + 4);
                u32x4 w; w.x = cvtpk_s(a[0], a[1]); w.y = cvtpk_s(a[2], a[3]); w.z = cvtpk_s(c[0], c[1]); w.w = cvtpk_s(c[2], c[3]);
                g = __builtin_amdgcn_mfma_f32_32x32x16_bf16(__builtin_bit_cast(bf16x8, w), qr[d0], g, 0, 0, 0); }
#pragma unroll
            for (int r = 0; r < 16; ++r) if (crow(r, hi) >= qb) g[r] = -INFINITY;
#pragma unroll
            for (int round = 0; round < 3; ++round) {
                float m = g[0];
#pragma unroll
                for (int r = 1; r < 16; ++r) m = fmaxf(m, g[r]);
                int idx = 64;
#pragma unroll
                for (int r = 15; r >= 0; --r) if (g[r] == m) idx = crow(r, hi);
                const float pm = __shfl_xor(m, 32); const int pidx = __shfl_xor(idx, 32);
                const bool mine = (m > pm) || (m == pm && idx < pidx);
                const int win = mine ? idx : pidx;
                selmask |= 1u << (win & 31);
#pragma unroll
                for (int r = 0; r < 16; ++r) if (mine && crow(r, hi) == idx) g[r] = -INFINITY;
            }
        }
    }
    float zf_; asm volatile("v_mov_b32 %0, 0" : "=v"(zf_));
    float mhat = 0.f, l_reg = 0.f; f32x16 o[2]; f32x16 negm;
#pragma unroll
    for (int r = 0; r < 16; ++r) { o[0][r] = zf_; o[1][r] = zf_; negm[r] = zf_; }
    asm volatile("" : "+v"(negm));
    const int qrel = wid * QBLK + r32;
#define MASKT(P0, P1, t) do { const int a_ = TM(t); const int jb_ = a_ - (NT - 4); if (jb_ >= 0) cmask(P0, P1, jb_, qrel, hi); else selapply(P0, P1, ((selmask >> (a_ >> 2)) & 1u) != 0u); } while (0)
    bool resc = false;
#define START(P0, P1) do { const float rm = rowmax(P0, P1); resc = false; \
    { const float dl = rm; mhat = fadd_s(mhat, dl); \
      _Pragma("unroll") for (int r = 0; r < 16; ++r) { P0[r] = fsub_s(P0[r], dl); P1[r] = fsub_s(P1[r], dl); } \
      _Pragma("unroll") for (int r = 0; r < 16; ++r) negm[r] = -mhat; asm volatile("" : "+v"(negm)); } \
    _Pragma("unroll") for (int r = 0; r < 16; ++r) P0[r] = __builtin_amdgcn_exp2f(P0[r]); } while (0)
#define RESC() do { if (resc) { asm volatile("s_waitcnt lgkmcnt(0)" ::: "memory"); \
      _Pragma("unroll") for (int d_ = 0; d_ < 2; ++d_) _Pragma("unroll") for (int r = 0; r < 16; ++r) o[d_][r] *= wsf[crow(r, hi)]; } } while (0)
    f32x16 pA0, pA1, pB0, pB1;
    int sl_prev = 0, sl_cur = 0, sl_next = SLOTB;
#define ROT() do { sl_prev = sl_cur; sl_cur = sl_next; sl_next = (sl_next == (NSLOT - 1) * SLOTB) ? 0 : sl_next + SLOTB; } while (0)
    DMA_K(2, 2 * SLOTB);
    WAIT_BAR(3);
    qkt(pA0, pA1, Kbase, qr, negm, r32, hi); asm volatile("s_nop 15\n\ts_nop 7" : "+v"(pA0), "+v"(pA1)); MASKT(pA0, pA1, 0);
    START(pA0, pA1);
    _Pragma("unroll") for (int r = 0; r < 16; ++r) pA1[r] = __builtin_amdgcn_exp2f(pA1[r]);
    WAIT_BAR(0);
    DMA_K(3, 0); DMA_V(1, SLOTB);
    ROT();
    kload8(kf, kp0 + sl_cur);
    WAIT_BAR(2);
    s16x4 vlo[8], vhi[8]; u32x4 pw0, pw1, pw2, pw3;
#define PKW(P, B) cvtpk_s(P[B], P[B + 1])
#define PAF(k) __builtin_bit_cast(bf16x8, pw##k)
#define VFR(i) (bf16x8){vlo[i][0], vlo[i][1], vlo[i][2], vlo[i][3], vhi[i][0], vhi[i][1], vhi[i][2], vhi[i][3]}
#define PIN(x) asm volatile("" : "+v"(x))
#define MX3(a, b, c) __builtin_fmaxf(__builtin_fmaxf((a), (b)), (c))
#define GAPA(MF, A0, A1, A2, A3, W0, W1, PW) do { MF; sacc += A0; sacc += A1; sacc += A2; sacc += A3; PIN(sacc); W0; W1; PIN(PW); SBAR(); } while (0)
#define EX(v) __builtin_amdgcn_exp2f(v)
#define GAPB(MF, X, B) do { MF; X[B] = EX(X[B]); X[B + 1] = EX(X[B + 1]); X[B + 2] = EX(X[B + 2]); X[B + 3] = EX(X[B + 3]); PIN(X); SBAR(); } while (0)
#define VRD(i) do { vlo[i] = vtr(vp_ + (((i) >> 2) * 4096 + ((i) & 3) * 1024)); vhi[i] = vtr(vp_ + (((i) >> 2) * 4096 + ((i) & 3) * 1024 + 512)); } while (0)
#define KRD(G, j) do { if (G) { kload2(kf, kp0 + sl_next, j); SBAR(); } } while (0)
#define STEP(C0, C1, P0, P1, t, GK, GV, GL) do { SBAR(); \
    const lds_cptr vp_ = vp0 + sl_prev; \
    VRD(0); SBAR(); float sacc = (P0[0] + P0[1]); \
    GAPA(C0 = __builtin_amdgcn_mfma_f32_32x32x16_bf16(kf[0], qr[0], negm, 0, 0, 0), P0[2], P0[3], P0[4], P0[5],     pw0[0] = PKW(P0, 0), pw0[1] = PKW(P0, 2), pw0); \
    VRD(4); SBAR(); GAPA(C1 = __builtin_amdgcn_mfma_f32_32x32x16_bf16(kf[1], qr[0], negm, 0, 0, 0), P0[6], P0[7], P0[8], P0[9],     pw0[2] = PKW(P0, 4), pw0[3] = PKW(P0, 6), pw0); \
    VRD(1); SBAR(); GAPA(C0 = __builtin_amdgcn_mfma_f32_32x32x16_bf16(kf[2], qr[1], C0, 0, 0, 0),   P0[10], P0[11], P0[12], P0[13], pw1[0] = PKW(P0, 8), pw1[1] = PKW(P0, 10), pw1); \
    VRD(5); SBAR(); GAPA(C1 = __builtin_amdgcn_mfma_f32_32x32x16_bf16(kf[3], qr[1], C1, 0, 0, 0),   P0[14], P0[15], P1[0], P1[1],   pw1[2] = PKW(P0, 12), pw1[3] = PKW(P0, 14), pw1); \
    VRD(2); SBAR(); GAPA(C0 = __builtin_amdgcn_mfma_f32_32x32x16_bf16(kf[4], qr[2], C0, 0, 0, 0),   P1[2], P1[3], P1[4], P1[5],     pw2[0] = PKW(P1, 0), pw2[1] = PKW(P1, 2), pw2); \
    VRD(6); SBAR(); GAPA(C1 = __builtin_amdgcn_mfma_f32_32x32x16_bf16(kf[5], qr[2], C1, 0, 0, 0),   P1[6], P1[7], P1[8], P1[9],     pw2[2] = PKW(P1, 4), pw2[3] = PKW(P1, 6), pw2); \
    VRD(3); SBAR(); GAPA(C0 = __builtin_amdgcn_mfma_f32_32x32x16_bf16(kf[6], qr[3], C0, 0, 0, 0),   P1[10], P1[11], P1[12], P1[13], pw3[0] = PKW(P1, 8), pw3[1] = PKW(P1, 10), pw3); \
    VRD(7); SBAR(); GAPA(C1 = __builtin_amdgcn_mfma_f32_32x32x16_bf16(kf[7], qr[3], C1, 0, 0, 0),   P1[14], P1[15], 0.f, 0.f,       pw3[2] = PKW(P1, 12), pw3[3] = PKW(P1, 14), pw3); \
    l_reg += sacc; \
    if (GK) { DMA_K((t) + 3, sl_cur); } if (GV) { DMA_V((t) + 1, sl_next); } \
    MASKT(C0, C1, t); \
    { float a = MX3(C0[0], C0[1], C1[0]), b = MX3(C0[2], C0[3], C1[1]); a = MX3(a, C1[2], C1[3]); \
      _Pragma("unroll") for (int r = 4; r < 16; r += 4) { a = MX3(a, C0[r], C0[r + 1]); b = MX3(b, C0[r + 2], C0[r + 3]); a = MX3(a, C1[r], C1[r + 1]); b = MX3(b, C1[r + 2], C1[r + 3]); } \
      float rm = __builtin_fmaxf(a, b); { auto rr = __builtin_amdgcn_permlane32_swap(__float_as_uint(rm), __float_as_uint(rm), false, false); rm = __builtin_fmaxf(__uint_as_float(rr[0]), __uint_as_float(rr[1])); } \
      resc = false; \
      if (__builtin_expect(__any(rm > (float)THRL), 0)) { const float dl = __builtin_fmaxf(rm, 0.f); mhat += dl; \
        _Pragma("unroll") for (int r = 0; r < 16; ++r) { C0[r] -= dl; C1[r] -= dl; } \
        _Pragma("unroll") for (int r = 0; r < 16; ++r) negm[r] = -mhat; asm volatile("" : "+v"(negm)); \
        const float f = __builtin_amdgcn_exp2f(-dl); l_reg *= f; if (hi == 0) wsf[r32] = f; resc = true; } } \
    SBAR(); \
    GAPB(o[0] = __builtin_amdgcn_mfma_f32_32x32x16_bf16(PAF(0), VFR(0), o[0], 0, 0, 0), C0, 0); \
    GAPB(o[1] = __builtin_amdgcn_mfma_f32_32x32x16_bf16(PAF(0), VFR(4), o[1], 0, 0, 0), C0, 4); \
    KRD(GL, 0); GAPB(o[0] = __builtin_amdgcn_mfma_f32_32x32x16_bf16(PAF(1), VFR(1), o[0], 0, 0, 0), C0, 8); \
    KRD(GL, 1); GAPB(o[1] = __builtin_amdgcn_mfma_f32_32x32x16_bf16(PAF(1), VFR(5), o[1], 0, 0, 0), C0, 12); \
    KRD(GL, 2); GAPB(o[0] = __builtin_amdgcn_mfma_f32_32x32x16_bf16(PAF(2), VFR(2), o[0], 0, 0, 0), C1, 0); \
    KRD(GL, 3); GAPB(o[1] = __builtin_amdgcn_mfma_f32_32x32x16_bf16(PAF(2), VFR(6), o[1], 0, 0, 0), C1, 4); \
    GAPB(o[0] = __builtin_amdgcn_mfma_f32_32x32x16_bf16(PAF(3), VFR(3), o[0], 0, 0, 0), C1, 8); \
    GAPB(o[1] = __builtin_amdgcn_mfma_f32_32x32x16_bf16(PAF(3), VFR(7), o[1], 0, 0, 0), C1, 12); \
    } while (0)
    int t = 1;
    for (; t + 5 < NT; t += 2) {
        STEP(pB0, pB1, pA0, pA1, t, true, true, true);     WAIT_BAR(2); RESC(); ROT();
        STEP(pA0, pA1, pB0, pB1, t + 1, true, true, true); WAIT_BAR(2); RESC(); ROT();
    }
#define ENDW(tt) do { if ((tt) + 3 < NT) { WAIT_BAR(2); } else if ((tt) + 2 < NT) { WAIT_BAR(1); } else { WAIT_BAR(0); } } while (0)
    for (; t + 1 < NT; t += 2) {
        STEP(pB0, pB1, pA0, pA1, t, (t + 3 < NT), (t + 1 < NT), (t + 1 < NT));       ENDW(t);     RESC(); ROT();
        STEP(pA0, pA1, pB0, pB1, t + 1, (t + 4 < NT), (t + 2 < NT), (t + 2 < NT));   ENDW(t + 1); RESC(); ROT();
    }
    STEP(pB0, pB1, pA0, pA1, NT - 1, false, false, false); RESC();
    { float sacc = pB0[0] + pB0[1]; _Pragma("unroll") for (int r = 2; r < 16; ++r) sacc += pB0[r]; _Pragma("unroll") for (int r = 0; r < 16; ++r) sacc += pB1[r]; l_reg += sacc;
      pw0 = (u32x4){PKW(pB0, 0), PKW(pB0, 2), PKW(pB0, 4), PKW(pB0, 6)}; pw1 = (u32x4){PKW(pB0, 8), PKW(pB0, 10), PKW(pB0, 12), PKW(pB0, 14)}; pw2 = (u32x4){PKW(pB1, 0), PKW(pB1, 2), PKW(pB1, 4), PKW(pB1, 6)}; pw3 = (u32x4){PKW(pB1, 8), PKW(pB1, 10), PKW(pB1, 12), PKW(pB1, 14)};
      SBAR(); pv(o, vb0 + sl_cur, PAF(0), PAF(1), PAF(2), PAF(3)); }
#undef PKW
#undef PAF
#undef VFR
#undef PIN
#undef MX3
#undef GAPA
#undef GAPB
#undef EX
#undef VRD
#undef KRD
#undef STEP
#undef ENDW
    { auto rr = __builtin_amdgcn_permlane32_swap(__float_as_uint(l_reg), __float_as_uint(l_reg), false, false); l_reg = __uint_as_float(rr[0]) + __uint_as_float(rr[1]); }
    if (hi == 0) wsf[32 + r32] = l_reg; asm volatile("s_waitcnt lgkmcnt(0)" ::: "memory");
    float rli[16];
#pragma unroll
    for (int r = 0; r < 16; ++r) rli[r] = __builtin_amdgcn_rcpf(wsf[32 + crow(r, hi)]);
    bf16* Ow = O + (rowbase + q0 + wid * QBLK) * PITCH + h * D;
    { bf16* stg = (bf16*)(shm + LDS_OST) + wid * 2048;
#pragma unroll
      for (int r = 0; r < 16; ++r) { const int orow = crow(r, hi);
#pragma unroll
        for (int d0 = 0; d0 < 2; ++d0) stg[orow * 64 + d0 * 32 + r32] = __float2bfloat16(o[d0][r] * rli[r]); }
      asm volatile("s_waitcnt lgkmcnt(0)" ::: "memory");
#pragma unroll
      for (int i = 0; i < 4; ++i) { const int row = i * 8 + (lane >> 3), ch = lane & 7; const u32x4 v = *(const u32x4*)(stg + row * 64 + ch * 8); *(u32x4*)(Ow + (long)row * PITCH + ch * 8) = v; } }
    asm volatile("s_waitcnt lgkmcnt(0)\n\ts_barrier" ::: "memory");
#undef DMA_K
#undef DMA_V
#undef TM
#undef MASKT
#undef START
#undef RESC
#undef ROT
}
#undef SBAR
#undef WAIT_BAR
}

#define XB_TMO      128
#define XB_XCNT(j)  (256  + 64 * (j))
#define XB_XSUB(j)  (1280 + 64 * (j))
#define XB_XGEN(j)  (2304 + 64 * (j))
#define XB_TOP      3328
#define XB_TOPGEN   3392
#define XCD_BAR_WORDS 3456
#define XB_SPIN_CAP (1u << 18)
__device__ __forceinline__ unsigned xb_ld(unsigned* p)              { return __hip_atomic_load(p, __ATOMIC_RELAXED, __HIP_MEMORY_SCOPE_AGENT); }
__device__ __forceinline__ unsigned xb_add(unsigned* p, unsigned v) { return __hip_atomic_fetch_add(p, v, __ATOMIC_RELAXED, __HIP_MEMORY_SCOPE_AGENT); }
__device__ __forceinline__ unsigned xb_xcc_id() { return (unsigned)__builtin_amdgcn_s_getreg((3 << 11) | 20) & 0xFu; }
#define XB_SPIN(cond, bar) do { unsigned _sp = 0; while (cond) { __builtin_amdgcn_s_sleep(1); \
    if ((++_sp & 255u) == 0u) { if (xb_ld(&(bar)[XB_TMO])) break; if (_sp > XB_SPIN_CAP) { atomicAdd(&(bar)[XB_TMO], 1u); break; } } } } while (0)
struct XcdBarrier { unsigned* bar; unsigned x; volatile LAS unsigned* st; };
__device__ __forceinline__ XcdBarrier xcd_barrier_post(unsigned* bar, volatile LAS unsigned* st) {
    XcdBarrier b; b.bar = bar; b.x = xb_xcc_id(); b.st = st;
    if (threadIdx.x == 0) (void)xb_add(&bar[XB_XCNT(b.x)], 1u);
    return b;
}
__device__ __forceinline__ void xcd_barrier_complete(unsigned* bar, unsigned x, unsigned& nloc, unsigned& nx) {
    const unsigned G = gridDim.x * gridDim.y * gridDim.z;
    unsigned sum, cnt, mine, sp = 0u;
    for (;;) {
        sum = 0u; cnt = 0u; mine = 0u;
#pragma unroll
        for (unsigned j = 0; j < 16; ++j) { const unsigned c = xb_ld(&bar[XB_XCNT(j)]); sum += c; cnt += (c > 0u) ? 1u : 0u; mine = (j == x) ? c : mine; }
        if (sum == G) break;
        __builtin_amdgcn_s_sleep(1);
        if ((++sp & 255u) == 0u) { if (xb_ld(&bar[XB_TMO])) break; if (sp > XB_SPIN_CAP) { atomicAdd(&bar[XB_TMO], 1u); break; } }
    }
    nloc = mine > 0u ? mine : 1u; nx = cnt > 0u ? cnt : 1u;
}
__device__ __forceinline__ void xcd_barrier(const XcdBarrier& b) {
    asm volatile("s_waitcnt vmcnt(0)" ::: "memory");
    __syncthreads();
    if (threadIdx.x == 0) {
        unsigned* bar = b.bar;
        __builtin_amdgcn_s_waitcnt(0);
        unsigned nloc = b.st[0], nx = b.st[1];
        if (nloc == 0u) { xcd_barrier_complete(bar, b.x, nloc, nx); b.st[0] = nloc; b.st[1] = nx; }
        const unsigned old = xb_add(&bar[XB_XSUB(b.x)], 1u);
        const unsigned gen = old / nloc;
        if (old + 1u == (gen + 1u) * nloc) {
            __builtin_amdgcn_fence(__ATOMIC_RELEASE, "agent");
            asm volatile("s_waitcnt vmcnt(0)" ::: "memory");
            const unsigned og = xb_add(&bar[XB_TOP], 1u);
            const unsigned tg = og / nx;
            if (og + 1u == (tg + 1u) * nx) xb_add(&bar[XB_TOPGEN], 1u);
            else XB_SPIN(xb_ld(&bar[XB_TOPGEN]) == tg, bar);
            __builtin_amdgcn_fence(__ATOMIC_ACQUIRE, "agent");
            xb_add(&bar[XB_XGEN(b.x)], 1u);
            asm volatile("s_waitcnt vmcnt(0)" ::: "memory");
        } else {
            XB_SPIN(xb_ld(&bar[XB_XGEN(b.x)]) == gen, bar);
            __builtin_amdgcn_fence(__ATOMIC_ACQUIRE, "agent");
            asm volatile("s_waitcnt vmcnt(0)" ::: "memory");
        }
    }
    __syncthreads();
}

struct Args { const float* in[22]; float* out; unsigned char* ws; int ph_lo, ph_hi; };
struct Frame {
    LAS unsigned char* lds; volatile LAS unsigned* MISC; gu32* ctl;
    int tid, lane, wave, vcu, G;
};
__device__ __forceinline__ int fresh_tid() { int t = threadIdx.x; asm volatile("" : "+v"(t)); return t; }
#define PHASE_IDS() do { F.tid = fresh_tid(); F.lane = F.tid & 63; F.wave = __builtin_amdgcn_readfirstlane(F.tid >> 6); } while (0)

__device__ __forceinline__ void transpose_item(const float* W, int ldw, int k0, int n0, bf16_t* WT, size_t row_off, int Kd, LAS float* scr, int lane) {
    const int half = lane >> 5, j2 = 2 * (lane & 31);
#pragma unroll 8
    for (int i = 0; i < 32; ++i) { const int kk = 2 * i + half; const f32x2 v = *(const f32x2*)(W + (size_t)(k0 + kk) * ldw + n0 + j2); scr[kk * 65 + j2] = v.x; scr[kk * 65 + j2 + 1] = v.y; }
    LDS_WAIT(); asm volatile("" ::: "memory");
    const int c = lane & 7;
#pragma unroll
    for (int j = 0; j < 8; ++j) { const int n = (lane >> 3) + 8 * j; const LAS float* s = scr + (8 * c) * 65 + n;
        u32x4 o; o.x = cvt_pk_bf16(s[0 * 65], s[1 * 65]); o.y = cvt_pk_bf16(s[2 * 65], s[3 * 65]); o.z = cvt_pk_bf16(s[4 * 65], s[5 * 65]); o.w = cvt_pk_bf16(s[6 * 65], s[7 * 65]);
        *(u32x4*)(WT + (row_off + n0 + n) * (size_t)Kd + k0 + 8 * c) = o; }
    LDS_WAIT(); asm volatile("" ::: "memory");
}

__global__ void __launch_bounds__(NWAVES * 64, 2) hybrid_fwd(Args args) {
    extern __shared__ __attribute__((aligned(16))) unsigned char lds_raw[];
    Frame F;
    F.lds = (LAS unsigned char*)lds_raw;
    F.MISC = (volatile LAS unsigned*)(F.lds + MISC_OFF);
    F.tid = threadIdx.x; F.lane = F.tid & 63; F.wave = __builtin_amdgcn_readfirstlane(F.tid >> 6);
    F.G = gridDim.x; { const int bx = blockIdx.x; F.vcu = (F.G % 8 == 0) ? (bx % 8) * (F.G / 8) + bx / 8 : bx; }
    unsigned char* ws = args.ws;
    F.ctl = (gu32*)(ws + WS_CTL);
    const float* x = args.in[0]; const float* cvec = args.in[1]; const float* ada_w = args.in[2]; const float* ada_b = args.in[3];
    const float* norm1_g = args.in[4]; const float* norm2_g = args.in[5]; const float* w_in = args.in[6]; const float* gmlp_ln_g = args.in[7]; const float* gmlp_ln_b = args.in[8];
    const float* w_spatial = args.in[9]; const float* b_spatial = args.in[10]; const float* w_branch_a = args.in[11]; const float* w_branch_b = args.in[12]; const float* w_out = args.in[13];
    const float* w_rg = args.in[14]; const float* b_rg = args.in[15]; const float* w_re = args.in[16]; const float* b_re = args.in[17];
    const float* w_gate = args.in[18]; const float* w_up = args.in[19]; const float* w_down = args.in[20]; const float* final_g = args.in[21];
    float* out = args.out;
    float* KSUM = (float*)(ws + WS_KSUM); float* MODP = (float*)(ws + WS_MODP); float* MOD = (float*)(ws + WS_MOD); float* ROPE = (float*)(ws + WS_ROPE);
    bf16_t* WST = (bf16_t*)(ws + WS_WST); bf16_t* WRT = (bf16_t*)(ws + WS_WRT); float* SSQ = (float*)(ws + WS_SSQ);
    unsigned long long* ROUTE = (unsigned long long*)(ws + WS_ROUTE);
    bf16_t* WIN = (bf16_t*)(ws + WS_WIN); bf16_t* WA = (bf16_t*)(ws + WS_WA); bf16_t* WB = (bf16_t*)(ws + WS_WB); bf16_t* WOUT = (bf16_t*)(ws + WS_WOUT);
    bf16_t* WGU = (bf16_t*)(ws + WS_WGU); bf16_t* WD = (bf16_t*)(ws + WS_WD);
    bf16_t* XN = (bf16_t*)(ws + WS_XN); bf16_t* PROJ = (bf16_t*)(ws + WS_PROJ); bf16_t* HID = (bf16_t*)(ws + WS_HID); bf16_t* YB = (bf16_t*)(ws + WS_Y);

    for (int u = F.tid; u < 256; u += NWAVES * 64) ((LAS unsigned*)(F.lds + MISC_OFF))[u] = 0u;
    __syncthreads();
    XcdBarrier bar; bar.bar = (unsigned*)(F.ctl + CW_BAR); bar.x = 0; bar.st = nullptr;
    if (!MK_PER_PHASE) bar = xcd_barrier_post((unsigned*)(F.ctl + CW_BAR), F.MISC + 8);
    const int lo = args.ph_lo, hi = args.ph_hi;
#define IN(k) (lo <= (k) && (k) < hi)
#define SEAM(k) do { if (IN(k) && IN((k) + 1)) xcd_barrier(bar); } while (0)

    if (IN(0)) { PHASE_IDS();
        const int gw = F.vcu * NWAVES + F.wave, NGW = F.G * NWAVES;
        const int gtid = F.vcu * (NWAVES * 64) + F.tid, NGT = F.G * NWAVES * 64;
        LAS float* scr = (LAS float*)(F.lds + F.wave * 16640);
        constexpr int I_MOD = 16 * 24, I_IN = 16 * 72, I_A = 8 * 16, I_O = 16 * 16, I_G = 32 * 16 * 8, I_D = 32 * 8 * 16;
        constexpr int NITEMS = I_MOD + I_IN + 2 * I_A + I_O + 2 * I_G + I_D;
        for (int it = gw; it < NITEMS; it += NGW) {
            int r = it;
            if (r < I_MOD) {
                const int s = r / 24, nc = r % 24, n = nc * 256 + 4 * F.lane;
                f32x4 a0 = {0.f, 0.f, 0.f, 0.f}, a1 = a0, a2 = a0, a3 = a0;
#pragma unroll 8
                for (int kk = 0; kk < 64; ++kk) { const int k = 64 * s + kk; const f32x4 w = *(const f32x4*)(ada_w + (size_t)k * 6144 + n);
                    a0 += w * cvec[k]; a1 += w * cvec[1024 + k]; a2 += w * cvec[2048 + k]; a3 += w * cvec[3072 + k]; }
                float* dst = MODP + (size_t)s * 24576 + n;
                *(f32x4*)(dst) = a0; *(f32x4*)(dst + 6144) = a1; *(f32x4*)(dst + 12288) = a2; *(f32x4*)(dst + 18432) = a3;
                continue; }
            r -= I_MOD;
            if (r < I_IN) { transpose_item(w_in, PC, 64 * (r / 72), 64 * (r % 72), WIN, 0, 1024, scr, F.lane); continue; } r -= I_IN;
            if (r < I_A) { transpose_item(w_branch_a, 1024, 64 * (r / 16), 64 * (r % 16), WA, 0, 512, scr, F.lane); continue; } r -= I_A;
            if (r < I_A) { transpose_item(w_branch_b, 1024, 64 * (r / 16), 64 * (r % 16), WB, 0, 512, scr, F.lane); continue; } r -= I_A;
            if (r < I_O) { transpose_item(w_out, 1024, 64 * (r / 16), 64 * (r % 16), WOUT, 0, 1024, scr, F.lane); continue; } r -= I_O;
            if (r < 2 * I_G) { const bool up = r >= I_G; if (up) r -= I_G; const int e = r / 128, kb = (r % 128) / 8, nb = r % 8, n0 = 64 * nb;
                const size_t row_off = (size_t)e * 1024 + (size_t)(n0 / 128) * 256 + (up ? 128 : 0) + (n0 % 128) - n0;
                transpose_item((up ? w_up : w_gate) + (size_t)e * 1024 * 512, 512, 64 * kb, n0, WGU, row_off, 1024, scr, F.lane); continue; }
            r -= 2 * I_G;
            { const int e = r / 128, kb = (r % 128) / 16, nb = r % 16; transpose_item(w_down + (size_t)e * 512 * 1024, 1024, 64 * kb, 64 * nb, WD, (size_t)e * 1024, 512, scr, F.lane); }
        }
        for (int i = gtid; i < 65536; i += NGT) {
            const int pos = i >> 3, j = i & 7; const float inv = powf(500000.0f, -(float)j * 2.0f / 16.0f); const float ang = (float)pos * inv;
            ROPE[i] = cosf(ang); ROPE[65536 + i] = sinf(ang); }
        for (int i = gtid; i < 65536; i += NGT) {
            const int s = i & 127, t_ = (i >> 7) & 127; const float v = (s <= t_) ? w_spatial[i] : 0.f; WST[i] = (bf16_t)(cvt_pk_bf16(v, 0.f) & 0xffffu); }
        for (int i = gtid; i < 48 * 1024; i += NGT) {
            const int j = i >> 10, k = i & 1023; float v = 0.f; if (j < 4) v = w_rg[k * 4 + j]; else if (j < 36) v = w_re[k * 32 + (j - 4)]; WRT[i] = (bf16_t)(cvt_pk_bf16(v, 0.f) & 0xffffu); }
    }
    SEAM(0);

    if (IN(1)) { PHASE_IDS();
        const int c = F.vcu, b = c >> 6;
        LAS float* f = (LAS float*)F.lds;
        for (int v = F.tid; v < 2048; v += NWAVES * 64) { float s = ada_b[v];
#pragma unroll
            for (int sl = 0; sl < 16; ++sl) s += MODP[(size_t)sl * 24576 + b * 6144 + v];
            f[v] = s; }
        if (F.tid < 96) { const int idx = 96 * c + F.tid; float s = ada_b[idx % 6144];
#pragma unroll
            for (int sl = 0; sl < 16; ++sl) s += MODP[(size_t)sl * 24576 + idx];
            MOD[idx] = s; }
        __syncthreads();
        f32x4 A1[4], B1[4];
#pragma unroll
        for (int j = 0; j < 4; ++j) { const int k = 4 * F.lane + 256 * j; const f32x4 g = *(const f32x4*)(norm1_g + k);
#pragma unroll
            for (int i = 0; i < 4; ++i) { A1[j][i] = g[i] * (1.0f + f[1024 + k + i]); B1[j][i] = f[k + i]; } }
        for (int i = 0; i < 16; ++i) { const size_t row = (size_t)c * 128 + F.wave * 16 + i;
            const f32x4* xr = (const f32x4*)(x + row * DM) + F.lane; f32x4 v[4]; float s = 0.f;
#pragma unroll
            for (int j = 0; j < 4; ++j) { v[j] = xr[64 * j]; s += (v[j].x * v[j].x + v[j].y * v[j].y) + (v[j].z * v[j].z + v[j].w * v[j].w); }
            const float rstd = 1.0f / sqrtf(wave_sum(s) * (1.0f / DM) + EPS);
            u32x2* o8 = (u32x2*)(XN + row * DM) + F.lane;
#pragma unroll
            for (int j = 0; j < 4; ++j) { const f32x4 hv = v[j] * rstd * A1[j] + B1[j]; u32x2 w; w.x = cvt_pk_bf16(hv.x, hv.y); w.y = cvt_pk_bf16(hv.z, hv.w); o8[64 * j] = w; } }
        __syncthreads();
    }
    SEAM(1);

    if (IN(2)) {
        pg8::DenseSched S; S.init(XN, DM, WIN, DM, T, PC, F.G, (int)blockIdx.x);
        pg8::EpiProj E{PROJ, ROPE, KSUM};
        pg8::gemm_phase<pg8::EpiProj, pg8::DenseSched, false>(F.lds, S, E);
    }
    SEAM(2);

    if (IN(3)) { PHASE_IDS();
        for (int chunk = F.vcu; chunk < T / 128; chunk += F.G) {
            const int lane = F.lane, w = F.wave, q = lane >> 4, l15 = lane & 15;
            const size_t row0 = (size_t)chunk * 128;
            float lg[8], lb[8];
            { const f32x4 g0 = *(const f32x4*)(gmlp_ln_g + 8 * lane), g1 = *(const f32x4*)(gmlp_ln_g + 8 * lane + 4), b0 = *(const f32x4*)(gmlp_ln_b + 8 * lane), b1 = *(const f32x4*)(gmlp_ln_b + 8 * lane + 4);
#pragma unroll
              for (int j = 0; j < 4; ++j) { lg[j] = g0[j]; lg[4 + j] = g1[j]; lb[j] = b0[j]; lb[4 + j] = b1[j]; } }
            u32x4 vn[16];
#pragma unroll
            for (int i = 0; i < 16; ++i) { const size_t row = row0 + 16 * w + i; const u32x4 raw = *(const u32x4*)(PROJ + row * PC + C_V + 8 * lane);
                float v[8] = {bflo(raw.x), bfhi(raw.x), bflo(raw.y), bfhi(raw.y), bflo(raw.z), bfhi(raw.z), bflo(raw.w), bfhi(raw.w)};
                float s = 0.f;
#pragma unroll
                for (int j = 0; j < 8; ++j) s += v[j];
                const float mean = wave_sum(s) * (1.0f / 512.0f); float s2 = 0.f;
#pragma unroll
                for (int j = 0; j < 8; ++j) { v[j] -= mean; s2 += v[j] * v[j]; }
                const float rstd = 1.0f / sqrtf(wave_sum(s2) * (1.0f / 512.0f) + EPS);
#pragma unroll
                for (int j = 0; j < 8; ++j) v[j] = v[j] * rstd * lg[j] + lb[j];
                vn[i].x = cvt_pk_bf16(v[0], v[1]); vn[i].y = cvt_pk_bf16(v[2], v[3]); vn[i].z = cvt_pk_bf16(v[4], v[5]); vn[i].w = cvt_pk_bf16(v[6], v[7]); }
            for (int g = 0; g < 4; ++g) {
                __syncthreads();
                if (q == g) {
#pragma unroll
                    for (int i = 0; i < 16; ++i) *(LAS u32x4*)(F.lds + (16 * w + i) * 288 + l15 * 16) = vn[i];
                }
                __syncthreads();
                f32x4 acc[8];
#pragma unroll
                for (int it = 0; it < 8; ++it) acc[it] = (f32x4){0.f, 0.f, 0.f, 0.f};
                const int tt = 16 * w + l15;
                const int nks = (16 * w + 16 + 31) / 32;
                for (int ks = 0; ks < nks; ++ks) {
                    const bf16_t* wp = WST + ((size_t)(g * 128 + tt)) * 128 + 32 * ks + 4 * q;
                    const u32x2 wlo = *(const u32x2*)wp, whi = *(const u32x2*)(wp + 16);
                    const bf16x8 bw = __builtin_bit_cast(bf16x8, (u32x4){wlo.x, wlo.y, whi.x, whi.y});
                    const attn_body::lds_cptr base = (attn_body::lds_cptr)F.lds + (32 * ks + 4 * q + (l15 >> 2)) * 288 + (l15 & 3) * 8;
#pragma unroll
                    for (int it = 0; it < 8; ++it) {
                        const s16x4 lo = attn_body::vtr(base + it * 32), hi_ = attn_body::vtr(base + 16 * 288 + it * 32);
                        const bf16x8 a = (bf16x8){lo[0], lo[1], lo[2], lo[3], hi_[0], hi_[1], hi_[2], hi_[3]};
                        acc[it] = __builtin_amdgcn_mfma_f32_16x16x32_bf16(a, bw, acc[it], 0, 0, 0);
                    }
                }
                const float bs = b_spatial[g * 128 + tt];
                bf16_t* prow = PROJ + (row0 + tt) * PC + C_U + 128 * g + 4 * q;
#pragma unroll
                for (int it = 0; it < 8; ++it) { const u32x2 uu = *(const u32x2*)(prow + 16 * it);
                    u32x2 o; o.x = cvt_pk_bf16(bflo(uu.x) * (acc[it][0] + bs), bfhi(uu.x) * (acc[it][1] + bs)); o.y = cvt_pk_bf16(bflo(uu.y) * (acc[it][2] + bs), bfhi(uu.y) * (acc[it][3] + bs));
                    *(u32x2*)(prow + 16 * it) = o; }
            }
            __syncthreads();
        }
        {
            const int s = F.vcu & 7, bh = F.vcu >> 3;
            if (bh < NB * 8) {
                for (int i = 0; i < 4; ++i) { const int qb = (i == 0) ? s : (i == 1) ? 15 - s : (i == 2) ? 16 + s : 31 - s;
                    attn_body::attn_unit<8>(bh >> 3, bh & 7, qb, (const attn_body::bf16*)(PROJ + C_Q), (const attn_body::bf16*)(PROJ + C_K), (const attn_body::bf16*)(PROJ + C_VV), (attn_body::bf16*)(PROJ + C_Q), KSUM, (char*)lds_raw); }
            }
        }
        VM_WAIT(); __syncthreads();
    }
    SEAM(3);

    if (IN(4)) {
        { pg8::DenseSched S; S.init(PROJ + C_U, PC, WA, 512, T, DM, F.G, (int)blockIdx.x); pg8::EpiMerge<true> E{PROJ, XN};
          pg8::gemm_phase<pg8::EpiMerge<true>, pg8::DenseSched, false>(F.lds, S, E); }
        { pg8::DenseSched S; S.init(PROJ + C_Q, PC, WB, 512, T, DM, F.G, (int)blockIdx.x); pg8::EpiMerge<false> E{PROJ, XN};
          pg8::gemm_phase<pg8::EpiMerge<false>, pg8::DenseSched, false>(F.lds, S, E); }
    }
    SEAM(4);

    if (IN(5)) {
        pg8::DenseSched S; S.init(XN, DM, WOUT, DM, T, DM, F.G, (int)blockIdx.x); pg8::EpiOut E{x, out, MOD, SSQ};
        pg8::gemm_phase<pg8::EpiOut, pg8::DenseSched, false>(F.lds, S, E);
    }
    SEAM(5);

    if (IN(6)) { PHASE_IDS();
        const int c = F.vcu, b = c >> 6, lane = F.lane, w = F.wave, r = lane & 15, q = lane >> 4;
        LAS float* A2 = (LAS float*)F.lds; LAS float* B2 = A2 + 1024; LAS float* LG = (LAS float*)(F.lds + 8192) + w * 768;
        LAS unsigned* hist = (LAS unsigned*)(F.lds + 8192 + 8 * 3072); LAS unsigned* basev = hist + 32;
        for (int k = F.tid; k < 1024; k += NWAVES * 64) { A2[k] = norm2_g[k] * (1.0f + MOD[b * 6144 + 4096 + k]); B2[k] = MOD[b * 6144 + 3072 + k]; }
        if (F.tid < 32) hist[F.tid] = 0u;
        __syncthreads();
        const size_t row = (size_t)c * 128 + w * 16 + r;
        float rs;
        { const f32x4* sp = (const f32x4*)(SSQ + row * 16); const f32x4 s0 = sp[0], s1 = sp[1], s2 = sp[2], s3 = sp[3];
          const float ss = ((s0[0] + s0[1]) + (s0[2] + s0[3])) + ((s1[0] + s1[1]) + (s1[2] + s1[3])) + ((s2[0] + s2[1]) + (s2[2] + s2[3])) + ((s3[0] + s3[1]) + (s3[2] + s3[3]));
          rs = 1.0f / sqrtf(ss * (1.0f / DM) + EPS); }
        f32x4 acc[3];
#pragma unroll
        for (int jt = 0; jt < 3; ++jt) acc[jt] = (f32x4){0.f, 0.f, 0.f, 0.f};
        const float* xrow = out + row * DM;
#pragma unroll 4
        for (int s = 0; s < 32; ++s) { const int k0 = 32 * s + 8 * q;
            const f32x4 x0 = *(const f32x4*)(xrow + k0), x1v = *(const f32x4*)(xrow + k0 + 4);
            const f32x4 a0 = *(const LAS f32x4*)(A2 + k0), a1 = *(const LAS f32x4*)(A2 + k0 + 4), b0 = *(const LAS f32x4*)(B2 + k0), b1 = *(const LAS f32x4*)(B2 + k0 + 4);
            const f32x4 h0 = x0 * rs * a0 + b0, h1 = x1v * rs * a1 + b1;
            u32x4 hw; hw.x = cvt_pk_bf16(h0[0], h0[1]); hw.y = cvt_pk_bf16(h0[2], h0[3]); hw.z = cvt_pk_bf16(h1[0], h1[1]); hw.w = cvt_pk_bf16(h1[2], h1[3]);
            *(u32x4*)(XN + row * DM + k0) = hw;
            const bf16x8 hb = __builtin_bit_cast(bf16x8, hw);
#pragma unroll
            for (int jt = 0; jt < 3; ++jt) { const bf16x8 wf = *(const bf16x8*)(WRT + (size_t)(16 * jt + r) * 1024 + k0);
                acc[jt] = __builtin_amdgcn_mfma_f32_16x16x32_bf16(wf, hb, acc[jt], 0, 0, 0); } }
#pragma unroll
        for (int jt = 0; jt < 3; ++jt) *(LAS f32x4*)(LG + r * 48 + 16 * jt + 4 * q) = acc[jt];
        LDS_WAIT(); asm volatile("" ::: "memory");
        int E0 = 0, E1 = 0; float w0 = 0.f, w1 = 0.f; unsigned lp0 = 0u, lp1 = 0u;
        if (lane < 16) {
            const LAS float* lgp = LG + lane * 48;
            float gl[4];
#pragma unroll
            for (int j = 0; j < 4; ++j) gl[j] = lgp[j] + b_rg[j];
            int g = 0; float gm = gl[0];
#pragma unroll
            for (int j = 1; j < 4; ++j) if (gl[j] > gm) { gm = gl[j]; g = j; }
            float gs = 0.f;
#pragma unroll
            for (int j = 0; j < 4; ++j) gs += __expf(gl[j] - gm);
            const float gp = 1.0f / gs;
            float m0 = -INFINITY, m1 = -INFINITY; int i0 = 0, i1 = 0;
#pragma unroll
            for (int j = 0; j < 8; ++j) { const float el = lgp[4 + 8 * g + j] + b_re[g * 8 + j];
                if (el > m0) { m1 = m0; i1 = i0; m0 = el; i0 = j; } else if (el > m1) { m1 = el; i1 = j; } }
            const float d = __expf(m1 - m0), inv = 1.0f / (1.0f + d);
            w0 = gp * inv; w1 = gp * d * inv; E0 = 8 * g + i0; E1 = 8 * g + i1;
            lp0 = __hip_atomic_fetch_add(hist + E0, 1u, __ATOMIC_RELAXED, __HIP_MEMORY_SCOPE_WORKGROUP);
            lp1 = __hip_atomic_fetch_add(hist + E1, 1u, __ATOMIC_RELAXED, __HIP_MEMORY_SCOPE_WORKGROUP);
        }
        __syncthreads();
        if (F.tid < 32) { const unsigned n = hist[F.tid]; basev[F.tid] = n ? __hip_atomic_fetch_add((unsigned*)(F.ctl + CW_CURSOR + 64 * F.tid), n, RLX_AGENT) : 0u; }
        __syncthreads();
        if (lane < 16) { const unsigned tok = (unsigned)(c * 128 + w * 16 + lane);
            ROUTE[(size_t)E0 * 32768 + basev[E0] + lp0] = ((unsigned long long)__float_as_uint(w0) << 32) | (unsigned long long)(2u * tok);
            ROUTE[(size_t)E1 * 32768 + basev[E1] + lp1] = ((unsigned long long)__float_as_uint(w1) << 32) | (unsigned long long)(2u * tok + 1u); }
        __syncthreads();
    }
    SEAM(6);

    if (IN(7) || IN(8)) { PHASE_IDS();
        volatile LAS int* tab = (volatile LAS int*)(F.lds + MISC_OFF + 256);
        if (F.tid < 32) tab[F.tid] = (int)__hip_atomic_load((unsigned*)(F.ctl + CW_CURSOR + 64 * F.tid), RLX_AGENT);
        __syncthreads();
        if (F.tid == 0) { int o = 0; for (int e = 0; e < 32; ++e) { tab[32 + e] = o; o += (tab[e] + 255) >> 8; } tab[64] = o; }
        __syncthreads();
        const int U = 4 * __builtin_amdgcn_readfirstlane(tab[64]);
        const int xq = F.vcu >> 5, jj = F.vcu & 31;
        pg8::MoeSched S; S.tab = tab; S.start = (int)(((long)U * xq) / 8); S.end = (int)(((long)U * (xq + 1)) / 8); S.j = jj; S.route = ROUTE;
        if (IN(7)) {
            S.A = (const char*)XN; S.lda = DM; S.K = DM; S.Bt = (const char*)WGU; S.bstride = (size_t)1024 * 1024 * 2; S.gather = true;
            pg8::EpiGU E{HID};
            pg8::gemm_phase<pg8::EpiGU, pg8::MoeSched, true>(F.lds, S, E);
        }
        SEAM(7);
        if (IN(8)) {
            S.A = (const char*)HID; S.lda = DEXP; S.K = DEXP; S.Bt = (const char*)WD; S.bstride = (size_t)1024 * 512 * 2; S.gather = false;
            pg8::EpiDown E{YB, ROUTE};
            pg8::gemm_phase<pg8::EpiDown, pg8::MoeSched, false>(F.lds, S, E);
        }
    }
    SEAM(8);

    if (IN(9)) { PHASE_IDS();
        const int c = F.vcu, b = c >> 6;
        f32x4 G2[4], FG[4];
#pragma unroll
        for (int j = 0; j < 4; ++j) { const int k = 4 * F.lane + 256 * j; G2[j] = *(const f32x4*)(MOD + b * 6144 + 5120 + k); FG[j] = *(const f32x4*)(final_g + k); }
        for (int i = 0; i < 16; ++i) { const size_t row = (size_t)c * 128 + F.wave * 16 + i;
            f32x4* xr = (f32x4*)(out + row * DM) + F.lane; const u32x2* y0 = (const u32x2*)(YB + (2 * row) * DM) + F.lane; const u32x2* y1 = (const u32x2*)(YB + (2 * row + 1) * DM) + F.lane;
            f32x4 v[4]; float s = 0.f;
#pragma unroll
            for (int j = 0; j < 4; ++j) { const u32x2 a = y0[64 * j], bb = y1[64 * j]; const f32x4 ys = {bflo(a.x) + bflo(bb.x), bfhi(a.x) + bfhi(bb.x), bflo(a.y) + bflo(bb.y), bfhi(a.y) + bfhi(bb.y)};
                v[j] = xr[64 * j] + G2[j] * ys; s += (v[j].x * v[j].x + v[j].y * v[j].y) + (v[j].z * v[j].z + v[j].w * v[j].w); }
            const float rstd = 1.0f / sqrtf(wave_sum(s) * (1.0f / DM) + EPS);
#pragma unroll
            for (int j = 0; j < 4; ++j) xr[64 * j] = v[j] * rstd * FG[j]; }
    }
#undef IN
#undef SEAM
}

extern "C" void kernel_launch(void* const* d_in, const int* in_sizes, int n_in, void* d_out, int out_size, void* d_ws, size_t ws_size, hipStream_t stream) {
    static int grid = 0;
    if (grid == 0) {
        if (n_in != 22 || in_sizes[0] != T * DM || out_size != T * DM || ws_size < WS_END) { fprintf(stderr, "kernel_launch: unexpected shapes (n_in %d, in0 %d, out %d, ws %zu); nothing launched\n", n_in, n_in > 0 ? in_sizes[0] : -1, out_size, ws_size); grid = -1; return; }
        int dev = 0, cus = 0, per_cu = 0;
        if (hipGetDevice(&dev) != hipSuccess || hipDeviceGetAttribute(&cus, hipDeviceAttributeMultiprocessorCount, dev) != hipSuccess) { fprintf(stderr, "kernel_launch: device query failed\n"); grid = -1; return; }
        if (hipFuncSetAttribute((const void*)hybrid_fwd, hipFuncAttributeMaxDynamicSharedMemorySize, LDS_BYTES) != hipSuccess) { fprintf(stderr, "kernel_launch: hipFuncSetAttribute failed\n"); grid = -1; return; }
        if (hipOccupancyMaxActiveBlocksPerMultiprocessor(&per_cu, (const void*)hybrid_fwd, NWAVES * 64, LDS_BYTES) != hipSuccess || per_cu < 1) { fprintf(stderr, "kernel_launch: occupancy query reports %d blocks per CU\n", per_cu); }
        (void)hipGetLastError();
        if (cus != 256) { fprintf(stderr, "kernel_launch: built for 256 CUs, device has %d; nothing launched\n", cus); grid = -1; return; }
        grid = cus;
    }
    if (grid < 0) return;
    (void)hipMemsetAsync((char*)d_ws + WS_CTL, 0, CTL_ZERO_BYTES, stream);
    Args a{};
    for (int i = 0; i < 22; ++i) a.in[i] = (const float*)d_in[i];
    a.out = (float*)d_out; a.ws = (unsigned char*)d_ws;
#if MK_PER_PHASE
    for (int p = 0; p < 10; ++p) { a.ph_lo = p; a.ph_hi = p + 1; hipLaunchKernelGGL(hybrid_fwd, dim3(grid), dim3(NWAVES * 64), LDS_BYTES, stream, a); }
#else
    a.ph_lo = 0; a.ph_hi = 10;
    hipLaunchKernelGGL(hybrid_fwd, dim3(grid), dim3(NWAVES * 64), LDS_BYTES, stream, a);
#endif
    const hipError_t le = hipPeekAtLastError();
    if (le != hipSuccess) fprintf(stderr, "kernel_launch: launch failed: %s\n", hipGetErrorName(le));
}
```

```cpp
#include <hip/hip_runtime.h>
#include <hip/hip_bf16.h>
#include <cstdio>
#include <cstdint>
#include <cmath>

#ifndef PROBE_ID
#define PROBE_ID 0
#endif
#ifndef ATTN_MODE
#define ATTN_MODE 1
#endif
#ifndef MK_PER_PHASE
#define MK_PER_PHASE 0
#endif

#define LAS __attribute__((address_space(3)))
#define GAS __attribute__((address_space(1)))
typedef unsigned short bf16_t;
typedef short bf16x8 __attribute__((ext_vector_type(8)));
typedef short s16x4 __attribute__((ext_vector_type(4)));
typedef float f32x2 __attribute__((ext_vector_type(2)));
typedef float f32x4 __attribute__((ext_vector_type(4)));
typedef float f32x16 __attribute__((ext_vector_type(16)));
typedef unsigned u32x2 __attribute__((ext_vector_type(2)));
typedef unsigned u32x4 __attribute__((ext_vector_type(4)));
typedef GAS unsigned gu32;

constexpr int NB = 4, SEQ = 8192, DM = 1024, T = NB * SEQ;
constexpr int PC = 4608;
constexpr int C_U = 0, C_V = 512, C_Q = 1024, C_K = 1536, C_VV = 2048, C_GA = 2560, C_GB = 3584;
constexpr int NEXP = 32, DEXP = 512;
constexpr float EPS = 1e-6f;
constexpr float QSCALE = 0.125f * 1.4426950408889634f;

constexpr size_t MiB = 1u << 20;
constexpr size_t WS_CTL = 0, CTL_ZERO_BYTES = 2 * MiB;
constexpr size_t WS_KSUM = 1 * MiB;
constexpr size_t WS_MODP = 2 * MiB;
constexpr size_t WS_MOD = 3 * MiB + 512 * 1024;
constexpr size_t WS_ROPE = 4 * MiB;
constexpr size_t WS_WST = 4 * MiB + 512 * 1024;
constexpr size_t WS_WRT = 4 * MiB + 768 * 1024;
constexpr size_t WS_SSQ = 5 * MiB;
constexpr size_t WS_ROUTE = 8 * MiB;
constexpr size_t WS_WIN = 24 * MiB;
constexpr size_t WS_WA = 34 * MiB, WS_WB = 35 * MiB, WS_WOUT = 36 * MiB;
constexpr size_t WS_WGU = 40 * MiB;
constexpr size_t WS_WD = 104 * MiB;
constexpr size_t WS_XN = 136 * MiB;
constexpr size_t WS_PROJ = 200 * MiB;
constexpr size_t WS_HID = 200 * MiB;
constexpr size_t WS_Y = 272 * MiB;
constexpr size_t WS_X1 = 400 * MiB;
constexpr size_t WS_PO = 40 * MiB;
constexpr size_t WS_PML = 136 * MiB;
constexpr size_t WS_LIST = 488 * MiB;
constexpr size_t WS_END = 504 * MiB;
constexpr int CW_TMO = 0, CW_DIFF = 2, CW_BAR = 4096, CW_CURSOR = 32768, CW_CNT = 65536;

constexpr int RING_BYTES = 131072;
constexpr int LDS_BYTES = 147456;
constexpr int MISC_OFF = LDS_BYTES - 1024;
constexpr int NWAVES = 8;

#define LDS_WAIT() asm volatile("s_waitcnt lgkmcnt(0)" ::: "memory")
#define VM_WAIT() asm volatile("s_waitcnt vmcnt(0)" ::: "memory")
#define RLX_AGENT __ATOMIC_RELAXED, __HIP_MEMORY_SCOPE_AGENT

__device__ __forceinline__ unsigned cvt_pk_bf16(float lo, float hi) { unsigned r; asm volatile("v_cvt_pk_bf16_f32 %0, %1, %2" : "=v"(r) : "v"(lo), "v"(hi)); return r; }
__device__ __forceinline__ float bflo(unsigned u) { return __uint_as_float(u << 16); }
__device__ __forceinline__ float bfhi(unsigned u) { return __uint_as_float(u & 0xffff0000u); }
__device__ __forceinline__ float sigmoidf_(float x) { return __builtin_amdgcn_rcpf(1.0f + __builtin_amdgcn_exp2f(-1.4426950408889634f * x)); }
__device__ __forceinline__ float gelu_tanh(float x) { const float u = x + 0.044715f * x * x * x; return x * __builtin_amdgcn_rcpf(1.0f + __builtin_amdgcn_exp2f(-2.3022081985f * u)); }
__device__ __forceinline__ float wave_sum(float v) {
#pragma unroll
    for (int o = 1; o < 64; o <<= 1) v += __shfl_xor(v, o);
    return v;
}

namespace pg8 {
constexpr int BM = 256, BK = 64, HALF = 128, HTB = HALF * BK * 2, STAGE_BYTES = 8 * HTB, NXCD = 8, WGM = 8;
__host__ __device__ __forceinline__ int lds_byte(int r, int c) { const int st = (r >> 4) * 2 + (c >> 5), rr = r & 15, cc = c & 31, ob = rr * 64 + cc * 2; return st * 1024 + (ob ^ (((ob >> 9) & 1) << 5)); }
__host__ __device__ __forceinline__ void stage_rc(int b, int& R, int& C) { const int st = b / 1024, sb = b % 1024, swz = sb ^ (((sb >> 9) & 1) << 5); R = (st >> 1) * 16 + swz / 64; C = (st & 1) * 32 + (swz % 64) / 2; }
__host__ __device__ __forceinline__ int perm32(int rho) { const int n = rho >> 4, i = rho & 15; return 8 * (i >> 2) + 4 * n + (i & 3); }

struct Unit { int pm, pn, e, lt, nvalid; };

struct DenseSched {
    const char* A; const char* Bt; int lda, K; int nM, nN, nwg, G, c;
    __device__ void init(const void* A_, int lda_, const void* Bt_, int K_, int M, int N, int G_, int c_) { A = (const char*)A_; Bt = (const char*)Bt_; lda = lda_; K = K_; nM = M / BM; nN = N / BM; nwg = nM * nN; G = G_; c = c_; }
    __device__ __forceinline__ bool next(int i, Unit& u) const {
        const long L = (long)i * G + c; if (L >= nwg) return false;
        int wgid = (int)L; { const int q = nwg / NXCD, r = nwg % NXCD, xcd = wgid % NXCD, off = wgid / NXCD; wgid = (xcd < r ? xcd * (q + 1) : r * (q + 1) + (xcd - r) * q) + off; }
        const int nig = WGM * nN, gid = wgid / nig, fm = gid * WGM, gsz = (nM - fm) < WGM ? (nM - fm) : WGM;
        u.pm = fm + ((wgid % nig) % gsz); u.pn = (wgid % nig) / gsz; u.e = 0; u.lt = 0; u.nvalid = 256; return true;
    }
    __device__ __forceinline__ const char* a_base(const Unit& u) const { return A + (size_t)u.pm * BM * lda * 2; }
    __device__ __forceinline__ const char* b_base(const Unit& u) const { return Bt + (size_t)u.pn * BM * K * 2; }
    __device__ __forceinline__ unsigned gather_off(const Unit&, int, int) const { return 0u; }
};
struct MoeSched {
    const char* A; const char* Bt; int lda, K; size_t bstride;
    const unsigned long long* route; bool gather;
    const volatile LAS int* tab;
    int start, end, j;
    __device__ __forceinline__ bool next(int i, Unit& u) const {
        const int idx = start + i * 32 + j; if (idx >= end) return false;
        const int tile = idx >> 2; u.pn = idx & 3; u.pm = tile;
        int e = 0;
        for (int k = 1; k < 32; ++k) e += (__builtin_amdgcn_readfirstlane(tab[32 + k]) <= tile) ? 1 : 0;
        u.e = e; u.lt = tile - __builtin_amdgcn_readfirstlane(tab[32 + e]);
        const int rem = __builtin_amdgcn_readfirstlane(tab[e]) - 256 * u.lt; u.nvalid = rem < 256 ? rem : 256; return true;
    }
    __device__ __forceinline__ const char* a_base(const Unit& u) const { return gather ? A : A + (size_t)u.pm * BM * lda * 2; }
    __device__ __forceinline__ const char* b_base(const Unit& u) const { return Bt + (size_t)u.e * bstride + (size_t)u.pn * BM * K * 2; }
    __device__ __forceinline__ unsigned gather_off(const Unit& u, int r, int C) const {
        unsigned tok = 0u;
        if (r < u.nvalid) tok = (unsigned)(route[(size_t)u.e * 32768 + (size_t)u.lt * 256 + r] & 0xffffffffull) >> 1;
        return (tok * (unsigned)lda + (unsigned)C) * 2u;
    }
};

template <class Epi, class Sched, bool GATHER>
__device__ __forceinline__ void gemm_phase(LAS unsigned char* lds, const Sched& S, const Epi& E) {
    const int tid = threadIdx.x, wid = __builtin_amdgcn_readfirstlane(tid >> 6), lane = tid & 63, wr = wid >> 2, wc = wid & 3, fr = lane & 15, fq = lane >> 4;
    const int K = S.K, lda = S.lda, nt = K / BK;
    unsigned voffA[2], voffB[2]; int RA[2], CA[2];
#pragma unroll
    for (int i = 0; i < 2; ++i) { int R, C; stage_rc(tid * 16 + i * 8192, R, C); const int Rb = Epi::PERM ? ((R & ~31) + perm32(R & 31)) : R;
        RA[i] = R; CA[i] = C; voffA[i] = (unsigned)(R * lda + C) * 2u; voffB[i] = (unsigned)(Rb * K + C) * 2u; }
    const size_t kstep = (size_t)(BK * 2);
    const unsigned hstepA = (unsigned)HALF * (unsigned)lda * 2u;
    const size_t hstepB = (size_t)HALF * K * 2;
    const unsigned ldsw = (unsigned)wid * 1024u;
    const int aoff = lds_byte(wr * 64 + fr, fq * 8), boff = lds_byte(wc * 32 + fr, fq * 8);
    unsigned og[2][2] = {{0u, 0u}, {0u, 0u}}, ogn[2][2] = {{0u, 0u}, {0u, 0u}};
#define PG8_SA(b, h) (((b) * 2 + (h)) * HTB)
#define PG8_SB(b, h) ((4 + (b) * 2 + (h)) * HTB)
#define PG8_STAGE_B(bufoff, gbase) do { _Pragma("unroll") for (int _i = 0; _i < 2; ++_i) \
        __builtin_amdgcn_global_load_lds((const unsigned*)((const char*)(gbase) + voffB[_i]), (LAS unsigned*)(lds + (bufoff) + ldsw + _i * 8192), 16, 0, 0); } while (0)
#define PG8_STAGE_A(bufoff, gbase, h) do { _Pragma("unroll") for (int _i = 0; _i < 2; ++_i) \
        __builtin_amdgcn_global_load_lds((const unsigned*)((const char*)(gbase) + (GATHER ? og[h][_i] : voffA[_i] + (h) * hstepA)), (LAS unsigned*)(lds + (bufoff) + ldsw + _i * 8192), 16, 0, 0); } while (0)
#define PG8_LDA(dst, b, h) do { _Pragma("unroll") for (int m = 0; m < 4; ++m) _Pragma("unroll") for (int k = 0; k < 2; ++k) dst[m][k] = *(const LAS bf16x8*)(lds + PG8_SA(b, h) + aoff + m * 2048 + k * 1024); } while (0)
#define PG8_LDB(dst, b, h) do { _Pragma("unroll") for (int n = 0; n < 2; ++n) _Pragma("unroll") for (int k = 0; k < 2; ++k) dst[n][k] = *(const LAS bf16x8*)(lds + PG8_SB(b, h) + boff + n * 2048 + k * 1024); } while (0)
#define PG8_MMA(ai, bj, At, Bt) do { __builtin_amdgcn_s_setprio(1); _Pragma("unroll") for (int m = 0; m < 4; ++m) _Pragma("unroll") for (int n = 0; n < 2; ++n) _Pragma("unroll") for (int k = 0; k < 2; ++k) \
        acc[ai][bj][m][n] = __builtin_amdgcn_mfma_f32_16x16x32_bf16(Bt[n][k], At[m][k], acc[ai][bj][m][n], 0, 0, 0); __builtin_amdgcn_s_setprio(0); } while (0)
#define PG8_WAIT_V(n) asm volatile("s_waitcnt vmcnt(" #n ")" ::: "memory")
#define PG8_WAIT_L(n) asm volatile("s_waitcnt lgkmcnt(" #n ")" ::: "memory")
#define PG8_BAR __builtin_amdgcn_s_barrier()
#define PG8_SCHED __builtin_amdgcn_sched_barrier(0)
    Unit cur, nxt; int ui = 0;
    if (!S.next(0, cur)) return;
    f32x4 acc[2][2][4][2];
#pragma unroll
    for (int a = 0; a < 2; ++a)
#pragma unroll
        for (int b = 0; b < 2; ++b)
#pragma unroll
            for (int m = 0; m < 4; ++m)
#pragma unroll
                for (int n = 0; n < 2; ++n) acc[a][b][m][n] = (f32x4){0.f, 0.f, 0.f, 0.f};
    bf16x8 At[4][2], B0[2][2], B1[2][2];
    const char* cA = S.a_base(cur); const char* cB = S.b_base(cur);
    if constexpr (GATHER) {
#pragma unroll
        for (int h = 0; h < 2; ++h)
#pragma unroll
            for (int i = 0; i < 2; ++i) og[h][i] = S.gather_off(cur, h * HALF + RA[i], CA[i]);
    }
    PG8_STAGE_B(PG8_SB(0, 0), cB); PG8_STAGE_B(PG8_SB(0, 1), cB + hstepB); PG8_STAGE_A(PG8_SA(0, 0), cA, 0); PG8_STAGE_A(PG8_SA(0, 1), cA, 1);
    if (wr == 1) PG8_BAR;
    PG8_WAIT_V(2); PG8_BAR;
    PG8_STAGE_B(PG8_SB(1, 0), cB + kstep); PG8_STAGE_A(PG8_SA(1, 0), cA + kstep, 0); PG8_STAGE_B(PG8_SB(1, 1), cB + hstepB + kstep);
    PG8_WAIT_V(6); PG8_BAR;
    for (;;) {
        const bool has_next = S.next(ui + 1, nxt);
        const char* nA = has_next ? S.a_base(nxt) : cA; const char* nB = has_next ? S.b_base(nxt) : cB;
        if constexpr (GATHER) {
            if (has_next) {
#pragma unroll
                for (int h = 0; h < 2; ++h)
#pragma unroll
                    for (int i = 0; i < 2; ++i) ogn[h][i] = S.gather_off(nxt, h * HALF + RA[i], CA[i]);
            }
        }
        for (int t = 0; t < nt; t += 2) {
            const bool last = (t == nt - 2);
            const char* a1 = cA + (size_t)(t + 1) * kstep;
            const char* a2 = last ? nA : cA + (size_t)(t + 2) * kstep; const char* b2 = last ? nB : cB + (size_t)(t + 2) * kstep;
            const char* a3 = a2 + kstep; const char* b3 = b2 + kstep;
            PG8_LDB(B0, 0, 0); PG8_LDB(B1, 0, 1); PG8_SCHED; PG8_LDA(At, 0, 0); PG8_STAGE_A(PG8_SA(1, 1), a1, 1);
            if constexpr (GATHER) { if (last && has_next) {
#pragma unroll
                for (int h = 0; h < 2; ++h)
#pragma unroll
                    for (int i = 0; i < 2; ++i) og[h][i] = ogn[h][i]; } }
            PG8_WAIT_V(8); PG8_WAIT_L(0); PG8_BAR; PG8_MMA(0, 0, At, B0); PG8_MMA(0, 1, At, B1); PG8_BAR; PG8_SCHED;
            PG8_LDA(At, 0, 1); PG8_STAGE_B(PG8_SB(0, 0), b2); PG8_STAGE_B(PG8_SB(0, 1), b2 + hstepB); PG8_STAGE_A(PG8_SA(0, 0), a2, 0);
            PG8_WAIT_V(8); PG8_WAIT_L(0); PG8_BAR; PG8_MMA(1, 0, At, B0); PG8_MMA(1, 1, At, B1); PG8_BAR; PG8_SCHED;
            PG8_LDB(B0, 1, 0); PG8_LDB(B1, 1, 1); PG8_SCHED; PG8_LDA(At, 1, 0); PG8_STAGE_A(PG8_SA(0, 1), a2, 1);
            PG8_WAIT_V(8); PG8_WAIT_L(0); PG8_BAR; PG8_MMA(0, 0, At, B0); PG8_MMA(0, 1, At, B1); PG8_BAR; PG8_SCHED;
            PG8_LDA(At, 1, 1); PG8_STAGE_B(PG8_SB(1, 0), b3); PG8_STAGE_B(PG8_SB(1, 1), b3 + hstepB); PG8_STAGE_A(PG8_SA(1, 0), a3, 0);
            PG8_WAIT_V(8); PG8_WAIT_L(0); PG8_BAR; PG8_MMA(1, 0, At, B0); PG8_MMA(1, 1, At, B1); PG8_BAR; PG8_SCHED;
        }
        if (wr == 0) PG8_BAR;
        E(acc, cur, wr, wc, fr, fq);
        if (!has_next) break;
#pragma unroll
        for (int a = 0; a < 2; ++a)
#pragma unroll
            for (int b = 0; b < 2; ++b)
#pragma unroll
                for (int m = 0; m < 4; ++m)
#pragma unroll
                    for (int n = 0; n < 2; ++n) acc[a][b][m][n] = (f32x4){0.f, 0.f, 0.f, 0.f};
        cur = nxt; cA = nA; cB = nB; ++ui;
        if (wr == 1) PG8_BAR;
    }
    PG8_WAIT_V(0);
    PG8_BAR;
#undef PG8_SA
#undef PG8_SB
#undef PG8_STAGE_A
#undef PG8_STAGE_B
#undef PG8_LDA
#undef PG8_LDB
#undef PG8_MMA
#undef PG8_WAIT_V
#undef PG8_WAIT_L
#undef PG8_BAR
#undef PG8_SCHED
}

struct EpiProj {
    static constexpr bool PERM = true;
    bf16_t* P; const float* rope; float* ksum;
    __device__ __forceinline__ void operator()(const f32x4 (&acc)[2][2][4][2], const Unit& u, int wr, int wc, int fr_in, int fq) const {
        int fr = fr_in; asm volatile("" : "+v"(fr));
        const int pn = u.pn, row0 = u.pm * BM + wr * 64 + fr, cl = wc * 32 + 8 * fq;
        const int mode = pn < 4 ? 0 : pn < 6 ? 1 : pn < 8 ? 2 : pn < 10 ? 3 : 4;
        const bool rot = (mode == 1 || mode == 2) && ((wc & 1) == 0);
        float ks[2][8];
#pragma unroll
        for (int bj = 0; bj < 2; ++bj)
#pragma unroll
            for (int j = 0; j < 8; ++j) ks[bj][j] = 0.f;
#pragma unroll
        for (int ai = 0; ai < 2; ++ai)
#pragma unroll
            for (int m = 0; m < 4; ++m) {
                const int row = row0 + ai * HALF + m * 16;
                float cs[8], sn[8];
                if (rot) { const int pos = row & (SEQ - 1); const f32x4 c0 = *(const f32x4*)(rope + pos * 8), c1 = *(const f32x4*)(rope + pos * 8 + 4), s0 = *(const f32x4*)(rope + 65536 + pos * 8), s1 = *(const f32x4*)(rope + 65536 + pos * 8 + 4);
#pragma unroll
                    for (int j = 0; j < 4; ++j) { cs[j] = c0[j]; cs[4 + j] = c1[j]; sn[j] = s0[j]; sn[4 + j] = s1[j]; } }
#pragma unroll
                for (int bj = 0; bj < 2; ++bj) {
                    float v[8];
#pragma unroll
                    for (int j = 0; j < 4; ++j) { v[j] = acc[ai][bj][m][0][j]; v[4 + j] = acc[ai][bj][m][1][j]; }
                    if (mode == 0) {
#pragma unroll
                        for (int j = 0; j < 8; ++j) v[j] = gelu_tanh(v[j]);
                    } else if (mode == 4) {
#pragma unroll
                        for (int j = 0; j < 8; ++j) v[j] = sigmoidf_(v[j]);
                    } else if (mode != 3) {
                        if (rot) {
                            const float sg = (fq == 0) ? -1.f : 1.f; const bool ap = fq < 2;
#pragma unroll
                            for (int j = 0; j < 8; ++j) { const float o = __shfl_xor(v[j], 16); const float r = v[j] * cs[j] + sg * o * sn[j]; v[j] = ap ? r : v[j]; }
                        }
                        if (mode == 1) {
#pragma unroll
                            for (int j = 0; j < 8; ++j) v[j] *= QSCALE;
                        } else {
#pragma unroll
                            for (int j = 0; j < 8; ++j) ks[bj][j] += v[j];
                        }
                    }
                    u32x4 w; w.x = cvt_pk_bf16(v[0], v[1]); w.y = cvt_pk_bf16(v[2], v[3]); w.z = cvt_pk_bf16(v[4], v[5]); w.w = cvt_pk_bf16(v[6], v[7]);
                    *(u32x4*)(P + (size_t)row * PC + pn * BM + bj * HALF + cl) = w;
                }
            }
        if (mode == 2) {
#pragma unroll
            for (int bj = 0; bj < 2; ++bj)
#pragma unroll
                for (int j = 0; j < 8; ++j) { float s = ks[bj][j]; s += __shfl_xor(s, 1); s += __shfl_xor(s, 2); s += __shfl_xor(s, 4); s += __shfl_xor(s, 8); ks[bj][j] = s; }
            if (fr == 0) {
                const int b = u.pm >> 5, kb = u.pm & 31;
#pragma unroll
                for (int bj = 0; bj < 2; ++bj) { const int ck = (pn - 6) * BM + bj * HALF + cl; const int h = ck >> 6, d = ck & 63;
                    float* dst = ksum + ((size_t)((b * 8 + h) * 32 + kb)) * 64 + d;
#pragma unroll
                    for (int j = 0; j < 8; ++j) atomicAdd(dst + j, ks[bj][j]); }
            }
        }
    }
};
template <bool FIRST> struct EpiMerge {
    static constexpr bool PERM = true;
    const bf16_t* P; bf16_t* MG;
    __device__ __forceinline__ void operator()(const f32x4 (&acc)[2][2][4][2], const Unit& u, int wr, int wc, int fr_in, int fq) const {
        int fr = fr_in; asm volatile("" : "+v"(fr));
        const int row0 = u.pm * BM + wr * 64 + fr, col0 = u.pn * BM + wc * 32 + 8 * fq;
        u32x4 gq[3][2], pq[3][2];
#define EM_LOAD(gi, slot) do { const int row_ = row0 + ((gi) >> 2) * HALF + ((gi) & 3) * 16; \
            _Pragma("unroll") for (int bj = 0; bj < 2; ++bj) { gq[slot][bj] = *(const u32x4*)(P + (size_t)row_ * PC + (FIRST ? C_GA : C_GB) + col0 + bj * HALF); \
                if (!FIRST) pq[slot][bj] = *(const u32x4*)(MG + (size_t)row_ * DM + col0 + bj * HALF); } } while (0)
        EM_LOAD(0, 0); EM_LOAD(1, 1);
#pragma unroll
        for (int gi = 0; gi < 8; ++gi) {
            if (gi + 2 < 8) EM_LOAD(gi + 2, (gi + 2) % 3);
            asm volatile("" ::: "memory");
            const int ai = gi >> 2, m = gi & 3, row = row0 + ai * HALF + m * 16;
#pragma unroll
            for (int bj = 0; bj < 2; ++bj) { const u32x4 g = gq[gi % 3][bj];
                bf16_t* dst = MG + (size_t)row * DM + col0 + bj * HALF;
                float v[8];
#pragma unroll
                for (int j = 0; j < 4; ++j) { v[j] = acc[ai][bj][m][0][j]; v[4 + j] = acc[ai][bj][m][1][j]; }
                v[0] *= bflo(g.x); v[1] *= bfhi(g.x); v[2] *= bflo(g.y); v[3] *= bfhi(g.y); v[4] *= bflo(g.z); v[5] *= bfhi(g.z); v[6] *= bflo(g.w); v[7] *= bfhi(g.w);
                if (!FIRST) { const u32x4 p = pq[gi % 3][bj];
                    v[0] += bflo(p.x); v[1] += bfhi(p.x); v[2] += bflo(p.y); v[3] += bfhi(p.y); v[4] += bflo(p.z); v[5] += bfhi(p.z); v[6] += bflo(p.w); v[7] += bfhi(p.w); }
                u32x4 w; w.x = cvt_pk_bf16(v[0], v[1]); w.y = cvt_pk_bf16(v[2], v[3]); w.z = cvt_pk_bf16(v[4], v[5]); w.w = cvt_pk_bf16(v[6], v[7]);
                *(u32x4*)dst = w; }
        }
#undef EM_LOAD
    }
};
struct EpiOut {
    static constexpr bool PERM = false;
    const float* x; bf16_t* x1; const float* mod; float* ssq;
    __device__ __forceinline__ void operator()(const f32x4 (&acc)[2][2][4][2], const Unit& u, int wr, int wc, int fr_in, int fq) const {
        int fr = fr_in; asm volatile("" : "+v"(fr));
        const int row0 = u.pm * BM + wr * 64 + fr, col0 = u.pn * BM + wc * 32 + 4 * fq, b = u.pm >> 5;
        f32x4 xq[3][2][2];
#define EO_LOAD(gi, slot) do { const size_t off_ = (size_t)(row0 + ((gi) >> 2) * HALF + ((gi) & 3) * 16) * DM + col0; \
            _Pragma("unroll") for (int bj = 0; bj < 2; ++bj) _Pragma("unroll") for (int n = 0; n < 2; ++n) xq[slot][bj][n] = *(const f32x4*)(x + off_ + bj * HALF + n * 16); } while (0)
        EO_LOAD(0, 0); EO_LOAD(1, 1);
        f32x4 g1[2][2];
#pragma unroll
        for (int bj = 0; bj < 2; ++bj)
#pragma unroll
            for (int n = 0; n < 2; ++n) g1[bj][n] = *(const f32x4*)(mod + b * 6144 + 2048 + col0 + bj * HALF + n * 16);
#pragma unroll
        for (int gi = 0; gi < 8; ++gi) {
            if (gi + 2 < 8) EO_LOAD(gi + 2, (gi + 2) % 3);
            asm volatile("" ::: "memory");
            const int ai = gi >> 2, m = gi & 3, row = row0 + ai * HALF + m * 16; const size_t off = (size_t)row * DM + col0; float s = 0.f;
#pragma unroll
            for (int bj = 0; bj < 2; ++bj)
#pragma unroll
                for (int n = 0; n < 2; ++n) { const f32x4 o = xq[gi % 3][bj][n] + g1[bj][n] * acc[ai][bj][m][n];
                    u32x2 w; w.x = cvt_pk_bf16(o[0], o[1]); w.y = cvt_pk_bf16(o[2], o[3]);
                    const float r0 = bflo(w.x), r1 = bfhi(w.x), r2 = bflo(w.y), r3 = bfhi(w.y);
                    s += (r0 * r0 + r1 * r1) + (r2 * r2 + r3 * r3); *(u32x2*)(x1 + off + bj * HALF + n * 16) = w; }
            s += __shfl_xor(s, 16); s += __shfl_xor(s, 32);
            if (fq == 0) ssq[(size_t)row * 16 + u.pn * 4 + wc] = s;
        }
#undef EO_LOAD
    }
};
struct EpiGU {
    static constexpr bool PERM = true;
    bf16_t* H;
    __device__ __forceinline__ void operator()(const f32x4 (&acc)[2][2][4][2], const Unit& u, int wr, int wc, int fr_in, int fq) const {
        int fr = fr_in; asm volatile("" : "+v"(fr));
        const int r0 = wr * 64 + fr, cl = wc * 32 + 8 * fq;
#pragma unroll
        for (int ai = 0; ai < 2; ++ai)
#pragma unroll
            for (int m = 0; m < 4; ++m) { const int r = r0 + ai * HALF + m * 16;
                float v[8];
#pragma unroll
                for (int j = 0; j < 4; ++j) { const float g0 = acc[ai][0][m][0][j], g1 = acc[ai][0][m][1][j]; v[j] = g0 * sigmoidf_(g0) * acc[ai][1][m][0][j]; v[4 + j] = g1 * sigmoidf_(g1) * acc[ai][1][m][1][j]; }
                u32x4 w; w.x = cvt_pk_bf16(v[0], v[1]); w.y = cvt_pk_bf16(v[2], v[3]); w.z = cvt_pk_bf16(v[4], v[5]); w.w = cvt_pk_bf16(v[6], v[7]);
                *(u32x4*)(H + ((size_t)u.pm * BM + r) * DEXP + u.pn * HALF + cl) = w; }
    }
};
struct EpiDown {
    static constexpr bool PERM = true;
    bf16_t* Y; const unsigned long long* route;
    __device__ __forceinline__ void operator()(const f32x4 (&acc)[2][2][4][2], const Unit& u, int wr, int wc, int fr_in, int fq) const {
        int fr = fr_in; asm volatile("" : "+v"(fr));
        const int r0 = wr * 64 + fr, col0 = u.pn * BM + wc * 32 + 8 * fq;
        const unsigned long long* rt = route + (size_t)u.e * 32768 + (size_t)u.lt * 256;
        unsigned long long ent[8];
#pragma unroll
        for (int gi = 0; gi < 8; ++gi) { const int r = r0 + (gi >> 2) * HALF + (gi & 3) * 16; ent[gi] = (r < u.nvalid) ? rt[r] : 0ull; }
#pragma unroll
        for (int gi = 0; gi < 8; ++gi) { const int ai = gi >> 2, m = gi & 3, r = r0 + ai * HALF + m * 16;
            if (r < u.nvalid) { const unsigned slot = (unsigned)(ent[gi] & 0xffffffffull); const float wt = __uint_as_float((unsigned)(ent[gi] >> 32));
#pragma unroll
                for (int bj = 0; bj < 2; ++bj) { const f32x4 a0 = acc[ai][bj][m][0] * wt, a1 = acc[ai][bj][m][1] * wt;
                    u32x4 w; w.x = cvt_pk_bf16(a0[0], a0[1]); w.y = cvt_pk_bf16(a0[2], a0[3]); w.z = cvt_pk_bf16(a1[0], a1[1]); w.w = cvt_pk_bf16(a1[2], a1[3]);
                    *(u32x4*)(Y + (size_t)slot * DM + col0 + bj * HALF) = w; } } }
    }
};
}

namespace attn_body {
using bf16 = __hip_bfloat16;
constexpr int NHEAD = 8, D = 64, PITCH = PC;
constexpr int NW = 8, QBLK = 32, QB = QBLK * NW, KVBLK = 64;
__device__ __forceinline__ int crow(int r, int hi) { return (r & 3) + 8 * (r >> 2) + 4 * hi; }
#define SBAR() __builtin_amdgcn_sched_barrier(0)
__device__ __forceinline__ void cmask(f32x16& p0, f32x16& p1, int jb, int qrel, int hi) {
    const float NEG = -INFINITY; int kb = 64 * jb + 4 * hi;
#pragma unroll
    for (int r = 0; r < 16; ++r) { int kv = kb + (r & 3) + 8 * (r >> 2); if (kv > qrel) p0[r] = NEG; if (kv + 32 > qrel) p1[r] = NEG; }
}
__device__ __forceinline__ void selapply(f32x16& p0, f32x16& p1, bool ok) {
    const float NEG = -INFINITY;
#pragma unroll
    for (int r = 0; r < 16; ++r) { p0[r] = ok ? p0[r] : NEG; p1[r] = ok ? p1[r] : NEG; }
}
constexpr int NSLOT = 3, SLOTB = 8192;
constexpr int LDS_K = 0, LDS_V = NSLOT * SLOTB, LDS_WS = 2 * NSLOT * SLOTB, LDS_OST = LDS_WS + NW * 64 * 4, LDS_BYTES_A = LDS_OST + NW * 4096;
__device__ __forceinline__ void glds16(const void* gsrc, unsigned lds_dst) { unsigned keep;
    asm volatile("s_mov_b32 %0, m0\n\ts_mov_b32 m0, %2\n\ts_nop 0\n\tglobal_load_lds_dwordx4 %1, off\n\ts_mov_b32 m0, %0" : "=&s"(keep) : "v"(gsrc), "s"(lds_dst) : "memory"); }
__device__ __forceinline__ float max3f(float a, float b, float c) { float r; asm("v_max3_f32 %0, %1, %2, %3" : "=v"(r) : "v"(a), "v"(b), "v"(c)); return r; }
__device__ __forceinline__ float max2f(float a, float b) { float r; asm("v_max_f32_e32 %0, %1, %2" : "=v"(r) : "v"(a), "v"(b)); return r; }
__device__ __forceinline__ float fadd_s(float a, float b) { float r; asm("v_add_f32_e32 %0, %1, %2" : "=v"(r) : "v"(a), "v"(b)); return r; }
__device__ __forceinline__ float fsub_s(float a, float b) { float r; asm("v_sub_f32_e32 %0, %1, %2" : "=v"(r) : "v"(a), "v"(b)); return r; }
typedef __bf16 bf16x2_t __attribute__((ext_vector_type(2)));
__device__ __forceinline__ unsigned cvtpk_s(float lo, float hi) { f32x2 v = {lo, hi}; bf16x2_t b = __builtin_convertvector(v, bf16x2_t); return __builtin_bit_cast(unsigned, b); }
#define WAIT_BAR(N) asm volatile("s_waitcnt vmcnt(" #N ") lgkmcnt(0)\n\ts_barrier" ::: "memory")

__device__ __forceinline__ void qkt(f32x16& p0, f32x16& p1, const char* Kslot, const bf16x8* qr, const f32x16& negm, int r32, int hi) {
    const char* kb = Kslot + hi * 1024 + r32 * 16;
#pragma unroll
    for (int d0 = 0; d0 < 4; ++d0) {
        const bf16x8 b0 = *reinterpret_cast<const bf16x8*>(kb + d0 * 2048);
        const bf16x8 b1 = *reinterpret_cast<const bf16x8*>(kb + d0 * 2048 + 512);
        if (d0 == 0) { p0 = __builtin_amdgcn_mfma_f32_32x32x16_bf16(b0, qr[0], negm, 0, 0, 0); p1 = __builtin_amdgcn_mfma_f32_32x32x16_bf16(b1, qr[0], negm, 0, 0, 0); }
        else { p0 = __builtin_amdgcn_mfma_f32_32x32x16_bf16(b0, qr[d0], p0, 0, 0, 0); p1 = __builtin_amdgcn_mfma_f32_32x32x16_bf16(b1, qr[d0], p1, 0, 0, 0); } }
}
typedef LAS const char* lds_cptr;
typedef short v4i16_t __attribute__((ext_vector_type(4)));
__device__ __forceinline__ void kload8(bf16x8* kf, lds_cptr kp) {
    kf[0] = *(const LAS bf16x8*)(kp);        kf[1] = *(const LAS bf16x8*)(kp + 512);
    kf[2] = *(const LAS bf16x8*)(kp + 2048); kf[3] = *(const LAS bf16x8*)(kp + 2560);
    kf[4] = *(const LAS bf16x8*)(kp + 4096); kf[5] = *(const LAS bf16x8*)(kp + 4608);
    kf[6] = *(const LAS bf16x8*)(kp + 6144); kf[7] = *(const LAS bf16x8*)(kp + 6656);
}
__device__ __forceinline__ void kload2(bf16x8* kf, lds_cptr kp, int j) { kf[2 * j] = *(const LAS bf16x8*)(kp + j * 2048); kf[2 * j + 1] = *(const LAS bf16x8*)(kp + j * 2048 + 512); }
__device__ __forceinline__ s16x4 vtr(lds_cptr p) { return __builtin_bit_cast(s16x4, __builtin_amdgcn_ds_read_tr16_b64_v4i16((LAS v4i16_t*)p)); }
__device__ __forceinline__ float rowmax(const f32x16& p0, const f32x16& p1) {
    float a = max3f(p0[0], p0[1], p1[0]), b = max3f(p0[2], p0[3], p1[1]); a = max3f(a, p1[2], p1[3]);
#pragma unroll
    for (int r = 4; r < 16; r += 4) { a = max3f(a, p0[r], p0[r + 1]); b = max3f(b, p0[r + 2], p0[r + 3]); a = max3f(a, p1[r], p1[r + 1]); b = max3f(b, p1[r + 2], p1[r + 3]); }
    const float m = max2f(a, b);
    auto rr = __builtin_amdgcn_permlane32_swap(__float_as_uint(m), __float_as_uint(m), false, false);
    return max2f(__uint_as_float(rr[0]), __uint_as_float(rr[1]));
}
__device__ __forceinline__ void pv(f32x16* o, int vb, bf16x8 pa0, bf16x8 pa1, bf16x8 pa2, bf16x8 pa3) {
#pragma unroll
    for (int d0 = 0; d0 < 2; ++d0) { s16x4 lo[4], hi[4];
#pragma unroll
        for (int ks = 0; ks < 4; ++ks) {
            asm volatile("ds_read_b64_tr_b16 %0,%1 offset:%c2" : "=&v"(lo[ks]) : "v"(vb), "i"(d0 * 4096 + ks * 1024) : "memory");
            asm volatile("ds_read_b64_tr_b16 %0,%1 offset:%c2" : "=&v"(hi[ks]) : "v"(vb), "i"(d0 * 4096 + ks * 1024 + 512) : "memory"); }
        asm volatile("s_waitcnt lgkmcnt(0)" ::: "memory"); SBAR();
#define PK(k) (bf16x8){lo[k][0], lo[k][1], lo[k][2], lo[k][3], hi[k][0], hi[k][1], hi[k][2], hi[k][3]}
        o[d0] = __builtin_amdgcn_mfma_f32_32x32x16_bf16(pa0, PK(0), o[d0], 0, 0, 0);
        o[d0] = __builtin_amdgcn_mfma_f32_32x32x16_bf16(pa1, PK(1), o[d0], 0, 0, 0);
        o[d0] = __builtin_amdgcn_mfma_f32_32x32x16_bf16(pa2, PK(2), o[d0], 0, 0, 0);
        o[d0] = __builtin_amdgcn_mfma_f32_32x32x16_bf16(pa3, PK(3), o[d0], 0, 0, 0);
#undef PK
    }
}

__device__ __forceinline__ void gate_top3(const float* ksum_bh, const bf16x8* qr, int qb, int r32, int hi, int (&kbs)[3]) {
    const float* km = ksum_bh + (size_t)r32 * 64 + hi * 8;
    f32x16 g = f32x16{};
#pragma unroll
    for (int d0 = 0; d0 < 4; ++d0) { const f32x4 a = *(const f32x4*)(km + d0 * 16), c = *(const f32x4*)(km + d0 * 16 + 4);
        u32x4 w; w.x = cvtpk_s(a[0], a[1]); w.y = cvtpk_s(a[2], a[3]); w.z = cvtpk_s(c[0], c[1]); w.w = cvtpk_s(c[2], c[3]);
        g = __builtin_amdgcn_mfma_f32_32x32x16_bf16(__builtin_bit_cast(bf16x8, w), qr[d0], g, 0, 0, 0); }
#pragma unroll
    for (int r = 0; r < 16; ++r) if (crow(r, hi) >= qb) g[r] = -INFINITY;
#pragma unroll
    for (int round = 0; round < 3; ++round) {
        float m = g[0];
#pragma unroll
        for (int r = 1; r < 16; ++r) m = fmaxf(m, g[r]);
        int idx = 64;
#pragma unroll
        for (int r = 15; r >= 0; --r) if (g[r] == m) idx = crow(r, hi);
        const float pm = __shfl_xor(m, 32); const int pidx = __shfl_xor(idx, 32);
        const bool mine = (m > pm) || (m == pm && idx < pidx);
        kbs[round] = (mine ? idx : pidx) & 31;
#pragma unroll
        for (int r = 0; r < 16; ++r) if (mine && crow(r, hi) == idx) g[r] = -INFINITY;
    }
}

template <int THRL, bool OWN> __device__ __forceinline__ void attn_unit(int b, int h, int qb, const bf16* Q, const bf16* __restrict__ K, const bf16* __restrict__ V, bf16* O, const float* ksum, char* shm, bool do_store, const bf16_t* PO, const float* PML) {
    const int tid = threadIdx.x, lane = tid & 63, r32 = lane & 31, hi = lane >> 5; const int wid = __builtin_amdgcn_readfirstlane(tid >> 6);
    const long rowbase = (long)b * SEQ; const int q0 = qb * QB;
    const bf16* Qw = Q + (rowbase + q0 + wid * QBLK) * PITCH + h * D;
    const bf16* Kh = K + rowbase * PITCH + h * D, *Vh = V + rowbase * PITCH + h * D;
    const unsigned lds0 = (unsigned)(uintptr_t)shm;
    float* wsf = (float*)(shm + LDS_WS) + wid * 64;
    const bf16* ksrc = Kh + (long)lane * PITCH + wid * 8;
    const bf16* vsrc = Vh + (long)(16 * (wid & 3) + (lane >> 2)) * PITCH + (wid >> 2) * 32 + (lane & 3) * 8;
    const unsigned kdst = lds0 + LDS_K + wid * 1024, vdst = lds0 + LDS_V + wid * 1024;
    const int NT = OWN ? 4 : (q0 + QB) / KVBLK;
    const int TBASE = OWN ? 4 * qb : 0;
#define TM(t) (OWN ? (t) : (((t) == 0) ? (NT - 4) : (((t) <= NT - 4) ? ((t) - 1) : (t))))
#define DMA_K(t, slot) glds16(ksrc + (long)(TBASE + TM(t)) * KVBLK * PITCH, (unsigned)__builtin_amdgcn_readfirstlane(kdst + (slot)))
#define DMA_V(t, slot) glds16(vsrc + (long)(TBASE + TM(t)) * KVBLK * PITCH, (unsigned)__builtin_amdgcn_readfirstlane(vdst + (slot)))
    const int vb0 = (int)(lds0 + LDS_V) + ((lane >> 4) & 1) * 32 + (lane & 3) * 8 + (4 * hi + ((lane & 15) >> 2)) * 64;
    const char* Kbase = shm + LDS_K; bf16x8 kf[8];
    const lds_cptr shm3 = (lds_cptr)shm; const lds_cptr kp0 = shm3 + LDS_K + hi * 1024 + r32 * 16; const lds_cptr vp0 = shm3 + LDS_V + ((lane >> 4) & 1) * 32 + (lane & 3) * 8 + (4 * hi + ((lane & 15) >> 2)) * 64;
    DMA_K(0, 0); DMA_V(0, 0); DMA_K(1, SLOTB);
    bf16x8 qr[4];
#pragma unroll
    for (int d0 = 0; d0 < 4; ++d0) qr[d0] = *reinterpret_cast<const bf16x8*>(&Qw[(long)r32 * PITCH + d0 * 16 + hi * 8]);
    unsigned selmask = 0u;
    if constexpr (!OWN) {
    if (qb > 0) {
        if (qb <= 3) selmask = (1u << qb) - 1u;
        else { int kbs[3]; gate_top3(ksum + ((size_t)(b * NHEAD + h) * 32) * 64, qr, qb, r32, hi, kbs); selmask = (1u << kbs[0]) | (1u << kbs[1]) | (1u << kbs[2]); }
    } }
    float zf_; asm volatile("v_mov_b32 %0, 0" : "=v"(zf_));
    float mhat = 0.f, l_reg = 0.f; f32x16 o[2]; f32x16 negm;
#pragma unroll
    for (int r = 0; r < 16; ++r) { o[0][r] = zf_; o[1][r] = zf_; negm[r] = zf_; }
    asm volatile("" : "+v"(negm));
    const int qrel = wid * QBLK + r32;
#define MASKT(P0, P1, t) do { const int a_ = TM(t); const int jb_ = a_ - (NT - 4); if (jb_ >= 0) cmask(P0, P1, jb_, qrel, hi); else selapply(P0, P1, ((selmask >> (a_ >> 2)) & 1u) != 0u); } while (0)
    bool resc = false;
#define START(P0, P1) do { const float rm = rowmax(P0, P1); resc = false; \
    { const float dl = rm; mhat = fadd_s(mhat, dl); \
      _Pragma("unroll") for (int r = 0; r < 16; ++r) { P0[r] = fsub_s(P0[r], dl); P1[r] = fsub_s(P1[r], dl); } \
      _Pragma("unroll") for (int r = 0; r < 16; ++r) negm[r] = -mhat; asm volatile("" : "+v"(negm)); } \
    _Pragma("unroll") for (int r = 0; r < 16; ++r) P0[r] = __builtin_amdgcn_exp2f(P0[r]); } while (0)
#define RESC() do { if (resc) { asm volatile("s_waitcnt lgkmcnt(0)" ::: "memory"); \
      _Pragma("unroll") for (int d_ = 0; d_ < 2; ++d_) _Pragma("unroll") for (int r = 0; r < 16; ++r) o[d_][r] *= wsf[crow(r, hi)]; } } while (0)
    f32x16 pA0, pA1, pB0, pB1;
    int sl_prev = 0, sl_cur = 0, sl_next = SLOTB;
#define ROT() do { sl_prev = sl_cur; sl_cur = sl_next; sl_next = (sl_next == (NSLOT - 1) * SLOTB) ? 0 : sl_next + SLOTB; } while (0)
    DMA_K(2, 2 * SLOTB);
    WAIT_BAR(3);
    qkt(pA0, pA1, Kbase, qr, negm, r32, hi); asm volatile("s_nop 15\n\ts_nop 7" : "+v"(pA0), "+v"(pA1)); MASKT(pA0, pA1, 0);
    START(pA0, pA1);
    _Pragma("unroll") for (int r = 0; r < 16; ++r) pA1[r] = __builtin_amdgcn_exp2f(pA1[r]);
    WAIT_BAR(0);
    DMA_K(3, 0); DMA_V(1, SLOTB);
    ROT();
    kload8(kf, kp0 + sl_cur);
    WAIT_BAR(2);
    s16x4 vlo[8], vhi[8]; u32x4 pw0, pw1, pw2, pw3;
#define PKW(P, B) cvtpk_s(P[B], P[B + 1])
#define PAF(k) __builtin_bit_cast(bf16x8, pw##k)
#define VFR(i) (bf16x8){vlo[i][0], vlo[i][1], vlo[i][2], vlo[i][3], vhi[i][0], vhi[i][1], vhi[i][2], vhi[i][3]}
#define PIN(x) asm volatile("" : "+v"(x))
#define MX3(a, b, c) __builtin_fmaxf(__builtin_fmaxf((a), (b)), (c))
#define GAPA(MF, A0, A1, A2, A3, W0, W1, PW) do { MF; sacc += A0; sacc += A1; sacc += A2; sacc += A3; PIN(sacc); W0; W1; PIN(PW); SBAR(); } while (0)
#define EX(v) __builtin_amdgcn_exp2f(v)
#define GAPB(MF, X, B) do { MF; X[B] = EX(X[B]); X[B + 1] = EX(X[B + 1]); X[B + 2] = EX(X[B + 2]); X[B + 3] = EX(X[B + 3]); PIN(X); SBAR(); } while (0)
#define VRD(i) do { vlo[i] = vtr(vp_ + (((i) >> 2) * 4096 + ((i) & 3) * 1024)); vhi[i] = vtr(vp_ + (((i) >> 2) * 4096 + ((i) & 3) * 1024 + 512)); } while (0)
#define KRD(G, j) do { if (G) { kload2(kf, kp0 + sl_next, j); SBAR(); } } while (0)
#define STEP(C0, C1, P0, P1, t, GK, GV, GL) do { SBAR(); \
    const lds_cptr vp_ = vp0 + sl_prev; \
    VRD(0); SBAR(); float sacc = (P0[0] + P0[1]); \
    GAPA(C0 = __builtin_amdgcn_mfma_f32_32x32x16_bf16(kf[0], qr[0], negm, 0, 0, 0), P0[2], P0[3], P0[4], P0[5],     pw0[0] = PKW(P0, 0), pw0[1] = PKW(P0, 2), pw0); \
    VRD(4); SBAR(); GAPA(C1 = __builtin_amdgcn_mfma_f32_32x32x16_bf16(kf[1], qr[0], negm, 0, 0, 0), P0[6], P0[7], P0[8], P0[9],     pw0[2] = PKW(P0, 4), pw0[3] = PKW(P0, 6), pw0); \
    VRD(1); SBAR(); GAPA(C0 = __builtin_amdgcn_mfma_f32_32x32x16_bf16(kf[2], qr[1], C0, 0, 0, 0),   P0[10], P0[11], P0[12], P0[13], pw1[0] = PKW(P0, 8), pw1[1] = PKW(P0, 10), pw1); \
    VRD(5); SBAR(); GAPA(C1 = __builtin_amdgcn_mfma_f32_32x32x16_bf16(kf[3], qr[1], C1, 0, 0, 0),   P0[14], P0[15], P1[0], P1[1],   pw1[2] = PKW(P0, 12), pw1[3] = PKW(P0, 14), pw1); \
    VRD(2); SBAR(); GAPA(C0 = __builtin_amdgcn_mfma_f32_32x32x16_bf16(kf[4], qr[2], C0, 0, 0, 0),   P1[2], P1[3], P1[4], P1[5],     pw2[0] = PKW(P1, 0), pw2[1] = PKW(P1, 2), pw2); \
    VRD(6); SBAR(); GAPA(C1 = __builtin_amdgcn_mfma_f32_32x32x16_bf16(kf[5], qr[2], C1, 0, 0, 0),   P1[6], P1[7], P1[8], P1[9],     pw2[2] = PKW(P1, 4), pw2[3] = PKW(P1, 6), pw2); \
    VRD(3); SBAR(); GAPA(C0 = __builtin_amdgcn_mfma_f32_32x32x16_bf16(kf[6], qr[3], C0, 0, 0, 0),   P1[10], P1[11], P1[12], P1[13], pw3[0] = PKW(P1, 8), pw3[1] = PKW(P1, 10), pw3); \
    VRD(7); SBAR(); GAPA(C1 = __builtin_amdgcn_mfma_f32_32x32x16_bf16(kf[7], qr[3], C1, 0, 0, 0),   P1[14], P1[15], 0.f, 0.f,       pw3[2] = PKW(P1, 12), pw3[3] = PKW(P1, 14), pw3); \
    l_reg += sacc; \
    if (GK) { DMA_K((t) + 3, sl_cur); } if (GV) { DMA_V((t) + 1, sl_next); } \
    MASKT(C0, C1, t); \
    { float a = MX3(C0[0], C0[1], C1[0]), b = MX3(C0[2], C0[3], C1[1]); a = MX3(a, C1[2], C1[3]); \
      _Pragma("unroll") for (int r = 4; r < 16; r += 4) { a = MX3(a, C0[r], C0[r + 1]); b = MX3(b, C0[r + 2], C0[r + 3]); a = MX3(a, C1[r], C1[r + 1]); b = MX3(b, C1[r + 2], C1[r + 3]); } \
      float rm = __builtin_fmaxf(a, b); { auto rr = __builtin_amdgcn_permlane32_swap(__float_as_uint(rm), __float_as_uint(rm), false, false); rm = __builtin_fmaxf(__uint_as_float(rr[0]), __uint_as_float(rr[1])); } \
      resc = false; \
      if (__builtin_expect(__any(rm > (float)THRL), 0)) { const float dl = __builtin_fmaxf(rm, 0.f); mhat += dl; \
        _Pragma("unroll") for (int r = 0; r < 16; ++r) { C0[r] -= dl; C1[r] -= dl; } \
        _Pragma("unroll") for (int r = 0; r < 16; ++r) negm[r] = -mhat; asm volatile("" : "+v"(negm)); \
        const float f = __builtin_amdgcn_exp2f(-dl); l_reg *= f; if (hi == 0) wsf[r32] = f; resc = true; } } \
    SBAR(); \
    GAPB(o[0] = __builtin_amdgcn_mfma_f32_32x32x16_bf16(PAF(0), VFR(0), o[0], 0, 0, 0), C0, 0); \
    GAPB(o[1] = __builtin_amdgcn_mfma_f32_32x32x16_bf16(PAF(0), VFR(4), o[1], 0, 0, 0), C0, 4); \
    KRD(GL, 0); GAPB(o[0] = __builtin_amdgcn_mfma_f32_32x32x16_bf16(PAF(1), VFR(1), o[0], 0, 0, 0), C0, 8); \
    KRD(GL, 1); GAPB(o[1] = __builtin_amdgcn_mfma_f32_32x32x16_bf16(PAF(1), VFR(5), o[1], 0, 0, 0), C0, 12); \
    KRD(GL, 2); GAPB(o[0] = __builtin_amdgcn_mfma_f32_32x32x16_bf16(PAF(2), VFR(2), o[0], 0, 0, 0), C1, 0); \
    KRD(GL, 3); GAPB(o[1] = __builtin_amdgcn_mfma_f32_32x32x16_bf16(PAF(2), VFR(6), o[1], 0, 0, 0), C1, 4); \
    GAPB(o[0] = __builtin_amdgcn_mfma_f32_32x32x16_bf16(PAF(3), VFR(3), o[0], 0, 0, 0), C1, 8); \
    GAPB(o[1] = __builtin_amdgcn_mfma_f32_32x32x16_bf16(PAF(3), VFR(7), o[1], 0, 0, 0), C1, 12); \
    } while (0)
    int t = 1;
    for (; t + 5 < NT; t += 2) {
        STEP(pB0, pB1, pA0, pA1, t, true, true, true);     WAIT_BAR(2); RESC(); ROT();
        STEP(pA0, pA1, pB0, pB1, t + 1, true, true, true); WAIT_BAR(2); RESC(); ROT();
    }
#define ENDW(tt) do { if ((tt) + 3 < NT) { WAIT_BAR(2); } else if ((tt) + 2 < NT) { WAIT_BAR(1); } else { WAIT_BAR(0); } } while (0)
    for (; t + 1 < NT; t += 2) {
        STEP(pB0, pB1, pA0, pA1, t, (t + 3 < NT), (t + 1 < NT), (t + 1 < NT));       ENDW(t);     RESC(); ROT();
        STEP(pA0, pA1, pB0, pB1, t + 1, (t + 4 < NT), (t + 2 < NT), (t + 2 < NT));   ENDW(t + 1); RESC(); ROT();
    }
    STEP(pB0, pB1, pA0, pA1, NT - 1, false, false, false); RESC();
    { float sacc = pB0[0] + pB0[1]; _Pragma("unroll") for (int r = 2; r < 16; ++r) sacc += pB0[r]; _Pragma("unroll") for (int r = 0; r < 16; ++r) sacc += pB1[r]; l_reg += sacc;
      pw0 = (u32x4){PKW(pB0, 0), PKW(pB0, 2), PKW(pB0, 4), PKW(pB0, 6)}; pw1 = (u32x4){PKW(pB0, 8), PKW(pB0, 10), PKW(pB0, 12), PKW(pB0, 14)}; pw2 = (u32x4){PKW(pB1, 0), PKW(pB1, 2), PKW(pB1, 4), PKW(pB1, 6)}; pw3 = (u32x4){PKW(pB1, 8), PKW(pB1, 10), PKW(pB1, 12), PKW(pB1, 14)};
      SBAR(); pv(o, vb0 + sl_cur, PAF(0), PAF(1), PAF(2), PAF(3)); }
#undef PKW
#undef PAF
#undef VFR
#undef PIN
#undef MX3
#undef GAPA
#undef GAPB
#undef EX
#undef VRD
#undef KRD
#undef STEP
#undef ENDW
    { auto rr = __builtin_amdgcn_permlane32_swap(__float_as_uint(l_reg), __float_as_uint(l_reg), false, false); l_reg = __uint_as_float(rr[0]) + __uint_as_float(rr[1]); }
    if (hi == 0) { wsf[32 + r32] = l_reg; if (OWN) wsf[r32] = mhat; } asm volatile("s_waitcnt lgkmcnt(0)" ::: "memory");
    float rli[16];
#pragma unroll
    for (int r = 0; r < 16; ++r) rli[r] = __builtin_amdgcn_rcpf(wsf[32 + crow(r, hi)]);
    bf16* Ow = O + (rowbase + q0 + wid * QBLK) * PITCH + h * D;
    { bf16* stg = (bf16*)(shm + LDS_OST) + wid * 2048;
#pragma unroll
      for (int r = 0; r < 16; ++r) { const int orow = crow(r, hi);
#pragma unroll
        for (int d0 = 0; d0 < 2; ++d0) stg[orow * 64 + d0 * 32 + r32] = __float2bfloat16(o[d0][r] * rli[r]); }
      asm volatile("s_waitcnt lgkmcnt(0)" ::: "memory");
      const int nsel = qb < 3 ? qb : 3;
#pragma unroll
      for (int i = 0; i < 4; ++i) { const int row = i * 8 + (lane >> 3), ch = lane & 7; u32x4 v = *(const u32x4*)(stg + row * 64 + ch * 8);
        if constexpr (OWN) {
          if (nsel > 0) {
            const float mo = wsf[row], lo = wsf[32 + row];
            const size_t e0 = (((size_t)(b * NHEAD + h)) * SEQ + q0 + wid * QBLK + row) * 3;
            float ms[3], ls[3]; u32x4 pp[3]; float M = mo;
#pragma unroll
            for (int s_ = 0; s_ < 3; ++s_) { ms[s_] = -INFINITY; ls[s_] = 0.f; pp[s_] = (u32x4){0u, 0u, 0u, 0u};
              if (s_ < nsel) { const f32x2 ml = *(const f32x2*)(PML + (e0 + s_) * 2); ms[s_] = ml.x; ls[s_] = ml.y; pp[s_] = *(const u32x4*)(PO + (e0 + s_) * 64 + ch * 8); M = fmaxf(M, ml.x); } }
            const float wo = lo * __builtin_amdgcn_exp2f(mo - M); float W = wo;
            float a[8] = {bflo(v.x) * wo, bfhi(v.x) * wo, bflo(v.y) * wo, bfhi(v.y) * wo, bflo(v.z) * wo, bfhi(v.z) * wo, bflo(v.w) * wo, bfhi(v.w) * wo};
#pragma unroll
            for (int s_ = 0; s_ < 3; ++s_) { const float w_ = (s_ < nsel) ? ls[s_] * __builtin_amdgcn_exp2f(ms[s_] - M) : 0.f; W += w_;
              a[0] += w_ * bflo(pp[s_].x); a[1] += w_ * bfhi(pp[s_].x); a[2] += w_ * bflo(pp[s_].y); a[3] += w_ * bfhi(pp[s_].y); a[4] += w_ * bflo(pp[s_].z); a[5] += w_ * bfhi(pp[s_].z); a[6] += w_ * bflo(pp[s_].w); a[7] += w_ * bfhi(pp[s_].w); }
            const float iw = 1.0f / W;
            v.x = cvtpk_s(a[0] * iw, a[1] * iw); v.y = cvtpk_s(a[2] * iw, a[3] * iw); v.z = cvtpk_s(a[4] * iw, a[5] * iw); v.w = cvtpk_s(a[6] * iw, a[7] * iw);
          } }
        if (do_store) *(u32x4*)(Ow + (long)row * PITCH + ch * 8) = v; } }
    asm volatile("s_waitcnt lgkmcnt(0)\n\ts_barrier" ::: "memory");
#undef DMA_K
#undef DMA_V
#undef TM
#undef MASKT
#undef START
#undef RESC
#undef ROT
}

__device__ __forceinline__ void select_unit(int b, int h, int qb, const bf16* Q, const float* ksum, unsigned short* LIST, unsigned* CNT, char* shm) {
    if (qb == 0) return;
    const int tid = threadIdx.x, lane = tid & 63, r32 = lane & 31, hi = lane >> 5; const int wid = __builtin_amdgcn_readfirstlane(tid >> 6);
    LAS unsigned* hist = (LAS unsigned*)shm; LAS unsigned* basev = hist + 32;
    if (tid < 32) hist[tid] = 0u;
    __syncthreads();
    int kbs[3] = {0, 1, 2}; const int ns = qb < 3 ? qb : 3;
    if (qb > 3) {
        const bf16* Qw = Q + ((long)b * SEQ + qb * QB + wid * QBLK) * PITCH + h * D;
        bf16x8 qr[4];
#pragma unroll
        for (int d0 = 0; d0 < 4; ++d0) qr[d0] = *reinterpret_cast<const bf16x8*>(&Qw[(long)r32 * PITCH + d0 * 16 + hi * 8]);
        gate_top3(ksum + ((size_t)(b * NHEAD + h) * 32) * 64, qr, qb, r32, hi, kbs);
    }
    unsigned pos[3] = {0u, 0u, 0u};
    if (hi == 0) {
#pragma unroll
        for (int s_ = 0; s_ < 3; ++s_) if (s_ < ns) pos[s_] = __hip_atomic_fetch_add(hist + kbs[s_], 1u, __ATOMIC_RELAXED, __HIP_MEMORY_SCOPE_WORKGROUP);
    }
    __syncthreads();
    const int bh = b * NHEAD + h;
    if (tid < 32) { const unsigned n = hist[tid]; basev[tid] = n ? __hip_atomic_fetch_add(CNT + bh * 32 + tid, n, __ATOMIC_RELAXED, __HIP_MEMORY_SCOPE_AGENT) : 0u; }
    __syncthreads();
    if (hi == 0) { const unsigned qv = (unsigned)(qb * QB + wid * QBLK + r32) << 2;
#pragma unroll
        for (int s_ = 0; s_ < 3; ++s_) if (s_ < ns) LIST[(size_t)(bh * 32 + kbs[s_]) * 8192 + basev[kbs[s_]] + pos[s_]] = (unsigned short)(qv | (unsigned)s_); }
    __syncthreads();
}

constexpr int G_K = 0, G_V = 32768, G_WS = 65536, G_OST = G_WS + NW * 512, G_TAB = G_OST + NW * 4096, G_BYTES = G_TAB + 8256 + 4096;
template <int THRL> __device__ __forceinline__ void gather_phase(char* shm, const bf16* Q, const bf16* __restrict__ K, const bf16* __restrict__ V, const unsigned short* LIST, unsigned* CNT, bf16_t* PO, float* PML, int vcu, int G) {
    const int tid = threadIdx.x, lane = tid & 63, r32 = lane & 31, hi = lane >> 5; const int wid = __builtin_amdgcn_readfirstlane(tid >> 6);
    LAS int* pre = (LAS int*)(shm + G_TAB); LAS int* wtot = pre + 1032; LAS int* cntl = (LAS int*)(shm + G_TAB + 8256);
    {
        const int c0 = (int)__hip_atomic_load(CNT + 2 * tid, __ATOMIC_RELAXED, __HIP_MEMORY_SCOPE_AGENT), c1 = (int)__hip_atomic_load(CNT + 2 * tid + 1, __ATOMIC_RELAXED, __HIP_MEMORY_SCOPE_AGENT);
        const int n0 = (c0 + 255) >> 8, n1 = (c1 + 255) >> 8, sm = n0 + n1; int v = sm;
#pragma unroll
        for (int o_ = 1; o_ < 64; o_ <<= 1) { const int t_ = __shfl_up(v, o_); if (lane >= o_) v += t_; }
        if (lane == 63) wtot[wid] = v;
        cntl[2 * tid] = c0; cntl[2 * tid + 1] = c1;
        __syncthreads();
        int off = 0;
        for (int w_ = 0; w_ < wid; ++w_) off += wtot[w_];
        const int excl = off + v - sm;
        pre[2 * tid] = excl; pre[2 * tid + 1] = excl + n0; if (tid == NW * 64 - 1) pre[1024] = excl + sm;
        __syncthreads();
    }
    const int P = __builtin_amdgcn_readfirstlane(pre[1024]);
    const int ulo = (int)(((long)P * vcu) / G), uhi = (int)(((long)P * (vcu + 1)) / G);
    const unsigned lds0 = (unsigned)(uintptr_t)shm;
    float* wsf = (float*)(shm + G_WS) + wid * 128; int* ent = (int*)(wsf + 64);
    const unsigned kdst = lds0 + G_K + wid * 1024, vdst = lds0 + G_V + wid * 1024;
    const int vb0 = (int)(lds0 + G_V) + ((lane >> 4) & 1) * 32 + (lane & 3) * 8 + (4 * hi + ((lane & 15) >> 2)) * 64;
    int item = 0, cur = -1;
    for (int u = ulo; u < uhi; ++u) {
        while (__builtin_amdgcn_readfirstlane(pre[item + 1]) <= u) ++item;
        const int pass = u - __builtin_amdgcn_readfirstlane(pre[item]), cnt = __builtin_amdgcn_readfirstlane(cntl[item]);
        const int bh = item >> 5, kb = item & 31, b = bh >> 3, h = bh & 7;
        if (item != cur) {
            asm volatile("s_waitcnt lgkmcnt(0)\n\ts_barrier" ::: "memory");
            const bf16* Kh = K + (long)b * SEQ * PITCH + h * D, *Vh = V + (long)b * SEQ * PITCH + h * D;
            const bf16* ksrc = Kh + (long)lane * PITCH + wid * 8;
            const bf16* vsrc = Vh + (long)(16 * (wid & 3) + (lane >> 2)) * PITCH + (wid >> 2) * 32 + (lane & 3) * 8;
#pragma unroll
            for (int t = 0; t < 4; ++t) { glds16(ksrc + (long)(4 * kb + t) * KVBLK * PITCH, (unsigned)__builtin_amdgcn_readfirstlane(kdst + t * 8192)); glds16(vsrc + (long)(4 * kb + t) * KVBLK * PITCH, (unsigned)__builtin_amdgcn_readfirstlane(vdst + t * 8192)); }
            asm volatile("s_waitcnt vmcnt(0)\n\ts_barrier" ::: "memory");
            cur = item;
        }
        const int li = pass * 256 + wid * QBLK + r32; const bool valid = li < cnt;
        const unsigned e = LIST[(size_t)item * 8192 + (valid ? li : 0)];
        const int q = (int)(e >> 2), slot = (int)(e & 3u);
        const bf16* Qrow = Q + ((long)b * SEQ + q) * PITCH + h * D;
        bf16x8 qr[4];
#pragma unroll
        for (int d0 = 0; d0 < 4; ++d0) qr[d0] = *reinterpret_cast<const bf16x8*>(Qrow + d0 * 16 + hi * 8);
        float mhat = 0.f, l_reg = 0.f; f32x16 o[2]; f32x16 negm;
#pragma unroll
        for (int r = 0; r < 16; ++r) { o[0][r] = 0.f; o[1][r] = 0.f; negm[r] = 0.f; }
#pragma unroll
        for (int t = 0; t < 4; ++t) {
            f32x16 p0, p1;
            qkt(p0, p1, shm + G_K + t * 8192, qr, negm, r32, hi);
            float a = fmaxf(fmaxf(p0[0], p0[1]), p1[0]), c_ = fmaxf(fmaxf(p0[2], p0[3]), p1[1]); a = fmaxf(fmaxf(a, p1[2]), p1[3]);
#pragma unroll
            for (int r = 4; r < 16; r += 4) { a = fmaxf(fmaxf(a, p0[r]), p0[r + 1]); c_ = fmaxf(fmaxf(c_, p0[r + 2]), p0[r + 3]); a = fmaxf(fmaxf(a, p1[r]), p1[r + 1]); c_ = fmaxf(fmaxf(c_, p1[r + 2]), p1[r + 3]); }
            float rm = fmaxf(a, c_); { auto rr = __builtin_amdgcn_permlane32_swap(__float_as_uint(rm), __float_as_uint(rm), false, false); rm = fmaxf(__uint_as_float(rr[0]), __uint_as_float(rr[1])); }
            if (t == 0) { mhat = rm;
#pragma unroll
                for (int r = 0; r < 16; ++r) { p0[r] -= rm; p1[r] -= rm; negm[r] = -mhat; }
            } else if (__any(rm > (float)THRL)) { const float dl = fmaxf(rm, 0.f); mhat += dl;
#pragma unroll
                for (int r = 0; r < 16; ++r) { p0[r] -= dl; p1[r] -= dl; negm[r] = -mhat; }
                const float f = __builtin_amdgcn_exp2f(-dl); l_reg *= f; if (hi == 0) wsf[r32] = f;
                asm volatile("s_waitcnt lgkmcnt(0)" ::: "memory");
#pragma unroll
                for (int d_ = 0; d_ < 2; ++d_)
#pragma unroll
                    for (int r = 0; r < 16; ++r) o[d_][r] *= wsf[crow(r, hi)];
            }
            float sacc = 0.f;
#pragma unroll
            for (int r = 0; r < 16; ++r) { p0[r] = __builtin_amdgcn_exp2f(p0[r]); p1[r] = __builtin_amdgcn_exp2f(p1[r]); sacc += p0[r] + p1[r]; }
            l_reg += sacc;
            const u32x4 pw0 = {cvtpk_s(p0[0], p0[1]), cvtpk_s(p0[2], p0[3]), cvtpk_s(p0[4], p0[5]), cvtpk_s(p0[6], p0[7])}, pw1 = {cvtpk_s(p0[8], p0[9]), cvtpk_s(p0[10], p0[11]), cvtpk_s(p0[12], p0[13]), cvtpk_s(p0[14], p0[15])};
            const u32x4 pw2 = {cvtpk_s(p1[0], p1[1]), cvtpk_s(p1[2], p1[3]), cvtpk_s(p1[4], p1[5]), cvtpk_s(p1[6], p1[7])}, pw3 = {cvtpk_s(p1[8], p1[9]), cvtpk_s(p1[10], p1[11]), cvtpk_s(p1[12], p1[13]), cvtpk_s(p1[14], p1[15])};
            __builtin_amdgcn_sched_barrier(0);
            pv(o, vb0 + t * 8192, __builtin_bit_cast(bf16x8, pw0), __builtin_bit_cast(bf16x8, pw1), __builtin_bit_cast(bf16x8, pw2), __builtin_bit_cast(bf16x8, pw3));
        }
        { auto rr = __builtin_amdgcn_permlane32_swap(__float_as_uint(l_reg), __float_as_uint(l_reg), false, false); l_reg = __uint_as_float(rr[0]) + __uint_as_float(rr[1]); }
        const int er = valid ? (q * 3 + slot) : -1;
        if (hi == 0) { wsf[32 + r32] = l_reg; ent[r32] = er; } asm volatile("s_waitcnt lgkmcnt(0)" ::: "memory");
        float rli[16];
#pragma unroll
        for (int r = 0; r < 16; ++r) rli[r] = __builtin_amdgcn_rcpf(wsf[32 + crow(r, hi)]);
        bf16* stg = (bf16*)(shm + G_OST) + wid * 2048;
#pragma unroll
        for (int r = 0; r < 16; ++r) { const int orow = crow(r, hi);
#pragma unroll
            for (int d0 = 0; d0 < 2; ++d0) stg[orow * 64 + d0 * 32 + r32] = __float2bfloat16(o[d0][r] * rli[r]); }
        asm volatile("s_waitcnt lgkmcnt(0)" ::: "memory");
        const size_t ebase = (size_t)bh * SEQ * 3;
#pragma unroll
        for (int i = 0; i < 4; ++i) { const int row = i * 8 + (lane >> 3), ch = lane & 7; const u32x4 v = *(const u32x4*)(stg + row * 64 + ch * 8); const int er_ = ent[row];
            if (er_ >= 0) *(u32x4*)(PO + (ebase + er_) * 64 + ch * 8) = v; }
        if (hi == 0 && valid) *(f32x2*)(PML + (ebase + er) * 2) = (f32x2){mhat, l_reg};
        asm volatile("s_waitcnt lgkmcnt(0)" ::: "memory");
    }
    asm volatile("s_waitcnt vmcnt(0) lgkmcnt(0)\n\ts_barrier" ::: "memory");
}
#undef SBAR
#undef WAIT_BAR
}

#define XB_TMO      128
#define XB_XCNT(j)  (256  + 64 * (j))
#define XB_XSUB(j)  (1280 + 64 * (j))
#define XB_XGEN(j)  (2304 + 64 * (j))
#define XB_TOP      3328
#define XB_TOPGEN   3392
#define XCD_BAR_WORDS 3456
#define XB_SPIN_CAP (1u << 18)
__device__ __forceinline__ unsigned xb_ld(unsigned* p)              { return __hip_atomic_load(p, __ATOMIC_RELAXED, __HIP_MEMORY_SCOPE_AGENT); }
__device__ __forceinline__ unsigned xb_add(unsigned* p, unsigned v) { return __hip_atomic_fetch_add(p, v, __ATOMIC_RELAXED, __HIP_MEMORY_SCOPE_AGENT); }
__device__ __forceinline__ unsigned xb_xcc_id() { return (unsigned)__builtin_amdgcn_s_getreg((3 << 11) | 20) & 0xFu; }
#define XB_SPIN(cond, bar) do { unsigned _sp = 0; while (cond) { __builtin_amdgcn_s_sleep(1); \
    if ((++_sp & 255u) == 0u) { if (xb_ld(&(bar)[XB_TMO])) break; if (_sp > XB_SPIN_CAP) { atomicAdd(&(bar)[XB_TMO], 1u); break; } } } } while (0)
struct XcdBarrier { unsigned* bar; unsigned x; volatile LAS unsigned* st; };
__device__ __forceinline__ XcdBarrier xcd_barrier_post(unsigned* bar, volatile LAS unsigned* st) {
    XcdBarrier b; b.bar = bar; b.x = xb_xcc_id(); b.st = st;
    if (threadIdx.x == 0) (void)xb_add(&bar[XB_XCNT(b.x)], 1u);
    return b;
}
__device__ __forceinline__ void xcd_barrier_complete(unsigned* bar, unsigned x, unsigned& nloc, unsigned& nx) {
    const unsigned G = gridDim.x * gridDim.y * gridDim.z;
    unsigned sum, cnt, mine, sp = 0u;
    for (;;) {
        sum = 0u; cnt = 0u; mine = 0u;
#pragma unroll
        for (unsigned j = 0; j < 16; ++j) { const unsigned c = xb_ld(&bar[XB_XCNT(j)]); sum += c; cnt += (c > 0u) ? 1u : 0u; mine = (j == x) ? c : mine; }
        if (sum == G) break;
        __builtin_amdgcn_s_sleep(1);
        if ((++sp & 255u) == 0u) { if (xb_ld(&bar[XB_TMO])) break; if (sp > XB_SPIN_CAP) { atomicAdd(&bar[XB_TMO], 1u); break; } }
    }
    nloc = mine > 0u ? mine : 1u; nx = cnt > 0u ? cnt : 1u;
}
__device__ __forceinline__ void xcd_barrier(const XcdBarrier& b) {
    asm volatile("s_waitcnt vmcnt(0)" ::: "memory");
    __syncthreads();
    if (threadIdx.x == 0) {
        unsigned* bar = b.bar;
        __builtin_amdgcn_s_waitcnt(0);
        unsigned nloc = b.st[0], nx = b.st[1];
        if (nloc == 0u) { xcd_barrier_complete(bar, b.x, nloc, nx); b.st[0] = nloc; b.st[1] = nx; }
        const unsigned old = xb_add(&bar[XB_XSUB(b.x)], 1u);
        const unsigned gen = old / nloc;
        if (old + 1u == (gen + 1u) * nloc) {
            __builtin_amdgcn_fence(__ATOMIC_RELEASE, "agent");
            asm volatile("s_waitcnt vmcnt(0)" ::: "memory");
            const unsigned og = xb_add(&bar[XB_TOP], 1u);
            const unsigned tg = og / nx;
            if (og + 1u == (tg + 1u) * nx) xb_add(&bar[XB_TOPGEN], 1u);
            else XB_SPIN(xb_ld(&bar[XB_TOPGEN]) == tg, bar);
            __builtin_amdgcn_fence(__ATOMIC_ACQUIRE, "agent");
            xb_add(&bar[XB_XGEN(b.x)], 1u);
            asm volatile("s_waitcnt vmcnt(0)" ::: "memory");
        } else {
            XB_SPIN(xb_ld(&bar[XB_XGEN(b.x)]) == gen, bar);
            __builtin_amdgcn_fence(__ATOMIC_ACQUIRE, "agent");
            asm volatile("s_waitcnt vmcnt(0)" ::: "memory");
        }
    }
    __syncthreads();
}

struct Args { const float* in[22]; float* out; unsigned char* ws; int ph_lo, ph_hi, li, flags; };
struct Frame {
    LAS unsigned char* lds; volatile LAS unsigned* MISC; gu32* ctl;
    int tid, lane, wave, vcu, G;
};
__device__ __forceinline__ int fresh_tid() { int t = threadIdx.x; asm volatile("" : "+v"(t)); return t; }
#define PHASE_IDS() do { F.tid = fresh_tid(); F.lane = F.tid & 63; F.wave = __builtin_amdgcn_readfirstlane(F.tid >> 6); } while (0)

__device__ __forceinline__ void transpose_item(const float* W, int ldw, int k0, int n0, bf16_t* WT, size_t row_off, int Kd, LAS float* scr, int lane) {
    const int half = lane >> 5, j2 = 2 * (lane & 31);
#pragma unroll 8
    for (int i = 0; i < 32; ++i) { const int kk = 2 * i + half; const f32x2 v = *(const f32x2*)(W + (size_t)(k0 + kk) * ldw + n0 + j2); scr[kk * 65 + j2] = v.x; scr[kk * 65 + j2 + 1] = v.y; }
    LDS_WAIT(); asm volatile("" ::: "memory");
    const int c = lane & 7;
#pragma unroll
    for (int j = 0; j < 8; ++j) { const int n = (lane >> 3) + 8 * j; const LAS float* s = scr + (8 * c) * 65 + n;
        u32x4 o; o.x = cvt_pk_bf16(s[0 * 65], s[1 * 65]); o.y = cvt_pk_bf16(s[2 * 65], s[3 * 65]); o.z = cvt_pk_bf16(s[4 * 65], s[5 * 65]); o.w = cvt_pk_bf16(s[6 * 65], s[7 * 65]);
        *(u32x4*)(WT + (row_off + n0 + n) * (size_t)Kd + k0 + 8 * c) = o; }
    LDS_WAIT(); asm volatile("" ::: "memory");
}

__global__ void __launch_bounds__(NWAVES * 64, 2) hybrid_fwd(Args args) {
    extern __shared__ __attribute__((aligned(16))) unsigned char lds_raw[];
    Frame F;
    F.lds = (LAS unsigned char*)lds_raw;
    F.MISC = (volatile LAS unsigned*)(F.lds + MISC_OFF);
    F.tid = threadIdx.x; F.lane = F.tid & 63; F.wave = __builtin_amdgcn_readfirstlane(F.tid >> 6);
    F.G = gridDim.x; { const int bx = blockIdx.x; F.vcu = (F.G % 8 == 0) ? (bx % 8) * (F.G / 8) + bx / 8 : bx; }
    unsigned char* ws = args.ws;
    F.ctl = (gu32*)(ws + WS_CTL);
    const float* x = args.in[0]; const float* cvec = args.in[1]; const float* ada_w = args.in[2]; const float* ada_b = args.in[3];
    const float* norm1_g = args.in[4]; const float* norm2_g = args.in[5]; const float* w_in = args.in[6]; const float* gmlp_ln_g = args.in[7]; const float* gmlp_ln_b = args.in[8];
    const float* w_spatial = args.in[9]; const float* b_spatial = args.in[10]; const float* w_branch_a = args.in[11]; const float* w_branch_b = args.in[12]; const float* w_out = args.in[13];
    const float* w_rg = args.in[14]; const float* b_rg = args.in[15]; const float* w_re = args.in[16]; const float* b_re = args.in[17];
    const float* w_gate = args.in[18]; const float* w_up = args.in[19]; const float* w_down = args.in[20]; const float* final_g = args.in[21];
    float* out = args.out;
    float* KSUM = (float*)(ws + WS_KSUM); float* MODP = (float*)(ws + WS_MODP); float* MOD = (float*)(ws + WS_MOD); float* ROPE = (float*)(ws + WS_ROPE);
    bf16_t* WST = (bf16_t*)(ws + WS_WST); bf16_t* WRT = (bf16_t*)(ws + WS_WRT); float* SSQ = (float*)(ws + WS_SSQ);
    unsigned long long* ROUTE = (unsigned long long*)(ws + WS_ROUTE);
    bf16_t* WIN = (bf16_t*)(ws + WS_WIN); bf16_t* WA = (bf16_t*)(ws + WS_WA); bf16_t* WB = (bf16_t*)(ws + WS_WB); bf16_t* WOUT = (bf16_t*)(ws + WS_WOUT);
    bf16_t* WGU = (bf16_t*)(ws + WS_WGU); bf16_t* WD = (bf16_t*)(ws + WS_WD);
    bf16_t* XN = (bf16_t*)(ws + WS_XN); bf16_t* PROJ = (bf16_t*)(ws + WS_PROJ); bf16_t* HID = (bf16_t*)(ws + WS_HID); bf16_t* YB = (bf16_t*)(ws + WS_Y); bf16_t* X1 = (bf16_t*)(ws + WS_X1);
    bf16_t* PO = (bf16_t*)(ws + WS_PO); float* PML = (float*)(ws + WS_PML); unsigned short* LIST = (unsigned short*)(ws + WS_LIST); unsigned* CNT = (unsigned*)(F.ctl + CW_CNT);

    for (int u = F.tid; u < 256; u += NWAVES * 64) ((LAS unsigned*)(F.lds + MISC_OFF))[u] = 0u;
    __syncthreads();
    XcdBarrier bar; bar.bar = (unsigned*)(F.ctl + CW_BAR) + args.li * XCD_BAR_WORDS; bar.x = 0; bar.st = nullptr;
    if (!MK_PER_PHASE) bar = xcd_barrier_post((unsigned*)(F.ctl + CW_BAR) + args.li * XCD_BAR_WORDS, F.MISC + 8);
    const int lo = args.ph_lo, hi = args.ph_hi;
#define IN(k) (lo <= (k) && (k) < hi)
#define SEAM(k) do { if (IN(k) && IN((k) + 1)) xcd_barrier(bar); } while (0)

    if (IN(0)) { PHASE_IDS();
        const int gw = F.vcu * NWAVES + F.wave, NGW = F.G * NWAVES;
        const int gtid = F.vcu * (NWAVES * 64) + F.tid, NGT = F.G * NWAVES * 64;
        LAS float* scr = (LAS float*)(F.lds + F.wave * 16640);
        constexpr int I_MOD = 16 * 24, I_IN = 16 * 72, I_A = 8 * 16, I_O = 16 * 16;
        constexpr int NITEMS = I_MOD + I_IN + 2 * I_A + I_O;
        for (int it = gw; it < NITEMS; it += NGW) {
            int r = it;
            if (r < I_MOD) {
                const int s = r / 24, nc = r % 24, n = nc * 256 + 4 * F.lane;
                f32x4 a0 = {0.f, 0.f, 0.f, 0.f}, a1 = a0, a2 = a0, a3 = a0;
#pragma unroll 8
                for (int kk = 0; kk < 64; ++kk) { const int k = 64 * s + kk; const f32x4 w = *(const f32x4*)(ada_w + (size_t)k * 6144 + n);
                    a0 += w * cvec[k]; a1 += w * cvec[1024 + k]; a2 += w * cvec[2048 + k]; a3 += w * cvec[3072 + k]; }
                float* dst = MODP + (size_t)s * 24576 + n;
                *(f32x4*)(dst) = a0; *(f32x4*)(dst + 6144) = a1; *(f32x4*)(dst + 12288) = a2; *(f32x4*)(dst + 18432) = a3;
                continue; }
            r -= I_MOD;
            if (r < I_IN) { transpose_item(w_in, PC, 64 * (r / 72), 64 * (r % 72), WIN, 0, 1024, scr, F.lane); continue; } r -= I_IN;
            if (r < I_A) { transpose_item(w_branch_a, 1024, 64 * (r / 16), 64 * (r % 16), WA, 0, 512, scr, F.lane); continue; } r -= I_A;
            if (r < I_A) { transpose_item(w_branch_b, 1024, 64 * (r / 16), 64 * (r % 16), WB, 0, 512, scr, F.lane); continue; } r -= I_A;
            transpose_item(w_out, 1024, 64 * (r / 16), 64 * (r % 16), WOUT, 0, 1024, scr, F.lane);
        }
        for (int i = gtid; i < 65536; i += NGT) {
            const int pos = i >> 3, j = i & 7; const float inv = powf(500000.0f, -(float)j * 2.0f / 16.0f); const float ang = (float)pos * inv;
            ROPE[i] = cosf(ang); ROPE[65536 + i] = sinf(ang); }
        for (int i = gtid; i < 65536; i += NGT) {
            const int s = i & 127, t_ = (i >> 7) & 127; const float v = (s <= t_) ? w_spatial[i] : 0.f; WST[i] = (bf16_t)(cvt_pk_bf16(v, 0.f) & 0xffffu); }
        for (int i = gtid; i < 48 * 1024; i += NGT) {
            const int j = i >> 10, k = i & 1023; float v = 0.f; if (j < 4) v = w_rg[k * 4 + j]; else if (j < 36) v = w_re[k * 32 + (j - 4)];
            const unsigned hb = cvt_pk_bf16(v, 0.f) & 0xffffu; const float lo = v - bflo(hb);
            WRT[i] = (bf16_t)hb; WRT[48 * 1024 + i] = (bf16_t)(cvt_pk_bf16(lo, 0.f) & 0xffffu); }
    }
    SEAM(0);

    if (IN(1)) { PHASE_IDS();
        const int c = F.vcu, b = c >> 6;
        LAS float* f = (LAS float*)F.lds;
        for (int v = F.tid; v < 2048; v += NWAVES * 64) { float s = ada_b[v];
#pragma unroll
            for (int sl = 0; sl < 16; ++sl) s += MODP[(size_t)sl * 24576 + b * 6144 + v];
            f[v] = s; }
        if (F.tid < 96) { const int idx = 96 * c + F.tid; float s = ada_b[idx % 6144];
#pragma unroll
            for (int sl = 0; sl < 16; ++sl) s += MODP[(size_t)sl * 24576 + idx];
            MOD[idx] = s; }
        __syncthreads();
        f32x4 A1[4], B1[4];
#pragma unroll
        for (int j = 0; j < 4; ++j) { const int k = 4 * F.lane + 256 * j; const f32x4 g = *(const f32x4*)(norm1_g + k);
#pragma unroll
            for (int i = 0; i < 4; ++i) { A1[j][i] = g[i] * (1.0f + f[1024 + k + i]); B1[j][i] = f[k + i]; } }
        for (int i = 0; i < 16; ++i) { const size_t row = (size_t)c * 128 + F.wave * 16 + i;
            const f32x4* xr = (const f32x4*)(x + row * DM) + F.lane; f32x4 v[4]; float s = 0.f;
#pragma unroll
            for (int j = 0; j < 4; ++j) { v[j] = xr[64 * j]; s += (v[j].x * v[j].x + v[j].y * v[j].y) + (v[j].z * v[j].z + v[j].w * v[j].w); }
            const float rstd = 1.0f / sqrtf(wave_sum(s) * (1.0f / DM) + EPS);
            u32x2* o8 = (u32x2*)(XN + row * DM) + F.lane;
#pragma unroll
            for (int j = 0; j < 4; ++j) { const f32x4 hv = v[j] * rstd * A1[j] + B1[j]; u32x2 w; w.x = cvt_pk_bf16(hv.x, hv.y); w.y = cvt_pk_bf16(hv.z, hv.w); o8[64 * j] = w; } }
        __syncthreads();
    }
    SEAM(1);

    if (IN(2)) {
        pg8::DenseSched S; S.init(XN, DM, WIN, DM, T, PC, F.G, (int)blockIdx.x);
        pg8::EpiProj E{PROJ, ROPE, KSUM};
        pg8::gemm_phase<pg8::EpiProj, pg8::DenseSched, false>(F.lds, S, E);
    }
    SEAM(2);

    if (IN(3)) { PHASE_IDS();
        for (int chunk = F.vcu; chunk < ((args.flags & 2) ? 0 : T / 128); chunk += F.G) {
            const int lane = F.lane, w = F.wave, q = lane >> 4, l15 = lane & 15;
            const size_t row0 = (size_t)chunk * 128;
            float lg[8], lb[8];
            { const f32x4 g0 = *(const f32x4*)(gmlp_ln_g + 8 * lane), g1 = *(const f32x4*)(gmlp_ln_g + 8 * lane + 4), b0 = *(const f32x4*)(gmlp_ln_b + 8 * lane), b1 = *(const f32x4*)(gmlp_ln_b + 8 * lane + 4);
#pragma unroll
              for (int j = 0; j < 4; ++j) { lg[j] = g0[j]; lg[4 + j] = g1[j]; lb[j] = b0[j]; lb[4 + j] = b1[j]; } }
            u32x4 vn[16];
#pragma unroll
            for (int i = 0; i < 16; ++i) { const size_t row = row0 + 16 * w + i; const u32x4 raw = *(const u32x4*)(PROJ + row * PC + C_V + 8 * lane);
                float v[8] = {bflo(raw.x), bfhi(raw.x), bflo(raw.y), bfhi(raw.y), bflo(raw.z), bfhi(raw.z), bflo(raw.w), bfhi(raw.w)};
                float s = 0.f;
#pragma unroll
                for (int j = 0; j < 8; ++j) s += v[j];
                const float mean = wave_sum(s) * (1.0f / 512.0f); float s2 = 0.f;
#pragma unroll
                for (int j = 0; j < 8; ++j) { v[j] -= mean; s2 += v[j] * v[j]; }
                const float rstd = 1.0f / sqrtf(wave_sum(s2) * (1.0f / 512.0f) + EPS);
#pragma unroll
                for (int j = 0; j < 8; ++j) v[j] = v[j] * rstd * lg[j] + lb[j];
                vn[i].x = cvt_pk_bf16(v[0], v[1]); vn[i].y = cvt_pk_bf16(v[2], v[3]); vn[i].z = cvt_pk_bf16(v[4], v[5]); vn[i].w = cvt_pk_bf16(v[6], v[7]); }
            for (int g = 0; g < 4; ++g) {
                __syncthreads();
                if (q == g) {
#pragma unroll
                    for (int i = 0; i < 16; ++i) *(LAS u32x4*)(F.lds + (16 * w + i) * 288 + l15 * 16) = vn[i];
                }
                __syncthreads();
                f32x4 acc[8];
#pragma unroll
                for (int it = 0; it < 8; ++it) acc[it] = (f32x4){0.f, 0.f, 0.f, 0.f};
                const int tt = 16 * w + l15;
                const int nks = (16 * w + 16 + 31) / 32;
                for (int ks = 0; ks < nks; ++ks) {
                    const bf16_t* wp = WST + ((size_t)(g * 128 + tt)) * 128 + 32 * ks + 4 * q;
                    const u32x2 wlo = *(const u32x2*)wp, whi = *(const u32x2*)(wp + 16);
                    const bf16x8 bw = __builtin_bit_cast(bf16x8, (u32x4){wlo.x, wlo.y, whi.x, whi.y});
                    const attn_body::lds_cptr base = (attn_body::lds_cptr)F.lds + (32 * ks + 4 * q + (l15 >> 2)) * 288 + (l15 & 3) * 8;
#pragma unroll
                    for (int it = 0; it < 8; ++it) {
                        const s16x4 lo = attn_body::vtr(base + it * 32), hi_ = attn_body::vtr(base + 16 * 288 + it * 32);
                        const bf16x8 a = (bf16x8){lo[0], lo[1], lo[2], lo[3], hi_[0], hi_[1], hi_[2], hi_[3]};
                        acc[it] = __builtin_amdgcn_mfma_f32_16x16x32_bf16(a, bw, acc[it], 0, 0, 0);
                    }
                }
                const float bs = b_spatial[g * 128 + tt];
                bf16_t* prow = PROJ + (row0 + tt) * PC + C_U + 128 * g + 4 * q;
#pragma unroll
                for (int it = 0; it < 8; ++it) { const u32x2 uu = *(const u32x2*)(prow + 16 * it);
                    u32x2 o; o.x = cvt_pk_bf16(bflo(uu.x) * (acc[it][0] + bs), bfhi(uu.x) * (acc[it][1] + bs)); o.y = cvt_pk_bf16(bflo(uu.y) * (acc[it][2] + bs), bfhi(uu.y) * (acc[it][3] + bs));
                    *(u32x2*)(prow + 16 * it) = o; }
            }
            __syncthreads();
        }
        {
            using namespace attn_body;
            const int s = F.vcu & 7, bh = F.vcu >> 3;
            const bf16* Qp = (const bf16*)(PROJ + C_Q); const bf16* Kp = (const bf16*)(PROJ + C_K); const bf16* Vp = (const bf16*)(PROJ + C_VV);
#define QBI(i) (((i) == 0) ? s : ((i) == 1) ? 15 - s : ((i) == 2) ? 16 + s : 31 - s)
            if (ATTN_MODE != 0) {
                if (bh < NB * 8) for (int i = 0; i < 4; ++i) select_unit(bh >> 3, bh & 7, QBI(i), Qp, KSUM, LIST, CNT, (char*)lds_raw + 40960);
                if (!MK_PER_PHASE) xcd_barrier(bar);
                gather_phase<8>((char*)lds_raw, Qp, Kp, Vp, LIST, CNT, PO, PML, F.vcu, F.G);
                if (!MK_PER_PHASE) xcd_barrier(bar);
                bf16* Op = (bf16*)(PROJ + (ATTN_MODE == 2 ? C_V : C_Q));
                if (bh < NB * 8) for (int i = 0; i < 4; ++i) attn_unit<8, true>(bh >> 3, bh & 7, QBI(i), Qp, Kp, Vp, Op, KSUM, (char*)lds_raw, (args.flags & 1) == 0, PO, PML);
            }
            if (ATTN_MODE == 0) {
                if (bh < NB * 8) for (int i = 0; i < 4; ++i) attn_unit<8, false>(bh >> 3, bh & 7, QBI(i), Qp, Kp, Vp, (bf16*)(PROJ + C_Q), KSUM, (char*)lds_raw, (args.flags & 1) == 0, PO, PML);
            }
#undef QBI
        }
        VM_WAIT(); __syncthreads();
    }
    SEAM(3);

    if (IN(4)) {
        { pg8::DenseSched S; S.init(PROJ + C_U, PC, WA, 512, T, DM, F.G, (int)blockIdx.x); pg8::EpiMerge<true> E{PROJ, XN};
          pg8::gemm_phase<pg8::EpiMerge<true>, pg8::DenseSched, false>(F.lds, S, E); }
        { pg8::DenseSched S; S.init(PROJ + C_Q, PC, WB, 512, T, DM, F.G, (int)blockIdx.x); pg8::EpiMerge<false> E{PROJ, XN};
          pg8::gemm_phase<pg8::EpiMerge<false>, pg8::DenseSched, false>(F.lds, S, E); }
    }
    SEAM(4);

    if (IN(5)) {
        pg8::DenseSched S; S.init(XN, DM, WOUT, DM, T, DM, F.G, (int)blockIdx.x); pg8::EpiOut E{x, X1, MOD, SSQ};
        pg8::gemm_phase<pg8::EpiOut, pg8::DenseSched, false>(F.lds, S, E);
    }
    SEAM(5);

    if (IN(6)) { PHASE_IDS();
        {
            LAS float* scr = (LAS float*)(F.lds + F.wave * 16640);
            const int gw = F.vcu * NWAVES + F.wave, NGW = F.G * NWAVES;
            constexpr int I_G = 32 * 16 * 8, I_D = 32 * 8 * 16;
            for (int it = gw; it < 2 * I_G + I_D; it += NGW) { int r = it;
                if (r < 2 * I_G) { const bool up = r >= I_G; if (up) r -= I_G; const int e = r / 128, kb = (r % 128) / 8, nb = r % 8, n0 = 64 * nb;
                    const size_t row_off = (size_t)e * 1024 + (size_t)(n0 / 128) * 256 + (up ? 128 : 0) + (n0 % 128) - n0;
                    transpose_item((up ? w_up : w_gate) + (size_t)e * 1024 * 512, 512, 64 * kb, n0, WGU, row_off, 1024, scr, F.lane); continue; }
                r -= 2 * I_G;
                { const int e = r / 128, kb = (r % 128) / 16, nb = r % 16; transpose_item(w_down + (size_t)e * 512 * 1024, 1024, 64 * kb, 64 * nb, WD, (size_t)e * 1024, 512, scr, F.lane); } }
            __syncthreads();
        }
        const int c = F.vcu, b = c >> 6, lane = F.lane, w = F.wave, r = lane & 15, q = lane >> 4;
        LAS float* A2 = (LAS float*)F.lds; LAS float* B2 = A2 + 1024; LAS float* LG = (LAS float*)(F.lds + 8192) + w * 768;
        LAS unsigned* hist = (LAS unsigned*)(F.lds + 8192 + 8 * 3072); LAS unsigned* basev = hist + 32;
        for (int k = F.tid; k < 1024; k += NWAVES * 64) { A2[k] = norm2_g[k] * (1.0f + MOD[b * 6144 + 4096 + k]); B2[k] = MOD[b * 6144 + 3072 + k]; }
        if (F.tid < 32) hist[F.tid] = 0u;
        __syncthreads();
        const size_t row = (size_t)c * 128 + w * 16 + r;
        float rs;
        { const f32x4* sp = (const f32x4*)(SSQ + row * 16); const f32x4 s0 = sp[0], s1 = sp[1], s2 = sp[2], s3 = sp[3];
          const float ss = ((s0[0] + s0[1]) + (s0[2] + s0[3])) + ((s1[0] + s1[1]) + (s1[2] + s1[3])) + ((s2[0] + s2[1]) + (s2[2] + s2[3])) + ((s3[0] + s3[1]) + (s3[2] + s3[3]));
          rs = 1.0f / sqrtf(ss * (1.0f / DM) + EPS); }
        f32x4 acc[3];
#pragma unroll
        for (int jt = 0; jt < 3; ++jt) acc[jt] = (f32x4){0.f, 0.f, 0.f, 0.f};
        const bf16_t* xrow = X1 + row * DM;
#pragma unroll 2
        for (int s = 0; s < 32; ++s) { const int k0 = 32 * s + 8 * q;
            const u32x4 xr = *(const u32x4*)(xrow + k0);
            const f32x4 x0 = {bflo(xr.x), bfhi(xr.x), bflo(xr.y), bfhi(xr.y)}, x1v = {bflo(xr.z), bfhi(xr.z), bflo(xr.w), bfhi(xr.w)};
            const f32x4 a0 = *(const LAS f32x4*)(A2 + k0), a1 = *(const LAS f32x4*)(A2 + k0 + 4), b0 = *(const LAS f32x4*)(B2 + k0), b1 = *(const LAS f32x4*)(B2 + k0 + 4);
            const f32x4 h0 = x0 * rs * a0 + b0, h1 = x1v * rs * a1 + b1;
            u32x4 hw; hw.x = cvt_pk_bf16(h0[0], h0[1]); hw.y = cvt_pk_bf16(h0[2], h0[3]); hw.z = cvt_pk_bf16(h1[0], h1[1]); hw.w = cvt_pk_bf16(h1[2], h1[3]);
            *(u32x4*)(XN + row * DM + k0) = hw;
            u32x4 lw; lw.x = cvt_pk_bf16(h0[0] - bflo(hw.x), h0[1] - bfhi(hw.x)); lw.y = cvt_pk_bf16(h0[2] - bflo(hw.y), h0[3] - bfhi(hw.y));
            lw.z = cvt_pk_bf16(h1[0] - bflo(hw.z), h1[1] - bfhi(hw.z)); lw.w = cvt_pk_bf16(h1[2] - bflo(hw.w), h1[3] - bfhi(hw.w));
            const bf16x8 hb = __builtin_bit_cast(bf16x8, hw), hl = __builtin_bit_cast(bf16x8, lw);
#pragma unroll
            for (int jt = 0; jt < 3; ++jt) { const bf16x8 wf = *(const bf16x8*)(WRT + (size_t)(16 * jt + r) * 1024 + k0), wl = *(const bf16x8*)(WRT + 48 * 1024 + (size_t)(16 * jt + r) * 1024 + k0);
                acc[jt] = __builtin_amdgcn_mfma_f32_16x16x32_bf16(wf, hb, acc[jt], 0, 0, 0);
                acc[jt] = __builtin_amdgcn_mfma_f32_16x16x32_bf16(wf, hl, acc[jt], 0, 0, 0);
                acc[jt] = __builtin_amdgcn_mfma_f32_16x16x32_bf16(wl, hb, acc[jt], 0, 0, 0); } }
#pragma unroll
        for (int jt = 0; jt < 3; ++jt) *(LAS f32x4*)(LG + r * 48 + 16 * jt + 4 * q) = acc[jt];
        LDS_WAIT(); asm volatile("" ::: "memory");
        int E0 = 0, E1 = 0; float w0 = 0.f, w1 = 0.f; unsigned lp0 = 0u, lp1 = 0u;
        if (lane < 16) {
            const LAS float* lgp = LG + lane * 48;
            float gl[4];
#pragma unroll
            for (int j = 0; j < 4; ++j) gl[j] = lgp[j] + b_rg[j];
            int g = 0; float gm = gl[0];
#pragma unroll
            for (int j = 1; j < 4; ++j) if (gl[j] > gm) { gm = gl[j]; g = j; }
            float gs = 0.f;
#pragma unroll
            for (int j = 0; j < 4; ++j) gs += __expf(gl[j] - gm);
            const float gp = 1.0f / gs;
            float m0 = -INFINITY, m1 = -INFINITY; int i0 = 0, i1 = 0;
#pragma unroll
            for (int j = 0; j < 8; ++j) { const float el = lgp[4 + 8 * g + j] + b_re[g * 8 + j];
                if (el > m0) { m1 = m0; i1 = i0; m0 = el; i0 = j; } else if (el > m1) { m1 = el; i1 = j; } }
            const float d = __expf(m1 - m0), inv = 1.0f / (1.0f + d);
            w0 = gp * inv; w1 = gp * d * inv; E0 = 8 * g + i0; E1 = 8 * g + i1;
            lp0 = __hip_atomic_fetch_add(hist + E0, 1u, __ATOMIC_RELAXED, __HIP_MEMORY_SCOPE_WORKGROUP);
            lp1 = __hip_atomic_fetch_add(hist + E1, 1u, __ATOMIC_RELAXED, __HIP_MEMORY_SCOPE_WORKGROUP);
        }
        __syncthreads();
        if (F.tid < 32) { const unsigned n = hist[F.tid]; basev[F.tid] = n ? __hip_atomic_fetch_add((unsigned*)(F.ctl + CW_CURSOR + 64 * F.tid), n, RLX_AGENT) : 0u; }
        __syncthreads();
        if (lane < 16) { const unsigned tok = (unsigned)(c * 128 + w * 16 + lane);
            ROUTE[(size_t)E0 * 32768 + basev[E0] + lp0] = ((unsigned long long)__float_as_uint(w0) << 32) | (unsigned long long)(2u * tok);
            ROUTE[(size_t)E1 * 32768 + basev[E1] + lp1] = ((unsigned long long)__float_as_uint(w1) << 32) | (unsigned long long)(2u * tok + 1u); }
        __syncthreads();
    }
    SEAM(6);

    if (IN(7) || IN(8)) { PHASE_IDS();
        volatile LAS int* tab = (volatile LAS int*)(F.lds + MISC_OFF + 256);
        if (F.tid < 32) tab[F.tid] = (int)__hip_atomic_load((unsigned*)(F.ctl + CW_CURSOR + 64 * F.tid), RLX_AGENT);
        __syncthreads();
        if (F.tid == 0) { int o = 0; for (int e = 0; e < 32; ++e) { tab[32 + e] = o; o += (tab[e] + 255) >> 8; } tab[64] = o; }
        __syncthreads();
        const int U = 4 * __builtin_amdgcn_readfirstlane(tab[64]);
        const int xq = F.vcu >> 5, jj = F.vcu & 31;
        pg8::MoeSched S; S.tab = tab; S.start = (int)(((long)U * xq) / 8); S.end = (int)(((long)U * (xq + 1)) / 8); S.j = jj; S.route = ROUTE;
        if (IN(7)) {
            S.A = (const char*)XN; S.lda = DM; S.K = DM; S.Bt = (const char*)WGU; S.bstride = (size_t)1024 * 1024 * 2; S.gather = true;
            pg8::EpiGU E{HID};
            pg8::gemm_phase<pg8::EpiGU, pg8::MoeSched, true>(F.lds, S, E);
        }
        SEAM(7);
        if (IN(8)) {
            S.A = (const char*)HID; S.lda = DEXP; S.K = DEXP; S.Bt = (const char*)WD; S.bstride = (size_t)1024 * 512 * 2; S.gather = false;
            pg8::EpiDown E{YB, ROUTE};
            pg8::gemm_phase<pg8::EpiDown, pg8::MoeSched, false>(F.lds, S, E);
        }
    }
    SEAM(8);

    if (IN(9)) { PHASE_IDS();
        const int c = F.vcu, b = c >> 6;
        f32x4 G2[4], FG[4];
#pragma unroll
        for (int j = 0; j < 4; ++j) { const int k = 4 * F.lane + 256 * j; G2[j] = *(const f32x4*)(MOD + b * 6144 + 5120 + k); FG[j] = *(const f32x4*)(final_g + k); }
        for (int i = 0; i < 16; ++i) { const size_t row = (size_t)c * 128 + F.wave * 16 + i;
            f32x4* xr = (f32x4*)(out + row * DM) + F.lane; const u32x2* xb = (const u32x2*)(X1 + row * DM) + F.lane; const u32x2* y0 = (const u32x2*)(YB + (2 * row) * DM) + F.lane; const u32x2* y1 = (const u32x2*)(YB + (2 * row + 1) * DM) + F.lane;
            f32x4 v[4]; float s = 0.f;
#pragma unroll
            for (int j = 0; j < 4; ++j) { const u32x2 a = y0[64 * j], bb = y1[64 * j], xx = xb[64 * j]; const f32x4 ys = {bflo(a.x) + bflo(bb.x), bfhi(a.x) + bfhi(bb.x), bflo(a.y) + bflo(bb.y), bfhi(a.y) + bfhi(bb.y)};
                const f32x4 xv = {bflo(xx.x), bfhi(xx.x), bflo(xx.y), bfhi(xx.y)};
                v[j] = xv + G2[j] * ys; s += (v[j].x * v[j].x + v[j].y * v[j].y) + (v[j].z * v[j].z + v[j].w * v[j].w); }
            const float rstd = 1.0f / sqrtf(wave_sum(s) * (1.0f / DM) + EPS);
#pragma unroll
            for (int j = 0; j < 4; ++j) xr[64 * j] = v[j] * rstd * FG[j];
            if (ATTN_MODE == 2 && row == 0 && F.lane == 0) { const float d_ = __uint_as_float(__hip_atomic_load((unsigned*)(F.ctl + CW_DIFF), RLX_AGENT)); ((float*)xr)[0] += 1.0e4f * d_; } }
    }
#undef IN
#undef SEAM
}


#if ATTN_MODE == 2
__global__ void __launch_bounds__(NWAVES * 64, 2) dbg_dense(Args args, int stage) {
    extern __shared__ __attribute__((aligned(16))) unsigned char lds_raw[];
    using namespace attn_body;
    unsigned char* ws = args.ws; bf16_t* PROJ = (bf16_t*)(ws + WS_PROJ); float* KSUM = (float*)(ws + WS_KSUM); gu32* ctl = (gu32*)(ws + WS_CTL);
    const int G = gridDim.x, bx = blockIdx.x, vcu = (bx % 8) * (G / 8) + bx / 8, tid = threadIdx.x, lane = tid & 63, wave = tid >> 6;
    if (stage == 0) {
        const int s = vcu & 7, bh = vcu >> 3;
        for (int i = 0; i < 4; ++i) { const int qb = (i == 0) ? s : (i == 1) ? 15 - s : (i == 2) ? 16 + s : 31 - s;
            attn_unit<8, false>(bh >> 3, bh & 7, qb, (const bf16*)(PROJ + C_Q), (const bf16*)(PROJ + C_K), (const bf16*)(PROJ + C_VV), (bf16*)(PROJ + C_Q), KSUM, (char*)lds_raw, true, nullptr, nullptr); }
    } else {
        float md = 0.f;
        for (int i = 0; i < 16; ++i) { const size_t row = (size_t)vcu * 128 + wave * 16 + i;
            const u32x4 a = *(const u32x4*)(PROJ + row * PC + C_V + 8 * lane), bq = *(const u32x4*)(PROJ + row * PC + C_Q + 8 * lane);
            md = fmaxf(md, fmaxf(fmaxf(fabsf(bflo(a.x) - bflo(bq.x)), fabsf(bfhi(a.x) - bfhi(bq.x))), fmaxf(fabsf(bflo(a.y) - bflo(bq.y)), fabsf(bfhi(a.y) - bfhi(bq.y)))));
            md = fmaxf(md, fmaxf(fmaxf(fabsf(bflo(a.z) - bflo(bq.z)), fabsf(bfhi(a.z) - bfhi(bq.z))), fmaxf(fabsf(bflo(a.w) - bflo(bq.w)), fabsf(bfhi(a.w) - bfhi(bq.w))))); }
#pragma unroll
        for (int o_ = 1; o_ < 64; o_ <<= 1) md = fmaxf(md, __shfl_xor(md, o_));
        if (lane == 0) atomicMax((unsigned*)(ctl + CW_DIFF), __float_as_uint(md));
    }
}
#endif
extern "C" void kernel_launch(void* const* d_in, const int* in_sizes, int n_in, void* d_out, int out_size, void* d_ws, size_t ws_size, hipStream_t stream) {
    static int grid = 0;
    if (grid == 0) {
        if (n_in != 22 || in_sizes[0] != T * DM || out_size != T * DM || ws_size < WS_END) { fprintf(stderr, "kernel_launch: unexpected shapes (n_in %d, in0 %d, out %d, ws %zu); nothing launched\n", n_in, n_in > 0 ? in_sizes[0] : -1, out_size, ws_size); grid = -1; return; }
        int dev = 0, cus = 0, per_cu = 0;
        if (hipGetDevice(&dev) != hipSuccess || hipDeviceGetAttribute(&cus, hipDeviceAttributeMultiprocessorCount, dev) != hipSuccess) { fprintf(stderr, "kernel_launch: device query failed\n"); grid = -1; return; }
        if (hipFuncSetAttribute((const void*)hybrid_fwd, hipFuncAttributeMaxDynamicSharedMemorySize, LDS_BYTES) != hipSuccess) { fprintf(stderr, "kernel_launch: hipFuncSetAttribute failed\n"); grid = -1; return; }
        if (hipOccupancyMaxActiveBlocksPerMultiprocessor(&per_cu, (const void*)hybrid_fwd, NWAVES * 64, LDS_BYTES) != hipSuccess || per_cu < 1) { fprintf(stderr, "kernel_launch: occupancy query reports %d blocks per CU\n", per_cu); }
        (void)hipGetLastError();
        if (cus != 256) { fprintf(stderr, "kernel_launch: built for 256 CUs, device has %d; nothing launched\n", cus); grid = -1; return; }
        grid = cus;
    }
    if (grid < 0) return;
    (void)hipMemsetAsync((char*)d_ws + WS_CTL, 0, CTL_ZERO_BYTES, stream);
    Args a{};
    for (int i = 0; i < 22; ++i) a.in[i] = (const float*)d_in[i];
    a.out = (float*)d_out; a.ws = (unsigned char*)d_ws;
    struct Spec { int lo, hi, flags; };
#if MK_PER_PHASE
    const Spec specs[10] = {{0,1,0},{1,2,0},{2,3,0},{3,4,0},{4,5,0},{5,6,0},{6,7,0},{7,8,0},{8,9,0},{9,10,0}}; const int nspec = 10;
#elif PROBE_ID == 1
    const Spec specs[2] = {{0,10,0},{0,2,0}}; const int nspec = 2;
#elif PROBE_ID == 2
    const Spec specs[2] = {{0,10,0},{2,3,0}}; const int nspec = 2;
#elif PROBE_ID == 3
    const Spec specs[3] = {{0,3,0},{3,4,3},{3,10,0}}; const int nspec = 3;
#elif PROBE_ID == 4
    const Spec specs[3] = {{0,4,0},{4,5,0},{4,10,0}}; const int nspec = 3;
#elif PROBE_ID == 5
    const Spec specs[3] = {{0,5,0},{5,6,0},{5,10,0}}; const int nspec = 3;
#elif PROBE_ID == 6
    const Spec specs[2] = {{0,10,0},{7,8,0}}; const int nspec = 2;
#elif PROBE_ID == 7
    const Spec specs[2] = {{0,10,0},{8,9,0}}; const int nspec = 2;
#elif PROBE_ID == 8
    const Spec specs[2] = {{0,5,0},{5,10,0}}; const int nspec = 2;
#elif PROBE_ID == 9
    const Spec specs[2] = {{0,10,0},{0,1,0}}; const int nspec = 2;
#else
    const Spec specs[1] = {{0,10,0}}; const int nspec = 1;
#endif
#if ATTN_MODE == 2
    (void)hipFuncSetAttribute((const void*)dbg_dense, hipFuncAttributeMaxDynamicSharedMemorySize, LDS_BYTES);
    a.ph_lo = 0; a.ph_hi = 4; a.flags = 0; a.li = 0; hipLaunchKernelGGL(hybrid_fwd, dim3(grid), dim3(NWAVES * 64), LDS_BYTES, stream, a);
    hipLaunchKernelGGL(dbg_dense, dim3(grid), dim3(NWAVES * 64), LDS_BYTES, stream, a, 0);
    hipLaunchKernelGGL(dbg_dense, dim3(grid), dim3(NWAVES * 64), LDS_BYTES, stream, a, 1);
    a.ph_lo = 4; a.ph_hi = 10; a.li = 1; hipLaunchKernelGGL(hybrid_fwd, dim3(grid), dim3(NWAVES * 64), LDS_BYTES, stream, a);
    (void)nspec; (void)specs;
#else
    for (int li = 0; li < nspec; ++li) { a.ph_lo = specs[li].lo; a.ph_hi = specs[li].hi; a.flags = specs[li].flags; a.li = MK_PER_PHASE ? 0 : li;
        hipLaunchKernelGGL(hybrid_fwd, dim3(grid), dim3(NWAVES * 64), LDS_BYTES, stream, a); }
#endif
    const hipError_t le = hipPeekAtLastError();
    if (le != hipSuccess) fprintf(stderr, "kernel_launch: launch failed: %s\n", hipGetErrorName(le));
}
```

```cpp
#include <hip/hip_runtime.h>
#include <hip/hip_bf16.h>
#include <cstdio>
#include <cstdint>
#include <cmath>

#ifndef PROBE_ID
#define PROBE_ID 0
#endif
#ifndef ATTN_MODE
#define ATTN_MODE 1
#endif
#ifndef MK_PER_PHASE
#define MK_PER_PHASE 0
#endif

#define LAS __attribute__((address_space(3)))
#define GAS __attribute__((address_space(1)))
typedef unsigned short bf16_t;
typedef short bf16x8 __attribute__((ext_vector_type(8)));
typedef short s16x4 __attribute__((ext_vector_type(4)));
typedef float f32x2 __attribute__((ext_vector_type(2)));
typedef float f32x4 __attribute__((ext_vector_type(4)));
typedef float f32x16 __attribute__((ext_vector_type(16)));
typedef unsigned u32x2 __attribute__((ext_vector_type(2)));
typedef unsigned u32x4 __attribute__((ext_vector_type(4)));
typedef GAS unsigned gu32;

constexpr int NB = 4, SEQ = 8192, DM = 1024, T = NB * SEQ;
constexpr int PC = 4608;
constexpr int C_U = 0, C_V = 512, C_Q = 1024, C_K = 1536, C_VV = 2048, C_GA = 2560, C_GB = 3584;
constexpr int NEXP = 32, DEXP = 512;
constexpr float EPS = 1e-6f;
constexpr float QSCALE = 0.125f * 1.4426950408889634f;

constexpr size_t MiB = 1u << 20;
constexpr size_t WS_CTL = 0, CTL_ZERO_BYTES = 2 * MiB;
constexpr size_t WS_KSUM = 1 * MiB;
constexpr size_t WS_MODP = 2 * MiB;
constexpr size_t WS_MOD = 3 * MiB + 512 * 1024;
constexpr size_t WS_ROPE = 4 * MiB;
constexpr size_t WS_WST = 4 * MiB + 512 * 1024;
constexpr size_t WS_WRT = 4 * MiB + 768 * 1024;
constexpr size_t WS_SSQ = 5 * MiB;
constexpr size_t WS_ROUTE = 8 * MiB;
constexpr size_t WS_WIN = 24 * MiB;
constexpr size_t WS_WA = 34 * MiB, WS_WB = 35 * MiB, WS_WOUT = 36 * MiB;
constexpr size_t WS_WGU = 40 * MiB;
constexpr size_t WS_WD = 104 * MiB;
constexpr size_t WS_XN = 136 * MiB;
constexpr size_t WS_PROJ = 200 * MiB;
constexpr size_t WS_HID = 200 * MiB;
constexpr size_t WS_Y = 272 * MiB;
constexpr size_t WS_X1 = 400 * MiB;
constexpr size_t WS_PO = 40 * MiB;
constexpr size_t WS_PML = 136 * MiB;
constexpr size_t WS_LIST = 488 * MiB;
constexpr size_t WS_END = 504 * MiB;
constexpr int CW_TMO = 0, CW_DIFF = 2, CW_BAR = 4096, CW_CURSOR = 32768, CW_CNT = 65536, CW_READY = 131072;

constexpr int RING_BYTES = 131072;
constexpr int LDS_BYTES = 147456;
constexpr int MISC_OFF = LDS_BYTES - 1024;
constexpr int NWAVES = 8;

#define LDS_WAIT() asm volatile("s_waitcnt lgkmcnt(0)" ::: "memory")
#define VM_WAIT() asm volatile("s_waitcnt vmcnt(0)" ::: "memory")
#define RLX_AGENT __ATOMIC_RELAXED, __HIP_MEMORY_SCOPE_AGENT

__device__ __forceinline__ unsigned cvt_pk_bf16(float lo, float hi) { unsigned r; asm volatile("v_cvt_pk_bf16_f32 %0, %1, %2" : "=v"(r) : "v"(lo), "v"(hi)); return r; }
__device__ __forceinline__ float bflo(unsigned u) { return __uint_as_float(u << 16); }
__device__ __forceinline__ float bfhi(unsigned u) { return __uint_as_float(u & 0xffff0000u); }
__device__ __forceinline__ float sigmoidf_(float x) { return __builtin_amdgcn_rcpf(1.0f + __builtin_amdgcn_exp2f(-1.4426950408889634f * x)); }
__device__ __forceinline__ float gelu_tanh(float x) { const float u = x + 0.044715f * x * x * x; return x * __builtin_amdgcn_rcpf(1.0f + __builtin_amdgcn_exp2f(-2.3022081985f * u)); }
__device__ __forceinline__ float wave_sum(float v) {
#pragma unroll
    for (int o = 1; o < 64; o <<= 1) v += __shfl_xor(v, o);
    return v;
}

namespace pg8 {
constexpr int BM = 256, BK = 64, HALF = 128, HTB = HALF * BK * 2, STAGE_BYTES = 8 * HTB, NXCD = 8, WGM = 8;
__host__ __device__ __forceinline__ int lds_byte(int r, int c) { const int st = (r >> 4) * 2 + (c >> 5), rr = r & 15, cc = c & 31, ob = rr * 64 + cc * 2; return st * 1024 + (ob ^ (((ob >> 9) & 1) << 5)); }
__host__ __device__ __forceinline__ void stage_rc(int b, int& R, int& C) { const int st = b / 1024, sb = b % 1024, swz = sb ^ (((sb >> 9) & 1) << 5); R = (st >> 1) * 16 + swz / 64; C = (st & 1) * 32 + (swz % 64) / 2; }
__host__ __device__ __forceinline__ int perm32(int rho) { const int n = rho >> 4, i = rho & 15; return 8 * (i >> 2) + 4 * n + (i & 3); }

struct Unit { int pm, pn, e, lt, nvalid; };

struct DenseSched {
    const char* A; const char* Bt; int lda, K; int nM, nN, nwg, G, c;
    __device__ void init(const void* A_, int lda_, const void* Bt_, int K_, int M, int N, int G_, int c_) { A = (const char*)A_; Bt = (const char*)Bt_; lda = lda_; K = K_; nM = M / BM; nN = N / BM; nwg = nM * nN; G = G_; c = c_; }
    __device__ __forceinline__ bool next(int i, Unit& u) const {
        const long L = (long)i * G + c; if (L >= nwg) return false;
        int wgid = (int)L; { const int q = nwg / NXCD, r = nwg % NXCD, xcd = wgid % NXCD, off = wgid / NXCD; wgid = (xcd < r ? xcd * (q + 1) : r * (q + 1) + (xcd - r) * q) + off; }
        const int nig = WGM * nN, gid = wgid / nig, fm = gid * WGM, gsz = (nM - fm) < WGM ? (nM - fm) : WGM;
        u.pm = fm + ((wgid % nig) % gsz); u.pn = (wgid % nig) / gsz; u.e = 0; u.lt = 0; u.nvalid = 256; return true;
    }
    __device__ __forceinline__ const char* a_base(const Unit& u) const { return A + (size_t)u.pm * BM * lda * 2; }
    __device__ __forceinline__ const char* b_base(const Unit& u) const { return Bt + (size_t)u.pn * BM * K * 2; }
    __device__ __forceinline__ unsigned gather_off(const Unit&, int, int) const { return 0u; }
    __device__ __forceinline__ void a_ready(const Unit&) const {}
    __device__ __forceinline__ void done(const Unit&) const {}
};
struct MoeSched {
    const char* A; const char* Bt; int lda, K; size_t bstride;
    const unsigned long long* route; bool gather;
    const volatile LAS int* tab;
    int start, end, j;
    unsigned* ready; int mode;
    __device__ __forceinline__ void done(const Unit& u) const {
        if (mode == 1) { asm volatile("s_waitcnt vmcnt(0)" ::: "memory");
            if ((threadIdx.x & 63) == 0) __hip_atomic_fetch_add(ready + 64 * u.pm, 1u, __ATOMIC_RELAXED, __HIP_MEMORY_SCOPE_AGENT); } }
    __device__ __forceinline__ void a_ready(const Unit& u) const {
        if (mode == 2) {
            if (threadIdx.x < 64) { unsigned sp = 0;
                while ((unsigned)__builtin_amdgcn_readfirstlane(__hip_atomic_load(ready + 64 * u.pm, __ATOMIC_RELAXED, __HIP_MEMORY_SCOPE_AGENT)) < 32u) { __builtin_amdgcn_s_sleep(2); if (++sp > (1u << 22)) break; }
                __builtin_amdgcn_fence(__ATOMIC_ACQUIRE, "agent");
                asm volatile("s_waitcnt vmcnt(0)" ::: "memory"); }
            asm volatile("" ::: "memory"); __builtin_amdgcn_s_barrier(); asm volatile("" ::: "memory"); } }
    __device__ __forceinline__ bool next(int i, Unit& u) const {
        const int idx = start + i * 32 + j; if (idx >= end) return false;
        const int tile = idx >> 2; u.pn = idx & 3; u.pm = tile;
        int e = 0;
        for (int k = 1; k < 32; ++k) e += (__builtin_amdgcn_readfirstlane(tab[32 + k]) <= tile) ? 1 : 0;
        u.e = e; u.lt = tile - __builtin_amdgcn_readfirstlane(tab[32 + e]);
        const int rem = __builtin_amdgcn_readfirstlane(tab[e]) - 256 * u.lt; u.nvalid = rem < 256 ? rem : 256; return true;
    }
    __device__ __forceinline__ const char* a_base(const Unit& u) const { return gather ? A : A + (size_t)u.pm * BM * lda * 2; }
    __device__ __forceinline__ const char* b_base(const Unit& u) const { return Bt + (size_t)u.e * bstride + (size_t)u.pn * BM * K * 2; }
    __device__ __forceinline__ unsigned gather_off(const Unit& u, int r, int C) const {
        unsigned tok = 0u;
        if (r < u.nvalid) tok = (unsigned)(route[(size_t)u.e * 32768 + (size_t)u.lt * 256 + r] & 0xffffffffull) >> 1;
        return (tok * (unsigned)lda + (unsigned)C) * 2u;
    }
};

template <class Epi, class Sched, bool GATHER>
__device__ __forceinline__ void gemm_phase(LAS unsigned char* lds, const Sched& S, const Epi& E) {
    const int tid = threadIdx.x, wid = __builtin_amdgcn_readfirstlane(tid >> 6), lane = tid & 63, wr = wid >> 2, wc = wid & 3, fr = lane & 15, fq = lane >> 4;
    const int K = S.K, lda = S.lda, nt = K / BK;
    unsigned voffA[2], voffB[2]; int RA[2], CA[2];
#pragma unroll
    for (int i = 0; i < 2; ++i) { int R, C; stage_rc(tid * 16 + i * 8192, R, C); const int Rb = Epi::PERM ? ((R & ~31) + perm32(R & 31)) : R;
        RA[i] = R; CA[i] = C; voffA[i] = (unsigned)(R * lda + C) * 2u; voffB[i] = (unsigned)(Rb * K + C) * 2u; }
    const size_t kstep = (size_t)(BK * 2);
    const unsigned hstepA = (unsigned)HALF * (unsigned)lda * 2u;
    const size_t hstepB = (size_t)HALF * K * 2;
    const unsigned ldsw = (unsigned)wid * 1024u;
    const int aoff = lds_byte(wr * 64 + fr, fq * 8), boff = lds_byte(wc * 32 + fr, fq * 8);
    unsigned og[2][2] = {{0u, 0u}, {0u, 0u}}, ogn[2][2] = {{0u, 0u}, {0u, 0u}};
#define PG8_SA(b, h) (((b) * 2 + (h)) * HTB)
#define PG8_SB(b, h) ((4 + (b) * 2 + (h)) * HTB)
#define PG8_STAGE_B(bufoff, gbase) do { _Pragma("unroll") for (int _i = 0; _i < 2; ++_i) \
        __builtin_amdgcn_global_load_lds((const unsigned*)((const char*)(gbase) + voffB[_i]), (LAS unsigned*)(lds + (bufoff) + ldsw + _i * 8192), 16, 0, 0); } while (0)
#define PG8_STAGE_A(bufoff, gbase, h) do { _Pragma("unroll") for (int _i = 0; _i < 2; ++_i) \
        __builtin_amdgcn_global_load_lds((const unsigned*)((const char*)(gbase) + (GATHER ? og[h][_i] : voffA[_i] + (h) * hstepA)), (LAS unsigned*)(lds + (bufoff) + ldsw + _i * 8192), 16, 0, 0); } while (0)
#define PG8_LDA(dst, b, h) do { _Pragma("unroll") for (int m = 0; m < 4; ++m) _Pragma("unroll") for (int k = 0; k < 2; ++k) dst[m][k] = *(const LAS bf16x8*)(lds + PG8_SA(b, h) + aoff + m * 2048 + k * 1024); } while (0)
#define PG8_LDB(dst, b, h) do { _Pragma("unroll") for (int n = 0; n < 2; ++n) _Pragma("unroll") for (int k = 0; k < 2; ++k) dst[n][k] = *(const LAS bf16x8*)(lds + PG8_SB(b, h) + boff + n * 2048 + k * 1024); } while (0)
#define PG8_MMA(ai, bj, At, Bt) do { __builtin_amdgcn_s_setprio(1); _Pragma("unroll") for (int m = 0; m < 4; ++m) _Pragma("unroll") for (int n = 0; n < 2; ++n) _Pragma("unroll") for (int k = 0; k < 2; ++k) \
        acc[ai][bj][m][n] = __builtin_amdgcn_mfma_f32_16x16x32_bf16(Bt[n][k], At[m][k], acc[ai][bj][m][n], 0, 0, 0); __builtin_amdgcn_s_setprio(0); } while (0)
#define PG8_WAIT_V(n) asm volatile("s_waitcnt vmcnt(" #n ")" ::: "memory")
#define PG8_WAIT_L(n) asm volatile("s_waitcnt lgkmcnt(" #n ")" ::: "memory")
#define PG8_BAR __builtin_amdgcn_s_barrier()
#define PG8_SCHED __builtin_amdgcn_sched_barrier(0)
    Unit cur, nxt; int ui = 0;
    if (!S.next(0, cur)) return;
    f32x4 acc[2][2][4][2];
#pragma unroll
    for (int a = 0; a < 2; ++a)
#pragma unroll
        for (int b = 0; b < 2; ++b)
#pragma unroll
            for (int m = 0; m < 4; ++m)
#pragma unroll
                for (int n = 0; n < 2; ++n) acc[a][b][m][n] = (f32x4){0.f, 0.f, 0.f, 0.f};
    bf16x8 At[4][2], B0[2][2], B1[2][2];
    const char* cA = S.a_base(cur); const char* cB = S.b_base(cur);
    S.a_ready(cur);
    if constexpr (GATHER) {
#pragma unroll
        for (int h = 0; h < 2; ++h)
#pragma unroll
            for (int i = 0; i < 2; ++i) og[h][i] = S.gather_off(cur, h * HALF + RA[i], CA[i]);
    }
    PG8_STAGE_B(PG8_SB(0, 0), cB); PG8_STAGE_B(PG8_SB(0, 1), cB + hstepB); PG8_STAGE_A(PG8_SA(0, 0), cA, 0); PG8_STAGE_A(PG8_SA(0, 1), cA, 1);
    if (wr == 1) PG8_BAR;
    PG8_WAIT_V(2); PG8_BAR;
    PG8_STAGE_B(PG8_SB(1, 0), cB + kstep); PG8_STAGE_A(PG8_SA(1, 0), cA + kstep, 0); PG8_STAGE_B(PG8_SB(1, 1), cB + hstepB + kstep);
    PG8_WAIT_V(6); PG8_BAR;
    for (;;) {
        const bool has_next = S.next(ui + 1, nxt);
        const char* nA = has_next ? S.a_base(nxt) : cA; const char* nB = has_next ? S.b_base(nxt) : cB;
        if constexpr (GATHER) {
            if (has_next) {
#pragma unroll
                for (int h = 0; h < 2; ++h)
#pragma unroll
                    for (int i = 0; i < 2; ++i) ogn[h][i] = S.gather_off(nxt, h * HALF + RA[i], CA[i]);
            }
        }
        for (int t = 0; t < nt; t += 2) {
            const bool last = (t == nt - 2);
            const char* a1 = cA + (size_t)(t + 1) * kstep;
            const char* a2 = last ? nA : cA + (size_t)(t + 2) * kstep; const char* b2 = last ? nB : cB + (size_t)(t + 2) * kstep;
            const char* a3 = a2 + kstep; const char* b3 = b2 + kstep;
            if (last && has_next) S.a_ready(nxt);
            PG8_LDB(B0, 0, 0); PG8_LDB(B1, 0, 1); PG8_SCHED; PG8_LDA(At, 0, 0); PG8_STAGE_A(PG8_SA(1, 1), a1, 1);
            if constexpr (GATHER) { if (last && has_next) {
#pragma unroll
                for (int h = 0; h < 2; ++h)
#pragma unroll
                    for (int i = 0; i < 2; ++i) og[h][i] = ogn[h][i]; } }
            PG8_WAIT_V(8); PG8_WAIT_L(0); PG8_BAR; PG8_MMA(0, 0, At, B0); PG8_MMA(0, 1, At, B1); PG8_BAR; PG8_SCHED;
            PG8_LDA(At, 0, 1); PG8_STAGE_B(PG8_SB(0, 0), b2); PG8_STAGE_B(PG8_SB(0, 1), b2 + hstepB); PG8_STAGE_A(PG8_SA(0, 0), a2, 0);
            PG8_WAIT_V(8); PG8_WAIT_L(0); PG8_BAR; PG8_MMA(1, 0, At, B0); PG8_MMA(1, 1, At, B1); PG8_BAR; PG8_SCHED;
            PG8_LDB(B0, 1, 0); PG8_LDB(B1, 1, 1); PG8_SCHED; PG8_LDA(At, 1, 0); PG8_STAGE_A(PG8_SA(0, 1), a2, 1);
            PG8_WAIT_V(8); PG8_WAIT_L(0); PG8_BAR; PG8_MMA(0, 0, At, B0); PG8_MMA(0, 1, At, B1); PG8_BAR; PG8_SCHED;
            PG8_LDA(At, 1, 1); PG8_STAGE_B(PG8_SB(1, 0), b3); PG8_STAGE_B(PG8_SB(1, 1), b3 + hstepB); PG8_STAGE_A(PG8_SA(1, 0), a3, 0);
            PG8_WAIT_V(8); PG8_WAIT_L(0); PG8_BAR; PG8_MMA(1, 0, At, B0); PG8_MMA(1, 1, At, B1); PG8_BAR; PG8_SCHED;
        }
        if (wr == 0) PG8_BAR;
        E(acc, cur, wr, wc, fr, fq); S.done(cur);
        if (!has_next) break;
#pragma unroll
        for (int a = 0; a < 2; ++a)
#pragma unroll
            for (int b = 0; b < 2; ++b)
#pragma unroll
                for (int m = 0; m < 4; ++m)
#pragma unroll
                    for (int n = 0; n < 2; ++n) acc[a][b][m][n] = (f32x4){0.f, 0.f, 0.f, 0.f};
        cur = nxt; cA = nA; cB = nB; ++ui;
        if (wr == 1) PG8_BAR;
    }
    PG8_WAIT_V(0);
    PG8_BAR;
#undef PG8_SA
#undef PG8_SB
#undef PG8_STAGE_A
#undef PG8_STAGE_B
#undef PG8_LDA
#undef PG8_LDB
#undef PG8_MMA
#undef PG8_WAIT_V
#undef PG8_WAIT_L
#undef PG8_BAR
#undef PG8_SCHED
}

struct EpiProj {
    static constexpr bool PERM = true;
    bf16_t* P; const float* rope; float* ksum;
    __device__ __forceinline__ void operator()(const f32x4 (&acc)[2][2][4][2], const Unit& u, int wr, int wc, int fr_in, int fq) const {
        int fr = fr_in; asm volatile("" : "+v"(fr));
        const int pn = u.pn, row0 = u.pm * BM + wr * 64 + fr, cl = wc * 32 + 8 * fq;
        const int mode = pn < 4 ? 0 : pn < 6 ? 1 : pn < 8 ? 2 : pn < 10 ? 3 : 4;
        const bool rot = (mode == 1 || mode == 2) && ((wc & 1) == 0);
        float ks[2][8];
#pragma unroll
        for (int bj = 0; bj < 2; ++bj)
#pragma unroll
            for (int j = 0; j < 8; ++j) ks[bj][j] = 0.f;
#pragma unroll
        for (int ai = 0; ai < 2; ++ai)
#pragma unroll
            for (int m = 0; m < 4; ++m) {
                const int row = row0 + ai * HALF + m * 16;
                float cs[8], sn[8];
                if (rot) { const int pos = row & (SEQ - 1); const f32x4 c0 = *(const f32x4*)(rope + pos * 8), c1 = *(const f32x4*)(rope + pos * 8 + 4), s0 = *(const f32x4*)(rope + 65536 + pos * 8), s1 = *(const f32x4*)(rope + 65536 + pos * 8 + 4);
#pragma unroll
                    for (int j = 0; j < 4; ++j) { cs[j] = c0[j]; cs[4 + j] = c1[j]; sn[j] = s0[j]; sn[4 + j] = s1[j]; } }
#pragma unroll
                for (int bj = 0; bj < 2; ++bj) {
                    float v[8];
#pragma unroll
                    for (int j = 0; j < 4; ++j) { v[j] = acc[ai][bj][m][0][j]; v[4 + j] = acc[ai][bj][m][1][j]; }
                    if (mode == 1 || mode == 2) {
                        if (rot) {
                            const float sg = (fq == 0) ? -1.f : 1.f; const bool ap = fq < 2;
#pragma unroll
                            for (int j = 0; j < 8; ++j) { const float o = __shfl_xor(v[j], 16); const float r = v[j] * cs[j] + sg * o * sn[j]; v[j] = ap ? r : v[j]; }
                        }
                        if (mode == 1) {
#pragma unroll
                            for (int j = 0; j < 8; ++j) v[j] *= QSCALE;
                        } else {
#pragma unroll
                            for (int j = 0; j < 8; ++j) ks[bj][j] += v[j];
                        }
                    }
                    u32x4 w; w.x = cvt_pk_bf16(v[0], v[1]); w.y = cvt_pk_bf16(v[2], v[3]); w.z = cvt_pk_bf16(v[4], v[5]); w.w = cvt_pk_bf16(v[6], v[7]);
                    *(u32x4*)(P + (size_t)row * PC + pn * BM + bj * HALF + cl) = w;
                }
            }
        if (mode == 2) {
#pragma unroll
            for (int bj = 0; bj < 2; ++bj)
#pragma unroll
                for (int j = 0; j < 8; ++j) { float s = ks[bj][j]; s += __shfl_xor(s, 1); s += __shfl_xor(s, 2); s += __shfl_xor(s, 4); s += __shfl_xor(s, 8); ks[bj][j] = s; }
            if (fr == 0) {
                const int b = u.pm >> 5, kb = u.pm & 31;
#pragma unroll
                for (int bj = 0; bj < 2; ++bj) { const int ck = (pn - 6) * BM + bj * HALF + cl; const int h = ck >> 6, d = ck & 63;
                    float* dst = ksum + ((size_t)((b * 8 + h) * 32 + kb)) * 64 + d;
#pragma unroll
                    for (int j = 0; j < 8; ++j) atomicAdd(dst + j, ks[bj][j]); }
            }
        }
    }
};
template <bool FIRST> struct EpiMerge {
    static constexpr bool PERM = true;
    const bf16_t* P; bf16_t* MG;
    __device__ __forceinline__ void operator()(const f32x4 (&acc)[2][2][4][2], const Unit& u, int wr, int wc, int fr_in, int fq) const {
        int fr = fr_in; asm volatile("" : "+v"(fr));
        const int row0 = u.pm * BM + wr * 64 + fr, col0 = u.pn * BM + wc * 32 + 8 * fq;
        u32x4 gq[3][2], pq[3][2];
#define EM_LOAD(gi, slot) do { const int row_ = row0 + ((gi) >> 2) * HALF + ((gi) & 3) * 16; \
            _Pragma("unroll") for (int bj = 0; bj < 2; ++bj) { gq[slot][bj] = *(const u32x4*)(P + (size_t)row_ * PC + (FIRST ? C_GA : C_GB) + col0 + bj * HALF); \
                if (!FIRST) pq[slot][bj] = *(const u32x4*)(MG + (size_t)row_ * DM + col0 + bj * HALF); } } while (0)
        EM_LOAD(0, 0); EM_LOAD(1, 1);
#pragma unroll
        for (int gi = 0; gi < 8; ++gi) {
            if (gi + 2 < 8) EM_LOAD(gi + 2, (gi + 2) % 3);
            asm volatile("" ::: "memory");
            const int ai = gi >> 2, m = gi & 3, row = row0 + ai * HALF + m * 16;
#pragma unroll
            for (int bj = 0; bj < 2; ++bj) { const u32x4 g = gq[gi % 3][bj];
                bf16_t* dst = MG + (size_t)row * DM + col0 + bj * HALF;
                float v[8];
#pragma unroll
                for (int j = 0; j < 4; ++j) { v[j] = acc[ai][bj][m][0][j]; v[4 + j] = acc[ai][bj][m][1][j]; }
                v[0] *= sigmoidf_(bflo(g.x)); v[1] *= sigmoidf_(bfhi(g.x)); v[2] *= sigmoidf_(bflo(g.y)); v[3] *= sigmoidf_(bfhi(g.y)); v[4] *= sigmoidf_(bflo(g.z)); v[5] *= sigmoidf_(bfhi(g.z)); v[6] *= sigmoidf_(bflo(g.w)); v[7] *= sigmoidf_(bfhi(g.w));
                if (!FIRST) { const u32x4 p = pq[gi % 3][bj];
                    v[0] += bflo(p.x); v[1] += bfhi(p.x); v[2] += bflo(p.y); v[3] += bfhi(p.y); v[4] += bflo(p.z); v[5] += bfhi(p.z); v[6] += bflo(p.w); v[7] += bfhi(p.w); }
                u32x4 w; w.x = cvt_pk_bf16(v[0], v[1]); w.y = cvt_pk_bf16(v[2], v[3]); w.z = cvt_pk_bf16(v[4], v[5]); w.w = cvt_pk_bf16(v[6], v[7]);
                *(u32x4*)dst = w; }
        }
#undef EM_LOAD
    }
};
struct EpiOut {
    static constexpr bool PERM = false;
    const float* x; bf16_t* x1; const float* mod; float* ssq;
    __device__ __forceinline__ void operator()(const f32x4 (&acc)[2][2][4][2], const Unit& u, int wr, int wc, int fr_in, int fq) const {
        int fr = fr_in; asm volatile("" : "+v"(fr));
        const int row0 = u.pm * BM + wr * 64 + fr, col0 = u.pn * BM + wc * 32 + 4 * fq, b = u.pm >> 5;
        f32x4 xq[3][2][2];
#define EO_LOAD(gi, slot) do { const size_t off_ = (size_t)(row0 + ((gi) >> 2) * HALF + ((gi) & 3) * 16) * DM + col0; \
            _Pragma("unroll") for (int bj = 0; bj < 2; ++bj) _Pragma("unroll") for (int n = 0; n < 2; ++n) xq[slot][bj][n] = *(const f32x4*)(x + off_ + bj * HALF + n * 16); } while (0)
        EO_LOAD(0, 0); EO_LOAD(1, 1);
        f32x4 g1[2][2];
#pragma unroll
        for (int bj = 0; bj < 2; ++bj)
#pragma unroll
            for (int n = 0; n < 2; ++n) g1[bj][n] = *(const f32x4*)(mod + b * 6144 + 2048 + col0 + bj * HALF + n * 16);
#pragma unroll
        for (int gi = 0; gi < 8; ++gi) {
            if (gi + 2 < 8) EO_LOAD(gi + 2, (gi + 2) % 3);
            asm volatile("" ::: "memory");
            const int ai = gi >> 2, m = gi & 3, row = row0 + ai * HALF + m * 16; const size_t off = (size_t)row * DM + col0; float s = 0.f;
#pragma unroll
            for (int bj = 0; bj < 2; ++bj)
#pragma unroll
                for (int n = 0; n < 2; ++n) { const f32x4 o = xq[gi % 3][bj][n] + g1[bj][n] * acc[ai][bj][m][n];
                    u32x2 w; w.x = cvt_pk_bf16(o[0], o[1]); w.y = cvt_pk_bf16(o[2], o[3]);
                    const float r0 = bflo(w.x), r1 = bfhi(w.x), r2 = bflo(w.y), r3 = bfhi(w.y);
                    s += (r0 * r0 + r1 * r1) + (r2 * r2 + r3 * r3); *(u32x2*)(x1 + off + bj * HALF + n * 16) = w; }
            s += __shfl_xor(s, 16); s += __shfl_xor(s, 32);
            if (fq == 0) ssq[(size_t)row * 16 + u.pn * 4 + wc] = s;
        }
#undef EO_LOAD
    }
};
struct EpiGU {
    static constexpr bool PERM = true;
    bf16_t* H;
    __device__ __forceinline__ void operator()(const f32x4 (&acc)[2][2][4][2], const Unit& u, int wr, int wc, int fr_in, int fq) const {
        int fr = fr_in; asm volatile("" : "+v"(fr));
        const int r0 = wr * 64 + fr, cl = wc * 32 + 8 * fq;
#pragma unroll
        for (int ai = 0; ai < 2; ++ai)
#pragma unroll
            for (int m = 0; m < 4; ++m) { const int r = r0 + ai * HALF + m * 16;
                float v[8];
#pragma unroll
                for (int j = 0; j < 4; ++j) { const float g0 = acc[ai][0][m][0][j], g1 = acc[ai][0][m][1][j]; v[j] = g0 * sigmoidf_(g0) * acc[ai][1][m][0][j]; v[4 + j] = g1 * sigmoidf_(g1) * acc[ai][1][m][1][j]; }
                u32x4 w; w.x = cvt_pk_bf16(v[0], v[1]); w.y = cvt_pk_bf16(v[2], v[3]); w.z = cvt_pk_bf16(v[4], v[5]); w.w = cvt_pk_bf16(v[6], v[7]);
                bf16_t* dst = H + ((size_t)u.pm * BM + r) * DEXP + u.pn * HALF + cl;
                asm volatile("global_store_dwordx4 %0, %1, off sc1\n\ts_nop 1" :: "v"(dst), "v"(w) : "memory"); }
    }
};
struct EpiDown {
    static constexpr bool PERM = true;
    bf16_t* Y; const unsigned long long* route;
    __device__ __forceinline__ void operator()(const f32x4 (&acc)[2][2][4][2], const Unit& u, int wr, int wc, int fr_in, int fq) const {
        int fr = fr_in; asm volatile("" : "+v"(fr));
        const int r0 = wr * 64 + fr, col0 = u.pn * BM + wc * 32 + 8 * fq;
        const unsigned long long* rt = route + (size_t)u.e * 32768 + (size_t)u.lt * 256;
        unsigned long long ent[8];
#pragma unroll
        for (int gi = 0; gi < 8; ++gi) { const int r = r0 + (gi >> 2) * HALF + (gi & 3) * 16; ent[gi] = (r < u.nvalid) ? rt[r] : 0ull; }
#pragma unroll
        for (int gi = 0; gi < 8; ++gi) { const int ai = gi >> 2, m = gi & 3, r = r0 + ai * HALF + m * 16;
            if (r < u.nvalid) { const unsigned slot = (unsigned)(ent[gi] & 0xffffffffull); const float wt = __uint_as_float((unsigned)(ent[gi] >> 32));
#pragma unroll
                for (int bj = 0; bj < 2; ++bj) { const f32x4 a0 = acc[ai][bj][m][0] * wt, a1 = acc[ai][bj][m][1] * wt;
                    u32x4 w; w.x = cvt_pk_bf16(a0[0], a0[1]); w.y = cvt_pk_bf16(a0[2], a0[3]); w.z = cvt_pk_bf16(a1[0], a1[1]); w.w = cvt_pk_bf16(a1[2], a1[3]);
                    *(u32x4*)(Y + (size_t)slot * DM + col0 + bj * HALF) = w; } } }
    }
};
}

namespace attn_body {
using bf16 = __hip_bfloat16;
constexpr int NHEAD = 8, D = 64, PITCH = PC;
constexpr int NW = 8, QBLK = 32, QB = QBLK * NW, KVBLK = 64;
__device__ __forceinline__ int crow(int r, int hi) { return (r & 3) + 8 * (r >> 2) + 4 * hi; }
#define SBAR() __builtin_amdgcn_sched_barrier(0)
__device__ __forceinline__ void cmask(f32x16& p0, f32x16& p1, int jb, int qrel, int hi) {
    const float NEG = -INFINITY; int kb = 64 * jb + 4 * hi;
#pragma unroll
    for (int r = 0; r < 16; ++r) { int kv = kb + (r & 3) + 8 * (r >> 2); if (kv > qrel) p0[r] = NEG; if (kv + 32 > qrel) p1[r] = NEG; }
}
__device__ __forceinline__ void selapply(f32x16& p0, f32x16& p1, bool ok) {
    const float NEG = -INFINITY;
#pragma unroll
    for (int r = 0; r < 16; ++r) { p0[r] = ok ? p0[r] : NEG; p1[r] = ok ? p1[r] : NEG; }
}
constexpr int NSLOT = 3, SLOTB = 8192;
constexpr int LDS_K = 0, LDS_V = NSLOT * SLOTB, LDS_WS = 2 * NSLOT * SLOTB, LDS_OST = LDS_WS + NW * 64 * 4, LDS_BYTES_A = LDS_OST + NW * 4096;
__device__ __forceinline__ void glds16(const void* gsrc, unsigned lds_dst) { unsigned keep;
    asm volatile("s_mov_b32 %0, m0\n\ts_mov_b32 m0, %2\n\ts_nop 0\n\tglobal_load_lds_dwordx4 %1, off\n\ts_mov_b32 m0, %0" : "=&s"(keep) : "v"(gsrc), "s"(lds_dst) : "memory"); }
__device__ __forceinline__ float max3f(float a, float b, float c) { float r; asm("v_max3_f32 %0, %1, %2, %3" : "=v"(r) : "v"(a), "v"(b), "v"(c)); return r; }
__device__ __forceinline__ float max2f(float a, float b) { float r; asm("v_max_f32_e32 %0, %1, %2" : "=v"(r) : "v"(a), "v"(b)); return r; }
__device__ __forceinline__ float fadd_s(float a, float b) { float r; asm("v_add_f32_e32 %0, %1, %2" : "=v"(r) : "v"(a), "v"(b)); return r; }
__device__ __forceinline__ float fsub_s(float a, float b) { float r; asm("v_sub_f32_e32 %0, %1, %2" : "=v"(r) : "v"(a), "v"(b)); return r; }
typedef __bf16 bf16x2_t __attribute__((ext_vector_type(2)));
__device__ __forceinline__ unsigned cvtpk_s(float lo, float hi) { f32x2 v = {lo, hi}; bf16x2_t b = __builtin_convertvector(v, bf16x2_t); return __builtin_bit_cast(unsigned, b); }
#define WAIT_BAR(N) asm volatile("s_waitcnt vmcnt(" #N ") lgkmcnt(0)\n\ts_barrier" ::: "memory")

__device__ __forceinline__ void qkt(f32x16& p0, f32x16& p1, const char* Kslot, const bf16x8* qr, const f32x16& negm, int r32, int hi) {
    const char* kb = Kslot + hi * 1024 + r32 * 16;
#pragma unroll
    for (int d0 = 0; d0 < 4; ++d0) {
        const bf16x8 b0 = *reinterpret_cast<const bf16x8*>(kb + d0 * 2048);
        const bf16x8 b1 = *reinterpret_cast<const bf16x8*>(kb + d0 * 2048 + 512);
        if (d0 == 0) { p0 = __builtin_amdgcn_mfma_f32_32x32x16_bf16(b0, qr[0], negm, 0, 0, 0); p1 = __builtin_amdgcn_mfma_f32_32x32x16_bf16(b1, qr[0], negm, 0, 0, 0); }
        else { p0 = __builtin_amdgcn_mfma_f32_32x32x16_bf16(b0, qr[d0], p0, 0, 0, 0); p1 = __builtin_amdgcn_mfma_f32_32x32x16_bf16(b1, qr[d0], p1, 0, 0, 0); } }
}
typedef LAS const char* lds_cptr;
typedef short v4i16_t __attribute__((ext_vector_type(4)));
__device__ __forceinline__ void kload8(bf16x8* kf, lds_cptr kp) {
    kf[0] = *(const LAS bf16x8*)(kp);        kf[1] = *(const LAS bf16x8*)(kp + 512);
    kf[2] = *(const LAS bf16x8*)(kp + 2048); kf[3] = *(const LAS bf16x8*)(kp + 2560);
    kf[4] = *(const LAS bf16x8*)(kp + 4096); kf[5] = *(const LAS bf16x8*)(kp + 4608);
    kf[6] = *(const LAS bf16x8*)(kp + 6144); kf[7] = *(const LAS bf16x8*)(kp + 6656);
}
__device__ __forceinline__ void kload2(bf16x8* kf, lds_cptr kp, int j) { kf[2 * j] = *(const LAS bf16x8*)(kp + j * 2048); kf[2 * j + 1] = *(const LAS bf16x8*)(kp + j * 2048 + 512); }
__device__ __forceinline__ s16x4 vtr(lds_cptr p) { return __builtin_bit_cast(s16x4, __builtin_amdgcn_ds_read_tr16_b64_v4i16((LAS v4i16_t*)p)); }
__device__ __forceinline__ float rowmax(const f32x16& p0, const f32x16& p1) {
    float a = max3f(p0[0], p0[1], p1[0]), b = max3f(p0[2], p0[3], p1[1]); a = max3f(a, p1[2], p1[3]);
#pragma unroll
    for (int r = 4; r < 16; r += 4) { a = max3f(a, p0[r], p0[r + 1]); b = max3f(b, p0[r + 2], p0[r + 3]); a = max3f(a, p1[r], p1[r + 1]); b = max3f(b, p1[r + 2], p1[r + 3]); }
    const float m = max2f(a, b);
    auto rr = __builtin_amdgcn_permlane32_swap(__float_as_uint(m), __float_as_uint(m), false, false);
    return max2f(__uint_as_float(rr[0]), __uint_as_float(rr[1]));
}
__device__ __forceinline__ void pv(f32x16* o, int vb, bf16x8 pa0, bf16x8 pa1, bf16x8 pa2, bf16x8 pa3) {
#pragma unroll
    for (int d0 = 0; d0 < 2; ++d0) { s16x4 lo[4], hi[4];
#pragma unroll
        for (int ks = 0; ks < 4; ++ks) {
            asm volatile("ds_read_b64_tr_b16 %0,%1 offset:%c2" : "=&v"(lo[ks]) : "v"(vb), "i"(d0 * 4096 + ks * 1024) : "memory");
            asm volatile("ds_read_b64_tr_b16 %0,%1 offset:%c2" : "=&v"(hi[ks]) : "v"(vb), "i"(d0 * 4096 + ks * 1024 + 512) : "memory"); }
        asm volatile("s_waitcnt lgkmcnt(0)" ::: "memory"); SBAR();
#define PK(k) (bf16x8){lo[k][0], lo[k][1], lo[k][2], lo[k][3], hi[k][0], hi[k][1], hi[k][2], hi[k][3]}
        o[d0] = __builtin_amdgcn_mfma_f32_32x32x16_bf16(pa0, PK(0), o[d0], 0, 0, 0);
        o[d0] = __builtin_amdgcn_mfma_f32_32x32x16_bf16(pa1, PK(1), o[d0], 0, 0, 0);
        o[d0] = __builtin_amdgcn_mfma_f32_32x32x16_bf16(pa2, PK(2), o[d0], 0, 0, 0);
        o[d0] = __builtin_amdgcn_mfma_f32_32x32x16_bf16(pa3, PK(3), o[d0], 0, 0, 0);
#undef PK
    }
}

__device__ __forceinline__ void gate_top3(const float* ksum_bh, const bf16x8* qr, int qb, int r32, int hi, int (&kbs)[3]) {
    const float* km = ksum_bh + (size_t)r32 * 64 + hi * 8;
    f32x16 g = f32x16{};
#pragma unroll
    for (int d0 = 0; d0 < 4; ++d0) { const f32x4 a = *(const f32x4*)(km + d0 * 16), c = *(const f32x4*)(km + d0 * 16 + 4);
        u32x4 w; w.x = cvtpk_s(a[0], a[1]); w.y = cvtpk_s(a[2], a[3]); w.z = cvtpk_s(c[0], c[1]); w.w = cvtpk_s(c[2], c[3]);
        g = __builtin_amdgcn_mfma_f32_32x32x16_bf16(__builtin_bit_cast(bf16x8, w), qr[d0], g, 0, 0, 0); }
#pragma unroll
    for (int r = 0; r < 16; ++r) if (crow(r, hi) >= qb) g[r] = -INFINITY;
#pragma unroll
    for (int round = 0; round < 3; ++round) {
        float m = g[0];
#pragma unroll
        for (int r = 1; r < 16; ++r) m = fmaxf(m, g[r]);
        int idx = 64;
#pragma unroll
        for (int r = 15; r >= 0; --r) if (g[r] == m) idx = crow(r, hi);
        const float pm = __shfl_xor(m, 32); const int pidx = __shfl_xor(idx, 32);
        const bool mine = (m > pm) || (m == pm && idx < pidx);
        kbs[round] = (mine ? idx : pidx) & 31;
#pragma unroll
        for (int r = 0; r < 16; ++r) if (mine && crow(r, hi) == idx) g[r] = -INFINITY;
    }
}

template <int THRL, bool OWN> __device__ __forceinline__ void attn_unit(int b, int h, int qb, const bf16* Q, const bf16* __restrict__ K, const bf16* __restrict__ V, bf16* O, const float* ksum, char* shm, bool do_store, const bf16_t* PO, const float* PML) {
    const int tid = threadIdx.x, lane = tid & 63, r32 = lane & 31, hi = lane >> 5; const int wid = __builtin_amdgcn_readfirstlane(tid >> 6);
    const long rowbase = (long)b * SEQ; const int q0 = qb * QB;
    const bf16* Qw = Q + (rowbase + q0 + wid * QBLK) * PITCH + h * D;
    const bf16* Kh = K + rowbase * PITCH + h * D, *Vh = V + rowbase * PITCH + h * D;
    const unsigned lds0 = (unsigned)(uintptr_t)shm;
    float* wsf = (float*)(shm + LDS_WS) + wid * 64;
    const bf16* ksrc = Kh + (long)lane * PITCH + wid * 8;
    const bf16* vsrc = Vh + (long)(16 * (wid & 3) + (lane >> 2)) * PITCH + (wid >> 2) * 32 + (lane & 3) * 8;
    const unsigned kdst = lds0 + LDS_K + wid * 1024, vdst = lds0 + LDS_V + wid * 1024;
    const int NT = OWN ? 4 : (q0 + QB) / KVBLK;
    const int TBASE = OWN ? 4 * qb : 0;
#define TM(t) (OWN ? (t) : (((t) == 0) ? (NT - 4) : (((t) <= NT - 4) ? ((t) - 1) : (t))))
#define DMA_K(t, slot) glds16(ksrc + (long)(TBASE + TM(t)) * KVBLK * PITCH, (unsigned)__builtin_amdgcn_readfirstlane(kdst + (slot)))
#define DMA_V(t, slot) glds16(vsrc + (long)(TBASE + TM(t)) * KVBLK * PITCH, (unsigned)__builtin_amdgcn_readfirstlane(vdst + (slot)))
    const int vb0 = (int)(lds0 + LDS_V) + ((lane >> 4) & 1) * 32 + (lane & 3) * 8 + (4 * hi + ((lane & 15) >> 2)) * 64;
    const char* Kbase = shm + LDS_K; bf16x8 kf[8];
    const lds_cptr shm3 = (lds_cptr)shm; const lds_cptr kp0 = shm3 + LDS_K + hi * 1024 + r32 * 16; const lds_cptr vp0 = shm3 + LDS_V + ((lane >> 4) & 1) * 32 + (lane & 3) * 8 + (4 * hi + ((lane & 15) >> 2)) * 64;
    DMA_K(0, 0); DMA_V(0, 0); DMA_K(1, SLOTB);
    bf16x8 qr[4];
#pragma unroll
    for (int d0 = 0; d0 < 4; ++d0) qr[d0] = *reinterpret_cast<const bf16x8*>(&Qw[(long)r32 * PITCH + d0 * 16 + hi * 8]);
    unsigned selmask = 0u;
    if constexpr (!OWN) {
    if (qb > 0) {
        if (qb <= 3) selmask = (1u << qb) - 1u;
        else { int kbs[3]; gate_top3(ksum + ((size_t)(b * NHEAD + h) * 32) * 64, qr, qb, r32, hi, kbs); selmask = (1u << kbs[0]) | (1u << kbs[1]) | (1u << kbs[2]); }
    } }
    float zf_; asm volatile("v_mov_b32 %0, 0" : "=v"(zf_));
    float mhat = 0.f, l_reg = 0.f; f32x16 o[2]; f32x16 negm;
#pragma unroll
    for (int r = 0; r < 16; ++r) { o[0][r] = zf_; o[1][r] = zf_; negm[r] = zf_; }
    asm volatile("" : "+v"(negm));
    const int qrel = wid * QBLK + r32;
#define MASKT(P0, P1, t) do { const int a_ = TM(t); const int jb_ = a_ - (NT - 4); if (jb_ >= 0) cmask(P0, P1, jb_, qrel, hi); else selapply(P0, P1, ((selmask >> (a_ >> 2)) & 1u) != 0u); } while (0)
    bool resc = false;
#define START(P0, P1) do { const float rm = rowmax(P0, P1); resc = false; \
    { const float dl = rm; mhat = fadd_s(mhat, dl); \
      _Pragma("unroll") for (int r = 0; r < 16; ++r) { P0[r] = fsub_s(P0[r], dl); P1[r] = fsub_s(P1[r], dl); } \
      _Pragma("unroll") for (int r = 0; r < 16; ++r) negm[r] = -mhat; asm volatile("" : "+v"(negm)); } \
    _Pragma("unroll") for (int r = 0; r < 16; ++r) P0[r] = __builtin_amdgcn_exp2f(P0[r]); } while (0)
#define RESC() do { if (resc) { asm volatile("s_waitcnt lgkmcnt(0)" ::: "memory"); \
      _Pragma("unroll") for (int d_ = 0; d_ < 2; ++d_) _Pragma("unroll") for (int r = 0; r < 16; ++r) o[d_][r] *= wsf[crow(r, hi)]; } } while (0)
    f32x16 pA0, pA1, pB0, pB1;
    int sl_prev = 0, sl_cur = 0, sl_next = SLOTB;
#define ROT() do { sl_prev = sl_cur; sl_cur = sl_next; sl_next = (sl_next == (NSLOT - 1) * SLOTB) ? 0 : sl_next + SLOTB; } while (0)
    DMA_K(2, 2 * SLOTB);
    WAIT_BAR(3);
    qkt(pA0, pA1, Kbase, qr, negm, r32, hi); asm volatile("s_nop 15\n\ts_nop 7" : "+v"(pA0), "+v"(pA1)); MASKT(pA0, pA1, 0);
    START(pA0, pA1);
    _Pragma("unroll") for (int r = 0; r < 16; ++r) pA1[r] = __builtin_amdgcn_exp2f(pA1[r]);
    WAIT_BAR(0);
    DMA_K(3, 0); DMA_V(1, SLOTB);
    ROT();
    kload8(kf, kp0 + sl_cur);
    WAIT_BAR(2);
    s16x4 vlo[8], vhi[8]; u32x4 pw0, pw1, pw2, pw3;
#define PKW(P, B) cvtpk_s(P[B], P[B + 1])
#define PAF(k) __builtin_bit_cast(bf16x8, pw##k)
#define VFR(i) (bf16x8){vlo[i][0], vlo[i][1], vlo[i][2], vlo[i][3], vhi[i][0], vhi[i][1], vhi[i][2], vhi[i][3]}
#define PIN(x) asm volatile("" : "+v"(x))
#define MX3(a, b, c) __builtin_fmaxf(__builtin_fmaxf((a), (b)), (c))
#define GAPA(MF, A0, A1, A2, A3, W0, W1, PW) do { MF; sacc += A0; sacc += A1; sacc += A2; sacc += A3; PIN(sacc); W0; W1; PIN(PW); SBAR(); } while (0)
#define EX(v) __builtin_amdgcn_exp2f(v)
#define GAPB(MF, X, B) do { MF; X[B] = EX(X[B]); X[B + 1] = EX(X[B + 1]); X[B + 2] = EX(X[B + 2]); X[B + 3] = EX(X[B + 3]); PIN(X); SBAR(); } while (0)
#define VRD(i) do { vlo[i] = vtr(vp_ + (((i) >> 2) * 4096 + ((i) & 3) * 1024)); vhi[i] = vtr(vp_ + (((i) >> 2) * 4096 + ((i) & 3) * 1024 + 512)); } while (0)
#define KRD(G, j) do { if (G) { kload2(kf, kp0 + sl_next, j); SBAR(); } } while (0)
#define STEP(C0, C1, P0, P1, t, GK, GV, GL) do { SBAR(); \
    const lds_cptr vp_ = vp0 + sl_prev; \
    VRD(0); SBAR(); float sacc = (P0[0] + P0[1]); \
    GAPA(C0 = __builtin_amdgcn_mfma_f32_32x32x16_bf16(kf[0], qr[0], negm, 0, 0, 0), P0[2], P0[3], P0[4], P0[5],     pw0[0] = PKW(P0, 0), pw0[1] = PKW(P0, 2), pw0); \
    VRD(4); SBAR(); GAPA(C1 = __builtin_amdgcn_mfma_f32_32x32x16_bf16(kf[1], qr[0], negm, 0, 0, 0), P0[6], P0[7], P0[8], P0[9],     pw0[2] = PKW(P0, 4), pw0[3] = PKW(P0, 6), pw0); \
    VRD(1); SBAR(); GAPA(C0 = __builtin_amdgcn_mfma_f32_32x32x16_bf16(kf[2], qr[1], C0, 0, 0, 0),   P0[10], P0[11], P0[12], P0[13], pw1[0] = PKW(P0, 8), pw1[1] = PKW(P0, 10), pw1); \
    VRD(5); SBAR(); GAPA(C1 = __builtin_amdgcn_mfma_f32_32x32x16_bf16(kf[3], qr[1], C1, 0, 0, 0),   P0[14], P0[15], P1[0], P1[1],   pw1[2] = PKW(P0, 12), pw1[3] = PKW(P0, 14), pw1); \
    VRD(2); SBAR(); GAPA(C0 = __builtin_amdgcn_mfma_f32_32x32x16_bf16(kf[4], qr[2], C0, 0, 0, 0),   P1[2], P1[3], P1[4], P1[5],     pw2[0] = PKW(P1, 0), pw2[1] = PKW(P1, 2), pw2); \
    VRD(6); SBAR(); GAPA(C1 = __builtin_amdgcn_mfma_f32_32x32x16_bf16(kf[5], qr[2], C1, 0, 0, 0),   P1[6], P1[7], P1[8], P1[9],     pw2[2] = PKW(P1, 4), pw2[3] = PKW(P1, 6), pw2); \
    VRD(3); SBAR(); GAPA(C0 = __builtin_amdgcn_mfma_f32_32x32x16_bf16(kf[6], qr[3], C0, 0, 0, 0),   P1[10], P1[11], P1[12], P1[13], pw3[0] = PKW(P1, 8), pw3[1] = PKW(P1, 10), pw3); \
    VRD(7); SBAR(); GAPA(C1 = __builtin_amdgcn_mfma_f32_32x32x16_bf16(kf[7], qr[3], C1, 0, 0, 0),   P1[14], P1[15], 0.f, 0.f,       pw3[2] = PKW(P1, 12), pw3[3] = PKW(P1, 14), pw3); \
    l_reg += sacc; \
    if (GK) { DMA_K((t) + 3, sl_cur); } if (GV) { DMA_V((t) + 1, sl_next); } \
    MASKT(C0, C1, t); \
    { float a = MX3(C0[0], C0[1], C1[0]), b = MX3(C0[2], C0[3], C1[1]); a = MX3(a, C1[2], C1[3]); \
      _Pragma("unroll") for (int r = 4; r < 16; r += 4) { a = MX3(a, C0[r], C0[r + 1]); b = MX3(b, C0[r + 2], C0[r + 3]); a = MX3(a, C1[r], C1[r + 1]); b = MX3(b, C1[r + 2], C1[r + 3]); } \
      float rm = __builtin_fmaxf(a, b); { auto rr = __builtin_amdgcn_permlane32_swap(__float_as_uint(rm), __float_as_uint(rm), false, false); rm = __builtin_fmaxf(__uint_as_float(rr[0]), __uint_as_float(rr[1])); } \
      resc = false; \
      if (__builtin_expect(__any(rm > (float)THRL), 0)) { const float dl = __builtin_fmaxf(rm, 0.f); mhat += dl; \
        _Pragma("unroll") for (int r = 0; r < 16; ++r) { C0[r] -= dl; C1[r] -= dl; } \
        _Pragma("unroll") for (int r = 0; r < 16; ++r) negm[r] = -mhat; asm volatile("" : "+v"(negm)); \
        const float f = __builtin_amdgcn_exp2f(-dl); l_reg *= f; if (hi == 0) wsf[r32] = f; resc = true; } } \
    SBAR(); \
    GAPB(o[0] = __builtin_amdgcn_mfma_f32_32x32x16_bf16(PAF(0), VFR(0), o[0], 0, 0, 0), C0, 0); \
    GAPB(o[1] = __builtin_amdgcn_mfma_f32_32x32x16_bf16(PAF(0), VFR(4), o[1], 0, 0, 0), C0, 4); \
    KRD(GL, 0); GAPB(o[0] = __builtin_amdgcn_mfma_f32_32x32x16_bf16(PAF(1), VFR(1), o[0], 0, 0, 0), C0, 8); \
    KRD(GL, 1); GAPB(o[1] = __builtin_amdgcn_mfma_f32_32x32x16_bf16(PAF(1), VFR(5), o[1], 0, 0, 0), C0, 12); \
    KRD(GL, 2); GAPB(o[0] = __builtin_amdgcn_mfma_f32_32x32x16_bf16(PAF(2), VFR(2), o[0], 0, 0, 0), C1, 0); \
    KRD(GL, 3); GAPB(o[1] = __builtin_amdgcn_mfma_f32_32x32x16_bf16(PAF(2), VFR(6), o[1], 0, 0, 0), C1, 4); \
    GAPB(o[0] = __builtin_amdgcn_mfma_f32_32x32x16_bf16(PAF(3), VFR(3), o[0], 0, 0, 0), C1, 8); \
    GAPB(o[1] = __builtin_amdgcn_mfma_f32_32x32x16_bf16(PAF(3), VFR(7), o[1], 0, 0, 0), C1, 12); \
    } while (0)
    int t = 1;
    for (; t + 5 < NT; t += 2) {
        STEP(pB0, pB1, pA0, pA1, t, true, true, true);     WAIT_BAR(2); RESC(); ROT();
        STEP(pA0, pA1, pB0, pB1, t + 1, true, true, true); WAIT_BAR(2); RESC(); ROT();
    }
#define ENDW(tt) do { if ((tt) + 3 < NT) { WAIT_BAR(2); } else if ((tt) + 2 < NT) { WAIT_BAR(1); } else { WAIT_BAR(0); } } while (0)
    for (; t + 1 < NT; t += 2) {
        STEP(pB0, pB1, pA0, pA1, t, (t + 3 < NT), (t + 1 < NT), (t + 1 < NT));       ENDW(t);     RESC(); ROT();
        STEP(pA0, pA1, pB0, pB1, t + 1, (t + 4 < NT), (t + 2 < NT), (t + 2 < NT));   ENDW(t + 1); RESC(); ROT();
    }
    STEP(pB0, pB1, pA0, pA1, NT - 1, false, false, false); RESC();
    { float sacc = pB0[0] + pB0[1]; _Pragma("unroll") for (int r = 2; r < 16; ++r) sacc += pB0[r]; _Pragma("unroll") for (int r = 0; r < 16; ++r) sacc += pB1[r]; l_reg += sacc;
      pw0 = (u32x4){PKW(pB0, 0), PKW(pB0, 2), PKW(pB0, 4), PKW(pB0, 6)}; pw1 = (u32x4){PKW(pB0, 8), PKW(pB0, 10), PKW(pB0, 12), PKW(pB0, 14)}; pw2 = (u32x4){PKW(pB1, 0), PKW(pB1, 2), PKW(pB1, 4), PKW(pB1, 6)}; pw3 = (u32x4){PKW(pB1, 8), PKW(pB1, 10), PKW(pB1, 12), PKW(pB1, 14)};
      SBAR(); pv(o, vb0 + sl_cur, PAF(0), PAF(1), PAF(2), PAF(3)); }
#undef PKW
#undef PAF
#undef VFR
#undef PIN
#undef MX3
#undef GAPA
#undef GAPB
#undef EX
#undef VRD
#undef KRD
#undef STEP
#undef ENDW
    { auto rr = __builtin_amdgcn_permlane32_swap(__float_as_uint(l_reg), __float_as_uint(l_reg), false, false); l_reg = __uint_as_float(rr[0]) + __uint_as_float(rr[1]); }
    if (hi == 0) { wsf[32 + r32] = l_reg; if (OWN) wsf[r32] = mhat; } asm volatile("s_waitcnt lgkmcnt(0)" ::: "memory");
    float rli[16];
#pragma unroll
    for (int r = 0; r < 16; ++r) rli[r] = __builtin_amdgcn_rcpf(wsf[32 + crow(r, hi)]);
    bf16* Ow = O + (rowbase + q0 + wid * QBLK) * PITCH + h * D;
    { bf16* stg = (bf16*)(shm + LDS_OST) + wid * 2048;
#pragma unroll
      for (int r = 0; r < 16; ++r) { const int orow = crow(r, hi);
#pragma unroll
        for (int d0 = 0; d0 < 2; ++d0) stg[orow * 64 + d0 * 32 + r32] = __float2bfloat16(o[d0][r] * rli[r]); }
      asm volatile("s_waitcnt lgkmcnt(0)" ::: "memory");
      const int nsel = qb < 3 ? qb : 3;
#pragma unroll
      for (int i = 0; i < 4; ++i) { const int row = i * 8 + (lane >> 3), ch = lane & 7; u32x4 v = *(const u32x4*)(stg + row * 64 + ch * 8);
        if constexpr (OWN) {
          if (nsel > 0) {
            const float mo = wsf[row], lo = wsf[32 + row];
            const size_t e0 = (((size_t)(b * NHEAD + h)) * SEQ + q0 + wid * QBLK + row) * 3;
            float ms[3], ls[3]; u32x4 pp[3]; float M = mo;
#pragma unroll
            for (int s_ = 0; s_ < 3; ++s_) { ms[s_] = -INFINITY; ls[s_] = 0.f; pp[s_] = (u32x4){0u, 0u, 0u, 0u};
              if (s_ < nsel) { const f32x2 ml = *(const f32x2*)(PML + (e0 + s_) * 2); ms[s_] = ml.x; ls[s_] = ml.y; pp[s_] = *(const u32x4*)(PO + (e0 + s_) * 64 + ch * 8); M = fmaxf(M, ml.x); } }
            const float wo = lo * __builtin_amdgcn_exp2f(mo - M); float W = wo;
            float a[8] = {bflo(v.x) * wo, bfhi(v.x) * wo, bflo(v.y) * wo, bfhi(v.y) * wo, bflo(v.z) * wo, bfhi(v.z) * wo, bflo(v.w) * wo, bfhi(v.w) * wo};
#pragma unroll
            for (int s_ = 0; s_ < 3; ++s_) { const float w_ = (s_ < nsel) ? ls[s_] * __builtin_amdgcn_exp2f(ms[s_] - M) : 0.f; W += w_;
              a[0] += w_ * bflo(pp[s_].x); a[1] += w_ * bfhi(pp[s_].x); a[2] += w_ * bflo(pp[s_].y); a[3] += w_ * bfhi(pp[s_].y); a[4] += w_ * bflo(pp[s_].z); a[5] += w_ * bfhi(pp[s_].z); a[6] += w_ * bflo(pp[s_].w); a[7] += w_ * bfhi(pp[s_].w); }
            const float iw = 1.0f / W;
            v.x = cvtpk_s(a[0] * iw, a[1] * iw); v.y = cvtpk_s(a[2] * iw, a[3] * iw); v.z = cvtpk_s(a[4] * iw, a[5] * iw); v.w = cvtpk_s(a[6] * iw, a[7] * iw);
          } }
        if (do_store) *(u32x4*)(Ow + (long)row * PITCH + ch * 8) = v; } }
    asm volatile("s_waitcnt lgkmcnt(0)\n\ts_barrier" ::: "memory");
#undef DMA_K
#undef DMA_V
#undef TM
#undef MASKT
#undef START
#undef RESC
#undef ROT
}

__device__ __forceinline__ void select_unit(int b, int h, int qb, const bf16* Q, const float* ksum, unsigned short* LIST, unsigned* CNT, char* shm) {
    if (qb == 0) return;
    const int tid = threadIdx.x, lane = tid & 63, r32 = lane & 31, hi = lane >> 5; const int wid = __builtin_amdgcn_readfirstlane(tid >> 6);
    LAS unsigned* hist = (LAS unsigned*)shm; LAS unsigned* basev = hist + 32;
    if (tid < 32) hist[tid] = 0u;
    __syncthreads();
    int kbs[3] = {0, 1, 2}; const int ns = qb < 3 ? qb : 3;
    if (qb > 3) {
        const bf16* Qw = Q + ((long)b * SEQ + qb * QB + wid * QBLK) * PITCH + h * D;
        bf16x8 qr[4];
#pragma unroll
        for (int d0 = 0; d0 < 4; ++d0) qr[d0] = *reinterpret_cast<const bf16x8*>(&Qw[(long)r32 * PITCH + d0 * 16 + hi * 8]);
        gate_top3(ksum + ((size_t)(b * NHEAD + h) * 32) * 64, qr, qb, r32, hi, kbs);
    }
    unsigned pos[3] = {0u, 0u, 0u};
    if (hi == 0) {
#pragma unroll
        for (int s_ = 0; s_ < 3; ++s_) if (s_ < ns) pos[s_] = __hip_atomic_fetch_add(hist + kbs[s_], 1u, __ATOMIC_RELAXED, __HIP_MEMORY_SCOPE_WORKGROUP);
    }
    __syncthreads();
    const int bh = b * NHEAD + h;
    if (tid < 32) { const unsigned n = hist[tid]; basev[tid] = n ? __hip_atomic_fetch_add(CNT + bh * 32 + tid, n, __ATOMIC_RELAXED, __HIP_MEMORY_SCOPE_AGENT) : 0u; }
    __syncthreads();
    if (hi == 0) { const unsigned qv = (unsigned)(qb * QB + wid * QBLK + r32) << 2;
#pragma unroll
        for (int s_ = 0; s_ < 3; ++s_) if (s_ < ns) LIST[(size_t)(bh * 32 + kbs[s_]) * 8192 + basev[kbs[s_]] + pos[s_]] = (unsigned short)(qv | (unsigned)s_); }
    __syncthreads();
}

constexpr int G_K = 0, G_V = 32768, G_WS = 65536, G_OST = G_WS + NW * 512, G_TAB = G_OST + NW * 4096, G_BYTES = G_TAB + 8256 + 4096;
template <int THRL> __device__ __forceinline__ void gather_phase(char* shm, const bf16* Q, const bf16* __restrict__ K, const bf16* __restrict__ V, const unsigned short* LIST, unsigned* CNT, bf16_t* PO, float* PML, int vcu, int G) {
    const int tid = threadIdx.x, lane = tid & 63, r32 = lane & 31, hi = lane >> 5; const int wid = __builtin_amdgcn_readfirstlane(tid >> 6);
    LAS int* pre = (LAS int*)(shm + G_TAB); LAS int* wtot = pre + 1032; LAS int* cntl = (LAS int*)(shm + G_TAB + 8256);
    {
        const int c0 = (int)__hip_atomic_load(CNT + 2 * tid, __ATOMIC_RELAXED, __HIP_MEMORY_SCOPE_AGENT), c1 = (int)__hip_atomic_load(CNT + 2 * tid + 1, __ATOMIC_RELAXED, __HIP_MEMORY_SCOPE_AGENT);
        const int n0 = (c0 + 255) >> 8, n1 = (c1 + 255) >> 8, sm = n0 + n1; int v = sm;
#pragma unroll
        for (int o_ = 1; o_ < 64; o_ <<= 1) { const int t_ = __shfl_up(v, o_); if (lane >= o_) v += t_; }
        if (lane == 63) wtot[wid] = v;
        cntl[2 * tid] = c0; cntl[2 * tid + 1] = c1;
        __syncthreads();
        int off = 0;
        for (int w_ = 0; w_ < wid; ++w_) off += wtot[w_];
        const int excl = off + v - sm;
        pre[2 * tid] = excl; pre[2 * tid + 1] = excl + n0; if (tid == NW * 64 - 1) pre[1024] = excl + sm;
        __syncthreads();
    }
    const int P = __builtin_amdgcn_readfirstlane(pre[1024]);
    const int ulo = (int)(((long)P * vcu) / G), uhi = (int)(((long)P * (vcu + 1)) / G);
    const unsigned lds0 = (unsigned)(uintptr_t)shm;
    float* wsf = (float*)(shm + G_WS) + wid * 128; int* ent = (int*)(wsf + 64);
    const unsigned kdst = lds0 + G_K + wid * 1024, vdst = lds0 + G_V + wid * 1024;
    const int vb0 = (int)(lds0 + G_V) + ((lane >> 4) & 1) * 32 + (lane & 3) * 8 + (4 * hi + ((lane & 15) >> 2)) * 64;
    int it0 = 0, it1 = 0, it2 = 0, cur = -1;
#define G_ITEM(itv, uu) do { while ((uu) < uhi && __builtin_amdgcn_readfirstlane(pre[(itv) + 1]) <= (uu)) ++(itv); } while (0)
#define G_ENTRY(itv, uu) ({ const int ps_ = (uu) - __builtin_amdgcn_readfirstlane(pre[itv]), cn_ = __builtin_amdgcn_readfirstlane(cntl[itv]); const int li_ = ps_ * 256 + wid * QBLK + r32; \
        (unsigned)LIST[(size_t)(itv) * 8192 + (li_ < cn_ ? li_ : 0)] | ((li_ < cn_) ? 0x10000u : 0u); })
#define G_QLOAD(dst, itv, ee) do { const int bh_ = (itv) >> 5; const bf16* Qrow_ = Q + ((long)(bh_ >> 3) * SEQ + (int)(((ee) & 0xffffu) >> 2)) * PITCH + (bh_ & 7) * D; \
        _Pragma("unroll") for (int d0 = 0; d0 < 4; ++d0) dst[d0] = *reinterpret_cast<const bf16x8*>(Qrow_ + d0 * 16 + hi * 8); } while (0)
    unsigned e0 = 0u, e1 = 0u, e2 = 0u; bf16x8 qr[4], qn[4];
    if (ulo < uhi) { G_ITEM(it0, ulo); e0 = G_ENTRY(it0, ulo); it1 = it0; { const int u1_ = (ulo + 1 < uhi) ? ulo + 1 : uhi - 1; G_ITEM(it1, u1_); e1 = G_ENTRY(it1, u1_); } G_QLOAD(qr, it0, e0); }
    it2 = it1;
    for (int u = ulo; u < uhi; ++u) {
        { const int u2_ = (u + 2 < uhi) ? u + 2 : uhi - 1; G_ITEM(it2, u2_); e2 = G_ENTRY(it2, u2_); }
        const int item = it0;
        const int bh = item >> 5, kb = item & 31, b = bh >> 3, h = bh & 7;
        if (item != cur) {
            asm volatile("s_waitcnt lgkmcnt(0)\n\ts_barrier" ::: "memory");
            const bf16* Kh = K + (long)b * SEQ * PITCH + h * D, *Vh = V + (long)b * SEQ * PITCH + h * D;
            const bf16* ksrc = Kh + (long)lane * PITCH + wid * 8;
            const bf16* vsrc = Vh + (long)(16 * (wid & 3) + (lane >> 2)) * PITCH + (wid >> 2) * 32 + (lane & 3) * 8;
#pragma unroll
            for (int t = 0; t < 4; ++t) { glds16(ksrc + (long)(4 * kb + t) * KVBLK * PITCH, (unsigned)__builtin_amdgcn_readfirstlane(kdst + t * 8192)); glds16(vsrc + (long)(4 * kb + t) * KVBLK * PITCH, (unsigned)__builtin_amdgcn_readfirstlane(vdst + t * 8192)); }
            asm volatile("s_waitcnt vmcnt(0)\n\ts_barrier" ::: "memory");
            cur = item;
        }
        G_QLOAD(qn, it1, e1);
        const bool valid = (e0 & 0x10000u) != 0u;
        const int q = (int)((e0 & 0xffffu) >> 2), slot = (int)(e0 & 3u);
        const bool wave_has_rows = __builtin_amdgcn_readfirstlane((int)(e0 >> 16) & 1) != 0 || __any(valid);
        if (wave_has_rows) {
        float mhat = 0.f, l_reg = 0.f; f32x16 o[2]; f32x16 negm;
#pragma unroll
        for (int r = 0; r < 16; ++r) { o[0][r] = 0.f; o[1][r] = 0.f; negm[r] = 0.f; }
        const lds_cptr kp0 = (lds_cptr)shm + G_K + hi * 1024 + r32 * 16; const lds_cptr vp0 = (lds_cptr)shm + G_V + ((lane >> 4) & 1) * 32 + (lane & 3) * 8 + (4 * hi + ((lane & 15) >> 2)) * 64;
        bf16x8 kf[8]; f32x16 p0, p1, s0, s1;
#define G_QK(D0, D1) do { D0 = __builtin_amdgcn_mfma_f32_32x32x16_bf16(kf[0], qr[0], negm, 0, 0, 0); D1 = __builtin_amdgcn_mfma_f32_32x32x16_bf16(kf[1], qr[0], negm, 0, 0, 0); \
            D0 = __builtin_amdgcn_mfma_f32_32x32x16_bf16(kf[2], qr[1], D0, 0, 0, 0); D1 = __builtin_amdgcn_mfma_f32_32x32x16_bf16(kf[3], qr[1], D1, 0, 0, 0); \
            D0 = __builtin_amdgcn_mfma_f32_32x32x16_bf16(kf[4], qr[2], D0, 0, 0, 0); D1 = __builtin_amdgcn_mfma_f32_32x32x16_bf16(kf[5], qr[2], D1, 0, 0, 0); \
            D0 = __builtin_amdgcn_mfma_f32_32x32x16_bf16(kf[6], qr[3], D0, 0, 0, 0); D1 = __builtin_amdgcn_mfma_f32_32x32x16_bf16(kf[7], qr[3], D1, 0, 0, 0); } while (0)
#define G_MX(D0, D1, FIRST) do { float a_ = fmaxf(fmaxf(D0[0], D0[1]), D1[0]), c_ = fmaxf(fmaxf(D0[2], D0[3]), D1[1]); a_ = fmaxf(fmaxf(a_, D1[2]), D1[3]); \
            _Pragma("unroll") for (int r = 4; r < 16; r += 4) { a_ = fmaxf(fmaxf(a_, D0[r]), D0[r + 1]); c_ = fmaxf(fmaxf(c_, D0[r + 2]), D0[r + 3]); a_ = fmaxf(fmaxf(a_, D1[r]), D1[r + 1]); c_ = fmaxf(fmaxf(c_, D1[r + 2]), D1[r + 3]); } \
            float rm_ = fmaxf(a_, c_); { auto rr_ = __builtin_amdgcn_permlane32_swap(__float_as_uint(rm_), __float_as_uint(rm_), false, false); rm_ = fmaxf(__uint_as_float(rr_[0]), __uint_as_float(rr_[1])); } \
            if (FIRST) { mhat = rm_; _Pragma("unroll") for (int r = 0; r < 16; ++r) { D0[r] -= rm_; D1[r] -= rm_; negm[r] = -mhat; } } \
            else if (__any(rm_ > (float)THRL)) { const float dl_ = fmaxf(rm_, 0.f); mhat += dl_; \
                _Pragma("unroll") for (int r = 0; r < 16; ++r) { D0[r] -= dl_; D1[r] -= dl_; negm[r] = -mhat; } \
                const float f_ = __builtin_amdgcn_exp2f(-dl_); l_reg *= f_; if (hi == 0) wsf[r32] = f_; \
                asm volatile("s_waitcnt lgkmcnt(0)" ::: "memory"); \
                _Pragma("unroll") for (int d_ = 0; d_ < 2; ++d_) _Pragma("unroll") for (int r = 0; r < 16; ++r) o[d_][r] *= wsf[crow(r, hi)]; } } while (0)
        kload8(kf, kp0);
        G_QK(p0, p1);
        kload8(kf, kp0 + 8192);
        G_MX(p0, p1, true);
#pragma unroll
        for (int t = 0; t < 4; ++t) {
            if (t < 3) { __builtin_amdgcn_sched_barrier(0); G_QK(s0, s1); if (t < 2) kload8(kf, kp0 + (t + 2) * 8192); }
            s16x4 vlo[8], vhi[8];
            const lds_cptr vp_ = vp0 + t * 8192;
#pragma unroll
            for (int i = 0; i < 8; ++i) { vlo[i] = vtr(vp_ + ((i >> 2) * 4096 + (i & 3) * 1024)); vhi[i] = vtr(vp_ + ((i >> 2) * 4096 + (i & 3) * 1024 + 512)); }
            __builtin_amdgcn_sched_barrier(0);
            float sacc = 0.f;
#pragma unroll
            for (int r = 0; r < 16; ++r) { p0[r] = __builtin_amdgcn_exp2f(p0[r]); p1[r] = __builtin_amdgcn_exp2f(p1[r]); sacc += p0[r] + p1[r]; }
            l_reg += sacc;
            const u32x4 pw0 = {cvtpk_s(p0[0], p0[1]), cvtpk_s(p0[2], p0[3]), cvtpk_s(p0[4], p0[5]), cvtpk_s(p0[6], p0[7])}, pw1 = {cvtpk_s(p0[8], p0[9]), cvtpk_s(p0[10], p0[11]), cvtpk_s(p0[12], p0[13]), cvtpk_s(p0[14], p0[15])};
            const u32x4 pw2 = {cvtpk_s(p1[0], p1[1]), cvtpk_s(p1[2], p1[3]), cvtpk_s(p1[4], p1[5]), cvtpk_s(p1[6], p1[7])}, pw3 = {cvtpk_s(p1[8], p1[9]), cvtpk_s(p1[10], p1[11]), cvtpk_s(p1[12], p1[13]), cvtpk_s(p1[14], p1[15])};
            __builtin_amdgcn_sched_barrier(0);
#define G_VF(i) (bf16x8){vlo[i][0], vlo[i][1], vlo[i][2], vlo[i][3], vhi[i][0], vhi[i][1], vhi[i][2], vhi[i][3]}
            o[0] = __builtin_amdgcn_mfma_f32_32x32x16_bf16(__builtin_bit_cast(bf16x8, pw0), G_VF(0), o[0], 0, 0, 0); o[1] = __builtin_amdgcn_mfma_f32_32x32x16_bf16(__builtin_bit_cast(bf16x8, pw0), G_VF(4), o[1], 0, 0, 0);
            o[0] = __builtin_amdgcn_mfma_f32_32x32x16_bf16(__builtin_bit_cast(bf16x8, pw1), G_VF(1), o[0], 0, 0, 0); o[1] = __builtin_amdgcn_mfma_f32_32x32x16_bf16(__builtin_bit_cast(bf16x8, pw1), G_VF(5), o[1], 0, 0, 0);
            o[0] = __builtin_amdgcn_mfma_f32_32x32x16_bf16(__builtin_bit_cast(bf16x8, pw2), G_VF(2), o[0], 0, 0, 0); o[1] = __builtin_amdgcn_mfma_f32_32x32x16_bf16(__builtin_bit_cast(bf16x8, pw2), G_VF(6), o[1], 0, 0, 0);
            o[0] = __builtin_amdgcn_mfma_f32_32x32x16_bf16(__builtin_bit_cast(bf16x8, pw3), G_VF(3), o[0], 0, 0, 0); o[1] = __builtin_amdgcn_mfma_f32_32x32x16_bf16(__builtin_bit_cast(bf16x8, pw3), G_VF(7), o[1], 0, 0, 0);
#undef G_VF
            if (t < 3) { G_MX(s0, s1, false); p0 = s0; p1 = s1; }
        }
#undef G_QK
#undef G_MX
        { auto rr = __builtin_amdgcn_permlane32_swap(__float_as_uint(l_reg), __float_as_uint(l_reg), false, false); l_reg = __uint_as_float(rr[0]) + __uint_as_float(rr[1]); }
        const int er = valid ? (q * 3 + slot) : -1;
        if (hi == 0) { wsf[32 + r32] = l_reg; ent[r32] = er; } asm volatile("s_waitcnt lgkmcnt(0)" ::: "memory");
        float rli[16];
#pragma unroll
        for (int r = 0; r < 16; ++r) rli[r] = __builtin_amdgcn_rcpf(wsf[32 + crow(r, hi)]);
        bf16* stg = (bf16*)(shm + G_OST) + wid * 2048;
#pragma unroll
        for (int r = 0; r < 16; ++r) { const int orow = crow(r, hi);
#pragma unroll
            for (int d0 = 0; d0 < 2; ++d0) stg[orow * 64 + d0 * 32 + r32] = __float2bfloat16(o[d0][r] * rli[r]); }
        asm volatile("s_waitcnt lgkmcnt(0)" ::: "memory");
        const size_t ebase = (size_t)bh * SEQ * 3;
#pragma unroll
        for (int i = 0; i < 4; ++i) { const int row = i * 8 + (lane >> 3), ch = lane & 7; const u32x4 v = *(const u32x4*)(stg + row * 64 + ch * 8); const int er_ = ent[row];
            if (er_ >= 0) *(u32x4*)(PO + (ebase + er_) * 64 + ch * 8) = v; }
        if (hi == 0 && valid) *(f32x2*)(PML + (ebase + er) * 2) = (f32x2){mhat, l_reg};
        asm volatile("s_waitcnt lgkmcnt(0)" ::: "memory");
        }
        e0 = e1; e1 = e2; it0 = it1; it1 = it2;
#pragma unroll
        for (int d0 = 0; d0 < 4; ++d0) qr[d0] = qn[d0];
    }
    asm volatile("s_waitcnt vmcnt(0) lgkmcnt(0)\n\ts_barrier" ::: "memory");
#undef G_ITEM
#undef G_ENTRY
#undef G_QLOAD
}
#undef SBAR
#undef WAIT_BAR
}

#define XB_TMO      128
#define XB_XCNT(j)  (256  + 64 * (j))
#define XB_XSUB(j)  (1280 + 64 * (j))
#define XB_XGEN(j)  (2304 + 64 * (j))
#define XB_TOP      3328
#define XB_TOPGEN   3392
#define XCD_BAR_WORDS 3456
#define XB_SPIN_CAP (1u << 18)
__device__ __forceinline__ unsigned xb_ld(unsigned* p)              { return __hip_atomic_load(p, __ATOMIC_RELAXED, __HIP_MEMORY_SCOPE_AGENT); }
__device__ __forceinline__ unsigned xb_add(unsigned* p, unsigned v) { return __hip_atomic_fetch_add(p, v, __ATOMIC_RELAXED, __HIP_MEMORY_SCOPE_AGENT); }
__device__ __forceinline__ unsigned xb_xcc_id() { return (unsigned)__builtin_amdgcn_s_getreg((3 << 11) | 20) & 0xFu; }
#define XB_SPIN(cond, bar) do { unsigned _sp = 0; while (cond) { __builtin_amdgcn_s_sleep(1); \
    if ((++_sp & 255u) == 0u) { if (xb_ld(&(bar)[XB_TMO])) break; if (_sp > XB_SPIN_CAP) { atomicAdd(&(bar)[XB_TMO], 1u); break; } } } } while (0)
struct XcdBarrier { unsigned* bar; unsigned x; volatile LAS unsigned* st; };
__device__ __forceinline__ XcdBarrier xcd_barrier_post(unsigned* bar, volatile LAS unsigned* st) {
    XcdBarrier b; b.bar = bar; b.x = xb_xcc_id(); b.st = st;
    if (threadIdx.x == 0) (void)xb_add(&bar[XB_XCNT(b.x)], 1u);
    return b;
}
__device__ __forceinline__ void xcd_barrier_complete(unsigned* bar, unsigned x, unsigned& nloc, unsigned& nx) {
    const unsigned G = gridDim.x * gridDim.y * gridDim.z;
    unsigned sum, cnt, mine, sp = 0u;
    for (;;) {
        sum = 0u; cnt = 0u; mine = 0u;
#pragma unroll
        for (unsigned j = 0; j < 16; ++j) { const unsigned c = xb_ld(&bar[XB_XCNT(j)]); sum += c; cnt += (c > 0u) ? 1u : 0u; mine = (j == x) ? c : mine; }
        if (sum == G) break;
        __builtin_amdgcn_s_sleep(1);
        if ((++sp & 255u) == 0u) { if (xb_ld(&bar[XB_TMO])) break; if (sp > XB_SPIN_CAP) { atomicAdd(&bar[XB_TMO], 1u); break; } }
    }
    nloc = mine > 0u ? mine : 1u; nx = cnt > 0u ? cnt : 1u;
}
__device__ __forceinline__ void xcd_barrier(const XcdBarrier& b) {
    asm volatile("s_waitcnt vmcnt(0)" ::: "memory");
    __syncthreads();
    if (threadIdx.x == 0) {
        unsigned* bar = b.bar;
        __builtin_amdgcn_s_waitcnt(0);
        unsigned nloc = b.st[0], nx = b.st[1];
        if (nloc == 0u) { xcd_barrier_complete(bar, b.x, nloc, nx); b.st[0] = nloc; b.st[1] = nx; }
        const unsigned old = xb_add(&bar[XB_XSUB(b.x)], 1u);
        const unsigned gen = old / nloc;
        if (old + 1u == (gen + 1u) * nloc) {
            __builtin_amdgcn_fence(__ATOMIC_RELEASE, "agent");
            asm volatile("s_waitcnt vmcnt(0)" ::: "memory");
            const unsigned og = xb_add(&bar[XB_TOP], 1u);
            const unsigned tg = og / nx;
            if (og + 1u == (tg + 1u) * nx) xb_add(&bar[XB_TOPGEN], 1u);
            else XB_SPIN(xb_ld(&bar[XB_TOPGEN]) == tg, bar);
            __builtin_amdgcn_fence(__ATOMIC_ACQUIRE, "agent");
            xb_add(&bar[XB_XGEN(b.x)], 1u);
            asm volatile("s_waitcnt vmcnt(0)" ::: "memory");
        } else {
            XB_SPIN(xb_ld(&bar[XB_XGEN(b.x)]) == gen, bar);
            __builtin_amdgcn_fence(__ATOMIC_ACQUIRE, "agent");
            asm volatile("s_waitcnt vmcnt(0)" ::: "memory");
        }
    }
    __syncthreads();
}

struct Args { const float* in[22]; float* out; unsigned char* ws; int ph_lo, ph_hi, li, flags; };
struct Frame {
    LAS unsigned char* lds; volatile LAS unsigned* MISC; gu32* ctl;
    int tid, lane, wave, vcu, G;
};
__device__ __forceinline__ int fresh_tid() { int t = threadIdx.x; asm volatile("" : "+v"(t)); return t; }
#define PHASE_IDS() do { F.tid = fresh_tid(); F.lane = F.tid & 63; F.wave = __builtin_amdgcn_readfirstlane(F.tid >> 6); } while (0)

__device__ __forceinline__ void transpose_item(const float* W, int ldw, int k0, int n0, bf16_t* WT, size_t row_off, int Kd, LAS float* scr, int lane) {
    const int half = lane >> 5, j2 = 2 * (lane & 31);
#pragma unroll 8
    for (int i = 0; i < 32; ++i) { const int kk = 2 * i + half; const f32x2 v = *(const f32x2*)(W + (size_t)(k0 + kk) * ldw + n0 + j2); scr[kk * 65 + j2] = v.x; scr[kk * 65 + j2 + 1] = v.y; }
    LDS_WAIT(); asm volatile("" ::: "memory");
    const int c = lane & 7;
#pragma unroll
    for (int j = 0; j < 8; ++j) { const int n = (lane >> 3) + 8 * j; const LAS float* s = scr + (8 * c) * 65 + n;
        u32x4 o; o.x = cvt_pk_bf16(s[0 * 65], s[1 * 65]); o.y = cvt_pk_bf16(s[2 * 65], s[3 * 65]); o.z = cvt_pk_bf16(s[4 * 65], s[5 * 65]); o.w = cvt_pk_bf16(s[6 * 65], s[7 * 65]);
        *(u32x4*)(WT + (row_off + n0 + n) * (size_t)Kd + k0 + 8 * c) = o; }
    LDS_WAIT(); asm volatile("" ::: "memory");
}

__global__ void __launch_bounds__(NWAVES * 64, 2) hybrid_fwd(Args args) {
    extern __shared__ __attribute__((aligned(16))) unsigned char lds_raw[];
    Frame F;
    F.lds = (LAS unsigned char*)lds_raw;
    F.MISC = (volatile LAS unsigned*)(F.lds + MISC_OFF);
    F.tid = threadIdx.x; F.lane = F.tid & 63; F.wave = __builtin_amdgcn_readfirstlane(F.tid >> 6);
    F.G = gridDim.x; { const int bx = blockIdx.x; F.vcu = (F.G % 8 == 0) ? (bx % 8) * (F.G / 8) + bx / 8 : bx; }
    unsigned char* ws = args.ws;
    F.ctl = (gu32*)(ws + WS_CTL);
    const float* x = args.in[0]; const float* cvec = args.in[1]; const float* ada_w = args.in[2]; const float* ada_b = args.in[3];
    const float* norm1_g = args.in[4]; const float* norm2_g = args.in[5]; const float* w_in = args.in[6]; const float* gmlp_ln_g = args.in[7]; const float* gmlp_ln_b = args.in[8];
    const float* w_spatial = args.in[9]; const float* b_spatial = args.in[10]; const float* w_branch_a = args.in[11]; const float* w_branch_b = args.in[12]; const float* w_out = args.in[13];
    const float* w_rg = args.in[14]; const float* b_rg = args.in[15]; const float* w_re = args.in[16]; const float* b_re = args.in[17];
    const float* w_gate = args.in[18]; const float* w_up = args.in[19]; const float* w_down = args.in[20]; const float* final_g = args.in[21];
    float* out = args.out;
    float* KSUM = (float*)(ws + WS_KSUM); float* MODP = (float*)(ws + WS_MODP); float* MOD = (float*)(ws + WS_MOD); float* ROPE = (float*)(ws + WS_ROPE);
    bf16_t* WST = (bf16_t*)(ws + WS_WST); bf16_t* WRT = (bf16_t*)(ws + WS_WRT); float* SSQ = (float*)(ws + WS_SSQ);
    unsigned long long* ROUTE = (unsigned long long*)(ws + WS_ROUTE);
    bf16_t* WIN = (bf16_t*)(ws + WS_WIN); bf16_t* WA = (bf16_t*)(ws + WS_WA); bf16_t* WB = (bf16_t*)(ws + WS_WB); bf16_t* WOUT = (bf16_t*)(ws + WS_WOUT);
    bf16_t* WGU = (bf16_t*)(ws + WS_WGU); bf16_t* WD = (bf16_t*)(ws + WS_WD);
    bf16_t* XN = (bf16_t*)(ws + WS_XN); bf16_t* PROJ = (bf16_t*)(ws + WS_PROJ); bf16_t* HID = (bf16_t*)(ws + WS_HID); bf16_t* YB = (bf16_t*)(ws + WS_Y); bf16_t* X1 = (bf16_t*)(ws + WS_X1);
    bf16_t* PO = (bf16_t*)(ws + WS_PO); float* PML = (float*)(ws + WS_PML); unsigned short* LIST = (unsigned short*)(ws + WS_LIST); unsigned* CNT = (unsigned*)(F.ctl + CW_CNT);

    for (int u = F.tid; u < 256; u += NWAVES * 64) ((LAS unsigned*)(F.lds + MISC_OFF))[u] = 0u;
    __syncthreads();
    XcdBarrier bar; bar.bar = (unsigned*)(F.ctl + CW_BAR) + args.li * XCD_BAR_WORDS; bar.x = 0; bar.st = nullptr;
    if (!MK_PER_PHASE) bar = xcd_barrier_post((unsigned*)(F.ctl + CW_BAR) + args.li * XCD_BAR_WORDS, F.MISC + 8);
    const int lo = args.ph_lo, hi = args.ph_hi;
#define IN(k) (lo <= (k) && (k) < hi)
#define SEAM(k) do { if (IN(k) && IN((k) + 1)) xcd_barrier(bar); } while (0)

    if (IN(0)) { PHASE_IDS();
        const int gw = F.vcu * NWAVES + F.wave, NGW = F.G * NWAVES;
        const int gtid = F.vcu * (NWAVES * 64) + F.tid, NGT = F.G * NWAVES * 64;
        LAS float* scr = (LAS float*)(F.lds + F.wave * 16640);
        constexpr int I_MOD = 16 * 24, I_IN = 16 * 72, I_A = 8 * 16, I_O = 16 * 16;
        constexpr int NITEMS = I_MOD + I_IN + 2 * I_A + I_O;
        for (int it = gw; it < NITEMS; it += NGW) {
            int r = it;
            if (r < I_MOD) {
                const int s = r / 24, nc = r % 24, n = nc * 256 + 4 * F.lane;
                f32x4 a0 = {0.f, 0.f, 0.f, 0.f}, a1 = a0, a2 = a0, a3 = a0;
#pragma unroll 8
                for (int kk = 0; kk < 64; ++kk) { const int k = 64 * s + kk; const f32x4 w = *(const f32x4*)(ada_w + (size_t)k * 6144 + n);
                    a0 += w * cvec[k]; a1 += w * cvec[1024 + k]; a2 += w * cvec[2048 + k]; a3 += w * cvec[3072 + k]; }
                float* dst = MODP + (size_t)s * 24576 + n;
                *(f32x4*)(dst) = a0; *(f32x4*)(dst + 6144) = a1; *(f32x4*)(dst + 12288) = a2; *(f32x4*)(dst + 18432) = a3;
                continue; }
            r -= I_MOD;
            if (r < I_IN) { transpose_item(w_in, PC, 64 * (r / 72), 64 * (r % 72), WIN, 0, 1024, scr, F.lane); continue; } r -= I_IN;
            if (r < I_A) { transpose_item(w_branch_a, 1024, 64 * (r / 16), 64 * (r % 16), WA, 0, 512, scr, F.lane); continue; } r -= I_A;
            if (r < I_A) { transpose_item(w_branch_b, 1024, 64 * (r / 16), 64 * (r % 16), WB, 0, 512, scr, F.lane); continue; } r -= I_A;
            transpose_item(w_out, 1024, 64 * (r / 16), 64 * (r % 16), WOUT, 0, 1024, scr, F.lane);
        }
        for (int i = gtid; i < 65536; i += NGT) {
            const int pos = i >> 3, j = i & 7; const float inv = powf(500000.0f, -(float)j * 2.0f / 16.0f); const float ang = (float)pos * inv;
            ROPE[i] = cosf(ang); ROPE[65536 + i] = sinf(ang); }
        for (int i = gtid; i < 65536; i += NGT) {
            const int s = i & 127, t_ = (i >> 7) & 127; const float v = (s <= t_) ? w_spatial[i] : 0.f; WST[i] = (bf16_t)(cvt_pk_bf16(v, 0.f) & 0xffffu); }
        for (int i = gtid; i < 48 * 1024; i += NGT) {
            const int j = i >> 10, k = i & 1023; float v = 0.f; if (j < 4) v = w_rg[k * 4 + j]; else if (j < 36) v = w_re[k * 32 + (j - 4)];
            const unsigned hb = cvt_pk_bf16(v, 0.f) & 0xffffu; const float lo = v - bflo(hb);
            WRT[i] = (bf16_t)hb; WRT[48 * 1024 + i] = (bf16_t)(cvt_pk_bf16(lo, 0.f) & 0xffffu); }
    }
    SEAM(0);

    if (IN(1)) { PHASE_IDS();
        const int c = F.vcu, b = c >> 6;
        LAS float* f = (LAS float*)F.lds;
        for (int v = F.tid; v < 2048; v += NWAVES * 64) { float s = ada_b[v];
#pragma unroll
            for (int sl = 0; sl < 16; ++sl) s += MODP[(size_t)sl * 24576 + b * 6144 + v];
            f[v] = s; }
        if (F.tid < 96) { const int idx = 96 * c + F.tid; float s = ada_b[idx % 6144];
#pragma unroll
            for (int sl = 0; sl < 16; ++sl) s += MODP[(size_t)sl * 24576 + idx];
            MOD[idx] = s; }
        __syncthreads();
        f32x4 A1[4], B1[4];
#pragma unroll
        for (int j = 0; j < 4; ++j) { const int k = 4 * F.lane + 256 * j; const f32x4 g = *(const f32x4*)(norm1_g + k);
#pragma unroll
            for (int i = 0; i < 4; ++i) { A1[j][i] = g[i] * (1.0f + f[1024 + k + i]); B1[j][i] = f[k + i]; } }
        for (int i0 = 0; i0 < 16; i0 += 4) {
            f32x4 v[4][4]; float ss[4];
#pragma unroll
            for (int u_ = 0; u_ < 4; ++u_) { const size_t row = (size_t)c * 128 + F.wave * 16 + i0 + u_; const f32x4* xr = (const f32x4*)(x + row * DM) + F.lane;
#pragma unroll
                for (int j = 0; j < 4; ++j) v[u_][j] = xr[64 * j]; }
#pragma unroll
            for (int u_ = 0; u_ < 4; ++u_) { float s = 0.f;
#pragma unroll
                for (int j = 0; j < 4; ++j) s += (v[u_][j].x * v[u_][j].x + v[u_][j].y * v[u_][j].y) + (v[u_][j].z * v[u_][j].z + v[u_][j].w * v[u_][j].w);
                ss[u_] = s; }
#pragma unroll
            for (int o_ = 1; o_ < 64; o_ <<= 1) {
#pragma unroll
                for (int u_ = 0; u_ < 4; ++u_) ss[u_] += __shfl_xor(ss[u_], o_); }
#pragma unroll
            for (int u_ = 0; u_ < 4; ++u_) { const size_t row = (size_t)c * 128 + F.wave * 16 + i0 + u_; const float rstd = 1.0f / sqrtf(ss[u_] * (1.0f / DM) + EPS);
                u32x2* o8 = (u32x2*)(XN + row * DM) + F.lane;
#pragma unroll
                for (int j = 0; j < 4; ++j) { const f32x4 hv = v[u_][j] * rstd * A1[j] + B1[j]; u32x2 w; w.x = cvt_pk_bf16(hv.x, hv.y); w.y = cvt_pk_bf16(hv.z, hv.w); o8[64 * j] = w; } } }
        __syncthreads();
    }
    SEAM(1);

    if (IN(2)) {
        pg8::DenseSched S; S.init(XN, DM, WIN, DM, T, PC, F.G, (int)blockIdx.x);
        pg8::EpiProj E{PROJ, ROPE, KSUM};
        pg8::gemm_phase<pg8::EpiProj, pg8::DenseSched, false>(F.lds, S, E);
    }
    SEAM(2);

    if (IN(3)) { PHASE_IDS();
        for (int chunk = F.vcu; chunk < ((args.flags & 2) ? 0 : T / 128); chunk += F.G) {
            const int lane = F.lane, w = F.wave, q = lane >> 4, l15 = lane & 15;
            const size_t row0 = (size_t)chunk * 128;
            float lg[8], lb[8];
            { const f32x4 g0 = *(const f32x4*)(gmlp_ln_g + 8 * lane), g1 = *(const f32x4*)(gmlp_ln_g + 8 * lane + 4), b0 = *(const f32x4*)(gmlp_ln_b + 8 * lane), b1 = *(const f32x4*)(gmlp_ln_b + 8 * lane + 4);
#pragma unroll
              for (int j = 0; j < 4; ++j) { lg[j] = g0[j]; lg[4 + j] = g1[j]; lb[j] = b0[j]; lb[4 + j] = b1[j]; } }
            u32x4 vn[16];
#pragma unroll
            for (int i = 0; i < 16; ++i) { const size_t row = row0 + 16 * w + i; const u32x4 raw = *(const u32x4*)(PROJ + row * PC + C_V + 8 * lane);
                float v[8] = {gelu_tanh(bflo(raw.x)), gelu_tanh(bfhi(raw.x)), gelu_tanh(bflo(raw.y)), gelu_tanh(bfhi(raw.y)), gelu_tanh(bflo(raw.z)), gelu_tanh(bfhi(raw.z)), gelu_tanh(bflo(raw.w)), gelu_tanh(bfhi(raw.w))};
                float s = 0.f;
#pragma unroll
                for (int j = 0; j < 8; ++j) s += v[j];
                const float mean = wave_sum(s) * (1.0f / 512.0f); float s2 = 0.f;
#pragma unroll
                for (int j = 0; j < 8; ++j) { v[j] -= mean; s2 += v[j] * v[j]; }
                const float rstd = 1.0f / sqrtf(wave_sum(s2) * (1.0f / 512.0f) + EPS);
#pragma unroll
                for (int j = 0; j < 8; ++j) v[j] = v[j] * rstd * lg[j] + lb[j];
                vn[i].x = cvt_pk_bf16(v[0], v[1]); vn[i].y = cvt_pk_bf16(v[2], v[3]); vn[i].z = cvt_pk_bf16(v[4], v[5]); vn[i].w = cvt_pk_bf16(v[6], v[7]); }
            const int tt = 16 * w + l15;
            u32x2 wfr[4][2]; u32x4 uq[4];
#define GM_LOAD(WF, UQ, g_) do { const bf16_t* wp_ = WST + ((size_t)((g_) * 128 + tt)) * 128 + 4 * q; \
                _Pragma("unroll") for (int ks = 0; ks < 4; ++ks) { WF[ks][0] = *(const u32x2*)(wp_ + 32 * ks); WF[ks][1] = *(const u32x2*)(wp_ + 32 * ks + 16); } \
                _Pragma("unroll") for (int i = 0; i < 4; ++i) UQ[i] = *(const u32x4*)(PROJ + (row0 + 16 * w + 4 * i + q) * PC + C_U + 128 * (g_) + 8 * l15); } while (0)
            GM_LOAD(wfr, uq, 0);
#pragma unroll
            for (int g = 0; g < 4; ++g) {
                __syncthreads();
                if (q == g) {
#pragma unroll
                    for (int i = 0; i < 16; ++i) *(LAS u32x4*)(F.lds + (16 * w + i) * 288 + l15 * 16) = vn[i];
                }
                __syncthreads();
                u32x2 wfn[4][2]; u32x4 uqn[4];
                if (g < 3) GM_LOAD(wfn, uqn, g + 1);
                f32x4 acc[8];
#pragma unroll
                for (int it = 0; it < 8; ++it) acc[it] = (f32x4){0.f, 0.f, 0.f, 0.f};
                const int nks = (16 * w + 16 + 31) / 32;
#pragma unroll
                for (int ks = 0; ks < 4; ++ks) { if (ks < nks) {
                    const bf16x8 bw = __builtin_bit_cast(bf16x8, (u32x4){wfr[ks][0].x, wfr[ks][0].y, wfr[ks][1].x, wfr[ks][1].y});
                    const attn_body::lds_cptr base = (attn_body::lds_cptr)F.lds + (32 * ks + 4 * q + (l15 >> 2)) * 288 + (l15 & 3) * 8;
#pragma unroll
                    for (int it = 0; it < 8; ++it) {
                        const s16x4 lo = attn_body::vtr(base + it * 32), hi_ = attn_body::vtr(base + 16 * 288 + it * 32);
                        const bf16x8 a = (bf16x8){lo[0], lo[1], lo[2], lo[3], hi_[0], hi_[1], hi_[2], hi_[3]};
                        acc[it] = __builtin_amdgcn_mfma_f32_16x16x32_bf16(a, bw, acc[it], 0, 0, 0);
                    } } }
                const float bs = b_spatial[g * 128 + tt];
                LAS unsigned char* svb = F.lds + 36864;
#pragma unroll
                for (int it = 0; it < 8; ++it) { u32x2 o; o.x = cvt_pk_bf16(acc[it][0] + bs, acc[it][1] + bs); o.y = cvt_pk_bf16(acc[it][2] + bs, acc[it][3] + bs);
                    *(LAS u32x2*)(svb + tt * 272 + (16 * it + 4 * q) * 2) = o; }
                LDS_WAIT(); asm volatile("" ::: "memory");
#pragma unroll
                for (int i = 0; i < 4; ++i) { const int tr_ = 16 * w + 4 * i + q; bf16_t* pp = PROJ + (row0 + tr_) * PC + C_U + 128 * g + 8 * l15;
                    const u32x4 uu = uq[i]; const u32x4 sv = *(const LAS u32x4*)(svb + tr_ * 272 + l15 * 16);
                    u32x4 o; o.x = cvt_pk_bf16(gelu_tanh(bflo(uu.x)) * bflo(sv.x), gelu_tanh(bfhi(uu.x)) * bfhi(sv.x)); o.y = cvt_pk_bf16(gelu_tanh(bflo(uu.y)) * bflo(sv.y), gelu_tanh(bfhi(uu.y)) * bfhi(sv.y));
                    o.z = cvt_pk_bf16(gelu_tanh(bflo(uu.z)) * bflo(sv.z), gelu_tanh(bfhi(uu.z)) * bfhi(sv.z)); o.w = cvt_pk_bf16(gelu_tanh(bflo(uu.w)) * bflo(sv.w), gelu_tanh(bfhi(uu.w)) * bfhi(sv.w));
                    *(u32x4*)pp = o; }
                LDS_WAIT(); asm volatile("" ::: "memory");
                if (g < 3) {
#pragma unroll
                    for (int ks = 0; ks < 4; ++ks) { wfr[ks][0] = wfn[ks][0]; wfr[ks][1] = wfn[ks][1]; }
#pragma unroll
                    for (int i = 0; i < 4; ++i) uq[i] = uqn[i]; }
            }
            __syncthreads();
        }
        {
            using namespace attn_body;
            const int s = F.vcu & 7, bh = F.vcu >> 3;
            const bf16* Qp = (const bf16*)(PROJ + C_Q); const bf16* Kp = (const bf16*)(PROJ + C_K); const bf16* Vp = (const bf16*)(PROJ + C_VV);
#define QBI(i) (((i) == 0) ? s : ((i) == 1) ? 15 - s : ((i) == 2) ? 16 + s : 31 - s)
            if (ATTN_MODE != 0) {
                if (bh < NB * 8 && !(args.flags & 4)) for (int i = 0; i < 4; ++i) select_unit(bh >> 3, bh & 7, QBI(i), Qp, KSUM, LIST, CNT, (char*)lds_raw + 40960);
                if (!MK_PER_PHASE) xcd_barrier(bar);
                if (!(args.flags & 8)) gather_phase<8>((char*)lds_raw, Qp, Kp, Vp, LIST, CNT, PO, PML, F.vcu, F.G);
                if (!MK_PER_PHASE) xcd_barrier(bar);
                bf16* Op = (bf16*)(PROJ + (ATTN_MODE == 2 ? C_V : C_Q));
                if (bh < NB * 8 && !(args.flags & 16)) for (int i = 0; i < 4; ++i) attn_unit<8, true>(bh >> 3, bh & 7, QBI(i), Qp, Kp, Vp, Op, KSUM, (char*)lds_raw, (args.flags & 1) == 0, PO, PML);
            }
            if (ATTN_MODE == 0) {
                if (bh < NB * 8) for (int i = 0; i < 4; ++i) attn_unit<8, false>(bh >> 3, bh & 7, QBI(i), Qp, Kp, Vp, (bf16*)(PROJ + C_Q), KSUM, (char*)lds_raw, (args.flags & 1) == 0, PO, PML);
            }
#undef QBI
#undef GM_LOAD
        }
        VM_WAIT(); __syncthreads();
    }
    SEAM(3);

    if (IN(4)) {
        { pg8::DenseSched S; S.init(PROJ + C_U, PC, WA, 512, T, DM, F.G, (int)blockIdx.x); pg8::EpiMerge<true> E{PROJ, XN};
          pg8::gemm_phase<pg8::EpiMerge<true>, pg8::DenseSched, false>(F.lds, S, E); }
        { pg8::DenseSched S; S.init(PROJ + C_Q, PC, WB, 512, T, DM, F.G, (int)blockIdx.x); pg8::EpiMerge<false> E{PROJ, XN};
          pg8::gemm_phase<pg8::EpiMerge<false>, pg8::DenseSched, false>(F.lds, S, E); }
    }
    SEAM(4);

    if (IN(5)) {
        pg8::DenseSched S; S.init(XN, DM, WOUT, DM, T, DM, F.G, (int)blockIdx.x); pg8::EpiOut E{x, X1, MOD, SSQ};
        pg8::gemm_phase<pg8::EpiOut, pg8::DenseSched, false>(F.lds, S, E);
    }
    SEAM(5);

    if (IN(6)) { PHASE_IDS();
        {
            LAS float* scr = (LAS float*)(F.lds + F.wave * 16640);
            const int gw = F.vcu * NWAVES + F.wave, NGW = F.G * NWAVES;
            constexpr int I_G = 32 * 16 * 8, I_D = 32 * 8 * 16;
            for (int it = gw; it < 2 * I_G + I_D; it += NGW) { int r = it;
                if (r < 2 * I_G) { const bool up = r >= I_G; if (up) r -= I_G; const int e = r / 128, kb = (r % 128) / 8, nb = r % 8, n0 = 64 * nb;
                    const size_t row_off = (size_t)e * 1024 + (size_t)(n0 / 128) * 256 + (up ? 128 : 0) + (n0 % 128) - n0;
                    transpose_item((up ? w_up : w_gate) + (size_t)e * 1024 * 512, 512, 64 * kb, n0, WGU, row_off, 1024, scr, F.lane); continue; }
                r -= 2 * I_G;
                { const int e = r / 128, kb = (r % 128) / 16, nb = r % 16; transpose_item(w_down + (size_t)e * 512 * 1024, 1024, 64 * kb, 64 * nb, WD, (size_t)e * 1024, 512, scr, F.lane); } }
            __syncthreads();
        }
        const int c = F.vcu, b = c >> 6, lane = F.lane, w = F.wave, r = lane & 15, q = lane >> 4;
        LAS float* A2 = (LAS float*)F.lds; LAS float* B2 = A2 + 1024; LAS float* LG = (LAS float*)(F.lds + 8192) + w * 768;
        LAS unsigned* hist = (LAS unsigned*)(F.lds + 8192 + 8 * 3072); LAS unsigned* basev = hist + 32;
        for (int k = F.tid; k < 1024; k += NWAVES * 64) { A2[k] = norm2_g[k] * (1.0f + MOD[b * 6144 + 4096 + k]); B2[k] = MOD[b * 6144 + 3072 + k]; }
        if (F.tid < 32) hist[F.tid] = 0u;
        __syncthreads();
        const size_t row = (size_t)c * 128 + w * 16 + r;
        float rs;
        { const f32x4* sp = (const f32x4*)(SSQ + row * 16); const f32x4 s0 = sp[0], s1 = sp[1], s2 = sp[2], s3 = sp[3];
          const float ss = ((s0[0] + s0[1]) + (s0[2] + s0[3])) + ((s1[0] + s1[1]) + (s1[2] + s1[3])) + ((s2[0] + s2[1]) + (s2[2] + s2[3])) + ((s3[0] + s3[1]) + (s3[2] + s3[3]));
          rs = 1.0f / sqrtf(ss * (1.0f / DM) + EPS); }
        f32x4 acc[3];
#pragma unroll
        for (int jt = 0; jt < 3; ++jt) acc[jt] = (f32x4){0.f, 0.f, 0.f, 0.f};
        const bf16_t* xrow = X1 + row * DM;
#pragma unroll 2
        for (int s = 0; s < 32; ++s) { const int k0 = 32 * s + 8 * q;
            const u32x4 xr = *(const u32x4*)(xrow + k0);
            const f32x4 x0 = {bflo(xr.x), bfhi(xr.x), bflo(xr.y), bfhi(xr.y)}, x1v = {bflo(xr.z), bfhi(xr.z), bflo(xr.w), bfhi(xr.w)};
            const f32x4 a0 = *(const LAS f32x4*)(A2 + k0), a1 = *(const LAS f32x4*)(A2 + k0 + 4), b0 = *(const LAS f32x4*)(B2 + k0), b1 = *(const LAS f32x4*)(B2 + k0 + 4);
            const f32x4 h0 = x0 * rs * a0 + b0, h1 = x1v * rs * a1 + b1;
            u32x4 hw; hw.x = cvt_pk_bf16(h0[0], h0[1]); hw.y = cvt_pk_bf16(h0[2], h0[3]); hw.z = cvt_pk_bf16(h1[0], h1[1]); hw.w = cvt_pk_bf16(h1[2], h1[3]);
            *(u32x4*)(XN + row * DM + k0) = hw;
            u32x4 lw; lw.x = cvt_pk_bf16(h0[0] - bflo(hw.x), h0[1] - bfhi(hw.x)); lw.y = cvt_pk_bf16(h0[2] - bflo(hw.y), h0[3] - bfhi(hw.y));
            lw.z = cvt_pk_bf16(h1[0] - bflo(hw.z), h1[1] - bfhi(hw.z)); lw.w = cvt_pk_bf16(h1[2] - bflo(hw.w), h1[3] - bfhi(hw.w));
            const bf16x8 hb = __builtin_bit_cast(bf16x8, hw), hl = __builtin_bit_cast(bf16x8, lw);
#pragma unroll
            for (int jt = 0; jt < 3; ++jt) { const bf16x8 wf = *(const bf16x8*)(WRT + (size_t)(16 * jt + r) * 1024 + k0), wl = *(const bf16x8*)(WRT + 48 * 1024 + (size_t)(16 * jt + r) * 1024 + k0);
                acc[jt] = __builtin_amdgcn_mfma_f32_16x16x32_bf16(wf, hb, acc[jt], 0, 0, 0);
                acc[jt] = __builtin_amdgcn_mfma_f32_16x16x32_bf16(wf, hl, acc[jt], 0, 0, 0);
                acc[jt] = __builtin_amdgcn_mfma_f32_16x16x32_bf16(wl, hb, acc[jt], 0, 0, 0); } }
#pragma unroll
        for (int jt = 0; jt < 3; ++jt) *(LAS f32x4*)(LG + r * 48 + 16 * jt + 4 * q) = acc[jt];
        LDS_WAIT(); asm volatile("" ::: "memory");
        int E0 = 0, E1 = 0; float w0 = 0.f, w1 = 0.f; unsigned lp0 = 0u, lp1 = 0u;
        if (lane < 16) {
            const LAS float* lgp = LG + lane * 48;
            float gl[4];
#pragma unroll
            for (int j = 0; j < 4; ++j) gl[j] = lgp[j] + b_rg[j];
            int g = 0; float gm = gl[0];
#pragma unroll
            for (int j = 1; j < 4; ++j) if (gl[j] > gm) { gm = gl[j]; g = j; }
            float gs = 0.f;
#pragma unroll
            for (int j = 0; j < 4; ++j) gs += __expf(gl[j] - gm);
            const float gp = 1.0f / gs;
            float m0 = -INFINITY, m1 = -INFINITY; int i0 = 0, i1 = 0;
#pragma unroll
            for (int j = 0; j < 8; ++j) { const float el = lgp[4 + 8 * g + j] + b_re[g * 8 + j];
                if (el > m0) { m1 = m0; i1 = i0; m0 = el; i0 = j; } else if (el > m1) { m1 = el; i1 = j; } }
            const float d = __expf(m1 - m0), inv = 1.0f / (1.0f + d);
            w0 = gp * inv; w1 = gp * d * inv; E0 = 8 * g + i0; E1 = 8 * g + i1;
            lp0 = __hip_atomic_fetch_add(hist + E0, 1u, __ATOMIC_RELAXED, __HIP_MEMORY_SCOPE_WORKGROUP);
            lp1 = __hip_atomic_fetch_add(hist + E1, 1u, __ATOMIC_RELAXED, __HIP_MEMORY_SCOPE_WORKGROUP);
        }
        __syncthreads();
        if (F.tid < 32) { const unsigned n = hist[F.tid]; basev[F.tid] = n ? __hip_atomic_fetch_add((unsigned*)(F.ctl + CW_CURSOR + 64 * F.tid), n, RLX_AGENT) : 0u; }
        __syncthreads();
        if (lane < 16) { const unsigned tok = (unsigned)(c * 128 + w * 16 + lane);
            ROUTE[(size_t)E0 * 32768 + basev[E0] + lp0] = ((unsigned long long)__float_as_uint(w0) << 32) | (unsigned long long)(2u * tok);
            ROUTE[(size_t)E1 * 32768 + basev[E1] + lp1] = ((unsigned long long)__float_as_uint(w1) << 32) | (unsigned long long)(2u * tok + 1u); }
        __syncthreads();
    }
    SEAM(6);

    if (IN(7) || IN(8)) { PHASE_IDS();
        volatile LAS int* tab = (volatile LAS int*)(F.lds + MISC_OFF + 256);
        if (F.tid < 32) tab[F.tid] = (int)__hip_atomic_load((unsigned*)(F.ctl + CW_CURSOR + 64 * F.tid), RLX_AGENT);
        __syncthreads();
        if (F.tid == 0) { int o = 0; for (int e = 0; e < 32; ++e) { tab[32 + e] = o; o += (tab[e] + 255) >> 8; } tab[64] = o; }
        __syncthreads();
        const int U = 4 * __builtin_amdgcn_readfirstlane(tab[64]);
        const int xq = F.vcu >> 5, jj = F.vcu & 31;
        pg8::MoeSched S; S.tab = tab; S.start = (int)(((long)U * xq) / 8); S.end = (int)(((long)U * (xq + 1)) / 8); S.j = jj; S.route = ROUTE; S.ready = (unsigned*)(F.ctl + CW_READY);
        if (IN(7)) {
            S.A = (const char*)XN; S.lda = DM; S.K = DM; S.Bt = (const char*)WGU; S.bstride = (size_t)1024 * 1024 * 2; S.gather = true; S.mode = 1;
            pg8::EpiGU E{HID};
            pg8::gemm_phase<pg8::EpiGU, pg8::MoeSched, true>(F.lds, S, E);
        }
        if (IN(8)) {
            S.A = (const char*)HID; S.lda = DEXP; S.K = DEXP; S.Bt = (const char*)WD; S.bstride = (size_t)1024 * 512 * 2; S.gather = false; S.mode = 2; S.j = (jj + 24) & 31;
            pg8::EpiDown E{YB, ROUTE};
            pg8::gemm_phase<pg8::EpiDown, pg8::MoeSched, false>(F.lds, S, E);
        }
    }
    SEAM(8);

    if (IN(9)) { PHASE_IDS();
        const int c = F.vcu, b = c >> 6;
        f32x4 G2[4], FG[4];
#pragma unroll
        for (int j = 0; j < 4; ++j) { const int k = 4 * F.lane + 256 * j; G2[j] = *(const f32x4*)(MOD + b * 6144 + 5120 + k); FG[j] = *(const f32x4*)(final_g + k); }
        for (int i0 = 0; i0 < 16; i0 += 4) {
            u32x2 ya[4][4], yb[4][4], xx[4][4]; f32x4 v[4][4]; float ss[4];
#pragma unroll
            for (int u_ = 0; u_ < 4; ++u_) { const size_t row = (size_t)c * 128 + F.wave * 16 + i0 + u_;
                const u32x2* xb = (const u32x2*)(X1 + row * DM) + F.lane; const u32x2* y0 = (const u32x2*)(YB + (2 * row) * DM) + F.lane; const u32x2* y1 = (const u32x2*)(YB + (2 * row + 1) * DM) + F.lane;
#pragma unroll
                for (int j = 0; j < 4; ++j) { ya[u_][j] = y0[64 * j]; yb[u_][j] = y1[64 * j]; xx[u_][j] = xb[64 * j]; } }
#pragma unroll
            for (int u_ = 0; u_ < 4; ++u_) { float s = 0.f;
#pragma unroll
                for (int j = 0; j < 4; ++j) { const u32x2 a = ya[u_][j], bb = yb[u_][j], x_ = xx[u_][j]; const f32x4 ys = {bflo(a.x) + bflo(bb.x), bfhi(a.x) + bfhi(bb.x), bflo(a.y) + bflo(bb.y), bfhi(a.y) + bfhi(bb.y)};
                    const f32x4 xv = {bflo(x_.x), bfhi(x_.x), bflo(x_.y), bfhi(x_.y)};
                    v[u_][j] = xv + G2[j] * ys; s += (v[u_][j].x * v[u_][j].x + v[u_][j].y * v[u_][j].y) + (v[u_][j].z * v[u_][j].z + v[u_][j].w * v[u_][j].w); }
                ss[u_] = s; }
#pragma unroll
            for (int o_ = 1; o_ < 64; o_ <<= 1) {
#pragma unroll
                for (int u_ = 0; u_ < 4; ++u_) ss[u_] += __shfl_xor(ss[u_], o_); }
#pragma unroll
            for (int u_ = 0; u_ < 4; ++u_) { const size_t row = (size_t)c * 128 + F.wave * 16 + i0 + u_; f32x4* xr = (f32x4*)(out + row * DM) + F.lane;
                const float rstd = 1.0f / sqrtf(ss[u_] * (1.0f / DM) + EPS);
#pragma unroll
                for (int j = 0; j < 4; ++j) xr[64 * j] = v[u_][j] * rstd * FG[j]; } }
    }
#undef IN
#undef SEAM
}


#if ATTN_MODE == 2
__global__ void __launch_bounds__(NWAVES * 64, 2) dbg_dense(Args args, int stage) {
    extern __shared__ __attribute__((aligned(16))) unsigned char lds_raw[];
    using namespace attn_body;
    unsigned char* ws = args.ws; bf16_t* PROJ = (bf16_t*)(ws + WS_PROJ); float* KSUM = (float*)(ws + WS_KSUM); gu32* ctl = (gu32*)(ws + WS_CTL);
    const int G = gridDim.x, bx = blockIdx.x, vcu = (bx % 8) * (G / 8) + bx / 8, tid = threadIdx.x, lane = tid & 63, wave = tid >> 6;
    if (stage == 0) {
        const int s = vcu & 7, bh = vcu >> 3;
        for (int i = 0; i < 4; ++i) { const int qb = (i == 0) ? s : (i == 1) ? 15 - s : (i == 2) ? 16 + s : 31 - s;
            attn_unit<8, false>(bh >> 3, bh & 7, qb, (const bf16*)(PROJ + C_Q), (const bf16*)(PROJ + C_K), (const bf16*)(PROJ + C_VV), (bf16*)(PROJ + C_Q), KSUM, (char*)lds_raw, true, nullptr, nullptr); }
    } else {
        float md = 0.f;
        for (int i = 0; i < 16; ++i) { const size_t row = (size_t)vcu * 128 + wave * 16 + i;
            const u32x4 a = *(const u32x4*)(PROJ + row * PC + C_V + 8 * lane), bq = *(const u32x4*)(PROJ + row * PC + C_Q + 8 * lane);
            md = fmaxf(md, fmaxf(fmaxf(fabsf(bflo(a.x) - bflo(bq.x)), fabsf(bfhi(a.x) - bfhi(bq.x))), fmaxf(fabsf(bflo(a.y) - bflo(bq.y)), fabsf(bfhi(a.y) - bfhi(bq.y)))));
            md = fmaxf(md, fmaxf(fmaxf(fabsf(bflo(a.z) - bflo(bq.z)), fabsf(bfhi(a.z) - bfhi(bq.z))), fmaxf(fabsf(bflo(a.w) - bflo(bq.w)), fabsf(bfhi(a.w) - bfhi(bq.w))))); }
#pragma unroll
        for (int o_ = 1; o_ < 64; o_ <<= 1) md = fmaxf(md, __shfl_xor(md, o_));
        if (lane == 0) atomicMax((unsigned*)(ctl + CW_DIFF), __float_as_uint(md));
    }
}
#endif
extern "C" void kernel_launch(void* const* d_in, const int* in_sizes, int n_in, void* d_out, int out_size, void* d_ws, size_t ws_size, hipStream_t stream) {
    static int grid = 0;
    if (grid == 0) {
        if (n_in != 22 || in_sizes[0] != T * DM || out_size != T * DM || ws_size < WS_END) { fprintf(stderr, "kernel_launch: unexpected shapes (n_in %d, in0 %d, out %d, ws %zu); nothing launched\n", n_in, n_in > 0 ? in_sizes[0] : -1, out_size, ws_size); grid = -1; return; }
        int dev = 0, cus = 0, per_cu = 0;
        if (hipGetDevice(&dev) != hipSuccess || hipDeviceGetAttribute(&cus, hipDeviceAttributeMultiprocessorCount, dev) != hipSuccess) { fprintf(stderr, "kernel_launch: device query failed\n"); grid = -1; return; }
        if (hipFuncSetAttribute((const void*)hybrid_fwd, hipFuncAttributeMaxDynamicSharedMemorySize, LDS_BYTES) != hipSuccess) { fprintf(stderr, "kernel_launch: hipFuncSetAttribute failed\n"); grid = -1; return; }
        if (hipOccupancyMaxActiveBlocksPerMultiprocessor(&per_cu, (const void*)hybrid_fwd, NWAVES * 64, LDS_BYTES) != hipSuccess || per_cu < 1) { fprintf(stderr, "kernel_launch: occupancy query reports %d blocks per CU\n", per_cu); }
        (void)hipGetLastError();
        if (cus != 256) { fprintf(stderr, "kernel_launch: built for 256 CUs, device has %d; nothing launched\n", cus); grid = -1; return; }
        grid = cus;
    }
    if (grid < 0) return;
    (void)hipMemsetAsync((char*)d_ws + WS_CTL, 0, CTL_ZERO_BYTES, stream);
    Args a{};
    for (int i = 0; i < 22; ++i) a.in[i] = (const float*)d_in[i];
    a.out = (float*)d_out; a.ws = (unsigned char*)d_ws;
    struct Spec { int lo, hi, flags; };
#if MK_PER_PHASE
    const Spec specs[10] = {{0,1,0},{1,2,0},{2,3,0},{3,4,0},{4,5,0},{5,6,0},{6,7,0},{7,8,0},{8,9,0},{9,10,0}}; const int nspec = 10;
#elif PROBE_ID == 1
    const Spec specs[2] = {{0,10,0},{0,2,0}}; const int nspec = 2;
#elif PROBE_ID == 2
    const Spec specs[2] = {{0,10,0},{2,3,0}}; const int nspec = 2;
#elif PROBE_ID == 3
    const Spec specs[3] = {{0,4,0},{3,4,1|2|4|16},{4,10,0}}; const int nspec = 3;
#elif PROBE_ID == 10
    const Spec specs[3] = {{0,4,0},{3,4,1|2|4|8},{4,10,0}}; const int nspec = 3;
#elif PROBE_ID == 11
    const Spec specs[3] = {{0,4,0},{3,4,1|2|8|16},{4,10,0}}; const int nspec = 3;
#elif PROBE_ID == 12
    const Spec specs[3] = {{0,4,0},{3,4,1|2|4|8|16},{4,10,0}}; const int nspec = 3;
#elif PROBE_ID == 13
    const Spec specs[2] = {{0,10,0},{3,4,1|4|8|16}}; const int nspec = 2;
#elif PROBE_ID == 4
    const Spec specs[3] = {{0,4,0},{4,5,0},{4,10,0}}; const int nspec = 3;
#elif PROBE_ID == 5
    const Spec specs[3] = {{0,5,0},{5,6,0},{5,10,0}}; const int nspec = 3;
#elif PROBE_ID == 6
    const Spec specs[2] = {{0,10,0},{7,8,0}}; const int nspec = 2;
#elif PROBE_ID == 7
    const Spec specs[2] = {{0,10,0},{8,9,0}}; const int nspec = 2;
#elif PROBE_ID == 14
    const Spec specs[2] = {{0,10,0},{7,9,0}}; const int nspec = 2;
#elif PROBE_ID == 15
    const Spec specs[2] = {{0,10,0},{9,10,0}}; const int nspec = 2;
#elif PROBE_ID == 16
    const Spec specs[2] = {{0,10,0},{6,7,0}}; const int nspec = 2;
#elif PROBE_ID == 8
    const Spec specs[2] = {{0,5,0},{5,10,0}}; const int nspec = 2;
#elif PROBE_ID == 9
    const Spec specs[2] = {{0,10,0},{0,1,0}}; const int nspec = 2;
#else
    const Spec specs[1] = {{0,10,0}}; const int nspec = 1;
#endif
#if ATTN_MODE == 2
    (void)hipFuncSetAttribute((const void*)dbg_dense, hipFuncAttributeMaxDynamicSharedMemorySize, LDS_BYTES);
    a.ph_lo = 0; a.ph_hi = 4; a.flags = 0; a.li = 0; hipLaunchKernelGGL(hybrid_fwd, dim3(grid), dim3(NWAVES * 64), LDS_BYTES, stream, a);
    hipLaunchKernelGGL(dbg_dense, dim3(grid), dim3(NWAVES * 64), LDS_BYTES, stream, a, 0);
    hipLaunchKernelGGL(dbg_dense, dim3(grid), dim3(NWAVES * 64), LDS_BYTES, stream, a, 1);
    a.ph_lo = 4; a.ph_hi = 10; a.li = 1; hipLaunchKernelGGL(hybrid_fwd, dim3(grid), dim3(NWAVES * 64), LDS_BYTES, stream, a);
    (void)nspec; (void)specs;
#else
    for (int li = 0; li < nspec; ++li) { a.ph_lo = specs[li].lo; a.ph_hi = specs[li].hi; a.flags = specs[li].flags; a.li = MK_PER_PHASE ? 0 : li;
        hipLaunchKernelGGL(hybrid_fwd, dim3(grid), dim3(NWAVES * 64), LDS_BYTES, stream, a); }
#endif
    const hipError_t le = hipPeekAtLastError();
    if (le != hipSuccess) fprintf(stderr, "kernel_launch: launch failed: %s\n", hipGetErrorName(le));
}
```

```cpp
#include <hip/hip_runtime.h>
#include <hip/hip_bf16.h>
#include <cstdio>
#include <cstdint>
#include <cmath>

#ifndef PROBE_ID
#define PROBE_ID 0
#endif
#ifndef ATTN_MODE
#define ATTN_MODE 1
#endif
#ifndef GPROBE
#define GPROBE 0
#endif
#ifndef MK_PER_PHASE
#define MK_PER_PHASE 0
#endif

#define LAS __attribute__((address_space(3)))
#define GAS __attribute__((address_space(1)))
typedef unsigned short bf16_t;
typedef short bf16x8 __attribute__((ext_vector_type(8)));
typedef short s16x4 __attribute__((ext_vector_type(4)));
typedef float f32x2 __attribute__((ext_vector_type(2)));
typedef float f32x4 __attribute__((ext_vector_type(4)));
typedef float f32x16 __attribute__((ext_vector_type(16)));
typedef unsigned u32x2 __attribute__((ext_vector_type(2)));
typedef unsigned u32x4 __attribute__((ext_vector_type(4)));
typedef GAS unsigned gu32;

constexpr int NB = 4, SEQ = 8192, DM = 1024, T = NB * SEQ;
constexpr int PC = 4608;
constexpr int C_U = 0, C_V = 512, C_Q = 1024, C_K = 1536, C_VV = 2048, C_GA = 2560, C_GB = 3584;
constexpr int NEXP = 32, DEXP = 512;
constexpr float EPS = 1e-6f;
constexpr float QSCALE = 0.125f * 1.4426950408889634f;

constexpr size_t MiB = 1u << 20;
constexpr size_t WS_CTL = 0, CTL_ZERO_BYTES = 2 * MiB;
constexpr size_t WS_KSUM = 1 * MiB;
constexpr size_t WS_MODP = 2 * MiB;
constexpr size_t WS_MOD = 3 * MiB + 512 * 1024;
constexpr size_t WS_ROPE = 4 * MiB;
constexpr size_t WS_WST = 4 * MiB + 512 * 1024;
constexpr size_t WS_WRT = 4 * MiB + 768 * 1024;
constexpr size_t WS_SSQ = 5 * MiB;
constexpr size_t WS_ROUTE = 8 * MiB;
constexpr size_t WS_WIN = 24 * MiB;
constexpr size_t WS_WAB = 34 * MiB, WS_WOUT = 36 * MiB;
constexpr size_t WS_WGU = 40 * MiB;
constexpr size_t WS_WD = 104 * MiB;
constexpr size_t WS_XN = 136 * MiB;
constexpr size_t WS_PROJ = 200 * MiB;
constexpr size_t WS_HID = 200 * MiB;
constexpr size_t WS_Y = 272 * MiB;
constexpr size_t WS_X1 = 400 * MiB;
constexpr size_t WS_PO = 40 * MiB;
constexpr size_t WS_PML = 136 * MiB;
constexpr size_t WS_LIST = 488 * MiB;
constexpr size_t WS_END = 504 * MiB;
constexpr int CW_TMO = 0, CW_DIFF = 2, CW_BAR = 4096, CW_CURSOR = 32768, CW_CNT = 65536, CW_READY = 131072, CW_QHEAD = 160000;

constexpr int RING_BYTES = 131072;
constexpr int LDS_BYTES = 147456;
constexpr int MISC_OFF = LDS_BYTES - 1024;
constexpr int NWAVES = 8;

#define LDS_WAIT() asm volatile("s_waitcnt lgkmcnt(0)" ::: "memory")
#define VM_WAIT() asm volatile("s_waitcnt vmcnt(0)" ::: "memory")
#define RLX_AGENT __ATOMIC_RELAXED, __HIP_MEMORY_SCOPE_AGENT

__device__ __forceinline__ unsigned cvt_pk_bf16(float lo, float hi) { unsigned r; asm volatile("v_cvt_pk_bf16_f32 %0, %1, %2" : "=v"(r) : "v"(lo), "v"(hi)); return r; }
__device__ __forceinline__ float bflo(unsigned u) { return __uint_as_float(u << 16); }
__device__ __forceinline__ float bfhi(unsigned u) { return __uint_as_float(u & 0xffff0000u); }
__device__ __forceinline__ float sigmoidf_(float x) { return __builtin_amdgcn_rcpf(1.0f + __builtin_amdgcn_exp2f(-1.4426950408889634f * x)); }
__device__ __forceinline__ float gelu_tanh(float x) { const float u = x + 0.044715f * x * x * x; return x * __builtin_amdgcn_rcpf(1.0f + __builtin_amdgcn_exp2f(-2.3022081985f * u)); }
__device__ __forceinline__ float wave_sum(float v) {
#pragma unroll
    for (int o = 1; o < 64; o <<= 1) v += __shfl_xor(v, o);
    return v;
}

namespace pg8 {
constexpr int BM = 256, BK = 64, HALF = 128, HTB = HALF * BK * 2, STAGE_BYTES = 8 * HTB, NXCD = 8, WGM = 8;
__host__ __device__ __forceinline__ int lds_byte(int r, int c) { const int st = (r >> 4) * 2 + (c >> 5), rr = r & 15, cc = c & 31, ob = rr * 64 + cc * 2; return st * 1024 + (ob ^ (((ob >> 9) & 1) << 5)); }
__host__ __device__ __forceinline__ void stage_rc(int b, int& R, int& C) { const int st = b / 1024, sb = b % 1024, swz = sb ^ (((sb >> 9) & 1) << 5); R = (st >> 1) * 16 + swz / 64; C = (st & 1) * 32 + (swz % 64) / 2; }
__host__ __device__ __forceinline__ int perm32(int rho) { const int n = rho >> 4, i = rho & 15; return 8 * (i >> 2) + 4 * n + (i & 3); }

struct Unit { int pm, pn, e, lt, nvalid; };

struct DenseSched {
    const char* A; const char* Bt; int lda, K; int nM, nN, nwg, G, c; int ksplit; unsigned kgap;
    __device__ void init(const void* A_, int lda_, const void* Bt_, int K_, int M, int N, int G_, int c_) { A = (const char*)A_; Bt = (const char*)Bt_; lda = lda_; K = K_; nM = M / BM; nN = N / BM; nwg = nM * nN; G = G_; c = c_; ksplit = 1 << 20; kgap = 0u; }
    __device__ __forceinline__ bool next(int i, Unit& u) const {
        const long L = (long)i * G + c; if (L >= nwg) return false;
        int wgid = (int)L; { const int q = nwg / NXCD, r = nwg % NXCD, xcd = wgid % NXCD, off = wgid / NXCD; wgid = (xcd < r ? xcd * (q + 1) : r * (q + 1) + (xcd - r) * q) + off; }
        const int nig = WGM * nN, gid = wgid / nig, fm = gid * WGM, gsz = (nM - fm) < WGM ? (nM - fm) : WGM;
        u.pm = fm + ((wgid % nig) % gsz); u.pn = (wgid % nig) / gsz; u.e = 0; u.lt = 0; u.nvalid = 256; return true;
    }
    __device__ __forceinline__ const char* a_base(const Unit& u) const { return A + (size_t)u.pm * BM * lda * 2; }
    __device__ __forceinline__ const char* b_base(const Unit& u) const { return Bt + (size_t)u.pn * BM * K * 2; }
    __device__ __forceinline__ unsigned gather_off(const Unit&, int, int) const { return 0u; }
    __device__ __forceinline__ void a_ready(const Unit&) const {}
    __device__ __forceinline__ void done(const Unit&) const {}
};
struct MoeSched {
    const char* A; const char* Bt; int lda, K; size_t bstride;
    const unsigned long long* route; bool gather;
    const volatile LAS int* tab;
    int start, end, j; static constexpr int ksplit = 1 << 20; static constexpr unsigned kgap = 0u;
    unsigned* ready; int mode;
    __device__ __forceinline__ void done(const Unit& u) const {
        if (mode == 1) { asm volatile("s_waitcnt vmcnt(0)" ::: "memory");
            if ((threadIdx.x & 63) == 0) __hip_atomic_fetch_add(ready + 64 * u.pm, 1u, __ATOMIC_RELAXED, __HIP_MEMORY_SCOPE_AGENT); } }
    __device__ __forceinline__ void a_ready(const Unit& u) const {
        if (mode == 2) {
            if (threadIdx.x < 64) { unsigned sp = 0;
                while ((unsigned)__builtin_amdgcn_readfirstlane(__hip_atomic_load(ready + 64 * u.pm, __ATOMIC_RELAXED, __HIP_MEMORY_SCOPE_AGENT)) < 32u) { __builtin_amdgcn_s_sleep(2); if (++sp > (1u << 22)) break; }
                __builtin_amdgcn_fence(__ATOMIC_ACQUIRE, "agent");
                asm volatile("s_waitcnt vmcnt(0)" ::: "memory"); }
            asm volatile("" ::: "memory"); __builtin_amdgcn_s_barrier(); asm volatile("" ::: "memory"); } }
    unsigned* qhead; volatile LAS int* qslot;
    __device__ __forceinline__ bool next(int i, Unit& u) const {
        int idx;
        if (mode == 2) {
            if (threadIdx.x == 0) qslot[i & 1] = start + (int)__hip_atomic_fetch_add(qhead, 1u, __ATOMIC_RELAXED, __HIP_MEMORY_SCOPE_AGENT);
            asm volatile("s_waitcnt vmcnt(0) lgkmcnt(0)" ::: "memory"); __builtin_amdgcn_s_barrier(); asm volatile("" ::: "memory");
            idx = __builtin_amdgcn_readfirstlane(qslot[i & 1]);
        } else idx = start + i * 32 + j;
        if (idx >= end) return false;
        const int tile = idx >> 2; u.pn = idx & 3; u.pm = tile;
        int e = 0;
        for (int k = 1; k < 32; ++k) e += (__builtin_amdgcn_readfirstlane(tab[32 + k]) <= tile) ? 1 : 0;
        u.e = e; u.lt = tile - __builtin_amdgcn_readfirstlane(tab[32 + e]);
        const int rem = __builtin_amdgcn_readfirstlane(tab[e]) - 256 * u.lt; u.nvalid = rem < 256 ? rem : 256; return true;
    }
    __device__ __forceinline__ const char* a_base(const Unit& u) const { return gather ? A : A + (size_t)u.pm * BM * lda * 2; }
    __device__ __forceinline__ const char* b_base(const Unit& u) const { return Bt + (size_t)u.e * bstride + (size_t)u.pn * BM * K * 2; }
    __device__ __forceinline__ unsigned gather_off(const Unit& u, int r, int C) const {
        unsigned tok = 0u;
        if (r < u.nvalid) tok = (unsigned)(route[(size_t)u.e * 32768 + (size_t)u.lt * 256 + r] & 0xffffffffull) >> 1;
        return (tok * (unsigned)lda + (unsigned)C) * 2u;
    }
};

template <class Epi, class Sched, bool GATHER>
__device__ __forceinline__ void gemm_phase(LAS unsigned char* lds, const Sched& S, const Epi& E) {
    const int tid = threadIdx.x, wid = __builtin_amdgcn_readfirstlane(tid >> 6), lane = tid & 63, wr = wid >> 2, wc = wid & 3, fr = lane & 15, fq = lane >> 4;
    const int K = S.K, lda = S.lda, nt = K / BK;
    unsigned voffA[2], voffB[2]; int RA[2], CA[2];
#pragma unroll
    for (int i = 0; i < 2; ++i) { int R, C; stage_rc(tid * 16 + i * 8192, R, C); const int Rb = Epi::PERM ? ((R & ~31) + perm32(R & 31)) : R;
        RA[i] = R; CA[i] = C; voffA[i] = (unsigned)(R * lda + C) * 2u; voffB[i] = (unsigned)(Rb * K + C) * 2u; }
    const size_t kstep = (size_t)(BK * 2);
    const unsigned hstepA = (unsigned)HALF * (unsigned)lda * 2u;
    const size_t hstepB = (size_t)HALF * K * 2;
    const unsigned ldsw = (unsigned)wid * 1024u;
    const int aoff = lds_byte(wr * 64 + fr, fq * 8), boff = lds_byte(wc * 32 + fr, fq * 8);
    unsigned og[2][2] = {{0u, 0u}, {0u, 0u}}, ogn[2][2] = {{0u, 0u}, {0u, 0u}};
#define PG8_SA(b, h) (((b) * 2 + (h)) * HTB)
#define PG8_SB(b, h) ((4 + (b) * 2 + (h)) * HTB)
#define PG8_STAGE_B(bufoff, gbase) do { _Pragma("unroll") for (int _i = 0; _i < 2; ++_i) \
        __builtin_amdgcn_global_load_lds((const unsigned*)((const char*)(gbase) + voffB[_i]), (LAS unsigned*)(lds + (bufoff) + ldsw + _i * 8192), 16, 0, 0); } while (0)
#define PG8_STAGE_A(bufoff, gbase, h) do { _Pragma("unroll") for (int _i = 0; _i < 2; ++_i) \
        __builtin_amdgcn_global_load_lds((const unsigned*)((const char*)(gbase) + (GATHER ? og[h][_i] : voffA[_i] + (h) * hstepA)), (LAS unsigned*)(lds + (bufoff) + ldsw + _i * 8192), 16, 0, 0); } while (0)
#define PG8_LDA(dst, b, h) do { _Pragma("unroll") for (int m = 0; m < 4; ++m) _Pragma("unroll") for (int k = 0; k < 2; ++k) dst[m][k] = *(const LAS bf16x8*)(lds + PG8_SA(b, h) + aoff + m * 2048 + k * 1024); } while (0)
#define PG8_LDB(dst, b, h) do { _Pragma("unroll") for (int n = 0; n < 2; ++n) _Pragma("unroll") for (int k = 0; k < 2; ++k) dst[n][k] = *(const LAS bf16x8*)(lds + PG8_SB(b, h) + boff + n * 2048 + k * 1024); } while (0)
#define PG8_MMA(ai, bj, At, Bt) do { __builtin_amdgcn_s_setprio(1); _Pragma("unroll") for (int m = 0; m < 4; ++m) _Pragma("unroll") for (int n = 0; n < 2; ++n) _Pragma("unroll") for (int k = 0; k < 2; ++k) \
        acc[ai][bj][m][n] = __builtin_amdgcn_mfma_f32_16x16x32_bf16(Bt[n][k], At[m][k], acc[ai][bj][m][n], 0, 0, 0); __builtin_amdgcn_s_setprio(0); } while (0)
#define PG8_WAIT_V(n) asm volatile("s_waitcnt vmcnt(" #n ")" ::: "memory")
#define PG8_WAIT_L(n) asm volatile("s_waitcnt lgkmcnt(" #n ")" ::: "memory")
#define PG8_BAR __builtin_amdgcn_s_barrier()
#define PG8_SCHED __builtin_amdgcn_sched_barrier(0)
    Unit cur, nxt; int ui = 0;
    if (!S.next(0, cur)) return;
    f32x4 acc[2][2][4][2];
#pragma unroll
    for (int a = 0; a < 2; ++a)
#pragma unroll
        for (int b = 0; b < 2; ++b)
#pragma unroll
            for (int m = 0; m < 4; ++m)
#pragma unroll
                for (int n = 0; n < 2; ++n) acc[a][b][m][n] = (f32x4){0.f, 0.f, 0.f, 0.f};
    bf16x8 At[4][2], B0[2][2], B1[2][2];
    const char* cA = S.a_base(cur); const char* cB = S.b_base(cur);
    S.a_ready(cur);
    if constexpr (GATHER) {
#pragma unroll
        for (int h = 0; h < 2; ++h)
#pragma unroll
            for (int i = 0; i < 2; ++i) og[h][i] = S.gather_off(cur, h * HALF + RA[i], CA[i]);
    }
    PG8_STAGE_B(PG8_SB(0, 0), cB); PG8_STAGE_B(PG8_SB(0, 1), cB + hstepB); PG8_STAGE_A(PG8_SA(0, 0), cA, 0); PG8_STAGE_A(PG8_SA(0, 1), cA, 1);
    if (wr == 1) PG8_BAR;
    PG8_WAIT_V(2); PG8_BAR;
    PG8_STAGE_B(PG8_SB(1, 0), cB + kstep); PG8_STAGE_A(PG8_SA(1, 0), cA + kstep, 0); PG8_STAGE_B(PG8_SB(1, 1), cB + hstepB + kstep);
    PG8_WAIT_V(6); PG8_BAR;
    for (;;) {
        const bool has_next = S.next(ui + 1, nxt);
        const char* nA = has_next ? S.a_base(nxt) : cA; const char* nB = has_next ? S.b_base(nxt) : cB;
        if constexpr (GATHER) {
            if (has_next) {
#pragma unroll
                for (int h = 0; h < 2; ++h)
#pragma unroll
                    for (int i = 0; i < 2; ++i) ogn[h][i] = S.gather_off(nxt, h * HALF + RA[i], CA[i]);
            }
        }
        for (int t = 0; t < nt; t += 2) {
            const bool last = (t == nt - 2);
            const char* a1 = cA + (size_t)(t + 1) * kstep + ((t + 1) >= S.ksplit ? S.kgap : 0u);
            const char* a2 = last ? nA : cA + (size_t)(t + 2) * kstep + ((t + 2) >= S.ksplit ? S.kgap : 0u); const char* b2 = last ? nB : cB + (size_t)(t + 2) * kstep;
            const char* a3 = last ? nA + kstep : cA + (size_t)(t + 3) * kstep + ((t + 3) >= S.ksplit ? S.kgap : 0u); const char* b3 = b2 + kstep;
            if (last && has_next) S.a_ready(nxt);
            if constexpr (Epi::HAS_MID) { if (t == S.ksplit) E.mid(acc, cur, wr, wc, fr, fq); }
            PG8_LDB(B0, 0, 0); PG8_LDB(B1, 0, 1); PG8_SCHED; PG8_LDA(At, 0, 0); PG8_STAGE_A(PG8_SA(1, 1), a1, 1);
            if constexpr (GATHER) { if (last && has_next) {
#pragma unroll
                for (int h = 0; h < 2; ++h)
#pragma unroll
                    for (int i = 0; i < 2; ++i) og[h][i] = ogn[h][i]; } }
            PG8_WAIT_V(8); PG8_WAIT_L(0); PG8_BAR; PG8_MMA(0, 0, At, B0); PG8_MMA(0, 1, At, B1); PG8_BAR; PG8_SCHED;
            PG8_LDA(At, 0, 1); PG8_STAGE_B(PG8_SB(0, 0), b2); PG8_STAGE_B(PG8_SB(0, 1), b2 + hstepB); PG8_STAGE_A(PG8_SA(0, 0), a2, 0);
            PG8_WAIT_V(8); PG8_WAIT_L(0); PG8_BAR; PG8_MMA(1, 0, At, B0); PG8_MMA(1, 1, At, B1); PG8_BAR; PG8_SCHED;
            PG8_LDB(B0, 1, 0); PG8_LDB(B1, 1, 1); PG8_SCHED; PG8_LDA(At, 1, 0); PG8_STAGE_A(PG8_SA(0, 1), a2, 1);
            PG8_WAIT_V(8); PG8_WAIT_L(0); PG8_BAR; PG8_MMA(0, 0, At, B0); PG8_MMA(0, 1, At, B1); PG8_BAR; PG8_SCHED;
            PG8_LDA(At, 1, 1); PG8_STAGE_B(PG8_SB(1, 0), b3); PG8_STAGE_B(PG8_SB(1, 1), b3 + hstepB); PG8_STAGE_A(PG8_SA(1, 0), a3, 0);
            PG8_WAIT_V(8); PG8_WAIT_L(0); PG8_BAR; PG8_MMA(1, 0, At, B0); PG8_MMA(1, 1, At, B1); PG8_BAR; PG8_SCHED;
        }
        if (wr == 0) PG8_BAR;
        E(acc, cur, wr, wc, fr, fq); S.done(cur);
        if (!has_next) break;
#pragma unroll
        for (int a = 0; a < 2; ++a)
#pragma unroll
            for (int b = 0; b < 2; ++b)
#pragma unroll
                for (int m = 0; m < 4; ++m)
#pragma unroll
                    for (int n = 0; n < 2; ++n) acc[a][b][m][n] = (f32x4){0.f, 0.f, 0.f, 0.f};
        cur = nxt; cA = nA; cB = nB; ++ui;
        if (wr == 1) PG8_BAR;
    }
    PG8_WAIT_V(0);
    PG8_BAR;
#undef PG8_SA
#undef PG8_SB
#undef PG8_STAGE_A
#undef PG8_STAGE_B
#undef PG8_LDA
#undef PG8_LDB
#undef PG8_MMA
#undef PG8_WAIT_V
#undef PG8_WAIT_L
#undef PG8_BAR
#undef PG8_SCHED
}

struct EpiProj {
    static constexpr bool PERM = true; static constexpr bool HAS_MID = false;
    bf16_t* P; const float* rope; float* ksum;
    __device__ __forceinline__ void operator()(const f32x4 (&acc)[2][2][4][2], const Unit& u, int wr, int wc, int fr_in, int fq) const {
        int fr = fr_in; asm volatile("" : "+v"(fr));
        const int pn = u.pn, row0 = u.pm * BM + wr * 64 + fr, cl = wc * 32 + 8 * fq;
        const int mode = pn < 4 ? 0 : pn < 6 ? 1 : pn < 8 ? 2 : pn < 10 ? 3 : 4;
        const bool rot = (mode == 1 || mode == 2) && ((wc & 1) == 0);
        float ks[2][8];
#pragma unroll
        for (int bj = 0; bj < 2; ++bj)
#pragma unroll
            for (int j = 0; j < 8; ++j) ks[bj][j] = 0.f;
        f32x4 rq[3][4];
#define RP_LOAD(gi, slot) do { if (rot) { const int pos_ = (row0 + ((gi) >> 2) * HALF + ((gi) & 3) * 16) & (SEQ - 1); \
            rq[slot][0] = *(const f32x4*)(rope + pos_ * 8); rq[slot][1] = *(const f32x4*)(rope + pos_ * 8 + 4); rq[slot][2] = *(const f32x4*)(rope + 65536 + pos_ * 8); rq[slot][3] = *(const f32x4*)(rope + 65536 + pos_ * 8 + 4); } } while (0)
        RP_LOAD(0, 0); RP_LOAD(1, 1);
#pragma unroll
        for (int ai = 0; ai < 2; ++ai)
#pragma unroll
            for (int m = 0; m < 4; ++m) {
                const int gi_ = ai * 4 + m;
                if (gi_ + 2 < 8) RP_LOAD(gi_ + 2, (gi_ + 2) % 3);
                const int row = row0 + ai * HALF + m * 16;
                float cs[8], sn[8];
                if (rot) {
#pragma unroll
                    for (int j = 0; j < 4; ++j) { cs[j] = rq[gi_ % 3][0][j]; cs[4 + j] = rq[gi_ % 3][1][j]; sn[j] = rq[gi_ % 3][2][j]; sn[4 + j] = rq[gi_ % 3][3][j]; } }
#pragma unroll
                for (int bj = 0; bj < 2; ++bj) {
                    float v[8];
#pragma unroll
                    for (int j = 0; j < 4; ++j) { v[j] = acc[ai][bj][m][0][j]; v[4 + j] = acc[ai][bj][m][1][j]; }
                    if (mode == 1 || mode == 2) {
                        if (rot) {
                            const float sg = (fq == 0) ? -1.f : 1.f; const bool ap = fq < 2;
#pragma unroll
                            for (int j = 0; j < 8; ++j) {
                                const auto sw = __builtin_amdgcn_permlane16_swap(__float_as_uint(v[j]), __float_as_uint(v[j]), false, false);
                                const float o = __uint_as_float((fq & 1) ? sw[0] : sw[1]); const float r = v[j] * cs[j] + sg * o * sn[j]; v[j] = ap ? r : v[j]; }
                        }
                        if (mode == 1) {
#pragma unroll
                            for (int j = 0; j < 8; ++j) v[j] *= QSCALE;
                        } else {
#pragma unroll
                            for (int j = 0; j < 8; ++j) ks[bj][j] += v[j];
                        }
                    }
                    u32x4 w; w.x = cvt_pk_bf16(v[0], v[1]); w.y = cvt_pk_bf16(v[2], v[3]); w.z = cvt_pk_bf16(v[4], v[5]); w.w = cvt_pk_bf16(v[6], v[7]);
                    *(u32x4*)(P + (size_t)row * PC + pn * BM + bj * HALF + cl) = w;
                }
            }
#undef RP_LOAD
        if (mode == 2) {
#pragma unroll
            for (int bj = 0; bj < 2; ++bj)
#pragma unroll
                for (int j = 0; j < 8; ++j) { float s = ks[bj][j]; s += __shfl_xor(s, 1); s += __shfl_xor(s, 2); s += __shfl_xor(s, 4); s += __shfl_xor(s, 8); ks[bj][j] = s; }
            if (fr == 0) {
                const int b = u.pm >> 5, kb = u.pm & 31;
#pragma unroll
                for (int bj = 0; bj < 2; ++bj) { const int ck = (pn - 6) * BM + bj * HALF + cl; const int h = ck >> 6, d = ck & 63;
                    float* dst = ksum + ((size_t)((b * 8 + h) * 32 + kb)) * 64 + d;
#pragma unroll
                    for (int j = 0; j < 8; ++j) atomicAdd(dst + j, ks[bj][j]); }
            }
        }
    }
};
struct EpiMergeF {
    static constexpr bool PERM = true; static constexpr bool HAS_MID = true;
    const bf16_t* P; bf16_t* MG;
    __device__ __forceinline__ void mid(f32x4 (&acc)[2][2][4][2], const Unit& u, int wr, int wc, int fr_in, int fq) const {
        int fr = fr_in; asm volatile("" : "+v"(fr));
        const int row0 = u.pm * BM + wr * 64 + fr, col0 = u.pn * BM + wc * 32 + 8 * fq;
#pragma unroll
        for (int g4 = 0; g4 < 8; g4 += 4) {
            u32x4 ga[4][2], gb[4][2];
#pragma unroll
            for (int k = 0; k < 4; ++k) { const int gi = g4 + k, row = row0 + (gi >> 2) * HALF + (gi & 3) * 16;
#pragma unroll
                for (int bj = 0; bj < 2; ++bj) { ga[k][bj] = *(const u32x4*)(P + (size_t)row * PC + C_GA + col0 + bj * HALF); gb[k][bj] = *(const u32x4*)(P + (size_t)row * PC + C_GB + col0 + bj * HALF); } }
#pragma unroll
            for (int k = 0; k < 4; ++k) { const int gi = g4 + k, ai = gi >> 2, m = gi & 3;
#pragma unroll
                for (int bj = 0; bj < 2; ++bj) {
#define RHO(a_, b_) ((1.0f + __builtin_amdgcn_exp2f(-1.4426950408889634f * fmaxf(b_, -60.f))) * sigmoidf_(a_))
                    const u32x4 A_ = ga[k][bj], B_ = gb[k][bj];
                    acc[ai][bj][m][0][0] *= RHO(bflo(A_.x), bflo(B_.x)); acc[ai][bj][m][0][1] *= RHO(bfhi(A_.x), bfhi(B_.x)); acc[ai][bj][m][0][2] *= RHO(bflo(A_.y), bflo(B_.y)); acc[ai][bj][m][0][3] *= RHO(bfhi(A_.y), bfhi(B_.y));
                    acc[ai][bj][m][1][0] *= RHO(bflo(A_.z), bflo(B_.z)); acc[ai][bj][m][1][1] *= RHO(bfhi(A_.z), bfhi(B_.z)); acc[ai][bj][m][1][2] *= RHO(bflo(A_.w), bflo(B_.w)); acc[ai][bj][m][1][3] *= RHO(bfhi(A_.w), bfhi(B_.w));
#undef RHO
                } }
        }
    }
    __device__ __forceinline__ void operator()(const f32x4 (&acc)[2][2][4][2], const Unit& u, int wr, int wc, int fr_in, int fq) const {
        int fr = fr_in; asm volatile("" : "+v"(fr));
        const int row0 = u.pm * BM + wr * 64 + fr, col0 = u.pn * BM + wc * 32 + 8 * fq;
        u32x4 gq[3][2];
#define EM_LOAD(gi, slot) do { const int row_ = row0 + ((gi) >> 2) * HALF + ((gi) & 3) * 16; \
            _Pragma("unroll") for (int bj = 0; bj < 2; ++bj) gq[slot][bj] = *(const u32x4*)(P + (size_t)row_ * PC + C_GB + col0 + bj * HALF); } while (0)
        EM_LOAD(0, 0); EM_LOAD(1, 1);
#pragma unroll
        for (int gi = 0; gi < 8; ++gi) {
            if (gi + 2 < 8) EM_LOAD(gi + 2, (gi + 2) % 3);
            asm volatile("" ::: "memory");
            const int ai = gi >> 2, m = gi & 3, row = row0 + ai * HALF + m * 16;
#pragma unroll
            for (int bj = 0; bj < 2; ++bj) { const u32x4 g = gq[gi % 3][bj];
                float v[8];
#pragma unroll
                for (int j = 0; j < 4; ++j) { v[j] = acc[ai][bj][m][0][j]; v[4 + j] = acc[ai][bj][m][1][j]; }
#define SGB(x_) sigmoidf_(fmaxf(x_, -60.f))
                v[0] *= SGB(bflo(g.x)); v[1] *= SGB(bfhi(g.x)); v[2] *= SGB(bflo(g.y)); v[3] *= SGB(bfhi(g.y)); v[4] *= SGB(bflo(g.z)); v[5] *= SGB(bfhi(g.z)); v[6] *= SGB(bflo(g.w)); v[7] *= SGB(bfhi(g.w));
#undef SGB
                u32x4 w; w.x = cvt_pk_bf16(v[0], v[1]); w.y = cvt_pk_bf16(v[2], v[3]); w.z = cvt_pk_bf16(v[4], v[5]); w.w = cvt_pk_bf16(v[6], v[7]);
                *(u32x4*)(MG + (size_t)row * DM + col0 + bj * HALF) = w; }
        }
#undef EM_LOAD
    }
};
struct EpiOut {
    static constexpr bool PERM = false; static constexpr bool HAS_MID = false;
    const float* x; bf16_t* x1; const float* mod; float* ssq;
    __device__ __forceinline__ void operator()(const f32x4 (&acc)[2][2][4][2], const Unit& u, int wr, int wc, int fr_in, int fq) const {
        int fr = fr_in; asm volatile("" : "+v"(fr));
        const int row0 = u.pm * BM + wr * 64 + fr, col0 = u.pn * BM + wc * 32 + 4 * fq, b = u.pm >> 5;
        f32x4 xq[3][2][2];
#define EO_LOAD(gi, slot) do { const size_t off_ = (size_t)(row0 + ((gi) >> 2) * HALF + ((gi) & 3) * 16) * DM + col0; \
            _Pragma("unroll") for (int bj = 0; bj < 2; ++bj) _Pragma("unroll") for (int n = 0; n < 2; ++n) xq[slot][bj][n] = *(const f32x4*)(x + off_ + bj * HALF + n * 16); } while (0)
        EO_LOAD(0, 0); EO_LOAD(1, 1);
        f32x4 g1[2][2];
#pragma unroll
        for (int bj = 0; bj < 2; ++bj)
#pragma unroll
            for (int n = 0; n < 2; ++n) g1[bj][n] = *(const f32x4*)(mod + b * 6144 + 2048 + col0 + bj * HALF + n * 16);
#pragma unroll
        for (int gi = 0; gi < 8; ++gi) {
            if (gi + 2 < 8) EO_LOAD(gi + 2, (gi + 2) % 3);
            asm volatile("" ::: "memory");
            const int ai = gi >> 2, m = gi & 3, row = row0 + ai * HALF + m * 16; const size_t off = (size_t)row * DM + col0; float s = 0.f;
#pragma unroll
            for (int bj = 0; bj < 2; ++bj)
#pragma unroll
                for (int n = 0; n < 2; ++n) { const f32x4 o = xq[gi % 3][bj][n] + g1[bj][n] * acc[ai][bj][m][n];
                    u32x2 w; w.x = cvt_pk_bf16(o[0], o[1]); w.y = cvt_pk_bf16(o[2], o[3]);
                    const float r0 = bflo(w.x), r1 = bfhi(w.x), r2 = bflo(w.y), r3 = bfhi(w.y);
                    s += (r0 * r0 + r1 * r1) + (r2 * r2 + r3 * r3); *(u32x2*)(x1 + off + bj * HALF + n * 16) = w; }
            s += __shfl_xor(s, 16); s += __shfl_xor(s, 32);
            if (fq == 0) ssq[(size_t)row * 16 + u.pn * 4 + wc] = s;
        }
#undef EO_LOAD
    }
};
struct EpiGU {
    static constexpr bool PERM = true; static constexpr bool HAS_MID = false;
    bf16_t* H;
    __device__ __forceinline__ void operator()(const f32x4 (&acc)[2][2][4][2], const Unit& u, int wr, int wc, int fr_in, int fq) const {
        int fr = fr_in; asm volatile("" : "+v"(fr));
        const int r0 = wr * 64 + fr, cl = wc * 32 + 8 * fq;
#pragma unroll
        for (int ai = 0; ai < 2; ++ai)
#pragma unroll
            for (int m = 0; m < 4; ++m) { const int r = r0 + ai * HALF + m * 16;
                float v[8];
#pragma unroll
                for (int j = 0; j < 4; ++j) { const float g0 = acc[ai][0][m][0][j], g1 = acc[ai][0][m][1][j]; v[j] = g0 * sigmoidf_(g0) * acc[ai][1][m][0][j]; v[4 + j] = g1 * sigmoidf_(g1) * acc[ai][1][m][1][j]; }
                u32x4 w; w.x = cvt_pk_bf16(v[0], v[1]); w.y = cvt_pk_bf16(v[2], v[3]); w.z = cvt_pk_bf16(v[4], v[5]); w.w = cvt_pk_bf16(v[6], v[7]);
                bf16_t* dst = H + ((size_t)u.pm * BM + r) * DEXP + u.pn * HALF + cl;
                asm volatile("global_store_dwordx4 %0, %1, off sc1\n\ts_nop 1" :: "v"(dst), "v"(w) : "memory"); }
    }
};
struct EpiDown {
    static constexpr bool PERM = true; static constexpr bool HAS_MID = false;
    bf16_t* Y; const unsigned long long* route;
    __device__ __forceinline__ void operator()(const f32x4 (&acc)[2][2][4][2], const Unit& u, int wr, int wc, int fr_in, int fq) const {
        int fr = fr_in; asm volatile("" : "+v"(fr));
        const int r0 = wr * 64 + fr, col0 = u.pn * BM + wc * 32 + 8 * fq;
        const unsigned long long* rt = route + (size_t)u.e * 32768 + (size_t)u.lt * 256;
        unsigned long long ent[8];
#pragma unroll
        for (int gi = 0; gi < 8; ++gi) { const int r = r0 + (gi >> 2) * HALF + (gi & 3) * 16; ent[gi] = (r < u.nvalid) ? rt[r] : 0ull; }
#pragma unroll
        for (int gi = 0; gi < 8; ++gi) { const int ai = gi >> 2, m = gi & 3, r = r0 + ai * HALF + m * 16;
            if (r < u.nvalid) { const unsigned slot = (unsigned)(ent[gi] & 0xffffffffull); const float wt = __uint_as_float((unsigned)(ent[gi] >> 32));
#pragma unroll
                for (int bj = 0; bj < 2; ++bj) { const f32x4 a0 = acc[ai][bj][m][0] * wt, a1 = acc[ai][bj][m][1] * wt;
                    u32x4 w; w.x = cvt_pk_bf16(a0[0], a0[1]); w.y = cvt_pk_bf16(a0[2], a0[3]); w.z = cvt_pk_bf16(a1[0], a1[1]); w.w = cvt_pk_bf16(a1[2], a1[3]);
                    *(u32x4*)(Y + (size_t)slot * DM + col0 + bj * HALF) = w; } } }
    }
};
}

namespace attn_body {
using bf16 = __hip_bfloat16;
constexpr int NHEAD = 8, D = 64, PITCH = PC;
constexpr int NW = 8, QBLK = 32, QB = QBLK * NW, KVBLK = 64;
__device__ __forceinline__ int crow(int r, int hi) { return (r & 3) + 8 * (r >> 2) + 4 * hi; }
#define SBAR() __builtin_amdgcn_sched_barrier(0)
__device__ __forceinline__ void cmask(f32x16& p0, f32x16& p1, int jb, int qrel, int hi) {
    const float NEG = -INFINITY; int kb = 64 * jb + 4 * hi;
#pragma unroll
    for (int r = 0; r < 16; ++r) { int kv = kb + (r & 3) + 8 * (r >> 2); if (kv > qrel) p0[r] = NEG; if (kv + 32 > qrel) p1[r] = NEG; }
}
__device__ __forceinline__ void selapply(f32x16& p0, f32x16& p1, bool ok) {
    const float NEG = -INFINITY;
#pragma unroll
    for (int r = 0; r < 16; ++r) { p0[r] = ok ? p0[r] : NEG; p1[r] = ok ? p1[r] : NEG; }
}
constexpr int NSLOT = 3, SLOTB = 8192;
constexpr int LDS_K = 0, LDS_V = NSLOT * SLOTB, LDS_WS = 2 * NSLOT * SLOTB, LDS_OST = LDS_WS + NW * 64 * 4, LDS_BYTES_A = LDS_OST + NW * 4096;
__device__ __forceinline__ void glds16(const void* gsrc, unsigned lds_dst) { unsigned keep;
    asm volatile("s_mov_b32 %0, m0\n\ts_mov_b32 m0, %2\n\ts_nop 0\n\tglobal_load_lds_dwordx4 %1, off\n\ts_mov_b32 m0, %0" : "=&s"(keep) : "v"(gsrc), "s"(lds_dst) : "memory"); }
__device__ __forceinline__ float max3f(float a, float b, float c) { float r; asm("v_max3_f32 %0, %1, %2, %3" : "=v"(r) : "v"(a), "v"(b), "v"(c)); return r; }
__device__ __forceinline__ float max2f(float a, float b) { float r; asm("v_max_f32_e32 %0, %1, %2" : "=v"(r) : "v"(a), "v"(b)); return r; }
__device__ __forceinline__ float fadd_s(float a, float b) { float r; asm("v_add_f32_e32 %0, %1, %2" : "=v"(r) : "v"(a), "v"(b)); return r; }
__device__ __forceinline__ float fsub_s(float a, float b) { float r; asm("v_sub_f32_e32 %0, %1, %2" : "=v"(r) : "v"(a), "v"(b)); return r; }
typedef __bf16 bf16x2_t __attribute__((ext_vector_type(2)));
__device__ __forceinline__ unsigned cvtpk_s(float lo, float hi) { f32x2 v = {lo, hi}; bf16x2_t b = __builtin_convertvector(v, bf16x2_t); return __builtin_bit_cast(unsigned, b); }
#define WAIT_BAR(N) asm volatile("s_waitcnt vmcnt(" #N ") lgkmcnt(0)\n\ts_barrier" ::: "memory")

__device__ __forceinline__ void qkt(f32x16& p0, f32x16& p1, const char* Kslot, const bf16x8* qr, const f32x16& negm, int r32, int hi) {
    const char* kb = Kslot + hi * 1024 + r32 * 16;
#pragma unroll
    for (int d0 = 0; d0 < 4; ++d0) {
        const bf16x8 b0 = *reinterpret_cast<const bf16x8*>(kb + d0 * 2048);
        const bf16x8 b1 = *reinterpret_cast<const bf16x8*>(kb + d0 * 2048 + 512);
        if (d0 == 0) { p0 = __builtin_amdgcn_mfma_f32_32x32x16_bf16(b0, qr[0], negm, 0, 0, 0); p1 = __builtin_amdgcn_mfma_f32_32x32x16_bf16(b1, qr[0], negm, 0, 0, 0); }
        else { p0 = __builtin_amdgcn_mfma_f32_32x32x16_bf16(b0, qr[d0], p0, 0, 0, 0); p1 = __builtin_amdgcn_mfma_f32_32x32x16_bf16(b1, qr[d0], p1, 0, 0, 0); } }
}
typedef LAS const char* lds_cptr;
typedef short v4i16_t __attribute__((ext_vector_type(4)));
__device__ __forceinline__ void kload8(bf16x8* kf, lds_cptr kp) {
    kf[0] = *(const LAS bf16x8*)(kp);        kf[1] = *(const LAS bf16x8*)(kp + 512);
    kf[2] = *(const LAS bf16x8*)(kp + 2048); kf[3] = *(const LAS bf16x8*)(kp + 2560);
    kf[4] = *(const LAS bf16x8*)(kp + 4096); kf[5] = *(const LAS bf16x8*)(kp + 4608);
    kf[6] = *(const LAS bf16x8*)(kp + 6144); kf[7] = *(const LAS bf16x8*)(kp + 6656);
}
__device__ __forceinline__ void kload2(bf16x8* kf, lds_cptr kp, int j) { kf[2 * j] = *(const LAS bf16x8*)(kp + j * 2048); kf[2 * j + 1] = *(const LAS bf16x8*)(kp + j * 2048 + 512); }
__device__ __forceinline__ s16x4 vtr(lds_cptr p) { return __builtin_bit_cast(s16x4, __builtin_amdgcn_ds_read_tr16_b64_v4i16((LAS v4i16_t*)p)); }
__device__ __forceinline__ float rowmax(const f32x16& p0, const f32x16& p1) {
    float a = max3f(p0[0], p0[1], p1[0]), b = max3f(p0[2], p0[3], p1[1]); a = max3f(a, p1[2], p1[3]);
#pragma unroll
    for (int r = 4; r < 16; r += 4) { a = max3f(a, p0[r], p0[r + 1]); b = max3f(b, p0[r + 2], p0[r + 3]); a = max3f(a, p1[r], p1[r + 1]); b = max3f(b, p1[r + 2], p1[r + 3]); }
    const float m = max2f(a, b);
    auto rr = __builtin_amdgcn_permlane32_swap(__float_as_uint(m), __float_as_uint(m), false, false);
    return max2f(__uint_as_float(rr[0]), __uint_as_float(rr[1]));
}
__device__ __forceinline__ void pv(f32x16* o, int vb, bf16x8 pa0, bf16x8 pa1, bf16x8 pa2, bf16x8 pa3) {
#pragma unroll
    for (int d0 = 0; d0 < 2; ++d0) { s16x4 lo[4], hi[4];
#pragma unroll
        for (int ks = 0; ks < 4; ++ks) {
            asm volatile("ds_read_b64_tr_b16 %0,%1 offset:%c2" : "=&v"(lo[ks]) : "v"(vb), "i"(d0 * 4096 + ks * 1024) : "memory");
            asm volatile("ds_read_b64_tr_b16 %0,%1 offset:%c2" : "=&v"(hi[ks]) : "v"(vb), "i"(d0 * 4096 + ks * 1024 + 512) : "memory"); }
        asm volatile("s_waitcnt lgkmcnt(0)" ::: "memory"); SBAR();
#define PK(k) (bf16x8){lo[k][0], lo[k][1], lo[k][2], lo[k][3], hi[k][0], hi[k][1], hi[k][2], hi[k][3]}
        o[d0] = __builtin_amdgcn_mfma_f32_32x32x16_bf16(pa0, PK(0), o[d0], 0, 0, 0);
        o[d0] = __builtin_amdgcn_mfma_f32_32x32x16_bf16(pa1, PK(1), o[d0], 0, 0, 0);
        o[d0] = __builtin_amdgcn_mfma_f32_32x32x16_bf16(pa2, PK(2), o[d0], 0, 0, 0);
        o[d0] = __builtin_amdgcn_mfma_f32_32x32x16_bf16(pa3, PK(3), o[d0], 0, 0, 0);
#undef PK
    }
}

__device__ __forceinline__ void gate_top3(const float* ksum_bh, const bf16x8* qr, int qb, int r32, int hi, int (&kbs)[3]) {
    const float* km = ksum_bh + (size_t)r32 * 64 + hi * 8;
    f32x16 g = f32x16{};
#pragma unroll
    for (int d0 = 0; d0 < 4; ++d0) { const f32x4 a = *(const f32x4*)(km + d0 * 16), c = *(const f32x4*)(km + d0 * 16 + 4);
        u32x4 w; w.x = cvtpk_s(a[0], a[1]); w.y = cvtpk_s(a[2], a[3]); w.z = cvtpk_s(c[0], c[1]); w.w = cvtpk_s(c[2], c[3]);
        g = __builtin_amdgcn_mfma_f32_32x32x16_bf16(__builtin_bit_cast(bf16x8, w), qr[d0], g, 0, 0, 0); }
#pragma unroll
    for (int r = 0; r < 16; ++r) if (crow(r, hi) >= qb) g[r] = -INFINITY;
#pragma unroll
    for (int round = 0; round < 3; ++round) {
        float m = g[0];
#pragma unroll
        for (int r = 1; r < 16; ++r) m = fmaxf(m, g[r]);
        int idx = 64;
#pragma unroll
        for (int r = 15; r >= 0; --r) if (g[r] == m) idx = crow(r, hi);
        const float pm = __shfl_xor(m, 32); const int pidx = __shfl_xor(idx, 32);
        const bool mine = (m > pm) || (m == pm && idx < pidx);
        kbs[round] = (mine ? idx : pidx) & 31;
#pragma unroll
        for (int r = 0; r < 16; ++r) if (mine && crow(r, hi) == idx) g[r] = -INFINITY;
    }
}

template <int THRL, bool OWN> __device__ __forceinline__ void attn_unit(int b, int h, int qb, const bf16* Q, const bf16* __restrict__ K, const bf16* __restrict__ V, bf16* O, const float* ksum, char* shm, bool do_store, const bf16_t* PO, const float* PML) {
    const int tid = threadIdx.x, lane = tid & 63, r32 = lane & 31, hi = lane >> 5; const int wid = __builtin_amdgcn_readfirstlane(tid >> 6);
    const long rowbase = (long)b * SEQ; const int q0 = qb * QB;
    const bf16* Qw = Q + (rowbase + q0 + wid * QBLK) * PITCH + h * D;
    const bf16* Kh = K + rowbase * PITCH + h * D, *Vh = V + rowbase * PITCH + h * D;
    const unsigned lds0 = (unsigned)(uintptr_t)shm;
    float* wsf = (float*)(shm + LDS_WS) + wid * 64;
    const bf16* ksrc = Kh + (long)lane * PITCH + wid * 8;
    const bf16* vsrc = Vh + (long)(16 * (wid & 3) + (lane >> 2)) * PITCH + (wid >> 2) * 32 + (lane & 3) * 8;
    const unsigned kdst = lds0 + LDS_K + wid * 1024, vdst = lds0 + LDS_V + wid * 1024;
    const int NT = OWN ? 4 : (q0 + QB) / KVBLK;
    const int TBASE = OWN ? 4 * qb : 0;
#define TM(t) (OWN ? (t) : (((t) == 0) ? (NT - 4) : (((t) <= NT - 4) ? ((t) - 1) : (t))))
#define DMA_K(t, slot) glds16(ksrc + (long)(TBASE + TM(t)) * KVBLK * PITCH, (unsigned)__builtin_amdgcn_readfirstlane(kdst + (slot)))
#define DMA_V(t, slot) glds16(vsrc + (long)(TBASE + TM(t)) * KVBLK * PITCH, (unsigned)__builtin_amdgcn_readfirstlane(vdst + (slot)))
    const int vb0 = (int)(lds0 + LDS_V) + ((lane >> 4) & 1) * 32 + (lane & 3) * 8 + (4 * hi + ((lane & 15) >> 2)) * 64;
    const char* Kbase = shm + LDS_K; bf16x8 kf[8];
    const lds_cptr shm3 = (lds_cptr)shm; const lds_cptr kp0 = shm3 + LDS_K + hi * 1024 + r32 * 16; const lds_cptr vp0 = shm3 + LDS_V + ((lane >> 4) & 1) * 32 + (lane & 3) * 8 + (4 * hi + ((lane & 15) >> 2)) * 64;
    DMA_K(0, 0); DMA_V(0, 0); DMA_K(1, SLOTB);
    bf16x8 qr[4];
#pragma unroll
    for (int d0 = 0; d0 < 4; ++d0) qr[d0] = *reinterpret_cast<const bf16x8*>(&Qw[(long)r32 * PITCH + d0 * 16 + hi * 8]);
    unsigned selmask = 0u;
    if constexpr (!OWN) {
    if (qb > 0) {
        if (qb <= 3) selmask = (1u << qb) - 1u;
        else { int kbs[3]; gate_top3(ksum + ((size_t)(b * NHEAD + h) * 32) * 64, qr, qb, r32, hi, kbs); selmask = (1u << kbs[0]) | (1u << kbs[1]) | (1u << kbs[2]); }
    } }
    float zf_; asm volatile("v_mov_b32 %0, 0" : "=v"(zf_));
    float mhat = 0.f, l_reg = 0.f; f32x16 o[2]; f32x16 negm;
#pragma unroll
    for (int r = 0; r < 16; ++r) { o[0][r] = zf_; o[1][r] = zf_; negm[r] = zf_; }
    asm volatile("" : "+v"(negm));
    const int qrel = wid * QBLK + r32;
#define MASKT(P0, P1, t) do { const int a_ = TM(t); const int jb_ = a_ - (NT - 4); if (jb_ >= 0) cmask(P0, P1, jb_, qrel, hi); else selapply(P0, P1, ((selmask >> (a_ >> 2)) & 1u) != 0u); } while (0)
    bool resc = false;
#define START(P0, P1) do { const float rm = rowmax(P0, P1); resc = false; \
    { const float dl = rm; mhat = fadd_s(mhat, dl); \
      _Pragma("unroll") for (int r = 0; r < 16; ++r) { P0[r] = fsub_s(P0[r], dl); P1[r] = fsub_s(P1[r], dl); } \
      _Pragma("unroll") for (int r = 0; r < 16; ++r) negm[r] = -mhat; asm volatile("" : "+v"(negm)); } \
    _Pragma("unroll") for (int r = 0; r < 16; ++r) P0[r] = __builtin_amdgcn_exp2f(P0[r]); } while (0)
#define RESC() do { if (resc) { asm volatile("s_waitcnt lgkmcnt(0)" ::: "memory"); \
      _Pragma("unroll") for (int d_ = 0; d_ < 2; ++d_) _Pragma("unroll") for (int r = 0; r < 16; ++r) o[d_][r] *= wsf[crow(r, hi)]; } } while (0)
    f32x16 pA0, pA1, pB0, pB1;
    int sl_prev = 0, sl_cur = 0, sl_next = SLOTB;
#define ROT() do { sl_prev = sl_cur; sl_cur = sl_next; sl_next = (sl_next == (NSLOT - 1) * SLOTB) ? 0 : sl_next + SLOTB; } while (0)
    DMA_K(2, 2 * SLOTB);
    WAIT_BAR(3);
    qkt(pA0, pA1, Kbase, qr, negm, r32, hi); asm volatile("s_nop 15\n\ts_nop 7" : "+v"(pA0), "+v"(pA1)); MASKT(pA0, pA1, 0);
    START(pA0, pA1);
    _Pragma("unroll") for (int r = 0; r < 16; ++r) pA1[r] = __builtin_amdgcn_exp2f(pA1[r]);
    WAIT_BAR(0);
    DMA_K(3, 0); DMA_V(1, SLOTB);
    ROT();
    kload8(kf, kp0 + sl_cur);
    WAIT_BAR(2);
    s16x4 vlo[8], vhi[8]; u32x4 pw0, pw1, pw2, pw3;
#define PKW(P, B) cvtpk_s(P[B], P[B + 1])
#define PAF(k) __builtin_bit_cast(bf16x8, pw##k)
#define VFR(i) (bf16x8){vlo[i][0], vlo[i][1], vlo[i][2], vlo[i][3], vhi[i][0], vhi[i][1], vhi[i][2], vhi[i][3]}
#define PIN(x) asm volatile("" : "+v"(x))
#define MX3(a, b, c) __builtin_fmaxf(__builtin_fmaxf((a), (b)), (c))
#define GAPA(MF, A0, A1, A2, A3, W0, W1, PW) do { MF; sacc += A0; sacc += A1; sacc += A2; sacc += A3; PIN(sacc); W0; W1; PIN(PW); SBAR(); } while (0)
#define EX(v) __builtin_amdgcn_exp2f(v)
#define GAPB(MF, X, B) do { MF; X[B] = EX(X[B]); X[B + 1] = EX(X[B + 1]); X[B + 2] = EX(X[B + 2]); X[B + 3] = EX(X[B + 3]); PIN(X); SBAR(); } while (0)
#define VRD(i) do { vlo[i] = vtr(vp_ + (((i) >> 2) * 4096 + ((i) & 3) * 1024)); vhi[i] = vtr(vp_ + (((i) >> 2) * 4096 + ((i) & 3) * 1024 + 512)); } while (0)
#define KRD(G, j) do { if (G) { kload2(kf, kp0 + sl_next, j); SBAR(); } } while (0)
#define STEP(C0, C1, P0, P1, t, GK, GV, GL) do { SBAR(); \
    const lds_cptr vp_ = vp0 + sl_prev; \
    VRD(0); SBAR(); float sacc = (P0[0] + P0[1]); \
    GAPA(C0 = __builtin_amdgcn_mfma_f32_32x32x16_bf16(kf[0], qr[0], negm, 0, 0, 0), P0[2], P0[3], P0[4], P0[5],     pw0[0] = PKW(P0, 0), pw0[1] = PKW(P0, 2), pw0); \
    VRD(4); SBAR(); GAPA(C1 = __builtin_amdgcn_mfma_f32_32x32x16_bf16(kf[1], qr[0], negm, 0, 0, 0), P0[6], P0[7], P0[8], P0[9],     pw0[2] = PKW(P0, 4), pw0[3] = PKW(P0, 6), pw0); \
    VRD(1); SBAR(); GAPA(C0 = __builtin_amdgcn_mfma_f32_32x32x16_bf16(kf[2], qr[1], C0, 0, 0, 0),   P0[10], P0[11], P0[12], P0[13], pw1[0] = PKW(P0, 8), pw1[1] = PKW(P0, 10), pw1); \
    VRD(5); SBAR(); GAPA(C1 = __builtin_amdgcn_mfma_f32_32x32x16_bf16(kf[3], qr[1], C1, 0, 0, 0),   P0[14], P0[15], P1[0], P1[1],   pw1[2] = PKW(P0, 12), pw1[3] = PKW(P0, 14), pw1); \
    VRD(2); SBAR(); GAPA(C0 = __builtin_amdgcn_mfma_f32_32x32x16_bf16(kf[4], qr[2], C0, 0, 0, 0),   P1[2], P1[3], P1[4], P1[5],     pw2[0] = PKW(P1, 0), pw2[1] = PKW(P1, 2), pw2); \
    VRD(6); SBAR(); GAPA(C1 = __builtin_amdgcn_mfma_f32_32x32x16_bf16(kf[5], qr[2], C1, 0, 0, 0),   P1[6], P1[7], P1[8], P1[9],     pw2[2] = PKW(P1, 4), pw2[3] = PKW(P1, 6), pw2); \
    VRD(3); SBAR(); GAPA(C0 = __builtin_amdgcn_mfma_f32_32x32x16_bf16(kf[6], qr[3], C0, 0, 0, 0),   P1[10], P1[11], P1[12], P1[13], pw3[0] = PKW(P1, 8), pw3[1] = PKW(P1, 10), pw3); \
    VRD(7); SBAR(); GAPA(C1 = __builtin_amdgcn_mfma_f32_32x32x16_bf16(kf[7], qr[3], C1, 0, 0, 0),   P1[14], P1[15], 0.f, 0.f,       pw3[2] = PKW(P1, 12), pw3[3] = PKW(P1, 14), pw3); \
    l_reg += sacc; \
    if (GK) { DMA_K((t) + 3, sl_cur); } if (GV) { DMA_V((t) + 1, sl_next); } \
    MASKT(C0, C1, t); \
    { float a = MX3(C0[0], C0[1], C1[0]), b = MX3(C0[2], C0[3], C1[1]); a = MX3(a, C1[2], C1[3]); \
      _Pragma("unroll") for (int r = 4; r < 16; r += 4) { a = MX3(a, C0[r], C0[r + 1]); b = MX3(b, C0[r + 2], C0[r + 3]); a = MX3(a, C1[r], C1[r + 1]); b = MX3(b, C1[r + 2], C1[r + 3]); } \
      float rm = __builtin_fmaxf(a, b); { auto rr = __builtin_amdgcn_permlane32_swap(__float_as_uint(rm), __float_as_uint(rm), false, false); rm = __builtin_fmaxf(__uint_as_float(rr[0]), __uint_as_float(rr[1])); } \
      resc = false; \
      if (__builtin_expect(__any(rm > (float)THRL), 0)) { const float dl = __builtin_fmaxf(rm, 0.f); mhat += dl; \
        _Pragma("unroll") for (int r = 0; r < 16; ++r) { C0[r] -= dl; C1[r] -= dl; } \
        _Pragma("unroll") for (int r = 0; r < 16; ++r) negm[r] = -mhat; asm volatile("" : "+v"(negm)); \
        const float f = __builtin_amdgcn_exp2f(-dl); l_reg *= f; if (hi == 0) wsf[r32] = f; resc = true; } } \
    SBAR(); \
    GAPB(o[0] = __builtin_amdgcn_mfma_f32_32x32x16_bf16(PAF(0), VFR(0), o[0], 0, 0, 0), C0, 0); \
    GAPB(o[1] = __builtin_amdgcn_mfma_f32_32x32x16_bf16(PAF(0), VFR(4), o[1], 0, 0, 0), C0, 4); \
    KRD(GL, 0); GAPB(o[0] = __builtin_amdgcn_mfma_f32_32x32x16_bf16(PAF(1), VFR(1), o[0], 0, 0, 0), C0, 8); \
    KRD(GL, 1); GAPB(o[1] = __builtin_amdgcn_mfma_f32_32x32x16_bf16(PAF(1), VFR(5), o[1], 0, 0, 0), C0, 12); \
    KRD(GL, 2); GAPB(o[0] = __builtin_amdgcn_mfma_f32_32x32x16_bf16(PAF(2), VFR(2), o[0], 0, 0, 0), C1, 0); \
    KRD(GL, 3); GAPB(o[1] = __builtin_amdgcn_mfma_f32_32x32x16_bf16(PAF(2), VFR(6), o[1], 0, 0, 0), C1, 4); \
    GAPB(o[0] = __builtin_amdgcn_mfma_f32_32x32x16_bf16(PAF(3), VFR(3), o[0], 0, 0, 0), C1, 8); \
    GAPB(o[1] = __builtin_amdgcn_mfma_f32_32x32x16_bf16(PAF(3), VFR(7), o[1], 0, 0, 0), C1, 12); \
    } while (0)
    int t = 1;
    for (; t + 5 < NT; t += 2) {
        STEP(pB0, pB1, pA0, pA1, t, true, true, true);     WAIT_BAR(2); RESC(); ROT();
        STEP(pA0, pA1, pB0, pB1, t + 1, true, true, true); WAIT_BAR(2); RESC(); ROT();
    }
#define ENDW(tt) do { if ((tt) + 3 < NT) { WAIT_BAR(2); } else if ((tt) + 2 < NT) { WAIT_BAR(1); } else { WAIT_BAR(0); } } while (0)
    for (; t + 1 < NT; t += 2) {
        STEP(pB0, pB1, pA0, pA1, t, (t + 3 < NT), (t + 1 < NT), (t + 1 < NT));       ENDW(t);     RESC(); ROT();
        STEP(pA0, pA1, pB0, pB1, t + 1, (t + 4 < NT), (t + 2 < NT), (t + 2 < NT));   ENDW(t + 1); RESC(); ROT();
    }
    STEP(pB0, pB1, pA0, pA1, NT - 1, false, false, false); RESC();
    { float sacc = pB0[0] + pB0[1]; _Pragma("unroll") for (int r = 2; r < 16; ++r) sacc += pB0[r]; _Pragma("unroll") for (int r = 0; r < 16; ++r) sacc += pB1[r]; l_reg += sacc;
      pw0 = (u32x4){PKW(pB0, 0), PKW(pB0, 2), PKW(pB0, 4), PKW(pB0, 6)}; pw1 = (u32x4){PKW(pB0, 8), PKW(pB0, 10), PKW(pB0, 12), PKW(pB0, 14)}; pw2 = (u32x4){PKW(pB1, 0), PKW(pB1, 2), PKW(pB1, 4), PKW(pB1, 6)}; pw3 = (u32x4){PKW(pB1, 8), PKW(pB1, 10), PKW(pB1, 12), PKW(pB1, 14)};
      SBAR(); pv(o, vb0 + sl_cur, PAF(0), PAF(1), PAF(2), PAF(3)); }
#undef PKW
#undef PAF
#undef VFR
#undef PIN
#undef MX3
#undef GAPA
#undef GAPB
#undef EX
#undef VRD
#undef KRD
#undef STEP
#undef ENDW
    { auto rr = __builtin_amdgcn_permlane32_swap(__float_as_uint(l_reg), __float_as_uint(l_reg), false, false); l_reg = __uint_as_float(rr[0]) + __uint_as_float(rr[1]); }
    if (hi == 0) { wsf[32 + r32] = l_reg; if (OWN) wsf[r32] = mhat; } asm volatile("s_waitcnt lgkmcnt(0)" ::: "memory");
    float rli[16];
#pragma unroll
    for (int r = 0; r < 16; ++r) rli[r] = __builtin_amdgcn_rcpf(wsf[32 + crow(r, hi)]);
    bf16* Ow = O + (rowbase + q0 + wid * QBLK) * PITCH + h * D;
    { bf16* stg = (bf16*)(shm + LDS_OST) + wid * 2048;
#pragma unroll
      for (int r = 0; r < 16; ++r) { const int orow = crow(r, hi);
#pragma unroll
        for (int d0 = 0; d0 < 2; ++d0) stg[orow * 64 + d0 * 32 + r32] = __float2bfloat16(o[d0][r] * rli[r]); }
      asm volatile("s_waitcnt lgkmcnt(0)" ::: "memory");
      const int nsel = qb < 3 ? qb : 3;
#pragma unroll
      for (int i = 0; i < 4; ++i) { const int row = i * 8 + (lane >> 3), ch = lane & 7; u32x4 v = *(const u32x4*)(stg + row * 64 + ch * 8);
        if constexpr (OWN) {
          if (nsel > 0) {
            const float mo = wsf[row], lo = wsf[32 + row];
            const size_t e0 = (((size_t)(b * NHEAD + h)) * SEQ + q0 + wid * QBLK + row) * 3;
            float ms[3], ls[3]; u32x4 pp[3]; float M = mo;
#pragma unroll
            for (int s_ = 0; s_ < 3; ++s_) { ms[s_] = -INFINITY; ls[s_] = 0.f; pp[s_] = (u32x4){0u, 0u, 0u, 0u};
              if (s_ < nsel) { const f32x2 ml = *(const f32x2*)(PML + (e0 + s_) * 2); ms[s_] = ml.x; ls[s_] = ml.y; pp[s_] = *(const u32x4*)(PO + (e0 + s_) * 64 + ch * 8); M = fmaxf(M, ml.x); } }
            const float wo = lo * __builtin_amdgcn_exp2f(mo - M); float W = wo;
            float a[8] = {bflo(v.x) * wo, bfhi(v.x) * wo, bflo(v.y) * wo, bfhi(v.y) * wo, bflo(v.z) * wo, bfhi(v.z) * wo, bflo(v.w) * wo, bfhi(v.w) * wo};
#pragma unroll
            for (int s_ = 0; s_ < 3; ++s_) { const float w_ = (s_ < nsel) ? ls[s_] * __builtin_amdgcn_exp2f(ms[s_] - M) : 0.f; W += w_;
              a[0] += w_ * bflo(pp[s_].x); a[1] += w_ * bfhi(pp[s_].x); a[2] += w_ * bflo(pp[s_].y); a[3] += w_ * bfhi(pp[s_].y); a[4] += w_ * bflo(pp[s_].z); a[5] += w_ * bfhi(pp[s_].z); a[6] += w_ * bflo(pp[s_].w); a[7] += w_ * bfhi(pp[s_].w); }
            const float iw = 1.0f / W;
            v.x = cvtpk_s(a[0] * iw, a[1] * iw); v.y = cvtpk_s(a[2] * iw, a[3] * iw); v.z = cvtpk_s(a[4] * iw, a[5] * iw); v.w = cvtpk_s(a[6] * iw, a[7] * iw);
          } }
        if (do_store) *(u32x4*)(Ow + (long)row * PITCH + ch * 8) = v; } }
    asm volatile("s_waitcnt lgkmcnt(0)\n\ts_barrier" ::: "memory");
#undef DMA_K
#undef DMA_V
#undef TM
#undef MASKT
#undef START
#undef RESC
#undef ROT
}

__device__ __forceinline__ void select_unit(int b, int h, int qb, const bf16* Q, const float* ksum, unsigned short* LIST, unsigned* CNT, char* shm) {
    if (qb == 0) return;
    const int tid = threadIdx.x, lane = tid & 63, r32 = lane & 31, hi = lane >> 5; const int wid = __builtin_amdgcn_readfirstlane(tid >> 6);
    LAS unsigned* hist = (LAS unsigned*)shm; LAS unsigned* basev = hist + 32;
    if (tid < 32) hist[tid] = 0u;
    __syncthreads();
    int kbs[3] = {0, 1, 2}; const int ns = qb < 3 ? qb : 3;
    if (qb > 3) {
        const bf16* Qw = Q + ((long)b * SEQ + qb * QB + wid * QBLK) * PITCH + h * D;
        bf16x8 qr[4];
#pragma unroll
        for (int d0 = 0; d0 < 4; ++d0) qr[d0] = *reinterpret_cast<const bf16x8*>(&Qw[(long)r32 * PITCH + d0 * 16 + hi * 8]);
        gate_top3(ksum + ((size_t)(b * NHEAD + h) * 32) * 64, qr, qb, r32, hi, kbs);
    }
    unsigned pos[3] = {0u, 0u, 0u};
    if (hi == 0) {
#pragma unroll
        for (int s_ = 0; s_ < 3; ++s_) if (s_ < ns) pos[s_] = __hip_atomic_fetch_add(hist + kbs[s_], 1u, __ATOMIC_RELAXED, __HIP_MEMORY_SCOPE_WORKGROUP);
    }
    __syncthreads();
    const int bh = b * NHEAD + h;
    if (tid < 32) { const unsigned n = hist[tid]; basev[tid] = n ? __hip_atomic_fetch_add(CNT + bh * 32 + tid, n, __ATOMIC_RELAXED, __HIP_MEMORY_SCOPE_AGENT) : 0u; }
    __syncthreads();
    if (hi == 0) { const unsigned qv = (unsigned)(qb * QB + wid * QBLK + r32) << 2;
#pragma unroll
        for (int s_ = 0; s_ < 3; ++s_) if (s_ < ns) LIST[(size_t)(bh * 32 + kbs[s_]) * 8192 + basev[kbs[s_]] + pos[s_]] = (unsigned short)(qv | (unsigned)s_); }
    __syncthreads();
}

constexpr int G_K = 0, G_V = 32768, G_WS = 65536, G_OST = G_WS + NW * 512, G_TAB = G_OST + NW * 4096, G_BYTES = G_TAB + 8256 + 4096;
template <int THRL> __device__ __forceinline__ void gather_phase(char* shm, const bf16* Q, const bf16* __restrict__ K, const bf16* __restrict__ V, const unsigned short* LIST, unsigned* CNT, bf16_t* PO, float* PML, int vcu, int G, bool do_store) {
    const int tid = threadIdx.x, lane = tid & 63, r32 = lane & 31, hi = lane >> 5; const int wid = __builtin_amdgcn_readfirstlane(tid >> 6);
    LAS int* pre = (LAS int*)(shm + G_TAB); LAS int* wtot = pre + 1032; LAS int* cntl = (LAS int*)(shm + G_TAB + 8256);
    {
        const int c0 = (int)__hip_atomic_load(CNT + 2 * tid, __ATOMIC_RELAXED, __HIP_MEMORY_SCOPE_AGENT), c1 = (int)__hip_atomic_load(CNT + 2 * tid + 1, __ATOMIC_RELAXED, __HIP_MEMORY_SCOPE_AGENT);
        const int n0 = (c0 + 255) >> 8, n1 = (c1 + 255) >> 8, sm = n0 + n1; int v = sm;
#pragma unroll
        for (int o_ = 1; o_ < 64; o_ <<= 1) { const int t_ = __shfl_up(v, o_); if (lane >= o_) v += t_; }
        if (lane == 63) wtot[wid] = v;
        cntl[2 * tid] = c0; cntl[2 * tid + 1] = c1;
        __syncthreads();
        int off = 0;
        for (int w_ = 0; w_ < wid; ++w_) off += wtot[w_];
        const int excl = off + v - sm;
        pre[2 * tid] = excl; pre[2 * tid + 1] = excl + n0; if (tid == NW * 64 - 1) pre[1024] = excl + sm;
        __syncthreads();
    }
    const int P = __builtin_amdgcn_readfirstlane(pre[1024]);
    const int ulo = (int)(((long)P * vcu) / G), uhi = (int)(((long)P * (vcu + 1)) / G);
    const unsigned lds0 = (unsigned)(uintptr_t)shm;
    float* wsf = (float*)(shm + G_WS) + wid * 128; int* ent = (int*)(wsf + 64);
    const unsigned kdst = lds0 + G_K + wid * 1024, vdst = lds0 + G_V + wid * 1024;
    const int vb0 = (int)(lds0 + G_V) + ((lane >> 4) & 1) * 32 + (lane & 3) * 8 + (4 * hi + ((lane & 15) >> 2)) * 64;
    int it0 = 0, it1 = 0, it2 = 0, cur = -1;
#define G_ITEM(itv, uu) do { while ((uu) < uhi && __builtin_amdgcn_readfirstlane(pre[(itv) + 1]) <= (uu)) ++(itv); } while (0)
#define G_ENTRY(itv, uu) ({ const int ps_ = (uu) - __builtin_amdgcn_readfirstlane(pre[itv]), cn_ = __builtin_amdgcn_readfirstlane(cntl[itv]); const int li_ = ps_ * 256 + wid * QBLK + r32; \
        (unsigned)LIST[(size_t)(itv) * 8192 + (li_ < cn_ ? li_ : 0)] | ((li_ < cn_) ? 0x10000u : 0u); })
#define G_QLOAD(dst, itv, ee) do { const int bh_ = (itv) >> 5; const bf16* Qrow_ = Q + ((long)(bh_ >> 3) * SEQ + (int)(((ee) & 0xffffu) >> 2)) * PITCH + (bh_ & 7) * D; \
        _Pragma("unroll") for (int d0 = 0; d0 < 4; ++d0) dst[d0] = *reinterpret_cast<const bf16x8*>(Qrow_ + d0 * 16 + hi * 8); } while (0)
    unsigned e0 = 0u, e1 = 0u, e2 = 0u; bf16x8 qr[4], qn[4];
    if (ulo < uhi) { G_ITEM(it0, ulo); e0 = G_ENTRY(it0, ulo); it1 = it0; { const int u1_ = (ulo + 1 < uhi) ? ulo + 1 : uhi - 1; G_ITEM(it1, u1_); e1 = G_ENTRY(it1, u1_); } G_QLOAD(qr, it0, e0); }
    it2 = it1;
    for (int u = ulo; u < uhi; ++u) {
        { const int u2_ = (u + 2 < uhi) ? u + 2 : uhi - 1; G_ITEM(it2, u2_); e2 = G_ENTRY(it2, u2_); }
        const int item = it0;
        const int bh = item >> 5, kb = item & 31, b = bh >> 3, h = bh & 7;
        if (item != cur) {
            asm volatile("s_waitcnt lgkmcnt(0)\n\ts_barrier" ::: "memory");
            const bf16* Kh = K + (long)b * SEQ * PITCH + h * D, *Vh = V + (long)b * SEQ * PITCH + h * D;
            const bf16* ksrc = Kh + (long)lane * PITCH + wid * 8;
            const bf16* vsrc = Vh + (long)(16 * (wid & 3) + (lane >> 2)) * PITCH + (wid >> 2) * 32 + (lane & 3) * 8;
#pragma unroll
            for (int t = 0; t < 4; ++t) { glds16(ksrc + (long)(4 * kb + t) * KVBLK * PITCH, (unsigned)__builtin_amdgcn_readfirstlane(kdst + t * 8192)); glds16(vsrc + (long)(4 * kb + t) * KVBLK * PITCH, (unsigned)__builtin_amdgcn_readfirstlane(vdst + t * 8192)); }
            asm volatile("s_waitcnt vmcnt(0)\n\ts_barrier" ::: "memory");
            cur = item;
            if (wid >= 4) __builtin_amdgcn_s_sleep(10);
        }
        G_QLOAD(qn, it1, e1);
        const bool valid = (e0 & 0x10000u) != 0u;
        const int q = (int)((e0 & 0xffffu) >> 2), slot = (int)(e0 & 3u);
        const bool wave_has_rows = __builtin_amdgcn_readfirstlane((int)(e0 >> 16) & 1) != 0 || __any(valid);
        if (wave_has_rows) {
        float mhat = 0.f, l_reg = 0.f; f32x16 o[2]; f32x16 negm;
#pragma unroll
        for (int r = 0; r < 16; ++r) { o[0][r] = 0.f; o[1][r] = 0.f; negm[r] = 0.f; }
        const lds_cptr kp0 = (lds_cptr)shm + G_K + hi * 1024 + r32 * 16; const lds_cptr vp0 = (lds_cptr)shm + G_V + ((lane >> 4) & 1) * 32 + (lane & 3) * 8 + (4 * hi + ((lane & 15) >> 2)) * 64;
        bf16x8 kf[8]; f32x16 p0, p1, s0, s1;
#define G_QK(D0, D1) do { D0 = __builtin_amdgcn_mfma_f32_32x32x16_bf16(kf[0], qr[0], negm, 0, 0, 0); D1 = __builtin_amdgcn_mfma_f32_32x32x16_bf16(kf[1], qr[0], negm, 0, 0, 0); \
            D0 = __builtin_amdgcn_mfma_f32_32x32x16_bf16(kf[2], qr[1], D0, 0, 0, 0); D1 = __builtin_amdgcn_mfma_f32_32x32x16_bf16(kf[3], qr[1], D1, 0, 0, 0); \
            D0 = __builtin_amdgcn_mfma_f32_32x32x16_bf16(kf[4], qr[2], D0, 0, 0, 0); D1 = __builtin_amdgcn_mfma_f32_32x32x16_bf16(kf[5], qr[2], D1, 0, 0, 0); \
            D0 = __builtin_amdgcn_mfma_f32_32x32x16_bf16(kf[6], qr[3], D0, 0, 0, 0); D1 = __builtin_amdgcn_mfma_f32_32x32x16_bf16(kf[7], qr[3], D1, 0, 0, 0); } while (0)
#define G_MX(D0, D1, FIRST) do { float a_ = fmaxf(fmaxf(D0[0], D0[1]), D1[0]), c_ = fmaxf(fmaxf(D0[2], D0[3]), D1[1]); a_ = fmaxf(fmaxf(a_, D1[2]), D1[3]); \
            _Pragma("unroll") for (int r = 4; r < 16; r += 4) { a_ = fmaxf(fmaxf(a_, D0[r]), D0[r + 1]); c_ = fmaxf(fmaxf(c_, D0[r + 2]), D0[r + 3]); a_ = fmaxf(fmaxf(a_, D1[r]), D1[r + 1]); c_ = fmaxf(fmaxf(c_, D1[r + 2]), D1[r + 3]); } \
            float rm_ = fmaxf(a_, c_); { auto rr_ = __builtin_amdgcn_permlane32_swap(__float_as_uint(rm_), __float_as_uint(rm_), false, false); rm_ = fmaxf(__uint_as_float(rr_[0]), __uint_as_float(rr_[1])); } \
            if (FIRST) { mhat = rm_; _Pragma("unroll") for (int r = 0; r < 16; ++r) { D0[r] -= rm_; D1[r] -= rm_; negm[r] = -mhat; } } \
            else if (__any(rm_ > (float)THRL)) { const float dl_ = fmaxf(rm_, 0.f); mhat += dl_; \
                _Pragma("unroll") for (int r = 0; r < 16; ++r) { D0[r] -= dl_; D1[r] -= dl_; negm[r] = -mhat; } \
                const float f_ = __builtin_amdgcn_exp2f(-dl_); l_reg *= f_; if (hi == 0) wsf[r32] = f_; \
                asm volatile("s_waitcnt lgkmcnt(0)" ::: "memory"); \
                _Pragma("unroll") for (int d_ = 0; d_ < 2; ++d_) _Pragma("unroll") for (int r = 0; r < 16; ++r) o[d_][r] *= wsf[crow(r, hi)]; } } while (0)
        const bool run_tiles = (GPROBE == 1) ? do_store : true;
        if (run_tiles) {
        kload8(kf, kp0);
        G_QK(p0, p1);
        kload8(kf, kp0 + 8192);
        G_MX(p0, p1, true);
#pragma unroll
        for (int t = 0; t < 4; ++t) {
            if (t < 3) { __builtin_amdgcn_sched_barrier(0); G_QK(s0, s1); if (t < 2) kload8(kf, kp0 + (t + 2) * 8192); }
            s16x4 vlo[8], vhi[8];
            const lds_cptr vp_ = vp0 + t * 8192;
#pragma unroll
            for (int i = 0; i < 8; ++i) { vlo[i] = vtr(vp_ + ((i >> 2) * 4096 + (i & 3) * 1024)); vhi[i] = vtr(vp_ + ((i >> 2) * 4096 + (i & 3) * 1024 + 512)); }
            __builtin_amdgcn_sched_barrier(0);
            float sacc = 0.f;
#pragma unroll
            for (int r = 0; r < 16; ++r) { p0[r] = __builtin_amdgcn_exp2f(p0[r]); p1[r] = __builtin_amdgcn_exp2f(p1[r]); sacc += p0[r] + p1[r]; }
            l_reg += sacc;
            const u32x4 pw0 = {cvtpk_s(p0[0], p0[1]), cvtpk_s(p0[2], p0[3]), cvtpk_s(p0[4], p0[5]), cvtpk_s(p0[6], p0[7])}, pw1 = {cvtpk_s(p0[8], p0[9]), cvtpk_s(p0[10], p0[11]), cvtpk_s(p0[12], p0[13]), cvtpk_s(p0[14], p0[15])};
            const u32x4 pw2 = {cvtpk_s(p1[0], p1[1]), cvtpk_s(p1[2], p1[3]), cvtpk_s(p1[4], p1[5]), cvtpk_s(p1[6], p1[7])}, pw3 = {cvtpk_s(p1[8], p1[9]), cvtpk_s(p1[10], p1[11]), cvtpk_s(p1[12], p1[13]), cvtpk_s(p1[14], p1[15])};
            __builtin_amdgcn_sched_barrier(0);
#define G_VF(i) (bf16x8){vlo[i][0], vlo[i][1], vlo[i][2], vlo[i][3], vhi[i][0], vhi[i][1], vhi[i][2], vhi[i][3]}
            if (GPROBE == 2 && !do_store) { asm volatile("" :: "v"(pw0), "v"(pw1), "v"(pw2), "v"(pw3)); } else {
            o[0] = __builtin_amdgcn_mfma_f32_32x32x16_bf16(__builtin_bit_cast(bf16x8, pw0), G_VF(0), o[0], 0, 0, 0); o[1] = __builtin_amdgcn_mfma_f32_32x32x16_bf16(__builtin_bit_cast(bf16x8, pw0), G_VF(4), o[1], 0, 0, 0);
            o[0] = __builtin_amdgcn_mfma_f32_32x32x16_bf16(__builtin_bit_cast(bf16x8, pw1), G_VF(1), o[0], 0, 0, 0); o[1] = __builtin_amdgcn_mfma_f32_32x32x16_bf16(__builtin_bit_cast(bf16x8, pw1), G_VF(5), o[1], 0, 0, 0);
            o[0] = __builtin_amdgcn_mfma_f32_32x32x16_bf16(__builtin_bit_cast(bf16x8, pw2), G_VF(2), o[0], 0, 0, 0); o[1] = __builtin_amdgcn_mfma_f32_32x32x16_bf16(__builtin_bit_cast(bf16x8, pw2), G_VF(6), o[1], 0, 0, 0);
            o[0] = __builtin_amdgcn_mfma_f32_32x32x16_bf16(__builtin_bit_cast(bf16x8, pw3), G_VF(3), o[0], 0, 0, 0); o[1] = __builtin_amdgcn_mfma_f32_32x32x16_bf16(__builtin_bit_cast(bf16x8, pw3), G_VF(7), o[1], 0, 0, 0);
            }
#undef G_VF
            if (t < 3) { G_MX(s0, s1, false); p0 = s0; p1 = s1; }
        }
        }
#undef G_QK
#undef G_MX
        { auto rr = __builtin_amdgcn_permlane32_swap(__float_as_uint(l_reg), __float_as_uint(l_reg), false, false); l_reg = __uint_as_float(rr[0]) + __uint_as_float(rr[1]); }
        const int er = valid ? (q * 3 + slot) : -1;
        if (hi == 0) { wsf[32 + r32] = l_reg; ent[r32] = er; } asm volatile("s_waitcnt lgkmcnt(0)" ::: "memory");
        float rli[16];
#pragma unroll
        for (int r = 0; r < 16; ++r) rli[r] = __builtin_amdgcn_rcpf(wsf[32 + crow(r, hi)]);
        bf16* stg = (bf16*)(shm + G_OST) + wid * 2048;
#pragma unroll
        for (int r = 0; r < 16; ++r) { const int orow = crow(r, hi);
#pragma unroll
            for (int d0 = 0; d0 < 2; ++d0) stg[orow * 64 + d0 * 32 + r32] = __float2bfloat16(o[d0][r] * rli[r]); }
        asm volatile("s_waitcnt lgkmcnt(0)" ::: "memory");
        const size_t ebase = (size_t)bh * SEQ * 3;
#pragma unroll
        for (int i = 0; i < 4; ++i) { const int row = i * 8 + (lane >> 3), ch = lane & 7; const u32x4 v = *(const u32x4*)(stg + row * 64 + ch * 8); const int er_ = ent[row];
            if (er_ >= 0 && do_store) *(u32x4*)(PO + (ebase + er_) * 64 + ch * 8) = v; }
        if (hi == 0 && valid && do_store) *(f32x2*)(PML + (ebase + er) * 2) = (f32x2){mhat, l_reg};
        asm volatile("s_waitcnt lgkmcnt(0)" ::: "memory");
        }
        e0 = e1; e1 = e2; it0 = it1; it1 = it2;
#pragma unroll
        for (int d0 = 0; d0 < 4; ++d0) qr[d0] = qn[d0];
    }
    asm volatile("s_waitcnt vmcnt(0) lgkmcnt(0)\n\ts_barrier" ::: "memory");
#undef G_ITEM
#undef G_ENTRY
#undef G_QLOAD
}
#undef SBAR
#undef WAIT_BAR
}

#define XB_TMO      128
#define XB_XCNT(j)  (256  + 64 * (j))
#define XB_XSUB(j)  (1280 + 64 * (j))
#define XB_XGEN(j)  (2304 + 64 * (j))
#define XB_TOP      3328
#define XB_TOPGEN   3392
#define XCD_BAR_WORDS 3456
#define XB_SPIN_CAP (1u << 18)
__device__ __forceinline__ unsigned xb_ld(unsigned* p)              { return __hip_atomic_load(p, __ATOMIC_RELAXED, __HIP_MEMORY_SCOPE_AGENT); }
__device__ __forceinline__ unsigned xb_add(unsigned* p, unsigned v) { return __hip_atomic_fetch_add(p, v, __ATOMIC_RELAXED, __HIP_MEMORY_SCOPE_AGENT); }
__device__ __forceinline__ unsigned xb_xcc_id() { return (unsigned)__builtin_amdgcn_s_getreg((3 << 11) | 20) & 0xFu; }
#define XB_SPIN(cond, bar) do { unsigned _sp = 0; while (cond) { __builtin_amdgcn_s_sleep(1); \
    if ((++_sp & 255u) == 0u) { if (xb_ld(&(bar)[XB_TMO])) break; if (_sp > XB_SPIN_CAP) { atomicAdd(&(bar)[XB_TMO], 1u); break; } } } } while (0)
struct XcdBarrier { unsigned* bar; unsigned x; volatile LAS unsigned* st; };
__device__ __forceinline__ XcdBarrier xcd_barrier_post(unsigned* bar, volatile LAS unsigned* st) {
    XcdBarrier b; b.bar = bar; b.x = xb_xcc_id(); b.st = st;
    if (threadIdx.x == 0) (void)xb_add(&bar[XB_XCNT(b.x)], 1u);
    return b;
}
__device__ __forceinline__ void xcd_barrier_complete(unsigned* bar, unsigned x, unsigned& nloc, unsigned& nx) {
    const unsigned G = gridDim.x * gridDim.y * gridDim.z;
    unsigned sum, cnt, mine, sp = 0u;
    for (;;) {
        sum = 0u; cnt = 0u; mine = 0u;
#pragma unroll
        for (unsigned j = 0; j < 16; ++j) { const unsigned c = xb_ld(&bar[XB_XCNT(j)]); sum += c; cnt += (c > 0u) ? 1u : 0u; mine = (j == x) ? c : mine; }
        if (sum == G) break;
        __builtin_amdgcn_s_sleep(1);
        if ((++sp & 255u) == 0u) { if (xb_ld(&bar[XB_TMO])) break; if (sp > XB_SPIN_CAP) { atomicAdd(&bar[XB_TMO], 1u); break; } }
    }
    nloc = mine > 0u ? mine : 1u; nx = cnt > 0u ? cnt : 1u;
}
__device__ __forceinline__ void xcd_barrier(const XcdBarrier& b) {
    asm volatile("s_waitcnt vmcnt(0)" ::: "memory");
    __syncthreads();
    if (threadIdx.x == 0) {
        unsigned* bar = b.bar;
        __builtin_amdgcn_s_waitcnt(0);
        unsigned nloc = b.st[0], nx = b.st[1];
        if (nloc == 0u) { xcd_barrier_complete(bar, b.x, nloc, nx); b.st[0] = nloc; b.st[1] = nx; }
        const unsigned old = xb_add(&bar[XB_XSUB(b.x)], 1u);
        const unsigned gen = old / nloc;
        if (old + 1u == (gen + 1u) * nloc) {
            __builtin_amdgcn_fence(__ATOMIC_RELEASE, "agent");
            asm volatile("s_waitcnt vmcnt(0)" ::: "memory");
            const unsigned og = xb_add(&bar[XB_TOP], 1u);
            const unsigned tg = og / nx;
            if (og + 1u == (tg + 1u) * nx) xb_add(&bar[XB_TOPGEN], 1u);
            else XB_SPIN(xb_ld(&bar[XB_TOPGEN]) == tg, bar);
            __builtin_amdgcn_fence(__ATOMIC_ACQUIRE, "agent");
            xb_add(&bar[XB_XGEN(b.x)], 1u);
            asm volatile("s_waitcnt vmcnt(0)" ::: "memory");
        } else {
            XB_SPIN(xb_ld(&bar[XB_XGEN(b.x)]) == gen, bar);
            __builtin_amdgcn_fence(__ATOMIC_ACQUIRE, "agent");
            asm volatile("s_waitcnt vmcnt(0)" ::: "memory");
        }
    }
    __syncthreads();
}

struct Args { const float* in[22]; float* out; unsigned char* ws; int ph_lo, ph_hi, li, flags; };
struct Frame {
    LAS unsigned char* lds; volatile LAS unsigned* MISC; gu32* ctl;
    int tid, lane, wave, vcu, G;
};
#ifndef SKEW_P2
#define SKEW_P2 0
#endif
#ifndef SKEW_P45
#define SKEW_P45 0
#endif
__device__ __forceinline__ void phase_skew(int vcu, unsigned ticks) {
    if (ticks) { const unsigned long long t0 = __builtin_amdgcn_s_memrealtime(), d = (unsigned long long)(vcu & 7) * ticks;
        while (__builtin_amdgcn_s_memrealtime() - t0 < d) __builtin_amdgcn_s_sleep(8); }
}
__device__ __forceinline__ int fresh_tid() { int t = threadIdx.x; asm volatile("" : "+v"(t)); return t; }
#define PHASE_IDS() do { F.tid = fresh_tid(); F.lane = F.tid & 63; F.wave = __builtin_amdgcn_readfirstlane(F.tid >> 6); } while (0)

__device__ __forceinline__ void transpose_item(const float* W, int ldw, int k0, int n0, bf16_t* WT, size_t row_off, int Kd, LAS float* scr, int lane) {
    const int half = lane >> 5, j2 = 2 * (lane & 31);
#pragma unroll 8
    for (int i = 0; i < 32; ++i) { const int kk = 2 * i + half; const f32x2 v = *(const f32x2*)(W + (size_t)(k0 + kk) * ldw + n0 + j2); scr[kk * 65 + j2] = v.x; scr[kk * 65 + j2 + 1] = v.y; }
    LDS_WAIT(); asm volatile("" ::: "memory");
    const int c = lane & 7;
#pragma unroll
    for (int j = 0; j < 8; ++j) { const int n = (lane >> 3) + 8 * j; const LAS float* s = scr + (8 * c) * 65 + n;
        u32x4 o; o.x = cvt_pk_bf16(s[0 * 65], s[1 * 65]); o.y = cvt_pk_bf16(s[2 * 65], s[3 * 65]); o.z = cvt_pk_bf16(s[4 * 65], s[5 * 65]); o.w = cvt_pk_bf16(s[6 * 65], s[7 * 65]);
        *(u32x4*)(WT + (row_off + n0 + n) * (size_t)Kd + k0 + 8 * c) = o; }
    LDS_WAIT(); asm volatile("" ::: "memory");
}

__global__ void __launch_bounds__(NWAVES * 64, 2) hybrid_fwd(Args args) {
    extern __shared__ __attribute__((aligned(16))) unsigned char lds_raw[];
    Frame F;
    F.lds = (LAS unsigned char*)lds_raw;
    F.MISC = (volatile LAS unsigned*)(F.lds + MISC_OFF);
    F.tid = threadIdx.x; F.lane = F.tid & 63; F.wave = __builtin_amdgcn_readfirstlane(F.tid >> 6);
    F.G = gridDim.x; { const int bx = blockIdx.x; F.vcu = (F.G % 8 == 0) ? (bx % 8) * (F.G / 8) + bx / 8 : bx; }
    unsigned char* ws = args.ws;
    F.ctl = (gu32*)(ws + WS_CTL);
    const float* x = args.in[0]; const float* cvec = args.in[1]; const float* ada_w = args.in[2]; const float* ada_b = args.in[3];
    const float* norm1_g = args.in[4]; const float* norm2_g = args.in[5]; const float* w_in = args.in[6]; const float* gmlp_ln_g = args.in[7]; const float* gmlp_ln_b = args.in[8];
    const float* w_spatial = args.in[9]; const float* b_spatial = args.in[10]; const float* w_branch_a = args.in[11]; const float* w_branch_b = args.in[12]; const float* w_out = args.in[13];
    const float* w_rg = args.in[14]; const float* b_rg = args.in[15]; const float* w_re = args.in[16]; const float* b_re = args.in[17];
    const float* w_gate = args.in[18]; const float* w_up = args.in[19]; const float* w_down = args.in[20]; const float* final_g = args.in[21];
    float* out = args.out;
    float* KSUM = (float*)(ws + WS_KSUM); float* MODP = (float*)(ws + WS_MODP); float* MOD = (float*)(ws + WS_MOD); float* ROPE = (float*)(ws + WS_ROPE);
    bf16_t* WST = (bf16_t*)(ws + WS_WST); bf16_t* WRT = (bf16_t*)(ws + WS_WRT); float* SSQ = (float*)(ws + WS_SSQ);
    unsigned long long* ROUTE = (unsigned long long*)(ws + WS_ROUTE);
    bf16_t* WIN = (bf16_t*)(ws + WS_WIN); bf16_t* WAB = (bf16_t*)(ws + WS_WAB); bf16_t* WOUT = (bf16_t*)(ws + WS_WOUT);
    bf16_t* WGU = (bf16_t*)(ws + WS_WGU); bf16_t* WD = (bf16_t*)(ws + WS_WD);
    bf16_t* XN = (bf16_t*)(ws + WS_XN); bf16_t* PROJ = (bf16_t*)(ws + WS_PROJ); bf16_t* HID = (bf16_t*)(ws + WS_HID); bf16_t* YB = (bf16_t*)(ws + WS_Y); bf16_t* X1 = (bf16_t*)(ws + WS_X1);
    bf16_t* PO = (bf16_t*)(ws + WS_PO); float* PML = (float*)(ws + WS_PML); unsigned short* LIST = (unsigned short*)(ws + WS_LIST); unsigned* CNT = (unsigned*)(F.ctl + CW_CNT);

    for (int u = F.tid; u < 256; u += NWAVES * 64) ((LAS unsigned*)(F.lds + MISC_OFF))[u] = 0u;
    __syncthreads();
    XcdBarrier bar; bar.bar = (unsigned*)(F.ctl + CW_BAR) + args.li * XCD_BAR_WORDS; bar.x = 0; bar.st = nullptr;
    if (!MK_PER_PHASE) bar = xcd_barrier_post((unsigned*)(F.ctl + CW_BAR) + args.li * XCD_BAR_WORDS, F.MISC + 8);
    const int lo = args.ph_lo, hi = args.ph_hi;
#define IN(k) (lo <= (k) && (k) < hi)
#define SEAM(k) do { if (IN(k) && IN((k) + 1)) xcd_barrier(bar); } while (0)

    if (IN(0)) { PHASE_IDS();
        const int gw = F.vcu * NWAVES + F.wave, NGW = F.G * NWAVES;
        const int gtid = F.vcu * (NWAVES * 64) + F.tid, NGT = F.G * NWAVES * 64;
        LAS float* scr = (LAS float*)(F.lds + F.wave * 16640);
        constexpr int I_MOD = 16 * 24, I_IN = 16 * 72, I_A = 8 * 16, I_O = 16 * 16;
        constexpr int NITEMS = I_MOD + I_IN + 2 * I_A + I_O;
        for (int it = gw; it < NITEMS; it += NGW) {
            int r = it;
            if (r < I_MOD) {
                const int s = r / 24, nc = r % 24, n = nc * 256 + 4 * F.lane;
                f32x4 a0 = {0.f, 0.f, 0.f, 0.f}, a1 = a0, a2 = a0, a3 = a0;
#pragma unroll 8
                for (int kk = 0; kk < 64; ++kk) { const int k = 64 * s + kk; const f32x4 w = *(const f32x4*)(ada_w + (size_t)k * 6144 + n);
                    a0 += w * cvec[k]; a1 += w * cvec[1024 + k]; a2 += w * cvec[2048 + k]; a3 += w * cvec[3072 + k]; }
                float* dst = MODP + (size_t)s * 24576 + n;
                *(f32x4*)(dst) = a0; *(f32x4*)(dst + 6144) = a1; *(f32x4*)(dst + 12288) = a2; *(f32x4*)(dst + 18432) = a3;
                continue; }
            r -= I_MOD;
            if (r < I_IN) { transpose_item(w_in, PC, 64 * (r / 72), 64 * (r % 72), WIN, 0, 1024, scr, F.lane); continue; } r -= I_IN;
            if (r < I_A) { transpose_item(w_branch_a, 1024, 64 * (r / 16), 64 * (r % 16), WAB, 0, 1024, scr, F.lane); continue; } r -= I_A;
            if (r < I_A) { transpose_item(w_branch_b, 1024, 64 * (r / 16), 64 * (r % 16), WAB + 512, 0, 1024, scr, F.lane); continue; } r -= I_A;
            transpose_item(w_out, 1024, 64 * (r / 16), 64 * (r % 16), WOUT, 0, 1024, scr, F.lane);
        }
        for (int i = gtid; i < 65536; i += NGT) {
            const int pos = i >> 3, j = i & 7; const float inv = powf(500000.0f, -(float)j * 2.0f / 16.0f); const float ang = (float)pos * inv;
            ROPE[i] = cosf(ang); ROPE[65536 + i] = sinf(ang); }
        for (int i = gtid; i < 65536; i += NGT) {
            const int s = i & 127, t_ = (i >> 7) & 127; const float v = (s <= t_) ? w_spatial[i] : 0.f; WST[i] = (bf16_t)(cvt_pk_bf16(v, 0.f) & 0xffffu); }
        for (int i = gtid; i < 48 * 1024; i += NGT) {
            const int j = i >> 10, k = i & 1023; float v = 0.f; if (j < 4) v = w_rg[k * 4 + j]; else if (j < 36) v = w_re[k * 32 + (j - 4)];
            const unsigned hb = cvt_pk_bf16(v, 0.f) & 0xffffu; const float lo = v - bflo(hb);
            WRT[i] = (bf16_t)hb; WRT[48 * 1024 + i] = (bf16_t)(cvt_pk_bf16(lo, 0.f) & 0xffffu); }
    }
    SEAM(0);

    if (IN(1)) { PHASE_IDS();
        const int c = F.vcu, b = c >> 6;
        LAS float* f = (LAS float*)F.lds;
        for (int v = F.tid; v < 2048; v += NWAVES * 64) { float s = ada_b[v];
#pragma unroll
            for (int sl = 0; sl < 16; ++sl) s += MODP[(size_t)sl * 24576 + b * 6144 + v];
            f[v] = s; }
        if (F.tid < 96) { const int idx = 96 * c + F.tid; float s = ada_b[idx % 6144];
#pragma unroll
            for (int sl = 0; sl < 16; ++sl) s += MODP[(size_t)sl * 24576 + idx];
            MOD[idx] = s; }
        __syncthreads();
        f32x4 A1[4], B1[4];
#pragma unroll
        for (int j = 0; j < 4; ++j) { const int k = 4 * F.lane + 256 * j; const f32x4 g = *(const f32x4*)(norm1_g + k);
#pragma unroll
            for (int i = 0; i < 4; ++i) { A1[j][i] = g[i] * (1.0f + f[1024 + k + i]); B1[j][i] = f[k + i]; } }
        for (int i0 = 0; i0 < 16; i0 += 4) {
            f32x4 v[4][4]; float ss[4];
#pragma unroll
            for (int u_ = 0; u_ < 4; ++u_) { const size_t row = (size_t)c * 128 + F.wave * 16 + i0 + u_; const f32x4* xr = (const f32x4*)(x + row * DM) + F.lane;
#pragma unroll
                for (int j = 0; j < 4; ++j) v[u_][j] = xr[64 * j]; }
#pragma unroll
            for (int u_ = 0; u_ < 4; ++u_) { float s = 0.f;
#pragma unroll
                for (int j = 0; j < 4; ++j) s += (v[u_][j].x * v[u_][j].x + v[u_][j].y * v[u_][j].y) + (v[u_][j].z * v[u_][j].z + v[u_][j].w * v[u_][j].w);
                ss[u_] = s; }
#pragma unroll
            for (int o_ = 1; o_ < 64; o_ <<= 1) {
#pragma unroll
                for (int u_ = 0; u_ < 4; ++u_) ss[u_] += __shfl_xor(ss[u_], o_); }
#pragma unroll
            for (int u_ = 0; u_ < 4; ++u_) { const size_t row = (size_t)c * 128 + F.wave * 16 + i0 + u_; const float rstd = 1.0f / sqrtf(ss[u_] * (1.0f / DM) + EPS);
                u32x2* o8 = (u32x2*)(XN + row * DM) + F.lane;
#pragma unroll
                for (int j = 0; j < 4; ++j) { const f32x4 hv = v[u_][j] * rstd * A1[j] + B1[j]; u32x2 w; w.x = cvt_pk_bf16(hv.x, hv.y); w.y = cvt_pk_bf16(hv.z, hv.w); o8[64 * j] = w; } } }
        __syncthreads();
    }
    SEAM(1);

    if (IN(2)) {
        pg8::DenseSched S; S.init(XN, DM, WIN, DM, T, PC, F.G, (int)blockIdx.x);
        pg8::EpiProj E{PROJ, ROPE, KSUM};
        phase_skew(F.vcu, SKEW_P2);
        pg8::gemm_phase<pg8::EpiProj, pg8::DenseSched, false>(F.lds, S, E);
    }
    SEAM(2);

    if (IN(3)) { PHASE_IDS();
        for (int chunk = F.vcu; chunk < ((args.flags & 2) ? 0 : T / 128); chunk += F.G) {
            const int lane = F.lane, w = F.wave, q = lane >> 4, l15 = lane & 15;
            const size_t row0 = (size_t)chunk * 128;
            float lg[8], lb[8];
            { const f32x4 g0 = *(const f32x4*)(gmlp_ln_g + 8 * lane), g1 = *(const f32x4*)(gmlp_ln_g + 8 * lane + 4), b0 = *(const f32x4*)(gmlp_ln_b + 8 * lane), b1 = *(const f32x4*)(gmlp_ln_b + 8 * lane + 4);
#pragma unroll
              for (int j = 0; j < 4; ++j) { lg[j] = g0[j]; lg[4 + j] = g1[j]; lb[j] = b0[j]; lb[4 + j] = b1[j]; } }
            u32x4 vn[16];
#pragma unroll
            for (int i = 0; i < 16; ++i) vn[i] = *(const u32x4*)(PROJ + (row0 + 16 * w + i) * PC + C_V + 8 * lane);
#pragma unroll
            for (int hb = 0; hb < 16; hb += 8) {
                float s1[8], s2[8];
#pragma unroll
                for (int i = 0; i < 8; ++i) { const u32x4 raw = vn[hb + i];
                    u32x4 gv; gv.x = cvt_pk_bf16(gelu_tanh(bflo(raw.x)), gelu_tanh(bfhi(raw.x))); gv.y = cvt_pk_bf16(gelu_tanh(bflo(raw.y)), gelu_tanh(bfhi(raw.y)));
                    gv.z = cvt_pk_bf16(gelu_tanh(bflo(raw.z)), gelu_tanh(bfhi(raw.z))); gv.w = cvt_pk_bf16(gelu_tanh(bflo(raw.w)), gelu_tanh(bfhi(raw.w)));
                    const float v0 = bflo(gv.x), v1 = bfhi(gv.x), v2 = bflo(gv.y), v3 = bfhi(gv.y), v4 = bflo(gv.z), v5 = bfhi(gv.z), v6 = bflo(gv.w), v7 = bfhi(gv.w);
                    s1[i] = ((v0 + v1) + (v2 + v3)) + ((v4 + v5) + (v6 + v7)); s2[i] = ((v0 * v0 + v1 * v1) + (v2 * v2 + v3 * v3)) + ((v4 * v4 + v5 * v5) + (v6 * v6 + v7 * v7));
                    vn[hb + i] = gv; }
#pragma unroll
                for (int o_ = 1; o_ < 64; o_ <<= 1) {
#pragma unroll
                    for (int i = 0; i < 8; ++i) { s1[i] += __shfl_xor(s1[i], o_); s2[i] += __shfl_xor(s2[i], o_); } }
#pragma unroll
                for (int i = 0; i < 8; ++i) { const float mean = s1[i] * (1.0f / 512.0f); const float var = fmaxf(s2[i] * (1.0f / 512.0f) - mean * mean, 0.f); const float rstd = 1.0f / sqrtf(var + EPS);
                    const u32x4 gv = vn[hb + i]; float v[8] = {bflo(gv.x), bfhi(gv.x), bflo(gv.y), bfhi(gv.y), bflo(gv.z), bfhi(gv.z), bflo(gv.w), bfhi(gv.w)};
#pragma unroll
                    for (int j = 0; j < 8; ++j) v[j] = (v[j] - mean) * rstd * lg[j] + lb[j];
                    vn[hb + i].x = cvt_pk_bf16(v[0], v[1]); vn[hb + i].y = cvt_pk_bf16(v[2], v[3]); vn[hb + i].z = cvt_pk_bf16(v[4], v[5]); vn[hb + i].w = cvt_pk_bf16(v[6], v[7]); }
            }
            const int tt = 16 * w + l15;
            u32x2 wfr[4][2]; u32x4 uq[4];
#define GM_LOAD(WF, UQ, g_) do { const bf16_t* wp_ = WST + ((size_t)((g_) * 128 + tt)) * 128 + 4 * q; \
                _Pragma("unroll") for (int ks = 0; ks < 4; ++ks) { WF[ks][0] = *(const u32x2*)(wp_ + 32 * ks); WF[ks][1] = *(const u32x2*)(wp_ + 32 * ks + 16); } \
                _Pragma("unroll") for (int i = 0; i < 4; ++i) UQ[i] = *(const u32x4*)(PROJ + (row0 + 16 * w + 4 * i + q) * PC + C_U + 128 * (g_) + 8 * l15); } while (0)
            GM_LOAD(wfr, uq, 0);
#pragma unroll
            for (int g = 0; g < 4; ++g) {
                __syncthreads();
                if (q == g) {
#pragma unroll
                    for (int i = 0; i < 16; ++i) *(LAS u32x4*)(F.lds + (16 * w + i) * 288 + l15 * 16) = vn[i];
                }
                __syncthreads();
                u32x2 wfn[4][2]; u32x4 uqn[4];
                if (g < 3) GM_LOAD(wfn, uqn, g + 1);
                f32x4 acc[8];
#pragma unroll
                for (int it = 0; it < 8; ++it) acc[it] = (f32x4){0.f, 0.f, 0.f, 0.f};
                const int nks = (16 * w + 16 + 31) / 32;
#pragma unroll
                for (int ks = 0; ks < 4; ++ks) { if (ks < nks) {
                    const bf16x8 bw = __builtin_bit_cast(bf16x8, (u32x4){wfr[ks][0].x, wfr[ks][0].y, wfr[ks][1].x, wfr[ks][1].y});
                    const attn_body::lds_cptr base = (attn_body::lds_cptr)F.lds + (32 * ks + 4 * q + (l15 >> 2)) * 288 + (l15 & 3) * 8;
#pragma unroll
                    for (int it = 0; it < 8; ++it) {
                        const s16x4 lo = attn_body::vtr(base + it * 32), hi_ = attn_body::vtr(base + 16 * 288 + it * 32);
                        const bf16x8 a = (bf16x8){lo[0], lo[1], lo[2], lo[3], hi_[0], hi_[1], hi_[2], hi_[3]};
                        acc[it] = __builtin_amdgcn_mfma_f32_16x16x32_bf16(a, bw, acc[it], 0, 0, 0);
                    } } }
                const float bs = b_spatial[g * 128 + tt];
                LAS unsigned char* svb = F.lds + 36864;
#pragma unroll
                for (int it = 0; it < 8; ++it) { u32x2 o; o.x = cvt_pk_bf16(acc[it][0] + bs, acc[it][1] + bs); o.y = cvt_pk_bf16(acc[it][2] + bs, acc[it][3] + bs);
                    *(LAS u32x2*)(svb + tt * 272 + (16 * it + 4 * q) * 2) = o; }
                LDS_WAIT(); asm volatile("" ::: "memory");
#pragma unroll
                for (int i = 0; i < 4; ++i) { const int tr_ = 16 * w + 4 * i + q; bf16_t* pp = PROJ + (row0 + tr_) * PC + C_U + 128 * g + 8 * l15;
                    const u32x4 uu = uq[i]; const u32x4 sv = *(const LAS u32x4*)(svb + tr_ * 272 + l15 * 16);
                    u32x4 o; o.x = cvt_pk_bf16(gelu_tanh(bflo(uu.x)) * bflo(sv.x), gelu_tanh(bfhi(uu.x)) * bfhi(sv.x)); o.y = cvt_pk_bf16(gelu_tanh(bflo(uu.y)) * bflo(sv.y), gelu_tanh(bfhi(uu.y)) * bfhi(sv.y));
                    o.z = cvt_pk_bf16(gelu_tanh(bflo(uu.z)) * bflo(sv.z), gelu_tanh(bfhi(uu.z)) * bfhi(sv.z)); o.w = cvt_pk_bf16(gelu_tanh(bflo(uu.w)) * bflo(sv.w), gelu_tanh(bfhi(uu.w)) * bfhi(sv.w));
                    *(u32x4*)pp = o; }
                LDS_WAIT(); asm volatile("" ::: "memory");
                if (g < 3) {
#pragma unroll
                    for (int ks = 0; ks < 4; ++ks) { wfr[ks][0] = wfn[ks][0]; wfr[ks][1] = wfn[ks][1]; }
#pragma unroll
                    for (int i = 0; i < 4; ++i) uq[i] = uqn[i]; }
            }
            __syncthreads();
        }
        {
            using namespace attn_body;
            const int s = F.vcu & 7, bh = F.vcu >> 3;
            const bf16* Qp = (const bf16*)(PROJ + C_Q); const bf16* Kp = (const bf16*)(PROJ + C_K); const bf16* Vp = (const bf16*)(PROJ + C_VV);
#define QBI(i) (((i) == 0) ? s : ((i) == 1) ? 15 - s : ((i) == 2) ? 16 + s : 31 - s)
            if (ATTN_MODE != 0) {
                if (bh < NB * 8 && !(args.flags & 4)) for (int i = 0; i < 4; ++i) select_unit(bh >> 3, bh & 7, QBI(i), Qp, KSUM, LIST, CNT, (char*)lds_raw + 40960);
                if (!MK_PER_PHASE) xcd_barrier(bar);
                if (!(args.flags & 8)) gather_phase<8>((char*)lds_raw, Qp, Kp, Vp, LIST, CNT, PO, PML, F.vcu, F.G, (args.flags & 1) == 0);
                if (!MK_PER_PHASE) xcd_barrier(bar);
                bf16* Op = (bf16*)(PROJ + (ATTN_MODE == 2 ? C_V : C_Q));
                if (bh < NB * 8 && !(args.flags & 16)) for (int i = 0; i < 4; ++i) attn_unit<8, true>(bh >> 3, bh & 7, QBI(i), Qp, Kp, Vp, Op, KSUM, (char*)lds_raw, (args.flags & 1) == 0, PO, PML);
            }
            if (ATTN_MODE == 0) {
                if (bh < NB * 8) for (int i = 0; i < 4; ++i) attn_unit<8, false>(bh >> 3, bh & 7, QBI(i), Qp, Kp, Vp, (bf16*)(PROJ + C_Q), KSUM, (char*)lds_raw, (args.flags & 1) == 0, PO, PML);
            }
#undef QBI
#undef GM_LOAD
        }
        VM_WAIT(); __syncthreads();
    }
    SEAM(3);

    if (IN(4)) {
        pg8::DenseSched S; S.init(PROJ + C_U, PC, WAB, 1024, T, DM, F.G, (int)blockIdx.x); S.ksplit = 8; S.kgap = (unsigned)(C_Q - C_U - 512) * 2u;
        pg8::EpiMergeF E{PROJ, XN};
        phase_skew(F.vcu, SKEW_P45);
        pg8::gemm_phase<pg8::EpiMergeF, pg8::DenseSched, false>(F.lds, S, E);
    }
    SEAM(4);

    if (IN(5)) {
        pg8::DenseSched S; S.init(XN, DM, WOUT, DM, T, DM, F.G, (int)blockIdx.x); pg8::EpiOut E{x, X1, MOD, SSQ};
        phase_skew(F.vcu, SKEW_P45);
        pg8::gemm_phase<pg8::EpiOut, pg8::DenseSched, false>(F.lds, S, E);
    }
    SEAM(5);

    if (IN(6)) { PHASE_IDS();
        {
            LAS float* scr = (LAS float*)(F.lds + F.wave * 16640);
            const int gw = F.vcu * NWAVES + F.wave, NGW = F.G * NWAVES;
            constexpr int I_G = 32 * 16 * 8, I_D = 32 * 8 * 16;
            for (int it = gw; it < 2 * I_G + I_D; it += NGW) { int r = it;
                if (r < 2 * I_G) { const bool up = r >= I_G; if (up) r -= I_G; const int e = r / 128, kb = (r % 128) / 8, nb = r % 8, n0 = 64 * nb;
                    const size_t row_off = (size_t)e * 1024 + (size_t)(n0 / 128) * 256 + (up ? 128 : 0) + (n0 % 128) - n0;
                    transpose_item((up ? w_up : w_gate) + (size_t)e * 1024 * 512, 512, 64 * kb, n0, WGU, row_off, 1024, scr, F.lane); continue; }
                r -= 2 * I_G;
                { const int e = r / 128, kb = (r % 128) / 16, nb = r % 16; transpose_item(w_down + (size_t)e * 512 * 1024, 1024, 64 * kb, 64 * nb, WD, (size_t)e * 1024, 512, scr, F.lane); } }
            __syncthreads();
        }
        const int c = F.vcu, b = c >> 6, lane = F.lane, w = F.wave, r = lane & 15, q = lane >> 4;
        LAS float* A2 = (LAS float*)F.lds; LAS float* B2 = A2 + 1024; LAS float* LG = (LAS float*)(F.lds + 8192) + w * 768;
        LAS unsigned* hist = (LAS unsigned*)(F.lds + 8192 + 8 * 3072); LAS unsigned* basev = hist + 32;
        for (int k = F.tid; k < 1024; k += NWAVES * 64) { A2[k] = norm2_g[k] * (1.0f + MOD[b * 6144 + 4096 + k]); B2[k] = MOD[b * 6144 + 3072 + k]; }
        if (F.tid < 32) hist[F.tid] = 0u;
        __syncthreads();
        const size_t row = (size_t)c * 128 + w * 16 + r;
        float rs;
        { const f32x4* sp = (const f32x4*)(SSQ + row * 16); const f32x4 s0 = sp[0], s1 = sp[1], s2 = sp[2], s3 = sp[3];
          const float ss = ((s0[0] + s0[1]) + (s0[2] + s0[3])) + ((s1[0] + s1[1]) + (s1[2] + s1[3])) + ((s2[0] + s2[1]) + (s2[2] + s2[3])) + ((s3[0] + s3[1]) + (s3[2] + s3[3]));
          rs = 1.0f / sqrtf(ss * (1.0f / DM) + EPS); }
        f32x4 acc[3];
#pragma unroll
        for (int jt = 0; jt < 3; ++jt) acc[jt] = (f32x4){0.f, 0.f, 0.f, 0.f};
        const bf16_t* xrow = X1 + row * DM;
#pragma unroll 2
        for (int s = 0; s < 32; ++s) { const int k0 = 32 * s + 8 * q;
            const u32x4 xr = *(const u32x4*)(xrow + k0);
            const f32x4 x0 = {bflo(xr.x), bfhi(xr.x), bflo(xr.y), bfhi(xr.y)}, x1v = {bflo(xr.z), bfhi(xr.z), bflo(xr.w), bfhi(xr.w)};
            const f32x4 a0 = *(const LAS f32x4*)(A2 + k0), a1 = *(const LAS f32x4*)(A2 + k0 + 4), b0 = *(const LAS f32x4*)(B2 + k0), b1 = *(const LAS f32x4*)(B2 + k0 + 4);
            const f32x4 h0 = x0 * rs * a0 + b0, h1 = x1v * rs * a1 + b1;
            u32x4 hw; hw.x = cvt_pk_bf16(h0[0], h0[1]); hw.y = cvt_pk_bf16(h0[2], h0[3]); hw.z = cvt_pk_bf16(h1[0], h1[1]); hw.w = cvt_pk_bf16(h1[2], h1[3]);
            *(u32x4*)(XN + row * DM + k0) = hw;
            u32x4 lw; lw.x = cvt_pk_bf16(h0[0] - bflo(hw.x), h0[1] - bfhi(hw.x)); lw.y = cvt_pk_bf16(h0[2] - bflo(hw.y), h0[3] - bfhi(hw.y));
            lw.z = cvt_pk_bf16(h1[0] - bflo(hw.z), h1[1] - bfhi(hw.z)); lw.w = cvt_pk_bf16(h1[2] - bflo(hw.w), h1[3] - bfhi(hw.w));
            const bf16x8 hb = __builtin_bit_cast(bf16x8, hw), hl = __builtin_bit_cast(bf16x8, lw);
#pragma unroll
            for (int jt = 0; jt < 3; ++jt) { const bf16x8 wf = *(const bf16x8*)(WRT + (size_t)(16 * jt + r) * 1024 + k0), wl = *(const bf16x8*)(WRT + 48 * 1024 + (size_t)(16 * jt + r) * 1024 + k0);
                acc[jt] = __builtin_amdgcn_mfma_f32_16x16x32_bf16(wf, hb, acc[jt], 0, 0, 0);
                acc[jt] = __builtin_amdgcn_mfma_f32_16x16x32_bf16(wf, hl, acc[jt], 0, 0, 0);
                acc[jt] = __builtin_amdgcn_mfma_f32_16x16x32_bf16(wl, hb, acc[jt], 0, 0, 0); } }
#pragma unroll
        for (int jt = 0; jt < 3; ++jt) *(LAS f32x4*)(LG + r * 48 + 16 * jt + 4 * q) = acc[jt];
        LDS_WAIT(); asm volatile("" ::: "memory");
        int E0 = 0, E1 = 0; float w0 = 0.f, w1 = 0.f; unsigned lp0 = 0u, lp1 = 0u;
        if (lane < 16) {
            const LAS float* lgp = LG + lane * 48;
            float gl[4];
#pragma unroll
            for (int j = 0; j < 4; ++j) gl[j] = lgp[j] + b_rg[j];
            int g = 0; float gm = gl[0];
#pragma unroll
            for (int j = 1; j < 4; ++j) if (gl[j] > gm) { gm = gl[j]; g = j; }
            float gs = 0.f;
#pragma unroll
            for (int j = 0; j < 4; ++j) gs += __expf(gl[j] - gm);
            const float gp = 1.0f / gs;
            float m0 = -INFINITY, m1 = -INFINITY; int i0 = 0, i1 = 0;
#pragma unroll
            for (int j = 0; j < 8; ++j) { const float el = lgp[4 + 8 * g + j] + b_re[g * 8 + j];
                if (el > m0) { m1 = m0; i1 = i0; m0 = el; i0 = j; } else if (el > m1) { m1 = el; i1 = j; } }
            const float d = __expf(m1 - m0), inv = 1.0f / (1.0f + d);
            w0 = gp * inv; w1 = gp * d * inv; E0 = 8 * g + i0; E1 = 8 * g + i1;
            lp0 = __hip_atomic_fetch_add(hist + E0, 1u, __ATOMIC_RELAXED, __HIP_MEMORY_SCOPE_WORKGROUP);
            lp1 = __hip_atomic_fetch_add(hist + E1, 1u, __ATOMIC_RELAXED, __HIP_MEMORY_SCOPE_WORKGROUP);
        }
        __syncthreads();
        if (F.tid < 32) { const unsigned n = hist[F.tid]; basev[F.tid] = n ? __hip_atomic_fetch_add((unsigned*)(F.ctl + CW_CURSOR + 64 * F.tid), n, RLX_AGENT) : 0u; }
        __syncthreads();
        if (lane < 16) { const unsigned tok = (unsigned)(c * 128 + w * 16 + lane);
            ROUTE[(size_t)E0 * 32768 + basev[E0] + lp0] = ((unsigned long long)__float_as_uint(w0) << 32) | (unsigned long long)(2u * tok);
            ROUTE[(size_t)E1 * 32768 + basev[E1] + lp1] = ((unsigned long long)__float_as_uint(w1) << 32) | (unsigned long long)(2u * tok + 1u); }
        __syncthreads();
    }
    SEAM(6);

    if (IN(7) || IN(8)) { PHASE_IDS();
        volatile LAS int* tab = (volatile LAS int*)(F.lds + MISC_OFF + 256);
        if (F.tid < 32) tab[F.tid] = (int)__hip_atomic_load((unsigned*)(F.ctl + CW_CURSOR + 64 * F.tid), RLX_AGENT);
        __syncthreads();
        if (F.tid == 0) { int o = 0; for (int e = 0; e < 32; ++e) { tab[32 + e] = o; o += (tab[e] + 255) >> 8; } tab[64] = o; }
        __syncthreads();
        const int U = 4 * __builtin_amdgcn_readfirstlane(tab[64]);
        const int xq = F.vcu >> 5, jj = F.vcu & 31;
        pg8::MoeSched S; S.tab = tab; S.start = (int)(((long)U * xq) / 8); S.end = (int)(((long)U * (xq + 1)) / 8); S.j = jj; S.route = ROUTE; S.ready = (unsigned*)(F.ctl + CW_READY);
        if (IN(7)) {
            S.A = (const char*)XN; S.lda = DM; S.K = DM; S.Bt = (const char*)WGU; S.bstride = (size_t)1024 * 1024 * 2; S.gather = true; S.mode = 1;
            pg8::EpiGU E{HID};
            pg8::gemm_phase<pg8::EpiGU, pg8::MoeSched, true>(F.lds, S, E);
        }
        if (IN(8)) {
            S.A = (const char*)HID; S.lda = DEXP; S.K = DEXP; S.Bt = (const char*)WD; S.bstride = (size_t)1024 * 512 * 2; S.gather = false; S.mode = 2; S.j = (jj + 24) & 31; S.qhead = (unsigned*)(F.ctl + CW_QHEAD + 64 * xq); S.qslot = (volatile LAS int*)(F.lds + MISC_OFF + 640);
            pg8::EpiDown E{YB, ROUTE};
            pg8::gemm_phase<pg8::EpiDown, pg8::MoeSched, false>(F.lds, S, E);
        }
    }
    SEAM(8);

    if (IN(9)) { PHASE_IDS();
        const int c = F.vcu, b = c >> 6;
        f32x4 G2[4], FG[4];
#pragma unroll
        for (int j = 0; j < 4; ++j) { const int k = 4 * F.lane + 256 * j; G2[j] = *(const f32x4*)(MOD + b * 6144 + 5120 + k); FG[j] = *(const f32x4*)(final_g + k); }
        for (int i0 = 0; i0 < 16; i0 += 4) {
            u32x2 ya[4][4], yb[4][4], xx[4][4]; f32x4 v[4][4]; float ss[4];
#pragma unroll
            for (int u_ = 0; u_ < 4; ++u_) { const size_t row = (size_t)c * 128 + F.wave * 16 + i0 + u_;
                const u32x2* xb = (const u32x2*)(X1 + row * DM) + F.lane; const u32x2* y0 = (const u32x2*)(YB + (2 * row) * DM) + F.lane; const u32x2* y1 = (const u32x2*)(YB + (2 * row + 1) * DM) + F.lane;
#pragma unroll
                for (int j = 0; j < 4; ++j) { ya[u_][j] = y0[64 * j]; yb[u_][j] = y1[64 * j]; xx[u_][j] = xb[64 * j]; } }
#pragma unroll
            for (int u_ = 0; u_ < 4; ++u_) { float s = 0.f;
#pragma unroll
                for (int j = 0; j < 4; ++j) { const u32x2 a = ya[u_][j], bb = yb[u_][j], x_ = xx[u_][j]; const f32x4 ys = {bflo(a.x) + bflo(bb.x), bfhi(a.x) + bfhi(bb.x), bflo(a.y) + bflo(bb.y), bfhi(a.y) + bfhi(bb.y)};
                    const f32x4 xv = {bflo(x_.x), bfhi(x_.x), bflo(x_.y), bfhi(x_.y)};
                    v[u_][j] = xv + G2[j] * ys; s += (v[u_][j].x * v[u_][j].x + v[u_][j].y * v[u_][j].y) + (v[u_][j].z * v[u_][j].z + v[u_][j].w * v[u_][j].w); }
                ss[u_] = s; }
#pragma unroll
            for (int o_ = 1; o_ < 64; o_ <<= 1) {
#pragma unroll
                for (int u_ = 0; u_ < 4; ++u_) ss[u_] += __shfl_xor(ss[u_], o_); }
#pragma unroll
            for (int u_ = 0; u_ < 4; ++u_) { const size_t row = (size_t)c * 128 + F.wave * 16 + i0 + u_; f32x4* xr = (f32x4*)(out + row * DM) + F.lane;
                const float rstd = 1.0f / sqrtf(ss[u_] * (1.0f / DM) + EPS);
#pragma unroll
                for (int j = 0; j < 4; ++j) xr[64 * j] = v[u_][j] * rstd * FG[j]; } }
    }
#undef IN
#undef SEAM
}


#if ATTN_MODE == 2
__global__ void __launch_bounds__(NWAVES * 64, 2) dbg_dense(Args args, int stage) {
    extern __shared__ __attribute__((aligned(16))) unsigned char lds_raw[];
    using namespace attn_body;
    unsigned char* ws = args.ws; bf16_t* PROJ = (bf16_t*)(ws + WS_PROJ); float* KSUM = (float*)(ws + WS_KSUM); gu32* ctl = (gu32*)(ws + WS_CTL);
    const int G = gridDim.x, bx = blockIdx.x, vcu = (bx % 8) * (G / 8) + bx / 8, tid = threadIdx.x, lane = tid & 63, wave = tid >> 6;
    if (stage == 0) {
        const int s = vcu & 7, bh = vcu >> 3;
        for (int i = 0; i < 4; ++i) { const int qb = (i == 0) ? s : (i == 1) ? 15 - s : (i == 2) ? 16 + s : 31 - s;
            attn_unit<8, false>(bh >> 3, bh & 7, qb, (const bf16*)(PROJ + C_Q), (const bf16*)(PROJ + C_K), (const bf16*)(PROJ + C_VV), (bf16*)(PROJ + C_Q), KSUM, (char*)lds_raw, true, nullptr, nullptr); }
    } else {
        float md = 0.f;
        for (int i = 0; i < 16; ++i) { const size_t row = (size_t)vcu * 128 + wave * 16 + i;
            const u32x4 a = *(const u32x4*)(PROJ + row * PC + C_V + 8 * lane), bq = *(const u32x4*)(PROJ + row * PC + C_Q + 8 * lane);
            md = fmaxf(md, fmaxf(fmaxf(fabsf(bflo(a.x) - bflo(bq.x)), fabsf(bfhi(a.x) - bfhi(bq.x))), fmaxf(fabsf(bflo(a.y) - bflo(bq.y)), fabsf(bfhi(a.y) - bfhi(bq.y)))));
            md = fmaxf(md, fmaxf(fmaxf(fabsf(bflo(a.z) - bflo(bq.z)), fabsf(bfhi(a.z) - bfhi(bq.z))), fmaxf(fabsf(bflo(a.w) - bflo(bq.w)), fabsf(bfhi(a.w) - bfhi(bq.w))))); }
#pragma unroll
        for (int o_ = 1; o_ < 64; o_ <<= 1) md = fmaxf(md, __shfl_xor(md, o_));
        if (lane == 0) atomicMax((unsigned*)(ctl + CW_DIFF), __float_as_uint(md));
    }
}
#endif
extern "C" void kernel_launch(void* const* d_in, const int* in_sizes, int n_in, void* d_out, int out_size, void* d_ws, size_t ws_size, hipStream_t stream) {
    static int grid = 0;
    if (grid == 0) {
        if (n_in != 22 || in_sizes[0] != T * DM || out_size != T * DM || ws_size < WS_END) { fprintf(stderr, "kernel_launch: unexpected shapes (n_in %d, in0 %d, out %d, ws %zu); nothing launched\n", n_in, n_in > 0 ? in_sizes[0] : -1, out_size, ws_size); grid = -1; return; }
        int dev = 0, cus = 0, per_cu = 0;
        if (hipGetDevice(&dev) != hipSuccess || hipDeviceGetAttribute(&cus, hipDeviceAttributeMultiprocessorCount, dev) != hipSuccess) { fprintf(stderr, "kernel_launch: device query failed\n"); grid = -1; return; }
        if (hipFuncSetAttribute((const void*)hybrid_fwd, hipFuncAttributeMaxDynamicSharedMemorySize, LDS_BYTES) != hipSuccess) { fprintf(stderr, "kernel_launch: hipFuncSetAttribute failed\n"); grid = -1; return; }
        if (hipOccupancyMaxActiveBlocksPerMultiprocessor(&per_cu, (const void*)hybrid_fwd, NWAVES * 64, LDS_BYTES) != hipSuccess || per_cu < 1) { fprintf(stderr, "kernel_launch: occupancy query reports %d blocks per CU\n", per_cu); }
        (void)hipGetLastError();
        if (cus != 256) { fprintf(stderr, "kernel_launch: built for 256 CUs, device has %d; nothing launched\n", cus); grid = -1; return; }
        grid = cus;
    }
    if (grid < 0) return;
    (void)hipMemsetAsync((char*)d_ws + WS_CTL, 0, CTL_ZERO_BYTES, stream);
    Args a{};
    for (int i = 0; i < 22; ++i) a.in[i] = (const float*)d_in[i];
    a.out = (float*)d_out; a.ws = (unsigned char*)d_ws;
    struct Spec { int lo, hi, flags; };
#if MK_PER_PHASE
    const Spec specs[10] = {{0,1,0},{1,2,0},{2,3,0},{3,4,0},{4,5,0},{5,6,0},{6,7,0},{7,8,0},{8,9,0},{9,10,0}}; const int nspec = 10;
#elif PROBE_ID == 1
    const Spec specs[2] = {{0,10,0},{0,2,0}}; const int nspec = 2;
#elif PROBE_ID == 2
    const Spec specs[2] = {{0,10,0},{2,3,0}}; const int nspec = 2;
#elif PROBE_ID == 3
    const Spec specs[3] = {{0,4,0},{3,4,1|2|4|16},{4,10,0}}; const int nspec = 3;
#elif PROBE_ID == 10
    const Spec specs[3] = {{0,4,0},{3,4,1|2|4|8},{4,10,0}}; const int nspec = 3;
#elif PROBE_ID == 11
    const Spec specs[3] = {{0,4,0},{3,4,1|2|8|16},{4,10,0}}; const int nspec = 3;
#elif PROBE_ID == 12
    const Spec specs[3] = {{0,4,0},{3,4,1|2|4|8|16},{4,10,0}}; const int nspec = 3;
#elif PROBE_ID == 13
    const Spec specs[2] = {{0,10,0},{3,4,1|4|8|16}}; const int nspec = 2;
#elif PROBE_ID == 4
    const Spec specs[3] = {{0,4,0},{4,5,0},{4,10,0}}; const int nspec = 3;
#elif PROBE_ID == 5
    const Spec specs[3] = {{0,5,0},{5,6,0},{5,10,0}}; const int nspec = 3;
#elif PROBE_ID == 6
    const Spec specs[2] = {{0,10,0},{7,8,0}}; const int nspec = 2;
#elif PROBE_ID == 7
    const Spec specs[2] = {{0,10,0},{8,9,0}}; const int nspec = 2;
#elif PROBE_ID == 14
    const Spec specs[2] = {{0,10,0},{7,9,0}}; const int nspec = 2;
#elif PROBE_ID == 15
    const Spec specs[2] = {{0,10,0},{9,10,0}}; const int nspec = 2;
#elif PROBE_ID == 16
    const Spec specs[2] = {{0,10,0},{6,7,0}}; const int nspec = 2;
#elif PROBE_ID == 8
    const Spec specs[2] = {{0,5,0},{5,10,0}}; const int nspec = 2;
#elif PROBE_ID == 9
    const Spec specs[2] = {{0,10,0},{0,1,0}}; const int nspec = 2;
#else
    const Spec specs[1] = {{0,10,0}}; const int nspec = 1;
#endif
#if ATTN_MODE == 2
    (void)hipFuncSetAttribute((const void*)dbg_dense, hipFuncAttributeMaxDynamicSharedMemorySize, LDS_BYTES);
    a.ph_lo = 0; a.ph_hi = 4; a.flags = 0; a.li = 0; hipLaunchKernelGGL(hybrid_fwd, dim3(grid), dim3(NWAVES * 64), LDS_BYTES, stream, a);
    hipLaunchKernelGGL(dbg_dense, dim3(grid), dim3(NWAVES * 64), LDS_BYTES, stream, a, 0);
    hipLaunchKernelGGL(dbg_dense, dim3(grid), dim3(NWAVES * 64), LDS_BYTES, stream, a, 1);
    a.ph_lo = 4; a.ph_hi = 10; a.li = 1; hipLaunchKernelGGL(hybrid_fwd, dim3(grid), dim3(NWAVES * 64), LDS_BYTES, stream, a);
    (void)nspec; (void)specs;
#else
    for (int li = 0; li < nspec; ++li) { a.ph_lo = specs[li].lo; a.ph_hi = specs[li].hi; a.flags = specs[li].flags; a.li = MK_PER_PHASE ? 0 : li;
        hipLaunchKernelGGL(hybrid_fwd, dim3(grid), dim3(NWAVES * 64), LDS_BYTES, stream, a); }
#endif
    const hipError_t le = hipPeekAtLastError();
    if (le != hipSuccess) fprintf(stderr, "kernel_launch: launch failed: %s\n", hipGetErrorName(le));
}
```

```cpp
#include <hip/hip_runtime.h>
#include <hip/hip_bf16.h>
#include <cstdio>
#include <cstdint>
#include <cmath>

#ifndef PROBE_ID
#define PROBE_ID 0
#endif
#ifndef ATTN_MODE
#define ATTN_MODE 1
#endif
#ifndef GPROBE
#define GPROBE 0
#endif
#ifndef TSEL
#define TSEL 0
#endif
#ifndef TPH
#define TPH -1
#endif
#ifndef TBLK
#define TBLK 0
#endif
#ifndef TVCU
#define TVCU 255
#endif
#define TMULT 8
__device__ unsigned long long g_tacc; __device__ int g_tphase; __device__ unsigned g_tw[256];
#define T_ON(k) (TSEL == (k) && blockIdx.x == TBLK && threadIdx.x == 0 && (TPH < 0 || g_tphase == TPH))
#define T_BEGIN(k, var) unsigned long long var = 0; if (TSEL == (k)) { if (T_ON(k)) var = __builtin_amdgcn_s_memrealtime(); }
#define T_END(k, var) do { if (TSEL == (k)) { if (T_ON(k)) g_tacc += __builtin_amdgcn_s_memrealtime() - var; } } while (0)
#define TP_BEGIN(ph, var) unsigned long long var = 0; if (TSEL == 4 && TPH == (ph)) { if (blockIdx.x == TBLK && threadIdx.x == 0) var = __builtin_amdgcn_s_memrealtime(); }
#define TP_END(ph, var) do { if (TSEL == 4 && TPH == (ph)) { if (blockIdx.x == TBLK && threadIdx.x == 0) g_tacc += __builtin_amdgcn_s_memrealtime() - var; } } while (0)
#ifndef MK_PER_PHASE
#define MK_PER_PHASE 0
#endif

#define LAS __attribute__((address_space(3)))
#define GAS __attribute__((address_space(1)))
typedef unsigned short bf16_t;
typedef short bf16x8 __attribute__((ext_vector_type(8)));
typedef short s16x4 __attribute__((ext_vector_type(4)));
typedef float f32x2 __attribute__((ext_vector_type(2)));
typedef float f32x4 __attribute__((ext_vector_type(4)));
typedef float f32x16 __attribute__((ext_vector_type(16)));
typedef unsigned u32x2 __attribute__((ext_vector_type(2)));
typedef unsigned u32x4 __attribute__((ext_vector_type(4)));
typedef GAS unsigned gu32;

constexpr int NB = 4, SEQ = 8192, DM = 1024, T = NB * SEQ;
constexpr int PC = 4608;
constexpr int C_U = 0, C_V = 512, C_Q = 1024, C_K = 1536, C_VV = 2048, C_GA = 2560, C_GB = 3584;
constexpr int NEXP = 32, DEXP = 512;
constexpr float EPS = 1e-6f;
constexpr float QSCALE = 0.125f * 1.4426950408889634f;

constexpr size_t MiB = 1u << 20;
constexpr size_t WS_CTL = 0, CTL_ZERO_BYTES = 2 * MiB;
constexpr size_t WS_KSUM = 1 * MiB;
constexpr size_t WS_MODP = 2 * MiB;
constexpr size_t WS_MOD = 3 * MiB + 512 * 1024;
constexpr size_t WS_ROPE = 4 * MiB;
constexpr size_t WS_WST = 4 * MiB + 512 * 1024;
constexpr size_t WS_WRT = 4 * MiB + 768 * 1024;
constexpr size_t WS_SSQ = 5 * MiB;
constexpr size_t WS_ROUTE = 8 * MiB;
constexpr size_t WS_WIN = 24 * MiB;
constexpr size_t WS_WAB = 34 * MiB, WS_WOUT = 36 * MiB;
constexpr size_t WS_WGU = 40 * MiB;
constexpr size_t WS_WD = 104 * MiB;
constexpr size_t WS_XN = 136 * MiB;
constexpr size_t WS_PROJ = 200 * MiB;
constexpr size_t WS_HID = 200 * MiB;
constexpr size_t WS_Y = 272 * MiB;
constexpr size_t WS_X1 = 400 * MiB;
constexpr size_t WS_PO = 40 * MiB;
constexpr size_t WS_PML = 136 * MiB;
constexpr size_t WS_LIST = 488 * MiB;
constexpr size_t WS_END = 504 * MiB;
constexpr int CW_TMO = 0, CW_DIFF = 2, CW_BAR = 4096, CW_CURSOR = 32768, CW_CNT = 65536, CW_READY = 131072, CW_QHEAD = 160000, CW_GQ = 161024;

constexpr int RING_BYTES = 131072;
constexpr int LDS_BYTES = 147456;
constexpr int MISC_OFF = LDS_BYTES - 1024;
constexpr int NWAVES = 8;

#define LDS_WAIT() asm volatile("s_waitcnt lgkmcnt(0)" ::: "memory")
#define VM_WAIT() asm volatile("s_waitcnt vmcnt(0)" ::: "memory")
#define RLX_AGENT __ATOMIC_RELAXED, __HIP_MEMORY_SCOPE_AGENT

__device__ __forceinline__ unsigned cvt_pk_bf16(float lo, float hi) { unsigned r; asm volatile("v_cvt_pk_bf16_f32 %0, %1, %2" : "=v"(r) : "v"(lo), "v"(hi)); return r; }
__device__ __forceinline__ float bflo(unsigned u) { return __uint_as_float(u << 16); }
__device__ __forceinline__ float bfhi(unsigned u) { return __uint_as_float(u & 0xffff0000u); }
__device__ __forceinline__ float sigmoidf_(float x) { return __builtin_amdgcn_rcpf(1.0f + __builtin_amdgcn_exp2f(-1.4426950408889634f * x)); }
__device__ __forceinline__ float gelu_tanh(float x) { const float u = x + 0.044715f * x * x * x; return x * __builtin_amdgcn_rcpf(1.0f + __builtin_amdgcn_exp2f(-2.3022081985f * u)); }
__device__ __forceinline__ float wave_sum(float v) {
#pragma unroll
    for (int o = 1; o < 64; o <<= 1) v += __shfl_xor(v, o);
    return v;
}

namespace pg8 {
constexpr int BM = 256, BK = 64, HALF = 128, HTB = HALF * BK * 2, STAGE_BYTES = 8 * HTB, NXCD = 8, WGM = 8;
__host__ __device__ __forceinline__ int lds_byte(int r, int c) { const int st = (r >> 4) * 2 + (c >> 5), rr = r & 15, cc = c & 31, ob = rr * 64 + cc * 2; return st * 1024 + (ob ^ (((ob >> 9) & 1) << 5)); }
__host__ __device__ __forceinline__ void stage_rc(int b, int& R, int& C) { const int st = b / 1024, sb = b % 1024, swz = sb ^ (((sb >> 9) & 1) << 5); R = (st >> 1) * 16 + swz / 64; C = (st & 1) * 32 + (swz % 64) / 2; }
__host__ __device__ __forceinline__ int perm32(int rho) { const int n = rho >> 4, i = rho & 15; return 8 * (i >> 2) + 4 * n + (i & 3); }

struct Unit { int pm, pn, e, lt, nvalid; };

struct DenseSched {
    const char* A; const char* Bt; int lda, K; int nM, nN, nwg, G, c; int ksplit; unsigned kgap;
    __device__ void init(const void* A_, int lda_, const void* Bt_, int K_, int M, int N, int G_, int c_) { A = (const char*)A_; Bt = (const char*)Bt_; lda = lda_; K = K_; nM = M / BM; nN = N / BM; nwg = nM * nN; G = G_; c = c_; ksplit = 1 << 20; kgap = 0u; }
    __device__ __forceinline__ bool next(int i, Unit& u) const {
        const long L = (long)i * G + c; if (L >= nwg) return false;
        int wgid = (int)L; { const int q = nwg / NXCD, r = nwg % NXCD, xcd = wgid % NXCD, off = wgid / NXCD; wgid = (xcd < r ? xcd * (q + 1) : r * (q + 1) + (xcd - r) * q) + off; }
        const int nig = WGM * nN, gid = wgid / nig, fm = gid * WGM, gsz = (nM - fm) < WGM ? (nM - fm) : WGM;
        u.pm = fm + ((wgid % nig) % gsz); u.pn = (wgid % nig) / gsz; u.e = 0; u.lt = 0; u.nvalid = 256; return true;
    }
    __device__ __forceinline__ const char* a_base(const Unit& u) const { return A + (size_t)u.pm * BM * lda * 2; }
    __device__ __forceinline__ const char* b_base(const Unit& u) const { return Bt + (size_t)u.pn * BM * K * 2; }
    __device__ __forceinline__ unsigned gather_off(const Unit&, int, int) const { return 0u; }
    __device__ __forceinline__ void a_ready(const Unit&) const {}
    __device__ __forceinline__ void done(const Unit&) const {}
};
struct MoeSched {
    const char* A; const char* Bt; int lda, K; size_t bstride;
    const unsigned long long* route; bool gather;
    const volatile LAS int* tab;
    int start, end, j; static constexpr int ksplit = 1 << 20; static constexpr unsigned kgap = 0u;
    unsigned* ready; int mode;
    __device__ __forceinline__ void done(const Unit& u) const {
        if (mode == 1) { asm volatile("s_waitcnt vmcnt(0)" ::: "memory");
            if ((threadIdx.x & 63) == 0) __hip_atomic_fetch_add(ready + 64 * u.pm, 1u, __ATOMIC_RELAXED, __HIP_MEMORY_SCOPE_AGENT); } }
    __device__ __forceinline__ void a_ready(const Unit& u) const {
        if (mode == 2) {
            if (threadIdx.x < 64) { unsigned sp = 0;
                while ((unsigned)__builtin_amdgcn_readfirstlane(__hip_atomic_load(ready + 64 * u.pm, __ATOMIC_RELAXED, __HIP_MEMORY_SCOPE_AGENT)) < 32u) { __builtin_amdgcn_s_sleep(2); if (++sp > (1u << 22)) break; }
                __builtin_amdgcn_fence(__ATOMIC_ACQUIRE, "agent");
                asm volatile("s_waitcnt vmcnt(0)" ::: "memory"); }
            asm volatile("" ::: "memory"); __builtin_amdgcn_s_barrier(); asm volatile("" ::: "memory"); } }
    unsigned* qhead; volatile LAS int* qslot;
    __device__ __forceinline__ bool next(int i, Unit& u) const {
        int idx;
        if (mode == 2) {
            if (threadIdx.x == 0) qslot[i & 1] = start + (int)__hip_atomic_fetch_add(qhead, 1u, __ATOMIC_RELAXED, __HIP_MEMORY_SCOPE_AGENT);
            asm volatile("s_waitcnt vmcnt(0) lgkmcnt(0)" ::: "memory"); __builtin_amdgcn_s_barrier(); asm volatile("" ::: "memory");
            idx = __builtin_amdgcn_readfirstlane(qslot[i & 1]);
        } else idx = start + i * 32 + j;
        if (idx >= end) return false;
        const int tile = idx >> 2; u.pn = idx & 3; u.pm = tile;
        int e = 0;
        for (int k = 1; k < 32; ++k) e += (__builtin_amdgcn_readfirstlane(tab[32 + k]) <= tile) ? 1 : 0;
        u.e = e; u.lt = tile - __builtin_amdgcn_readfirstlane(tab[32 + e]);
        const int rem = __builtin_amdgcn_readfirstlane(tab[e]) - 256 * u.lt; u.nvalid = rem < 256 ? rem : 256; return true;
    }
    __device__ __forceinline__ const char* a_base(const Unit& u) const { return gather ? A : A + (size_t)u.pm * BM * lda * 2; }
    __device__ __forceinline__ const char* b_base(const Unit& u) const { return Bt + (size_t)u.e * bstride + (size_t)u.pn * BM * K * 2; }
    __device__ __forceinline__ unsigned gather_off(const Unit& u, int r, int C) const {
        unsigned tok = 0u;
        if (r < u.nvalid) tok = (unsigned)(route[(size_t)u.e * 32768 + (size_t)u.lt * 256 + r] & 0xffffffffull) >> 1;
        return (tok * (unsigned)lda + (unsigned)C) * 2u;
    }
};

template <class Epi, class Sched, bool GATHER>
__device__ __forceinline__ void gemm_phase(LAS unsigned char* lds, const Sched& S, const Epi& E) {
    const int tid = threadIdx.x, wid = __builtin_amdgcn_readfirstlane(tid >> 6), lane = tid & 63, wr = wid >> 2, wc = wid & 3, fr = lane & 15, fq = lane >> 4;
    const int K = S.K, lda = S.lda, nt = K / BK;
    unsigned voffA[2], voffB[2]; int RA[2], CA[2];
#pragma unroll
    for (int i = 0; i < 2; ++i) { int R, C; stage_rc(tid * 16 + i * 8192, R, C); const int Rb = Epi::PERM ? ((R & ~31) + perm32(R & 31)) : R;
        RA[i] = R; CA[i] = C; voffA[i] = (unsigned)(R * lda + C) * 2u; voffB[i] = (unsigned)(Rb * K + C) * 2u; }
    const size_t kstep = (size_t)(BK * 2);
    const unsigned hstepA = (unsigned)HALF * (unsigned)lda * 2u;
    const size_t hstepB = (size_t)HALF * K * 2;
    const unsigned ldsw = (unsigned)wid * 1024u;
    const int aoff = lds_byte(wr * 64 + fr, fq * 8), boff = lds_byte(wc * 32 + fr, fq * 8);
    unsigned og[2][2] = {{0u, 0u}, {0u, 0u}}, ogn[2][2] = {{0u, 0u}, {0u, 0u}};
#define PG8_SA(b, h) (((b) * 2 + (h)) * HTB)
#define PG8_SB(b, h) ((4 + (b) * 2 + (h)) * HTB)
#define PG8_STAGE_B(bufoff, gbase) do { _Pragma("unroll") for (int _i = 0; _i < 2; ++_i) \
        __builtin_amdgcn_global_load_lds((const unsigned*)((const char*)(gbase) + voffB[_i]), (LAS unsigned*)(lds + (bufoff) + ldsw + _i * 8192), 16, 0, 0); } while (0)
#define PG8_STAGE_A(bufoff, gbase, h) do { _Pragma("unroll") for (int _i = 0; _i < 2; ++_i) \
        __builtin_amdgcn_global_load_lds((const unsigned*)((const char*)(gbase) + (GATHER ? og[h][_i] : voffA[_i] + (h) * hstepA)), (LAS unsigned*)(lds + (bufoff) + ldsw + _i * 8192), 16, 0, 0); } while (0)
#define PG8_LDA(dst, b, h) do { _Pragma("unroll") for (int m = 0; m < 4; ++m) _Pragma("unroll") for (int k = 0; k < 2; ++k) dst[m][k] = *(const LAS bf16x8*)(lds + PG8_SA(b, h) + aoff + m * 2048 + k * 1024); } while (0)
#define PG8_LDB(dst, b, h) do { _Pragma("unroll") for (int n = 0; n < 2; ++n) _Pragma("unroll") for (int k = 0; k < 2; ++k) dst[n][k] = *(const LAS bf16x8*)(lds + PG8_SB(b, h) + boff + n * 2048 + k * 1024); } while (0)
#define PG8_MMA(ai, bj, At, Bt) do { __builtin_amdgcn_s_setprio(1); _Pragma("unroll") for (int m = 0; m < 4; ++m) _Pragma("unroll") for (int n = 0; n < 2; ++n) _Pragma("unroll") for (int k = 0; k < 2; ++k) \
        acc[ai][bj][m][n] = __builtin_amdgcn_mfma_f32_16x16x32_bf16(Bt[n][k], At[m][k], acc[ai][bj][m][n], 0, 0, 0); __builtin_amdgcn_s_setprio(0); } while (0)
#define PG8_WAIT_V(n) asm volatile("s_waitcnt vmcnt(" #n ")" ::: "memory")
#define PG8_WAIT_L(n) asm volatile("s_waitcnt lgkmcnt(" #n ")" ::: "memory")
#define PG8_BAR __builtin_amdgcn_s_barrier()
#define PG8_SCHED __builtin_amdgcn_sched_barrier(0)
    Unit cur, nxt; int ui = 0;
    if (!S.next(0, cur)) return;
    f32x4 acc[2][2][4][2];
#pragma unroll
    for (int a = 0; a < 2; ++a)
#pragma unroll
        for (int b = 0; b < 2; ++b)
#pragma unroll
            for (int m = 0; m < 4; ++m)
#pragma unroll
                for (int n = 0; n < 2; ++n) acc[a][b][m][n] = (f32x4){0.f, 0.f, 0.f, 0.f};
    bf16x8 At[4][2], B0[2][2], B1[2][2];
    const char* cA = S.a_base(cur); const char* cB = S.b_base(cur);
    S.a_ready(cur);
    if constexpr (GATHER) {
#pragma unroll
        for (int h = 0; h < 2; ++h)
#pragma unroll
            for (int i = 0; i < 2; ++i) og[h][i] = S.gather_off(cur, h * HALF + RA[i], CA[i]);
    }
    PG8_STAGE_B(PG8_SB(0, 0), cB); PG8_STAGE_B(PG8_SB(0, 1), cB + hstepB); PG8_STAGE_A(PG8_SA(0, 0), cA, 0); PG8_STAGE_A(PG8_SA(0, 1), cA, 1);
    if (wr == 1) PG8_BAR;
    PG8_WAIT_V(2); PG8_BAR;
    PG8_STAGE_B(PG8_SB(1, 0), cB + kstep); PG8_STAGE_A(PG8_SA(1, 0), cA + kstep, 0); PG8_STAGE_B(PG8_SB(1, 1), cB + hstepB + kstep);
    PG8_WAIT_V(6); PG8_BAR;
    unsigned long long t3_ = 0;
    for (;;) {
        const bool has_next = S.next(ui + 1, nxt);
        const char* nA = has_next ? S.a_base(nxt) : cA; const char* nB = has_next ? S.b_base(nxt) : cB;
        if constexpr (GATHER) {
            if (has_next) {
#pragma unroll
                for (int h = 0; h < 2; ++h)
#pragma unroll
                    for (int i = 0; i < 2; ++i) ogn[h][i] = S.gather_off(nxt, h * HALF + RA[i], CA[i]);
            }
        }
        for (int t = 0; t < nt; t += 2) {
            const bool last = (t == nt - 2);
            const char* a1 = cA + (size_t)(t + 1) * kstep + ((t + 1) >= S.ksplit ? S.kgap : 0u);
            const char* a2 = last ? nA : cA + (size_t)(t + 2) * kstep + ((t + 2) >= S.ksplit ? S.kgap : 0u); const char* b2 = last ? nB : cB + (size_t)(t + 2) * kstep;
            const char* a3 = last ? nA + kstep : cA + (size_t)(t + 3) * kstep + ((t + 3) >= S.ksplit ? S.kgap : 0u); const char* b3 = b2 + kstep;
            if (last && has_next) S.a_ready(nxt);
            if constexpr (Epi::HAS_MID) { if (t == S.ksplit) E.mid(acc, cur, wr, wc, fr, fq); }
            PG8_LDB(B0, 0, 0); PG8_LDB(B1, 0, 1); PG8_SCHED; PG8_LDA(At, 0, 0); PG8_STAGE_A(PG8_SA(1, 1), a1, 1);
            if constexpr (GATHER) { if (last && has_next) {
#pragma unroll
                for (int h = 0; h < 2; ++h)
#pragma unroll
                    for (int i = 0; i < 2; ++i) og[h][i] = ogn[h][i]; } }
            PG8_WAIT_V(8); PG8_WAIT_L(0); PG8_BAR;
            if (TSEL == 3) { if (t == 0 && t3_ != 0 && T_ON(3)) { g_tacc += __builtin_amdgcn_s_memrealtime() - t3_; t3_ = 0; } }
            PG8_MMA(0, 0, At, B0); PG8_MMA(0, 1, At, B1); PG8_BAR; PG8_SCHED;
            PG8_LDA(At, 0, 1); PG8_STAGE_B(PG8_SB(0, 0), b2); PG8_STAGE_B(PG8_SB(0, 1), b2 + hstepB); PG8_STAGE_A(PG8_SA(0, 0), a2, 0);
            PG8_WAIT_V(8); PG8_WAIT_L(0); PG8_BAR; PG8_MMA(1, 0, At, B0); PG8_MMA(1, 1, At, B1); PG8_BAR; PG8_SCHED;
            PG8_LDB(B0, 1, 0); PG8_LDB(B1, 1, 1); PG8_SCHED; PG8_LDA(At, 1, 0); PG8_STAGE_A(PG8_SA(0, 1), a2, 1);
            PG8_WAIT_V(8); PG8_WAIT_L(0); PG8_BAR; PG8_MMA(0, 0, At, B0); PG8_MMA(0, 1, At, B1); PG8_BAR; PG8_SCHED;
            PG8_LDA(At, 1, 1); PG8_STAGE_B(PG8_SB(1, 0), b3); PG8_STAGE_B(PG8_SB(1, 1), b3 + hstepB); PG8_STAGE_A(PG8_SA(1, 0), a3, 0);
            PG8_WAIT_V(8); PG8_WAIT_L(0); PG8_BAR; PG8_MMA(1, 0, At, B0); PG8_MMA(1, 1, At, B1); PG8_BAR; PG8_SCHED;
        }
        if (wr == 0) PG8_BAR;
        { T_BEGIN(2, t2_) E(acc, cur, wr, wc, fr, fq); S.done(cur); T_END(2, t2_); }
        if (!has_next) break;
        if (TSEL == 3 && T_ON(3)) t3_ = __builtin_amdgcn_s_memrealtime();
#pragma unroll
        for (int a = 0; a < 2; ++a)
#pragma unroll
            for (int b = 0; b < 2; ++b)
#pragma unroll
                for (int m = 0; m < 4; ++m)
#pragma unroll
                    for (int n = 0; n < 2; ++n) acc[a][b][m][n] = (f32x4){0.f, 0.f, 0.f, 0.f};
        cur = nxt; cA = nA; cB = nB; ++ui;
        if (wr == 1) PG8_BAR;
    }
    PG8_WAIT_V(0);
    PG8_BAR;
#undef PG8_SA
#undef PG8_SB
#undef PG8_STAGE_A
#undef PG8_STAGE_B
#undef PG8_LDA
#undef PG8_LDB
#undef PG8_MMA
#undef PG8_WAIT_V
#undef PG8_WAIT_L
#undef PG8_BAR
#undef PG8_SCHED
}

struct EpiProj {
    static constexpr bool PERM = true; static constexpr bool HAS_MID = false;
    bf16_t* P; const float* rope; float* ksum;
    __device__ __forceinline__ void operator()(const f32x4 (&acc)[2][2][4][2], const Unit& u, int wr, int wc, int fr_in, int fq) const {
        int fr = fr_in; asm volatile("" : "+v"(fr));
        const int pn = u.pn, row0 = u.pm * BM + wr * 64 + fr, cl = wc * 32 + 8 * fq;
        const int mode = pn < 4 ? 0 : pn < 6 ? 1 : pn < 8 ? 2 : pn < 10 ? 3 : 4;
        const bool rot = (mode == 1 || mode == 2) && ((wc & 1) == 0);
        float ks[2][8];
#pragma unroll
        for (int bj = 0; bj < 2; ++bj)
#pragma unroll
            for (int j = 0; j < 8; ++j) ks[bj][j] = 0.f;
        f32x4 rq[3][4];
#define RP_LOAD(gi, slot) do { if (rot) { const int pos_ = (row0 + ((gi) >> 2) * HALF + ((gi) & 3) * 16) & (SEQ - 1); \
            rq[slot][0] = *(const f32x4*)(rope + pos_ * 8); rq[slot][1] = *(const f32x4*)(rope + pos_ * 8 + 4); rq[slot][2] = *(const f32x4*)(rope + 65536 + pos_ * 8); rq[slot][3] = *(const f32x4*)(rope + 65536 + pos_ * 8 + 4); } } while (0)
        RP_LOAD(0, 0); RP_LOAD(1, 1);
#pragma unroll
        for (int ai = 0; ai < 2; ++ai)
#pragma unroll
            for (int m = 0; m < 4; ++m) {
                const int gi_ = ai * 4 + m;
                if (gi_ + 2 < 8) RP_LOAD(gi_ + 2, (gi_ + 2) % 3);
                const int row = row0 + ai * HALF + m * 16;
                float cs[8], sn[8];
                if (rot) {
#pragma unroll
                    for (int j = 0; j < 4; ++j) { cs[j] = rq[gi_ % 3][0][j]; cs[4 + j] = rq[gi_ % 3][1][j]; sn[j] = rq[gi_ % 3][2][j]; sn[4 + j] = rq[gi_ % 3][3][j]; } }
#pragma unroll
                for (int bj = 0; bj < 2; ++bj) {
                    float v[8];
#pragma unroll
                    for (int j = 0; j < 4; ++j) { v[j] = acc[ai][bj][m][0][j]; v[4 + j] = acc[ai][bj][m][1][j]; }
                    if (mode == 1 || mode == 2) {
                        if (rot) {
                            const float sg = (fq == 0) ? -1.f : 1.f; const bool ap = fq < 2;
#pragma unroll
                            for (int j = 0; j < 8; ++j) {
                                const auto sw = __builtin_amdgcn_permlane16_swap(__float_as_uint(v[j]), __float_as_uint(v[j]), false, false);
                                const float o = __uint_as_float((fq & 1) ? sw[0] : sw[1]); const float r = v[j] * cs[j] + sg * o * sn[j]; v[j] = ap ? r : v[j]; }
                        }
                        if (mode == 1) {
#pragma unroll
                            for (int j = 0; j < 8; ++j) v[j] *= QSCALE;
                        } else {
#pragma unroll
                            for (int j = 0; j < 8; ++j) ks[bj][j] += v[j];
                        }
                    }
                    u32x4 w; w.x = cvt_pk_bf16(v[0], v[1]); w.y = cvt_pk_bf16(v[2], v[3]); w.z = cvt_pk_bf16(v[4], v[5]); w.w = cvt_pk_bf16(v[6], v[7]);
                    *(u32x4*)(P + (size_t)row * PC + pn * BM + bj * HALF + cl) = w;
                }
            }
#undef RP_LOAD
        if (mode == 2) {
#pragma unroll
            for (int bj = 0; bj < 2; ++bj)
#pragma unroll
                for (int j = 0; j < 8; ++j) { float s = ks[bj][j]; s += __shfl_xor(s, 1); s += __shfl_xor(s, 2); s += __shfl_xor(s, 4); s += __shfl_xor(s, 8); ks[bj][j] = s; }
            if (fr == 0) {
                const int b = u.pm >> 5, kb = u.pm & 31;
#pragma unroll
                for (int bj = 0; bj < 2; ++bj) { const int ck = (pn - 6) * BM + bj * HALF + cl; const int h = ck >> 6, d = ck & 63;
                    float* dst = ksum + ((size_t)((b * 8 + h) * 32 + kb)) * 64 + d;
#pragma unroll
                    for (int j = 0; j < 8; ++j) atomicAdd(dst + j, ks[bj][j]); }
            }
        }
    }
};
struct EpiMergeF {
    static constexpr bool PERM = true; static constexpr bool HAS_MID = true;
    const bf16_t* P; bf16_t* MG;
    __device__ __forceinline__ void mid(f32x4 (&acc)[2][2][4][2], const Unit& u, int wr, int wc, int fr_in, int fq) const {
        int fr = fr_in; asm volatile("" : "+v"(fr));
        const int row0 = u.pm * BM + wr * 64 + fr, col0 = u.pn * BM + wc * 32 + 8 * fq;
#pragma unroll
        for (int g4 = 0; g4 < 8; g4 += 4) {
            u32x4 ga[4][2], gb[4][2];
#pragma unroll
            for (int k = 0; k < 4; ++k) { const int gi = g4 + k, row = row0 + (gi >> 2) * HALF + (gi & 3) * 16;
#pragma unroll
                for (int bj = 0; bj < 2; ++bj) { ga[k][bj] = *(const u32x4*)(P + (size_t)row * PC + C_GA + col0 + bj * HALF); gb[k][bj] = *(const u32x4*)(P + (size_t)row * PC + C_GB + col0 + bj * HALF); } }
#pragma unroll
            for (int k = 0; k < 4; ++k) { const int gi = g4 + k, ai = gi >> 2, m = gi & 3;
#pragma unroll
                for (int bj = 0; bj < 2; ++bj) {
#define RHO(a_, b_) ((1.0f + __builtin_amdgcn_exp2f(-1.4426950408889634f * fmaxf(b_, -60.f))) * sigmoidf_(a_))
                    const u32x4 A_ = ga[k][bj], B_ = gb[k][bj];
                    acc[ai][bj][m][0][0] *= RHO(bflo(A_.x), bflo(B_.x)); acc[ai][bj][m][0][1] *= RHO(bfhi(A_.x), bfhi(B_.x)); acc[ai][bj][m][0][2] *= RHO(bflo(A_.y), bflo(B_.y)); acc[ai][bj][m][0][3] *= RHO(bfhi(A_.y), bfhi(B_.y));
                    acc[ai][bj][m][1][0] *= RHO(bflo(A_.z), bflo(B_.z)); acc[ai][bj][m][1][1] *= RHO(bfhi(A_.z), bfhi(B_.z)); acc[ai][bj][m][1][2] *= RHO(bflo(A_.w), bflo(B_.w)); acc[ai][bj][m][1][3] *= RHO(bfhi(A_.w), bfhi(B_.w));
#undef RHO
                } }
        }
    }
    __device__ __forceinline__ void operator()(const f32x4 (&acc)[2][2][4][2], const Unit& u, int wr, int wc, int fr_in, int fq) const {
        int fr = fr_in; asm volatile("" : "+v"(fr));
        const int row0 = u.pm * BM + wr * 64 + fr, col0 = u.pn * BM + wc * 32 + 8 * fq;
        u32x4 gq[3][2];
#define EM_LOAD(gi, slot) do { const int row_ = row0 + ((gi) >> 2) * HALF + ((gi) & 3) * 16; \
            _Pragma("unroll") for (int bj = 0; bj < 2; ++bj) gq[slot][bj] = *(const u32x4*)(P + (size_t)row_ * PC + C_GB + col0 + bj * HALF); } while (0)
        EM_LOAD(0, 0); EM_LOAD(1, 1);
#pragma unroll
        for (int gi = 0; gi < 8; ++gi) {
            if (gi + 2 < 8) EM_LOAD(gi + 2, (gi + 2) % 3);
            asm volatile("" ::: "memory");
            const int ai = gi >> 2, m = gi & 3, row = row0 + ai * HALF + m * 16;
#pragma unroll
            for (int bj = 0; bj < 2; ++bj) { const u32x4 g = gq[gi % 3][bj];
                float v[8];
#pragma unroll
                for (int j = 0; j < 4; ++j) { v[j] = acc[ai][bj][m][0][j]; v[4 + j] = acc[ai][bj][m][1][j]; }
#define SGB(x_) sigmoidf_(fmaxf(x_, -60.f))
                v[0] *= SGB(bflo(g.x)); v[1] *= SGB(bfhi(g.x)); v[2] *= SGB(bflo(g.y)); v[3] *= SGB(bfhi(g.y)); v[4] *= SGB(bflo(g.z)); v[5] *= SGB(bfhi(g.z)); v[6] *= SGB(bflo(g.w)); v[7] *= SGB(bfhi(g.w));
#undef SGB
                u32x4 w; w.x = cvt_pk_bf16(v[0], v[1]); w.y = cvt_pk_bf16(v[2], v[3]); w.z = cvt_pk_bf16(v[4], v[5]); w.w = cvt_pk_bf16(v[6], v[7]);
                *(u32x4*)(MG + (size_t)row * DM + col0 + bj * HALF) = w; }
        }
#undef EM_LOAD
    }
};
struct EpiOut {
    static constexpr bool PERM = false; static constexpr bool HAS_MID = false;
    const float* x; bf16_t* x1; const float* mod; float* ssq;
    __device__ __forceinline__ void operator()(const f32x4 (&acc)[2][2][4][2], const Unit& u, int wr, int wc, int fr_in, int fq) const {
        int fr = fr_in; asm volatile("" : "+v"(fr));
        const int row0 = u.pm * BM + wr * 64 + fr, col0 = u.pn * BM + wc * 32 + 4 * fq, b = u.pm >> 5;
        f32x4 xq[3][2][2];
#define EO_LOAD(gi, slot) do { const size_t off_ = (size_t)(row0 + ((gi) >> 2) * HALF + ((gi) & 3) * 16) * DM + col0; \
            _Pragma("unroll") for (int bj = 0; bj < 2; ++bj) _Pragma("unroll") for (int n = 0; n < 2; ++n) xq[slot][bj][n] = *(const f32x4*)(x + off_ + bj * HALF + n * 16); } while (0)
        EO_LOAD(0, 0); EO_LOAD(1, 1);
        f32x4 g1[2][2];
#pragma unroll
        for (int bj = 0; bj < 2; ++bj)
#pragma unroll
            for (int n = 0; n < 2; ++n) g1[bj][n] = *(const f32x4*)(mod + b * 6144 + 2048 + col0 + bj * HALF + n * 16);
#pragma unroll
        for (int gi = 0; gi < 8; ++gi) {
            if (gi + 2 < 8) EO_LOAD(gi + 2, (gi + 2) % 3);
            asm volatile("" ::: "memory");
            const int ai = gi >> 2, m = gi & 3, row = row0 + ai * HALF + m * 16; const size_t off = (size_t)row * DM + col0; float s = 0.f;
#pragma unroll
            for (int bj = 0; bj < 2; ++bj)
#pragma unroll
                for (int n = 0; n < 2; ++n) { const f32x4 o = xq[gi % 3][bj][n] + g1[bj][n] * acc[ai][bj][m][n];
                    u32x2 w; w.x = cvt_pk_bf16(o[0], o[1]); w.y = cvt_pk_bf16(o[2], o[3]);
                    const float r0 = bflo(w.x), r1 = bfhi(w.x), r2 = bflo(w.y), r3 = bfhi(w.y);
                    s += (r0 * r0 + r1 * r1) + (r2 * r2 + r3 * r3); *(u32x2*)(x1 + off + bj * HALF + n * 16) = w; }
            s += __shfl_xor(s, 16); s += __shfl_xor(s, 32);
            if (fq == 0) ssq[(size_t)row * 16 + u.pn * 4 + wc] = s;
        }
#undef EO_LOAD
    }
};
struct EpiGU {
    static constexpr bool PERM = true; static constexpr bool HAS_MID = false;
    bf16_t* H;
    __device__ __forceinline__ void operator()(const f32x4 (&acc)[2][2][4][2], const Unit& u, int wr, int wc, int fr_in, int fq) const {
        int fr = fr_in; asm volatile("" : "+v"(fr));
        const int r0 = wr * 64 + fr, cl = wc * 32 + 8 * fq;
#pragma unroll
        for (int ai = 0; ai < 2; ++ai)
#pragma unroll
            for (int m = 0; m < 4; ++m) { const int r = r0 + ai * HALF + m * 16;
                float v[8];
#pragma unroll
                for (int j = 0; j < 4; ++j) { const float g0 = acc[ai][0][m][0][j], g1 = acc[ai][0][m][1][j]; v[j] = g0 * sigmoidf_(g0) * acc[ai][1][m][0][j]; v[4 + j] = g1 * sigmoidf_(g1) * acc[ai][1][m][1][j]; }
                u32x4 w; w.x = cvt_pk_bf16(v[0], v[1]); w.y = cvt_pk_bf16(v[2], v[3]); w.z = cvt_pk_bf16(v[4], v[5]); w.w = cvt_pk_bf16(v[6], v[7]);
                bf16_t* dst = H + ((size_t)u.pm * BM + r) * DEXP + u.pn * HALF + cl;
                asm volatile("global_store_dwordx4 %0, %1, off sc1\n\ts_nop 1" :: "v"(dst), "v"(w) : "memory"); }
    }
};
struct EpiDown {
    static constexpr bool PERM = true; static constexpr bool HAS_MID = false;
    bf16_t* Y; const unsigned long long* route;
    __device__ __forceinline__ void operator()(const f32x4 (&acc)[2][2][4][2], const Unit& u, int wr, int wc, int fr_in, int fq) const {
        int fr = fr_in; asm volatile("" : "+v"(fr));
        const int r0 = wr * 64 + fr, col0 = u.pn * BM + wc * 32 + 8 * fq;
        const unsigned long long* rt = route + (size_t)u.e * 32768 + (size_t)u.lt * 256;
        unsigned long long ent[8];
#pragma unroll
        for (int gi = 0; gi < 8; ++gi) { const int r = r0 + (gi >> 2) * HALF + (gi & 3) * 16; ent[gi] = (r < u.nvalid) ? rt[r] : 0ull; }
#pragma unroll
        for (int gi = 0; gi < 8; ++gi) { const int ai = gi >> 2, m = gi & 3, r = r0 + ai * HALF + m * 16;
            if (r < u.nvalid) { const unsigned slot = (unsigned)(ent[gi] & 0xffffffffull); const float wt = __uint_as_float((unsigned)(ent[gi] >> 32));
#pragma unroll
                for (int bj = 0; bj < 2; ++bj) { const f32x4 a0 = acc[ai][bj][m][0] * wt, a1 = acc[ai][bj][m][1] * wt;
                    u32x4 w; w.x = cvt_pk_bf16(a0[0], a0[1]); w.y = cvt_pk_bf16(a0[2], a0[3]); w.z = cvt_pk_bf16(a1[0], a1[1]); w.w = cvt_pk_bf16(a1[2], a1[3]);
                    *(u32x4*)(Y + (size_t)slot * DM + col0 + bj * HALF) = w; } } }
    }
};
}

namespace attn_body {
using bf16 = __hip_bfloat16;
constexpr int NHEAD = 8, D = 64, PITCH = PC;
constexpr int NW = 8, QBLK = 32, QB = QBLK * NW, KVBLK = 64;
__device__ __forceinline__ int crow(int r, int hi) { return (r & 3) + 8 * (r >> 2) + 4 * hi; }
#define SBAR() __builtin_amdgcn_sched_barrier(0)
__device__ __forceinline__ void cmask(f32x16& p0, f32x16& p1, int jb, int qrel, int hi) {
    const float NEG = -INFINITY; int kb = 64 * jb + 4 * hi;
#pragma unroll
    for (int r = 0; r < 16; ++r) { int kv = kb + (r & 3) + 8 * (r >> 2); if (kv > qrel) p0[r] = NEG; if (kv + 32 > qrel) p1[r] = NEG; }
}
__device__ __forceinline__ void selapply(f32x16& p0, f32x16& p1, bool ok) {
    const float NEG = -INFINITY;
#pragma unroll
    for (int r = 0; r < 16; ++r) { p0[r] = ok ? p0[r] : NEG; p1[r] = ok ? p1[r] : NEG; }
}
constexpr int NSLOT = 3, SLOTB = 8192;
constexpr int LDS_K = 0, LDS_V = NSLOT * SLOTB, LDS_WS = 2 * NSLOT * SLOTB, LDS_OST = LDS_WS + NW * 64 * 4, LDS_BYTES_A = LDS_OST + NW * 4096;
__device__ __forceinline__ void glds16(const void* gsrc, unsigned lds_dst) { unsigned keep;
    asm volatile("s_mov_b32 %0, m0\n\ts_mov_b32 m0, %2\n\ts_nop 0\n\tglobal_load_lds_dwordx4 %1, off\n\ts_mov_b32 m0, %0" : "=&s"(keep) : "v"(gsrc), "s"(lds_dst) : "memory"); }
__device__ __forceinline__ float max3f(float a, float b, float c) { float r; asm("v_max3_f32 %0, %1, %2, %3" : "=v"(r) : "v"(a), "v"(b), "v"(c)); return r; }
__device__ __forceinline__ float max2f(float a, float b) { float r; asm("v_max_f32_e32 %0, %1, %2" : "=v"(r) : "v"(a), "v"(b)); return r; }
__device__ __forceinline__ float fadd_s(float a, float b) { float r; asm("v_add_f32_e32 %0, %1, %2" : "=v"(r) : "v"(a), "v"(b)); return r; }
__device__ __forceinline__ float fsub_s(float a, float b) { float r; asm("v_sub_f32_e32 %0, %1, %2" : "=v"(r) : "v"(a), "v"(b)); return r; }
typedef __bf16 bf16x2_t __attribute__((ext_vector_type(2)));
__device__ __forceinline__ unsigned cvtpk_s(float lo, float hi) { f32x2 v = {lo, hi}; bf16x2_t b = __builtin_convertvector(v, bf16x2_t); return __builtin_bit_cast(unsigned, b); }
#define WAIT_BAR(N) asm volatile("s_waitcnt vmcnt(" #N ") lgkmcnt(0)\n\ts_barrier" ::: "memory")

__device__ __forceinline__ void qkt(f32x16& p0, f32x16& p1, const char* Kslot, const bf16x8* qr, const f32x16& negm, int r32, int hi) {
    const char* kb = Kslot + hi * 1024 + r32 * 16;
#pragma unroll
    for (int d0 = 0; d0 < 4; ++d0) {
        const bf16x8 b0 = *reinterpret_cast<const bf16x8*>(kb + d0 * 2048);
        const bf16x8 b1 = *reinterpret_cast<const bf16x8*>(kb + d0 * 2048 + 512);
        if (d0 == 0) { p0 = __builtin_amdgcn_mfma_f32_32x32x16_bf16(b0, qr[0], negm, 0, 0, 0); p1 = __builtin_amdgcn_mfma_f32_32x32x16_bf16(b1, qr[0], negm, 0, 0, 0); }
        else { p0 = __builtin_amdgcn_mfma_f32_32x32x16_bf16(b0, qr[d0], p0, 0, 0, 0); p1 = __builtin_amdgcn_mfma_f32_32x32x16_bf16(b1, qr[d0], p1, 0, 0, 0); } }
}
typedef LAS const char* lds_cptr;
typedef short v4i16_t __attribute__((ext_vector_type(4)));
__device__ __forceinline__ void kload8(bf16x8* kf, lds_cptr kp) {
    kf[0] = *(const LAS bf16x8*)(kp);        kf[1] = *(const LAS bf16x8*)(kp + 512);
    kf[2] = *(const LAS bf16x8*)(kp + 2048); kf[3] = *(const LAS bf16x8*)(kp + 2560);
    kf[4] = *(const LAS bf16x8*)(kp + 4096); kf[5] = *(const LAS bf16x8*)(kp + 4608);
    kf[6] = *(const LAS bf16x8*)(kp + 6144); kf[7] = *(const LAS bf16x8*)(kp + 6656);
}
__device__ __forceinline__ void kload2(bf16x8* kf, lds_cptr kp, int j) { kf[2 * j] = *(const LAS bf16x8*)(kp + j * 2048); kf[2 * j + 1] = *(const LAS bf16x8*)(kp + j * 2048 + 512); }
__device__ __forceinline__ s16x4 vtr(lds_cptr p) { return __builtin_bit_cast(s16x4, __builtin_amdgcn_ds_read_tr16_b64_v4i16((LAS v4i16_t*)p)); }
__device__ __forceinline__ float rowmax(const f32x16& p0, const f32x16& p1) {
    float a = max3f(p0[0], p0[1], p1[0]), b = max3f(p0[2], p0[3], p1[1]); a = max3f(a, p1[2], p1[3]);
#pragma unroll
    for (int r = 4; r < 16; r += 4) { a = max3f(a, p0[r], p0[r + 1]); b = max3f(b, p0[r + 2], p0[r + 3]); a = max3f(a, p1[r], p1[r + 1]); b = max3f(b, p1[r + 2], p1[r + 3]); }
    const float m = max2f(a, b);
    auto rr = __builtin_amdgcn_permlane32_swap(__float_as_uint(m), __float_as_uint(m), false, false);
    return max2f(__uint_as_float(rr[0]), __uint_as_float(rr[1]));
}
__device__ __forceinline__ void pv(f32x16* o, int vb, bf16x8 pa0, bf16x8 pa1, bf16x8 pa2, bf16x8 pa3) {
#pragma unroll
    for (int d0 = 0; d0 < 2; ++d0) { s16x4 lo[4], hi[4];
#pragma unroll
        for (int ks = 0; ks < 4; ++ks) {
            asm volatile("ds_read_b64_tr_b16 %0,%1 offset:%c2" : "=&v"(lo[ks]) : "v"(vb), "i"(d0 * 4096 + ks * 1024) : "memory");
            asm volatile("ds_read_b64_tr_b16 %0,%1 offset:%c2" : "=&v"(hi[ks]) : "v"(vb), "i"(d0 * 4096 + ks * 1024 + 512) : "memory"); }
        asm volatile("s_waitcnt lgkmcnt(0)" ::: "memory"); SBAR();
#define PK(k) (bf16x8){lo[k][0], lo[k][1], lo[k][2], lo[k][3], hi[k][0], hi[k][1], hi[k][2], hi[k][3]}
        o[d0] = __builtin_amdgcn_mfma_f32_32x32x16_bf16(pa0, PK(0), o[d0], 0, 0, 0);
        o[d0] = __builtin_amdgcn_mfma_f32_32x32x16_bf16(pa1, PK(1), o[d0], 0, 0, 0);
        o[d0] = __builtin_amdgcn_mfma_f32_32x32x16_bf16(pa2, PK(2), o[d0], 0, 0, 0);
        o[d0] = __builtin_amdgcn_mfma_f32_32x32x16_bf16(pa3, PK(3), o[d0], 0, 0, 0);
#undef PK
    }
}

__device__ __forceinline__ void gate_top3(const float* ksum_bh, const bf16x8* qr, int qb, int r32, int hi, int (&kbs)[3]) {
    const float* km = ksum_bh + (size_t)r32 * 64 + hi * 8;
    f32x16 g = f32x16{};
#pragma unroll
    for (int d0 = 0; d0 < 4; ++d0) { const f32x4 a = *(const f32x4*)(km + d0 * 16), c = *(const f32x4*)(km + d0 * 16 + 4);
        u32x4 w; w.x = cvtpk_s(a[0], a[1]); w.y = cvtpk_s(a[2], a[3]); w.z = cvtpk_s(c[0], c[1]); w.w = cvtpk_s(c[2], c[3]);
        g = __builtin_amdgcn_mfma_f32_32x32x16_bf16(__builtin_bit_cast(bf16x8, w), qr[d0], g, 0, 0, 0); }
#pragma unroll
    for (int r = 0; r < 16; ++r) if (crow(r, hi) >= qb) g[r] = -INFINITY;
#pragma unroll
    for (int round = 0; round < 3; ++round) {
        float m = g[0];
#pragma unroll
        for (int r = 1; r < 16; ++r) m = fmaxf(m, g[r]);
        int idx = 64;
#pragma unroll
        for (int r = 15; r >= 0; --r) if (g[r] == m) idx = crow(r, hi);
        const float pm = __shfl_xor(m, 32); const int pidx = __shfl_xor(idx, 32);
        const bool mine = (m > pm) || (m == pm && idx < pidx);
        kbs[round] = (mine ? idx : pidx) & 31;
#pragma unroll
        for (int r = 0; r < 16; ++r) if (mine && crow(r, hi) == idx) g[r] = -INFINITY;
    }
}

template <int THRL, bool OWN> __device__ __forceinline__ void attn_unit(int b, int h, int qb, const bf16* Q, const bf16* __restrict__ K, const bf16* __restrict__ V, bf16* O, const float* ksum, char* shm, bool do_store, const bf16_t* PO, const float* PML) {
    const int tid = threadIdx.x, lane = tid & 63, r32 = lane & 31, hi = lane >> 5; const int wid = __builtin_amdgcn_readfirstlane(tid >> 6);
    const long rowbase = (long)b * SEQ; const int q0 = qb * QB;
    const bf16* Qw = Q + (rowbase + q0 + wid * QBLK) * PITCH + h * D;
    const bf16* Kh = K + rowbase * PITCH + h * D, *Vh = V + rowbase * PITCH + h * D;
    const unsigned lds0 = (unsigned)(uintptr_t)shm;
    float* wsf = (float*)(shm + LDS_WS) + wid * 64;
    const bf16* ksrc = Kh + (long)lane * PITCH + wid * 8;
    const bf16* vsrc = Vh + (long)(16 * (wid & 3) + (lane >> 2)) * PITCH + (wid >> 2) * 32 + (lane & 3) * 8;
    const unsigned kdst = lds0 + LDS_K + wid * 1024, vdst = lds0 + LDS_V + wid * 1024;
    const int NT = OWN ? 4 : (q0 + QB) / KVBLK;
    const int TBASE = OWN ? 4 * qb : 0;
#define TM(t) (OWN ? (t) : (((t) == 0) ? (NT - 4) : (((t) <= NT - 4) ? ((t) - 1) : (t))))
#define DMA_K(t, slot) glds16(ksrc + (long)(TBASE + TM(t)) * KVBLK * PITCH, (unsigned)__builtin_amdgcn_readfirstlane(kdst + (slot)))
#define DMA_V(t, slot) glds16(vsrc + (long)(TBASE + TM(t)) * KVBLK * PITCH, (unsigned)__builtin_amdgcn_readfirstlane(vdst + (slot)))
    const int vb0 = (int)(lds0 + LDS_V) + ((lane >> 4) & 1) * 32 + (lane & 3) * 8 + (4 * hi + ((lane & 15) >> 2)) * 64;
    const char* Kbase = shm + LDS_K; bf16x8 kf[8];
    const lds_cptr shm3 = (lds_cptr)shm; const lds_cptr kp0 = shm3 + LDS_K + hi * 1024 + r32 * 16; const lds_cptr vp0 = shm3 + LDS_V + ((lane >> 4) & 1) * 32 + (lane & 3) * 8 + (4 * hi + ((lane & 15) >> 2)) * 64;
    DMA_K(0, 0); DMA_V(0, 0); DMA_K(1, SLOTB);
    bf16x8 qr[4];
#pragma unroll
    for (int d0 = 0; d0 < 4; ++d0) qr[d0] = *reinterpret_cast<const bf16x8*>(&Qw[(long)r32 * PITCH + d0 * 16 + hi * 8]);
    unsigned selmask = 0u;
    if constexpr (!OWN) {
    if (qb > 0) {
        if (qb <= 3) selmask = (1u << qb) - 1u;
        else { int kbs[3]; gate_top3(ksum + ((size_t)(b * NHEAD + h) * 32) * 64, qr, qb, r32, hi, kbs); selmask = (1u << kbs[0]) | (1u << kbs[1]) | (1u << kbs[2]); }
    } }
    float zf_; asm volatile("v_mov_b32 %0, 0" : "=v"(zf_));
    float mhat = 0.f, l_reg = 0.f; f32x16 o[2]; f32x16 negm;
#pragma unroll
    for (int r = 0; r < 16; ++r) { o[0][r] = zf_; o[1][r] = zf_; negm[r] = zf_; }
    asm volatile("" : "+v"(negm));
    const int qrel = wid * QBLK + r32;
#define MASKT(P0, P1, t) do { const int a_ = TM(t); const int jb_ = a_ - (NT - 4); if (jb_ >= 0) cmask(P0, P1, jb_, qrel, hi); else selapply(P0, P1, ((selmask >> (a_ >> 2)) & 1u) != 0u); } while (0)
    bool resc = false;
#define START(P0, P1) do { const float rm = rowmax(P0, P1); resc = false; \
    { const float dl = rm; mhat = fadd_s(mhat, dl); \
      _Pragma("unroll") for (int r = 0; r < 16; ++r) { P0[r] = fsub_s(P0[r], dl); P1[r] = fsub_s(P1[r], dl); } \
      _Pragma("unroll") for (int r = 0; r < 16; ++r) negm[r] = -mhat; asm volatile("" : "+v"(negm)); } \
    _Pragma("unroll") for (int r = 0; r < 16; ++r) P0[r] = __builtin_amdgcn_exp2f(P0[r]); } while (0)
#define RESC() do { if (resc) { asm volatile("s_waitcnt lgkmcnt(0)" ::: "memory"); \
      _Pragma("unroll") for (int d_ = 0; d_ < 2; ++d_) _Pragma("unroll") for (int r = 0; r < 16; ++r) o[d_][r] *= wsf[crow(r, hi)]; } } while (0)
    f32x16 pA0, pA1, pB0, pB1;
    int sl_prev = 0, sl_cur = 0, sl_next = SLOTB;
#define ROT() do { sl_prev = sl_cur; sl_cur = sl_next; sl_next = (sl_next == (NSLOT - 1) * SLOTB) ? 0 : sl_next + SLOTB; } while (0)
    DMA_K(2, 2 * SLOTB);
    WAIT_BAR(3);
    qkt(pA0, pA1, Kbase, qr, negm, r32, hi); asm volatile("s_nop 15\n\ts_nop 7" : "+v"(pA0), "+v"(pA1)); MASKT(pA0, pA1, 0);
    START(pA0, pA1);
    _Pragma("unroll") for (int r = 0; r < 16; ++r) pA1[r] = __builtin_amdgcn_exp2f(pA1[r]);
    WAIT_BAR(0);
    DMA_K(3, 0); DMA_V(1, SLOTB);
    ROT();
    kload8(kf, kp0 + sl_cur);
    WAIT_BAR(2);
    s16x4 vlo[8], vhi[8]; u32x4 pw0, pw1, pw2, pw3;
#define PKW(P, B) cvtpk_s(P[B], P[B + 1])
#define PAF(k) __builtin_bit_cast(bf16x8, pw##k)
#define VFR(i) (bf16x8){vlo[i][0], vlo[i][1], vlo[i][2], vlo[i][3], vhi[i][0], vhi[i][1], vhi[i][2], vhi[i][3]}
#define PIN(x) asm volatile("" : "+v"(x))
#define MX3(a, b, c) __builtin_fmaxf(__builtin_fmaxf((a), (b)), (c))
#define GAPA(MF, A0, A1, A2, A3, W0, W1, PW) do { MF; sacc += A0; sacc += A1; sacc += A2; sacc += A3; PIN(sacc); W0; W1; PIN(PW); SBAR(); } while (0)
#define EX(v) __builtin_amdgcn_exp2f(v)
#define GAPB(MF, X, B) do { MF; X[B] = EX(X[B]); X[B + 1] = EX(X[B + 1]); X[B + 2] = EX(X[B + 2]); X[B + 3] = EX(X[B + 3]); PIN(X); SBAR(); } while (0)
#define VRD(i) do { vlo[i] = vtr(vp_ + (((i) >> 2) * 4096 + ((i) & 3) * 1024)); vhi[i] = vtr(vp_ + (((i) >> 2) * 4096 + ((i) & 3) * 1024 + 512)); } while (0)
#define KRD(G, j) do { if (G) { kload2(kf, kp0 + sl_next, j); SBAR(); } } while (0)
#define STEP(C0, C1, P0, P1, t, GK, GV, GL) do { SBAR(); \
    const lds_cptr vp_ = vp0 + sl_prev; \
    VRD(0); SBAR(); float sacc = (P0[0] + P0[1]); \
    GAPA(C0 = __builtin_amdgcn_mfma_f32_32x32x16_bf16(kf[0], qr[0], negm, 0, 0, 0), P0[2], P0[3], P0[4], P0[5],     pw0[0] = PKW(P0, 0), pw0[1] = PKW(P0, 2), pw0); \
    VRD(4); SBAR(); GAPA(C1 = __builtin_amdgcn_mfma_f32_32x32x16_bf16(kf[1], qr[0], negm, 0, 0, 0), P0[6], P0[7], P0[8], P0[9],     pw0[2] = PKW(P0, 4), pw0[3] = PKW(P0, 6), pw0); \
    VRD(1); SBAR(); GAPA(C0 = __builtin_amdgcn_mfma_f32_32x32x16_bf16(kf[2], qr[1], C0, 0, 0, 0),   P0[10], P0[11], P0[12], P0[13], pw1[0] = PKW(P0, 8), pw1[1] = PKW(P0, 10), pw1); \
    VRD(5); SBAR(); GAPA(C1 = __builtin_amdgcn_mfma_f32_32x32x16_bf16(kf[3], qr[1], C1, 0, 0, 0),   P0[14], P0[15], P1[0], P1[1],   pw1[2] = PKW(P0, 12), pw1[3] = PKW(P0, 14), pw1); \
    VRD(2); SBAR(); GAPA(C0 = __builtin_amdgcn_mfma_f32_32x32x16_bf16(kf[4], qr[2], C0, 0, 0, 0),   P1[2], P1[3], P1[4], P1[5],     pw2[0] = PKW(P1, 0), pw2[1] = PKW(P1, 2), pw2); \
    VRD(6); SBAR(); GAPA(C1 = __builtin_amdgcn_mfma_f32_32x32x16_bf16(kf[5], qr[2], C1, 0, 0, 0),   P1[6], P1[7], P1[8], P1[9],     pw2[2] = PKW(P1, 4), pw2[3] = PKW(P1, 6), pw2); \
    VRD(3); SBAR(); GAPA(C0 = __builtin_amdgcn_mfma_f32_32x32x16_bf16(kf[6], qr[3], C0, 0, 0, 0),   P1[10], P1[11], P1[12], P1[13], pw3[0] = PKW(P1, 8), pw3[1] = PKW(P1, 10), pw3); \
    VRD(7); SBAR(); GAPA(C1 = __builtin_amdgcn_mfma_f32_32x32x16_bf16(kf[7], qr[3], C1, 0, 0, 0),   P1[14], P1[15], 0.f, 0.f,       pw3[2] = PKW(P1, 12), pw3[3] = PKW(P1, 14), pw3); \
    l_reg += sacc; \
    if (GK) { DMA_K((t) + 3, sl_cur); } if (GV) { DMA_V((t) + 1, sl_next); } \
    MASKT(C0, C1, t); \
    { float a = MX3(C0[0], C0[1], C1[0]), b = MX3(C0[2], C0[3], C1[1]); a = MX3(a, C1[2], C1[3]); \
      _Pragma("unroll") for (int r = 4; r < 16; r += 4) { a = MX3(a, C0[r], C0[r + 1]); b = MX3(b, C0[r + 2], C0[r + 3]); a = MX3(a, C1[r], C1[r + 1]); b = MX3(b, C1[r + 2], C1[r + 3]); } \
      float rm = __builtin_fmaxf(a, b); { auto rr = __builtin_amdgcn_permlane32_swap(__float_as_uint(rm), __float_as_uint(rm), false, false); rm = __builtin_fmaxf(__uint_as_float(rr[0]), __uint_as_float(rr[1])); } \
      resc = false; \
      if (__builtin_expect(__any(rm > (float)THRL), 0)) { const float dl = __builtin_fmaxf(rm, 0.f); mhat += dl; \
        _Pragma("unroll") for (int r = 0; r < 16; ++r) { C0[r] -= dl; C1[r] -= dl; } \
        _Pragma("unroll") for (int r = 0; r < 16; ++r) negm[r] = -mhat; asm volatile("" : "+v"(negm)); \
        const float f = __builtin_amdgcn_exp2f(-dl); l_reg *= f; if (hi == 0) wsf[r32] = f; resc = true; } } \
    SBAR(); \
    GAPB(o[0] = __builtin_amdgcn_mfma_f32_32x32x16_bf16(PAF(0), VFR(0), o[0], 0, 0, 0), C0, 0); \
    GAPB(o[1] = __builtin_amdgcn_mfma_f32_32x32x16_bf16(PAF(0), VFR(4), o[1], 0, 0, 0), C0, 4); \
    KRD(GL, 0); GAPB(o[0] = __builtin_amdgcn_mfma_f32_32x32x16_bf16(PAF(1), VFR(1), o[0], 0, 0, 0), C0, 8); \
    KRD(GL, 1); GAPB(o[1] = __builtin_amdgcn_mfma_f32_32x32x16_bf16(PAF(1), VFR(5), o[1], 0, 0, 0), C0, 12); \
    KRD(GL, 2); GAPB(o[0] = __builtin_amdgcn_mfma_f32_32x32x16_bf16(PAF(2), VFR(2), o[0], 0, 0, 0), C1, 0); \
    KRD(GL, 3); GAPB(o[1] = __builtin_amdgcn_mfma_f32_32x32x16_bf16(PAF(2), VFR(6), o[1], 0, 0, 0), C1, 4); \
    GAPB(o[0] = __builtin_amdgcn_mfma_f32_32x32x16_bf16(PAF(3), VFR(3), o[0], 0, 0, 0), C1, 8); \
    GAPB(o[1] = __builtin_amdgcn_mfma_f32_32x32x16_bf16(PAF(3), VFR(7), o[1], 0, 0, 0), C1, 12); \
    } while (0)
    int t = 1;
    for (; t + 5 < NT; t += 2) {
        STEP(pB0, pB1, pA0, pA1, t, true, true, true);     WAIT_BAR(2); RESC(); ROT();
        STEP(pA0, pA1, pB0, pB1, t + 1, true, true, true); WAIT_BAR(2); RESC(); ROT();
    }
#define ENDW(tt) do { if ((tt) + 3 < NT) { WAIT_BAR(2); } else if ((tt) + 2 < NT) { WAIT_BAR(1); } else { WAIT_BAR(0); } } while (0)
    for (; t + 1 < NT; t += 2) {
        STEP(pB0, pB1, pA0, pA1, t, (t + 3 < NT), (t + 1 < NT), (t + 1 < NT));       ENDW(t);     RESC(); ROT();
        STEP(pA0, pA1, pB0, pB1, t + 1, (t + 4 < NT), (t + 2 < NT), (t + 2 < NT));   ENDW(t + 1); RESC(); ROT();
    }
    STEP(pB0, pB1, pA0, pA1, NT - 1, false, false, false); RESC();
    { float sacc = pB0[0] + pB0[1]; _Pragma("unroll") for (int r = 2; r < 16; ++r) sacc += pB0[r]; _Pragma("unroll") for (int r = 0; r < 16; ++r) sacc += pB1[r]; l_reg += sacc;
      pw0 = (u32x4){PKW(pB0, 0), PKW(pB0, 2), PKW(pB0, 4), PKW(pB0, 6)}; pw1 = (u32x4){PKW(pB0, 8), PKW(pB0, 10), PKW(pB0, 12), PKW(pB0, 14)}; pw2 = (u32x4){PKW(pB1, 0), PKW(pB1, 2), PKW(pB1, 4), PKW(pB1, 6)}; pw3 = (u32x4){PKW(pB1, 8), PKW(pB1, 10), PKW(pB1, 12), PKW(pB1, 14)};
      SBAR(); pv(o, vb0 + sl_cur, PAF(0), PAF(1), PAF(2), PAF(3)); }
#undef PKW
#undef PAF
#undef VFR
#undef PIN
#undef MX3
#undef GAPA
#undef GAPB
#undef EX
#undef VRD
#undef KRD
#undef STEP
#undef ENDW
    { auto rr = __builtin_amdgcn_permlane32_swap(__float_as_uint(l_reg), __float_as_uint(l_reg), false, false); l_reg = __uint_as_float(rr[0]) + __uint_as_float(rr[1]); }
    if (hi == 0) { wsf[32 + r32] = l_reg; if (OWN) wsf[r32] = mhat; } asm volatile("s_waitcnt lgkmcnt(0)" ::: "memory");
    float rli[16];
#pragma unroll
    for (int r = 0; r < 16; ++r) rli[r] = __builtin_amdgcn_rcpf(wsf[32 + crow(r, hi)]);
    bf16* Ow = O + (rowbase + q0 + wid * QBLK) * PITCH + h * D;
    { bf16* stg = (bf16*)(shm + LDS_OST) + wid * 2048;
#pragma unroll
      for (int r = 0; r < 16; ++r) { const int orow = crow(r, hi);
#pragma unroll
        for (int d0 = 0; d0 < 2; ++d0) stg[orow * 64 + d0 * 32 + r32] = __float2bfloat16(o[d0][r] * rli[r]); }
      asm volatile("s_waitcnt lgkmcnt(0)" ::: "memory");
      const int nsel = qb < 3 ? qb : 3;
#pragma unroll
      for (int i = 0; i < 4; ++i) { const int row = i * 8 + (lane >> 3), ch = lane & 7; u32x4 v = *(const u32x4*)(stg + row * 64 + ch * 8);
        if constexpr (OWN) {
          if (nsel > 0) {
            const float mo = wsf[row], lo = wsf[32 + row];
            const size_t e0 = (((size_t)(b * NHEAD + h)) * SEQ + q0 + wid * QBLK + row) * 3;
            float ms[3], ls[3]; u32x4 pp[3]; float M = mo;
#pragma unroll
            for (int s_ = 0; s_ < 3; ++s_) { ms[s_] = -INFINITY; ls[s_] = 0.f; pp[s_] = (u32x4){0u, 0u, 0u, 0u};
              if (s_ < nsel) { const f32x2 ml = *(const f32x2*)(PML + (e0 + s_) * 2); ms[s_] = ml.x; ls[s_] = ml.y; pp[s_] = *(const u32x4*)(PO + (e0 + s_) * 64 + ch * 8); M = fmaxf(M, ml.x); } }
            const float wo = lo * __builtin_amdgcn_exp2f(mo - M); float W = wo;
            float a[8] = {bflo(v.x) * wo, bfhi(v.x) * wo, bflo(v.y) * wo, bfhi(v.y) * wo, bflo(v.z) * wo, bfhi(v.z) * wo, bflo(v.w) * wo, bfhi(v.w) * wo};
#pragma unroll
            for (int s_ = 0; s_ < 3; ++s_) { const float w_ = (s_ < nsel) ? ls[s_] * __builtin_amdgcn_exp2f(ms[s_] - M) : 0.f; W += w_;
              a[0] += w_ * bflo(pp[s_].x); a[1] += w_ * bfhi(pp[s_].x); a[2] += w_ * bflo(pp[s_].y); a[3] += w_ * bfhi(pp[s_].y); a[4] += w_ * bflo(pp[s_].z); a[5] += w_ * bfhi(pp[s_].z); a[6] += w_ * bflo(pp[s_].w); a[7] += w_ * bfhi(pp[s_].w); }
            const float iw = 1.0f / W;
            v.x = cvtpk_s(a[0] * iw, a[1] * iw); v.y = cvtpk_s(a[2] * iw, a[3] * iw); v.z = cvtpk_s(a[4] * iw, a[5] * iw); v.w = cvtpk_s(a[6] * iw, a[7] * iw);
          } }
        if (do_store) *(u32x4*)(Ow + (long)row * PITCH + ch * 8) = v; } }
    asm volatile("s_waitcnt lgkmcnt(0)\n\ts_barrier" ::: "memory");
#undef DMA_K
#undef DMA_V
#undef TM
#undef MASKT
#undef START
#undef RESC
#undef ROT
}

__device__ __forceinline__ void select_unit(int b, int h, int qb, const bf16* Q, const float* ksum, unsigned short* LIST, unsigned* CNT, char* shm) {
    if (qb == 0) return;
    const int tid = threadIdx.x, lane = tid & 63, r32 = lane & 31, hi = lane >> 5; const int wid = __builtin_amdgcn_readfirstlane(tid >> 6);
    LAS unsigned* hist = (LAS unsigned*)shm; LAS unsigned* basev = hist + 32;
    if (tid < 32) hist[tid] = 0u;
    __syncthreads();
    int kbs[3] = {0, 1, 2}; const int ns = qb < 3 ? qb : 3;
    if (qb > 3) {
        const bf16* Qw = Q + ((long)b * SEQ + qb * QB + wid * QBLK) * PITCH + h * D;
        bf16x8 qr[4];
#pragma unroll
        for (int d0 = 0; d0 < 4; ++d0) qr[d0] = *reinterpret_cast<const bf16x8*>(&Qw[(long)r32 * PITCH + d0 * 16 + hi * 8]);
        gate_top3(ksum + ((size_t)(b * NHEAD + h) * 32) * 64, qr, qb, r32, hi, kbs);
    }
    unsigned pos[3] = {0u, 0u, 0u};
    if (hi == 0) {
#pragma unroll
        for (int s_ = 0; s_ < 3; ++s_) if (s_ < ns) pos[s_] = __hip_atomic_fetch_add(hist + kbs[s_], 1u, __ATOMIC_RELAXED, __HIP_MEMORY_SCOPE_WORKGROUP);
    }
    __syncthreads();
    const int bh = b * NHEAD + h;
    if (tid < 32) { const unsigned n = hist[tid]; basev[tid] = n ? __hip_atomic_fetch_add(CNT + bh * 32 + tid, n, __ATOMIC_RELAXED, __HIP_MEMORY_SCOPE_AGENT) : 0u; }
    __syncthreads();
    if (hi == 0) { const unsigned qv = (unsigned)(qb * QB + wid * QBLK + r32) << 2;
#pragma unroll
        for (int s_ = 0; s_ < 3; ++s_) if (s_ < ns) LIST[(size_t)(bh * 32 + kbs[s_]) * 8192 + basev[kbs[s_]] + pos[s_]] = (unsigned short)(qv | (unsigned)s_); }
    __syncthreads();
}

constexpr int G_K = 0, G_V = 32768, G_WS = 65536, G_OST = G_WS + NW * 512, G_TAB = G_OST + NW * 4096, G_BYTES = G_TAB + 8256 + 4096 + 4104;
template <int THRL> __device__ __forceinline__ void gather_phase(char* shm, const bf16* Q, const bf16* __restrict__ K, const bf16* __restrict__ V, const unsigned short* LIST, unsigned* CNT, bf16_t* PO, float* PML, int vcu, int G, bool do_store) {
    const int tid = threadIdx.x, lane = tid & 63, r32 = lane & 31, hi = lane >> 5; const int wid = __builtin_amdgcn_readfirstlane(tid >> 6);
    LAS int* pre = (LAS int*)(shm + G_TAB); LAS int* wtot = pre + 1032; LAS int* cntl = (LAS int*)(shm + G_TAB + 8256); LAS int* prw = (LAS int*)(shm + G_TAB + 8256 + 4096);
    constexpr int WL = 24, WP = 20;
    {
        const int c0 = (int)__hip_atomic_load(CNT + 2 * tid, __ATOMIC_RELAXED, __HIP_MEMORY_SCOPE_AGENT), c1 = (int)__hip_atomic_load(CNT + 2 * tid + 1, __ATOMIC_RELAXED, __HIP_MEMORY_SCOPE_AGENT);
        const int n0 = (c0 + 255) >> 8, n1 = (c1 + 255) >> 8, sm = n0 + n1;
        const int w0 = c0 ? WL + (n0 - 1) * WP + 12 + ((c0 - 256 * (n0 - 1) + 31) >> 5) : 0, w1 = c1 ? WL + (n1 - 1) * WP + 12 + ((c1 - 256 * (n1 - 1) + 31) >> 5) : 0, sw = w0 + w1;
        int v = sm, vw = sw;
#pragma unroll
        for (int o_ = 1; o_ < 64; o_ <<= 1) { const int t_ = __shfl_up(v, o_), tw_ = __shfl_up(vw, o_); if (lane >= o_) { v += t_; vw += tw_; } }
        if (lane == 63) { wtot[wid] = v; wtot[8 + wid] = vw; }
        cntl[2 * tid] = c0; cntl[2 * tid + 1] = c1;
        __syncthreads();
        int off = 0, offw = 0;
        for (int w_ = 0; w_ < wid; ++w_) { off += wtot[w_]; offw += wtot[8 + w_]; }
        const int excl = off + v - sm, exclw = offw + vw - sw;
        pre[2 * tid] = excl; pre[2 * tid + 1] = excl + n0; prw[2 * tid] = exclw; prw[2 * tid + 1] = exclw + w0;
        if (tid == NW * 64 - 1) { pre[1024] = excl + sm; prw[1024] = exclw + sw; }
        __syncthreads();
    }
    const int Wtot = __builtin_amdgcn_readfirstlane(prw[1024]);
    int ub[2], istart = 0;
#pragma unroll
    for (int e_ = 0; e_ < 2; ++e_) { const int tgt = (int)(((long)Wtot * (vcu + e_)) / G);
        int lo_ = 0, hi_ = 1024;
        while (hi_ - lo_ > 1) { const int mid = (lo_ + hi_) >> 1; if (__builtin_amdgcn_readfirstlane(prw[mid]) <= tgt) lo_ = mid; else hi_ = mid; }
        const int npi = __builtin_amdgcn_readfirstlane(pre[lo_ + 1]) - __builtin_amdgcn_readfirstlane(pre[lo_]);
        int p_ = (tgt - __builtin_amdgcn_readfirstlane(prw[lo_]) - WL + WP / 2) / WP; p_ = p_ < 0 ? 0 : (p_ > npi ? npi : p_);
        ub[e_] = (vcu + e_ >= G) ? __builtin_amdgcn_readfirstlane(pre[1024]) : __builtin_amdgcn_readfirstlane(pre[lo_]) + p_;
        if (e_ == 0 && vcu != 0) istart = lo_; }
    const int ulo = (vcu == 0) ? 0 : ub[0], uhi = ub[1];
    const unsigned lds0 = (unsigned)(uintptr_t)shm;
    float* wsf = (float*)(shm + G_WS) + wid * 128; int* ent = (int*)(wsf + 64);
    const unsigned kdst = lds0 + G_K + wid * 1024, vdst = lds0 + G_V + wid * 1024;
    const int vb0 = (int)(lds0 + G_V) + ((lane >> 4) & 1) * 32 + (lane & 3) * 8 + (4 * hi + ((lane & 15) >> 2)) * 64;
    int it0 = istart, it1 = istart, it2 = istart, cur = -1;
#define G_ITEM(itv, uu) do { while ((uu) < uhi && __builtin_amdgcn_readfirstlane(pre[(itv) + 1]) <= (uu)) ++(itv); } while (0)
#define G_ENTRY(itv, uu) ({ const int ps_ = (uu) - __builtin_amdgcn_readfirstlane(pre[itv]), cn_ = __builtin_amdgcn_readfirstlane(cntl[itv]); const int li_ = ps_ * 256 + wid * QBLK + r32; \
        (unsigned)LIST[(size_t)(itv) * 8192 + (li_ < cn_ ? li_ : 0)] | ((li_ < cn_) ? 0x10000u : 0u); })
#define G_QLOAD(dst, itv, ee) do { const int bh_ = (itv) >> 5; const bf16* Qrow_ = Q + ((long)(bh_ >> 3) * SEQ + (int)(((ee) & 0xffffu) >> 2)) * PITCH + (bh_ & 7) * D; \
        _Pragma("unroll") for (int d0 = 0; d0 < 4; ++d0) dst[d0] = *reinterpret_cast<const bf16x8*>(Qrow_ + d0 * 16 + hi * 8); } while (0)
    unsigned e0 = 0u, e1 = 0u, e2 = 0u; bf16x8 qr[4], qn[4];
    if (ulo < uhi) { G_ITEM(it0, ulo); e0 = G_ENTRY(it0, ulo); it1 = it0; { const int u1_ = (ulo + 1 < uhi) ? ulo + 1 : uhi - 1; G_ITEM(it1, u1_); e1 = G_ENTRY(it1, u1_); } G_QLOAD(qr, it0, e0); }
    it2 = it1;
    for (int u = ulo; u < uhi; ++u) {
        { const int u2_ = (u + 2 < uhi) ? u + 2 : uhi - 1; G_ITEM(it2, u2_); e2 = G_ENTRY(it2, u2_); }
        const int item = it0;
        const int bh = item >> 5, kb = item & 31, b = bh >> 3, h = bh & 7;
        if (item != cur) {
            asm volatile("s_waitcnt lgkmcnt(0)\n\ts_barrier" ::: "memory");
            const bf16* Kh = K + (long)b * SEQ * PITCH + h * D, *Vh = V + (long)b * SEQ * PITCH + h * D;
            const bf16* ksrc = Kh + (long)lane * PITCH + wid * 8;
            const bf16* vsrc = Vh + (long)(16 * (wid & 3) + (lane >> 2)) * PITCH + (wid >> 2) * 32 + (lane & 3) * 8;
#pragma unroll
            for (int t = 0; t < 4; ++t) { glds16(ksrc + (long)(4 * kb + t) * KVBLK * PITCH, (unsigned)__builtin_amdgcn_readfirstlane(kdst + t * 8192)); glds16(vsrc + (long)(4 * kb + t) * KVBLK * PITCH, (unsigned)__builtin_amdgcn_readfirstlane(vdst + t * 8192)); }
            asm volatile("s_waitcnt vmcnt(0)\n\ts_barrier" ::: "memory");
            cur = item;
            if (wid >= 4) __builtin_amdgcn_s_sleep(10);
        }
        G_QLOAD(qn, it1, e1);
        const bool valid = (e0 & 0x10000u) != 0u;
        const int q = (int)((e0 & 0xffffu) >> 2), slot = (int)(e0 & 3u);
        const bool wave_has_rows = __builtin_amdgcn_readfirstlane((int)(e0 >> 16) & 1) != 0 || __any(valid);
        if (wave_has_rows) {
        float mhat = 0.f, l_reg = 0.f; f32x16 o[2]; f32x16 negm;
#pragma unroll
        for (int r = 0; r < 16; ++r) { o[0][r] = 0.f; o[1][r] = 0.f; negm[r] = 0.f; }
        const lds_cptr kp0 = (lds_cptr)shm + G_K + hi * 1024 + r32 * 16; const lds_cptr vp0 = (lds_cptr)shm + G_V + ((lane >> 4) & 1) * 32 + (lane & 3) * 8 + (4 * hi + ((lane & 15) >> 2)) * 64;
        bf16x8 kf[8]; f32x16 p0, p1, s0, s1;
#define G_QK(D0, D1) do { D0 = __builtin_amdgcn_mfma_f32_32x32x16_bf16(kf[0], qr[0], negm, 0, 0, 0); D1 = __builtin_amdgcn_mfma_f32_32x32x16_bf16(kf[1], qr[0], negm, 0, 0, 0); \
            D0 = __builtin_amdgcn_mfma_f32_32x32x16_bf16(kf[2], qr[1], D0, 0, 0, 0); D1 = __builtin_amdgcn_mfma_f32_32x32x16_bf16(kf[3], qr[1], D1, 0, 0, 0); \
            D0 = __builtin_amdgcn_mfma_f32_32x32x16_bf16(kf[4], qr[2], D0, 0, 0, 0); D1 = __builtin_amdgcn_mfma_f32_32x32x16_bf16(kf[5], qr[2], D1, 0, 0, 0); \
            D0 = __builtin_amdgcn_mfma_f32_32x32x16_bf16(kf[6], qr[3], D0, 0, 0, 0); D1 = __builtin_amdgcn_mfma_f32_32x32x16_bf16(kf[7], qr[3], D1, 0, 0, 0); } while (0)
#define G_MX(D0, D1, FIRST) do { float a_ = fmaxf(fmaxf(D0[0], D0[1]), D1[0]), c_ = fmaxf(fmaxf(D0[2], D0[3]), D1[1]); a_ = fmaxf(fmaxf(a_, D1[2]), D1[3]); \
            _Pragma("unroll") for (int r = 4; r < 16; r += 4) { a_ = fmaxf(fmaxf(a_, D0[r]), D0[r + 1]); c_ = fmaxf(fmaxf(c_, D0[r + 2]), D0[r + 3]); a_ = fmaxf(fmaxf(a_, D1[r]), D1[r + 1]); c_ = fmaxf(fmaxf(c_, D1[r + 2]), D1[r + 3]); } \
            float rm_ = fmaxf(a_, c_); { auto rr_ = __builtin_amdgcn_permlane32_swap(__float_as_uint(rm_), __float_as_uint(rm_), false, false); rm_ = fmaxf(__uint_as_float(rr_[0]), __uint_as_float(rr_[1])); } \
            if (FIRST) { mhat = rm_; _Pragma("unroll") for (int r = 0; r < 16; ++r) { D0[r] -= rm_; D1[r] -= rm_; negm[r] = -mhat; } } \
            else if (__any(rm_ > (float)THRL)) { const float dl_ = fmaxf(rm_, 0.f); mhat += dl_; \
                _Pragma("unroll") for (int r = 0; r < 16; ++r) { D0[r] -= dl_; D1[r] -= dl_; negm[r] = -mhat; } \
                const float f_ = __builtin_amdgcn_exp2f(-dl_); l_reg *= f_; if (hi == 0) wsf[r32] = f_; \
                asm volatile("s_waitcnt lgkmcnt(0)" ::: "memory"); \
                _Pragma("unroll") for (int d_ = 0; d_ < 2; ++d_) _Pragma("unroll") for (int r = 0; r < 16; ++r) o[d_][r] *= wsf[crow(r, hi)]; } } while (0)
        const bool run_tiles = (GPROBE == 1) ? do_store : true;
        if (run_tiles) {
        kload8(kf, kp0);
        G_QK(p0, p1);
        kload8(kf, kp0 + 8192);
        G_MX(p0, p1, true);
#pragma unroll
        for (int t = 0; t < 4; ++t) {
            if (t < 3) { __builtin_amdgcn_sched_barrier(0); G_QK(s0, s1); if (t < 2) kload8(kf, kp0 + (t + 2) * 8192); }
            s16x4 vlo[8], vhi[8];
            const lds_cptr vp_ = vp0 + t * 8192;
#pragma unroll
            for (int i = 0; i < 8; ++i) { vlo[i] = vtr(vp_ + ((i >> 2) * 4096 + (i & 3) * 1024)); vhi[i] = vtr(vp_ + ((i >> 2) * 4096 + (i & 3) * 1024 + 512)); }
            __builtin_amdgcn_sched_barrier(0);
            float sacc = 0.f;
#pragma unroll
            for (int r = 0; r < 16; ++r) { p0[r] = __builtin_amdgcn_exp2f(p0[r]); p1[r] = __builtin_amdgcn_exp2f(p1[r]); sacc += p0[r] + p1[r]; }
            l_reg += sacc;
            const u32x4 pw0 = {cvtpk_s(p0[0], p0[1]), cvtpk_s(p0[2], p0[3]), cvtpk_s(p0[4], p0[5]), cvtpk_s(p0[6], p0[7])}, pw1 = {cvtpk_s(p0[8], p0[9]), cvtpk_s(p0[10], p0[11]), cvtpk_s(p0[12], p0[13]), cvtpk_s(p0[14], p0[15])};
            const u32x4 pw2 = {cvtpk_s(p1[0], p1[1]), cvtpk_s(p1[2], p1[3]), cvtpk_s(p1[4], p1[5]), cvtpk_s(p1[6], p1[7])}, pw3 = {cvtpk_s(p1[8], p1[9]), cvtpk_s(p1[10], p1[11]), cvtpk_s(p1[12], p1[13]), cvtpk_s(p1[14], p1[15])};
            __builtin_amdgcn_sched_barrier(0);
#define G_VF(i) (bf16x8){vlo[i][0], vlo[i][1], vlo[i][2], vlo[i][3], vhi[i][0], vhi[i][1], vhi[i][2], vhi[i][3]}
            if (GPROBE == 2 && !do_store) { asm volatile("" :: "v"(pw0), "v"(pw1), "v"(pw2), "v"(pw3)); } else {
            o[0] = __builtin_amdgcn_mfma_f32_32x32x16_bf16(__builtin_bit_cast(bf16x8, pw0), G_VF(0), o[0], 0, 0, 0); o[1] = __builtin_amdgcn_mfma_f32_32x32x16_bf16(__builtin_bit_cast(bf16x8, pw0), G_VF(4), o[1], 0, 0, 0);
            o[0] = __builtin_amdgcn_mfma_f32_32x32x16_bf16(__builtin_bit_cast(bf16x8, pw1), G_VF(1), o[0], 0, 0, 0); o[1] = __builtin_amdgcn_mfma_f32_32x32x16_bf16(__builtin_bit_cast(bf16x8, pw1), G_VF(5), o[1], 0, 0, 0);
            o[0] = __builtin_amdgcn_mfma_f32_32x32x16_bf16(__builtin_bit_cast(bf16x8, pw2), G_VF(2), o[0], 0, 0, 0); o[1] = __builtin_amdgcn_mfma_f32_32x32x16_bf16(__builtin_bit_cast(bf16x8, pw2), G_VF(6), o[1], 0, 0, 0);
            o[0] = __builtin_amdgcn_mfma_f32_32x32x16_bf16(__builtin_bit_cast(bf16x8, pw3), G_VF(3), o[0], 0, 0, 0); o[1] = __builtin_amdgcn_mfma_f32_32x32x16_bf16(__builtin_bit_cast(bf16x8, pw3), G_VF(7), o[1], 0, 0, 0);
            }
#undef G_VF
            if (t < 3) { G_MX(s0, s1, false); p0 = s0; p1 = s1; }
        }
        }
#undef G_QK
#undef G_MX
        { auto rr = __builtin_amdgcn_permlane32_swap(__float_as_uint(l_reg), __float_as_uint(l_reg), false, false); l_reg = __uint_as_float(rr[0]) + __uint_as_float(rr[1]); }
        const int er = valid ? (q * 3 + slot) : -1;
        if (hi == 0) { wsf[32 + r32] = l_reg; ent[r32] = er; } asm volatile("s_waitcnt lgkmcnt(0)" ::: "memory");
        float rli[16];
#pragma unroll
        for (int r = 0; r < 16; ++r) rli[r] = __builtin_amdgcn_rcpf(wsf[32 + crow(r, hi)]);
        bf16* stg = (bf16*)(shm + G_OST) + wid * 2048;
#pragma unroll
        for (int r = 0; r < 16; ++r) { const int orow = crow(r, hi);
#pragma unroll
            for (int d0 = 0; d0 < 2; ++d0) stg[orow * 64 + d0 * 32 + r32] = __float2bfloat16(o[d0][r] * rli[r]); }
        asm volatile("s_waitcnt lgkmcnt(0)" ::: "memory");
        const size_t ebase = (size_t)bh * SEQ * 3;
#pragma unroll
        for (int i = 0; i < 4; ++i) { const int row = i * 8 + (lane >> 3), ch = lane & 7; const u32x4 v = *(const u32x4*)(stg + row * 64 + ch * 8); const int er_ = ent[row];
            if (er_ >= 0 && do_store) *(u32x4*)(PO + (ebase + er_) * 64 + ch * 8) = v; }
        if (hi == 0 && valid && do_store) *(f32x2*)(PML + (ebase + er) * 2) = (f32x2){mhat, l_reg};
        asm volatile("s_waitcnt lgkmcnt(0)" ::: "memory");
        }
        e0 = e1; e1 = e2; it0 = it1; it1 = it2;
#pragma unroll
        for (int d0 = 0; d0 < 4; ++d0) qr[d0] = qn[d0];
    }
    asm volatile("s_waitcnt vmcnt(0) lgkmcnt(0)\n\ts_barrier" ::: "memory");
#undef G_ITEM
#undef G_ENTRY
#undef G_QLOAD
}
#undef SBAR
#undef WAIT_BAR
}

#define XB_TMO      128
#define XB_XCNT(j)  (256  + 64 * (j))
#define XB_XSUB(j)  (1280 + 64 * (j))
#define XB_XGEN(j)  (2304 + 64 * (j))
#define XB_TOP      3328
#define XB_TOPGEN   3392
#define XCD_BAR_WORDS 3456
#define XB_SPIN_CAP (1u << 18)
__device__ __forceinline__ unsigned xb_ld(unsigned* p)              { return __hip_atomic_load(p, __ATOMIC_RELAXED, __HIP_MEMORY_SCOPE_AGENT); }
__device__ __forceinline__ unsigned xb_add(unsigned* p, unsigned v) { return __hip_atomic_fetch_add(p, v, __ATOMIC_RELAXED, __HIP_MEMORY_SCOPE_AGENT); }
__device__ __forceinline__ unsigned xb_xcc_id() { return (unsigned)__builtin_amdgcn_s_getreg((3 << 11) | 20) & 0xFu; }
#define XB_SPIN(cond, bar) do { unsigned _sp = 0; while (cond) { __builtin_amdgcn_s_sleep(1); \
    if ((++_sp & 255u) == 0u) { if (xb_ld(&(bar)[XB_TMO])) break; if (_sp > XB_SPIN_CAP) { atomicAdd(&(bar)[XB_TMO], 1u); break; } } } } while (0)
struct XcdBarrier { unsigned* bar; unsigned x; volatile LAS unsigned* st; };
__device__ __forceinline__ XcdBarrier xcd_barrier_post(unsigned* bar, volatile LAS unsigned* st) {
    XcdBarrier b; b.bar = bar; b.x = xb_xcc_id(); b.st = st;
    if (threadIdx.x == 0) (void)xb_add(&bar[XB_XCNT(b.x)], 1u);
    return b;
}
__device__ __forceinline__ void xcd_barrier_complete(unsigned* bar, unsigned x, unsigned& nloc, unsigned& nx) {
    const unsigned G = gridDim.x * gridDim.y * gridDim.z;
    unsigned sum, cnt, mine, sp = 0u;
    for (;;) {
        sum = 0u; cnt = 0u; mine = 0u;
#pragma unroll
        for (unsigned j = 0; j < 16; ++j) { const unsigned c = xb_ld(&bar[XB_XCNT(j)]); sum += c; cnt += (c > 0u) ? 1u : 0u; mine = (j == x) ? c : mine; }
        if (sum == G) break;
        __builtin_amdgcn_s_sleep(1);
        if ((++sp & 255u) == 0u) { if (xb_ld(&bar[XB_TMO])) break; if (sp > XB_SPIN_CAP) { atomicAdd(&bar[XB_TMO], 1u); break; } }
    }
    nloc = mine > 0u ? mine : 1u; nx = cnt > 0u ? cnt : 1u;
}
__device__ __forceinline__ void xcd_barrier_(const XcdBarrier& b);
__device__ __forceinline__ void xcd_barrier(const XcdBarrier& b) { T_BEGIN(1, t1_) xcd_barrier_(b); T_END(1, t1_); }
__device__ __forceinline__ void xcd_barrier_(const XcdBarrier& b) {
    asm volatile("s_waitcnt vmcnt(0)" ::: "memory");
    __syncthreads();
    if (threadIdx.x == 0) {
        unsigned* bar = b.bar;
        __builtin_amdgcn_s_waitcnt(0);
        unsigned nloc = b.st[0], nx = b.st[1];
        if (nloc == 0u) { xcd_barrier_complete(bar, b.x, nloc, nx); b.st[0] = nloc; b.st[1] = nx; }
        const unsigned old = xb_add(&bar[XB_XSUB(b.x)], 1u);
        const unsigned gen = old / nloc;
        if (old + 1u == (gen + 1u) * nloc) {
            __builtin_amdgcn_fence(__ATOMIC_RELEASE, "agent");
            asm volatile("s_waitcnt vmcnt(0)" ::: "memory");
            const unsigned og = xb_add(&bar[XB_TOP], 1u);
            const unsigned tg = og / nx;
            if (og + 1u == (tg + 1u) * nx) xb_add(&bar[XB_TOPGEN], 1u);
            else XB_SPIN(xb_ld(&bar[XB_TOPGEN]) == tg, bar);
            __builtin_amdgcn_fence(__ATOMIC_ACQUIRE, "agent");
            xb_add(&bar[XB_XGEN(b.x)], 1u);
            asm volatile("s_waitcnt vmcnt(0)" ::: "memory");
        } else {
            XB_SPIN(xb_ld(&bar[XB_XGEN(b.x)]) == gen, bar);
            __builtin_amdgcn_fence(__ATOMIC_ACQUIRE, "agent");
            asm volatile("s_waitcnt vmcnt(0)" ::: "memory");
        }
    }
    __syncthreads();
}

struct Args { const float* in[22]; float* out; unsigned char* ws; int ph_lo, ph_hi, li, flags; };
struct Frame {
    LAS unsigned char* lds; volatile LAS unsigned* MISC; gu32* ctl;
    int tid, lane, wave, vcu, G;
};
#ifndef SKEW_P2
#define SKEW_P2 0
#endif
#ifndef SKEW_P45
#define SKEW_P45 0
#endif
__device__ __forceinline__ void phase_skew(int vcu, unsigned ticks) {
    if (ticks) { const unsigned long long t0 = __builtin_amdgcn_s_memrealtime(), d = (unsigned long long)(vcu & 7) * ticks;
        while (__builtin_amdgcn_s_memrealtime() - t0 < d) __builtin_amdgcn_s_sleep(8); }
}
__device__ __forceinline__ int fresh_tid() { int t = threadIdx.x; asm volatile("" : "+v"(t)); return t; }
#define PHASE_IDS() do { F.tid = fresh_tid(); F.lane = F.tid & 63; F.wave = __builtin_amdgcn_readfirstlane(F.tid >> 6); } while (0)

__device__ __forceinline__ void transpose_item(const float* W, int ldw, int k0, int n0, bf16_t* WT, size_t row_off, int Kd, LAS float* scr, int lane) {
    const int half = lane >> 5, j2 = 2 * (lane & 31);
#pragma unroll 8
    for (int i = 0; i < 32; ++i) { const int kk = 2 * i + half; const f32x2 v = *(const f32x2*)(W + (size_t)(k0 + kk) * ldw + n0 + j2); scr[kk * 65 + j2] = v.x; scr[kk * 65 + j2 + 1] = v.y; }
    LDS_WAIT(); asm volatile("" ::: "memory");
    const int c = lane & 7;
#pragma unroll
    for (int j = 0; j < 8; ++j) { const int n = (lane >> 3) + 8 * j; const LAS float* s = scr + (8 * c) * 65 + n;
        u32x4 o; o.x = cvt_pk_bf16(s[0 * 65], s[1 * 65]); o.y = cvt_pk_bf16(s[2 * 65], s[3 * 65]); o.z = cvt_pk_bf16(s[4 * 65], s[5 * 65]); o.w = cvt_pk_bf16(s[6 * 65], s[7 * 65]);
        *(u32x4*)(WT + (row_off + n0 + n) * (size_t)Kd + k0 + 8 * c) = o; }
    LDS_WAIT(); asm volatile("" ::: "memory");
}

__global__ void __launch_bounds__(NWAVES * 64, 2) hybrid_fwd(Args args) {
    extern __shared__ __attribute__((aligned(16))) unsigned char lds_raw[];
    Frame F;
    F.lds = (LAS unsigned char*)lds_raw;
    F.MISC = (volatile LAS unsigned*)(F.lds + MISC_OFF);
    F.tid = threadIdx.x; F.lane = F.tid & 63; F.wave = __builtin_amdgcn_readfirstlane(F.tid >> 6);
    F.G = gridDim.x; { const int bx = blockIdx.x; F.vcu = (F.G % 8 == 0) ? (bx % 8) * (F.G / 8) + bx / 8 : bx; }
    unsigned char* ws = args.ws;
    F.ctl = (gu32*)(ws + WS_CTL);
    const float* x = args.in[0]; const float* cvec = args.in[1]; const float* ada_w = args.in[2]; const float* ada_b = args.in[3];
    const float* norm1_g = args.in[4]; const float* norm2_g = args.in[5]; const float* w_in = args.in[6]; const float* gmlp_ln_g = args.in[7]; const float* gmlp_ln_b = args.in[8];
    const float* w_spatial = args.in[9]; const float* b_spatial = args.in[10]; const float* w_branch_a = args.in[11]; const float* w_branch_b = args.in[12]; const float* w_out = args.in[13];
    const float* w_rg = args.in[14]; const float* b_rg = args.in[15]; const float* w_re = args.in[16]; const float* b_re = args.in[17];
    const float* w_gate = args.in[18]; const float* w_up = args.in[19]; const float* w_down = args.in[20]; const float* final_g = args.in[21];
    float* out = args.out;
    float* KSUM = (float*)(ws + WS_KSUM); float* MODP = (float*)(ws + WS_MODP); float* MOD = (float*)(ws + WS_MOD); float* ROPE = (float*)(ws + WS_ROPE);
    bf16_t* WST = (bf16_t*)(ws + WS_WST); bf16_t* WRT = (bf16_t*)(ws + WS_WRT); float* SSQ = (float*)(ws + WS_SSQ);
    unsigned long long* ROUTE = (unsigned long long*)(ws + WS_ROUTE);
    bf16_t* WIN = (bf16_t*)(ws + WS_WIN); bf16_t* WAB = (bf16_t*)(ws + WS_WAB); bf16_t* WOUT = (bf16_t*)(ws + WS_WOUT);
    bf16_t* WGU = (bf16_t*)(ws + WS_WGU); bf16_t* WD = (bf16_t*)(ws + WS_WD);
    bf16_t* XN = (bf16_t*)(ws + WS_XN); bf16_t* PROJ = (bf16_t*)(ws + WS_PROJ); bf16_t* HID = (bf16_t*)(ws + WS_HID); bf16_t* YB = (bf16_t*)(ws + WS_Y); bf16_t* X1 = (bf16_t*)(ws + WS_X1);
    bf16_t* PO = (bf16_t*)(ws + WS_PO); float* PML = (float*)(ws + WS_PML); unsigned short* LIST = (unsigned short*)(ws + WS_LIST); unsigned* CNT = (unsigned*)(F.ctl + CW_CNT);

    for (int u = F.tid; u < 256; u += NWAVES * 64) ((LAS unsigned*)(F.lds + MISC_OFF))[u] = 0u;
    __syncthreads();
    XcdBarrier bar; bar.bar = (unsigned*)(F.ctl + CW_BAR) + args.li * XCD_BAR_WORDS; bar.x = 0; bar.st = nullptr;
    if (!MK_PER_PHASE) bar = xcd_barrier_post((unsigned*)(F.ctl + CW_BAR) + args.li * XCD_BAR_WORDS, F.MISC + 8);
    const int lo = args.ph_lo, hi = args.ph_hi;
#define IN(k) (lo <= (k) && (k) < hi)
#define PH_SET(k) do { if (TSEL != 0 && blockIdx.x == TBLK && threadIdx.x == 0) g_tphase = (k); } while (0)
    if (TSEL != 0 && blockIdx.x == TBLK && threadIdx.x == 0) { g_tacc = 0; g_tphase = -2; }
#define SEAM(k) do { if (IN(k) && IN((k) + 1)) xcd_barrier(bar); } while (0)

    PH_SET(0); TP_BEGIN(0, tp0_) if (IN(0)) { PHASE_IDS();
        const int gw = F.vcu * NWAVES + F.wave, NGW = F.G * NWAVES;
        const int gtid = F.vcu * (NWAVES * 64) + F.tid, NGT = F.G * NWAVES * 64;
        LAS float* scr = (LAS float*)(F.lds + F.wave * 16640);
        constexpr int I_MOD = 16 * 24, I_IN = 16 * 72, I_A = 8 * 16, I_O = 16 * 16;
        constexpr int NITEMS = I_MOD + I_IN + 2 * I_A + I_O;
        for (int it = gw; it < NITEMS; it += NGW) {
            int r = it;
            if (r < I_MOD) {
                const int s = r / 24, nc = r % 24, n = nc * 256 + 4 * F.lane;
                f32x4 a0 = {0.f, 0.f, 0.f, 0.f}, a1 = a0, a2 = a0, a3 = a0;
#pragma unroll 8
                for (int kk = 0; kk < 64; ++kk) { const int k = 64 * s + kk; const f32x4 w = *(const f32x4*)(ada_w + (size_t)k * 6144 + n);
                    a0 += w * cvec[k]; a1 += w * cvec[1024 + k]; a2 += w * cvec[2048 + k]; a3 += w * cvec[3072 + k]; }
                float* dst = MODP + (size_t)s * 24576 + n;
                *(f32x4*)(dst) = a0; *(f32x4*)(dst + 6144) = a1; *(f32x4*)(dst + 12288) = a2; *(f32x4*)(dst + 18432) = a3;
                continue; }
            r -= I_MOD;
            if (r < I_IN) { transpose_item(w_in, PC, 64 * (r / 72), 64 * (r % 72), WIN, 0, 1024, scr, F.lane); continue; } r -= I_IN;
            if (r < I_A) { transpose_item(w_branch_a, 1024, 64 * (r / 16), 64 * (r % 16), WAB, 0, 1024, scr, F.lane); continue; } r -= I_A;
            if (r < I_A) { transpose_item(w_branch_b, 1024, 64 * (r / 16), 64 * (r % 16), WAB + 512, 0, 1024, scr, F.lane); continue; } r -= I_A;
            transpose_item(w_out, 1024, 64 * (r / 16), 64 * (r % 16), WOUT, 0, 1024, scr, F.lane);
        }
        for (int i = gtid; i < 65536; i += NGT) {
            const int pos = i >> 3, j = i & 7; const float inv = powf(500000.0f, -(float)j * 2.0f / 16.0f); const float ang = (float)pos * inv;
            ROPE[i] = cosf(ang); ROPE[65536 + i] = sinf(ang); }
        for (int i = gtid; i < 65536; i += NGT) {
            const int s = i & 127, t_ = (i >> 7) & 127; const float v = (s <= t_) ? w_spatial[i] : 0.f; WST[i] = (bf16_t)(cvt_pk_bf16(v, 0.f) & 0xffffu); }
        for (int i = gtid; i < 48 * 1024; i += NGT) {
            const int j = i >> 10, k = i & 1023; float v = 0.f; if (j < 4) v = w_rg[k * 4 + j]; else if (j < 36) v = w_re[k * 32 + (j - 4)];
            const unsigned hb = cvt_pk_bf16(v, 0.f) & 0xffffu; const float lo = v - bflo(hb);
            WRT[i] = (bf16_t)hb; WRT[48 * 1024 + i] = (bf16_t)(cvt_pk_bf16(lo, 0.f) & 0xffffu); }
    }
    TP_END(0, tp0_); SEAM(0);

    PH_SET(1); TP_BEGIN(1, tp1_) if (IN(1)) { PHASE_IDS();
        const int c = F.vcu, b = c >> 6;
        LAS float* f = (LAS float*)F.lds;
        for (int v = F.tid; v < 2048; v += NWAVES * 64) { float s = ada_b[v];
#pragma unroll
            for (int sl = 0; sl < 16; ++sl) s += MODP[(size_t)sl * 24576 + b * 6144 + v];
            f[v] = s; }
        if (F.tid < 96) { const int idx = 96 * c + F.tid; float s = ada_b[idx % 6144];
#pragma unroll
            for (int sl = 0; sl < 16; ++sl) s += MODP[(size_t)sl * 24576 + idx];
            MOD[idx] = s; }
        __syncthreads();
        f32x4 A1[4], B1[4];
#pragma unroll
        for (int j = 0; j < 4; ++j) { const int k = 4 * F.lane + 256 * j; const f32x4 g = *(const f32x4*)(norm1_g + k);
#pragma unroll
            for (int i = 0; i < 4; ++i) { A1[j][i] = g[i] * (1.0f + f[1024 + k + i]); B1[j][i] = f[k + i]; } }
        for (int i0 = 0; i0 < 16; i0 += 4) {
            f32x4 v[4][4]; float ss[4];
#pragma unroll
            for (int u_ = 0; u_ < 4; ++u_) { const size_t row = (size_t)c * 128 + F.wave * 16 + i0 + u_; const f32x4* xr = (const f32x4*)(x + row * DM) + F.lane;
#pragma unroll
                for (int j = 0; j < 4; ++j) v[u_][j] = xr[64 * j]; }
#pragma unroll
            for (int u_ = 0; u_ < 4; ++u_) { float s = 0.f;
#pragma unroll
                for (int j = 0; j < 4; ++j) s += (v[u_][j].x * v[u_][j].x + v[u_][j].y * v[u_][j].y) + (v[u_][j].z * v[u_][j].z + v[u_][j].w * v[u_][j].w);
                ss[u_] = s; }
#pragma unroll
            for (int o_ = 1; o_ < 64; o_ <<= 1) {
#pragma unroll
                for (int u_ = 0; u_ < 4; ++u_) ss[u_] += __shfl_xor(ss[u_], o_); }
#pragma unroll
            for (int u_ = 0; u_ < 4; ++u_) { const size_t row = (size_t)c * 128 + F.wave * 16 + i0 + u_; const float rstd = 1.0f / sqrtf(ss[u_] * (1.0f / DM) + EPS);
                u32x2* o8 = (u32x2*)(XN + row * DM) + F.lane;
#pragma unroll
                for (int j = 0; j < 4; ++j) { const f32x4 hv = v[u_][j] * rstd * A1[j] + B1[j]; u32x2 w; w.x = cvt_pk_bf16(hv.x, hv.y); w.y = cvt_pk_bf16(hv.z, hv.w); o8[64 * j] = w; } } }
        __syncthreads();
    }
    TP_END(1, tp1_); SEAM(1);

    PH_SET(2); TP_BEGIN(2, tp2_) if (IN(2)) {
        pg8::DenseSched S; S.init(XN, DM, WIN, DM, T, PC, F.G, (int)blockIdx.x);
        pg8::EpiProj E{PROJ, ROPE, KSUM};
        phase_skew(F.vcu, SKEW_P2);
        pg8::gemm_phase<pg8::EpiProj, pg8::DenseSched, false>(F.lds, S, E);
    }
    TP_END(2, tp2_); SEAM(2);

    PH_SET(3); TP_BEGIN(3, tp3_) if (IN(3)) { PHASE_IDS();
        for (int chunk = F.vcu; chunk < ((args.flags & 2) ? 0 : T / 128); chunk += F.G) {
            const int lane = F.lane, w = F.wave, q = lane >> 4, l15 = lane & 15;
            const size_t row0 = (size_t)chunk * 128;
            float lg[8], lb[8];
            { const f32x4 g0 = *(const f32x4*)(gmlp_ln_g + 8 * lane), g1 = *(const f32x4*)(gmlp_ln_g + 8 * lane + 4), b0 = *(const f32x4*)(gmlp_ln_b + 8 * lane), b1 = *(const f32x4*)(gmlp_ln_b + 8 * lane + 4);
#pragma unroll
              for (int j = 0; j < 4; ++j) { lg[j] = g0[j]; lg[4 + j] = g1[j]; lb[j] = b0[j]; lb[4 + j] = b1[j]; } }
            u32x4 vn[16];
#pragma unroll
            for (int i = 0; i < 16; ++i) vn[i] = *(const u32x4*)(PROJ + (row0 + 16 * w + i) * PC + C_V + 8 * lane);
#pragma unroll
            for (int hb = 0; hb < 16; hb += 8) {
                float s1[8], s2[8];
#pragma unroll
                for (int i = 0; i < 8; ++i) { const u32x4 raw = vn[hb + i];
                    u32x4 gv; gv.x = cvt_pk_bf16(gelu_tanh(bflo(raw.x)), gelu_tanh(bfhi(raw.x))); gv.y = cvt_pk_bf16(gelu_tanh(bflo(raw.y)), gelu_tanh(bfhi(raw.y)));
                    gv.z = cvt_pk_bf16(gelu_tanh(bflo(raw.z)), gelu_tanh(bfhi(raw.z))); gv.w = cvt_pk_bf16(gelu_tanh(bflo(raw.w)), gelu_tanh(bfhi(raw.w)));
                    const float v0 = bflo(gv.x), v1 = bfhi(gv.x), v2 = bflo(gv.y), v3 = bfhi(gv.y), v4 = bflo(gv.z), v5 = bfhi(gv.z), v6 = bflo(gv.w), v7 = bfhi(gv.w);
                    s1[i] = ((v0 + v1) + (v2 + v3)) + ((v4 + v5) + (v6 + v7)); s2[i] = ((v0 * v0 + v1 * v1) + (v2 * v2 + v3 * v3)) + ((v4 * v4 + v5 * v5) + (v6 * v6 + v7 * v7));
                    vn[hb + i] = gv; }
#pragma unroll
                for (int o_ = 1; o_ < 64; o_ <<= 1) {
#pragma unroll
                    for (int i = 0; i < 8; ++i) { s1[i] += __shfl_xor(s1[i], o_); s2[i] += __shfl_xor(s2[i], o_); } }
#pragma unroll
                for (int i = 0; i < 8; ++i) { const float mean = s1[i] * (1.0f / 512.0f); const float var = fmaxf(s2[i] * (1.0f / 512.0f) - mean * mean, 0.f); const float rstd = 1.0f / sqrtf(var + EPS);
                    const u32x4 gv = vn[hb + i]; float v[8] = {bflo(gv.x), bfhi(gv.x), bflo(gv.y), bfhi(gv.y), bflo(gv.z), bfhi(gv.z), bflo(gv.w), bfhi(gv.w)};
#pragma unroll
                    for (int j = 0; j < 8; ++j) v[j] = (v[j] - mean) * rstd * lg[j] + lb[j];
                    vn[hb + i].x = cvt_pk_bf16(v[0], v[1]); vn[hb + i].y = cvt_pk_bf16(v[2], v[3]); vn[hb + i].z = cvt_pk_bf16(v[4], v[5]); vn[hb + i].w = cvt_pk_bf16(v[6], v[7]); }
            }
            const int tt = 16 * w + l15;
            u32x2 wfr[4][2]; u32x4 uq[4];
#define GM_LOAD(WF, UQ, g_) do { const bf16_t* wp_ = WST + ((size_t)((g_) * 128 + tt)) * 128 + 4 * q; \
                _Pragma("unroll") for (int ks = 0; ks < 4; ++ks) { WF[ks][0] = *(const u32x2*)(wp_ + 32 * ks); WF[ks][1] = *(const u32x2*)(wp_ + 32 * ks + 16); } \
                _Pragma("unroll") for (int i = 0; i < 4; ++i) UQ[i] = *(const u32x4*)(PROJ + (row0 + 16 * w + 4 * i + q) * PC + C_U + 128 * (g_) + 8 * l15); } while (0)
            GM_LOAD(wfr, uq, 0);
#pragma unroll
            for (int g = 0; g < 4; ++g) {
                __syncthreads();
                if (q == g) {
#pragma unroll
                    for (int i = 0; i < 16; ++i) *(LAS u32x4*)(F.lds + (16 * w + i) * 288 + l15 * 16) = vn[i];
                }
                __syncthreads();
                u32x2 wfn[4][2]; u32x4 uqn[4];
                if (g < 3) GM_LOAD(wfn, uqn, g + 1);
                f32x4 acc[8];
#pragma unroll
                for (int it = 0; it < 8; ++it) acc[it] = (f32x4){0.f, 0.f, 0.f, 0.f};
                const int nks = (16 * w + 16 + 31) / 32;
#pragma unroll
                for (int ks = 0; ks < 4; ++ks) { if (ks < nks) {
                    const bf16x8 bw = __builtin_bit_cast(bf16x8, (u32x4){wfr[ks][0].x, wfr[ks][0].y, wfr[ks][1].x, wfr[ks][1].y});
                    const attn_body::lds_cptr base = (attn_body::lds_cptr)F.lds + (32 * ks + 4 * q + (l15 >> 2)) * 288 + (l15 & 3) * 8;
#pragma unroll
                    for (int it = 0; it < 8; ++it) {
                        const s16x4 lo = attn_body::vtr(base + it * 32), hi_ = attn_body::vtr(base + 16 * 288 + it * 32);
                        const bf16x8 a = (bf16x8){lo[0], lo[1], lo[2], lo[3], hi_[0], hi_[1], hi_[2], hi_[3]};
                        acc[it] = __builtin_amdgcn_mfma_f32_16x16x32_bf16(a, bw, acc[it], 0, 0, 0);
                    } } }
                const float bs = b_spatial[g * 128 + tt];
                LAS unsigned char* svb = F.lds + 36864;
#pragma unroll
                for (int it = 0; it < 8; ++it) { u32x2 o; o.x = cvt_pk_bf16(acc[it][0] + bs, acc[it][1] + bs); o.y = cvt_pk_bf16(acc[it][2] + bs, acc[it][3] + bs);
                    *(LAS u32x2*)(svb + tt * 272 + (16 * it + 4 * q) * 2) = o; }
                LDS_WAIT(); asm volatile("" ::: "memory");
#pragma unroll
                for (int i = 0; i < 4; ++i) { const int tr_ = 16 * w + 4 * i + q; bf16_t* pp = PROJ + (row0 + tr_) * PC + C_U + 128 * g + 8 * l15;
                    const u32x4 uu = uq[i]; const u32x4 sv = *(const LAS u32x4*)(svb + tr_ * 272 + l15 * 16);
                    u32x4 o; o.x = cvt_pk_bf16(gelu_tanh(bflo(uu.x)) * bflo(sv.x), gelu_tanh(bfhi(uu.x)) * bfhi(sv.x)); o.y = cvt_pk_bf16(gelu_tanh(bflo(uu.y)) * bflo(sv.y), gelu_tanh(bfhi(uu.y)) * bfhi(sv.y));
                    o.z = cvt_pk_bf16(gelu_tanh(bflo(uu.z)) * bflo(sv.z), gelu_tanh(bfhi(uu.z)) * bfhi(sv.z)); o.w = cvt_pk_bf16(gelu_tanh(bflo(uu.w)) * bflo(sv.w), gelu_tanh(bfhi(uu.w)) * bfhi(sv.w));
                    *(u32x4*)pp = o; }
                LDS_WAIT(); asm volatile("" ::: "memory");
                if (g < 3) {
#pragma unroll
                    for (int ks = 0; ks < 4; ++ks) { wfr[ks][0] = wfn[ks][0]; wfr[ks][1] = wfn[ks][1]; }
#pragma unroll
                    for (int i = 0; i < 4; ++i) uq[i] = uqn[i]; }
            }
            __syncthreads();
        }
        {
            using namespace attn_body;
            const int s = F.vcu & 7, bh = F.vcu >> 3;
            const bf16* Qp = (const bf16*)(PROJ + C_Q); const bf16* Kp = (const bf16*)(PROJ + C_K); const bf16* Vp = (const bf16*)(PROJ + C_VV);
#define QBI(i) (((i) == 0) ? s : ((i) == 1) ? 15 - s : ((i) == 2) ? 16 + s : 31 - s)
            if (ATTN_MODE != 0) {
                if (bh < NB * 8 && !(args.flags & 4)) for (int i = 0; i < 4; ++i) select_unit(bh >> 3, bh & 7, QBI(i), Qp, KSUM, LIST, CNT, (char*)lds_raw + 40960);
                TP_END(3, tp3_);
                if (!MK_PER_PHASE) xcd_barrier(bar);
                PH_SET(31); TP_BEGIN(31, tp31_)
                unsigned long long tg0_ = 0; if (TSEL >= 5 && TSEL <= 7) tg0_ = __builtin_amdgcn_s_memrealtime();
                if (!(args.flags & 8)) gather_phase<8>((char*)lds_raw, Qp, Kp, Vp, LIST, CNT, PO, PML, F.vcu, F.G, (args.flags & 1) == 0);
                TP_END(31, tp31_);
                if (TSEL >= 5 && TSEL <= 7) { if (threadIdx.x == 0) __hip_atomic_store(&g_tw[F.vcu], (unsigned)(__builtin_amdgcn_s_memrealtime() - tg0_), __ATOMIC_RELAXED, __HIP_MEMORY_SCOPE_AGENT); }
                if (!MK_PER_PHASE) xcd_barrier(bar);
                if (TSEL == 5 || TSEL == 6) { if (blockIdx.x == TBLK && threadIdx.x == 0) { unsigned mx = 0, am = 0; for (int i = 0; i < 256; ++i) { const unsigned t_ = __hip_atomic_load(&g_tw[i], __ATOMIC_RELAXED, __HIP_MEMORY_SCOPE_AGENT); if (t_ > mx) { mx = t_; am = i; } }
                    g_tacc += (TSEL == 5) ? mx : am * 100u; } }
                if (TSEL == 7) { if (blockIdx.x == 0 && threadIdx.x == 0) g_tacc += __hip_atomic_load(&g_tw[TVCU], __ATOMIC_RELAXED, __HIP_MEMORY_SCOPE_AGENT); }
                PH_SET(32);
                bf16* Op = (bf16*)(PROJ + (ATTN_MODE == 2 ? C_V : C_Q));
                TP_BEGIN(32, tp32_)
                if (bh < NB * 8 && !(args.flags & 16)) for (int i = 0; i < 4; ++i) attn_unit<8, true>(bh >> 3, bh & 7, QBI(i), Qp, Kp, Vp, Op, KSUM, (char*)lds_raw, (args.flags & 1) == 0, PO, PML);
                TP_END(32, tp32_);
            }
            if (ATTN_MODE == 0) {
                if (bh < NB * 8) for (int i = 0; i < 4; ++i) attn_unit<8, false>(bh >> 3, bh & 7, QBI(i), Qp, Kp, Vp, (bf16*)(PROJ + C_Q), KSUM, (char*)lds_raw, (args.flags & 1) == 0, PO, PML);
            }
#undef QBI
#undef GM_LOAD
        }
        VM_WAIT(); __syncthreads();
    }
    SEAM(3);

    PH_SET(4); TP_BEGIN(4, tp4_) if (IN(4)) {
        pg8::DenseSched S; S.init(PROJ + C_U, PC, WAB, 1024, T, DM, F.G, (int)blockIdx.x); S.ksplit = 8; S.kgap = (unsigned)(C_Q - C_U - 512) * 2u;
        pg8::EpiMergeF E{PROJ, XN};
        phase_skew(F.vcu, SKEW_P45);
        pg8::gemm_phase<pg8::EpiMergeF, pg8::DenseSched, false>(F.lds, S, E);
    }
    TP_END(4, tp4_); SEAM(4);

    PH_SET(5); TP_BEGIN(5, tp5_) if (IN(5)) {
        pg8::DenseSched S; S.init(XN, DM, WOUT, DM, T, DM, F.G, (int)blockIdx.x); pg8::EpiOut E{x, X1, MOD, SSQ};
        phase_skew(F.vcu, SKEW_P45);
        pg8::gemm_phase<pg8::EpiOut, pg8::DenseSched, false>(F.lds, S, E);
    }
    TP_END(5, tp5_); SEAM(5);

    PH_SET(6); TP_BEGIN(6, tp6_) if (IN(6)) { PHASE_IDS();
        {
            LAS float* scr = (LAS float*)(F.lds + F.wave * 16640);
            const int gw = F.vcu * NWAVES + F.wave, NGW = F.G * NWAVES;
            constexpr int I_G = 32 * 16 * 8, I_D = 32 * 8 * 16;
            for (int it = gw; it < 2 * I_G + I_D; it += NGW) { int r = it;
                if (r < 2 * I_G) { const bool up = r >= I_G; if (up) r -= I_G; const int e = r / 128, kb = (r % 128) / 8, nb = r % 8, n0 = 64 * nb;
                    const size_t row_off = (size_t)e * 1024 + (size_t)(n0 / 128) * 256 + (up ? 128 : 0) + (n0 % 128) - n0;
                    transpose_item((up ? w_up : w_gate) + (size_t)e * 1024 * 512, 512, 64 * kb, n0, WGU, row_off, 1024, scr, F.lane); continue; }
                r -= 2 * I_G;
                { const int e = r / 128, kb = (r % 128) / 16, nb = r % 16; transpose_item(w_down + (size_t)e * 512 * 1024, 1024, 64 * kb, 64 * nb, WD, (size_t)e * 1024, 512, scr, F.lane); } }
            __syncthreads();
        }
        const int c = F.vcu, b = c >> 6, lane = F.lane, w = F.wave, r = lane & 15, q = lane >> 4;
        LAS float* A2 = (LAS float*)F.lds; LAS float* B2 = A2 + 1024; LAS float* LG = (LAS float*)(F.lds + 8192) + w * 768;
        LAS unsigned* hist = (LAS unsigned*)(F.lds + 8192 + 8 * 3072); LAS unsigned* basev = hist + 32;
        for (int k = F.tid; k < 1024; k += NWAVES * 64) { A2[k] = norm2_g[k] * (1.0f + MOD[b * 6144 + 4096 + k]); B2[k] = MOD[b * 6144 + 3072 + k]; }
        if (F.tid < 32) hist[F.tid] = 0u;
        __syncthreads();
        const size_t row = (size_t)c * 128 + w * 16 + r;
        float rs;
        { const f32x4* sp = (const f32x4*)(SSQ + row * 16); const f32x4 s0 = sp[0], s1 = sp[1], s2 = sp[2], s3 = sp[3];
          const float ss = ((s0[0] + s0[1]) + (s0[2] + s0[3])) + ((s1[0] + s1[1]) + (s1[2] + s1[3])) + ((s2[0] + s2[1]) + (s2[2] + s2[3])) + ((s3[0] + s3[1]) + (s3[2] + s3[3]));
          rs = 1.0f / sqrtf(ss * (1.0f / DM) + EPS); }
        f32x4 acc[3];
#pragma unroll
        for (int jt = 0; jt < 3; ++jt) acc[jt] = (f32x4){0.f, 0.f, 0.f, 0.f};
        const bf16_t* xrow = X1 + row * DM;
#pragma unroll 2
        for (int s = 0; s < 32; ++s) { const int k0 = 32 * s + 8 * q;
            const u32x4 xr = *(const u32x4*)(xrow + k0);
            const f32x4 x0 = {bflo(xr.x), bfhi(xr.x), bflo(xr.y), bfhi(xr.y)}, x1v = {bflo(xr.z), bfhi(xr.z), bflo(xr.w), bfhi(xr.w)};
            const f32x4 a0 = *(const LAS f32x4*)(A2 + k0), a1 = *(const LAS f32x4*)(A2 + k0 + 4), b0 = *(const LAS f32x4*)(B2 + k0), b1 = *(const LAS f32x4*)(B2 + k0 + 4);
            const f32x4 h0 = x0 * rs * a0 + b0, h1 = x1v * rs * a1 + b1;
            u32x4 hw; hw.x = cvt_pk_bf16(h0[0], h0[1]); hw.y = cvt_pk_bf16(h0[2], h0[3]); hw.z = cvt_pk_bf16(h1[0], h1[1]); hw.w = cvt_pk_bf16(h1[2], h1[3]);
            *(u32x4*)(XN + row * DM + k0) = hw;
            u32x4 lw; lw.x = cvt_pk_bf16(h0[0] - bflo(hw.x), h0[1] - bfhi(hw.x)); lw.y = cvt_pk_bf16(h0[2] - bflo(hw.y), h0[3] - bfhi(hw.y));
            lw.z = cvt_pk_bf16(h1[0] - bflo(hw.z), h1[1] - bfhi(hw.z)); lw.w = cvt_pk_bf16(h1[2] - bflo(hw.w), h1[3] - bfhi(hw.w));
            const bf16x8 hb = __builtin_bit_cast(bf16x8, hw), hl = __builtin_bit_cast(bf16x8, lw);
#pragma unroll
            for (int jt = 0; jt < 3; ++jt) { const bf16x8 wf = *(const bf16x8*)(WRT + (size_t)(16 * jt + r) * 1024 + k0), wl = *(const bf16x8*)(WRT + 48 * 1024 + (size_t)(16 * jt + r) * 1024 + k0);
                acc[jt] = __builtin_amdgcn_mfma_f32_16x16x32_bf16(wf, hb, acc[jt], 0, 0, 0);
                acc[jt] = __builtin_amdgcn_mfma_f32_16x16x32_bf16(wf, hl, acc[jt], 0, 0, 0);
                acc[jt] = __builtin_amdgcn_mfma_f32_16x16x32_bf16(wl, hb, acc[jt], 0, 0, 0); } }
#pragma unroll
        for (int jt = 0; jt < 3; ++jt) *(LAS f32x4*)(LG + r * 48 + 16 * jt + 4 * q) = acc[jt];
        LDS_WAIT(); asm volatile("" ::: "memory");
        int E0 = 0, E1 = 0; float w0 = 0.f, w1 = 0.f; unsigned lp0 = 0u, lp1 = 0u;
        if (lane < 16) {
            const LAS float* lgp = LG + lane * 48;
            float gl[4];
#pragma unroll
            for (int j = 0; j < 4; ++j) gl[j] = lgp[j] + b_rg[j];
            int g = 0; float gm = gl[0];
#pragma unroll
            for (int j = 1; j < 4; ++j) if (gl[j] > gm) { gm = gl[j]; g = j; }
            float gs = 0.f;
#pragma unroll
            for (int j = 0; j < 4; ++j) gs += __expf(gl[j] - gm);
            const float gp = 1.0f / gs;
            float m0 = -INFINITY, m1 = -INFINITY; int i0 = 0, i1 = 0;
#pragma unroll
            for (int j = 0; j < 8; ++j) { const float el = lgp[4 + 8 * g + j] + b_re[g * 8 + j];
                if (el > m0) { m1 = m0; i1 = i0; m0 = el; i0 = j; } else if (el > m1) { m1 = el; i1 = j; } }
            const float d = __expf(m1 - m0), inv = 1.0f / (1.0f + d);
            w0 = gp * inv; w1 = gp * d * inv; E0 = 8 * g + i0; E1 = 8 * g + i1;
            lp0 = __hip_atomic_fetch_add(hist + E0, 1u, __ATOMIC_RELAXED, __HIP_MEMORY_SCOPE_WORKGROUP);
            lp1 = __hip_atomic_fetch_add(hist + E1, 1u, __ATOMIC_RELAXED, __HIP_MEMORY_SCOPE_WORKGROUP);
        }
        __syncthreads();
        if (F.tid < 32) { const unsigned n = hist[F.tid]; basev[F.tid] = n ? __hip_atomic_fetch_add((unsigned*)(F.ctl + CW_CURSOR + 64 * F.tid), n, RLX_AGENT) : 0u; }
        __syncthreads();
        if (lane < 16) { const unsigned tok = (unsigned)(c * 128 + w * 16 + lane);
            ROUTE[(size_t)E0 * 32768 + basev[E0] + lp0] = ((unsigned long long)__float_as_uint(w0) << 32) | (unsigned long long)(2u * tok);
            ROUTE[(size_t)E1 * 32768 + basev[E1] + lp1] = ((unsigned long long)__float_as_uint(w1) << 32) | (unsigned long long)(2u * tok + 1u); }
        __syncthreads();
    }
    TP_END(6, tp6_); SEAM(6);

    PH_SET(7); TP_BEGIN(7, tp7_) if (IN(7) || IN(8)) { PHASE_IDS();
        volatile LAS int* tab = (volatile LAS int*)(F.lds + MISC_OFF + 256);
        if (F.tid < 32) tab[F.tid] = (int)__hip_atomic_load((unsigned*)(F.ctl + CW_CURSOR + 64 * F.tid), RLX_AGENT);
        __syncthreads();
        if (F.tid == 0) { int o = 0; for (int e = 0; e < 32; ++e) { tab[32 + e] = o; o += (tab[e] + 255) >> 8; } tab[64] = o; }
        __syncthreads();
        const int U = 4 * __builtin_amdgcn_readfirstlane(tab[64]);
        const int xq = F.vcu >> 5, jj = F.vcu & 31;
        pg8::MoeSched S; S.tab = tab; S.start = (int)(((long)U * xq) / 8); S.end = (int)(((long)U * (xq + 1)) / 8); S.j = jj; S.route = ROUTE; S.ready = (unsigned*)(F.ctl + CW_READY);
        if (IN(7)) {
            S.A = (const char*)XN; S.lda = DM; S.K = DM; S.Bt = (const char*)WGU; S.bstride = (size_t)1024 * 1024 * 2; S.gather = true; S.mode = 1;
            pg8::EpiGU E{HID};
            pg8::gemm_phase<pg8::EpiGU, pg8::MoeSched, true>(F.lds, S, E);
        }
        TP_END(7, tp7_);
        PH_SET(8); TP_BEGIN(8, tp8_) if (IN(8)) {
            S.A = (const char*)HID; S.lda = DEXP; S.K = DEXP; S.Bt = (const char*)WD; S.bstride = (size_t)1024 * 512 * 2; S.gather = false; S.mode = 2; S.j = (jj + 24) & 31; S.qhead = (unsigned*)(F.ctl + CW_QHEAD + 64 * xq); S.qslot = (volatile LAS int*)(F.lds + MISC_OFF + 640);
            pg8::EpiDown E{YB, ROUTE};
            pg8::gemm_phase<pg8::EpiDown, pg8::MoeSched, false>(F.lds, S, E);
        }
        TP_END(8, tp8_);
    }
    SEAM(8);

    PH_SET(9); TP_BEGIN(9, tp9_) if (IN(9)) { PHASE_IDS();
        const int c = F.vcu, b = c >> 6;
        f32x4 G2[4], FG[4];
#pragma unroll
        for (int j = 0; j < 4; ++j) { const int k = 4 * F.lane + 256 * j; G2[j] = *(const f32x4*)(MOD + b * 6144 + 5120 + k); FG[j] = *(const f32x4*)(final_g + k); }
        for (int i0 = 0; i0 < 16; i0 += 4) {
            u32x2 ya[4][4], yb[4][4], xx[4][4]; f32x4 v[4][4]; float ss[4];
#pragma unroll
            for (int u_ = 0; u_ < 4; ++u_) { const size_t row = (size_t)c * 128 + F.wave * 16 + i0 + u_;
                const u32x2* xb = (const u32x2*)(X1 + row * DM) + F.lane; const u32x2* y0 = (const u32x2*)(YB + (2 * row) * DM) + F.lane; const u32x2* y1 = (const u32x2*)(YB + (2 * row + 1) * DM) + F.lane;
#pragma unroll
                for (int j = 0; j < 4; ++j) { ya[u_][j] = y0[64 * j]; yb[u_][j] = y1[64 * j]; xx[u_][j] = xb[64 * j]; } }
#pragma unroll
            for (int u_ = 0; u_ < 4; ++u_) { float s = 0.f;
#pragma unroll
                for (int j = 0; j < 4; ++j) { const u32x2 a = ya[u_][j], bb = yb[u_][j], x_ = xx[u_][j]; const f32x4 ys = {bflo(a.x) + bflo(bb.x), bfhi(a.x) + bfhi(bb.x), bflo(a.y) + bflo(bb.y), bfhi(a.y) + bfhi(bb.y)};
                    const f32x4 xv = {bflo(x_.x), bfhi(x_.x), bflo(x_.y), bfhi(x_.y)};
                    v[u_][j] = xv + G2[j] * ys; s += (v[u_][j].x * v[u_][j].x + v[u_][j].y * v[u_][j].y) + (v[u_][j].z * v[u_][j].z + v[u_][j].w * v[u_][j].w); }
                ss[u_] = s; }
#pragma unroll
            for (int o_ = 1; o_ < 64; o_ <<= 1) {
#pragma unroll
                for (int u_ = 0; u_ < 4; ++u_) ss[u_] += __shfl_xor(ss[u_], o_); }
#pragma unroll
            for (int u_ = 0; u_ < 4; ++u_) { const size_t row = (size_t)c * 128 + F.wave * 16 + i0 + u_; f32x4* xr = (f32x4*)(out + row * DM) + F.lane;
                const float rstd = 1.0f / sqrtf(ss[u_] * (1.0f / DM) + EPS);
#pragma unroll
                for (int j = 0; j < 4; ++j) xr[64 * j] = v[u_][j] * rstd * FG[j]; } }
    }
    TP_END(9, tp9_);
    if (TSEL != 0 && blockIdx.x == TBLK && threadIdx.x == 0) { const unsigned long long t0 = __builtin_amdgcn_s_memrealtime(), d = g_tacc * TMULT; while (__builtin_amdgcn_s_memrealtime() - t0 < d) __builtin_amdgcn_s_sleep(16); }
#undef IN
#undef SEAM
}


#if ATTN_MODE == 2
__global__ void __launch_bounds__(NWAVES * 64, 2) dbg_dense(Args args, int stage) {
    extern __shared__ __attribute__((aligned(16))) unsigned char lds_raw[];
    using namespace attn_body;
    unsigned char* ws = args.ws; bf16_t* PROJ = (bf16_t*)(ws + WS_PROJ); float* KSUM = (float*)(ws + WS_KSUM); gu32* ctl = (gu32*)(ws + WS_CTL);
    const int G = gridDim.x, bx = blockIdx.x, vcu = (bx % 8) * (G / 8) + bx / 8, tid = threadIdx.x, lane = tid & 63, wave = tid >> 6;
    if (stage == 0) {
        const int s = vcu & 7, bh = vcu >> 3;
        for (int i = 0; i < 4; ++i) { const int qb = (i == 0) ? s : (i == 1) ? 15 - s : (i == 2) ? 16 + s : 31 - s;
            attn_unit<8, false>(bh >> 3, bh & 7, qb, (const bf16*)(PROJ + C_Q), (const bf16*)(PROJ + C_K), (const bf16*)(PROJ + C_VV), (bf16*)(PROJ + C_Q), KSUM, (char*)lds_raw, true, nullptr, nullptr); }
    } else {
        float md = 0.f;
        for (int i = 0; i < 16; ++i) { const size_t row = (size_t)vcu * 128 + wave * 16 + i;
            const u32x4 a = *(const u32x4*)(PROJ + row * PC + C_V + 8 * lane), bq = *(const u32x4*)(PROJ + row * PC + C_Q + 8 * lane);
            md = fmaxf(md, fmaxf(fmaxf(fabsf(bflo(a.x) - bflo(bq.x)), fabsf(bfhi(a.x) - bfhi(bq.x))), fmaxf(fabsf(bflo(a.y) - bflo(bq.y)), fabsf(bfhi(a.y) - bfhi(bq.y)))));
            md = fmaxf(md, fmaxf(fmaxf(fabsf(bflo(a.z) - bflo(bq.z)), fabsf(bfhi(a.z) - bfhi(bq.z))), fmaxf(fabsf(bflo(a.w) - bflo(bq.w)), fabsf(bfhi(a.w) - bfhi(bq.w))))); }
#pragma unroll
        for (int o_ = 1; o_ < 64; o_ <<= 1) md = fmaxf(md, __shfl_xor(md, o_));
        if (lane == 0) atomicMax((unsigned*)(ctl + CW_DIFF), __float_as_uint(md));
    }
}
#endif
extern "C" void kernel_launch(void* const* d_in, const int* in_sizes, int n_in, void* d_out, int out_size, void* d_ws, size_t ws_size, hipStream_t stream) {
    static int grid = 0;
    if (grid == 0) {
        if (n_in != 22 || in_sizes[0] != T * DM || out_size != T * DM || ws_size < WS_END) { fprintf(stderr, "kernel_launch: unexpected shapes (n_in %d, in0 %d, out %d, ws %zu); nothing launched\n", n_in, n_in > 0 ? in_sizes[0] : -1, out_size, ws_size); grid = -1; return; }
        int dev = 0, cus = 0, per_cu = 0;
        if (hipGetDevice(&dev) != hipSuccess || hipDeviceGetAttribute(&cus, hipDeviceAttributeMultiprocessorCount, dev) != hipSuccess) { fprintf(stderr, "kernel_launch: device query failed\n"); grid = -1; return; }
        if (hipFuncSetAttribute((const void*)hybrid_fwd, hipFuncAttributeMaxDynamicSharedMemorySize, LDS_BYTES) != hipSuccess) { fprintf(stderr, "kernel_launch: hipFuncSetAttribute failed\n"); grid = -1; return; }
        if (hipOccupancyMaxActiveBlocksPerMultiprocessor(&per_cu, (const void*)hybrid_fwd, NWAVES * 64, LDS_BYTES) != hipSuccess || per_cu < 1) { fprintf(stderr, "kernel_launch: occupancy query reports %d blocks per CU\n", per_cu); }
        (void)hipGetLastError();
        if (cus != 256) { fprintf(stderr, "kernel_launch: built for 256 CUs, device has %d; nothing launched\n", cus); grid = -1; return; }
        grid = cus;
    }
    if (grid < 0) return;
    (void)hipMemsetAsync((char*)d_ws + WS_CTL, 0, CTL_ZERO_BYTES, stream);
    Args a{};
    for (int i = 0; i < 22; ++i) a.in[i] = (const float*)d_in[i];
    a.out = (float*)d_out; a.ws = (unsigned char*)d_ws;
    struct Spec { int lo, hi, flags; };
#if MK_PER_PHASE
    const Spec specs[10] = {{0,1,0},{1,2,0},{2,3,0},{3,4,0},{4,5,0},{5,6,0},{6,7,0},{7,8,0},{8,9,0},{9,10,0}}; const int nspec = 10;
#elif PROBE_ID == 1
    const Spec specs[2] = {{0,10,0},{0,2,0}}; const int nspec = 2;
#elif PROBE_ID == 2
    const Spec specs[2] = {{0,10,0},{2,3,0}}; const int nspec = 2;
#elif PROBE_ID == 3
    const Spec specs[3] = {{0,4,0},{3,4,1|2|4|16},{4,10,0}}; const int nspec = 3;
#elif PROBE_ID == 10
    const Spec specs[3] = {{0,4,0},{3,4,1|2|4|8},{4,10,0}}; const int nspec = 3;
#elif PROBE_ID == 11
    const Spec specs[3] = {{0,4,0},{3,4,1|2|8|16},{4,10,0}}; const int nspec = 3;
#elif PROBE_ID == 12
    const Spec specs[3] = {{0,4,0},{3,4,1|2|4|8|16},{4,10,0}}; const int nspec = 3;
#elif PROBE_ID == 13
    const Spec specs[2] = {{0,10,0},{3,4,1|4|8|16}}; const int nspec = 2;
#elif PROBE_ID == 4
    const Spec specs[3] = {{0,4,0},{4,5,0},{4,10,0}}; const int nspec = 3;
#elif PROBE_ID == 5
    const Spec specs[3] = {{0,5,0},{5,6,0},{5,10,0}}; const int nspec = 3;
#elif PROBE_ID == 6
    const Spec specs[2] = {{0,10,0},{7,8,0}}; const int nspec = 2;
#elif PROBE_ID == 7
    const Spec specs[2] = {{0,10,0},{8,9,0}}; const int nspec = 2;
#elif PROBE_ID == 14
    const Spec specs[2] = {{0,10,0},{7,9,0}}; const int nspec = 2;
#elif PROBE_ID == 15
    const Spec specs[2] = {{0,10,0},{9,10,0}}; const int nspec = 2;
#elif PROBE_ID == 16
    const Spec specs[2] = {{0,10,0},{6,7,0}}; const int nspec = 2;
#elif PROBE_ID == 8
    const Spec specs[2] = {{0,5,0},{5,10,0}}; const int nspec = 2;
#elif PROBE_ID == 9
    const Spec specs[2] = {{0,10,0},{0,1,0}}; const int nspec = 2;
#else
    const Spec specs[1] = {{0,10,0}}; const int nspec = 1;
#endif
#if ATTN_MODE == 2
    (void)hipFuncSetAttribute((const void*)dbg_dense, hipFuncAttributeMaxDynamicSharedMemorySize, LDS_BYTES);
    a.ph_lo = 0; a.ph_hi = 4; a.flags = 0; a.li = 0; hipLaunchKernelGGL(hybrid_fwd, dim3(grid), dim3(NWAVES * 64), LDS_BYTES, stream, a);
    hipLaunchKernelGGL(dbg_dense, dim3(grid), dim3(NWAVES * 64), LDS_BYTES, stream, a, 0);
    hipLaunchKernelGGL(dbg_dense, dim3(grid), dim3(NWAVES * 64), LDS_BYTES, stream, a, 1);
    a.ph_lo = 4; a.ph_hi = 10; a.li = 1; hipLaunchKernelGGL(hybrid_fwd, dim3(grid), dim3(NWAVES * 64), LDS_BYTES, stream, a);
    (void)nspec; (void)specs;
#else
    for (int li = 0; li < nspec; ++li) { a.ph_lo = specs[li].lo; a.ph_hi = specs[li].hi; a.flags = specs[li].flags; a.li = MK_PER_PHASE ? 0 : li;
        hipLaunchKernelGGL(hybrid_fwd, dim3(grid), dim3(NWAVES * 64), LDS_BYTES, stream, a); }
#endif
    const hipError_t le = hipPeekAtLastError();
    if (le != hipSuccess) fprintf(stderr, "kernel_launch: launch failed: %s\n", hipGetErrorName(le));
}
```

```cpp
#include <hip/hip_runtime.h>
#include <hip/hip_bf16.h>
#include <cstdio>
#include <cstdint>
#include <cmath>

#ifndef PROBE_ID
#define PROBE_ID 0
#endif
#ifndef ATTN_MODE
#define ATTN_MODE 1
#endif
#ifndef GPROBE
#define GPROBE 0
#endif
#ifndef TSEL
#define TSEL 0
#endif
#ifndef TPH
#define TPH -1
#endif
#ifndef TBLK
#define TBLK 0
#endif
#ifndef TVCU
#define TVCU 255
#endif
#define TMULT 8
__device__ unsigned long long g_tacc; __device__ int g_tphase; __device__ unsigned g_tw[256];
#define T_ON(k) (TSEL == (k) && blockIdx.x == TBLK && threadIdx.x == 0 && (TPH < 0 || g_tphase == TPH))
#define T_BEGIN(k, var) unsigned long long var = 0; if (TSEL == (k)) { if (T_ON(k)) var = __builtin_amdgcn_s_memrealtime(); }
#define T_END(k, var) do { if (TSEL == (k)) { if (T_ON(k)) g_tacc += __builtin_amdgcn_s_memrealtime() - var; } } while (0)
#define TP_BEGIN(ph, var) unsigned long long var = 0; if (TSEL == 4 && TPH == (ph)) { if (blockIdx.x == TBLK && threadIdx.x == 0) var = __builtin_amdgcn_s_memrealtime(); } \
        if (TSEL >= 10 && TSEL <= 12 && TPH == (ph)) { if (threadIdx.x == 0) var = __builtin_amdgcn_s_memrealtime(); }
#define TP_END(ph, var) do { if (TSEL == 4 && TPH == (ph)) { if (blockIdx.x == TBLK && threadIdx.x == 0) g_tacc += __builtin_amdgcn_s_memrealtime() - var; } \
        if (TSEL >= 10 && TSEL <= 12 && TPH == (ph)) { if (threadIdx.x == 0) __hip_atomic_store(&g_tw[(blockIdx.x % 8) * 32 + blockIdx.x / 8], (unsigned)(__builtin_amdgcn_s_memrealtime() - var), __ATOMIC_RELAXED, __HIP_MEMORY_SCOPE_AGENT); } } while (0)
#ifndef MK_PER_PHASE
#define MK_PER_PHASE 0
#endif

#define LAS __attribute__((address_space(3)))
#define GAS __attribute__((address_space(1)))
typedef unsigned short bf16_t;
typedef short bf16x8 __attribute__((ext_vector_type(8)));
typedef short s16x4 __attribute__((ext_vector_type(4)));
typedef float f32x2 __attribute__((ext_vector_type(2)));
typedef float f32x4 __attribute__((ext_vector_type(4)));
typedef float f32x16 __attribute__((ext_vector_type(16)));
typedef unsigned u32x2 __attribute__((ext_vector_type(2)));
typedef unsigned u32x4 __attribute__((ext_vector_type(4)));
typedef GAS unsigned gu32;

constexpr int NB = 4, SEQ = 8192, DM = 1024, T = NB * SEQ;
constexpr int PC = 4608;
constexpr int C_U = 0, C_V = 512, C_Q = 1024, C_K = 1536, C_VV = 2048, C_GA = 2560, C_GB = 3584;
constexpr int NEXP = 32, DEXP = 512;
constexpr float EPS = 1e-6f;
constexpr float QSCALE = 0.125f * 1.4426950408889634f;

constexpr size_t MiB = 1u << 20;
constexpr size_t WS_CTL = 0, CTL_ZERO_BYTES = 2 * MiB;
constexpr size_t WS_KSUM = 1 * MiB;
constexpr size_t WS_MODP = 2 * MiB;
constexpr size_t WS_MOD = 3 * MiB + 512 * 1024;
constexpr size_t WS_ROPE = 4 * MiB;
constexpr size_t WS_WST = 4 * MiB + 512 * 1024;
constexpr size_t WS_WRT = 4 * MiB + 768 * 1024;
constexpr size_t WS_SSQ = 5 * MiB;
constexpr size_t WS_ROUTE = 8 * MiB;
constexpr size_t WS_WIN = 24 * MiB;
constexpr size_t WS_WAB = 34 * MiB, WS_WOUT = 36 * MiB;
constexpr size_t WS_WGU = 40 * MiB;
constexpr size_t WS_WD = 104 * MiB;
constexpr size_t WS_XN = 136 * MiB;
constexpr size_t WS_PROJ = 200 * MiB;
constexpr size_t WS_HID = 200 * MiB;
constexpr size_t WS_Y = 272 * MiB;
constexpr size_t WS_X1 = 400 * MiB;
constexpr size_t WS_PO = 40 * MiB;
constexpr size_t WS_PML = 136 * MiB;
constexpr size_t WS_LIST = 488 * MiB;
constexpr size_t WS_END = 504 * MiB;
constexpr int CW_TMO = 0, CW_DIFF = 2, CW_BAR = 4096, CW_CURSOR = 32768, CW_CNT = 65536, CW_READY = 131072, CW_QHEAD = 160000, CW_GQ = 161024;

constexpr int RING_BYTES = 131072;
constexpr int LDS_BYTES = 147456;
constexpr int MISC_OFF = LDS_BYTES - 1024;
constexpr int NWAVES = 8;

#define LDS_WAIT() asm volatile("s_waitcnt lgkmcnt(0)" ::: "memory")
#define VM_WAIT() asm volatile("s_waitcnt vmcnt(0)" ::: "memory")
#define RLX_AGENT __ATOMIC_RELAXED, __HIP_MEMORY_SCOPE_AGENT

__device__ __forceinline__ unsigned cvt_pk_bf16(float lo, float hi) { unsigned r; asm volatile("v_cvt_pk_bf16_f32 %0, %1, %2" : "=v"(r) : "v"(lo), "v"(hi)); return r; }
__device__ __forceinline__ float bflo(unsigned u) { return __uint_as_float(u << 16); }
__device__ __forceinline__ float bfhi(unsigned u) { return __uint_as_float(u & 0xffff0000u); }
__device__ __forceinline__ float sigmoidf_(float x) { return __builtin_amdgcn_rcpf(1.0f + __builtin_amdgcn_exp2f(-1.4426950408889634f * x)); }
__device__ __forceinline__ float gelu_tanh(float x) { const float u = x + 0.044715f * x * x * x; return x * __builtin_amdgcn_rcpf(1.0f + __builtin_amdgcn_exp2f(-2.3022081985f * u)); }
__device__ __forceinline__ float wave_sum(float v) {
#pragma unroll
    for (int o = 1; o < 64; o <<= 1) v += __shfl_xor(v, o);
    return v;
}

namespace pg8 {
constexpr int BM = 256, BK = 64, HALF = 128, HTB = HALF * BK * 2, STAGE_BYTES = 8 * HTB, NXCD = 8, WGM = 8;
__host__ __device__ __forceinline__ int lds_byte(int r, int c) { const int st = (r >> 4) * 2 + (c >> 5), rr = r & 15, cc = c & 31, ob = rr * 64 + cc * 2; return st * 1024 + (ob ^ (((ob >> 9) & 1) << 5)); }
__host__ __device__ __forceinline__ void stage_rc(int b, int& R, int& C) { const int st = b / 1024, sb = b % 1024, swz = sb ^ (((sb >> 9) & 1) << 5); R = (st >> 1) * 16 + swz / 64; C = (st & 1) * 32 + (swz % 64) / 2; }
__host__ __device__ __forceinline__ int perm32(int rho) { const int n = rho >> 4, i = rho & 15; return 8 * (i >> 2) + 4 * n + (i & 3); }

struct Unit { int pm, pn, e, lt, nvalid; };

struct DenseSched {
    const char* A; const char* Bt; int lda, K; int nM, nN, nwg, G, c; int ksplit; unsigned kgap;
    __device__ void init(const void* A_, int lda_, const void* Bt_, int K_, int M, int N, int G_, int c_) { A = (const char*)A_; Bt = (const char*)Bt_; lda = lda_; K = K_; nM = M / BM; nN = N / BM; nwg = nM * nN; G = G_; c = c_; ksplit = 1 << 20; kgap = 0u; }
    __device__ __forceinline__ bool next(int i, Unit& u) const {
        const long L = (long)i * G + c; if (L >= nwg) return false;
        int wgid = (int)L; { const int q = nwg / NXCD, r = nwg % NXCD, xcd = wgid % NXCD, off = wgid / NXCD; wgid = (xcd < r ? xcd * (q + 1) : r * (q + 1) + (xcd - r) * q) + off; }
        const int nig = WGM * nN, gid = wgid / nig, fm = gid * WGM, gsz = (nM - fm) < WGM ? (nM - fm) : WGM;
        u.pm = fm + ((wgid % nig) % gsz); u.pn = (wgid % nig) / gsz; u.e = 0; u.lt = 0; u.nvalid = 256; return true;
    }
    __device__ __forceinline__ const char* a_base(const Unit& u) const { return A + (size_t)u.pm * BM * lda * 2; }
    __device__ __forceinline__ const char* b_base(const Unit& u) const { return Bt + (size_t)u.pn * BM * K * 2; }
    __device__ __forceinline__ unsigned gather_off(const Unit&, int, int) const { return 0u; }
    __device__ __forceinline__ void a_ready(const Unit&) const {}
    __device__ __forceinline__ void done(const Unit&) const {}
};
struct MoeSched {
    const char* A; const char* Bt; int lda, K; size_t bstride;
    const unsigned long long* route; bool gather;
    const volatile LAS int* tab;
    int start, end, j; static constexpr int ksplit = 1 << 20; static constexpr unsigned kgap = 0u;
    unsigned* ready; int mode;
    __device__ __forceinline__ void done(const Unit& u) const {
        if (mode == 1) { asm volatile("s_waitcnt vmcnt(0)" ::: "memory");
            if ((threadIdx.x & 63) == 0) __hip_atomic_fetch_add(ready + 64 * u.pm, 1u, __ATOMIC_RELAXED, __HIP_MEMORY_SCOPE_AGENT); } }
    __device__ __forceinline__ void a_ready(const Unit& u) const {
        if (mode == 2) {
            if (threadIdx.x < 64) { unsigned sp = 0;
                while ((unsigned)__builtin_amdgcn_readfirstlane(__hip_atomic_load(ready + 64 * u.pm, __ATOMIC_RELAXED, __HIP_MEMORY_SCOPE_AGENT)) < 32u) { __builtin_amdgcn_s_sleep(2); if (++sp > (1u << 22)) break; }
                __builtin_amdgcn_fence(__ATOMIC_ACQUIRE, "agent");
                asm volatile("s_waitcnt vmcnt(0)" ::: "memory"); }
            asm volatile("" ::: "memory"); __builtin_amdgcn_s_barrier(); asm volatile("" ::: "memory"); } }
    unsigned* qhead; volatile LAS int* qslot;
    __device__ __forceinline__ bool next(int i, Unit& u) const {
        int idx;
        if (mode == 2) {
            if (threadIdx.x == 0) qslot[i & 1] = start + (int)__hip_atomic_fetch_add(qhead, 1u, __ATOMIC_RELAXED, __HIP_MEMORY_SCOPE_AGENT);
            asm volatile("s_waitcnt vmcnt(0) lgkmcnt(0)" ::: "memory"); __builtin_amdgcn_s_barrier(); asm volatile("" ::: "memory");
            idx = __builtin_amdgcn_readfirstlane(qslot[i & 1]);
        } else idx = start + i * 32 + j;
        if (idx >= end) return false;
        const int tile = idx >> 2; u.pn = idx & 3; u.pm = tile;
        int e = 0;
        for (int k = 1; k < 32; ++k) e += (__builtin_amdgcn_readfirstlane(tab[32 + k]) <= tile) ? 1 : 0;
        u.e = e; u.lt = tile - __builtin_amdgcn_readfirstlane(tab[32 + e]);
        const int rem = __builtin_amdgcn_readfirstlane(tab[e]) - 256 * u.lt; u.nvalid = rem < 256 ? rem : 256; return true;
    }
    __device__ __forceinline__ const char* a_base(const Unit& u) const { return gather ? A : A + (size_t)u.pm * BM * lda * 2; }
    __device__ __forceinline__ const char* b_base(const Unit& u) const { return Bt + (size_t)u.e * bstride + (size_t)u.pn * BM * K * 2; }
    __device__ __forceinline__ unsigned gather_off(const Unit& u, int r, int C) const {
        unsigned tok = 0u;
        if (r < u.nvalid) tok = (unsigned)(route[(size_t)u.e * 32768 + (size_t)u.lt * 256 + r] & 0xffffffffull) >> 1;
        return (tok * (unsigned)lda + (unsigned)C) * 2u;
    }
};

template <class Epi, class Sched, bool GATHER>
__device__ __forceinline__ void gemm_phase(LAS unsigned char* lds, const Sched& S, const Epi& E) {
    const int tid = threadIdx.x, wid = __builtin_amdgcn_readfirstlane(tid >> 6), lane = tid & 63, wr = wid >> 2, wc = wid & 3, fr = lane & 15, fq = lane >> 4;
    const int K = S.K, lda = S.lda, nt = K / BK;
    unsigned voffA[2], voffB[2]; int RA[2], CA[2];
#pragma unroll
    for (int i = 0; i < 2; ++i) { int R, C; stage_rc(tid * 16 + i * 8192, R, C); const int Rb = Epi::PERM ? ((R & ~31) + perm32(R & 31)) : R;
        RA[i] = R; CA[i] = C; voffA[i] = (unsigned)(R * lda + C) * 2u; voffB[i] = (unsigned)(Rb * K + C) * 2u; }
    const size_t kstep = (size_t)(BK * 2);
    const unsigned hstepA = (unsigned)HALF * (unsigned)lda * 2u;
    const size_t hstepB = (size_t)HALF * K * 2;
    const unsigned ldsw = (unsigned)wid * 1024u;
    const int aoff = lds_byte(wr * 64 + fr, fq * 8), boff = lds_byte(wc * 32 + fr, fq * 8);
    unsigned og[2][2] = {{0u, 0u}, {0u, 0u}}, ogn[2][2] = {{0u, 0u}, {0u, 0u}};
#define PG8_SA(b, h) (((b) * 2 + (h)) * HTB)
#define PG8_SB(b, h) ((4 + (b) * 2 + (h)) * HTB)
#define PG8_STAGE_B(bufoff, gbase) do { _Pragma("unroll") for (int _i = 0; _i < 2; ++_i) \
        __builtin_amdgcn_global_load_lds((const unsigned*)((const char*)(gbase) + voffB[_i]), (LAS unsigned*)(lds + (bufoff) + ldsw + _i * 8192), 16, 0, 0); } while (0)
#define PG8_STAGE_A(bufoff, gbase, h) do { _Pragma("unroll") for (int _i = 0; _i < 2; ++_i) \
        __builtin_amdgcn_global_load_lds((const unsigned*)((const char*)(gbase) + (GATHER ? og[h][_i] : voffA[_i] + (h) * hstepA)), (LAS unsigned*)(lds + (bufoff) + ldsw + _i * 8192), 16, 0, 0); } while (0)
#define PG8_LDA(dst, b, h) do { _Pragma("unroll") for (int m = 0; m < 4; ++m) _Pragma("unroll") for (int k = 0; k < 2; ++k) dst[m][k] = *(const LAS bf16x8*)(lds + PG8_SA(b, h) + aoff + m * 2048 + k * 1024); } while (0)
#define PG8_LDB(dst, b, h) do { _Pragma("unroll") for (int n = 0; n < 2; ++n) _Pragma("unroll") for (int k = 0; k < 2; ++k) dst[n][k] = *(const LAS bf16x8*)(lds + PG8_SB(b, h) + boff + n * 2048 + k * 1024); } while (0)
#define PG8_MMA(ai, bj, At, Bt) do { __builtin_amdgcn_s_setprio(1); _Pragma("unroll") for (int m = 0; m < 4; ++m) _Pragma("unroll") for (int n = 0; n < 2; ++n) _Pragma("unroll") for (int k = 0; k < 2; ++k) \
        acc[ai][bj][m][n] = __builtin_amdgcn_mfma_f32_16x16x32_bf16(Bt[n][k], At[m][k], acc[ai][bj][m][n], 0, 0, 0); __builtin_amdgcn_s_setprio(0); } while (0)
#define PG8_WAIT_V(n) asm volatile("s_waitcnt vmcnt(" #n ")" ::: "memory")
#define PG8_WAIT_L(n) asm volatile("s_waitcnt lgkmcnt(" #n ")" ::: "memory")
#define PG8_BAR __builtin_amdgcn_s_barrier()
#define PG8_SCHED __builtin_amdgcn_sched_barrier(0)
    Unit cur, nxt; int ui = 0;
    if (!S.next(0, cur)) return;
    f32x4 acc[2][2][4][2];
#pragma unroll
    for (int a = 0; a < 2; ++a)
#pragma unroll
        for (int b = 0; b < 2; ++b)
#pragma unroll
            for (int m = 0; m < 4; ++m)
#pragma unroll
                for (int n = 0; n < 2; ++n) acc[a][b][m][n] = (f32x4){0.f, 0.f, 0.f, 0.f};
    bf16x8 At[4][2], B0[2][2], B1[2][2];
    const char* cA = S.a_base(cur); const char* cB = S.b_base(cur);
    S.a_ready(cur);
    if constexpr (GATHER) {
#pragma unroll
        for (int h = 0; h < 2; ++h)
#pragma unroll
            for (int i = 0; i < 2; ++i) og[h][i] = S.gather_off(cur, h * HALF + RA[i], CA[i]);
    }
    PG8_STAGE_B(PG8_SB(0, 0), cB); PG8_STAGE_B(PG8_SB(0, 1), cB + hstepB); PG8_STAGE_A(PG8_SA(0, 0), cA, 0); PG8_STAGE_A(PG8_SA(0, 1), cA, 1);
    if (wr == 1) PG8_BAR;
    PG8_WAIT_V(2); PG8_BAR;
    PG8_STAGE_B(PG8_SB(1, 0), cB + kstep); PG8_STAGE_A(PG8_SA(1, 0), cA + kstep, 0); PG8_STAGE_B(PG8_SB(1, 1), cB + hstepB + kstep);
    PG8_WAIT_V(6); PG8_BAR;
    unsigned long long t3_ = 0;
    for (;;) {
        const bool has_next = S.next(ui + 1, nxt);
        const char* nA = has_next ? S.a_base(nxt) : cA; const char* nB = has_next ? S.b_base(nxt) : cB;
        if constexpr (GATHER) {
            if (has_next) {
#pragma unroll
                for (int h = 0; h < 2; ++h)
#pragma unroll
                    for (int i = 0; i < 2; ++i) ogn[h][i] = S.gather_off(nxt, h * HALF + RA[i], CA[i]);
            }
        }
        for (int t = 0; t < nt; t += 2) {
            const bool last = (t == nt - 2);
            const char* a1 = cA + (size_t)(t + 1) * kstep + ((t + 1) >= S.ksplit ? S.kgap : 0u);
            const char* a2 = last ? nA : cA + (size_t)(t + 2) * kstep + ((t + 2) >= S.ksplit ? S.kgap : 0u); const char* b2 = last ? nB : cB + (size_t)(t + 2) * kstep;
            const char* a3 = last ? nA + kstep : cA + (size_t)(t + 3) * kstep + ((t + 3) >= S.ksplit ? S.kgap : 0u); const char* b3 = b2 + kstep;
            if (last && has_next) S.a_ready(nxt);
            if constexpr (Epi::HAS_MID) { if (t == S.ksplit) E.mid(acc, cur, wr, wc, fr, fq); }
            PG8_LDB(B0, 0, 0); PG8_LDB(B1, 0, 1); PG8_SCHED; PG8_LDA(At, 0, 0); PG8_STAGE_A(PG8_SA(1, 1), a1, 1);
            if constexpr (GATHER) { if (last && has_next) {
#pragma unroll
                for (int h = 0; h < 2; ++h)
#pragma unroll
                    for (int i = 0; i < 2; ++i) og[h][i] = ogn[h][i]; } }
            PG8_WAIT_V(8); PG8_WAIT_L(0); PG8_BAR;
            if (TSEL == 3) { if (t == 0 && t3_ != 0 && T_ON(3)) { g_tacc += __builtin_amdgcn_s_memrealtime() - t3_; t3_ = 0; } }
            PG8_MMA(0, 0, At, B0); PG8_MMA(0, 1, At, B1); PG8_BAR; PG8_SCHED;
            PG8_LDA(At, 0, 1); PG8_STAGE_B(PG8_SB(0, 0), b2); PG8_STAGE_B(PG8_SB(0, 1), b2 + hstepB); PG8_STAGE_A(PG8_SA(0, 0), a2, 0);
            PG8_WAIT_V(8); PG8_WAIT_L(0); PG8_BAR; PG8_MMA(1, 0, At, B0); PG8_MMA(1, 1, At, B1); PG8_BAR; PG8_SCHED;
            PG8_LDB(B0, 1, 0); PG8_LDB(B1, 1, 1); PG8_SCHED; PG8_LDA(At, 1, 0); PG8_STAGE_A(PG8_SA(0, 1), a2, 1);
            PG8_WAIT_V(8); PG8_WAIT_L(0); PG8_BAR; PG8_MMA(0, 0, At, B0); PG8_MMA(0, 1, At, B1); PG8_BAR; PG8_SCHED;
            PG8_LDA(At, 1, 1); PG8_STAGE_B(PG8_SB(1, 0), b3); PG8_STAGE_B(PG8_SB(1, 1), b3 + hstepB); PG8_STAGE_A(PG8_SA(1, 0), a3, 0);
            PG8_WAIT_V(8); PG8_WAIT_L(0); PG8_BAR; PG8_MMA(1, 0, At, B0); PG8_MMA(1, 1, At, B1); PG8_BAR; PG8_SCHED;
        }
        if (wr == 0) PG8_BAR;
        { T_BEGIN(2, t2_) E(acc, cur, wr, wc, fr, fq); S.done(cur); T_END(2, t2_); }
        if (!has_next) break;
        if (TSEL == 3 && T_ON(3)) t3_ = __builtin_amdgcn_s_memrealtime();
#pragma unroll
        for (int a = 0; a < 2; ++a)
#pragma unroll
            for (int b = 0; b < 2; ++b)
#pragma unroll
                for (int m = 0; m < 4; ++m)
#pragma unroll
                    for (int n = 0; n < 2; ++n) acc[a][b][m][n] = (f32x4){0.f, 0.f, 0.f, 0.f};
        cur = nxt; cA = nA; cB = nB; ++ui;
        if (wr == 1) PG8_BAR;
    }
    PG8_WAIT_V(0);
    PG8_BAR;
#undef PG8_SA
#undef PG8_SB
#undef PG8_STAGE_A
#undef PG8_STAGE_B
#undef PG8_LDA
#undef PG8_LDB
#undef PG8_MMA
#undef PG8_WAIT_V
#undef PG8_WAIT_L
#undef PG8_BAR
#undef PG8_SCHED
}

struct EpiProj {
    static constexpr bool PERM = true; static constexpr bool HAS_MID = false;
    bf16_t* P; const float* rope; float* ksum;
    __device__ __forceinline__ void operator()(const f32x4 (&acc)[2][2][4][2], const Unit& u, int wr, int wc, int fr_in, int fq) const {
        int fr = fr_in; asm volatile("" : "+v"(fr));
        const int pn = u.pn, row0 = u.pm * BM + wr * 64 + fr, cl = wc * 32 + 8 * fq;
        const int mode = pn < 4 ? 0 : pn < 6 ? 1 : pn < 8 ? 2 : pn < 10 ? 3 : 4;
        const bool rot = (mode == 1 || mode == 2) && ((wc & 1) == 0);
        float ks[2][8];
#pragma unroll
        for (int bj = 0; bj < 2; ++bj)
#pragma unroll
            for (int j = 0; j < 8; ++j) ks[bj][j] = 0.f;
        f32x4 rq[3][4];
#define RP_LOAD(gi, slot) do { if (rot) { const int pos_ = (row0 + ((gi) >> 2) * HALF + ((gi) & 3) * 16) & (SEQ - 1); \
            rq[slot][0] = *(const f32x4*)(rope + pos_ * 8); rq[slot][1] = *(const f32x4*)(rope + pos_ * 8 + 4); rq[slot][2] = *(const f32x4*)(rope + 65536 + pos_ * 8); rq[slot][3] = *(const f32x4*)(rope + 65536 + pos_ * 8 + 4); } } while (0)
        RP_LOAD(0, 0); RP_LOAD(1, 1);
#pragma unroll
        for (int ai = 0; ai < 2; ++ai)
#pragma unroll
            for (int m = 0; m < 4; ++m) {
                const int gi_ = ai * 4 + m;
                if (gi_ + 2 < 8) RP_LOAD(gi_ + 2, (gi_ + 2) % 3);
                const int row = row0 + ai * HALF + m * 16;
                float cs[8], sn[8];
                if (rot) {
#pragma unroll
                    for (int j = 0; j < 4; ++j) { cs[j] = rq[gi_ % 3][0][j]; cs[4 + j] = rq[gi_ % 3][1][j]; sn[j] = rq[gi_ % 3][2][j]; sn[4 + j] = rq[gi_ % 3][3][j]; } }
#pragma unroll
                for (int bj = 0; bj < 2; ++bj) {
                    float v[8];
#pragma unroll
                    for (int j = 0; j < 4; ++j) { v[j] = acc[ai][bj][m][0][j]; v[4 + j] = acc[ai][bj][m][1][j]; }
                    if (mode == 1 || mode == 2) {
                        if (rot) {
                            const float sg = (fq == 0) ? -1.f : 1.f; const bool ap = fq < 2;
#pragma unroll
                            for (int j = 0; j < 8; ++j) {
                                const auto sw = __builtin_amdgcn_permlane16_swap(__float_as_uint(v[j]), __float_as_uint(v[j]), false, false);
                                const float o = __uint_as_float((fq & 1) ? sw[0] : sw[1]); const float r = v[j] * cs[j] + sg * o * sn[j]; v[j] = ap ? r : v[j]; }
                        }
                        if (mode == 1) {
#pragma unroll
                            for (int j = 0; j < 8; ++j) v[j] *= QSCALE;
                        } else {
#pragma unroll
                            for (int j = 0; j < 8; ++j) ks[bj][j] += v[j];
                        }
                    }
                    u32x4 w; w.x = cvt_pk_bf16(v[0], v[1]); w.y = cvt_pk_bf16(v[2], v[3]); w.z = cvt_pk_bf16(v[4], v[5]); w.w = cvt_pk_bf16(v[6], v[7]);
                    *(u32x4*)(P + (size_t)row * PC + pn * BM + bj * HALF + cl) = w;
                }
            }
#undef RP_LOAD
        if (mode == 2) {
#pragma unroll
            for (int bj = 0; bj < 2; ++bj)
#pragma unroll
                for (int j = 0; j < 8; ++j) { float s = ks[bj][j]; s += __shfl_xor(s, 1); s += __shfl_xor(s, 2); s += __shfl_xor(s, 4); s += __shfl_xor(s, 8); ks[bj][j] = s; }
            if (fr == 0) {
                const int b = u.pm >> 5, kb = u.pm & 31;
#pragma unroll
                for (int bj = 0; bj < 2; ++bj) { const int ck = (pn - 6) * BM + bj * HALF + cl; const int h = ck >> 6, d = ck & 63;
                    float* dst = ksum + ((size_t)((b * 8 + h) * 32 + kb)) * 64 + d;
#pragma unroll
                    for (int j = 0; j < 8; ++j) atomicAdd(dst + j, ks[bj][j]); }
            }
        }
    }
};
struct EpiMergeF {
    static constexpr bool PERM = true; static constexpr bool HAS_MID = true;
    const bf16_t* P; bf16_t* MG;
    __device__ __forceinline__ void mid(f32x4 (&acc)[2][2][4][2], const Unit& u, int wr, int wc, int fr_in, int fq) const {
        int fr = fr_in; asm volatile("" : "+v"(fr));
        const int row0 = u.pm * BM + wr * 64 + fr, col0 = u.pn * BM + wc * 32 + 8 * fq;
#pragma unroll
        for (int g4 = 0; g4 < 8; g4 += 4) {
            u32x4 ga[4][2], gb[4][2];
#pragma unroll
            for (int k = 0; k < 4; ++k) { const int gi = g4 + k, row = row0 + (gi >> 2) * HALF + (gi & 3) * 16;
#pragma unroll
                for (int bj = 0; bj < 2; ++bj) { ga[k][bj] = *(const u32x4*)(P + (size_t)row * PC + C_GA + col0 + bj * HALF); gb[k][bj] = *(const u32x4*)(P + (size_t)row * PC + C_GB + col0 + bj * HALF); } }
#pragma unroll
            for (int k = 0; k < 4; ++k) { const int gi = g4 + k, ai = gi >> 2, m = gi & 3;
#pragma unroll
                for (int bj = 0; bj < 2; ++bj) {
#define RHO(a_, b_) ((1.0f + __builtin_amdgcn_exp2f(-1.4426950408889634f * fmaxf(b_, -60.f))) * sigmoidf_(a_))
                    const u32x4 A_ = ga[k][bj], B_ = gb[k][bj];
                    acc[ai][bj][m][0][0] *= RHO(bflo(A_.x), bflo(B_.x)); acc[ai][bj][m][0][1] *= RHO(bfhi(A_.x), bfhi(B_.x)); acc[ai][bj][m][0][2] *= RHO(bflo(A_.y), bflo(B_.y)); acc[ai][bj][m][0][3] *= RHO(bfhi(A_.y), bfhi(B_.y));
                    acc[ai][bj][m][1][0] *= RHO(bflo(A_.z), bflo(B_.z)); acc[ai][bj][m][1][1] *= RHO(bfhi(A_.z), bfhi(B_.z)); acc[ai][bj][m][1][2] *= RHO(bflo(A_.w), bflo(B_.w)); acc[ai][bj][m][1][3] *= RHO(bfhi(A_.w), bfhi(B_.w));
#undef RHO
                } }
        }
    }
    __device__ __forceinline__ void operator()(const f32x4 (&acc)[2][2][4][2], const Unit& u, int wr, int wc, int fr_in, int fq) const {
        int fr = fr_in; asm volatile("" : "+v"(fr));
        const int row0 = u.pm * BM + wr * 64 + fr, col0 = u.pn * BM + wc * 32 + 8 * fq;
        u32x4 gq[3][2];
#define EM_LOAD(gi, slot) do { const int row_ = row0 + ((gi) >> 2) * HALF + ((gi) & 3) * 16; \
            _Pragma("unroll") for (int bj = 0; bj < 2; ++bj) gq[slot][bj] = *(const u32x4*)(P + (size_t)row_ * PC + C_GB + col0 + bj * HALF); } while (0)
        EM_LOAD(0, 0); EM_LOAD(1, 1);
#pragma unroll
        for (int gi = 0; gi < 8; ++gi) {
            if (gi + 2 < 8) EM_LOAD(gi + 2, (gi + 2) % 3);
            asm volatile("" ::: "memory");
            const int ai = gi >> 2, m = gi & 3, row = row0 + ai * HALF + m * 16;
#pragma unroll
            for (int bj = 0; bj < 2; ++bj) { const u32x4 g = gq[gi % 3][bj];
                float v[8];
#pragma unroll
                for (int j = 0; j < 4; ++j) { v[j] = acc[ai][bj][m][0][j]; v[4 + j] = acc[ai][bj][m][1][j]; }
#define SGB(x_) sigmoidf_(fmaxf(x_, -60.f))
                v[0] *= SGB(bflo(g.x)); v[1] *= SGB(bfhi(g.x)); v[2] *= SGB(bflo(g.y)); v[3] *= SGB(bfhi(g.y)); v[4] *= SGB(bflo(g.z)); v[5] *= SGB(bfhi(g.z)); v[6] *= SGB(bflo(g.w)); v[7] *= SGB(bfhi(g.w));
#undef SGB
                u32x4 w; w.x = cvt_pk_bf16(v[0], v[1]); w.y = cvt_pk_bf16(v[2], v[3]); w.z = cvt_pk_bf16(v[4], v[5]); w.w = cvt_pk_bf16(v[6], v[7]);
                *(u32x4*)(MG + (size_t)row * DM + col0 + bj * HALF) = w; }
        }
#undef EM_LOAD
    }
};
struct EpiOut {
    static constexpr bool PERM = false; static constexpr bool HAS_MID = false;
    const float* x; bf16_t* x1; const float* mod; float* ssq;
    __device__ __forceinline__ void operator()(const f32x4 (&acc)[2][2][4][2], const Unit& u, int wr, int wc, int fr_in, int fq) const {
        int fr = fr_in; asm volatile("" : "+v"(fr));
        const int row0 = u.pm * BM + wr * 64 + fr, col0 = u.pn * BM + wc * 32 + 4 * fq, b = u.pm >> 5;
        f32x4 xq[3][2][2];
#define EO_LOAD(gi, slot) do { const size_t off_ = (size_t)(row0 + ((gi) >> 2) * HALF + ((gi) & 3) * 16) * DM + col0; \
            _Pragma("unroll") for (int bj = 0; bj < 2; ++bj) _Pragma("unroll") for (int n = 0; n < 2; ++n) xq[slot][bj][n] = *(const f32x4*)(x + off_ + bj * HALF + n * 16); } while (0)
        EO_LOAD(0, 0); EO_LOAD(1, 1);
        f32x4 g1[2][2];
#pragma unroll
        for (int bj = 0; bj < 2; ++bj)
#pragma unroll
            for (int n = 0; n < 2; ++n) g1[bj][n] = *(const f32x4*)(mod + b * 6144 + 2048 + col0 + bj * HALF + n * 16);
#pragma unroll
        for (int gi = 0; gi < 8; ++gi) {
            if (gi + 2 < 8) EO_LOAD(gi + 2, (gi + 2) % 3);
            asm volatile("" ::: "memory");
            const int ai = gi >> 2, m = gi & 3, row = row0 + ai * HALF + m * 16; const size_t off = (size_t)row * DM + col0; float s = 0.f;
#pragma unroll
            for (int bj = 0; bj < 2; ++bj)
#pragma unroll
                for (int n = 0; n < 2; ++n) { const f32x4 o = xq[gi % 3][bj][n] + g1[bj][n] * acc[ai][bj][m][n];
                    u32x2 w; w.x = cvt_pk_bf16(o[0], o[1]); w.y = cvt_pk_bf16(o[2], o[3]);
                    const float r0 = bflo(w.x), r1 = bfhi(w.x), r2 = bflo(w.y), r3 = bfhi(w.y);
                    s += (r0 * r0 + r1 * r1) + (r2 * r2 + r3 * r3); *(u32x2*)(x1 + off + bj * HALF + n * 16) = w; }
            s += __shfl_xor(s, 16); s += __shfl_xor(s, 32);
            if (fq == 0) ssq[(size_t)row * 16 + u.pn * 4 + wc] = s;
        }
#undef EO_LOAD
    }
};
struct EpiGU {
    static constexpr bool PERM = true; static constexpr bool HAS_MID = false;
    bf16_t* H;
    __device__ __forceinline__ void operator()(const f32x4 (&acc)[2][2][4][2], const Unit& u, int wr, int wc, int fr_in, int fq) const {
        int fr = fr_in; asm volatile("" : "+v"(fr));
        const int r0 = wr * 64 + fr, cl = wc * 32 + 8 * fq;
#pragma unroll
        for (int ai = 0; ai < 2; ++ai)
#pragma unroll
            for (int m = 0; m < 4; ++m) { const int r = r0 + ai * HALF + m * 16;
                float v[8];
#pragma unroll
                for (int j = 0; j < 4; ++j) { const float g0 = acc[ai][0][m][0][j], g1 = acc[ai][0][m][1][j]; v[j] = g0 * sigmoidf_(g0) * acc[ai][1][m][0][j]; v[4 + j] = g1 * sigmoidf_(g1) * acc[ai][1][m][1][j]; }
                u32x4 w; w.x = cvt_pk_bf16(v[0], v[1]); w.y = cvt_pk_bf16(v[2], v[3]); w.z = cvt_pk_bf16(v[4], v[5]); w.w = cvt_pk_bf16(v[6], v[7]);
                bf16_t* dst = H + ((size_t)u.pm * BM + r) * DEXP + u.pn * HALF + cl;
                asm volatile("global_store_dwordx4 %0, %1, off sc1\n\ts_nop 1" :: "v"(dst), "v"(w) : "memory"); }
    }
};
struct EpiDown {
    static constexpr bool PERM = true; static constexpr bool HAS_MID = false;
    bf16_t* Y; const unsigned long long* route;
    __device__ __forceinline__ void operator()(const f32x4 (&acc)[2][2][4][2], const Unit& u, int wr, int wc, int fr_in, int fq) const {
        int fr = fr_in; asm volatile("" : "+v"(fr));
        const int r0 = wr * 64 + fr, col0 = u.pn * BM + wc * 32 + 8 * fq;
        const unsigned long long* rt = route + (size_t)u.e * 32768 + (size_t)u.lt * 256;
        unsigned long long ent[8];
#pragma unroll
        for (int gi = 0; gi < 8; ++gi) { const int r = r0 + (gi >> 2) * HALF + (gi & 3) * 16; ent[gi] = (r < u.nvalid) ? rt[r] : 0ull; }
#pragma unroll
        for (int gi = 0; gi < 8; ++gi) { const int ai = gi >> 2, m = gi & 3, r = r0 + ai * HALF + m * 16;
            if (r < u.nvalid) { const unsigned slot = (unsigned)(ent[gi] & 0xffffffffull); const float wt = __uint_as_float((unsigned)(ent[gi] >> 32));
#pragma unroll
                for (int bj = 0; bj < 2; ++bj) { const f32x4 a0 = acc[ai][bj][m][0] * wt, a1 = acc[ai][bj][m][1] * wt;
                    u32x4 w; w.x = cvt_pk_bf16(a0[0], a0[1]); w.y = cvt_pk_bf16(a0[2], a0[3]); w.z = cvt_pk_bf16(a1[0], a1[1]); w.w = cvt_pk_bf16(a1[2], a1[3]);
                    *(u32x4*)(Y + (size_t)slot * DM + col0 + bj * HALF) = w; } } }
    }
};
}

namespace attn_body {
using bf16 = __hip_bfloat16;
constexpr int NHEAD = 8, D = 64, PITCH = PC;
constexpr int NW = 8, QBLK = 32, QB = QBLK * NW, KVBLK = 64;
__device__ __forceinline__ int crow(int r, int hi) { return (r & 3) + 8 * (r >> 2) + 4 * hi; }
#define SBAR() __builtin_amdgcn_sched_barrier(0)
__device__ __forceinline__ void cmask(f32x16& p0, f32x16& p1, int jb, int qrel, int hi) {
    const float NEG = -INFINITY; int kb = 64 * jb + 4 * hi;
#pragma unroll
    for (int r = 0; r < 16; ++r) { int kv = kb + (r & 3) + 8 * (r >> 2); if (kv > qrel) p0[r] = NEG; if (kv + 32 > qrel) p1[r] = NEG; }
}
__device__ __forceinline__ void selapply(f32x16& p0, f32x16& p1, bool ok) {
    const float NEG = -INFINITY;
#pragma unroll
    for (int r = 0; r < 16; ++r) { p0[r] = ok ? p0[r] : NEG; p1[r] = ok ? p1[r] : NEG; }
}
constexpr int NSLOT = 3, SLOTB = 8192;
constexpr int LDS_K = 0, LDS_V = NSLOT * SLOTB, LDS_WS = 2 * NSLOT * SLOTB, LDS_OST = LDS_WS + NW * 64 * 4, LDS_BYTES_A = LDS_OST + NW * 4096;
__device__ __forceinline__ void glds16(const void* gsrc, unsigned lds_dst) { unsigned keep;
    asm volatile("s_mov_b32 %0, m0\n\ts_mov_b32 m0, %2\n\ts_nop 0\n\tglobal_load_lds_dwordx4 %1, off\n\ts_mov_b32 m0, %0" : "=&s"(keep) : "v"(gsrc), "s"(lds_dst) : "memory"); }
__device__ __forceinline__ float max3f(float a, float b, float c) { float r; asm("v_max3_f32 %0, %1, %2, %3" : "=v"(r) : "v"(a), "v"(b), "v"(c)); return r; }
__device__ __forceinline__ float max2f(float a, float b) { float r; asm("v_max_f32_e32 %0, %1, %2" : "=v"(r) : "v"(a), "v"(b)); return r; }
__device__ __forceinline__ float fadd_s(float a, float b) { float r; asm("v_add_f32_e32 %0, %1, %2" : "=v"(r) : "v"(a), "v"(b)); return r; }
__device__ __forceinline__ float fsub_s(float a, float b) { float r; asm("v_sub_f32_e32 %0, %1, %2" : "=v"(r) : "v"(a), "v"(b)); return r; }
typedef __bf16 bf16x2_t __attribute__((ext_vector_type(2)));
__device__ __forceinline__ unsigned cvtpk_s(float lo, float hi) { f32x2 v = {lo, hi}; bf16x2_t b = __builtin_convertvector(v, bf16x2_t); return __builtin_bit_cast(unsigned, b); }
#define WAIT_BAR(N) asm volatile("s_waitcnt vmcnt(" #N ") lgkmcnt(0)\n\ts_barrier" ::: "memory")

__device__ __forceinline__ void qkt(f32x16& p0, f32x16& p1, const char* Kslot, const bf16x8* qr, const f32x16& negm, int r32, int hi) {
    const char* kb = Kslot + hi * 1024 + r32 * 16;
#pragma unroll
    for (int d0 = 0; d0 < 4; ++d0) {
        const bf16x8 b0 = *reinterpret_cast<const bf16x8*>(kb + d0 * 2048);
        const bf16x8 b1 = *reinterpret_cast<const bf16x8*>(kb + d0 * 2048 + 512);
        if (d0 == 0) { p0 = __builtin_amdgcn_mfma_f32_32x32x16_bf16(b0, qr[0], negm, 0, 0, 0); p1 = __builtin_amdgcn_mfma_f32_32x32x16_bf16(b1, qr[0], negm, 0, 0, 0); }
        else { p0 = __builtin_amdgcn_mfma_f32_32x32x16_bf16(b0, qr[d0], p0, 0, 0, 0); p1 = __builtin_amdgcn_mfma_f32_32x32x16_bf16(b1, qr[d0], p1, 0, 0, 0); } }
}
typedef LAS const char* lds_cptr;
typedef short v4i16_t __attribute__((ext_vector_type(4)));
__device__ __forceinline__ void kload8(bf16x8* kf, lds_cptr kp) {
    kf[0] = *(const LAS bf16x8*)(kp);        kf[1] = *(const LAS bf16x8*)(kp + 512);
    kf[2] = *(const LAS bf16x8*)(kp + 2048); kf[3] = *(const LAS bf16x8*)(kp + 2560);
    kf[4] = *(const LAS bf16x8*)(kp + 4096); kf[5] = *(const LAS bf16x8*)(kp + 4608);
    kf[6] = *(const LAS bf16x8*)(kp + 6144); kf[7] = *(const LAS bf16x8*)(kp + 6656);
}
__device__ __forceinline__ void kload2(bf16x8* kf, lds_cptr kp, int j) { kf[2 * j] = *(const LAS bf16x8*)(kp + j * 2048); kf[2 * j + 1] = *(const LAS bf16x8*)(kp + j * 2048 + 512); }
__device__ __forceinline__ s16x4 vtr(lds_cptr p) { return __builtin_bit_cast(s16x4, __builtin_amdgcn_ds_read_tr16_b64_v4i16((LAS v4i16_t*)p)); }
__device__ __forceinline__ float rowmax(const f32x16& p0, const f32x16& p1) {
    float a = max3f(p0[0], p0[1], p1[0]), b = max3f(p0[2], p0[3], p1[1]); a = max3f(a, p1[2], p1[3]);
#pragma unroll
    for (int r = 4; r < 16; r += 4) { a = max3f(a, p0[r], p0[r + 1]); b = max3f(b, p0[r + 2], p0[r + 3]); a = max3f(a, p1[r], p1[r + 1]); b = max3f(b, p1[r + 2], p1[r + 3]); }
    const float m = max2f(a, b);
    auto rr = __builtin_amdgcn_permlane32_swap(__float_as_uint(m), __float_as_uint(m), false, false);
    return max2f(__uint_as_float(rr[0]), __uint_as_float(rr[1]));
}
__device__ __forceinline__ void pv(f32x16* o, int vb, bf16x8 pa0, bf16x8 pa1, bf16x8 pa2, bf16x8 pa3) {
#pragma unroll
    for (int d0 = 0; d0 < 2; ++d0) { s16x4 lo[4], hi[4];
#pragma unroll
        for (int ks = 0; ks < 4; ++ks) {
            asm volatile("ds_read_b64_tr_b16 %0,%1 offset:%c2" : "=&v"(lo[ks]) : "v"(vb), "i"(d0 * 4096 + ks * 1024) : "memory");
            asm volatile("ds_read_b64_tr_b16 %0,%1 offset:%c2" : "=&v"(hi[ks]) : "v"(vb), "i"(d0 * 4096 + ks * 1024 + 512) : "memory"); }
        asm volatile("s_waitcnt lgkmcnt(0)" ::: "memory"); SBAR();
#define PK(k) (bf16x8){lo[k][0], lo[k][1], lo[k][2], lo[k][3], hi[k][0], hi[k][1], hi[k][2], hi[k][3]}
        o[d0] = __builtin_amdgcn_mfma_f32_32x32x16_bf16(pa0, PK(0), o[d0], 0, 0, 0);
        o[d0] = __builtin_amdgcn_mfma_f32_32x32x16_bf16(pa1, PK(1), o[d0], 0, 0, 0);
        o[d0] = __builtin_amdgcn_mfma_f32_32x32x16_bf16(pa2, PK(2), o[d0], 0, 0, 0);
        o[d0] = __builtin_amdgcn_mfma_f32_32x32x16_bf16(pa3, PK(3), o[d0], 0, 0, 0);
#undef PK
    }
}

__device__ __forceinline__ void gate_top3(const float* ksum_bh, const bf16x8* qr, int qb, int r32, int hi, int (&kbs)[3]) {
    const float* km = ksum_bh + (size_t)r32 * 64 + hi * 8;
    f32x16 g = f32x16{};
#pragma unroll
    for (int d0 = 0; d0 < 4; ++d0) { const f32x4 a = *(const f32x4*)(km + d0 * 16), c = *(const f32x4*)(km + d0 * 16 + 4);
        u32x4 w; w.x = cvtpk_s(a[0], a[1]); w.y = cvtpk_s(a[2], a[3]); w.z = cvtpk_s(c[0], c[1]); w.w = cvtpk_s(c[2], c[3]);
        g = __builtin_amdgcn_mfma_f32_32x32x16_bf16(__builtin_bit_cast(bf16x8, w), qr[d0], g, 0, 0, 0); }
#pragma unroll
    for (int r = 0; r < 16; ++r) if (crow(r, hi) >= qb) g[r] = -INFINITY;
#pragma unroll
    for (int round = 0; round < 3; ++round) {
        float m = g[0];
#pragma unroll
        for (int r = 1; r < 16; ++r) m = fmaxf(m, g[r]);
        int idx = 64;
#pragma unroll
        for (int r = 15; r >= 0; --r) if (g[r] == m) idx = crow(r, hi);
        const float pm = __shfl_xor(m, 32); const int pidx = __shfl_xor(idx, 32);
        const bool mine = (m > pm) || (m == pm && idx < pidx);
        kbs[round] = (mine ? idx : pidx) & 31;
#pragma unroll
        for (int r = 0; r < 16; ++r) if (mine && crow(r, hi) == idx) g[r] = -INFINITY;
    }
}

template <int THRL, bool OWN> __device__ __forceinline__ void attn_unit(int b, int h, int qb, const bf16* Q, const bf16* __restrict__ K, const bf16* __restrict__ V, bf16* O, const float* ksum, char* shm, bool do_store, const bf16_t* PO, const float* PML) {
    const int tid = threadIdx.x, lane = tid & 63, r32 = lane & 31, hi = lane >> 5; const int wid = __builtin_amdgcn_readfirstlane(tid >> 6);
    const long rowbase = (long)b * SEQ; const int q0 = qb * QB;
    const bf16* Qw = Q + (rowbase + q0 + wid * QBLK) * PITCH + h * D;
    const bf16* Kh = K + rowbase * PITCH + h * D, *Vh = V + rowbase * PITCH + h * D;
    const unsigned lds0 = (unsigned)(uintptr_t)shm;
    float* wsf = (float*)(shm + LDS_WS) + wid * 64;
    const bf16* ksrc = Kh + (long)lane * PITCH + wid * 8;
    const bf16* vsrc = Vh + (long)(16 * (wid & 3) + (lane >> 2)) * PITCH + (wid >> 2) * 32 + (lane & 3) * 8;
    const unsigned kdst = lds0 + LDS_K + wid * 1024, vdst = lds0 + LDS_V + wid * 1024;
    const int NT = OWN ? 4 : (q0 + QB) / KVBLK;
    const int TBASE = OWN ? 4 * qb : 0;
#define TM(t) (OWN ? (t) : (((t) == 0) ? (NT - 4) : (((t) <= NT - 4) ? ((t) - 1) : (t))))
#define DMA_K(t, slot) glds16(ksrc + (long)(TBASE + TM(t)) * KVBLK * PITCH, (unsigned)__builtin_amdgcn_readfirstlane(kdst + (slot)))
#define DMA_V(t, slot) glds16(vsrc + (long)(TBASE + TM(t)) * KVBLK * PITCH, (unsigned)__builtin_amdgcn_readfirstlane(vdst + (slot)))
    const int vb0 = (int)(lds0 + LDS_V) + ((lane >> 4) & 1) * 32 + (lane & 3) * 8 + (4 * hi + ((lane & 15) >> 2)) * 64;
    const char* Kbase = shm + LDS_K; bf16x8 kf[8];
    const lds_cptr shm3 = (lds_cptr)shm; const lds_cptr kp0 = shm3 + LDS_K + hi * 1024 + r32 * 16; const lds_cptr vp0 = shm3 + LDS_V + ((lane >> 4) & 1) * 32 + (lane & 3) * 8 + (4 * hi + ((lane & 15) >> 2)) * 64;
    DMA_K(0, 0); DMA_V(0, 0); DMA_K(1, SLOTB);
    bf16x8 qr[4];
#pragma unroll
    for (int d0 = 0; d0 < 4; ++d0) qr[d0] = *reinterpret_cast<const bf16x8*>(&Qw[(long)r32 * PITCH + d0 * 16 + hi * 8]);
    unsigned selmask = 0u;
    if constexpr (!OWN) {
    if (qb > 0) {
        if (qb <= 3) selmask = (1u << qb) - 1u;
        else { int kbs[3]; gate_top3(ksum + ((size_t)(b * NHEAD + h) * 32) * 64, qr, qb, r32, hi, kbs); selmask = (1u << kbs[0]) | (1u << kbs[1]) | (1u << kbs[2]); }
    } }
    float zf_; asm volatile("v_mov_b32 %0, 0" : "=v"(zf_));
    float mhat = 0.f, l_reg = 0.f; f32x16 o[2]; f32x16 negm;
#pragma unroll
    for (int r = 0; r < 16; ++r) { o[0][r] = zf_; o[1][r] = zf_; negm[r] = zf_; }
    asm volatile("" : "+v"(negm));
    const int qrel = wid * QBLK + r32;
#define MASKT(P0, P1, t) do { const int a_ = TM(t); const int jb_ = a_ - (NT - 4); if (jb_ >= 0) cmask(P0, P1, jb_, qrel, hi); else selapply(P0, P1, ((selmask >> (a_ >> 2)) & 1u) != 0u); } while (0)
    bool resc = false;
#define START(P0, P1) do { const float rm = rowmax(P0, P1); resc = false; \
    { const float dl = rm; mhat = fadd_s(mhat, dl); \
      _Pragma("unroll") for (int r = 0; r < 16; ++r) { P0[r] = fsub_s(P0[r], dl); P1[r] = fsub_s(P1[r], dl); } \
      _Pragma("unroll") for (int r = 0; r < 16; ++r) negm[r] = -mhat; asm volatile("" : "+v"(negm)); } \
    _Pragma("unroll") for (int r = 0; r < 16; ++r) P0[r] = __builtin_amdgcn_exp2f(P0[r]); } while (0)
#define RESC() do { if (resc) { asm volatile("s_waitcnt lgkmcnt(0)" ::: "memory"); \
      _Pragma("unroll") for (int d_ = 0; d_ < 2; ++d_) _Pragma("unroll") for (int r = 0; r < 16; ++r) o[d_][r] *= wsf[crow(r, hi)]; } } while (0)
    f32x16 pA0, pA1, pB0, pB1;
    int sl_prev = 0, sl_cur = 0, sl_next = SLOTB;
#define ROT() do { sl_prev = sl_cur; sl_cur = sl_next; sl_next = (sl_next == (NSLOT - 1) * SLOTB) ? 0 : sl_next + SLOTB; } while (0)
    DMA_K(2, 2 * SLOTB);
    WAIT_BAR(3);
    qkt(pA0, pA1, Kbase, qr, negm, r32, hi); asm volatile("s_nop 15\n\ts_nop 7" : "+v"(pA0), "+v"(pA1)); MASKT(pA0, pA1, 0);
    START(pA0, pA1);
    _Pragma("unroll") for (int r = 0; r < 16; ++r) pA1[r] = __builtin_amdgcn_exp2f(pA1[r]);
    WAIT_BAR(0);
    DMA_K(3, 0); DMA_V(1, SLOTB);
    ROT();
    kload8(kf, kp0 + sl_cur);
    WAIT_BAR(2);
    s16x4 vlo[8], vhi[8]; u32x4 pw0, pw1, pw2, pw3;
#define PKW(P, B) cvtpk_s(P[B], P[B + 1])
#define PAF(k) __builtin_bit_cast(bf16x8, pw##k)
#define VFR(i) (bf16x8){vlo[i][0], vlo[i][1], vlo[i][2], vlo[i][3], vhi[i][0], vhi[i][1], vhi[i][2], vhi[i][3]}
#define PIN(x) asm volatile("" : "+v"(x))
#define MX3(a, b, c) __builtin_fmaxf(__builtin_fmaxf((a), (b)), (c))
#define GAPA(MF, A0, A1, A2, A3, W0, W1, PW) do { MF; sacc += A0; sacc += A1; sacc += A2; sacc += A3; PIN(sacc); W0; W1; PIN(PW); SBAR(); } while (0)
#define EX(v) __builtin_amdgcn_exp2f(v)
#define GAPB(MF, X, B) do { MF; X[B] = EX(X[B]); X[B + 1] = EX(X[B + 1]); X[B + 2] = EX(X[B + 2]); X[B + 3] = EX(X[B + 3]); PIN(X); SBAR(); } while (0)
#define VRD(i) do { vlo[i] = vtr(vp_ + (((i) >> 2) * 4096 + ((i) & 3) * 1024)); vhi[i] = vtr(vp_ + (((i) >> 2) * 4096 + ((i) & 3) * 1024 + 512)); } while (0)
#define KRD(G, j) do { if (G) { kload2(kf, kp0 + sl_next, j); SBAR(); } } while (0)
#define STEP(C0, C1, P0, P1, t, GK, GV, GL) do { SBAR(); \
    const lds_cptr vp_ = vp0 + sl_prev; \
    VRD(0); SBAR(); float sacc = (P0[0] + P0[1]); \
    GAPA(C0 = __builtin_amdgcn_mfma_f32_32x32x16_bf16(kf[0], qr[0], negm, 0, 0, 0), P0[2], P0[3], P0[4], P0[5],     pw0[0] = PKW(P0, 0), pw0[1] = PKW(P0, 2), pw0); \
    VRD(4); SBAR(); GAPA(C1 = __builtin_amdgcn_mfma_f32_32x32x16_bf16(kf[1], qr[0], negm, 0, 0, 0), P0[6], P0[7], P0[8], P0[9],     pw0[2] = PKW(P0, 4), pw0[3] = PKW(P0, 6), pw0); \
    VRD(1); SBAR(); GAPA(C0 = __builtin_amdgcn_mfma_f32_32x32x16_bf16(kf[2], qr[1], C0, 0, 0, 0),   P0[10], P0[11], P0[12], P0[13], pw1[0] = PKW(P0, 8), pw1[1] = PKW(P0, 10), pw1); \
    VRD(5); SBAR(); GAPA(C1 = __builtin_amdgcn_mfma_f32_32x32x16_bf16(kf[3], qr[1], C1, 0, 0, 0),   P0[14], P0[15], P1[0], P1[1],   pw1[2] = PKW(P0, 12), pw1[3] = PKW(P0, 14), pw1); \
    VRD(2); SBAR(); GAPA(C0 = __builtin_amdgcn_mfma_f32_32x32x16_bf16(kf[4], qr[2], C0, 0, 0, 0),   P1[2], P1[3], P1[4], P1[5],     pw2[0] = PKW(P1, 0), pw2[1] = PKW(P1, 2), pw2); \
    VRD(6); SBAR(); GAPA(C1 = __builtin_amdgcn_mfma_f32_32x32x16_bf16(kf[5], qr[2], C1, 0, 0, 0),   P1[6], P1[7], P1[8], P1[9],     pw2[2] = PKW(P1, 4), pw2[3] = PKW(P1, 6), pw2); \
    VRD(3); SBAR(); GAPA(C0 = __builtin_amdgcn_mfma_f32_32x32x16_bf16(kf[6], qr[3], C0, 0, 0, 0),   P1[10], P1[11], P1[12], P1[13], pw3[0] = PKW(P1, 8), pw3[1] = PKW(P1, 10), pw3); \
    VRD(7); SBAR(); GAPA(C1 = __builtin_amdgcn_mfma_f32_32x32x16_bf16(kf[7], qr[3], C1, 0, 0, 0),   P1[14], P1[15], 0.f, 0.f,       pw3[2] = PKW(P1, 12), pw3[3] = PKW(P1, 14), pw3); \
    l_reg += sacc; \
    if (GK) { DMA_K((t) + 3, sl_cur); } if (GV) { DMA_V((t) + 1, sl_next); } \
    MASKT(C0, C1, t); \
    { float a = MX3(C0[0], C0[1], C1[0]), b = MX3(C0[2], C0[3], C1[1]); a = MX3(a, C1[2], C1[3]); \
      _Pragma("unroll") for (int r = 4; r < 16; r += 4) { a = MX3(a, C0[r], C0[r + 1]); b = MX3(b, C0[r + 2], C0[r + 3]); a = MX3(a, C1[r], C1[r + 1]); b = MX3(b, C1[r + 2], C1[r + 3]); } \
      float rm = __builtin_fmaxf(a, b); { auto rr = __builtin_amdgcn_permlane32_swap(__float_as_uint(rm), __float_as_uint(rm), false, false); rm = __builtin_fmaxf(__uint_as_float(rr[0]), __uint_as_float(rr[1])); } \
      resc = false; \
      if (__builtin_expect(__any(rm > (float)THRL), 0)) { const float dl = __builtin_fmaxf(rm, 0.f); mhat += dl; \
        _Pragma("unroll") for (int r = 0; r < 16; ++r) { C0[r] -= dl; C1[r] -= dl; } \
        _Pragma("unroll") for (int r = 0; r < 16; ++r) negm[r] = -mhat; asm volatile("" : "+v"(negm)); \
        const float f = __builtin_amdgcn_exp2f(-dl); l_reg *= f; if (hi == 0) wsf[r32] = f; resc = true; } } \
    SBAR(); \
    GAPB(o[0] = __builtin_amdgcn_mfma_f32_32x32x16_bf16(PAF(0), VFR(0), o[0], 0, 0, 0), C0, 0); \
    GAPB(o[1] = __builtin_amdgcn_mfma_f32_32x32x16_bf16(PAF(0), VFR(4), o[1], 0, 0, 0), C0, 4); \
    KRD(GL, 0); GAPB(o[0] = __builtin_amdgcn_mfma_f32_32x32x16_bf16(PAF(1), VFR(1), o[0], 0, 0, 0), C0, 8); \
    KRD(GL, 1); GAPB(o[1] = __builtin_amdgcn_mfma_f32_32x32x16_bf16(PAF(1), VFR(5), o[1], 0, 0, 0), C0, 12); \
    KRD(GL, 2); GAPB(o[0] = __builtin_amdgcn_mfma_f32_32x32x16_bf16(PAF(2), VFR(2), o[0], 0, 0, 0), C1, 0); \
    KRD(GL, 3); GAPB(o[1] = __builtin_amdgcn_mfma_f32_32x32x16_bf16(PAF(2), VFR(6), o[1], 0, 0, 0), C1, 4); \
    GAPB(o[0] = __builtin_amdgcn_mfma_f32_32x32x16_bf16(PAF(3), VFR(3), o[0], 0, 0, 0), C1, 8); \
    GAPB(o[1] = __builtin_amdgcn_mfma_f32_32x32x16_bf16(PAF(3), VFR(7), o[1], 0, 0, 0), C1, 12); \
    } while (0)
    int t = 1;
    for (; t + 5 < NT; t += 2) {
        STEP(pB0, pB1, pA0, pA1, t, true, true, true);     WAIT_BAR(2); RESC(); ROT();
        STEP(pA0, pA1, pB0, pB1, t + 1, true, true, true); WAIT_BAR(2); RESC(); ROT();
    }
#define ENDW(tt) do { if ((tt) + 3 < NT) { WAIT_BAR(2); } else if ((tt) + 2 < NT) { WAIT_BAR(1); } else { WAIT_BAR(0); } } while (0)
    for (; t + 1 < NT; t += 2) {
        STEP(pB0, pB1, pA0, pA1, t, (t + 3 < NT), (t + 1 < NT), (t + 1 < NT));       ENDW(t);     RESC(); ROT();
        STEP(pA0, pA1, pB0, pB1, t + 1, (t + 4 < NT), (t + 2 < NT), (t + 2 < NT));   ENDW(t + 1); RESC(); ROT();
    }
    STEP(pB0, pB1, pA0, pA1, NT - 1, false, false, false); RESC();
    { float sacc = pB0[0] + pB0[1]; _Pragma("unroll") for (int r = 2; r < 16; ++r) sacc += pB0[r]; _Pragma("unroll") for (int r = 0; r < 16; ++r) sacc += pB1[r]; l_reg += sacc;
      pw0 = (u32x4){PKW(pB0, 0), PKW(pB0, 2), PKW(pB0, 4), PKW(pB0, 6)}; pw1 = (u32x4){PKW(pB0, 8), PKW(pB0, 10), PKW(pB0, 12), PKW(pB0, 14)}; pw2 = (u32x4){PKW(pB1, 0), PKW(pB1, 2), PKW(pB1, 4), PKW(pB1, 6)}; pw3 = (u32x4){PKW(pB1, 8), PKW(pB1, 10), PKW(pB1, 12), PKW(pB1, 14)};
      SBAR(); pv(o, vb0 + sl_cur, PAF(0), PAF(1), PAF(2), PAF(3)); }
#undef PKW
#undef PAF
#undef VFR
#undef PIN
#undef MX3
#undef GAPA
#undef GAPB
#undef EX
#undef VRD
#undef KRD
#undef STEP
#undef ENDW
    { auto rr = __builtin_amdgcn_permlane32_swap(__float_as_uint(l_reg), __float_as_uint(l_reg), false, false); l_reg = __uint_as_float(rr[0]) + __uint_as_float(rr[1]); }
    if (hi == 0) { wsf[32 + r32] = l_reg; if (OWN) wsf[r32] = mhat; } asm volatile("s_waitcnt lgkmcnt(0)" ::: "memory");
    float rli[16];
#pragma unroll
    for (int r = 0; r < 16; ++r) rli[r] = __builtin_amdgcn_rcpf(wsf[32 + crow(r, hi)]);
    bf16* Ow = O + (rowbase + q0 + wid * QBLK) * PITCH + h * D;
    { bf16* stg = (bf16*)(shm + LDS_OST) + wid * 2048;
#pragma unroll
      for (int r = 0; r < 16; ++r) { const int orow = crow(r, hi);
#pragma unroll
        for (int d0 = 0; d0 < 2; ++d0) stg[orow * 64 + d0 * 32 + r32] = __float2bfloat16(o[d0][r] * rli[r]); }
      asm volatile("s_waitcnt lgkmcnt(0)" ::: "memory");
      const int nsel = qb < 3 ? qb : 3;
#pragma unroll
      for (int i = 0; i < 4; ++i) { const int row = i * 8 + (lane >> 3), ch = lane & 7; u32x4 v = *(const u32x4*)(stg + row * 64 + ch * 8);
        if constexpr (OWN) {
          if (nsel > 0) {
            const float mo = wsf[row], lo = wsf[32 + row];
            const size_t e0 = (((size_t)(b * NHEAD + h)) * SEQ + q0 + wid * QBLK + row) * 3;
            float ms[3], ls[3]; u32x4 pp[3]; float M = mo;
#pragma unroll
            for (int s_ = 0; s_ < 3; ++s_) { ms[s_] = -INFINITY; ls[s_] = 0.f; pp[s_] = (u32x4){0u, 0u, 0u, 0u};
              if (s_ < nsel) { const f32x2 ml = *(const f32x2*)(PML + (e0 + s_) * 2); ms[s_] = ml.x; ls[s_] = ml.y; pp[s_] = *(const u32x4*)(PO + (e0 + s_) * 64 + ch * 8); M = fmaxf(M, ml.x); } }
            const float wo = lo * __builtin_amdgcn_exp2f(mo - M); float W = wo;
            float a[8] = {bflo(v.x) * wo, bfhi(v.x) * wo, bflo(v.y) * wo, bfhi(v.y) * wo, bflo(v.z) * wo, bfhi(v.z) * wo, bflo(v.w) * wo, bfhi(v.w) * wo};
#pragma unroll
            for (int s_ = 0; s_ < 3; ++s_) { const float w_ = (s_ < nsel) ? ls[s_] * __builtin_amdgcn_exp2f(ms[s_] - M) : 0.f; W += w_;
              a[0] += w_ * bflo(pp[s_].x); a[1] += w_ * bfhi(pp[s_].x); a[2] += w_ * bflo(pp[s_].y); a[3] += w_ * bfhi(pp[s_].y); a[4] += w_ * bflo(pp[s_].z); a[5] += w_ * bfhi(pp[s_].z); a[6] += w_ * bflo(pp[s_].w); a[7] += w_ * bfhi(pp[s_].w); }
            const float iw = 1.0f / W;
            v.x = cvtpk_s(a[0] * iw, a[1] * iw); v.y = cvtpk_s(a[2] * iw, a[3] * iw); v.z = cvtpk_s(a[4] * iw, a[5] * iw); v.w = cvtpk_s(a[6] * iw, a[7] * iw);
          } }
        if (do_store) *(u32x4*)(Ow + (long)row * PITCH + ch * 8) = v; } }
    asm volatile("s_waitcnt lgkmcnt(0)\n\ts_barrier" ::: "memory");
#undef DMA_K
#undef DMA_V
#undef TM
#undef MASKT
#undef START
#undef RESC
#undef ROT
}

__device__ __forceinline__ void select_unit(int b, int h, int qb, const bf16* Q, const float* ksum, unsigned short* LIST, unsigned* CNT, char* shm) {
    if (qb == 0) return;
    const int tid = threadIdx.x, lane = tid & 63, r32 = lane & 31, hi = lane >> 5; const int wid = __builtin_amdgcn_readfirstlane(tid >> 6);
    LAS unsigned* hist = (LAS unsigned*)shm; LAS unsigned* basev = hist + 32;
    if (tid < 32) hist[tid] = 0u;
    __syncthreads();
    int kbs[3] = {0, 1, 2}; const int ns = qb < 3 ? qb : 3;
    if (qb > 3) {
        const bf16* Qw = Q + ((long)b * SEQ + qb * QB + wid * QBLK) * PITCH + h * D;
        bf16x8 qr[4];
#pragma unroll
        for (int d0 = 0; d0 < 4; ++d0) qr[d0] = *reinterpret_cast<const bf16x8*>(&Qw[(long)r32 * PITCH + d0 * 16 + hi * 8]);
        gate_top3(ksum + ((size_t)(b * NHEAD + h) * 32) * 64, qr, qb, r32, hi, kbs);
    }
    unsigned pos[3] = {0u, 0u, 0u};
    if (hi == 0) {
#pragma unroll
        for (int s_ = 0; s_ < 3; ++s_) if (s_ < ns) pos[s_] = __hip_atomic_fetch_add(hist + kbs[s_], 1u, __ATOMIC_RELAXED, __HIP_MEMORY_SCOPE_WORKGROUP);
    }
    __syncthreads();
    const int bh = b * NHEAD + h;
    if (tid < 32) { const unsigned n = hist[tid]; basev[tid] = n ? __hip_atomic_fetch_add(CNT + bh * 32 + tid, n, __ATOMIC_RELAXED, __HIP_MEMORY_SCOPE_AGENT) : 0u; }
    __syncthreads();
    if (hi == 0) { const unsigned qv = (unsigned)(qb * QB + wid * QBLK + r32) << 2;
#pragma unroll
        for (int s_ = 0; s_ < 3; ++s_) if (s_ < ns) LIST[(size_t)(bh * 32 + kbs[s_]) * 8192 + basev[kbs[s_]] + pos[s_]] = (unsigned short)(qv | (unsigned)s_); }
    __syncthreads();
}

constexpr int G_K = 0, G_V = 32768, G_WS = 65536, G_OST = G_WS + NW * 512, G_TAB = G_OST + NW * 4096, G_BYTES = G_TAB + 8256 + 4096 + 4104;
template <int THRL> __device__ __forceinline__ void gather_phase(char* shm, const bf16* Q, const bf16* __restrict__ K, const bf16* __restrict__ V, const unsigned short* LIST, unsigned* CNT, bf16_t* PO, float* PML, int vcu, int G, bool do_store) {
    const int tid = threadIdx.x, lane = tid & 63, r32 = lane & 31, hi = lane >> 5; const int wid = __builtin_amdgcn_readfirstlane(tid >> 6);
    LAS int* pre = (LAS int*)(shm + G_TAB); LAS int* wtot = pre + 1032; LAS int* cntl = (LAS int*)(shm + G_TAB + 8256); LAS int* prw = (LAS int*)(shm + G_TAB + 8256 + 4096);
    constexpr int WL = 24, WP = 20;
    {
        const int c0 = (int)__hip_atomic_load(CNT + 2 * tid, __ATOMIC_RELAXED, __HIP_MEMORY_SCOPE_AGENT), c1 = (int)__hip_atomic_load(CNT + 2 * tid + 1, __ATOMIC_RELAXED, __HIP_MEMORY_SCOPE_AGENT);
        const int n0 = (c0 + 255) >> 8, n1 = (c1 + 255) >> 8, sm = n0 + n1;
        const int w0 = c0 ? WL + (n0 - 1) * WP + 12 + ((c0 - 256 * (n0 - 1) + 31) >> 5) : 0, w1 = c1 ? WL + (n1 - 1) * WP + 12 + ((c1 - 256 * (n1 - 1) + 31) >> 5) : 0, sw = w0 + w1;
        int v = sm, vw = sw;
#pragma unroll
        for (int o_ = 1; o_ < 64; o_ <<= 1) { const int t_ = __shfl_up(v, o_), tw_ = __shfl_up(vw, o_); if (lane >= o_) { v += t_; vw += tw_; } }
        if (lane == 63) { wtot[wid] = v; wtot[8 + wid] = vw; }
        cntl[2 * tid] = c0; cntl[2 * tid + 1] = c1;
        __syncthreads();
        int off = 0, offw = 0;
        for (int w_ = 0; w_ < wid; ++w_) { off += wtot[w_]; offw += wtot[8 + w_]; }
        const int excl = off + v - sm, exclw = offw + vw - sw;
        pre[2 * tid] = excl; pre[2 * tid + 1] = excl + n0; prw[2 * tid] = exclw; prw[2 * tid + 1] = exclw + w0;
        if (tid == NW * 64 - 1) { pre[1024] = excl + sm; prw[1024] = exclw + sw; }
        __syncthreads();
    }
    const int Wtot = __builtin_amdgcn_readfirstlane(prw[1024]);
    int ub[2], istart = 0;
#pragma unroll
    for (int e_ = 0; e_ < 2; ++e_) { const int tgt = (int)(((long)Wtot * (vcu + e_)) / G);
        int lo_ = 0, hi_ = 1024;
        while (hi_ - lo_ > 1) { const int mid = (lo_ + hi_) >> 1; if (__builtin_amdgcn_readfirstlane(prw[mid]) <= tgt) lo_ = mid; else hi_ = mid; }
        const int npi = __builtin_amdgcn_readfirstlane(pre[lo_ + 1]) - __builtin_amdgcn_readfirstlane(pre[lo_]);
        int p_ = (tgt - __builtin_amdgcn_readfirstlane(prw[lo_]) - WL + WP / 2) / WP; p_ = p_ < 0 ? 0 : (p_ > npi ? npi : p_);
        ub[e_] = (vcu + e_ >= G) ? __builtin_amdgcn_readfirstlane(pre[1024]) : __builtin_amdgcn_readfirstlane(pre[lo_]) + p_;
        if (e_ == 0 && vcu != 0) istart = lo_; }
    const int ulo = (vcu == 0) ? 0 : ub[0], uhi = ub[1];
    const unsigned lds0 = (unsigned)(uintptr_t)shm;
    float* wsf = (float*)(shm + G_WS) + wid * 128; int* ent = (int*)(wsf + 64);
    const unsigned kdst = lds0 + G_K + wid * 1024, vdst = lds0 + G_V + wid * 1024;
    const int vb0 = (int)(lds0 + G_V) + ((lane >> 4) & 1) * 32 + (lane & 3) * 8 + (4 * hi + ((lane & 15) >> 2)) * 64;
    int it0 = istart, it1 = istart, it2 = istart, cur = -1;
#define G_ITEM(itv, uu) do { while ((uu) < uhi && __builtin_amdgcn_readfirstlane(pre[(itv) + 1]) <= (uu)) ++(itv); } while (0)
#define G_ENTRY(itv, uu) ({ const int ps_ = (uu) - __builtin_amdgcn_readfirstlane(pre[itv]), cn_ = __builtin_amdgcn_readfirstlane(cntl[itv]); const int li_ = ps_ * 256 + wid * QBLK + r32; \
        (unsigned)LIST[(size_t)(itv) * 8192 + (li_ < cn_ ? li_ : 0)] | ((li_ < cn_) ? 0x10000u : 0u); })
#define G_QLOAD(dst, itv, ee) do { const int bh_ = (itv) >> 5; const bf16* Qrow_ = Q + ((long)(bh_ >> 3) * SEQ + (int)(((ee) & 0xffffu) >> 2)) * PITCH + (bh_ & 7) * D; \
        _Pragma("unroll") for (int d0 = 0; d0 < 4; ++d0) dst[d0] = *reinterpret_cast<const bf16x8*>(Qrow_ + d0 * 16 + hi * 8); } while (0)
    unsigned e0 = 0u, e1 = 0u, e2 = 0u; bf16x8 qr[4], qn[4];
    if (ulo < uhi) { G_ITEM(it0, ulo); e0 = G_ENTRY(it0, ulo); it1 = it0; { const int u1_ = (ulo + 1 < uhi) ? ulo + 1 : uhi - 1; G_ITEM(it1, u1_); e1 = G_ENTRY(it1, u1_); } G_QLOAD(qr, it0, e0); }
    it2 = it1;
    for (int u = ulo; u < uhi; ++u) {
        { const int u2_ = (u + 2 < uhi) ? u + 2 : uhi - 1; G_ITEM(it2, u2_); e2 = G_ENTRY(it2, u2_); }
        const int item = it0;
        const int bh = item >> 5, kb = item & 31, b = bh >> 3, h = bh & 7;
        if (item != cur) {
            asm volatile("s_waitcnt lgkmcnt(0)\n\ts_barrier" ::: "memory");
            const bf16* Kh = K + (long)b * SEQ * PITCH + h * D, *Vh = V + (long)b * SEQ * PITCH + h * D;
            const bf16* ksrc = Kh + (long)lane * PITCH + wid * 8;
            const bf16* vsrc = Vh + (long)(16 * (wid & 3) + (lane >> 2)) * PITCH + (wid >> 2) * 32 + (lane & 3) * 8;
#pragma unroll
            for (int t = 0; t < 4; ++t) { glds16(ksrc + (long)(4 * kb + t) * KVBLK * PITCH, (unsigned)__builtin_amdgcn_readfirstlane(kdst + t * 8192)); glds16(vsrc + (long)(4 * kb + t) * KVBLK * PITCH, (unsigned)__builtin_amdgcn_readfirstlane(vdst + t * 8192)); }
            asm volatile("s_waitcnt vmcnt(0)\n\ts_barrier" ::: "memory");
            cur = item;
            if (wid >= 4) __builtin_amdgcn_s_sleep(10);
        }
        G_QLOAD(qn, it1, e1);
        const bool valid = (e0 & 0x10000u) != 0u;
        const int q = (int)((e0 & 0xffffu) >> 2), slot = (int)(e0 & 3u);
        const bool wave_has_rows = __builtin_amdgcn_readfirstlane((int)(e0 >> 16) & 1) != 0 || __any(valid);
        if (wave_has_rows) {
        float mhat = 0.f, l_reg = 0.f; f32x16 o[2]; f32x16 negm;
#pragma unroll
        for (int r = 0; r < 16; ++r) { o[0][r] = 0.f; o[1][r] = 0.f; negm[r] = 0.f; }
        const lds_cptr kp0 = (lds_cptr)shm + G_K + hi * 1024 + r32 * 16; const lds_cptr vp0 = (lds_cptr)shm + G_V + ((lane >> 4) & 1) * 32 + (lane & 3) * 8 + (4 * hi + ((lane & 15) >> 2)) * 64;
        bf16x8 kf[8]; f32x16 p0, p1, s0, s1;
#define G_QK(D0, D1) do { D0 = __builtin_amdgcn_mfma_f32_32x32x16_bf16(kf[0], qr[0], negm, 0, 0, 0); D1 = __builtin_amdgcn_mfma_f32_32x32x16_bf16(kf[1], qr[0], negm, 0, 0, 0); \
            D0 = __builtin_amdgcn_mfma_f32_32x32x16_bf16(kf[2], qr[1], D0, 0, 0, 0); D1 = __builtin_amdgcn_mfma_f32_32x32x16_bf16(kf[3], qr[1], D1, 0, 0, 0); \
            D0 = __builtin_amdgcn_mfma_f32_32x32x16_bf16(kf[4], qr[2], D0, 0, 0, 0); D1 = __builtin_amdgcn_mfma_f32_32x32x16_bf16(kf[5], qr[2], D1, 0, 0, 0); \
            D0 = __builtin_amdgcn_mfma_f32_32x32x16_bf16(kf[6], qr[3], D0, 0, 0, 0); D1 = __builtin_amdgcn_mfma_f32_32x32x16_bf16(kf[7], qr[3], D1, 0, 0, 0); } while (0)
#define G_MX(D0, D1, FIRST) do { float a_ = fmaxf(fmaxf(D0[0], D0[1]), D1[0]), c_ = fmaxf(fmaxf(D0[2], D0[3]), D1[1]); a_ = fmaxf(fmaxf(a_, D1[2]), D1[3]); \
            _Pragma("unroll") for (int r = 4; r < 16; r += 4) { a_ = fmaxf(fmaxf(a_, D0[r]), D0[r + 1]); c_ = fmaxf(fmaxf(c_, D0[r + 2]), D0[r + 3]); a_ = fmaxf(fmaxf(a_, D1[r]), D1[r + 1]); c_ = fmaxf(fmaxf(c_, D1[r + 2]), D1[r + 3]); } \
            float rm_ = fmaxf(a_, c_); { auto rr_ = __builtin_amdgcn_permlane32_swap(__float_as_uint(rm_), __float_as_uint(rm_), false, false); rm_ = fmaxf(__uint_as_float(rr_[0]), __uint_as_float(rr_[1])); } \
            if (FIRST) { mhat = rm_; _Pragma("unroll") for (int r = 0; r < 16; ++r) { D0[r] -= rm_; D1[r] -= rm_; negm[r] = -mhat; } } \
            else if (__any(rm_ > (float)THRL)) { const float dl_ = fmaxf(rm_, 0.f); mhat += dl_; \
                _Pragma("unroll") for (int r = 0; r < 16; ++r) { D0[r] -= dl_; D1[r] -= dl_; negm[r] = -mhat; } \
                const float f_ = __builtin_amdgcn_exp2f(-dl_); l_reg *= f_; if (hi == 0) wsf[r32] = f_; \
                asm volatile("s_waitcnt lgkmcnt(0)" ::: "memory"); \
                _Pragma("unroll") for (int d_ = 0; d_ < 2; ++d_) _Pragma("unroll") for (int r = 0; r < 16; ++r) o[d_][r] *= wsf[crow(r, hi)]; } } while (0)
        const bool run_tiles = (GPROBE == 1) ? do_store : true;
        if (run_tiles) {
        kload8(kf, kp0);
        G_QK(p0, p1);
        kload8(kf, kp0 + 8192);
        G_MX(p0, p1, true);
#pragma unroll
        for (int t = 0; t < 4; ++t) {
            if (t < 3) { __builtin_amdgcn_sched_barrier(0); G_QK(s0, s1); if (t < 2) kload8(kf, kp0 + (t + 2) * 8192); }
            s16x4 vlo[8], vhi[8];
            const lds_cptr vp_ = vp0 + t * 8192;
#pragma unroll
            for (int i = 0; i < 8; ++i) { vlo[i] = vtr(vp_ + ((i >> 2) * 4096 + (i & 3) * 1024)); vhi[i] = vtr(vp_ + ((i >> 2) * 4096 + (i & 3) * 1024 + 512)); }
            __builtin_amdgcn_sched_barrier(0);
            float sacc = 0.f;
#pragma unroll
            for (int r = 0; r < 16; ++r) { p0[r] = __builtin_amdgcn_exp2f(p0[r]); p1[r] = __builtin_amdgcn_exp2f(p1[r]); sacc += p0[r] + p1[r]; }
            l_reg += sacc;
            const u32x4 pw0 = {cvtpk_s(p0[0], p0[1]), cvtpk_s(p0[2], p0[3]), cvtpk_s(p0[4], p0[5]), cvtpk_s(p0[6], p0[7])}, pw1 = {cvtpk_s(p0[8], p0[9]), cvtpk_s(p0[10], p0[11]), cvtpk_s(p0[12], p0[13]), cvtpk_s(p0[14], p0[15])};
            const u32x4 pw2 = {cvtpk_s(p1[0], p1[1]), cvtpk_s(p1[2], p1[3]), cvtpk_s(p1[4], p1[5]), cvtpk_s(p1[6], p1[7])}, pw3 = {cvtpk_s(p1[8], p1[9]), cvtpk_s(p1[10], p1[11]), cvtpk_s(p1[12], p1[13]), cvtpk_s(p1[14], p1[15])};
            __builtin_amdgcn_sched_barrier(0);
#define G_VF(i) (bf16x8){vlo[i][0], vlo[i][1], vlo[i][2], vlo[i][3], vhi[i][0], vhi[i][1], vhi[i][2], vhi[i][3]}
            if (GPROBE == 2 && !do_store) { asm volatile("" :: "v"(pw0), "v"(pw1), "v"(pw2), "v"(pw3)); } else {
            o[0] = __builtin_amdgcn_mfma_f32_32x32x16_bf16(__builtin_bit_cast(bf16x8, pw0), G_VF(0), o[0], 0, 0, 0); o[1] = __builtin_amdgcn_mfma_f32_32x32x16_bf16(__builtin_bit_cast(bf16x8, pw0), G_VF(4), o[1], 0, 0, 0);
            o[0] = __builtin_amdgcn_mfma_f32_32x32x16_bf16(__builtin_bit_cast(bf16x8, pw1), G_VF(1), o[0], 0, 0, 0); o[1] = __builtin_amdgcn_mfma_f32_32x32x16_bf16(__builtin_bit_cast(bf16x8, pw1), G_VF(5), o[1], 0, 0, 0);
            o[0] = __builtin_amdgcn_mfma_f32_32x32x16_bf16(__builtin_bit_cast(bf16x8, pw2), G_VF(2), o[0], 0, 0, 0); o[1] = __builtin_amdgcn_mfma_f32_32x32x16_bf16(__builtin_bit_cast(bf16x8, pw2), G_VF(6), o[1], 0, 0, 0);
            o[0] = __builtin_amdgcn_mfma_f32_32x32x16_bf16(__builtin_bit_cast(bf16x8, pw3), G_VF(3), o[0], 0, 0, 0); o[1] = __builtin_amdgcn_mfma_f32_32x32x16_bf16(__builtin_bit_cast(bf16x8, pw3), G_VF(7), o[1], 0, 0, 0);
            }
#undef G_VF
            if (t < 3) { G_MX(s0, s1, false); p0 = s0; p1 = s1; }
        }
        }
#undef G_QK
#undef G_MX
        { auto rr = __builtin_amdgcn_permlane32_swap(__float_as_uint(l_reg), __float_as_uint(l_reg), false, false); l_reg = __uint_as_float(rr[0]) + __uint_as_float(rr[1]); }
        const int er = valid ? (q * 3 + slot) : -1;
        if (hi == 0) { wsf[32 + r32] = l_reg; ent[r32] = er; } asm volatile("s_waitcnt lgkmcnt(0)" ::: "memory");
        float rli[16];
#pragma unroll
        for (int r = 0; r < 16; ++r) rli[r] = __builtin_amdgcn_rcpf(wsf[32 + crow(r, hi)]);
        bf16* stg = (bf16*)(shm + G_OST) + wid * 2048;
#pragma unroll
        for (int r = 0; r < 16; ++r) { const int orow = crow(r, hi);
#pragma unroll
            for (int d0 = 0; d0 < 2; ++d0) stg[orow * 64 + d0 * 32 + r32] = __float2bfloat16(o[d0][r] * rli[r]); }
        asm volatile("s_waitcnt lgkmcnt(0)" ::: "memory");
        const size_t ebase = (size_t)bh * SEQ * 3;
#pragma unroll
        for (int i = 0; i < 4; ++i) { const int row = i * 8 + (lane >> 3), ch = lane & 7; const u32x4 v = *(const u32x4*)(stg + row * 64 + ch * 8); const int er_ = ent[row];
            if (er_ >= 0 && do_store) *(u32x4*)(PO + (ebase + er_) * 64 + ch * 8) = v; }
        if (hi == 0 && valid && do_store) *(f32x2*)(PML + (ebase + er) * 2) = (f32x2){mhat, l_reg};
        asm volatile("s_waitcnt lgkmcnt(0)" ::: "memory");
        }
        e0 = e1; e1 = e2; it0 = it1; it1 = it2;
#pragma unroll
        for (int d0 = 0; d0 < 4; ++d0) qr[d0] = qn[d0];
    }
    asm volatile("s_waitcnt vmcnt(0) lgkmcnt(0)\n\ts_barrier" ::: "memory");
#undef G_ITEM
#undef G_ENTRY
#undef G_QLOAD
}
#undef SBAR
#undef WAIT_BAR
}

#define XB_TMO      128
#define XB_XCNT(j)  (256  + 64 * (j))
#define XB_XSUB(j)  (1280 + 64 * (j))
#define XB_XGEN(j)  (2304 + 64 * (j))
#define XB_TOP      3328
#define XB_TOPGEN   3392
#define XCD_BAR_WORDS 3456
#define XB_SPIN_CAP (1u << 18)
__device__ __forceinline__ unsigned xb_ld(unsigned* p)              { return __hip_atomic_load(p, __ATOMIC_RELAXED, __HIP_MEMORY_SCOPE_AGENT); }
__device__ __forceinline__ unsigned xb_add(unsigned* p, unsigned v) { return __hip_atomic_fetch_add(p, v, __ATOMIC_RELAXED, __HIP_MEMORY_SCOPE_AGENT); }
__device__ __forceinline__ unsigned xb_xcc_id() { return (unsigned)__builtin_amdgcn_s_getreg((3 << 11) | 20) & 0xFu; }
#define XB_SPIN(cond, bar) do { unsigned _sp = 0; while (cond) { __builtin_amdgcn_s_sleep(1); \
    if ((++_sp & 255u) == 0u) { if (xb_ld(&(bar)[XB_TMO])) break; if (_sp > XB_SPIN_CAP) { atomicAdd(&(bar)[XB_TMO], 1u); break; } } } } while (0)
struct XcdBarrier { unsigned* bar; unsigned x; volatile LAS unsigned* st; };
__device__ __forceinline__ XcdBarrier xcd_barrier_post(unsigned* bar, volatile LAS unsigned* st) {
    XcdBarrier b; b.bar = bar; b.x = xb_xcc_id(); b.st = st;
    if (threadIdx.x == 0) (void)xb_add(&bar[XB_XCNT(b.x)], 1u);
    return b;
}
__device__ __forceinline__ void xcd_barrier_complete(unsigned* bar, unsigned x, unsigned& nloc, unsigned& nx) {
    const unsigned G = gridDim.x * gridDim.y * gridDim.z;
    unsigned sum, cnt, mine, sp = 0u;
    for (;;) {
        sum = 0u; cnt = 0u; mine = 0u;
#pragma unroll
        for (unsigned j = 0; j < 16; ++j) { const unsigned c = xb_ld(&bar[XB_XCNT(j)]); sum += c; cnt += (c > 0u) ? 1u : 0u; mine = (j == x) ? c : mine; }
        if (sum == G) break;
        __builtin_amdgcn_s_sleep(1);
        if ((++sp & 255u) == 0u) { if (xb_ld(&bar[XB_TMO])) break; if (sp > XB_SPIN_CAP) { atomicAdd(&bar[XB_TMO], 1u); break; } }
    }
    nloc = mine > 0u ? mine : 1u; nx = cnt > 0u ? cnt : 1u;
}
__device__ __forceinline__ void xcd_barrier_(const XcdBarrier& b);
__device__ __forceinline__ void xcd_barrier(const XcdBarrier& b) { T_BEGIN(1, t1_) xcd_barrier_(b); T_END(1, t1_); }
__device__ __forceinline__ void xcd_barrier_(const XcdBarrier& b) {
    asm volatile("s_waitcnt vmcnt(0)" ::: "memory");
    __syncthreads();
    if (threadIdx.x == 0) {
        unsigned* bar = b.bar;
        __builtin_amdgcn_s_waitcnt(0);
        unsigned nloc = b.st[0], nx = b.st[1];
        if (nloc == 0u) { xcd_barrier_complete(bar, b.x, nloc, nx); b.st[0] = nloc; b.st[1] = nx; }
        const unsigned old = xb_add(&bar[XB_XSUB(b.x)], 1u);
        const unsigned gen = old / nloc;
        if (old + 1u == (gen + 1u) * nloc) {
            __builtin_amdgcn_fence(__ATOMIC_RELEASE, "agent");
            asm volatile("s_waitcnt vmcnt(0)" ::: "memory");
            const unsigned og = xb_add(&bar[XB_TOP], 1u);
            const unsigned tg = og / nx;
            if (og + 1u == (tg + 1u) * nx) xb_add(&bar[XB_TOPGEN], 1u);
            else XB_SPIN(xb_ld(&bar[XB_TOPGEN]) == tg, bar);
            __builtin_amdgcn_fence(__ATOMIC_ACQUIRE, "agent");
            xb_add(&bar[XB_XGEN(b.x)], 1u);
            asm volatile("s_waitcnt vmcnt(0)" ::: "memory");
        } else {
            XB_SPIN(xb_ld(&bar[XB_XGEN(b.x)]) == gen, bar);
            __builtin_amdgcn_fence(__ATOMIC_ACQUIRE, "agent");
            asm volatile("s_waitcnt vmcnt(0)" ::: "memory");
        }
    }
    __syncthreads();
}

struct Args { const float* in[22]; float* out; unsigned char* ws; int ph_lo, ph_hi, li, flags; };
struct Frame {
    LAS unsigned char* lds; volatile LAS unsigned* MISC; gu32* ctl;
    int tid, lane, wave, vcu, G;
};
#ifndef SKEW_P2
#define SKEW_P2 0
#endif
#ifndef SKEW_P45
#define SKEW_P45 0
#endif
__device__ __forceinline__ void phase_skew(int vcu, unsigned ticks) {
    if (ticks) { const unsigned long long t0 = __builtin_amdgcn_s_memrealtime(), d = (unsigned long long)(vcu & 7) * ticks;
        while (__builtin_amdgcn_s_memrealtime() - t0 < d) __builtin_amdgcn_s_sleep(8); }
}
__device__ __forceinline__ int fresh_tid() { int t = threadIdx.x; asm volatile("" : "+v"(t)); return t; }
#define PHASE_IDS() do { F.tid = fresh_tid(); F.lane = F.tid & 63; F.wave = __builtin_amdgcn_readfirstlane(F.tid >> 6); } while (0)

__device__ __forceinline__ void transpose_item(const float* W, int ldw, int k0, int n0, bf16_t* WT, size_t row_off, int Kd, LAS float* scr, int lane) {
    const int half = lane >> 5, j2 = 2 * (lane & 31);
#pragma unroll 8
    for (int i = 0; i < 32; ++i) { const int kk = 2 * i + half; const f32x2 v = *(const f32x2*)(W + (size_t)(k0 + kk) * ldw + n0 + j2); scr[kk * 65 + j2] = v.x; scr[kk * 65 + j2 + 1] = v.y; }
    LDS_WAIT(); asm volatile("" ::: "memory");
    const int c = lane & 7;
#pragma unroll
    for (int j = 0; j < 8; ++j) { const int n = (lane >> 3) + 8 * j; const LAS float* s = scr + (8 * c) * 65 + n;
        u32x4 o; o.x = cvt_pk_bf16(s[0 * 65], s[1 * 65]); o.y = cvt_pk_bf16(s[2 * 65], s[3 * 65]); o.z = cvt_pk_bf16(s[4 * 65], s[5 * 65]); o.w = cvt_pk_bf16(s[6 * 65], s[7 * 65]);
        *(u32x4*)(WT + (row_off + n0 + n) * (size_t)Kd + k0 + 8 * c) = o; }
    LDS_WAIT(); asm volatile("" ::: "memory");
}

__global__ void __launch_bounds__(NWAVES * 64, 2) hybrid_fwd(Args args) {
    extern __shared__ __attribute__((aligned(16))) unsigned char lds_raw[];
    Frame F;
    F.lds = (LAS unsigned char*)lds_raw;
    F.MISC = (volatile LAS unsigned*)(F.lds + MISC_OFF);
    F.tid = threadIdx.x; F.lane = F.tid & 63; F.wave = __builtin_amdgcn_readfirstlane(F.tid >> 6);
    F.G = gridDim.x; { const int bx = blockIdx.x; F.vcu = (F.G % 8 == 0) ? (bx % 8) * (F.G / 8) + bx / 8 : bx; }
    unsigned char* ws = args.ws;
    F.ctl = (gu32*)(ws + WS_CTL);
    const float* x = args.in[0]; const float* cvec = args.in[1]; const float* ada_w = args.in[2]; const float* ada_b = args.in[3];
    const float* norm1_g = args.in[4]; const float* norm2_g = args.in[5]; const float* w_in = args.in[6]; const float* gmlp_ln_g = args.in[7]; const float* gmlp_ln_b = args.in[8];
    const float* w_spatial = args.in[9]; const float* b_spatial = args.in[10]; const float* w_branch_a = args.in[11]; const float* w_branch_b = args.in[12]; const float* w_out = args.in[13];
    const float* w_rg = args.in[14]; const float* b_rg = args.in[15]; const float* w_re = args.in[16]; const float* b_re = args.in[17];
    const float* w_gate = args.in[18]; const float* w_up = args.in[19]; const float* w_down = args.in[20]; const float* final_g = args.in[21];
    float* out = args.out;
    float* KSUM = (float*)(ws + WS_KSUM); float* MODP = (float*)(ws + WS_MODP); float* MOD = (float*)(ws + WS_MOD); float* ROPE = (float*)(ws + WS_ROPE);
    bf16_t* WST = (bf16_t*)(ws + WS_WST); bf16_t* WRT = (bf16_t*)(ws + WS_WRT); float* SSQ = (float*)(ws + WS_SSQ);
    unsigned long long* ROUTE = (unsigned long long*)(ws + WS_ROUTE);
    bf16_t* WIN = (bf16_t*)(ws + WS_WIN); bf16_t* WAB = (bf16_t*)(ws + WS_WAB); bf16_t* WOUT = (bf16_t*)(ws + WS_WOUT);
    bf16_t* WGU = (bf16_t*)(ws + WS_WGU); bf16_t* WD = (bf16_t*)(ws + WS_WD);
    bf16_t* XN = (bf16_t*)(ws + WS_XN); bf16_t* PROJ = (bf16_t*)(ws + WS_PROJ); bf16_t* HID = (bf16_t*)(ws + WS_HID); bf16_t* YB = (bf16_t*)(ws + WS_Y); bf16_t* X1 = (bf16_t*)(ws + WS_X1);
    bf16_t* PO = (bf16_t*)(ws + WS_PO); float* PML = (float*)(ws + WS_PML); unsigned short* LIST = (unsigned short*)(ws + WS_LIST); unsigned* CNT = (unsigned*)(F.ctl + CW_CNT);

    for (int u = F.tid; u < 256; u += NWAVES * 64) ((LAS unsigned*)(F.lds + MISC_OFF))[u] = 0u;
    __syncthreads();
    XcdBarrier bar; bar.bar = (unsigned*)(F.ctl + CW_BAR) + args.li * XCD_BAR_WORDS; bar.x = 0; bar.st = nullptr;
    if (!MK_PER_PHASE) bar = xcd_barrier_post((unsigned*)(F.ctl + CW_BAR) + args.li * XCD_BAR_WORDS, F.MISC + 8);
    const int lo = args.ph_lo, hi = args.ph_hi;
#define IN(k) (lo <= (k) && (k) < hi)
#define PH_SET(k) do { if (TSEL != 0 && blockIdx.x == TBLK && threadIdx.x == 0) g_tphase = (k); } while (0)
    if (TSEL != 0 && blockIdx.x == TBLK && threadIdx.x == 0) { g_tacc = 0; g_tphase = -2; }
#define SEAM(k) do { if (IN(k) && IN((k) + 1)) xcd_barrier(bar); } while (0)

    PH_SET(0); TP_BEGIN(0, tp0_) if (IN(0)) { PHASE_IDS();
        const int gw = F.vcu * NWAVES + F.wave, NGW = F.G * NWAVES;
        const int gtid = F.vcu * (NWAVES * 64) + F.tid, NGT = F.G * NWAVES * 64;
        LAS float* scr = (LAS float*)(F.lds + F.wave * 16640);
        constexpr int I_MOD = 16 * 24, I_IN = 16 * 72, I_A = 8 * 16, I_O = 16 * 16;
        constexpr int NITEMS = I_MOD + I_IN + 2 * I_A + I_O;
        for (int it = gw; it < NITEMS; it += NGW) {
            int r = it;
            if (r < I_MOD) {
                const int s = r / 24, nc = r % 24, n = nc * 256 + 4 * F.lane;
                f32x4 a0 = {0.f, 0.f, 0.f, 0.f}, a1 = a0, a2 = a0, a3 = a0;
#pragma unroll 8
                for (int kk = 0; kk < 64; ++kk) { const int k = 64 * s + kk; const f32x4 w = *(const f32x4*)(ada_w + (size_t)k * 6144 + n);
                    a0 += w * cvec[k]; a1 += w * cvec[1024 + k]; a2 += w * cvec[2048 + k]; a3 += w * cvec[3072 + k]; }
                float* dst = MODP + (size_t)s * 24576 + n;
                *(f32x4*)(dst) = a0; *(f32x4*)(dst + 6144) = a1; *(f32x4*)(dst + 12288) = a2; *(f32x4*)(dst + 18432) = a3;
                continue; }
            r -= I_MOD;
            if (r < I_IN) { transpose_item(w_in, PC, 64 * (r / 72), 64 * (r % 72), WIN, 0, 1024, scr, F.lane); continue; } r -= I_IN;
            if (r < I_A) { transpose_item(w_branch_a, 1024, 64 * (r / 16), 64 * (r % 16), WAB, 0, 1024, scr, F.lane); continue; } r -= I_A;
            if (r < I_A) { transpose_item(w_branch_b, 1024, 64 * (r / 16), 64 * (r % 16), WAB + 512, 0, 1024, scr, F.lane); continue; } r -= I_A;
            transpose_item(w_out, 1024, 64 * (r / 16), 64 * (r % 16), WOUT, 0, 1024, scr, F.lane);
        }
        for (int i = gtid; i < 65536; i += NGT) {
            const int pos = i >> 3, j = i & 7; const float inv = powf(500000.0f, -(float)j * 2.0f / 16.0f); const float ang = (float)pos * inv;
            ROPE[i] = cosf(ang); ROPE[65536 + i] = sinf(ang); }
        for (int i = gtid; i < 65536; i += NGT) {
            const int s = i & 127, t_ = (i >> 7) & 127; const float v = (s <= t_) ? w_spatial[i] : 0.f; WST[i] = (bf16_t)(cvt_pk_bf16(v, 0.f) & 0xffffu); }
        for (int i = gtid; i < 48 * 1024; i += NGT) {
            const int j = i >> 10, k = i & 1023; float v = 0.f; if (j < 4) v = w_rg[k * 4 + j]; else if (j < 36) v = w_re[k * 32 + (j - 4)];
            const unsigned hb = cvt_pk_bf16(v, 0.f) & 0xffffu; const float lo = v - bflo(hb);
            WRT[i] = (bf16_t)hb; WRT[48 * 1024 + i] = (bf16_t)(cvt_pk_bf16(lo, 0.f) & 0xffffu); }
    }
    TP_END(0, tp0_); SEAM(0);

    PH_SET(1); TP_BEGIN(1, tp1_) if (IN(1)) { PHASE_IDS();
        const int c = F.vcu, b = c >> 6;
        LAS float* f = (LAS float*)F.lds;
        for (int v = F.tid; v < 2048; v += NWAVES * 64) { float s = ada_b[v];
#pragma unroll
            for (int sl = 0; sl < 16; ++sl) s += MODP[(size_t)sl * 24576 + b * 6144 + v];
            f[v] = s; }
        if (F.tid < 96) { const int idx = 96 * c + F.tid; float s = ada_b[idx % 6144];
#pragma unroll
            for (int sl = 0; sl < 16; ++sl) s += MODP[(size_t)sl * 24576 + idx];
            MOD[idx] = s; }
        __syncthreads();
        f32x4 A1[4], B1[4];
#pragma unroll
        for (int j = 0; j < 4; ++j) { const int k = 4 * F.lane + 256 * j; const f32x4 g = *(const f32x4*)(norm1_g + k);
#pragma unroll
            for (int i = 0; i < 4; ++i) { A1[j][i] = g[i] * (1.0f + f[1024 + k + i]); B1[j][i] = f[k + i]; } }
        for (int i0 = 0; i0 < 16; i0 += 4) {
            f32x4 v[4][4]; float ss[4];
#pragma unroll
            for (int u_ = 0; u_ < 4; ++u_) { const size_t row = (size_t)c * 128 + F.wave * 16 + i0 + u_; const f32x4* xr = (const f32x4*)(x + row * DM) + F.lane;
#pragma unroll
                for (int j = 0; j < 4; ++j) v[u_][j] = xr[64 * j]; }
#pragma unroll
            for (int u_ = 0; u_ < 4; ++u_) { float s = 0.f;
#pragma unroll
                for (int j = 0; j < 4; ++j) s += (v[u_][j].x * v[u_][j].x + v[u_][j].y * v[u_][j].y) + (v[u_][j].z * v[u_][j].z + v[u_][j].w * v[u_][j].w);
                ss[u_] = s; }
#pragma unroll
            for (int o_ = 1; o_ < 64; o_ <<= 1) {
#pragma unroll
                for (int u_ = 0; u_ < 4; ++u_) ss[u_] += __shfl_xor(ss[u_], o_); }
#pragma unroll
            for (int u_ = 0; u_ < 4; ++u_) { const size_t row = (size_t)c * 128 + F.wave * 16 + i0 + u_; const float rstd = 1.0f / sqrtf(ss[u_] * (1.0f / DM) + EPS);
                u32x2* o8 = (u32x2*)(XN + row * DM) + F.lane;
#pragma unroll
                for (int j = 0; j < 4; ++j) { const f32x4 hv = v[u_][j] * rstd * A1[j] + B1[j]; u32x2 w; w.x = cvt_pk_bf16(hv.x, hv.y); w.y = cvt_pk_bf16(hv.z, hv.w); o8[64 * j] = w; } } }
        __syncthreads();
    }
    TP_END(1, tp1_); SEAM(1);

    PH_SET(2); TP_BEGIN(2, tp2_) if (IN(2)) {
        pg8::DenseSched S; S.init(XN, DM, WIN, DM, T, PC, F.G, (int)blockIdx.x);
        pg8::EpiProj E{PROJ, ROPE, KSUM};
        phase_skew(F.vcu, SKEW_P2);
        pg8::gemm_phase<pg8::EpiProj, pg8::DenseSched, false>(F.lds, S, E);
    }
    TP_END(2, tp2_); SEAM(2);

    PH_SET(3); TP_BEGIN(3, tp3_) if (IN(3)) { PHASE_IDS();
        for (int chunk = F.vcu; chunk < ((args.flags & 2) ? 0 : T / 128); chunk += F.G) {
            const int lane = F.lane, w = F.wave, q = lane >> 4, l15 = lane & 15;
            const size_t row0 = (size_t)chunk * 128;
            float lg[8], lb[8];
            { const f32x4 g0 = *(const f32x4*)(gmlp_ln_g + 8 * lane), g1 = *(const f32x4*)(gmlp_ln_g + 8 * lane + 4), b0 = *(const f32x4*)(gmlp_ln_b + 8 * lane), b1 = *(const f32x4*)(gmlp_ln_b + 8 * lane + 4);
#pragma unroll
              for (int j = 0; j < 4; ++j) { lg[j] = g0[j]; lg[4 + j] = g1[j]; lb[j] = b0[j]; lb[4 + j] = b1[j]; } }
            u32x4 vn[16];
#pragma unroll
            for (int i = 0; i < 16; ++i) vn[i] = *(const u32x4*)(PROJ + (row0 + 16 * w + i) * PC + C_V + 8 * lane);
#pragma unroll
            for (int hb = 0; hb < 16; hb += 8) {
                float s1[8], s2[8];
#pragma unroll
                for (int i = 0; i < 8; ++i) { const u32x4 raw = vn[hb + i];
                    u32x4 gv; gv.x = cvt_pk_bf16(gelu_tanh(bflo(raw.x)), gelu_tanh(bfhi(raw.x))); gv.y = cvt_pk_bf16(gelu_tanh(bflo(raw.y)), gelu_tanh(bfhi(raw.y)));
                    gv.z = cvt_pk_bf16(gelu_tanh(bflo(raw.z)), gelu_tanh(bfhi(raw.z))); gv.w = cvt_pk_bf16(gelu_tanh(bflo(raw.w)), gelu_tanh(bfhi(raw.w)));
                    const float v0 = bflo(gv.x), v1 = bfhi(gv.x), v2 = bflo(gv.y), v3 = bfhi(gv.y), v4 = bflo(gv.z), v5 = bfhi(gv.z), v6 = bflo(gv.w), v7 = bfhi(gv.w);
                    s1[i] = ((v0 + v1) + (v2 + v3)) + ((v4 + v5) + (v6 + v7)); s2[i] = ((v0 * v0 + v1 * v1) + (v2 * v2 + v3 * v3)) + ((v4 * v4 + v5 * v5) + (v6 * v6 + v7 * v7));
                    vn[hb + i] = gv; }
#pragma unroll
                for (int o_ = 1; o_ < 64; o_ <<= 1) {
#pragma unroll
                    for (int i = 0; i < 8; ++i) { s1[i] += __shfl_xor(s1[i], o_); s2[i] += __shfl_xor(s2[i], o_); } }
#pragma unroll
                for (int i = 0; i < 8; ++i) { const float mean = s1[i] * (1.0f / 512.0f); const float var = fmaxf(s2[i] * (1.0f / 512.0f) - mean * mean, 0.f); const float rstd = 1.0f / sqrtf(var + EPS);
                    const u32x4 gv = vn[hb + i]; float v[8] = {bflo(gv.x), bfhi(gv.x), bflo(gv.y), bfhi(gv.y), bflo(gv.z), bfhi(gv.z), bflo(gv.w), bfhi(gv.w)};
#pragma unroll
                    for (int j = 0; j < 8; ++j) v[j] = (v[j] - mean) * rstd * lg[j] + lb[j];
                    vn[hb + i].x = cvt_pk_bf16(v[0], v[1]); vn[hb + i].y = cvt_pk_bf16(v[2], v[3]); vn[hb + i].z = cvt_pk_bf16(v[4], v[5]); vn[hb + i].w = cvt_pk_bf16(v[6], v[7]); }
            }
            const int tt = 16 * w + l15;
            u32x2 wfr[4][2]; u32x4 uq[4];
#define GM_LOAD(WF, UQ, g_) do { const bf16_t* wp_ = WST + ((size_t)((g_) * 128 + tt)) * 128 + 4 * q; \
                _Pragma("unroll") for (int ks = 0; ks < 4; ++ks) { WF[ks][0] = *(const u32x2*)(wp_ + 32 * ks); WF[ks][1] = *(const u32x2*)(wp_ + 32 * ks + 16); } \
                _Pragma("unroll") for (int i = 0; i < 4; ++i) UQ[i] = *(const u32x4*)(PROJ + (row0 + 16 * w + 4 * i + q) * PC + C_U + 128 * (g_) + 8 * l15); } while (0)
            GM_LOAD(wfr, uq, 0);
#pragma unroll
            for (int g = 0; g < 4; ++g) {
                __syncthreads();
                if (q == g) {
#pragma unroll
                    for (int i = 0; i < 16; ++i) *(LAS u32x4*)(F.lds + (16 * w + i) * 288 + l15 * 16) = vn[i];
                }
                __syncthreads();
                u32x2 wfn[4][2]; u32x4 uqn[4];
                if (g < 3) GM_LOAD(wfn, uqn, g + 1);
                f32x4 acc[8];
#pragma unroll
                for (int it = 0; it < 8; ++it) acc[it] = (f32x4){0.f, 0.f, 0.f, 0.f};
                const int nks = (16 * w + 16 + 31) / 32;
#pragma unroll
                for (int ks = 0; ks < 4; ++ks) { if (ks < nks) {
                    const bf16x8 bw = __builtin_bit_cast(bf16x8, (u32x4){wfr[ks][0].x, wfr[ks][0].y, wfr[ks][1].x, wfr[ks][1].y});
                    const attn_body::lds_cptr base = (attn_body::lds_cptr)F.lds + (32 * ks + 4 * q + (l15 >> 2)) * 288 + (l15 & 3) * 8;
#pragma unroll
                    for (int it = 0; it < 8; ++it) {
                        const s16x4 lo = attn_body::vtr(base + it * 32), hi_ = attn_body::vtr(base + 16 * 288 + it * 32);
                        const bf16x8 a = (bf16x8){lo[0], lo[1], lo[2], lo[3], hi_[0], hi_[1], hi_[2], hi_[3]};
                        acc[it] = __builtin_amdgcn_mfma_f32_16x16x32_bf16(a, bw, acc[it], 0, 0, 0);
                    } } }
                const float bs = b_spatial[g * 128 + tt];
                LAS unsigned char* svb = F.lds + 36864;
#pragma unroll
                for (int it = 0; it < 8; ++it) { u32x2 o; o.x = cvt_pk_bf16(acc[it][0] + bs, acc[it][1] + bs); o.y = cvt_pk_bf16(acc[it][2] + bs, acc[it][3] + bs);
                    *(LAS u32x2*)(svb + tt * 272 + (16 * it + 4 * q) * 2) = o; }
                LDS_WAIT(); asm volatile("" ::: "memory");
#pragma unroll
                for (int i = 0; i < 4; ++i) { const int tr_ = 16 * w + 4 * i + q; bf16_t* pp = PROJ + (row0 + tr_) * PC + C_U + 128 * g + 8 * l15;
                    const u32x4 uu = uq[i]; const u32x4 sv = *(const LAS u32x4*)(svb + tr_ * 272 + l15 * 16);
                    u32x4 o; o.x = cvt_pk_bf16(gelu_tanh(bflo(uu.x)) * bflo(sv.x), gelu_tanh(bfhi(uu.x)) * bfhi(sv.x)); o.y = cvt_pk_bf16(gelu_tanh(bflo(uu.y)) * bflo(sv.y), gelu_tanh(bfhi(uu.y)) * bfhi(sv.y));
                    o.z = cvt_pk_bf16(gelu_tanh(bflo(uu.z)) * bflo(sv.z), gelu_tanh(bfhi(uu.z)) * bfhi(sv.z)); o.w = cvt_pk_bf16(gelu_tanh(bflo(uu.w)) * bflo(sv.w), gelu_tanh(bfhi(uu.w)) * bfhi(sv.w));
                    *(u32x4*)pp = o; }
                LDS_WAIT(); asm volatile("" ::: "memory");
                if (g < 3) {
#pragma unroll
                    for (int ks = 0; ks < 4; ++ks) { wfr[ks][0] = wfn[ks][0]; wfr[ks][1] = wfn[ks][1]; }
#pragma unroll
                    for (int i = 0; i < 4; ++i) uq[i] = uqn[i]; }
            }
            __syncthreads();
        }
        {
            using namespace attn_body;
            const int s = F.vcu & 7, bh = F.vcu >> 3;
            const bf16* Qp = (const bf16*)(PROJ + C_Q); const bf16* Kp = (const bf16*)(PROJ + C_K); const bf16* Vp = (const bf16*)(PROJ + C_VV);
#define QBI(i) (((i) == 0) ? s : ((i) == 1) ? 15 - s : ((i) == 2) ? 16 + s : 31 - s)
            if (ATTN_MODE != 0) {
                if (bh < NB * 8 && !(args.flags & 4)) for (int i = 0; i < 4; ++i) select_unit(bh >> 3, bh & 7, QBI(i), Qp, KSUM, LIST, CNT, (char*)lds_raw + 40960);
                TP_END(3, tp3_);
                if (!MK_PER_PHASE) xcd_barrier(bar);
                PH_SET(31); TP_BEGIN(31, tp31_)
                unsigned long long tg0_ = 0; if (TSEL >= 5 && TSEL <= 7) tg0_ = __builtin_amdgcn_s_memrealtime();
                if (!(args.flags & 8)) gather_phase<8>((char*)lds_raw, Qp, Kp, Vp, LIST, CNT, PO, PML, F.vcu, F.G, (args.flags & 1) == 0);
                TP_END(31, tp31_);
                if (TSEL >= 5 && TSEL <= 7) { if (threadIdx.x == 0) __hip_atomic_store(&g_tw[F.vcu], (unsigned)(__builtin_amdgcn_s_memrealtime() - tg0_), __ATOMIC_RELAXED, __HIP_MEMORY_SCOPE_AGENT); }
                if (!MK_PER_PHASE) xcd_barrier(bar);
                if (TSEL == 5 || TSEL == 6) { if (blockIdx.x == TBLK && threadIdx.x == 0) { unsigned mx = 0, am = 0; for (int i = 0; i < 256; ++i) { const unsigned t_ = __hip_atomic_load(&g_tw[i], __ATOMIC_RELAXED, __HIP_MEMORY_SCOPE_AGENT); if (t_ > mx) { mx = t_; am = i; } }
                    g_tacc += (TSEL == 5) ? mx : am * 100u; } }
                if (TSEL == 7) { if (blockIdx.x == 0 && threadIdx.x == 0) g_tacc += __hip_atomic_load(&g_tw[TVCU], __ATOMIC_RELAXED, __HIP_MEMORY_SCOPE_AGENT); }
                PH_SET(32);
                bf16* Op = (bf16*)(PROJ + (ATTN_MODE == 2 ? C_V : C_Q));
                TP_BEGIN(32, tp32_)
                if (bh < NB * 8 && !(args.flags & 16)) for (int i = 0; i < 4; ++i) attn_unit<8, true>(bh >> 3, bh & 7, QBI(i), Qp, Kp, Vp, Op, KSUM, (char*)lds_raw, (args.flags & 1) == 0, PO, PML);
                TP_END(32, tp32_);
            }
            if (ATTN_MODE == 0) {
                if (bh < NB * 8) for (int i = 0; i < 4; ++i) attn_unit<8, false>(bh >> 3, bh & 7, QBI(i), Qp, Kp, Vp, (bf16*)(PROJ + C_Q), KSUM, (char*)lds_raw, (args.flags & 1) == 0, PO, PML);
            }
#undef QBI
#undef GM_LOAD
        }
        VM_WAIT(); __syncthreads();
    }
    SEAM(3);

    PH_SET(4); TP_BEGIN(4, tp4_) if (IN(4)) {
        pg8::DenseSched S; S.init(PROJ + C_U, PC, WAB, 1024, T, DM, F.G, (int)blockIdx.x); S.ksplit = 8; S.kgap = (unsigned)(C_Q - C_U - 512) * 2u;
        pg8::EpiMergeF E{PROJ, XN};
        phase_skew(F.vcu, SKEW_P45);
        pg8::gemm_phase<pg8::EpiMergeF, pg8::DenseSched, false>(F.lds, S, E);
    }
    TP_END(4, tp4_); SEAM(4);

    PH_SET(5); TP_BEGIN(5, tp5_) if (IN(5)) {
        pg8::DenseSched S; S.init(XN, DM, WOUT, DM, T, DM, F.G, (int)blockIdx.x); pg8::EpiOut E{x, X1, MOD, SSQ};
        phase_skew(F.vcu, SKEW_P45);
        pg8::gemm_phase<pg8::EpiOut, pg8::DenseSched, false>(F.lds, S, E);
    }
    TP_END(5, tp5_); SEAM(5);

    PH_SET(6); TP_BEGIN(6, tp6_) if (IN(6)) { PHASE_IDS();
        {
            LAS float* scr = (LAS float*)(F.lds + F.wave * 16640);
            const int gw = F.vcu * NWAVES + F.wave, NGW = F.G * NWAVES;
            constexpr int I_G = 32 * 16 * 8, I_D = 32 * 8 * 16;
            for (int it = gw; it < 2 * I_G + I_D; it += NGW) { int r = it;
                if (r < 2 * I_G) { const bool up = r >= I_G; if (up) r -= I_G; const int e = r / 128, kb = (r % 128) / 8, nb = r % 8, n0 = 64 * nb;
                    const size_t row_off = (size_t)e * 1024 + (size_t)(n0 / 128) * 256 + (up ? 128 : 0) + (n0 % 128) - n0;
                    transpose_item((up ? w_up : w_gate) + (size_t)e * 1024 * 512, 512, 64 * kb, n0, WGU, row_off, 1024, scr, F.lane); continue; }
                r -= 2 * I_G;
                { const int e = r / 128, kb = (r % 128) / 16, nb = r % 16; transpose_item(w_down + (size_t)e * 512 * 1024, 1024, 64 * kb, 64 * nb, WD, (size_t)e * 1024, 512, scr, F.lane); } }
            __syncthreads();
        }
        TP_END(6, tp6_);
        TP_BEGIN(61, tp61_)
        const int c = F.vcu, b = c >> 6, lane = F.lane, w = F.wave, r = lane & 15, q = lane >> 4;
        constexpr int WPITCH = 1056, WPLANE = 48 * WPITCH, WL_OFF = 8192, LG_OFF = WL_OFF + 2 * WPLANE, HI_OFF = LG_OFF + 8 * 3072;
        static_assert(HI_OFF + 512 <= MISC_OFF, "P6 LDS map");
        LAS float* A2 = (LAS float*)F.lds; LAS float* B2 = A2 + 1024; LAS float* LG = (LAS float*)(F.lds + LG_OFF) + w * 768;
        LAS unsigned* hist = (LAS unsigned*)(F.lds + HI_OFF); LAS unsigned* basev = hist + 32;
        for (int k = F.tid; k < 1024; k += NWAVES * 64) { A2[k] = norm2_g[k] * (1.0f + MOD[b * 6144 + 4096 + k]); B2[k] = MOD[b * 6144 + 3072 + k]; }
        if (F.tid < 32) hist[F.tid] = 0u;
        const size_t row = (size_t)c * 128 + w * 16 + r;
        float rs;
        { const f32x4* sp = (const f32x4*)(SSQ + row * 16); const f32x4 s0 = sp[0], s1 = sp[1], s2 = sp[2], s3 = sp[3];
          const float ss = ((s0[0] + s0[1]) + (s0[2] + s0[3])) + ((s1[0] + s1[1]) + (s1[2] + s1[3])) + ((s2[0] + s2[1]) + (s2[2] + s2[3])) + ((s3[0] + s3[1]) + (s3[2] + s3[3]));
          rs = 1.0f / sqrtf(ss * (1.0f / DM) + EPS); }
        f32x4 acc[3];
#pragma unroll
        for (int jt = 0; jt < 3; ++jt) acc[jt] = (f32x4){0.f, 0.f, 0.f, 0.f};
        const bf16_t* xrow = X1 + row * DM;
        for (int hf = 0; hf < 2; ++hf) {
            __syncthreads();
#pragma unroll
            for (int ps = 0; ps < 12; ++ps) { const int idx = ps * 512 + F.tid, rw = idx >> 6, c16 = idx & 63;
                const u32x4 v = *(const u32x4*)(WRT + (size_t)rw * 1024 + hf * 512 + c16 * 8);
                *(LAS u32x4*)(F.lds + WL_OFF + (rw / 48) * WPLANE + (rw % 48) * WPITCH + c16 * 16) = v; }
            __syncthreads();
#pragma unroll 4
            for (int s_ = 0; s_ < 16; ++s_) { const int k0 = 512 * hf + 32 * s_ + 8 * q;
                const u32x4 xr = *(const u32x4*)(xrow + k0);
                const f32x4 x0 = {bflo(xr.x), bfhi(xr.x), bflo(xr.y), bfhi(xr.y)}, x1v = {bflo(xr.z), bfhi(xr.z), bflo(xr.w), bfhi(xr.w)};
                const f32x4 a0 = *(const LAS f32x4*)(A2 + k0), a1 = *(const LAS f32x4*)(A2 + k0 + 4), b0 = *(const LAS f32x4*)(B2 + k0), b1 = *(const LAS f32x4*)(B2 + k0 + 4);
                const f32x4 h0 = x0 * rs * a0 + b0, h1 = x1v * rs * a1 + b1;
                u32x4 hw; hw.x = cvt_pk_bf16(h0[0], h0[1]); hw.y = cvt_pk_bf16(h0[2], h0[3]); hw.z = cvt_pk_bf16(h1[0], h1[1]); hw.w = cvt_pk_bf16(h1[2], h1[3]);
                *(u32x4*)(XN + row * DM + k0) = hw;
                u32x4 lw; lw.x = cvt_pk_bf16(h0[0] - bflo(hw.x), h0[1] - bfhi(hw.x)); lw.y = cvt_pk_bf16(h0[2] - bflo(hw.y), h0[3] - bfhi(hw.y));
                lw.z = cvt_pk_bf16(h1[0] - bflo(hw.z), h1[1] - bfhi(hw.z)); lw.w = cvt_pk_bf16(h1[2] - bflo(hw.w), h1[3] - bfhi(hw.w));
                const bf16x8 hb = __builtin_bit_cast(bf16x8, hw), hl = __builtin_bit_cast(bf16x8, lw);
#pragma unroll
                for (int jt = 0; jt < 3; ++jt) { const LAS unsigned char* wp = F.lds + WL_OFF + (16 * jt + r) * WPITCH + (32 * s_ + 8 * q) * 2;
                    const bf16x8 wf = *(const LAS bf16x8*)wp, wl = *(const LAS bf16x8*)(wp + WPLANE);
                    acc[jt] = __builtin_amdgcn_mfma_f32_16x16x32_bf16(wf, hb, acc[jt], 0, 0, 0);
                    acc[jt] = __builtin_amdgcn_mfma_f32_16x16x32_bf16(wf, hl, acc[jt], 0, 0, 0);
                    acc[jt] = __builtin_amdgcn_mfma_f32_16x16x32_bf16(wl, hb, acc[jt], 0, 0, 0); } }
        }
#pragma unroll
        for (int jt = 0; jt < 3; ++jt) *(LAS f32x4*)(LG + r * 48 + 16 * jt + 4 * q) = acc[jt];
        LDS_WAIT(); asm volatile("" ::: "memory");
        int E0 = 0, E1 = 0; float w0 = 0.f, w1 = 0.f; unsigned lp0 = 0u, lp1 = 0u;
        if (lane < 16) {
            const LAS float* lgp = LG + lane * 48;
            float gl[4];
#pragma unroll
            for (int j = 0; j < 4; ++j) gl[j] = lgp[j] + b_rg[j];
            int g = 0; float gm = gl[0];
#pragma unroll
            for (int j = 1; j < 4; ++j) if (gl[j] > gm) { gm = gl[j]; g = j; }
            float gs = 0.f;
#pragma unroll
            for (int j = 0; j < 4; ++j) gs += __expf(gl[j] - gm);
            const float gp = 1.0f / gs;
            float m0 = -INFINITY, m1 = -INFINITY; int i0 = 0, i1 = 0;
#pragma unroll
            for (int j = 0; j < 8; ++j) { const float el = lgp[4 + 8 * g + j] + b_re[g * 8 + j];
                if (el > m0) { m1 = m0; i1 = i0; m0 = el; i0 = j; } else if (el > m1) { m1 = el; i1 = j; } }
            const float d = __expf(m1 - m0), inv = 1.0f / (1.0f + d);
            w0 = gp * inv; w1 = gp * d * inv; E0 = 8 * g + i0; E1 = 8 * g + i1;
            lp0 = __hip_atomic_fetch_add(hist + E0, 1u, __ATOMIC_RELAXED, __HIP_MEMORY_SCOPE_WORKGROUP);
            lp1 = __hip_atomic_fetch_add(hist + E1, 1u, __ATOMIC_RELAXED, __HIP_MEMORY_SCOPE_WORKGROUP);
        }
        __syncthreads();
        if (F.tid < 32) { const unsigned n = hist[F.tid]; basev[F.tid] = n ? __hip_atomic_fetch_add((unsigned*)(F.ctl + CW_CURSOR + 64 * F.tid), n, RLX_AGENT) : 0u; }
        __syncthreads();
        if (lane < 16) { const unsigned tok = (unsigned)(c * 128 + w * 16 + lane);
            ROUTE[(size_t)E0 * 32768 + basev[E0] + lp0] = ((unsigned long long)__float_as_uint(w0) << 32) | (unsigned long long)(2u * tok);
            ROUTE[(size_t)E1 * 32768 + basev[E1] + lp1] = ((unsigned long long)__float_as_uint(w1) << 32) | (unsigned long long)(2u * tok + 1u); }
        __syncthreads();
        TP_END(61, tp61_);
    }
    SEAM(6);

    PH_SET(7); TP_BEGIN(7, tp7_) if (IN(7) || IN(8)) { PHASE_IDS();
        volatile LAS int* tab = (volatile LAS int*)(F.lds + MISC_OFF + 256);
        if (F.tid < 32) tab[F.tid] = (int)__hip_atomic_load((unsigned*)(F.ctl + CW_CURSOR + 64 * F.tid), RLX_AGENT);
        __syncthreads();
        if (F.tid == 0) { int o = 0; for (int e = 0; e < 32; ++e) { tab[32 + e] = o; o += (tab[e] + 255) >> 8; } tab[64] = o; }
        __syncthreads();
        const int U = 4 * __builtin_amdgcn_readfirstlane(tab[64]);
        const int xq = F.vcu >> 5, jj = F.vcu & 31;
        pg8::MoeSched S; S.tab = tab; S.start = (int)(((long)U * xq) / 8); S.end = (int)(((long)U * (xq + 1)) / 8); S.j = jj; S.route = ROUTE; S.ready = (unsigned*)(F.ctl + CW_READY);
        if (IN(7)) {
            S.A = (const char*)XN; S.lda = DM; S.K = DM; S.Bt = (const char*)WGU; S.bstride = (size_t)1024 * 1024 * 2; S.gather = true; S.mode = 1;
            pg8::EpiGU E{HID};
            pg8::gemm_phase<pg8::EpiGU, pg8::MoeSched, true>(F.lds, S, E);
        }
        TP_END(7, tp7_);
        PH_SET(8); TP_BEGIN(8, tp8_) if (IN(8)) {
            S.A = (const char*)HID; S.lda = DEXP; S.K = DEXP; S.Bt = (const char*)WD; S.bstride = (size_t)1024 * 512 * 2; S.gather = false; S.mode = 2; S.j = (jj + 24) & 31; S.qhead = (unsigned*)(F.ctl + CW_QHEAD + 64 * xq); S.qslot = (volatile LAS int*)(F.lds + MISC_OFF + 640);
            pg8::EpiDown E{YB, ROUTE};
            pg8::gemm_phase<pg8::EpiDown, pg8::MoeSched, false>(F.lds, S, E);
        }
        TP_END(8, tp8_);
    }
    SEAM(8);

    PH_SET(9); TP_BEGIN(9, tp9_) if (IN(9)) { PHASE_IDS();
        const int c = F.vcu, b = c >> 6;
        f32x4 G2[4], FG[4];
#pragma unroll
        for (int j = 0; j < 4; ++j) { const int k = 4 * F.lane + 256 * j; G2[j] = *(const f32x4*)(MOD + b * 6144 + 5120 + k); FG[j] = *(const f32x4*)(final_g + k); }
        for (int i0 = 0; i0 < 16; i0 += 4) {
            u32x2 ya[4][4], yb[4][4], xx[4][4]; f32x4 v[4][4]; float ss[4];
#pragma unroll
            for (int u_ = 0; u_ < 4; ++u_) { const size_t row = (size_t)c * 128 + F.wave * 16 + i0 + u_;
                const u32x2* xb = (const u32x2*)(X1 + row * DM) + F.lane; const u32x2* y0 = (const u32x2*)(YB + (2 * row) * DM) + F.lane; const u32x2* y1 = (const u32x2*)(YB + (2 * row + 1) * DM) + F.lane;
#pragma unroll
                for (int j = 0; j < 4; ++j) { ya[u_][j] = y0[64 * j]; yb[u_][j] = y1[64 * j]; xx[u_][j] = xb[64 * j]; } }
#pragma unroll
            for (int u_ = 0; u_ < 4; ++u_) { float s = 0.f;
#pragma unroll
                for (int j = 0; j < 4; ++j) { const u32x2 a = ya[u_][j], bb = yb[u_][j], x_ = xx[u_][j]; const f32x4 ys = {bflo(a.x) + bflo(bb.x), bfhi(a.x) + bfhi(bb.x), bflo(a.y) + bflo(bb.y), bfhi(a.y) + bfhi(bb.y)};
                    const f32x4 xv = {bflo(x_.x), bfhi(x_.x), bflo(x_.y), bfhi(x_.y)};
                    v[u_][j] = xv + G2[j] * ys; s += (v[u_][j].x * v[u_][j].x + v[u_][j].y * v[u_][j].y) + (v[u_][j].z * v[u_][j].z + v[u_][j].w * v[u_][j].w); }
                ss[u_] = s; }
#pragma unroll
            for (int o_ = 1; o_ < 64; o_ <<= 1) {
#pragma unroll
                for (int u_ = 0; u_ < 4; ++u_) ss[u_] += __shfl_xor(ss[u_], o_); }
#pragma unroll
            for (int u_ = 0; u_ < 4; ++u_) { const size_t row = (size_t)c * 128 + F.wave * 16 + i0 + u_; f32x4* xr = (f32x4*)(out + row * DM) + F.lane;
                const float rstd = 1.0f / sqrtf(ss[u_] * (1.0f / DM) + EPS);
#pragma unroll
                for (int j = 0; j < 4; ++j) xr[64 * j] = v[u_][j] * rstd * FG[j]; } }
    }
    TP_END(9, tp9_);
    if (TSEL >= 10 && TSEL <= 12 && blockIdx.x == TBLK && threadIdx.x == 0) { unsigned mx = 0, am = 0; unsigned long long sm = 0;
        for (int i = 0; i < 256; ++i) { const unsigned t_ = __hip_atomic_load(&g_tw[i], __ATOMIC_RELAXED, __HIP_MEMORY_SCOPE_AGENT); sm += t_; if (t_ > mx) { mx = t_; am = i; } }
        g_tacc += (TSEL == 10) ? mx : (TSEL == 11) ? am * 100u : (unsigned)(sm / 256); }
    if (TSEL != 0 && blockIdx.x == TBLK && threadIdx.x == 0) { const unsigned long long t0 = __builtin_amdgcn_s_memrealtime(), d = g_tacc * TMULT; while (__builtin_amdgcn_s_memrealtime() - t0 < d) __builtin_amdgcn_s_sleep(16); }
#undef IN
#undef SEAM
}


#if ATTN_MODE == 2
__global__ void __launch_bounds__(NWAVES * 64, 2) dbg_dense(Args args, int stage) {
    extern __shared__ __attribute__((aligned(16))) unsigned char lds_raw[];
    using namespace attn_body;
    unsigned char* ws = args.ws; bf16_t* PROJ = (bf16_t*)(ws + WS_PROJ); float* KSUM = (float*)(ws + WS_KSUM); gu32* ctl = (gu32*)(ws + WS_CTL);
    const int G = gridDim.x, bx = blockIdx.x, vcu = (bx % 8) * (G / 8) + bx / 8, tid = threadIdx.x, lane = tid & 63, wave = tid >> 6;
    if (stage == 0) {
        const int s = vcu & 7, bh = vcu >> 3;
        for (int i = 0; i < 4; ++i) { const int qb = (i == 0) ? s : (i == 1) ? 15 - s : (i == 2) ? 16 + s : 31 - s;
            attn_unit<8, false>(bh >> 3, bh & 7, qb, (const bf16*)(PROJ + C_Q), (const bf16*)(PROJ + C_K), (const bf16*)(PROJ + C_VV), (bf16*)(PROJ + C_Q), KSUM, (char*)lds_raw, true, nullptr, nullptr); }
    } else {
        float md = 0.f;
        for (int i = 0; i < 16; ++i) { const size_t row = (size_t)vcu * 128 + wave * 16 + i;
            const u32x4 a = *(const u32x4*)(PROJ + row * PC + C_V + 8 * lane), bq = *(const u32x4*)(PROJ + row * PC + C_Q + 8 * lane);
            md = fmaxf(md, fmaxf(fmaxf(fabsf(bflo(a.x) - bflo(bq.x)), fabsf(bfhi(a.x) - bfhi(bq.x))), fmaxf(fabsf(bflo(a.y) - bflo(bq.y)), fabsf(bfhi(a.y) - bfhi(bq.y)))));
            md = fmaxf(md, fmaxf(fmaxf(fabsf(bflo(a.z) - bflo(bq.z)), fabsf(bfhi(a.z) - bfhi(bq.z))), fmaxf(fabsf(bflo(a.w) - bflo(bq.w)), fabsf(bfhi(a.w) - bfhi(bq.w))))); }
#pragma unroll
        for (int o_ = 1; o_ < 64; o_ <<= 1) md = fmaxf(md, __shfl_xor(md, o_));
        if (lane == 0) atomicMax((unsigned*)(ctl + CW_DIFF), __float_as_uint(md));
    }
}
#endif
extern "C" void kernel_launch(void* const* d_in, const int* in_sizes, int n_in, void* d_out, int out_size, void* d_ws, size_t ws_size, hipStream_t stream) {
    static int grid = 0;
    if (grid == 0) {
        if (n_in != 22 || in_sizes[0] != T * DM || out_size != T * DM || ws_size < WS_END) { fprintf(stderr, "kernel_launch: unexpected shapes (n_in %d, in0 %d, out %d, ws %zu); nothing launched\n", n_in, n_in > 0 ? in_sizes[0] : -1, out_size, ws_size); grid = -1; return; }
        int dev = 0, cus = 0, per_cu = 0;
        if (hipGetDevice(&dev) != hipSuccess || hipDeviceGetAttribute(&cus, hipDeviceAttributeMultiprocessorCount, dev) != hipSuccess) { fprintf(stderr, "kernel_launch: device query failed\n"); grid = -1; return; }
        if (hipFuncSetAttribute((const void*)hybrid_fwd, hipFuncAttributeMaxDynamicSharedMemorySize, LDS_BYTES) != hipSuccess) { fprintf(stderr, "kernel_launch: hipFuncSetAttribute failed\n"); grid = -1; return; }
        if (hipOccupancyMaxActiveBlocksPerMultiprocessor(&per_cu, (const void*)hybrid_fwd, NWAVES * 64, LDS_BYTES) != hipSuccess || per_cu < 1) { fprintf(stderr, "kernel_launch: occupancy query reports %d blocks per CU\n", per_cu); }
        (void)hipGetLastError();
        if (cus != 256) { fprintf(stderr, "kernel_launch: built for 256 CUs, device has %d; nothing launched\n", cus); grid = -1; return; }
        grid = cus;
    }
    if (grid < 0) return;
    (void)hipMemsetAsync((char*)d_ws + WS_CTL, 0, CTL_ZERO_BYTES, stream);
    Args a{};
    for (int i = 0; i < 22; ++i) a.in[i] = (const float*)d_in[i];
    a.out = (float*)d_out; a.ws = (unsigned char*)d_ws;
    struct Spec { int lo, hi, flags; };
#if MK_PER_PHASE
    const Spec specs[10] = {{0,1,0},{1,2,0},{2,3,0},{3,4,0},{4,5,0},{5,6,0},{6,7,0},{7,8,0},{8,9,0},{9,10,0}}; const int nspec = 10;
#elif PROBE_ID == 1
    const Spec specs[2] = {{0,10,0},{0,2,0}}; const int nspec = 2;
#elif PROBE_ID == 2
    const Spec specs[2] = {{0,10,0},{2,3,0}}; const int nspec = 2;
#elif PROBE_ID == 3
    const Spec specs[3] = {{0,4,0},{3,4,1|2|4|16},{4,10,0}}; const int nspec = 3;
#elif PROBE_ID == 10
    const Spec specs[3] = {{0,4,0},{3,4,1|2|4|8},{4,10,0}}; const int nspec = 3;
#elif PROBE_ID == 11
    const Spec specs[3] = {{0,4,0},{3,4,1|2|8|16},{4,10,0}}; const int nspec = 3;
#elif PROBE_ID == 12
    const Spec specs[3] = {{0,4,0},{3,4,1|2|4|8|16},{4,10,0}}; const int nspec = 3;
#elif PROBE_ID == 13
    const Spec specs[2] = {{0,10,0},{3,4,1|4|8|16}}; const int nspec = 2;
#elif PROBE_ID == 4
    const Spec specs[3] = {{0,4,0},{4,5,0},{4,10,0}}; const int nspec = 3;
#elif PROBE_ID == 5
    const Spec specs[3] = {{0,5,0},{5,6,0},{5,10,0}}; const int nspec = 3;
#elif PROBE_ID == 6
    const Spec specs[2] = {{0,10,0},{7,8,0}}; const int nspec = 2;
#elif PROBE_ID == 7
    const Spec specs[2] = {{0,10,0},{8,9,0}}; const int nspec = 2;
#elif PROBE_ID == 14
    const Spec specs[2] = {{0,10,0},{7,9,0}}; const int nspec = 2;
#elif PROBE_ID == 15
    const Spec specs[2] = {{0,10,0},{9,10,0}}; const int nspec = 2;
#elif PROBE_ID == 16
    const Spec specs[2] = {{0,10,0},{6,7,0}}; const int nspec = 2;
#elif PROBE_ID == 8
    const Spec specs[2] = {{0,5,0},{5,10,0}}; const int nspec = 2;
#elif PROBE_ID == 9
    const Spec specs[2] = {{0,10,0},{0,1,0}}; const int nspec = 2;
#else
    const Spec specs[1] = {{0,10,0}}; const int nspec = 1;
#endif
#if ATTN_MODE == 2
    (void)hipFuncSetAttribute((const void*)dbg_dense, hipFuncAttributeMaxDynamicSharedMemorySize, LDS_BYTES);
    a.ph_lo = 0; a.ph_hi = 4; a.flags = 0; a.li = 0; hipLaunchKernelGGL(hybrid_fwd, dim3(grid), dim3(NWAVES * 64), LDS_BYTES, stream, a);
    hipLaunchKernelGGL(dbg_dense, dim3(grid), dim3(NWAVES * 64), LDS_BYTES, stream, a, 0);
    hipLaunchKernelGGL(dbg_dense, dim3(grid), dim3(NWAVES * 64), LDS_BYTES, stream, a, 1);
    a.ph_lo = 4; a.ph_hi = 10; a.li = 1; hipLaunchKernelGGL(hybrid_fwd, dim3(grid), dim3(NWAVES * 64), LDS_BYTES, stream, a);
    (void)nspec; (void)specs;
#else
    for (int li = 0; li < nspec; ++li) { a.ph_lo = specs[li].lo; a.ph_hi = specs[li].hi; a.flags = specs[li].flags; a.li = MK_PER_PHASE ? 0 : li;
        hipLaunchKernelGGL(hybrid_fwd, dim3(grid), dim3(NWAVES * 64), LDS_BYTES, stream, a); }
#endif
    const hipError_t le = hipPeekAtLastError();
    if (le != hipSuccess) fprintf(stderr, "kernel_launch: launch failed: %s\n", hipGetErrorName(le));
}
```

```cpp
#include <hip/hip_runtime.h>
#include <hip/hip_bf16.h>
#include <cstdio>
#include <cstdint>
#include <cmath>

#ifndef PROBE_ID
#define PROBE_ID 0
#endif
#ifndef ATTN_MODE
#define ATTN_MODE 1
#endif
#ifndef GPROBE
#define GPROBE 0
#endif
#ifndef TSEL
#define TSEL 0
#endif
#ifndef TPH
#define TPH -1
#endif
#ifndef TBLK
#define TBLK 0
#endif
#ifndef TVCU
#define TVCU 255
#endif
#define TMULT 8
__device__ unsigned long long g_tacc; __device__ int g_tphase; __device__ unsigned g_tw[256];
#define T_ON(k) (TSEL == (k) && blockIdx.x == TBLK && threadIdx.x == 0 && (TPH < 0 || g_tphase == TPH))
#define T_BEGIN(k, var) unsigned long long var = 0; if (TSEL == (k)) { if (T_ON(k)) var = __builtin_amdgcn_s_memrealtime(); }
#define T_END(k, var) do { if (TSEL == (k)) { if (T_ON(k)) g_tacc += __builtin_amdgcn_s_memrealtime() - var; } } while (0)
#define TP_BEGIN(ph, var) unsigned long long var = 0; if (TSEL == 4 && TPH == (ph)) { if (blockIdx.x == TBLK && threadIdx.x == 0) var = __builtin_amdgcn_s_memrealtime(); } \
        if (TSEL >= 10 && TSEL <= 12 && TPH == (ph)) { if (threadIdx.x == 0) var = __builtin_amdgcn_s_memrealtime(); }
#define TP_END(ph, var) do { if (TSEL == 4 && TPH == (ph)) { if (blockIdx.x == TBLK && threadIdx.x == 0) g_tacc += __builtin_amdgcn_s_memrealtime() - var; } \
        if (TSEL >= 10 && TSEL <= 12 && TPH == (ph)) { if (threadIdx.x == 0) __hip_atomic_store(&g_tw[(blockIdx.x % 8) * 32 + blockIdx.x / 8], (unsigned)(__builtin_amdgcn_s_memrealtime() - var), __ATOMIC_RELAXED, __HIP_MEMORY_SCOPE_AGENT); } } while (0)
#ifndef MK_PER_PHASE
#define MK_PER_PHASE 0
#endif

#define LAS __attribute__((address_space(3)))
#define GAS __attribute__((address_space(1)))
typedef unsigned short bf16_t;
typedef short bf16x8 __attribute__((ext_vector_type(8)));
typedef short s16x4 __attribute__((ext_vector_type(4)));
typedef float f32x2 __attribute__((ext_vector_type(2)));
typedef float f32x4 __attribute__((ext_vector_type(4)));
typedef float f32x16 __attribute__((ext_vector_type(16)));
typedef unsigned u32x2 __attribute__((ext_vector_type(2)));
typedef unsigned u32x4 __attribute__((ext_vector_type(4)));
typedef GAS unsigned gu32;

constexpr int NB = 4, SEQ = 8192, DM = 1024, T = NB * SEQ;
constexpr int PC = 4608;
constexpr int C_U = 0, C_V = 512, C_Q = 1024, C_K = 1536, C_VV = 2048, C_GA = 2560, C_GB = 3584;
constexpr int NEXP = 32, DEXP = 512;
constexpr float EPS = 1e-6f;
constexpr float QSCALE = 0.125f * 1.4426950408889634f;

constexpr size_t MiB = 1u << 20;
constexpr size_t WS_CTL = 0, CTL_ZERO_BYTES = 2 * MiB;
constexpr size_t WS_KSUM = 1 * MiB;
constexpr size_t WS_MODP = 2 * MiB;
constexpr size_t WS_MOD = 3 * MiB + 512 * 1024;
constexpr size_t WS_ROPE = 4 * MiB;
constexpr size_t WS_WST = 4 * MiB + 512 * 1024;
constexpr size_t WS_WRT = 4 * MiB + 768 * 1024;
constexpr size_t WS_SSQ = 5 * MiB;
constexpr size_t WS_ROUTE = 8 * MiB;
constexpr size_t WS_WIN = 24 * MiB;
constexpr size_t WS_WAB = 34 * MiB, WS_WOUT = 36 * MiB;
constexpr size_t WS_WGU = 40 * MiB;
constexpr size_t WS_WD = 104 * MiB;
constexpr size_t WS_XN = 136 * MiB;
constexpr size_t WS_PROJ = 200 * MiB;
constexpr size_t WS_HID = 200 * MiB;
constexpr size_t WS_Y = 272 * MiB;
constexpr size_t WS_X1 = 400 * MiB;
constexpr size_t WS_PO = 40 * MiB;
constexpr size_t WS_PML = 136 * MiB;
constexpr size_t WS_LIST = 488 * MiB;
constexpr size_t WS_END = 504 * MiB;
constexpr int CW_TMO = 0, CW_DIFF = 2, CW_BAR = 4096, CW_CURSOR = 32768, CW_CNT = 65536, CW_READY = 131072, CW_QHEAD = 160000, CW_GQ = 161024;

constexpr int RING_BYTES = 131072;
constexpr int LDS_BYTES = 147456;
constexpr int MISC_OFF = LDS_BYTES - 1024;
constexpr int NWAVES = 8;

#define LDS_WAIT() asm volatile("s_waitcnt lgkmcnt(0)" ::: "memory")
#define VM_WAIT() asm volatile("s_waitcnt vmcnt(0)" ::: "memory")
#define RLX_AGENT __ATOMIC_RELAXED, __HIP_MEMORY_SCOPE_AGENT

__device__ __forceinline__ unsigned cvt_pk_bf16(float lo, float hi) { unsigned r; asm volatile("v_cvt_pk_bf16_f32 %0, %1, %2" : "=v"(r) : "v"(lo), "v"(hi)); return r; }
__device__ __forceinline__ float bflo(unsigned u) { return __uint_as_float(u << 16); }
__device__ __forceinline__ float bfhi(unsigned u) { return __uint_as_float(u & 0xffff0000u); }
__device__ __forceinline__ float sigmoidf_(float x) { return __builtin_amdgcn_rcpf(1.0f + __builtin_amdgcn_exp2f(-1.4426950408889634f * x)); }
__device__ __forceinline__ float gelu_tanh(float x) { const float u = x + 0.044715f * x * x * x; return x * __builtin_amdgcn_rcpf(1.0f + __builtin_amdgcn_exp2f(-2.3022081985f * u)); }
__device__ __forceinline__ float wave_sum(float v) {
#pragma unroll
    for (int o = 1; o < 64; o <<= 1) v += __shfl_xor(v, o);
    return v;
}

namespace pg8 {
constexpr int BM = 256, BK = 64, HALF = 128, HTB = HALF * BK * 2, STAGE_BYTES = 8 * HTB, NXCD = 8, WGM = 8;
__host__ __device__ __forceinline__ int lds_byte(int r, int c) { const int st = (r >> 4) * 2 + (c >> 5), rr = r & 15, cc = c & 31, ob = rr * 64 + cc * 2; return st * 1024 + (ob ^ (((ob >> 9) & 1) << 5)); }
__host__ __device__ __forceinline__ void stage_rc(int b, int& R, int& C) { const int st = b / 1024, sb = b % 1024, swz = sb ^ (((sb >> 9) & 1) << 5); R = (st >> 1) * 16 + swz / 64; C = (st & 1) * 32 + (swz % 64) / 2; }
__host__ __device__ __forceinline__ int perm32(int rho) { const int n = rho >> 4, i = rho & 15; return 8 * (i >> 2) + 4 * n + (i & 3); }

struct Unit { int pm, pn, e, lt, nvalid; };

struct DenseSched {
    const char* A; const char* Bt; int lda, K; int nM, nN, nwg, G, c; int ksplit; unsigned kgap;
    __device__ void init(const void* A_, int lda_, const void* Bt_, int K_, int M, int N, int G_, int c_) { A = (const char*)A_; Bt = (const char*)Bt_; lda = lda_; K = K_; nM = M / BM; nN = N / BM; nwg = nM * nN; G = G_; c = c_; ksplit = 1 << 20; kgap = 0u; }
    __device__ __forceinline__ bool next(int i, Unit& u) const {
        const long L = (long)i * G + c; if (L >= nwg) return false;
        int wgid = (int)L; { const int q = nwg / NXCD, r = nwg % NXCD, xcd = wgid % NXCD, off = wgid / NXCD; wgid = (xcd < r ? xcd * (q + 1) : r * (q + 1) + (xcd - r) * q) + off; }
        const int nig = WGM * nN, gid = wgid / nig, fm = gid * WGM, gsz = (nM - fm) < WGM ? (nM - fm) : WGM;
        u.pm = fm + ((wgid % nig) % gsz); u.pn = (wgid % nig) / gsz; u.e = 0; u.lt = 0; u.nvalid = 256; return true;
    }
    __device__ __forceinline__ const char* a_base(const Unit& u) const { return A + (size_t)u.pm * BM * lda * 2; }
    __device__ __forceinline__ const char* b_base(const Unit& u) const { return Bt + (size_t)u.pn * BM * K * 2; }
    __device__ __forceinline__ unsigned gather_off(const Unit&, int, int) const { return 0u; }
    __device__ __forceinline__ void a_ready(const Unit&) const {}
    __device__ __forceinline__ void done(const Unit&) const {}
};
struct MoeSched {
    const char* A; const char* Bt; int lda, K; size_t bstride;
    const unsigned long long* route; bool gather;
    const volatile LAS int* tab;
    int start, end, j; static constexpr int ksplit = 1 << 20; static constexpr unsigned kgap = 0u;
    unsigned* ready; int mode;
    __device__ __forceinline__ void done(const Unit& u) const {
        if (mode == 1) { asm volatile("s_waitcnt vmcnt(0)" ::: "memory");
            if ((threadIdx.x & 63) == 0) __hip_atomic_fetch_add(ready + 64 * u.pm, 1u, __ATOMIC_RELAXED, __HIP_MEMORY_SCOPE_AGENT); } }
    __device__ __forceinline__ void a_ready(const Unit& u) const {
        if (mode == 2) {
            if (threadIdx.x < 64) { unsigned sp = 0;
                while ((unsigned)__builtin_amdgcn_readfirstlane(__hip_atomic_load(ready + 64 * u.pm, __ATOMIC_RELAXED, __HIP_MEMORY_SCOPE_AGENT)) < 32u) { __builtin_amdgcn_s_sleep(2); if (++sp > (1u << 22)) break; }
                __builtin_amdgcn_fence(__ATOMIC_ACQUIRE, "agent");
                asm volatile("s_waitcnt vmcnt(0)" ::: "memory"); }
            asm volatile("" ::: "memory"); __builtin_amdgcn_s_barrier(); asm volatile("" ::: "memory"); } }
    unsigned* qhead; volatile LAS int* qslot;
    __device__ __forceinline__ bool next(int i, Unit& u) const {
        int idx;
        if (mode == 2) {
            if (threadIdx.x == 0) qslot[i & 1] = start + (int)__hip_atomic_fetch_add(qhead, 1u, __ATOMIC_RELAXED, __HIP_MEMORY_SCOPE_AGENT);
            asm volatile("s_waitcnt vmcnt(0) lgkmcnt(0)" ::: "memory"); __builtin_amdgcn_s_barrier(); asm volatile("" ::: "memory");
            idx = __builtin_amdgcn_readfirstlane(qslot[i & 1]);
        } else idx = start + i * 32 + j;
        if (idx >= end) return false;
        const int tile = idx >> 2; u.pn = idx & 3; u.pm = tile;
        int e = 0;
        for (int k = 1; k < 32; ++k) e += (__builtin_amdgcn_readfirstlane(tab[32 + k]) <= tile) ? 1 : 0;
        u.e = e; u.lt = tile - __builtin_amdgcn_readfirstlane(tab[32 + e]);
        const int rem = __builtin_amdgcn_readfirstlane(tab[e]) - 256 * u.lt; u.nvalid = rem < 256 ? rem : 256; return true;
    }
    __device__ __forceinline__ const char* a_base(const Unit& u) const { return gather ? A : A + (size_t)u.pm * BM * lda * 2; }
    __device__ __forceinline__ const char* b_base(const Unit& u) const { return Bt + (size_t)u.e * bstride + (size_t)u.pn * BM * K * 2; }
    __device__ __forceinline__ unsigned gather_off(const Unit& u, int r, int C) const {
        unsigned tok = 0u;
        if (r < u.nvalid) tok = (unsigned)(route[(size_t)u.e * 32768 + (size_t)u.lt * 256 + r] & 0xffffffffull) >> 1;
        return (tok * (unsigned)lda + (unsigned)C) * 2u;
    }
};

template <class Epi, class Sched, bool GATHER>
__device__ __forceinline__ void gemm_phase(LAS unsigned char* lds, const Sched& S, const Epi& E) {
    const int tid = threadIdx.x, wid = __builtin_amdgcn_readfirstlane(tid >> 6), lane = tid & 63, wr = wid >> 2, wc = wid & 3, fr = lane & 15, fq = lane >> 4;
    const int K = S.K, lda = S.lda, nt = K / BK;
    unsigned voffA[2], voffB[2]; int RA[2], CA[2];
#pragma unroll
    for (int i = 0; i < 2; ++i) { int R, C; stage_rc(tid * 16 + i * 8192, R, C); const int Rb = Epi::PERM ? ((R & ~31) + perm32(R & 31)) : R;
        RA[i] = R; CA[i] = C; voffA[i] = (unsigned)(R * lda + C) * 2u; voffB[i] = (unsigned)(Rb * K + C) * 2u; }
    const size_t kstep = (size_t)(BK * 2);
    const unsigned hstepA = (unsigned)HALF * (unsigned)lda * 2u;
    const size_t hstepB = (size_t)HALF * K * 2;
    const unsigned ldsw = (unsigned)wid * 1024u;
    const int aoff = lds_byte(wr * 64 + fr, fq * 8), boff = lds_byte(wc * 32 + fr, fq * 8);
    unsigned og[2][2] = {{0u, 0u}, {0u, 0u}}, ogn[2][2] = {{0u, 0u}, {0u, 0u}};
#define PG8_SA(b, h) (((b) * 2 + (h)) * HTB)
#define PG8_SB(b, h) ((4 + (b) * 2 + (h)) * HTB)
#define PG8_STAGE_B(bufoff, gbase) do { _Pragma("unroll") for (int _i = 0; _i < 2; ++_i) \
        __builtin_amdgcn_global_load_lds((const unsigned*)((const char*)(gbase) + voffB[_i]), (LAS unsigned*)(lds + (bufoff) + ldsw + _i * 8192), 16, 0, 0); } while (0)
#define PG8_STAGE_A(bufoff, gbase, h) do { _Pragma("unroll") for (int _i = 0; _i < 2; ++_i) \
        __builtin_amdgcn_global_load_lds((const unsigned*)((const char*)(gbase) + (GATHER ? og[h][_i] : voffA[_i] + (h) * hstepA)), (LAS unsigned*)(lds + (bufoff) + ldsw + _i * 8192), 16, 0, 0); } while (0)
#define PG8_LDA(dst, b, h) do { _Pragma("unroll") for (int m = 0; m < 4; ++m) _Pragma("unroll") for (int k = 0; k < 2; ++k) dst[m][k] = *(const LAS bf16x8*)(lds + PG8_SA(b, h) + aoff + m * 2048 + k * 1024); } while (0)
#define PG8_LDB(dst, b, h) do { _Pragma("unroll") for (int n = 0; n < 2; ++n) _Pragma("unroll") for (int k = 0; k < 2; ++k) dst[n][k] = *(const LAS bf16x8*)(lds + PG8_SB(b, h) + boff + n * 2048 + k * 1024); } while (0)
#define PG8_MMA(ai, bj, At, Bt) do { __builtin_amdgcn_s_setprio(1); _Pragma("unroll") for (int m = 0; m < 4; ++m) _Pragma("unroll") for (int n = 0; n < 2; ++n) _Pragma("unroll") for (int k = 0; k < 2; ++k) \
        acc[ai][bj][m][n] = __builtin_amdgcn_mfma_f32_16x16x32_bf16(Bt[n][k], At[m][k], acc[ai][bj][m][n], 0, 0, 0); __builtin_amdgcn_s_setprio(0); } while (0)
#define PG8_WAIT_V(n) asm volatile("s_waitcnt vmcnt(" #n ")" ::: "memory")
#define PG8_WAIT_L(n) asm volatile("s_waitcnt lgkmcnt(" #n ")" ::: "memory")
#define PG8_BAR __builtin_amdgcn_s_barrier()
#define PG8_SCHED __builtin_amdgcn_sched_barrier(0)
    Unit cur, nxt; int ui = 0;
    if (!S.next(0, cur)) return;
    f32x4 acc[2][2][4][2];
#pragma unroll
    for (int a = 0; a < 2; ++a)
#pragma unroll
        for (int b = 0; b < 2; ++b)
#pragma unroll
            for (int m = 0; m < 4; ++m)
#pragma unroll
                for (int n = 0; n < 2; ++n) acc[a][b][m][n] = (f32x4){0.f, 0.f, 0.f, 0.f};
    bf16x8 At[4][2], B0[2][2], B1[2][2];
    const char* cA = S.a_base(cur); const char* cB = S.b_base(cur);
    S.a_ready(cur);
    if constexpr (GATHER) {
#pragma unroll
        for (int h = 0; h < 2; ++h)
#pragma unroll
            for (int i = 0; i < 2; ++i) og[h][i] = S.gather_off(cur, h * HALF + RA[i], CA[i]);
    }
    PG8_STAGE_B(PG8_SB(0, 0), cB); PG8_STAGE_B(PG8_SB(0, 1), cB + hstepB); PG8_STAGE_A(PG8_SA(0, 0), cA, 0); PG8_STAGE_A(PG8_SA(0, 1), cA, 1);
    if (wr == 1) PG8_BAR;
    PG8_WAIT_V(2); PG8_BAR;
    PG8_STAGE_B(PG8_SB(1, 0), cB + kstep); PG8_STAGE_A(PG8_SA(1, 0), cA + kstep, 0); PG8_STAGE_B(PG8_SB(1, 1), cB + hstepB + kstep);
    PG8_WAIT_V(6); PG8_BAR;
    unsigned long long t3_ = 0;
    for (;;) {
        const bool has_next = S.next(ui + 1, nxt);
        const char* nA = has_next ? S.a_base(nxt) : cA; const char* nB = has_next ? S.b_base(nxt) : cB;
        if constexpr (GATHER) {
            if (has_next) {
#pragma unroll
                for (int h = 0; h < 2; ++h)
#pragma unroll
                    for (int i = 0; i < 2; ++i) ogn[h][i] = S.gather_off(nxt, h * HALF + RA[i], CA[i]);
            }
        }
        for (int t = 0; t < nt; t += 2) {
            const bool last = (t == nt - 2);
            const char* a1 = cA + (size_t)(t + 1) * kstep + ((t + 1) >= S.ksplit ? S.kgap : 0u);
            const char* a2 = last ? nA : cA + (size_t)(t + 2) * kstep + ((t + 2) >= S.ksplit ? S.kgap : 0u); const char* b2 = last ? nB : cB + (size_t)(t + 2) * kstep;
            const char* a3 = last ? nA + kstep : cA + (size_t)(t + 3) * kstep + ((t + 3) >= S.ksplit ? S.kgap : 0u); const char* b3 = b2 + kstep;
            if (last && has_next) S.a_ready(nxt);
            if constexpr (Epi::HAS_MID) { if (t == S.ksplit) E.mid(acc, cur, wr, wc, fr, fq); }
            PG8_LDB(B0, 0, 0); PG8_LDB(B1, 0, 1); PG8_SCHED; PG8_LDA(At, 0, 0); PG8_STAGE_A(PG8_SA(1, 1), a1, 1);
            if constexpr (GATHER) { if (last && has_next) {
#pragma unroll
                for (int h = 0; h < 2; ++h)
#pragma unroll
                    for (int i = 0; i < 2; ++i) og[h][i] = ogn[h][i]; } }
            PG8_WAIT_V(8); PG8_WAIT_L(0); PG8_BAR;
            if (TSEL == 3) { if (t == 0 && t3_ != 0 && T_ON(3)) { g_tacc += __builtin_amdgcn_s_memrealtime() - t3_; t3_ = 0; } }
            PG8_MMA(0, 0, At, B0); PG8_MMA(0, 1, At, B1); PG8_BAR; PG8_SCHED;
            PG8_LDA(At, 0, 1); PG8_STAGE_B(PG8_SB(0, 0), b2); PG8_STAGE_B(PG8_SB(0, 1), b2 + hstepB); PG8_STAGE_A(PG8_SA(0, 0), a2, 0);
            PG8_WAIT_V(8); PG8_WAIT_L(0); PG8_BAR; PG8_MMA(1, 0, At, B0); PG8_MMA(1, 1, At, B1); PG8_BAR; PG8_SCHED;
            PG8_LDB(B0, 1, 0); PG8_LDB(B1, 1, 1); PG8_SCHED; PG8_LDA(At, 1, 0); PG8_STAGE_A(PG8_SA(0, 1), a2, 1);
            PG8_WAIT_V(8); PG8_WAIT_L(0); PG8_BAR; PG8_MMA(0, 0, At, B0); PG8_MMA(0, 1, At, B1); PG8_BAR; PG8_SCHED;
            PG8_LDA(At, 1, 1); PG8_STAGE_B(PG8_SB(1, 0), b3); PG8_STAGE_B(PG8_SB(1, 1), b3 + hstepB); PG8_STAGE_A(PG8_SA(1, 0), a3, 0);
            PG8_WAIT_V(8); PG8_WAIT_L(0); PG8_BAR; PG8_MMA(1, 0, At, B0); PG8_MMA(1, 1, At, B1); PG8_BAR; PG8_SCHED;
        }
        if (wr == 0) PG8_BAR;
        { T_BEGIN(2, t2_) E(acc, cur, wr, wc, fr, fq); S.done(cur); T_END(2, t2_); }
        if (!has_next) break;
        if (TSEL == 3 && T_ON(3)) t3_ = __builtin_amdgcn_s_memrealtime();
#pragma unroll
        for (int a = 0; a < 2; ++a)
#pragma unroll
            for (int b = 0; b < 2; ++b)
#pragma unroll
                for (int m = 0; m < 4; ++m)
#pragma unroll
                    for (int n = 0; n < 2; ++n) acc[a][b][m][n] = (f32x4){0.f, 0.f, 0.f, 0.f};
        cur = nxt; cA = nA; cB = nB; ++ui;
        if (wr == 1) PG8_BAR;
    }
    PG8_WAIT_V(0);
    PG8_BAR;
#undef PG8_SA
#undef PG8_SB
#undef PG8_STAGE_A
#undef PG8_STAGE_B
#undef PG8_LDA
#undef PG8_LDB
#undef PG8_MMA
#undef PG8_WAIT_V
#undef PG8_WAIT_L
#undef PG8_BAR
#undef PG8_SCHED
}

struct EpiProj {
    static constexpr bool PERM = true; static constexpr bool HAS_MID = false;
    bf16_t* P; const float* rope; float* ksum;
    __device__ __forceinline__ void operator()(const f32x4 (&acc)[2][2][4][2], const Unit& u, int wr, int wc, int fr_in, int fq) const {
        int fr = fr_in; asm volatile("" : "+v"(fr));
        const int pn = u.pn, row0 = u.pm * BM + wr * 64 + fr, cl = wc * 32 + 8 * fq;
        const int mode = pn < 4 ? 0 : pn < 6 ? 1 : pn < 8 ? 2 : pn < 10 ? 3 : 4;
        const bool rot = (mode == 1 || mode == 2) && ((wc & 1) == 0);
        float ks[2][8];
#pragma unroll
        for (int bj = 0; bj < 2; ++bj)
#pragma unroll
            for (int j = 0; j < 8; ++j) ks[bj][j] = 0.f;
        f32x4 rq[3][4];
#define RP_LOAD(gi, slot) do { if (rot) { const int pos_ = (row0 + ((gi) >> 2) * HALF + ((gi) & 3) * 16) & (SEQ - 1); \
            rq[slot][0] = *(const f32x4*)(rope + pos_ * 8); rq[slot][1] = *(const f32x4*)(rope + pos_ * 8 + 4); rq[slot][2] = *(const f32x4*)(rope + 65536 + pos_ * 8); rq[slot][3] = *(const f32x4*)(rope + 65536 + pos_ * 8 + 4); } } while (0)
        RP_LOAD(0, 0); RP_LOAD(1, 1);
#pragma unroll
        for (int ai = 0; ai < 2; ++ai)
#pragma unroll
            for (int m = 0; m < 4; ++m) {
                const int gi_ = ai * 4 + m;
                if (gi_ + 2 < 8) RP_LOAD(gi_ + 2, (gi_ + 2) % 3);
                const int row = row0 + ai * HALF + m * 16;
                float cs[8], sn[8];
                if (rot) {
#pragma unroll
                    for (int j = 0; j < 4; ++j) { cs[j] = rq[gi_ % 3][0][j]; cs[4 + j] = rq[gi_ % 3][1][j]; sn[j] = rq[gi_ % 3][2][j]; sn[4 + j] = rq[gi_ % 3][3][j]; } }
#pragma unroll
                for (int bj = 0; bj < 2; ++bj) {
                    float v[8];
#pragma unroll
                    for (int j = 0; j < 4; ++j) { v[j] = acc[ai][bj][m][0][j]; v[4 + j] = acc[ai][bj][m][1][j]; }
                    if (mode == 1 || mode == 2) {
                        if (rot) {
                            const float sg = (fq == 0) ? -1.f : 1.f; const bool ap = fq < 2;
#pragma unroll
                            for (int j = 0; j < 8; ++j) {
                                const auto sw = __builtin_amdgcn_permlane16_swap(__float_as_uint(v[j]), __float_as_uint(v[j]), false, false);
                                const float o = __uint_as_float((fq & 1) ? sw[0] : sw[1]); const float r = v[j] * cs[j] + sg * o * sn[j]; v[j] = ap ? r : v[j]; }
                        }
                        if (mode == 1) {
#pragma unroll
                            for (int j = 0; j < 8; ++j) v[j] *= QSCALE;
                        } else {
#pragma unroll
                            for (int j = 0; j < 8; ++j) ks[bj][j] += v[j];
                        }
                    }
                    u32x4 w; w.x = cvt_pk_bf16(v[0], v[1]); w.y = cvt_pk_bf16(v[2], v[3]); w.z = cvt_pk_bf16(v[4], v[5]); w.w = cvt_pk_bf16(v[6], v[7]);
                    *(u32x4*)(P + (size_t)row * PC + pn * BM + bj * HALF + cl) = w;
                }
            }
#undef RP_LOAD
        if (mode == 2) {
#pragma unroll
            for (int bj = 0; bj < 2; ++bj)
#pragma unroll
                for (int j = 0; j < 8; ++j) { float s = ks[bj][j]; s += __shfl_xor(s, 1); s += __shfl_xor(s, 2); s += __shfl_xor(s, 4); s += __shfl_xor(s, 8); ks[bj][j] = s; }
            if (fr == 0) {
                const int b = u.pm >> 5, kb = u.pm & 31;
#pragma unroll
                for (int bj = 0; bj < 2; ++bj) { const int ck = (pn - 6) * BM + bj * HALF + cl; const int h = ck >> 6, d = ck & 63;
                    float* dst = ksum + ((size_t)((b * 8 + h) * 32 + kb)) * 64 + d;
#pragma unroll
                    for (int j = 0; j < 8; ++j) atomicAdd(dst + j, ks[bj][j]); }
            }
        }
    }
};
struct EpiMergeF {
    static constexpr bool PERM = true; static constexpr bool HAS_MID = true;
    const bf16_t* P; bf16_t* MG;
    __device__ __forceinline__ void mid(f32x4 (&acc)[2][2][4][2], const Unit& u, int wr, int wc, int fr_in, int fq) const {
        int fr = fr_in; asm volatile("" : "+v"(fr));
        const int row0 = u.pm * BM + wr * 64 + fr, col0 = u.pn * BM + wc * 32 + 8 * fq;
#pragma unroll
        for (int g4 = 0; g4 < 8; g4 += 4) {
            u32x4 ga[4][2], gb[4][2];
#pragma unroll
            for (int k = 0; k < 4; ++k) { const int gi = g4 + k, row = row0 + (gi >> 2) * HALF + (gi & 3) * 16;
#pragma unroll
                for (int bj = 0; bj < 2; ++bj) { ga[k][bj] = *(const u32x4*)(P + (size_t)row * PC + C_GA + col0 + bj * HALF); gb[k][bj] = *(const u32x4*)(P + (size_t)row * PC + C_GB + col0 + bj * HALF); } }
#pragma unroll
            for (int k = 0; k < 4; ++k) { const int gi = g4 + k, ai = gi >> 2, m = gi & 3;
#pragma unroll
                for (int bj = 0; bj < 2; ++bj) {
#define RHO(a_, b_) ((1.0f + __builtin_amdgcn_exp2f(-1.4426950408889634f * fmaxf(b_, -60.f))) * sigmoidf_(a_))
                    const u32x4 A_ = ga[k][bj], B_ = gb[k][bj];
                    acc[ai][bj][m][0][0] *= RHO(bflo(A_.x), bflo(B_.x)); acc[ai][bj][m][0][1] *= RHO(bfhi(A_.x), bfhi(B_.x)); acc[ai][bj][m][0][2] *= RHO(bflo(A_.y), bflo(B_.y)); acc[ai][bj][m][0][3] *= RHO(bfhi(A_.y), bfhi(B_.y));
                    acc[ai][bj][m][1][0] *= RHO(bflo(A_.z), bflo(B_.z)); acc[ai][bj][m][1][1] *= RHO(bfhi(A_.z), bfhi(B_.z)); acc[ai][bj][m][1][2] *= RHO(bflo(A_.w), bflo(B_.w)); acc[ai][bj][m][1][3] *= RHO(bfhi(A_.w), bfhi(B_.w));
#undef RHO
                } }
        }
    }
    __device__ __forceinline__ void operator()(const f32x4 (&acc)[2][2][4][2], const Unit& u, int wr, int wc, int fr_in, int fq) const {
        int fr = fr_in; asm volatile("" : "+v"(fr));
        const int row0 = u.pm * BM + wr * 64 + fr, col0 = u.pn * BM + wc * 32 + 8 * fq;
        u32x4 gq[3][2];
#define EM_LOAD(gi, slot) do { const int row_ = row0 + ((gi) >> 2) * HALF + ((gi) & 3) * 16; \
            _Pragma("unroll") for (int bj = 0; bj < 2; ++bj) gq[slot][bj] = *(const u32x4*)(P + (size_t)row_ * PC + C_GB + col0 + bj * HALF); } while (0)
        EM_LOAD(0, 0); EM_LOAD(1, 1);
#pragma unroll
        for (int gi = 0; gi < 8; ++gi) {
            if (gi + 2 < 8) EM_LOAD(gi + 2, (gi + 2) % 3);
            asm volatile("" ::: "memory");
            const int ai = gi >> 2, m = gi & 3, row = row0 + ai * HALF + m * 16;
#pragma unroll
            for (int bj = 0; bj < 2; ++bj) { const u32x4 g = gq[gi % 3][bj];
                float v[8];
#pragma unroll
                for (int j = 0; j < 4; ++j) { v[j] = acc[ai][bj][m][0][j]; v[4 + j] = acc[ai][bj][m][1][j]; }
#define SGB(x_) sigmoidf_(fmaxf(x_, -60.f))
                v[0] *= SGB(bflo(g.x)); v[1] *= SGB(bfhi(g.x)); v[2] *= SGB(bflo(g.y)); v[3] *= SGB(bfhi(g.y)); v[4] *= SGB(bflo(g.z)); v[5] *= SGB(bfhi(g.z)); v[6] *= SGB(bflo(g.w)); v[7] *= SGB(bfhi(g.w));
#undef SGB
                u32x4 w; w.x = cvt_pk_bf16(v[0], v[1]); w.y = cvt_pk_bf16(v[2], v[3]); w.z = cvt_pk_bf16(v[4], v[5]); w.w = cvt_pk_bf16(v[6], v[7]);
                *(u32x4*)(MG + (size_t)row * DM + col0 + bj * HALF) = w; }
        }
#undef EM_LOAD
    }
};
struct EpiOut {
    static constexpr bool PERM = false; static constexpr bool HAS_MID = false;
    const float* x; bf16_t* x1; const float* mod; float* ssq;
    __device__ __forceinline__ void operator()(const f32x4 (&acc)[2][2][4][2], const Unit& u, int wr, int wc, int fr_in, int fq) const {
        int fr = fr_in; asm volatile("" : "+v"(fr));
        const int row0 = u.pm * BM + wr * 64 + fr, col0 = u.pn * BM + wc * 32 + 4 * fq, b = u.pm >> 5;
        f32x4 xq[3][2][2];
#define EO_LOAD(gi, slot) do { const size_t off_ = (size_t)(row0 + ((gi) >> 2) * HALF + ((gi) & 3) * 16) * DM + col0; \
            _Pragma("unroll") for (int bj = 0; bj < 2; ++bj) _Pragma("unroll") for (int n = 0; n < 2; ++n) xq[slot][bj][n] = *(const f32x4*)(x + off_ + bj * HALF + n * 16); } while (0)
        EO_LOAD(0, 0); EO_LOAD(1, 1);
        f32x4 g1[2][2];
#pragma unroll
        for (int bj = 0; bj < 2; ++bj)
#pragma unroll
            for (int n = 0; n < 2; ++n) g1[bj][n] = *(const f32x4*)(mod + b * 6144 + 2048 + col0 + bj * HALF + n * 16);
#pragma unroll
        for (int gi = 0; gi < 8; ++gi) {
            if (gi + 2 < 8) EO_LOAD(gi + 2, (gi + 2) % 3);
            asm volatile("" ::: "memory");
            const int ai = gi >> 2, m = gi & 3, row = row0 + ai * HALF + m * 16; const size_t off = (size_t)row * DM + col0; float s = 0.f;
#pragma unroll
            for (int bj = 0; bj < 2; ++bj)
#pragma unroll
                for (int n = 0; n < 2; ++n) { const f32x4 o = xq[gi % 3][bj][n] + g1[bj][n] * acc[ai][bj][m][n];
                    u32x2 w; w.x = cvt_pk_bf16(o[0], o[1]); w.y = cvt_pk_bf16(o[2], o[3]);
                    const float r0 = bflo(w.x), r1 = bfhi(w.x), r2 = bflo(w.y), r3 = bfhi(w.y);
                    s += (r0 * r0 + r1 * r1) + (r2 * r2 + r3 * r3); *(u32x2*)(x1 + off + bj * HALF + n * 16) = w; }
            s += __shfl_xor(s, 16); s += __shfl_xor(s, 32);
            if (fq == 0) ssq[(size_t)row * 16 + u.pn * 4 + wc] = s;
        }
#undef EO_LOAD
    }
};
struct EpiGU {
    static constexpr bool PERM = true; static constexpr bool HAS_MID = false;
    bf16_t* H;
    __device__ __forceinline__ void operator()(const f32x4 (&acc)[2][2][4][2], const Unit& u, int wr, int wc, int fr_in, int fq) const {
        int fr = fr_in; asm volatile("" : "+v"(fr));
        const int r0 = wr * 64 + fr, cl = wc * 32 + 8 * fq;
#pragma unroll
        for (int ai = 0; ai < 2; ++ai)
#pragma unroll
            for (int m = 0; m < 4; ++m) { const int r = r0 + ai * HALF + m * 16;
                float v[8];
#pragma unroll
                for (int j = 0; j < 4; ++j) { const float g0 = acc[ai][0][m][0][j], g1 = acc[ai][0][m][1][j]; v[j] = g0 * sigmoidf_(g0) * acc[ai][1][m][0][j]; v[4 + j] = g1 * sigmoidf_(g1) * acc[ai][1][m][1][j]; }
                u32x4 w; w.x = cvt_pk_bf16(v[0], v[1]); w.y = cvt_pk_bf16(v[2], v[3]); w.z = cvt_pk_bf16(v[4], v[5]); w.w = cvt_pk_bf16(v[6], v[7]);
                bf16_t* dst = H + ((size_t)u.pm * BM + r) * DEXP + u.pn * HALF + cl;
                asm volatile("global_store_dwordx4 %0, %1, off sc1\n\ts_nop 1" :: "v"(dst), "v"(w) : "memory"); }
    }
};
struct EpiDown {
    static constexpr bool PERM = true; static constexpr bool HAS_MID = false;
    bf16_t* Y; const unsigned long long* route;
    __device__ __forceinline__ void operator()(const f32x4 (&acc)[2][2][4][2], const Unit& u, int wr, int wc, int fr_in, int fq) const {
        int fr = fr_in; asm volatile("" : "+v"(fr));
        const int r0 = wr * 64 + fr, col0 = u.pn * BM + wc * 32 + 8 * fq;
        const unsigned long long* rt = route + (size_t)u.e * 32768 + (size_t)u.lt * 256;
        unsigned long long ent[8];
#pragma unroll
        for (int gi = 0; gi < 8; ++gi) { const int r = r0 + (gi >> 2) * HALF + (gi & 3) * 16; ent[gi] = (r < u.nvalid) ? rt[r] : 0ull; }
#pragma unroll
        for (int gi = 0; gi < 8; ++gi) { const int ai = gi >> 2, m = gi & 3, r = r0 + ai * HALF + m * 16;
            if (r < u.nvalid) { const unsigned slot = (unsigned)(ent[gi] & 0xffffffffull); const float wt = __uint_as_float((unsigned)(ent[gi] >> 32));
#pragma unroll
                for (int bj = 0; bj < 2; ++bj) { const f32x4 a0 = acc[ai][bj][m][0] * wt, a1 = acc[ai][bj][m][1] * wt;
                    u32x4 w; w.x = cvt_pk_bf16(a0[0], a0[1]); w.y = cvt_pk_bf16(a0[2], a0[3]); w.z = cvt_pk_bf16(a1[0], a1[1]); w.w = cvt_pk_bf16(a1[2], a1[3]);
                    *(u32x4*)(Y + (size_t)slot * DM + col0 + bj * HALF) = w; } } }
    }
};
}

namespace attn_body {
using bf16 = __hip_bfloat16;
constexpr int NHEAD = 8, D = 64, PITCH = PC;
constexpr int NW = 8, QBLK = 32, QB = QBLK * NW, KVBLK = 64;
__device__ __forceinline__ int crow(int r, int hi) { return (r & 3) + 8 * (r >> 2) + 4 * hi; }
#define SBAR() __builtin_amdgcn_sched_barrier(0)
__device__ __forceinline__ void cmask(f32x16& p0, f32x16& p1, int jb, int qrel, int hi) {
    const float NEG = -INFINITY; int kb = 64 * jb + 4 * hi;
#pragma unroll
    for (int r = 0; r < 16; ++r) { int kv = kb + (r & 3) + 8 * (r >> 2); if (kv > qrel) p0[r] = NEG; if (kv + 32 > qrel) p1[r] = NEG; }
}
__device__ __forceinline__ void selapply(f32x16& p0, f32x16& p1, bool ok) {
    const float NEG = -INFINITY;
#pragma unroll
    for (int r = 0; r < 16; ++r) { p0[r] = ok ? p0[r] : NEG; p1[r] = ok ? p1[r] : NEG; }
}
constexpr int NSLOT = 3, SLOTB = 8192;
constexpr int LDS_K = 0, LDS_V = NSLOT * SLOTB, LDS_WS = 2 * NSLOT * SLOTB, LDS_OST = LDS_WS + NW * 64 * 4, LDS_BYTES_A = LDS_OST + NW * 4096;
__device__ __forceinline__ void glds16(const void* gsrc, unsigned lds_dst) { unsigned keep;
    asm volatile("s_mov_b32 %0, m0\n\ts_mov_b32 m0, %2\n\ts_nop 0\n\tglobal_load_lds_dwordx4 %1, off\n\ts_mov_b32 m0, %0" : "=&s"(keep) : "v"(gsrc), "s"(lds_dst) : "memory"); }
__device__ __forceinline__ float max3f(float a, float b, float c) { float r; asm("v_max3_f32 %0, %1, %2, %3" : "=v"(r) : "v"(a), "v"(b), "v"(c)); return r; }
__device__ __forceinline__ float max2f(float a, float b) { float r; asm("v_max_f32_e32 %0, %1, %2" : "=v"(r) : "v"(a), "v"(b)); return r; }
__device__ __forceinline__ float fadd_s(float a, float b) { float r; asm("v_add_f32_e32 %0, %1, %2" : "=v"(r) : "v"(a), "v"(b)); return r; }
__device__ __forceinline__ float fsub_s(float a, float b) { float r; asm("v_sub_f32_e32 %0, %1, %2" : "=v"(r) : "v"(a), "v"(b)); return r; }
typedef __bf16 bf16x2_t __attribute__((ext_vector_type(2)));
__device__ __forceinline__ unsigned cvtpk_s(float lo, float hi) { f32x2 v = {lo, hi}; bf16x2_t b = __builtin_convertvector(v, bf16x2_t); return __builtin_bit_cast(unsigned, b); }
#define WAIT_BAR(N) asm volatile("s_waitcnt vmcnt(" #N ") lgkmcnt(0)\n\ts_barrier" ::: "memory")

__device__ __forceinline__ void qkt(f32x16& p0, f32x16& p1, const char* Kslot, const bf16x8* qr, const f32x16& negm, int r32, int hi) {
    const char* kb = Kslot + hi * 1024 + r32 * 16;
#pragma unroll
    for (int d0 = 0; d0 < 4; ++d0) {
        const bf16x8 b0 = *reinterpret_cast<const bf16x8*>(kb + d0 * 2048);
        const bf16x8 b1 = *reinterpret_cast<const bf16x8*>(kb + d0 * 2048 + 512);
        if (d0 == 0) { p0 = __builtin_amdgcn_mfma_f32_32x32x16_bf16(b0, qr[0], negm, 0, 0, 0); p1 = __builtin_amdgcn_mfma_f32_32x32x16_bf16(b1, qr[0], negm, 0, 0, 0); }
        else { p0 = __builtin_amdgcn_mfma_f32_32x32x16_bf16(b0, qr[d0], p0, 0, 0, 0); p1 = __builtin_amdgcn_mfma_f32_32x32x16_bf16(b1, qr[d0], p1, 0, 0, 0); } }
}
typedef LAS const char* lds_cptr;
typedef short v4i16_t __attribute__((ext_vector_type(4)));
__device__ __forceinline__ void kload8(bf16x8* kf, lds_cptr kp) {
    kf[0] = *(const LAS bf16x8*)(kp);        kf[1] = *(const LAS bf16x8*)(kp + 512);
    kf[2] = *(const LAS bf16x8*)(kp + 2048); kf[3] = *(const LAS bf16x8*)(kp + 2560);
    kf[4] = *(const LAS bf16x8*)(kp + 4096); kf[5] = *(const LAS bf16x8*)(kp + 4608);
    kf[6] = *(const LAS bf16x8*)(kp + 6144); kf[7] = *(const LAS bf16x8*)(kp + 6656);
}
__device__ __forceinline__ void kload2(bf16x8* kf, lds_cptr kp, int j) { kf[2 * j] = *(const LAS bf16x8*)(kp + j * 2048); kf[2 * j + 1] = *(const LAS bf16x8*)(kp + j * 2048 + 512); }
__device__ __forceinline__ s16x4 vtr(lds_cptr p) { return __builtin_bit_cast(s16x4, __builtin_amdgcn_ds_read_tr16_b64_v4i16((LAS v4i16_t*)p)); }
__device__ __forceinline__ float rowmax(const f32x16& p0, const f32x16& p1) {
    float a = max3f(p0[0], p0[1], p1[0]), b = max3f(p0[2], p0[3], p1[1]); a = max3f(a, p1[2], p1[3]);
#pragma unroll
    for (int r = 4; r < 16; r += 4) { a = max3f(a, p0[r], p0[r + 1]); b = max3f(b, p0[r + 2], p0[r + 3]); a = max3f(a, p1[r], p1[r + 1]); b = max3f(b, p1[r + 2], p1[r + 3]); }
    const float m = max2f(a, b);
    auto rr = __builtin_amdgcn_permlane32_swap(__float_as_uint(m), __float_as_uint(m), false, false);
    return max2f(__uint_as_float(rr[0]), __uint_as_float(rr[1]));
}
__device__ __forceinline__ void pv(f32x16* o, int vb, bf16x8 pa0, bf16x8 pa1, bf16x8 pa2, bf16x8 pa3) {
#pragma unroll
    for (int d0 = 0; d0 < 2; ++d0) { s16x4 lo[4], hi[4];
#pragma unroll
        for (int ks = 0; ks < 4; ++ks) {
            asm volatile("ds_read_b64_tr_b16 %0,%1 offset:%c2" : "=&v"(lo[ks]) : "v"(vb), "i"(d0 * 4096 + ks * 1024) : "memory");
            asm volatile("ds_read_b64_tr_b16 %0,%1 offset:%c2" : "=&v"(hi[ks]) : "v"(vb), "i"(d0 * 4096 + ks * 1024 + 512) : "memory"); }
        asm volatile("s_waitcnt lgkmcnt(0)" ::: "memory"); SBAR();
#define PK(k) (bf16x8){lo[k][0], lo[k][1], lo[k][2], lo[k][3], hi[k][0], hi[k][1], hi[k][2], hi[k][3]}
        o[d0] = __builtin_amdgcn_mfma_f32_32x32x16_bf16(pa0, PK(0), o[d0], 0, 0, 0);
        o[d0] = __builtin_amdgcn_mfma_f32_32x32x16_bf16(pa1, PK(1), o[d0], 0, 0, 0);
        o[d0] = __builtin_amdgcn_mfma_f32_32x32x16_bf16(pa2, PK(2), o[d0], 0, 0, 0);
        o[d0] = __builtin_amdgcn_mfma_f32_32x32x16_bf16(pa3, PK(3), o[d0], 0, 0, 0);
#undef PK
    }
}

__device__ __forceinline__ void gate_top3(const float* ksum_bh, const bf16x8* qr, int qb, int r32, int hi, int (&kbs)[3]) {
    const float* km = ksum_bh + (size_t)r32 * 64 + hi * 8;
    f32x16 g = f32x16{};
#pragma unroll
    for (int d0 = 0; d0 < 4; ++d0) { const f32x4 a = *(const f32x4*)(km + d0 * 16), c = *(const f32x4*)(km + d0 * 16 + 4);
        u32x4 w; w.x = cvtpk_s(a[0], a[1]); w.y = cvtpk_s(a[2], a[3]); w.z = cvtpk_s(c[0], c[1]); w.w = cvtpk_s(c[2], c[3]);
        g = __builtin_amdgcn_mfma_f32_32x32x16_bf16(__builtin_bit_cast(bf16x8, w), qr[d0], g, 0, 0, 0); }
#pragma unroll
    for (int r = 0; r < 16; ++r) if (crow(r, hi) >= qb) g[r] = -INFINITY;
#pragma unroll
    for (int round = 0; round < 3; ++round) {
        float m = g[0];
#pragma unroll
        for (int r = 1; r < 16; ++r) m = fmaxf(m, g[r]);
        int idx = 64;
#pragma unroll
        for (int r = 15; r >= 0; --r) if (g[r] == m) idx = crow(r, hi);
        const float pm = __shfl_xor(m, 32); const int pidx = __shfl_xor(idx, 32);
        const bool mine = (m > pm) || (m == pm && idx < pidx);
        kbs[round] = (mine ? idx : pidx) & 31;
#pragma unroll
        for (int r = 0; r < 16; ++r) if (mine && crow(r, hi) == idx) g[r] = -INFINITY;
    }
}

template <int THRL, bool OWN> __device__ __forceinline__ void attn_unit(int b, int h, int qb, const bf16* Q, const bf16* __restrict__ K, const bf16* __restrict__ V, bf16* O, const float* ksum, char* shm, bool do_store, const bf16_t* PO, const float* PML) {
    const int tid = threadIdx.x, lane = tid & 63, r32 = lane & 31, hi = lane >> 5; const int wid = __builtin_amdgcn_readfirstlane(tid >> 6);
    const long rowbase = (long)b * SEQ; const int q0 = qb * QB;
    const bf16* Qw = Q + (rowbase + q0 + wid * QBLK) * PITCH + h * D;
    const bf16* Kh = K + rowbase * PITCH + h * D, *Vh = V + rowbase * PITCH + h * D;
    const unsigned lds0 = (unsigned)(uintptr_t)shm;
    float* wsf = (float*)(shm + LDS_WS) + wid * 64;
    const bf16* ksrc = Kh + (long)lane * PITCH + wid * 8;
    const bf16* vsrc = Vh + (long)(16 * (wid & 3) + (lane >> 2)) * PITCH + (wid >> 2) * 32 + (lane & 3) * 8;
    const unsigned kdst = lds0 + LDS_K + wid * 1024, vdst = lds0 + LDS_V + wid * 1024;
    const int NT = OWN ? 4 : (q0 + QB) / KVBLK;
    const int TBASE = OWN ? 4 * qb : 0;
#define TM(t) (OWN ? (t) : (((t) == 0) ? (NT - 4) : (((t) <= NT - 4) ? ((t) - 1) : (t))))
#define DMA_K(t, slot) glds16(ksrc + (long)(TBASE + TM(t)) * KVBLK * PITCH, (unsigned)__builtin_amdgcn_readfirstlane(kdst + (slot)))
#define DMA_V(t, slot) glds16(vsrc + (long)(TBASE + TM(t)) * KVBLK * PITCH, (unsigned)__builtin_amdgcn_readfirstlane(vdst + (slot)))
    const int vb0 = (int)(lds0 + LDS_V) + ((lane >> 4) & 1) * 32 + (lane & 3) * 8 + (4 * hi + ((lane & 15) >> 2)) * 64;
    const char* Kbase = shm + LDS_K; bf16x8 kf[8];
    const lds_cptr shm3 = (lds_cptr)shm; const lds_cptr kp0 = shm3 + LDS_K + hi * 1024 + r32 * 16; const lds_cptr vp0 = shm3 + LDS_V + ((lane >> 4) & 1) * 32 + (lane & 3) * 8 + (4 * hi + ((lane & 15) >> 2)) * 64;
    DMA_K(0, 0); DMA_V(0, 0); DMA_K(1, SLOTB);
    bf16x8 qr[4];
#pragma unroll
    for (int d0 = 0; d0 < 4; ++d0) qr[d0] = *reinterpret_cast<const bf16x8*>(&Qw[(long)r32 * PITCH + d0 * 16 + hi * 8]);
    unsigned selmask = 0u;
    if constexpr (!OWN) {
    if (qb > 0) {
        if (qb <= 3) selmask = (1u << qb) - 1u;
        else { int kbs[3]; gate_top3(ksum + ((size_t)(b * NHEAD + h) * 32) * 64, qr, qb, r32, hi, kbs); selmask = (1u << kbs[0]) | (1u << kbs[1]) | (1u << kbs[2]); }
    } }
    float zf_; asm volatile("v_mov_b32 %0, 0" : "=v"(zf_));
    float mhat = 0.f, l_reg = 0.f; f32x16 o[2]; f32x16 negm;
#pragma unroll
    for (int r = 0; r < 16; ++r) { o[0][r] = zf_; o[1][r] = zf_; negm[r] = zf_; }
    asm volatile("" : "+v"(negm));
    const int qrel = wid * QBLK + r32;
#define MASKT(P0, P1, t) do { const int a_ = TM(t); const int jb_ = a_ - (NT - 4); if (jb_ >= 0) cmask(P0, P1, jb_, qrel, hi); else selapply(P0, P1, ((selmask >> (a_ >> 2)) & 1u) != 0u); } while (0)
    bool resc = false;
#define START(P0, P1) do { const float rm = rowmax(P0, P1); resc = false; \
    { const float dl = rm; mhat = fadd_s(mhat, dl); \
      _Pragma("unroll") for (int r = 0; r < 16; ++r) { P0[r] = fsub_s(P0[r], dl); P1[r] = fsub_s(P1[r], dl); } \
      _Pragma("unroll") for (int r = 0; r < 16; ++r) negm[r] = -mhat; asm volatile("" : "+v"(negm)); } \
    _Pragma("unroll") for (int r = 0; r < 16; ++r) P0[r] = __builtin_amdgcn_exp2f(P0[r]); } while (0)
#define RESC() do { if (resc) { asm volatile("s_waitcnt lgkmcnt(0)" ::: "memory"); \
      _Pragma("unroll") for (int d_ = 0; d_ < 2; ++d_) _Pragma("unroll") for (int r = 0; r < 16; ++r) o[d_][r] *= wsf[crow(r, hi)]; } } while (0)
    f32x16 pA0, pA1, pB0, pB1;
    int sl_prev = 0, sl_cur = 0, sl_next = SLOTB;
#define ROT() do { sl_prev = sl_cur; sl_cur = sl_next; sl_next = (sl_next == (NSLOT - 1) * SLOTB) ? 0 : sl_next + SLOTB; } while (0)
    DMA_K(2, 2 * SLOTB);
    WAIT_BAR(3);
    qkt(pA0, pA1, Kbase, qr, negm, r32, hi); asm volatile("s_nop 15\n\ts_nop 7" : "+v"(pA0), "+v"(pA1)); MASKT(pA0, pA1, 0);
    START(pA0, pA1);
    _Pragma("unroll") for (int r = 0; r < 16; ++r) pA1[r] = __builtin_amdgcn_exp2f(pA1[r]);
    WAIT_BAR(0);
    DMA_K(3, 0); DMA_V(1, SLOTB);
    ROT();
    kload8(kf, kp0 + sl_cur);
    WAIT_BAR(2);
    s16x4 vlo[8], vhi[8]; u32x4 pw0, pw1, pw2, pw3;
#define PKW(P, B) cvtpk_s(P[B], P[B + 1])
#define PAF(k) __builtin_bit_cast(bf16x8, pw##k)
#define VFR(i) (bf16x8){vlo[i][0], vlo[i][1], vlo[i][2], vlo[i][3], vhi[i][0], vhi[i][1], vhi[i][2], vhi[i][3]}
#define PIN(x) asm volatile("" : "+v"(x))
#define MX3(a, b, c) __builtin_fmaxf(__builtin_fmaxf((a), (b)), (c))
#define GAPA(MF, A0, A1, A2, A3, W0, W1, PW) do { MF; sacc += A0; sacc += A1; sacc += A2; sacc += A3; PIN(sacc); W0; W1; PIN(PW); SBAR(); } while (0)
#define EX(v) __builtin_amdgcn_exp2f(v)
#define GAPB(MF, X, B) do { MF; X[B] = EX(X[B]); X[B + 1] = EX(X[B + 1]); X[B + 2] = EX(X[B + 2]); X[B + 3] = EX(X[B + 3]); PIN(X); SBAR(); } while (0)
#define VRD(i) do { vlo[i] = vtr(vp_ + (((i) >> 2) * 4096 + ((i) & 3) * 1024)); vhi[i] = vtr(vp_ + (((i) >> 2) * 4096 + ((i) & 3) * 1024 + 512)); } while (0)
#define KRD(G, j) do { if (G) { kload2(kf, kp0 + sl_next, j); SBAR(); } } while (0)
#define STEP(C0, C1, P0, P1, t, GK, GV, GL) do { SBAR(); \
    const lds_cptr vp_ = vp0 + sl_prev; \
    VRD(0); SBAR(); float sacc = (P0[0] + P0[1]); \
    GAPA(C0 = __builtin_amdgcn_mfma_f32_32x32x16_bf16(kf[0], qr[0], negm, 0, 0, 0), P0[2], P0[3], P0[4], P0[5],     pw0[0] = PKW(P0, 0), pw0[1] = PKW(P0, 2), pw0); \
    VRD(4); SBAR(); GAPA(C1 = __builtin_amdgcn_mfma_f32_32x32x16_bf16(kf[1], qr[0], negm, 0, 0, 0), P0[6], P0[7], P0[8], P0[9],     pw0[2] = PKW(P0, 4), pw0[3] = PKW(P0, 6), pw0); \
    VRD(1); SBAR(); GAPA(C0 = __builtin_amdgcn_mfma_f32_32x32x16_bf16(kf[2], qr[1], C0, 0, 0, 0),   P0[10], P0[11], P0[12], P0[13], pw1[0] = PKW(P0, 8), pw1[1] = PKW(P0, 10), pw1); \
    VRD(5); SBAR(); GAPA(C1 = __builtin_amdgcn_mfma_f32_32x32x16_bf16(kf[3], qr[1], C1, 0, 0, 0),   P0[14], P0[15], P1[0], P1[1],   pw1[2] = PKW(P0, 12), pw1[3] = PKW(P0, 14), pw1); \
    VRD(2); SBAR(); GAPA(C0 = __builtin_amdgcn_mfma_f32_32x32x16_bf16(kf[4], qr[2], C0, 0, 0, 0),   P1[2], P1[3], P1[4], P1[5],     pw2[0] = PKW(P1, 0), pw2[1] = PKW(P1, 2), pw2); \
    VRD(6); SBAR(); GAPA(C1 = __builtin_amdgcn_mfma_f32_32x32x16_bf16(kf[5], qr[2], C1, 0, 0, 0),   P1[6], P1[7], P1[8], P1[9],     pw2[2] = PKW(P1, 4), pw2[3] = PKW(P1, 6), pw2); \
    VRD(3); SBAR(); GAPA(C0 = __builtin_amdgcn_mfma_f32_32x32x16_bf16(kf[6], qr[3], C0, 0, 0, 0),   P1[10], P1[11], P1[12], P1[13], pw3[0] = PKW(P1, 8), pw3[1] = PKW(P1, 10), pw3); \
    VRD(7); SBAR(); GAPA(C1 = __builtin_amdgcn_mfma_f32_32x32x16_bf16(kf[7], qr[3], C1, 0, 0, 0),   P1[14], P1[15], 0.f, 0.f,       pw3[2] = PKW(P1, 12), pw3[3] = PKW(P1, 14), pw3); \
    l_reg += sacc; \
    if (GK) { DMA_K((t) + 3, sl_cur); } if (GV) { DMA_V((t) + 1, sl_next); } \
    MASKT(C0, C1, t); \
    { float a = MX3(C0[0], C0[1], C1[0]), b = MX3(C0[2], C0[3], C1[1]); a = MX3(a, C1[2], C1[3]); \
      _Pragma("unroll") for (int r = 4; r < 16; r += 4) { a = MX3(a, C0[r], C0[r + 1]); b = MX3(b, C0[r + 2], C0[r + 3]); a = MX3(a, C1[r], C1[r + 1]); b = MX3(b, C1[r + 2], C1[r + 3]); } \
      float rm = __builtin_fmaxf(a, b); { auto rr = __builtin_amdgcn_permlane32_swap(__float_as_uint(rm), __float_as_uint(rm), false, false); rm = __builtin_fmaxf(__uint_as_float(rr[0]), __uint_as_float(rr[1])); } \
      resc = false; \
      if (__builtin_expect(__any(rm > (float)THRL), 0)) { const float dl = __builtin_fmaxf(rm, 0.f); mhat += dl; \
        _Pragma("unroll") for (int r = 0; r < 16; ++r) { C0[r] -= dl; C1[r] -= dl; } \
        _Pragma("unroll") for (int r = 0; r < 16; ++r) negm[r] = -mhat; asm volatile("" : "+v"(negm)); \
        const float f = __builtin_amdgcn_exp2f(-dl); l_reg *= f; if (hi == 0) wsf[r32] = f; resc = true; } } \
    SBAR(); \
    GAPB(o[0] = __builtin_amdgcn_mfma_f32_32x32x16_bf16(PAF(0), VFR(0), o[0], 0, 0, 0), C0, 0); \
    GAPB(o[1] = __builtin_amdgcn_mfma_f32_32x32x16_bf16(PAF(0), VFR(4), o[1], 0, 0, 0), C0, 4); \
    KRD(GL, 0); GAPB(o[0] = __builtin_amdgcn_mfma_f32_32x32x16_bf16(PAF(1), VFR(1), o[0], 0, 0, 0), C0, 8); \
    KRD(GL, 1); GAPB(o[1] = __builtin_amdgcn_mfma_f32_32x32x16_bf16(PAF(1), VFR(5), o[1], 0, 0, 0), C0, 12); \
    KRD(GL, 2); GAPB(o[0] = __builtin_amdgcn_mfma_f32_32x32x16_bf16(PAF(2), VFR(2), o[0], 0, 0, 0), C1, 0); \
    KRD(GL, 3); GAPB(o[1] = __builtin_amdgcn_mfma_f32_32x32x16_bf16(PAF(2), VFR(6), o[1], 0, 0, 0), C1, 4); \
    GAPB(o[0] = __builtin_amdgcn_mfma_f32_32x32x16_bf16(PAF(3), VFR(3), o[0], 0, 0, 0), C1, 8); \
    GAPB(o[1] = __builtin_amdgcn_mfma_f32_32x32x16_bf16(PAF(3), VFR(7), o[1], 0, 0, 0), C1, 12); \
    } while (0)
    int t = 1;
    for (; t + 5 < NT; t += 2) {
        STEP(pB0, pB1, pA0, pA1, t, true, true, true);     WAIT_BAR(2); RESC(); ROT();
        STEP(pA0, pA1, pB0, pB1, t + 1, true, true, true); WAIT_BAR(2); RESC(); ROT();
    }
#define ENDW(tt) do { if ((tt) + 3 < NT) { WAIT_BAR(2); } else if ((tt) + 2 < NT) { WAIT_BAR(1); } else { WAIT_BAR(0); } } while (0)
    for (; t + 1 < NT; t += 2) {
        STEP(pB0, pB1, pA0, pA1, t, (t + 3 < NT), (t + 1 < NT), (t + 1 < NT));       ENDW(t);     RESC(); ROT();
        STEP(pA0, pA1, pB0, pB1, t + 1, (t + 4 < NT), (t + 2 < NT), (t + 2 < NT));   ENDW(t + 1); RESC(); ROT();
    }
    STEP(pB0, pB1, pA0, pA1, NT - 1, false, false, false); RESC();
    { float sacc = pB0[0] + pB0[1]; _Pragma("unroll") for (int r = 2; r < 16; ++r) sacc += pB0[r]; _Pragma("unroll") for (int r = 0; r < 16; ++r) sacc += pB1[r]; l_reg += sacc;
      pw0 = (u32x4){PKW(pB0, 0), PKW(pB0, 2), PKW(pB0, 4), PKW(pB0, 6)}; pw1 = (u32x4){PKW(pB0, 8), PKW(pB0, 10), PKW(pB0, 12), PKW(pB0, 14)}; pw2 = (u32x4){PKW(pB1, 0), PKW(pB1, 2), PKW(pB1, 4), PKW(pB1, 6)}; pw3 = (u32x4){PKW(pB1, 8), PKW(pB1, 10), PKW(pB1, 12), PKW(pB1, 14)};
      SBAR(); pv(o, vb0 + sl_cur, PAF(0), PAF(1), PAF(2), PAF(3)); }
#undef PKW
#undef PAF
#undef VFR
#undef PIN
#undef MX3
#undef GAPA
#undef GAPB
#undef EX
#undef VRD
#undef KRD
#undef STEP
#undef ENDW
    { auto rr = __builtin_amdgcn_permlane32_swap(__float_as_uint(l_reg), __float_as_uint(l_reg), false, false); l_reg = __uint_as_float(rr[0]) + __uint_as_float(rr[1]); }
    if (hi == 0) { wsf[32 + r32] = l_reg; if (OWN) wsf[r32] = mhat; } asm volatile("s_waitcnt lgkmcnt(0)" ::: "memory");
    float rli[16];
#pragma unroll
    for (int r = 0; r < 16; ++r) rli[r] = __builtin_amdgcn_rcpf(wsf[32 + crow(r, hi)]);
    bf16* Ow = O + (rowbase + q0 + wid * QBLK) * PITCH + h * D;
    { bf16* stg = (bf16*)(shm + LDS_OST) + wid * 2048;
#pragma unroll
      for (int r = 0; r < 16; ++r) { const int orow = crow(r, hi);
#pragma unroll
        for (int d0 = 0; d0 < 2; ++d0) stg[orow * 64 + d0 * 32 + r32] = __float2bfloat16(o[d0][r] * rli[r]); }
      asm volatile("s_waitcnt lgkmcnt(0)" ::: "memory");
      const int nsel = qb < 3 ? qb : 3;
#pragma unroll
      for (int i = 0; i < 4; ++i) { const int row = i * 8 + (lane >> 3), ch = lane & 7; u32x4 v = *(const u32x4*)(stg + row * 64 + ch * 8);
        if constexpr (OWN) {
          if (nsel > 0) {
            const float mo = wsf[row], lo = wsf[32 + row];
            const size_t e0 = (((size_t)(b * NHEAD + h)) * SEQ + q0 + wid * QBLK + row) * 3;
            float ms[3], ls[3]; u32x4 pp[3]; float M = mo;
#pragma unroll
            for (int s_ = 0; s_ < 3; ++s_) { ms[s_] = -INFINITY; ls[s_] = 0.f; pp[s_] = (u32x4){0u, 0u, 0u, 0u};
              if (s_ < nsel) { const f32x2 ml = *(const f32x2*)(PML + (e0 + s_) * 2); ms[s_] = ml.x; ls[s_] = ml.y; pp[s_] = *(const u32x4*)(PO + (e0 + s_) * 64 + ch * 8); M = fmaxf(M, ml.x); } }
            const float wo = lo * __builtin_amdgcn_exp2f(mo - M); float W = wo;
            float a[8] = {bflo(v.x) * wo, bfhi(v.x) * wo, bflo(v.y) * wo, bfhi(v.y) * wo, bflo(v.z) * wo, bfhi(v.z) * wo, bflo(v.w) * wo, bfhi(v.w) * wo};
#pragma unroll
            for (int s_ = 0; s_ < 3; ++s_) { const float w_ = (s_ < nsel) ? ls[s_] * __builtin_amdgcn_exp2f(ms[s_] - M) : 0.f; W += w_;
              a[0] += w_ * bflo(pp[s_].x); a[1] += w_ * bfhi(pp[s_].x); a[2] += w_ * bflo(pp[s_].y); a[3] += w_ * bfhi(pp[s_].y); a[4] += w_ * bflo(pp[s_].z); a[5] += w_ * bfhi(pp[s_].z); a[6] += w_ * bflo(pp[s_].w); a[7] += w_ * bfhi(pp[s_].w); }
            const float iw = 1.0f / W;
            v.x = cvtpk_s(a[0] * iw, a[1] * iw); v.y = cvtpk_s(a[2] * iw, a[3] * iw); v.z = cvtpk_s(a[4] * iw, a[5] * iw); v.w = cvtpk_s(a[6] * iw, a[7] * iw);
          } }
        if (do_store) *(u32x4*)(Ow + (long)row * PITCH + ch * 8) = v; } }
    asm volatile("s_waitcnt lgkmcnt(0)\n\ts_barrier" ::: "memory");
#undef DMA_K
#undef DMA_V
#undef TM
#undef MASKT
#undef START
#undef RESC
#undef ROT
}

__device__ __forceinline__ void select_unit(int b, int h, int qb, const bf16* Q, const float* ksum, unsigned short* LIST, unsigned* CNT, char* shm) {
    if (qb == 0) return;
    const int tid = threadIdx.x, lane = tid & 63, r32 = lane & 31, hi = lane >> 5; const int wid = __builtin_amdgcn_readfirstlane(tid >> 6);
    LAS unsigned* hist = (LAS unsigned*)shm; LAS unsigned* basev = hist + 32;
    if (tid < 32) hist[tid] = 0u;
    __syncthreads();
    int kbs[3] = {0, 1, 2}; const int ns = qb < 3 ? qb : 3;
    if (qb > 3) {
        const bf16* Qw = Q + ((long)b * SEQ + qb * QB + wid * QBLK) * PITCH + h * D;
        bf16x8 qr[4];
#pragma unroll
        for (int d0 = 0; d0 < 4; ++d0) qr[d0] = *reinterpret_cast<const bf16x8*>(&Qw[(long)r32 * PITCH + d0 * 16 + hi * 8]);
        gate_top3(ksum + ((size_t)(b * NHEAD + h) * 32) * 64, qr, qb, r32, hi, kbs);
    }
    unsigned pos[3] = {0u, 0u, 0u};
    if (hi == 0) {
#pragma unroll
        for (int s_ = 0; s_ < 3; ++s_) if (s_ < ns) pos[s_] = __hip_atomic_fetch_add(hist + kbs[s_], 1u, __ATOMIC_RELAXED, __HIP_MEMORY_SCOPE_WORKGROUP);
    }
    __syncthreads();
    const int bh = b * NHEAD + h;
    if (tid < 32) { const unsigned n = hist[tid]; basev[tid] = n ? __hip_atomic_fetch_add(CNT + bh * 32 + tid, n, __ATOMIC_RELAXED, __HIP_MEMORY_SCOPE_AGENT) : 0u; }
    __syncthreads();
    if (hi == 0) { const unsigned qv = (unsigned)(qb * QB + wid * QBLK + r32) << 2;
#pragma unroll
        for (int s_ = 0; s_ < 3; ++s_) if (s_ < ns) LIST[(size_t)(bh * 32 + kbs[s_]) * 8192 + basev[kbs[s_]] + pos[s_]] = (unsigned short)(qv | (unsigned)s_); }
    __syncthreads();
}

constexpr int G_K = 0, G_V = 32768, G_WS = 65536, G_OST = G_WS + NW * 512, G_TAB = G_OST + NW * 4096, G_BYTES = G_TAB + 8256 + 4096 + 4104;
template <int THRL> __device__ __forceinline__ void gather_phase(char* shm, const bf16* Q, const bf16* __restrict__ K, const bf16* __restrict__ V, const unsigned short* LIST, unsigned* CNT, bf16_t* PO, float* PML, int vcu, int G, bool do_store) {
    const int tid = threadIdx.x, lane = tid & 63, r32 = lane & 31, hi = lane >> 5; const int wid = __builtin_amdgcn_readfirstlane(tid >> 6);
    LAS int* pre = (LAS int*)(shm + G_TAB); LAS int* wtot = pre + 1032; LAS int* cntl = (LAS int*)(shm + G_TAB + 8256); LAS int* prw = (LAS int*)(shm + G_TAB + 8256 + 4096);
    constexpr int WL = 24, WP = 20;
    {
        const int c0 = (int)__hip_atomic_load(CNT + 2 * tid, __ATOMIC_RELAXED, __HIP_MEMORY_SCOPE_AGENT), c1 = (int)__hip_atomic_load(CNT + 2 * tid + 1, __ATOMIC_RELAXED, __HIP_MEMORY_SCOPE_AGENT);
        const int n0 = (c0 + 255) >> 8, n1 = (c1 + 255) >> 8, sm = n0 + n1;
        const int w0 = c0 ? WL + (n0 - 1) * WP + 12 + ((c0 - 256 * (n0 - 1) + 31) >> 5) : 0, w1 = c1 ? WL + (n1 - 1) * WP + 12 + ((c1 - 256 * (n1 - 1) + 31) >> 5) : 0, sw = w0 + w1;
        int v = sm, vw = sw;
#pragma unroll
        for (int o_ = 1; o_ < 64; o_ <<= 1) { const int t_ = __shfl_up(v, o_), tw_ = __shfl_up(vw, o_); if (lane >= o_) { v += t_; vw += tw_; } }
        if (lane == 63) { wtot[wid] = v; wtot[8 + wid] = vw; }
        cntl[2 * tid] = c0; cntl[2 * tid + 1] = c1;
        __syncthreads();
        int off = 0, offw = 0;
        for (int w_ = 0; w_ < wid; ++w_) { off += wtot[w_]; offw += wtot[8 + w_]; }
        const int excl = off + v - sm, exclw = offw + vw - sw;
        pre[2 * tid] = excl; pre[2 * tid + 1] = excl + n0; prw[2 * tid] = exclw; prw[2 * tid + 1] = exclw + w0;
        if (tid == NW * 64 - 1) { pre[1024] = excl + sm; prw[1024] = exclw + sw; }
        __syncthreads();
    }
    const int Wtot = __builtin_amdgcn_readfirstlane(prw[1024]);
    int ub[2], istart = 0;
#pragma unroll
    for (int e_ = 0; e_ < 2; ++e_) { const int tgt = (int)(((long)Wtot * (vcu + e_)) / G);
        int lo_ = 0, hi_ = 1024;
        while (hi_ - lo_ > 1) { const int mid = (lo_ + hi_) >> 1; if (__builtin_amdgcn_readfirstlane(prw[mid]) <= tgt) lo_ = mid; else hi_ = mid; }
        const int npi = __builtin_amdgcn_readfirstlane(pre[lo_ + 1]) - __builtin_amdgcn_readfirstlane(pre[lo_]);
        int p_ = (tgt - __builtin_amdgcn_readfirstlane(prw[lo_]) - WL + WP / 2) / WP; p_ = p_ < 0 ? 0 : (p_ > npi ? npi : p_);
        ub[e_] = (vcu + e_ >= G) ? __builtin_amdgcn_readfirstlane(pre[1024]) : __builtin_amdgcn_readfirstlane(pre[lo_]) + p_;
        if (e_ == 0 && vcu != 0) istart = lo_; }
    const int ulo = (vcu == 0) ? 0 : ub[0], uhi = ub[1];
    const unsigned lds0 = (unsigned)(uintptr_t)shm;
    float* wsf = (float*)(shm + G_WS) + wid * 128; int* ent = (int*)(wsf + 64);
    const unsigned kdst = lds0 + G_K + wid * 1024, vdst = lds0 + G_V + wid * 1024;
    const int vb0 = (int)(lds0 + G_V) + ((lane >> 4) & 1) * 32 + (lane & 3) * 8 + (4 * hi + ((lane & 15) >> 2)) * 64;
    int it0 = istart, it1 = istart, it2 = istart, cur = -1;
#define G_ITEM(itv, uu) do { while ((uu) < uhi && __builtin_amdgcn_readfirstlane(pre[(itv) + 1]) <= (uu)) ++(itv); } while (0)
#define G_ENTRY(itv, uu) ({ const int ps_ = (uu) - __builtin_amdgcn_readfirstlane(pre[itv]), cn_ = __builtin_amdgcn_readfirstlane(cntl[itv]); const int li_ = ps_ * 256 + wid * QBLK + r32; \
        (unsigned)LIST[(size_t)(itv) * 8192 + (li_ < cn_ ? li_ : 0)] | ((li_ < cn_) ? 0x10000u : 0u); })
#define G_QLOAD(dst, itv, ee) do { const int bh_ = (itv) >> 5; const bf16* Qrow_ = Q + ((long)(bh_ >> 3) * SEQ + (int)(((ee) & 0xffffu) >> 2)) * PITCH + (bh_ & 7) * D; \
        _Pragma("unroll") for (int d0 = 0; d0 < 4; ++d0) dst[d0] = *reinterpret_cast<const bf16x8*>(Qrow_ + d0 * 16 + hi * 8); } while (0)
    unsigned e0 = 0u, e1 = 0u, e2 = 0u; bf16x8 qr[4], qn[4];
    if (ulo < uhi) { G_ITEM(it0, ulo); e0 = G_ENTRY(it0, ulo); it1 = it0; { const int u1_ = (ulo + 1 < uhi) ? ulo + 1 : uhi - 1; G_ITEM(it1, u1_); e1 = G_ENTRY(it1, u1_); } G_QLOAD(qr, it0, e0); }
    it2 = it1;
    for (int u = ulo; u < uhi; ++u) {
        { const int u2_ = (u + 2 < uhi) ? u + 2 : uhi - 1; G_ITEM(it2, u2_); e2 = G_ENTRY(it2, u2_); }
        const int item = it0;
        const int bh = item >> 5, kb = item & 31, b = bh >> 3, h = bh & 7;
        if (item != cur) {
            asm volatile("s_waitcnt lgkmcnt(0)\n\ts_barrier" ::: "memory");
            const bf16* Kh = K + (long)b * SEQ * PITCH + h * D, *Vh = V + (long)b * SEQ * PITCH + h * D;
            const bf16* ksrc = Kh + (long)lane * PITCH + wid * 8;
            const bf16* vsrc = Vh + (long)(16 * (wid & 3) + (lane >> 2)) * PITCH + (wid >> 2) * 32 + (lane & 3) * 8;
#pragma unroll
            for (int t = 0; t < 4; ++t) { glds16(ksrc + (long)(4 * kb + t) * KVBLK * PITCH, (unsigned)__builtin_amdgcn_readfirstlane(kdst + t * 8192)); glds16(vsrc + (long)(4 * kb + t) * KVBLK * PITCH, (unsigned)__builtin_amdgcn_readfirstlane(vdst + t * 8192)); }
            asm volatile("s_waitcnt vmcnt(0)\n\ts_barrier" ::: "memory");
            cur = item;
            if (wid >= 4) __builtin_amdgcn_s_sleep(10);
        }
        G_QLOAD(qn, it1, e1);
        const bool valid = (e0 & 0x10000u) != 0u;
        const int q = (int)((e0 & 0xffffu) >> 2), slot = (int)(e0 & 3u);
        const bool wave_has_rows = __builtin_amdgcn_readfirstlane((int)(e0 >> 16) & 1) != 0 || __any(valid);
        if (wave_has_rows) {
        float mhat = 0.f, l_reg = 0.f; f32x16 o[2]; f32x16 negm;
#pragma unroll
        for (int r = 0; r < 16; ++r) { o[0][r] = 0.f; o[1][r] = 0.f; negm[r] = 0.f; }
        const lds_cptr kp0 = (lds_cptr)shm + G_K + hi * 1024 + r32 * 16; const lds_cptr vp0 = (lds_cptr)shm + G_V + ((lane >> 4) & 1) * 32 + (lane & 3) * 8 + (4 * hi + ((lane & 15) >> 2)) * 64;
        bf16x8 kf[8]; f32x16 p0, p1, s0, s1;
#define G_QK(D0, D1) do { D0 = __builtin_amdgcn_mfma_f32_32x32x16_bf16(kf[0], qr[0], negm, 0, 0, 0); D1 = __builtin_amdgcn_mfma_f32_32x32x16_bf16(kf[1], qr[0], negm, 0, 0, 0); \
            D0 = __builtin_amdgcn_mfma_f32_32x32x16_bf16(kf[2], qr[1], D0, 0, 0, 0); D1 = __builtin_amdgcn_mfma_f32_32x32x16_bf16(kf[3], qr[1], D1, 0, 0, 0); \
            D0 = __builtin_amdgcn_mfma_f32_32x32x16_bf16(kf[4], qr[2], D0, 0, 0, 0); D1 = __builtin_amdgcn_mfma_f32_32x32x16_bf16(kf[5], qr[2], D1, 0, 0, 0); \
            D0 = __builtin_amdgcn_mfma_f32_32x32x16_bf16(kf[6], qr[3], D0, 0, 0, 0); D1 = __builtin_amdgcn_mfma_f32_32x32x16_bf16(kf[7], qr[3], D1, 0, 0, 0); } while (0)
#define G_MX(D0, D1, FIRST) do { float a_ = fmaxf(fmaxf(D0[0], D0[1]), D1[0]), c_ = fmaxf(fmaxf(D0[2], D0[3]), D1[1]); a_ = fmaxf(fmaxf(a_, D1[2]), D1[3]); \
            _Pragma("unroll") for (int r = 4; r < 16; r += 4) { a_ = fmaxf(fmaxf(a_, D0[r]), D0[r + 1]); c_ = fmaxf(fmaxf(c_, D0[r + 2]), D0[r + 3]); a_ = fmaxf(fmaxf(a_, D1[r]), D1[r + 1]); c_ = fmaxf(fmaxf(c_, D1[r + 2]), D1[r + 3]); } \
            float rm_ = fmaxf(a_, c_); { auto rr_ = __builtin_amdgcn_permlane32_swap(__float_as_uint(rm_), __float_as_uint(rm_), false, false); rm_ = fmaxf(__uint_as_float(rr_[0]), __uint_as_float(rr_[1])); } \
            if (FIRST) { mhat = rm_; _Pragma("unroll") for (int r = 0; r < 16; ++r) { D0[r] -= rm_; D1[r] -= rm_; negm[r] = -mhat; } } \
            else if (__any(rm_ > (float)THRL)) { const float dl_ = fmaxf(rm_, 0.f); mhat += dl_; \
                _Pragma("unroll") for (int r = 0; r < 16; ++r) { D0[r] -= dl_; D1[r] -= dl_; negm[r] = -mhat; } \
                const float f_ = __builtin_amdgcn_exp2f(-dl_); l_reg *= f_; if (hi == 0) wsf[r32] = f_; \
                asm volatile("s_waitcnt lgkmcnt(0)" ::: "memory"); \
                _Pragma("unroll") for (int d_ = 0; d_ < 2; ++d_) _Pragma("unroll") for (int r = 0; r < 16; ++r) o[d_][r] *= wsf[crow(r, hi)]; } } while (0)
        const bool run_tiles = (GPROBE == 1) ? do_store : true;
        if (run_tiles) {
        kload8(kf, kp0);
        G_QK(p0, p1);
        kload8(kf, kp0 + 8192);
        G_MX(p0, p1, true);
#pragma unroll
        for (int t = 0; t < 4; ++t) {
            if (t < 3) { __builtin_amdgcn_sched_barrier(0); G_QK(s0, s1); if (t < 2) kload8(kf, kp0 + (t + 2) * 8192); }
            s16x4 vlo[8], vhi[8];
            const lds_cptr vp_ = vp0 + t * 8192;
#pragma unroll
            for (int i = 0; i < 8; ++i) { vlo[i] = vtr(vp_ + ((i >> 2) * 4096 + (i & 3) * 1024)); vhi[i] = vtr(vp_ + ((i >> 2) * 4096 + (i & 3) * 1024 + 512)); }
            __builtin_amdgcn_sched_barrier(0);
            float sacc = 0.f;
#pragma unroll
            for (int r = 0; r < 16; ++r) { p0[r] = __builtin_amdgcn_exp2f(p0[r]); p1[r] = __builtin_amdgcn_exp2f(p1[r]); sacc += p0[r] + p1[r]; }
            l_reg += sacc;
            const u32x4 pw0 = {cvtpk_s(p0[0], p0[1]), cvtpk_s(p0[2], p0[3]), cvtpk_s(p0[4], p0[5]), cvtpk_s(p0[6], p0[7])}, pw1 = {cvtpk_s(p0[8], p0[9]), cvtpk_s(p0[10], p0[11]), cvtpk_s(p0[12], p0[13]), cvtpk_s(p0[14], p0[15])};
            const u32x4 pw2 = {cvtpk_s(p1[0], p1[1]), cvtpk_s(p1[2], p1[3]), cvtpk_s(p1[4], p1[5]), cvtpk_s(p1[6], p1[7])}, pw3 = {cvtpk_s(p1[8], p1[9]), cvtpk_s(p1[10], p1[11]), cvtpk_s(p1[12], p1[13]), cvtpk_s(p1[14], p1[15])};
            __builtin_amdgcn_sched_barrier(0);
#define G_VF(i) (bf16x8){vlo[i][0], vlo[i][1], vlo[i][2], vlo[i][3], vhi[i][0], vhi[i][1], vhi[i][2], vhi[i][3]}
            if (GPROBE == 2 && !do_store) { asm volatile("" :: "v"(pw0), "v"(pw1), "v"(pw2), "v"(pw3)); } else {
            o[0] = __builtin_amdgcn_mfma_f32_32x32x16_bf16(__builtin_bit_cast(bf16x8, pw0), G_VF(0), o[0], 0, 0, 0); o[1] = __builtin_amdgcn_mfma_f32_32x32x16_bf16(__builtin_bit_cast(bf16x8, pw0), G_VF(4), o[1], 0, 0, 0);
            o[0] = __builtin_amdgcn_mfma_f32_32x32x16_bf16(__builtin_bit_cast(bf16x8, pw1), G_VF(1), o[0], 0, 0, 0); o[1] = __builtin_amdgcn_mfma_f32_32x32x16_bf16(__builtin_bit_cast(bf16x8, pw1), G_VF(5), o[1], 0, 0, 0);
            o[0] = __builtin_amdgcn_mfma_f32_32x32x16_bf16(__builtin_bit_cast(bf16x8, pw2), G_VF(2), o[0], 0, 0, 0); o[1] = __builtin_amdgcn_mfma_f32_32x32x16_bf16(__builtin_bit_cast(bf16x8, pw2), G_VF(6), o[1], 0, 0, 0);
            o[0] = __builtin_amdgcn_mfma_f32_32x32x16_bf16(__builtin_bit_cast(bf16x8, pw3), G_VF(3), o[0], 0, 0, 0); o[1] = __builtin_amdgcn_mfma_f32_32x32x16_bf16(__builtin_bit_cast(bf16x8, pw3), G_VF(7), o[1], 0, 0, 0);
            }
#undef G_VF
            if (t < 3) { G_MX(s0, s1, false); p0 = s0; p1 = s1; }
        }
        }
#undef G_QK
#undef G_MX
        { auto rr = __builtin_amdgcn_permlane32_swap(__float_as_uint(l_reg), __float_as_uint(l_reg), false, false); l_reg = __uint_as_float(rr[0]) + __uint_as_float(rr[1]); }
        const int er = valid ? (q * 3 + slot) : -1;
        if (hi == 0) { wsf[32 + r32] = l_reg; ent[r32] = er; } asm volatile("s_waitcnt lgkmcnt(0)" ::: "memory");
        float rli[16];
#pragma unroll
        for (int r = 0; r < 16; ++r) rli[r] = __builtin_amdgcn_rcpf(wsf[32 + crow(r, hi)]);
        bf16* stg = (bf16*)(shm + G_OST) + wid * 2048;
#pragma unroll
        for (int r = 0; r < 16; ++r) { const int orow = crow(r, hi);
#pragma unroll
            for (int d0 = 0; d0 < 2; ++d0) stg[orow * 64 + d0 * 32 + r32] = __float2bfloat16(o[d0][r] * rli[r]); }
        asm volatile("s_waitcnt lgkmcnt(0)" ::: "memory");
        const size_t ebase = (size_t)bh * SEQ * 3;
#pragma unroll
        for (int i = 0; i < 4; ++i) { const int row = i * 8 + (lane >> 3), ch = lane & 7; const u32x4 v = *(const u32x4*)(stg + row * 64 + ch * 8); const int er_ = ent[row];
            if (er_ >= 0 && do_store) *(u32x4*)(PO + (ebase + er_) * 64 + ch * 8) = v; }
        if (hi == 0 && valid && do_store) *(f32x2*)(PML + (ebase + er) * 2) = (f32x2){mhat, l_reg};
        asm volatile("s_waitcnt lgkmcnt(0)" ::: "memory");
        }
        e0 = e1; e1 = e2; it0 = it1; it1 = it2;
#pragma unroll
        for (int d0 = 0; d0 < 4; ++d0) qr[d0] = qn[d0];
    }
    asm volatile("s_waitcnt vmcnt(0) lgkmcnt(0)\n\ts_barrier" ::: "memory");
#undef G_ITEM
#undef G_ENTRY
#undef G_QLOAD
}
#undef SBAR
#undef WAIT_BAR
}

#define XB_TMO      128
#define XB_XCNT(j)  (256  + 64 * (j))
#define XB_XSUB(j)  (1280 + 64 * (j))
#define XB_XGEN(j)  (2304 + 64 * (j))
#define XB_TOP      3328
#define XB_TOPGEN   3392
#define XCD_BAR_WORDS 3456
#define XB_SPIN_CAP (1u << 18)
__device__ __forceinline__ unsigned xb_ld(unsigned* p)              { return __hip_atomic_load(p, __ATOMIC_RELAXED, __HIP_MEMORY_SCOPE_AGENT); }
__device__ __forceinline__ unsigned xb_add(unsigned* p, unsigned v) { return __hip_atomic_fetch_add(p, v, __ATOMIC_RELAXED, __HIP_MEMORY_SCOPE_AGENT); }
__device__ __forceinline__ unsigned xb_xcc_id() { return (unsigned)__builtin_amdgcn_s_getreg((3 << 11) | 20) & 0xFu; }
#define XB_SPIN(cond, bar) do { unsigned _sp = 0; while (cond) { __builtin_amdgcn_s_sleep(1); \
    if ((++_sp & 255u) == 0u) { if (xb_ld(&(bar)[XB_TMO])) break; if (_sp > XB_SPIN_CAP) { atomicAdd(&(bar)[XB_TMO], 1u); break; } } } } while (0)
struct XcdBarrier { unsigned* bar; unsigned x; volatile LAS unsigned* st; };
__device__ __forceinline__ XcdBarrier xcd_barrier_post(unsigned* bar, volatile LAS unsigned* st) {
    XcdBarrier b; b.bar = bar; b.x = xb_xcc_id(); b.st = st;
    if (threadIdx.x == 0) (void)xb_add(&bar[XB_XCNT(b.x)], 1u);
    return b;
}
__device__ __forceinline__ void xcd_barrier_complete(unsigned* bar, unsigned x, unsigned& nloc, unsigned& nx) {
    const unsigned G = gridDim.x * gridDim.y * gridDim.z;
    unsigned sum, cnt, mine, sp = 0u;
    for (;;) {
        sum = 0u; cnt = 0u; mine = 0u;
#pragma unroll
        for (unsigned j = 0; j < 16; ++j) { const unsigned c = xb_ld(&bar[XB_XCNT(j)]); sum += c; cnt += (c > 0u) ? 1u : 0u; mine = (j == x) ? c : mine; }
        if (sum == G) break;
        __builtin_amdgcn_s_sleep(1);
        if ((++sp & 255u) == 0u) { if (xb_ld(&bar[XB_TMO])) break; if (sp > XB_SPIN_CAP) { atomicAdd(&bar[XB_TMO], 1u); break; } }
    }
    nloc = mine > 0u ? mine : 1u; nx = cnt > 0u ? cnt : 1u;
}
__device__ __forceinline__ void xcd_barrier_(const XcdBarrier& b);
__device__ __forceinline__ void xcd_barrier(const XcdBarrier& b) { T_BEGIN(1, t1_) xcd_barrier_(b); T_END(1, t1_); }
__device__ __forceinline__ void xcd_barrier_(const XcdBarrier& b) {
    asm volatile("s_waitcnt vmcnt(0)" ::: "memory");
    __syncthreads();
    if (threadIdx.x == 0) {
        unsigned* bar = b.bar;
        __builtin_amdgcn_s_waitcnt(0);
        unsigned nloc = b.st[0], nx = b.st[1];
        if (nloc == 0u) { xcd_barrier_complete(bar, b.x, nloc, nx); b.st[0] = nloc; b.st[1] = nx; }
        const unsigned old = xb_add(&bar[XB_XSUB(b.x)], 1u);
        const unsigned gen = old / nloc;
        if (old + 1u == (gen + 1u) * nloc) {
            __builtin_amdgcn_fence(__ATOMIC_RELEASE, "agent");
            asm volatile("s_waitcnt vmcnt(0)" ::: "memory");
            const unsigned og = xb_add(&bar[XB_TOP], 1u);
            const unsigned tg = og / nx;
            if (og + 1u == (tg + 1u) * nx) xb_add(&bar[XB_TOPGEN], 1u);
            else XB_SPIN(xb_ld(&bar[XB_TOPGEN]) == tg, bar);
            __builtin_amdgcn_fence(__ATOMIC_ACQUIRE, "agent");
            xb_add(&bar[XB_XGEN(b.x)], 1u);
            asm volatile("s_waitcnt vmcnt(0)" ::: "memory");
        } else {
            XB_SPIN(xb_ld(&bar[XB_XGEN(b.x)]) == gen, bar);
            __builtin_amdgcn_fence(__ATOMIC_ACQUIRE, "agent");
            asm volatile("s_waitcnt vmcnt(0)" ::: "memory");
        }
    }
    __syncthreads();
}

struct Args { const float* in[22]; float* out; unsigned char* ws; int ph_lo, ph_hi, li, flags; };
struct Frame {
    LAS unsigned char* lds; volatile LAS unsigned* MISC; gu32* ctl;
    int tid, lane, wave, vcu, G;
};
#ifndef SKEW_P2
#define SKEW_P2 0
#endif
#ifndef SKEW_P45
#define SKEW_P45 0
#endif
__device__ __forceinline__ void phase_skew(int vcu, unsigned ticks) {
    if (ticks) { const unsigned long long t0 = __builtin_amdgcn_s_memrealtime(), d = (unsigned long long)(vcu & 7) * ticks;
        while (__builtin_amdgcn_s_memrealtime() - t0 < d) __builtin_amdgcn_s_sleep(8); }
}
__device__ __forceinline__ int fresh_tid() { int t = threadIdx.x; asm volatile("" : "+v"(t)); return t; }
#define PHASE_IDS() do { F.tid = fresh_tid(); F.lane = F.tid & 63; F.wave = __builtin_amdgcn_readfirstlane(F.tid >> 6); } while (0)

__device__ __forceinline__ void transpose_item(const float* W, int ldw, int k0, int n0, bf16_t* WT, size_t row_off, int Kd, LAS float* scr, int lane) {
    const int qr_ = lane >> 4, j4 = 4 * (lane & 15);
#pragma unroll 8
    for (int i = 0; i < 16; ++i) { const int kk = 4 * i + qr_; const f32x4 v = *(const f32x4*)(W + (size_t)(k0 + kk) * ldw + n0 + j4); LAS float* d = scr + kk * 65 + j4; d[0] = v.x; d[1] = v.y; d[2] = v.z; d[3] = v.w; }
    LDS_WAIT(); asm volatile("" ::: "memory");
    const int c = lane & 7;
#pragma unroll
    for (int j = 0; j < 8; ++j) { const int n = (lane >> 3) + 8 * j; const LAS float* s = scr + (8 * c) * 65 + n;
        u32x4 o; o.x = cvt_pk_bf16(s[0 * 65], s[1 * 65]); o.y = cvt_pk_bf16(s[2 * 65], s[3 * 65]); o.z = cvt_pk_bf16(s[4 * 65], s[5 * 65]); o.w = cvt_pk_bf16(s[6 * 65], s[7 * 65]);
        *(u32x4*)(WT + (row_off + n0 + n) * (size_t)Kd + k0 + 8 * c) = o; }
    LDS_WAIT(); asm volatile("" ::: "memory");
}

__global__ void __launch_bounds__(NWAVES * 64, 2) hybrid_fwd(Args args) {
    extern __shared__ __attribute__((aligned(16))) unsigned char lds_raw[];
    Frame F;
    F.lds = (LAS unsigned char*)lds_raw;
    F.MISC = (volatile LAS unsigned*)(F.lds + MISC_OFF);
    F.tid = threadIdx.x; F.lane = F.tid & 63; F.wave = __builtin_amdgcn_readfirstlane(F.tid >> 6);
    F.G = gridDim.x; { const int bx = blockIdx.x; F.vcu = (F.G % 8 == 0) ? (bx % 8) * (F.G / 8) + bx / 8 : bx; }
    unsigned char* ws = args.ws;
    F.ctl = (gu32*)(ws + WS_CTL);
    const float* x = args.in[0]; const float* cvec = args.in[1]; const float* ada_w = args.in[2]; const float* ada_b = args.in[3];
    const float* norm1_g = args.in[4]; const float* norm2_g = args.in[5]; const float* w_in = args.in[6]; const float* gmlp_ln_g = args.in[7]; const float* gmlp_ln_b = args.in[8];
    const float* w_spatial = args.in[9]; const float* b_spatial = args.in[10]; const float* w_branch_a = args.in[11]; const float* w_branch_b = args.in[12]; const float* w_out = args.in[13];
    const float* w_rg = args.in[14]; const float* b_rg = args.in[15]; const float* w_re = args.in[16]; const float* b_re = args.in[17];
    const float* w_gate = args.in[18]; const float* w_up = args.in[19]; const float* w_down = args.in[20]; const float* final_g = args.in[21];
    float* out = args.out;
    float* KSUM = (float*)(ws + WS_KSUM); float* MODP = (float*)(ws + WS_MODP); float* MOD = (float*)(ws + WS_MOD); float* ROPE = (float*)(ws + WS_ROPE);
    bf16_t* WST = (bf16_t*)(ws + WS_WST); bf16_t* WRT = (bf16_t*)(ws + WS_WRT); float* SSQ = (float*)(ws + WS_SSQ);
    unsigned long long* ROUTE = (unsigned long long*)(ws + WS_ROUTE);
    bf16_t* WIN = (bf16_t*)(ws + WS_WIN); bf16_t* WAB = (bf16_t*)(ws + WS_WAB); bf16_t* WOUT = (bf16_t*)(ws + WS_WOUT);
    bf16_t* WGU = (bf16_t*)(ws + WS_WGU); bf16_t* WD = (bf16_t*)(ws + WS_WD);
    bf16_t* XN = (bf16_t*)(ws + WS_XN); bf16_t* PROJ = (bf16_t*)(ws + WS_PROJ); bf16_t* HID = (bf16_t*)(ws + WS_HID); bf16_t* YB = (bf16_t*)(ws + WS_Y); bf16_t* X1 = (bf16_t*)(ws + WS_X1);
    bf16_t* PO = (bf16_t*)(ws + WS_PO); float* PML = (float*)(ws + WS_PML); unsigned short* LIST = (unsigned short*)(ws + WS_LIST); unsigned* CNT = (unsigned*)(F.ctl + CW_CNT);

    for (int u = F.tid; u < 256; u += NWAVES * 64) ((LAS unsigned*)(F.lds + MISC_OFF))[u] = 0u;
    __syncthreads();
    XcdBarrier bar; bar.bar = (unsigned*)(F.ctl + CW_BAR) + args.li * XCD_BAR_WORDS; bar.x = 0; bar.st = nullptr;
    if (!MK_PER_PHASE) bar = xcd_barrier_post((unsigned*)(F.ctl + CW_BAR) + args.li * XCD_BAR_WORDS, F.MISC + 8);
    const int lo = args.ph_lo, hi = args.ph_hi;
#define IN(k) (lo <= (k) && (k) < hi)
#define PH_SET(k) do { if (TSEL != 0 && blockIdx.x == TBLK && threadIdx.x == 0) g_tphase = (k); } while (0)
    if (TSEL != 0 && blockIdx.x == TBLK && threadIdx.x == 0) { g_tacc = 0; g_tphase = -2; }
#define SEAM(k) do { if (IN(k) && IN((k) + 1)) xcd_barrier(bar); } while (0)

    PH_SET(0); TP_BEGIN(0, tp0_) if (IN(0)) { PHASE_IDS();
        const int gw = F.vcu * NWAVES + F.wave, NGW = F.G * NWAVES;
        const int gtid = F.vcu * (NWAVES * 64) + F.tid, NGT = F.G * NWAVES * 64;
        LAS float* scr = (LAS float*)(F.lds + F.wave * 16640);
        constexpr int I_MOD = 16 * 24, I_IN = 16 * 72, I_A = 8 * 16, I_O = 16 * 16;
        constexpr int NITEMS = I_MOD + I_IN + 2 * I_A + I_O;
        for (int it = gw; it < NITEMS; it += NGW) {
            int r = it;
            if (r < I_MOD) {
                const int s = r / 24, nc = r % 24, n = nc * 256 + 4 * F.lane;
                f32x4 a0 = {0.f, 0.f, 0.f, 0.f}, a1 = a0, a2 = a0, a3 = a0;
#pragma unroll 8
                for (int kk = 0; kk < 64; ++kk) { const int k = 64 * s + kk; const f32x4 w = *(const f32x4*)(ada_w + (size_t)k * 6144 + n);
                    a0 += w * cvec[k]; a1 += w * cvec[1024 + k]; a2 += w * cvec[2048 + k]; a3 += w * cvec[3072 + k]; }
                float* dst = MODP + (size_t)s * 24576 + n;
                *(f32x4*)(dst) = a0; *(f32x4*)(dst + 6144) = a1; *(f32x4*)(dst + 12288) = a2; *(f32x4*)(dst + 18432) = a3;
                continue; }
            r -= I_MOD;
            if (r < I_IN) { transpose_item(w_in, PC, 64 * (r / 72), 64 * (r % 72), WIN, 0, 1024, scr, F.lane); continue; } r -= I_IN;
            if (r < I_A) { transpose_item(w_branch_a, 1024, 64 * (r / 16), 64 * (r % 16), WAB, 0, 1024, scr, F.lane); continue; } r -= I_A;
            if (r < I_A) { transpose_item(w_branch_b, 1024, 64 * (r / 16), 64 * (r % 16), WAB + 512, 0, 1024, scr, F.lane); continue; } r -= I_A;
            transpose_item(w_out, 1024, 64 * (r / 16), 64 * (r % 16), WOUT, 0, 1024, scr, F.lane);
        }
        for (int i = gtid; i < 65536; i += NGT) {
            const int pos = i >> 3, j = i & 7; const float inv = powf(500000.0f, -(float)j * 2.0f / 16.0f); const float ang = (float)pos * inv;
            ROPE[i] = cosf(ang); ROPE[65536 + i] = sinf(ang); }
        for (int i = gtid; i < 65536; i += NGT) {
            const int s = i & 127, t_ = (i >> 7) & 127; const float v = (s <= t_) ? w_spatial[i] : 0.f; WST[i] = (bf16_t)(cvt_pk_bf16(v, 0.f) & 0xffffu); }
        for (int i = gtid; i < 48 * 1024; i += NGT) {
            const int j = i >> 10, k = i & 1023; float v = 0.f; if (j < 4) v = w_rg[k * 4 + j]; else if (j < 36) v = w_re[k * 32 + (j - 4)];
            const unsigned hb = cvt_pk_bf16(v, 0.f) & 0xffffu; const float lo = v - bflo(hb);
            WRT[i] = (bf16_t)hb; WRT[48 * 1024 + i] = (bf16_t)(cvt_pk_bf16(lo, 0.f) & 0xffffu); }
    }
    TP_END(0, tp0_); SEAM(0);

    PH_SET(1); TP_BEGIN(1, tp1_) if (IN(1)) { PHASE_IDS();
        const int c = F.vcu, b = c >> 6;
        LAS float* f = (LAS float*)F.lds;
        for (int v = F.tid; v < 2048; v += NWAVES * 64) { float s = ada_b[v];
#pragma unroll
            for (int sl = 0; sl < 16; ++sl) s += MODP[(size_t)sl * 24576 + b * 6144 + v];
            f[v] = s; }
        if (F.tid < 96) { const int idx = 96 * c + F.tid; float s = ada_b[idx % 6144];
#pragma unroll
            for (int sl = 0; sl < 16; ++sl) s += MODP[(size_t)sl * 24576 + idx];
            MOD[idx] = s; }
        __syncthreads();
        f32x4 A1[4], B1[4];
#pragma unroll
        for (int j = 0; j < 4; ++j) { const int k = 4 * F.lane + 256 * j; const f32x4 g = *(const f32x4*)(norm1_g + k);
#pragma unroll
            for (int i = 0; i < 4; ++i) { A1[j][i] = g[i] * (1.0f + f[1024 + k + i]); B1[j][i] = f[k + i]; } }
        for (int i0 = 0; i0 < 16; i0 += 4) {
            f32x4 v[4][4]; float ss[4];
#pragma unroll
            for (int u_ = 0; u_ < 4; ++u_) { const size_t row = (size_t)c * 128 + F.wave * 16 + i0 + u_; const f32x4* xr = (const f32x4*)(x + row * DM) + F.lane;
#pragma unroll
                for (int j = 0; j < 4; ++j) v[u_][j] = xr[64 * j]; }
#pragma unroll
            for (int u_ = 0; u_ < 4; ++u_) { float s = 0.f;
#pragma unroll
                for (int j = 0; j < 4; ++j) s += (v[u_][j].x * v[u_][j].x + v[u_][j].y * v[u_][j].y) + (v[u_][j].z * v[u_][j].z + v[u_][j].w * v[u_][j].w);
                ss[u_] = s; }
#pragma unroll
            for (int o_ = 1; o_ < 64; o_ <<= 1) {
#pragma unroll
                for (int u_ = 0; u_ < 4; ++u_) ss[u_] += __shfl_xor(ss[u_], o_); }
#pragma unroll
            for (int u_ = 0; u_ < 4; ++u_) { const size_t row = (size_t)c * 128 + F.wave * 16 + i0 + u_; const float rstd = 1.0f / sqrtf(ss[u_] * (1.0f / DM) + EPS);
                u32x2* o8 = (u32x2*)(XN + row * DM) + F.lane;
#pragma unroll
                for (int j = 0; j < 4; ++j) { const f32x4 hv = v[u_][j] * rstd * A1[j] + B1[j]; u32x2 w; w.x = cvt_pk_bf16(hv.x, hv.y); w.y = cvt_pk_bf16(hv.z, hv.w); o8[64 * j] = w; } } }
        __syncthreads();
    }
    TP_END(1, tp1_); SEAM(1);

    PH_SET(2); TP_BEGIN(2, tp2_) if (IN(2)) {
        pg8::DenseSched S; S.init(XN, DM, WIN, DM, T, PC, F.G, (int)blockIdx.x);
        pg8::EpiProj E{PROJ, ROPE, KSUM};
        phase_skew(F.vcu, SKEW_P2);
        pg8::gemm_phase<pg8::EpiProj, pg8::DenseSched, false>(F.lds, S, E);
    }
    TP_END(2, tp2_); SEAM(2);

    PH_SET(3); TP_BEGIN(3, tp3_) if (IN(3)) { PHASE_IDS();
        for (int chunk = F.vcu; chunk < ((args.flags & 2) ? 0 : T / 128); chunk += F.G) {
            const int lane = F.lane, w = F.wave, q = lane >> 4, l15 = lane & 15;
            const size_t row0 = (size_t)chunk * 128;
            float lg[8], lb[8];
            { const f32x4 g0 = *(const f32x4*)(gmlp_ln_g + 8 * lane), g1 = *(const f32x4*)(gmlp_ln_g + 8 * lane + 4), b0 = *(const f32x4*)(gmlp_ln_b + 8 * lane), b1 = *(const f32x4*)(gmlp_ln_b + 8 * lane + 4);
#pragma unroll
              for (int j = 0; j < 4; ++j) { lg[j] = g0[j]; lg[4 + j] = g1[j]; lb[j] = b0[j]; lb[4 + j] = b1[j]; } }
            u32x4 vn[16];
#pragma unroll
            for (int i = 0; i < 16; ++i) vn[i] = *(const u32x4*)(PROJ + (row0 + 16 * w + i) * PC + C_V + 8 * lane);
#pragma unroll
            for (int hb = 0; hb < 16; hb += 8) {
                float s1[8], s2[8];
#pragma unroll
                for (int i = 0; i < 8; ++i) { const u32x4 raw = vn[hb + i];
                    u32x4 gv; gv.x = cvt_pk_bf16(gelu_tanh(bflo(raw.x)), gelu_tanh(bfhi(raw.x))); gv.y = cvt_pk_bf16(gelu_tanh(bflo(raw.y)), gelu_tanh(bfhi(raw.y)));
                    gv.z = cvt_pk_bf16(gelu_tanh(bflo(raw.z)), gelu_tanh(bfhi(raw.z))); gv.w = cvt_pk_bf16(gelu_tanh(bflo(raw.w)), gelu_tanh(bfhi(raw.w)));
                    const float v0 = bflo(gv.x), v1 = bfhi(gv.x), v2 = bflo(gv.y), v3 = bfhi(gv.y), v4 = bflo(gv.z), v5 = bfhi(gv.z), v6 = bflo(gv.w), v7 = bfhi(gv.w);
                    s1[i] = ((v0 + v1) + (v2 + v3)) + ((v4 + v5) + (v6 + v7)); s2[i] = ((v0 * v0 + v1 * v1) + (v2 * v2 + v3 * v3)) + ((v4 * v4 + v5 * v5) + (v6 * v6 + v7 * v7));
                    vn[hb + i] = gv; }
#pragma unroll
                for (int o_ = 1; o_ < 64; o_ <<= 1) {
#pragma unroll
                    for (int i = 0; i < 8; ++i) { s1[i] += __shfl_xor(s1[i], o_); s2[i] += __shfl_xor(s2[i], o_); } }
#pragma unroll
                for (int i = 0; i < 8; ++i) { const float mean = s1[i] * (1.0f / 512.0f); const float var = fmaxf(s2[i] * (1.0f / 512.0f) - mean * mean, 0.f); const float rstd = 1.0f / sqrtf(var + EPS);
                    const u32x4 gv = vn[hb + i]; float v[8] = {bflo(gv.x), bfhi(gv.x), bflo(gv.y), bfhi(gv.y), bflo(gv.z), bfhi(gv.z), bflo(gv.w), bfhi(gv.w)};
#pragma unroll
                    for (int j = 0; j < 8; ++j) v[j] = (v[j] - mean) * rstd * lg[j] + lb[j];
                    vn[hb + i].x = cvt_pk_bf16(v[0], v[1]); vn[hb + i].y = cvt_pk_bf16(v[2], v[3]); vn[hb + i].z = cvt_pk_bf16(v[4], v[5]); vn[hb + i].w = cvt_pk_bf16(v[6], v[7]); }
            }
            const int tt = 16 * w + l15;
            u32x2 wfr[4][2]; u32x4 uq[4];
#define GM_LOAD(WF, UQ, g_) do { const bf16_t* wp_ = WST + ((size_t)((g_) * 128 + tt)) * 128 + 4 * q; \
                _Pragma("unroll") for (int ks = 0; ks < 4; ++ks) { WF[ks][0] = *(const u32x2*)(wp_ + 32 * ks); WF[ks][1] = *(const u32x2*)(wp_ + 32 * ks + 16); } \
                _Pragma("unroll") for (int i = 0; i < 4; ++i) UQ[i] = *(const u32x4*)(PROJ + (row0 + 16 * w + 4 * i + q) * PC + C_U + 128 * (g_) + 8 * l15); } while (0)
            GM_LOAD(wfr, uq, 0);
#pragma unroll
            for (int g = 0; g < 4; ++g) {
                __syncthreads();
                if (q == g) {
#pragma unroll
                    for (int i = 0; i < 16; ++i) *(LAS u32x4*)(F.lds + (16 * w + i) * 288 + l15 * 16) = vn[i];
                }
                __syncthreads();
                u32x2 wfn[4][2]; u32x4 uqn[4];
                if (g < 3) GM_LOAD(wfn, uqn, g + 1);
                f32x4 acc[8];
#pragma unroll
                for (int it = 0; it < 8; ++it) acc[it] = (f32x4){0.f, 0.f, 0.f, 0.f};
                const int nks = (16 * w + 16 + 31) / 32;
#pragma unroll
                for (int ks = 0; ks < 4; ++ks) { if (ks < nks) {
                    const bf16x8 bw = __builtin_bit_cast(bf16x8, (u32x4){wfr[ks][0].x, wfr[ks][0].y, wfr[ks][1].x, wfr[ks][1].y});
                    const attn_body::lds_cptr base = (attn_body::lds_cptr)F.lds + (32 * ks + 4 * q + (l15 >> 2)) * 288 + (l15 & 3) * 8;
#pragma unroll
                    for (int it = 0; it < 8; ++it) {
                        const s16x4 lo = attn_body::vtr(base + it * 32), hi_ = attn_body::vtr(base + 16 * 288 + it * 32);
                        const bf16x8 a = (bf16x8){lo[0], lo[1], lo[2], lo[3], hi_[0], hi_[1], hi_[2], hi_[3]};
                        acc[it] = __builtin_amdgcn_mfma_f32_16x16x32_bf16(a, bw, acc[it], 0, 0, 0);
                    } } }
                const float bs = b_spatial[g * 128 + tt];
                LAS unsigned char* svb = F.lds + 36864;
#pragma unroll
                for (int it = 0; it < 8; ++it) { u32x2 o; o.x = cvt_pk_bf16(acc[it][0] + bs, acc[it][1] + bs); o.y = cvt_pk_bf16(acc[it][2] + bs, acc[it][3] + bs);
                    *(LAS u32x2*)(svb + tt * 272 + (16 * it + 4 * q) * 2) = o; }
                LDS_WAIT(); asm volatile("" ::: "memory");
#pragma unroll
                for (int i = 0; i < 4; ++i) { const int tr_ = 16 * w + 4 * i + q; bf16_t* pp = PROJ + (row0 + tr_) * PC + C_U + 128 * g + 8 * l15;
                    const u32x4 uu = uq[i]; const u32x4 sv = *(const LAS u32x4*)(svb + tr_ * 272 + l15 * 16);
                    u32x4 o; o.x = cvt_pk_bf16(gelu_tanh(bflo(uu.x)) * bflo(sv.x), gelu_tanh(bfhi(uu.x)) * bfhi(sv.x)); o.y = cvt_pk_bf16(gelu_tanh(bflo(uu.y)) * bflo(sv.y), gelu_tanh(bfhi(uu.y)) * bfhi(sv.y));
                    o.z = cvt_pk_bf16(gelu_tanh(bflo(uu.z)) * bflo(sv.z), gelu_tanh(bfhi(uu.z)) * bfhi(sv.z)); o.w = cvt_pk_bf16(gelu_tanh(bflo(uu.w)) * bflo(sv.w), gelu_tanh(bfhi(uu.w)) * bfhi(sv.w));
                    *(u32x4*)pp = o; }
                LDS_WAIT(); asm volatile("" ::: "memory");
                if (g < 3) {
#pragma unroll
                    for (int ks = 0; ks < 4; ++ks) { wfr[ks][0] = wfn[ks][0]; wfr[ks][1] = wfn[ks][1]; }
#pragma unroll
                    for (int i = 0; i < 4; ++i) uq[i] = uqn[i]; }
            }
            __syncthreads();
        }
        {
            using namespace attn_body;
            const int s = F.vcu & 7, bh = F.vcu >> 3;
            const bf16* Qp = (const bf16*)(PROJ + C_Q); const bf16* Kp = (const bf16*)(PROJ + C_K); const bf16* Vp = (const bf16*)(PROJ + C_VV);
#define QBI(i) (((i) == 0) ? s : ((i) == 1) ? 15 - s : ((i) == 2) ? 16 + s : 31 - s)
            if (ATTN_MODE != 0) {
                if (bh < NB * 8 && !(args.flags & 4)) for (int i = 0; i < 4; ++i) select_unit(bh >> 3, bh & 7, QBI(i), Qp, KSUM, LIST, CNT, (char*)lds_raw + 40960);
                TP_END(3, tp3_);
                if (!MK_PER_PHASE) xcd_barrier(bar);
                PH_SET(31); TP_BEGIN(31, tp31_)
                unsigned long long tg0_ = 0; if (TSEL >= 5 && TSEL <= 7) tg0_ = __builtin_amdgcn_s_memrealtime();
                if (!(args.flags & 8)) gather_phase<8>((char*)lds_raw, Qp, Kp, Vp, LIST, CNT, PO, PML, F.vcu, F.G, (args.flags & 1) == 0);
                TP_END(31, tp31_);
                if (TSEL >= 5 && TSEL <= 7) { if (threadIdx.x == 0) __hip_atomic_store(&g_tw[F.vcu], (unsigned)(__builtin_amdgcn_s_memrealtime() - tg0_), __ATOMIC_RELAXED, __HIP_MEMORY_SCOPE_AGENT); }
                if (!MK_PER_PHASE) xcd_barrier(bar);
                if (TSEL == 5 || TSEL == 6) { if (blockIdx.x == TBLK && threadIdx.x == 0) { unsigned mx = 0, am = 0; for (int i = 0; i < 256; ++i) { const unsigned t_ = __hip_atomic_load(&g_tw[i], __ATOMIC_RELAXED, __HIP_MEMORY_SCOPE_AGENT); if (t_ > mx) { mx = t_; am = i; } }
                    g_tacc += (TSEL == 5) ? mx : am * 100u; } }
                if (TSEL == 7) { if (blockIdx.x == 0 && threadIdx.x == 0) g_tacc += __hip_atomic_load(&g_tw[TVCU], __ATOMIC_RELAXED, __HIP_MEMORY_SCOPE_AGENT); }
                PH_SET(32);
                bf16* Op = (bf16*)(PROJ + (ATTN_MODE == 2 ? C_V : C_Q));
                TP_BEGIN(32, tp32_)
                if (bh < NB * 8 && !(args.flags & 16)) for (int i = 0; i < 4; ++i) attn_unit<8, true>(bh >> 3, bh & 7, QBI(i), Qp, Kp, Vp, Op, KSUM, (char*)lds_raw, (args.flags & 1) == 0, PO, PML);
                TP_END(32, tp32_);
            }
            if (ATTN_MODE == 0) {
                if (bh < NB * 8) for (int i = 0; i < 4; ++i) attn_unit<8, false>(bh >> 3, bh & 7, QBI(i), Qp, Kp, Vp, (bf16*)(PROJ + C_Q), KSUM, (char*)lds_raw, (args.flags & 1) == 0, PO, PML);
            }
#undef QBI
#undef GM_LOAD
        }
        VM_WAIT(); __syncthreads();
    }
    SEAM(3);

    PH_SET(4); TP_BEGIN(4, tp4_) if (IN(4)) {
        pg8::DenseSched S; S.init(PROJ + C_U, PC, WAB, 1024, T, DM, F.G, (int)blockIdx.x); S.ksplit = 8; S.kgap = (unsigned)(C_Q - C_U - 512) * 2u;
        pg8::EpiMergeF E{PROJ, XN};
        phase_skew(F.vcu, SKEW_P45);
        pg8::gemm_phase<pg8::EpiMergeF, pg8::DenseSched, false>(F.lds, S, E);
    }
    TP_END(4, tp4_); SEAM(4);

    PH_SET(5); TP_BEGIN(5, tp5_) if (IN(5)) {
        pg8::DenseSched S; S.init(XN, DM, WOUT, DM, T, DM, F.G, (int)blockIdx.x); pg8::EpiOut E{x, X1, MOD, SSQ};
        phase_skew(F.vcu, SKEW_P45);
        pg8::gemm_phase<pg8::EpiOut, pg8::DenseSched, false>(F.lds, S, E);
    }
    TP_END(5, tp5_); SEAM(5);

    PH_SET(6); TP_BEGIN(6, tp6_) if (IN(6)) { PHASE_IDS();
        {
            LAS float* scr = (LAS float*)(F.lds + F.wave * 16640);
            const int gw = F.vcu * NWAVES + F.wave, NGW = F.G * NWAVES;
            constexpr int I_G = 32 * 16 * 8, I_D = 32 * 8 * 16;
            for (int it = gw; it < 2 * I_G + I_D; it += NGW) { int r = it;
                if (r < 2 * I_G) { const bool up = r >= I_G; if (up) r -= I_G; const int e = r / 128, kb = (r % 128) / 8, nb = r % 8, n0 = 64 * nb;
                    const size_t row_off = (size_t)e * 1024 + (size_t)(n0 / 128) * 256 + (up ? 128 : 0) + (n0 % 128) - n0;
                    transpose_item((up ? w_up : w_gate) + (size_t)e * 1024 * 512, 512, 64 * kb, n0, WGU, row_off, 1024, scr, F.lane); continue; }
                r -= 2 * I_G;
                { const int e = r / 128, kb = (r % 128) / 16, nb = r % 16; transpose_item(w_down + (size_t)e * 512 * 1024, 1024, 64 * kb, 64 * nb, WD, (size_t)e * 1024, 512, scr, F.lane); } }
            __syncthreads();
        }
        TP_END(6, tp6_);
        TP_BEGIN(61, tp61_)
        const int c = F.vcu, b = c >> 6, lane = F.lane, w = F.wave, r = lane & 15, q = lane >> 4;
        constexpr int WPITCH = 1056, WPLANE = 48 * WPITCH, WL_OFF = 8192, LG_OFF = WL_OFF + 2 * WPLANE, HI_OFF = LG_OFF + 8 * 3072;
        static_assert(HI_OFF + 512 <= MISC_OFF, "P6 LDS map");
        LAS float* A2 = (LAS float*)F.lds; LAS float* B2 = A2 + 1024; LAS float* LG = (LAS float*)(F.lds + LG_OFF) + w * 768;
        LAS unsigned* hist = (LAS unsigned*)(F.lds + HI_OFF); LAS unsigned* basev = hist + 32;
        for (int k = F.tid; k < 1024; k += NWAVES * 64) { A2[k] = norm2_g[k] * (1.0f + MOD[b * 6144 + 4096 + k]); B2[k] = MOD[b * 6144 + 3072 + k]; }
        if (F.tid < 32) hist[F.tid] = 0u;
        const size_t row = (size_t)c * 128 + w * 16 + r;
        float rs;
        { const f32x4* sp = (const f32x4*)(SSQ + row * 16); const f32x4 s0 = sp[0], s1 = sp[1], s2 = sp[2], s3 = sp[3];
          const float ss = ((s0[0] + s0[1]) + (s0[2] + s0[3])) + ((s1[0] + s1[1]) + (s1[2] + s1[3])) + ((s2[0] + s2[1]) + (s2[2] + s2[3])) + ((s3[0] + s3[1]) + (s3[2] + s3[3]));
          rs = 1.0f / sqrtf(ss * (1.0f / DM) + EPS); }
        f32x4 acc[3];
#pragma unroll
        for (int jt = 0; jt < 3; ++jt) acc[jt] = (f32x4){0.f, 0.f, 0.f, 0.f};
        const bf16_t* xrow = X1 + row * DM;
        for (int hf = 0; hf < 2; ++hf) {
            __syncthreads();
#pragma unroll
            for (int ps = 0; ps < 12; ++ps) { const int idx = ps * 512 + F.tid, rw = idx >> 6, c16 = idx & 63;
                const u32x4 v = *(const u32x4*)(WRT + (size_t)rw * 1024 + hf * 512 + c16 * 8);
                *(LAS u32x4*)(F.lds + WL_OFF + (rw / 48) * WPLANE + (rw % 48) * WPITCH + c16 * 16) = v; }
            __syncthreads();
#pragma unroll 4
            for (int s_ = 0; s_ < 16; ++s_) { const int k0 = 512 * hf + 32 * s_ + 8 * q;
                const u32x4 xr = *(const u32x4*)(xrow + k0);
                const f32x4 x0 = {bflo(xr.x), bfhi(xr.x), bflo(xr.y), bfhi(xr.y)}, x1v = {bflo(xr.z), bfhi(xr.z), bflo(xr.w), bfhi(xr.w)};
                const f32x4 a0 = *(const LAS f32x4*)(A2 + k0), a1 = *(const LAS f32x4*)(A2 + k0 + 4), b0 = *(const LAS f32x4*)(B2 + k0), b1 = *(const LAS f32x4*)(B2 + k0 + 4);
                const f32x4 h0 = x0 * rs * a0 + b0, h1 = x1v * rs * a1 + b1;
                u32x4 hw; hw.x = cvt_pk_bf16(h0[0], h0[1]); hw.y = cvt_pk_bf16(h0[2], h0[3]); hw.z = cvt_pk_bf16(h1[0], h1[1]); hw.w = cvt_pk_bf16(h1[2], h1[3]);
                *(u32x4*)(XN + row * DM + k0) = hw;
                u32x4 lw; lw.x = cvt_pk_bf16(h0[0] - bflo(hw.x), h0[1] - bfhi(hw.x)); lw.y = cvt_pk_bf16(h0[2] - bflo(hw.y), h0[3] - bfhi(hw.y));
                lw.z = cvt_pk_bf16(h1[0] - bflo(hw.z), h1[1] - bfhi(hw.z)); lw.w = cvt_pk_bf16(h1[2] - bflo(hw.w), h1[3] - bfhi(hw.w));
                const bf16x8 hb = __builtin_bit_cast(bf16x8, hw), hl = __builtin_bit_cast(bf16x8, lw);
#pragma unroll
                for (int jt = 0; jt < 3; ++jt) { const LAS unsigned char* wp = F.lds + WL_OFF + (16 * jt + r) * WPITCH + (32 * s_ + 8 * q) * 2;
                    const bf16x8 wf = *(const LAS bf16x8*)wp, wl = *(const LAS bf16x8*)(wp + WPLANE);
                    acc[jt] = __builtin_amdgcn_mfma_f32_16x16x32_bf16(wf, hb, acc[jt], 0, 0, 0);
                    acc[jt] = __builtin_amdgcn_mfma_f32_16x16x32_bf16(wf, hl, acc[jt], 0, 0, 0);
                    acc[jt] = __builtin_amdgcn_mfma_f32_16x16x32_bf16(wl, hb, acc[jt], 0, 0, 0); } }
        }
#pragma unroll
        for (int jt = 0; jt < 3; ++jt) *(LAS f32x4*)(LG + r * 48 + 16 * jt + 4 * q) = acc[jt];
        LDS_WAIT(); asm volatile("" ::: "memory");
        int E0 = 0, E1 = 0; float w0 = 0.f, w1 = 0.f; unsigned lp0 = 0u, lp1 = 0u;
        if (lane < 16) {
            const LAS float* lgp = LG + lane * 48;
            float gl[4];
#pragma unroll
            for (int j = 0; j < 4; ++j) gl[j] = lgp[j] + b_rg[j];
            int g = 0; float gm = gl[0];
#pragma unroll
            for (int j = 1; j < 4; ++j) if (gl[j] > gm) { gm = gl[j]; g = j; }
            float gs = 0.f;
#pragma unroll
            for (int j = 0; j < 4; ++j) gs += __expf(gl[j] - gm);
            const float gp = 1.0f / gs;
            float m0 = -INFINITY, m1 = -INFINITY; int i0 = 0, i1 = 0;
#pragma unroll
            for (int j = 0; j < 8; ++j) { const float el = lgp[4 + 8 * g + j] + b_re[g * 8 + j];
                if (el > m0) { m1 = m0; i1 = i0; m0 = el; i0 = j; } else if (el > m1) { m1 = el; i1 = j; } }
            const float d = __expf(m1 - m0), inv = 1.0f / (1.0f + d);
            w0 = gp * inv; w1 = gp * d * inv; E0 = 8 * g + i0; E1 = 8 * g + i1;
            lp0 = __hip_atomic_fetch_add(hist + E0, 1u, __ATOMIC_RELAXED, __HIP_MEMORY_SCOPE_WORKGROUP);
            lp1 = __hip_atomic_fetch_add(hist + E1, 1u, __ATOMIC_RELAXED, __HIP_MEMORY_SCOPE_WORKGROUP);
        }
        __syncthreads();
        if (F.tid < 32) { const unsigned n = hist[F.tid]; basev[F.tid] = n ? __hip_atomic_fetch_add((unsigned*)(F.ctl + CW_CURSOR + 64 * F.tid), n, RLX_AGENT) : 0u; }
        __syncthreads();
        if (lane < 16) { const unsigned tok = (unsigned)(c * 128 + w * 16 + lane);
            ROUTE[(size_t)E0 * 32768 + basev[E0] + lp0] = ((unsigned long long)__float_as_uint(w0) << 32) | (unsigned long long)(2u * tok);
            ROUTE[(size_t)E1 * 32768 + basev[E1] + lp1] = ((unsigned long long)__float_as_uint(w1) << 32) | (unsigned long long)(2u * tok + 1u); }
        __syncthreads();
        TP_END(61, tp61_);
    }
    SEAM(6);

    PH_SET(7); TP_BEGIN(7, tp7_) if (IN(7) || IN(8)) { PHASE_IDS();
        volatile LAS int* tab = (volatile LAS int*)(F.lds + MISC_OFF + 256);
        if (F.tid < 32) tab[F.tid] = (int)__hip_atomic_load((unsigned*)(F.ctl + CW_CURSOR + 64 * F.tid), RLX_AGENT);
        __syncthreads();
        if (F.tid == 0) { int o = 0; for (int e = 0; e < 32; ++e) { tab[32 + e] = o; o += (tab[e] + 255) >> 8; } tab[64] = o; }
        __syncthreads();
        const int U = 4 * __builtin_amdgcn_readfirstlane(tab[64]);
        const int xq = F.vcu >> 5, jj = F.vcu & 31;
        pg8::MoeSched S; S.tab = tab; S.start = (int)(((long)U * xq) / 8); S.end = (int)(((long)U * (xq + 1)) / 8); S.j = jj; S.route = ROUTE; S.ready = (unsigned*)(F.ctl + CW_READY);
        if (IN(7)) {
            S.A = (const char*)XN; S.lda = DM; S.K = DM; S.Bt = (const char*)WGU; S.bstride = (size_t)1024 * 1024 * 2; S.gather = true; S.mode = 1;
            pg8::EpiGU E{HID};
            pg8::gemm_phase<pg8::EpiGU, pg8::MoeSched, true>(F.lds, S, E);
        }
        TP_END(7, tp7_);
        PH_SET(8); TP_BEGIN(8, tp8_) if (IN(8)) {
            S.A = (const char*)HID; S.lda = DEXP; S.K = DEXP; S.Bt = (const char*)WD; S.bstride = (size_t)1024 * 512 * 2; S.gather = false; S.mode = 2; S.j = (jj + 24) & 31; S.qhead = (unsigned*)(F.ctl + CW_QHEAD + 64 * xq); S.qslot = (volatile LAS int*)(F.lds + MISC_OFF + 640);
            pg8::EpiDown E{YB, ROUTE};
            pg8::gemm_phase<pg8::EpiDown, pg8::MoeSched, false>(F.lds, S, E);
        }
        TP_END(8, tp8_);
    }
    SEAM(8);

    PH_SET(9); TP_BEGIN(9, tp9_) if (IN(9)) { PHASE_IDS();
        const int c = F.vcu, b = c >> 6;
        f32x4 G2[4], FG[4];
#pragma unroll
        for (int j = 0; j < 4; ++j) { const int k = 4 * F.lane + 256 * j; G2[j] = *(const f32x4*)(MOD + b * 6144 + 5120 + k); FG[j] = *(const f32x4*)(final_g + k); }
        for (int i0 = 0; i0 < 16; i0 += 4) {
            u32x2 ya[4][4], yb[4][4], xx[4][4]; f32x4 v[4][4]; float ss[4];
#pragma unroll
            for (int u_ = 0; u_ < 4; ++u_) { const size_t row = (size_t)c * 128 + F.wave * 16 + i0 + u_;
                const u32x2* xb = (const u32x2*)(X1 + row * DM) + F.lane; const u32x2* y0 = (const u32x2*)(YB + (2 * row) * DM) + F.lane; const u32x2* y1 = (const u32x2*)(YB + (2 * row + 1) * DM) + F.lane;
#pragma unroll
                for (int j = 0; j < 4; ++j) { ya[u_][j] = y0[64 * j]; yb[u_][j] = y1[64 * j]; xx[u_][j] = xb[64 * j]; } }
#pragma unroll
            for (int u_ = 0; u_ < 4; ++u_) { float s = 0.f;
#pragma unroll
                for (int j = 0; j < 4; ++j) { const u32x2 a = ya[u_][j], bb = yb[u_][j], x_ = xx[u_][j]; const f32x4 ys = {bflo(a.x) + bflo(bb.x), bfhi(a.x) + bfhi(bb.x), bflo(a.y) + bflo(bb.y), bfhi(a.y) + bfhi(bb.y)};
                    const f32x4 xv = {bflo(x_.x), bfhi(x_.x), bflo(x_.y), bfhi(x_.y)};
                    v[u_][j] = xv + G2[j] * ys; s += (v[u_][j].x * v[u_][j].x + v[u_][j].y * v[u_][j].y) + (v[u_][j].z * v[u_][j].z + v[u_][j].w * v[u_][j].w); }
                ss[u_] = s; }
#pragma unroll
            for (int o_ = 1; o_ < 64; o_ <<= 1) {
#pragma unroll
                for (int u_ = 0; u_ < 4; ++u_) ss[u_] += __shfl_xor(ss[u_], o_); }
#pragma unroll
            for (int u_ = 0; u_ < 4; ++u_) { const size_t row = (size_t)c * 128 + F.wave * 16 + i0 + u_; f32x4* xr = (f32x4*)(out + row * DM) + F.lane;
                const float rstd = 1.0f / sqrtf(ss[u_] * (1.0f / DM) + EPS);
#pragma unroll
                for (int j = 0; j < 4; ++j) xr[64 * j] = v[u_][j] * rstd * FG[j]; } }
    }
    TP_END(9, tp9_);
    if (TSEL >= 10 && TSEL <= 12 && blockIdx.x == TBLK && threadIdx.x == 0) { unsigned mx = 0, am = 0; unsigned long long sm = 0;
        for (int i = 0; i < 256; ++i) { const unsigned t_ = __hip_atomic_load(&g_tw[i], __ATOMIC_RELAXED, __HIP_MEMORY_SCOPE_AGENT); sm += t_; if (t_ > mx) { mx = t_; am = i; } }
        g_tacc += (TSEL == 10) ? mx : (TSEL == 11) ? am * 100u : (unsigned)(sm / 256); }
    if (TSEL != 0 && blockIdx.x == TBLK && threadIdx.x == 0) { const unsigned long long t0 = __builtin_amdgcn_s_memrealtime(), d = g_tacc * TMULT; while (__builtin_amdgcn_s_memrealtime() - t0 < d) __builtin_amdgcn_s_sleep(16); }
#undef IN
#undef SEAM
}


#if ATTN_MODE == 2
__global__ void __launch_bounds__(NWAVES * 64, 2) dbg_dense(Args args, int stage) {
    extern __shared__ __attribute__((aligned(16))) unsigned char lds_raw[];
    using namespace attn_body;
    unsigned char* ws = args.ws; bf16_t* PROJ = (bf16_t*)(ws + WS_PROJ); float* KSUM = (float*)(ws + WS_KSUM); gu32* ctl = (gu32*)(ws + WS_CTL);
    const int G = gridDim.x, bx = blockIdx.x, vcu = (bx % 8) * (G / 8) + bx / 8, tid = threadIdx.x, lane = tid & 63, wave = tid >> 6;
    if (stage == 0) {
        const int s = vcu & 7, bh = vcu >> 3;
        for (int i = 0; i < 4; ++i) { const int qb = (i == 0) ? s : (i == 1) ? 15 - s : (i == 2) ? 16 + s : 31 - s;
            attn_unit<8, false>(bh >> 3, bh & 7, qb, (const bf16*)(PROJ + C_Q), (const bf16*)(PROJ + C_K), (const bf16*)(PROJ + C_VV), (bf16*)(PROJ + C_Q), KSUM, (char*)lds_raw, true, nullptr, nullptr); }
    } else {
        float md = 0.f;
        for (int i = 0; i < 16; ++i) { const size_t row = (size_t)vcu * 128 + wave * 16 + i;
            const u32x4 a = *(const u32x4*)(PROJ + row * PC + C_V + 8 * lane), bq = *(const u32x4*)(PROJ + row * PC + C_Q + 8 * lane);
            md = fmaxf(md, fmaxf(fmaxf(fabsf(bflo(a.x) - bflo(bq.x)), fabsf(bfhi(a.x) - bfhi(bq.x))), fmaxf(fabsf(bflo(a.y) - bflo(bq.y)), fabsf(bfhi(a.y) - bfhi(bq.y)))));
            md = fmaxf(md, fmaxf(fmaxf(fabsf(bflo(a.z) - bflo(bq.z)), fabsf(bfhi(a.z) - bfhi(bq.z))), fmaxf(fabsf(bflo(a.w) - bflo(bq.w)), fabsf(bfhi(a.w) - bfhi(bq.w))))); }
#pragma unroll
        for (int o_ = 1; o_ < 64; o_ <<= 1) md = fmaxf(md, __shfl_xor(md, o_));
        if (lane == 0) atomicMax((unsigned*)(ctl + CW_DIFF), __float_as_uint(md));
    }
}
#endif
extern "C" void kernel_launch(void* const* d_in, const int* in_sizes, int n_in, void* d_out, int out_size, void* d_ws, size_t ws_size, hipStream_t stream) {
    static int grid = 0;
    if (grid == 0) {
        if (n_in != 22 || in_sizes[0] != T * DM || out_size != T * DM || ws_size < WS_END) { fprintf(stderr, "kernel_launch: unexpected shapes (n_in %d, in0 %d, out %d, ws %zu); nothing launched\n", n_in, n_in > 0 ? in_sizes[0] : -1, out_size, ws_size); grid = -1; return; }
        int dev = 0, cus = 0, per_cu = 0;
        if (hipGetDevice(&dev) != hipSuccess || hipDeviceGetAttribute(&cus, hipDeviceAttributeMultiprocessorCount, dev) != hipSuccess) { fprintf(stderr, "kernel_launch: device query failed\n"); grid = -1; return; }
        if (hipFuncSetAttribute((const void*)hybrid_fwd, hipFuncAttributeMaxDynamicSharedMemorySize, LDS_BYTES) != hipSuccess) { fprintf(stderr, "kernel_launch: hipFuncSetAttribute failed\n"); grid = -1; return; }
        if (hipOccupancyMaxActiveBlocksPerMultiprocessor(&per_cu, (const void*)hybrid_fwd, NWAVES * 64, LDS_BYTES) != hipSuccess || per_cu < 1) { fprintf(stderr, "kernel_launch: occupancy query reports %d blocks per CU\n", per_cu); }
        (void)hipGetLastError();
        if (cus != 256) { fprintf(stderr, "kernel_launch: built for 256 CUs, device has %d; nothing launched\n", cus); grid = -1; return; }
        grid = cus;
    }
    if (grid < 0) return;
    (void)hipMemsetAsync((char*)d_ws + WS_CTL, 0, CTL_ZERO_BYTES, stream);
    Args a{};
    for (int i = 0; i < 22; ++i) a.in[i] = (const float*)d_in[i];
    a.out = (float*)d_out; a.ws = (unsigned char*)d_ws;
    struct Spec { int lo, hi, flags; };
#if MK_PER_PHASE
    const Spec specs[10] = {{0,1,0},{1,2,0},{2,3,0},{3,4,0},{4,5,0},{5,6,0},{6,7,0},{7,8,0},{8,9,0},{9,10,0}}; const int nspec = 10;
#elif PROBE_ID == 1
    const Spec specs[2] = {{0,10,0},{0,2,0}}; const int nspec = 2;
#elif PROBE_ID == 2
    const Spec specs[2] = {{0,10,0},{2,3,0}}; const int nspec = 2;
#elif PROBE_ID == 3
    const Spec specs[3] = {{0,4,0},{3,4,1|2|4|16},{4,10,0}}; const int nspec = 3;
#elif PROBE_ID == 10
    const Spec specs[3] = {{0,4,0},{3,4,1|2|4|8},{4,10,0}}; const int nspec = 3;
#elif PROBE_ID == 11
    const Spec specs[3] = {{0,4,0},{3,4,1|2|8|16},{4,10,0}}; const int nspec = 3;
#elif PROBE_ID == 12
    const Spec specs[3] = {{0,4,0},{3,4,1|2|4|8|16},{4,10,0}}; const int nspec = 3;
#elif PROBE_ID == 13
    const Spec specs[2] = {{0,10,0},{3,4,1|4|8|16}}; const int nspec = 2;
#elif PROBE_ID == 4
    const Spec specs[3] = {{0,4,0},{4,5,0},{4,10,0}}; const int nspec = 3;
#elif PROBE_ID == 5
    const Spec specs[3] = {{0,5,0},{5,6,0},{5,10,0}}; const int nspec = 3;
#elif PROBE_ID == 6
    const Spec specs[2] = {{0,10,0},{7,8,0}}; const int nspec = 2;
#elif PROBE_ID == 7
    const Spec specs[2] = {{0,10,0},{8,9,0}}; const int nspec = 2;
#elif PROBE_ID == 14
    const Spec specs[2] = {{0,10,0},{7,9,0}}; const int nspec = 2;
#elif PROBE_ID == 15
    const Spec specs[2] = {{0,10,0},{9,10,0}}; const int nspec = 2;
#elif PROBE_ID == 16
    const Spec specs[2] = {{0,10,0},{6,7,0}}; const int nspec = 2;
#elif PROBE_ID == 8
    const Spec specs[2] = {{0,5,0},{5,10,0}}; const int nspec = 2;
#elif PROBE_ID == 9
    const Spec specs[2] = {{0,10,0},{0,1,0}}; const int nspec = 2;
#else
    const Spec specs[1] = {{0,10,0}}; const int nspec = 1;
#endif
#if ATTN_MODE == 2
    (void)hipFuncSetAttribute((const void*)dbg_dense, hipFuncAttributeMaxDynamicSharedMemorySize, LDS_BYTES);
    a.ph_lo = 0; a.ph_hi = 4; a.flags = 0; a.li = 0; hipLaunchKernelGGL(hybrid_fwd, dim3(grid), dim3(NWAVES * 64), LDS_BYTES, stream, a);
    hipLaunchKernelGGL(dbg_dense, dim3(grid), dim3(NWAVES * 64), LDS_BYTES, stream, a, 0);
    hipLaunchKernelGGL(dbg_dense, dim3(grid), dim3(NWAVES * 64), LDS_BYTES, stream, a, 1);
    a.ph_lo = 4; a.ph_hi = 10; a.li = 1; hipLaunchKernelGGL(hybrid_fwd, dim3(grid), dim3(NWAVES * 64), LDS_BYTES, stream, a);
    (void)nspec; (void)specs;
#else
    for (int li = 0; li < nspec; ++li) { a.ph_lo = specs[li].lo; a.ph_hi = specs[li].hi; a.flags = specs[li].flags; a.li = MK_PER_PHASE ? 0 : li;
        hipLaunchKernelGGL(hybrid_fwd, dim3(grid), dim3(NWAVES * 64), LDS_BYTES, stream, a); }
#endif
    const hipError_t le = hipPeekAtLastError();
    if (le != hipSuccess) fprintf(stderr, "kernel_launch: launch failed: %s\n", hipGetErrorName(le));
}
```

```cpp
#include <hip/hip_runtime.h>
#include <hip/hip_bf16.h>
#include <cstdio>
#include <cstdint>
#include <cmath>

#ifndef PROBE_ID
#define PROBE_ID 0
#endif
#ifndef ATTN_MODE
#define ATTN_MODE 1
#endif
#ifndef GPROBE
#define GPROBE 0
#endif
#ifndef TSEL
#define TSEL 0
#endif
#ifndef TPH
#define TPH -1
#endif
#ifndef TBLK
#define TBLK 0
#endif
#ifndef TVCU
#define TVCU 255
#endif
#define TMULT 8
__device__ unsigned long long g_tacc; __device__ int g_tphase; __device__ unsigned g_tw[256];
#define T_ON(k) (TSEL == (k) && blockIdx.x == TBLK && threadIdx.x == 0 && (TPH < 0 || g_tphase == TPH))
#define T_BEGIN(k, var) unsigned long long var = 0; if (TSEL == (k)) { if (T_ON(k)) var = __builtin_amdgcn_s_memrealtime(); }
#define T_END(k, var) do { if (TSEL == (k)) { if (T_ON(k)) g_tacc += __builtin_amdgcn_s_memrealtime() - var; } } while (0)
#define TP_BEGIN(ph, var) unsigned long long var = 0; if (TSEL == 4 && TPH == (ph)) { if (blockIdx.x == TBLK && threadIdx.x == 0) var = __builtin_amdgcn_s_memrealtime(); } \
        if (TSEL >= 10 && TSEL <= 12 && TPH == (ph)) { if (threadIdx.x == 0) var = __builtin_amdgcn_s_memrealtime(); }
#define TP_END(ph, var) do { if (TSEL == 4 && TPH == (ph)) { if (blockIdx.x == TBLK && threadIdx.x == 0) g_tacc += __builtin_amdgcn_s_memrealtime() - var; } \
        if (TSEL >= 10 && TSEL <= 12 && TPH == (ph)) { if (threadIdx.x == 0) __hip_atomic_store(&g_tw[(blockIdx.x % 8) * 32 + blockIdx.x / 8], (unsigned)(__builtin_amdgcn_s_memrealtime() - var), __ATOMIC_RELAXED, __HIP_MEMORY_SCOPE_AGENT); } } while (0)
#ifndef MK_PER_PHASE
#define MK_PER_PHASE 0
#endif

#define LAS __attribute__((address_space(3)))
#define GAS __attribute__((address_space(1)))
typedef unsigned short bf16_t;
typedef short bf16x8 __attribute__((ext_vector_type(8)));
typedef short s16x4 __attribute__((ext_vector_type(4)));
typedef float f32x2 __attribute__((ext_vector_type(2)));
typedef float f32x4 __attribute__((ext_vector_type(4)));
typedef float f32x16 __attribute__((ext_vector_type(16)));
typedef unsigned u32x2 __attribute__((ext_vector_type(2)));
typedef unsigned u32x4 __attribute__((ext_vector_type(4)));
typedef GAS unsigned gu32;

constexpr int NB = 4, SEQ = 8192, DM = 1024, T = NB * SEQ;
constexpr int PC = 4608;
constexpr int C_U = 0, C_V = 512, C_Q = 1024, C_K = 1536, C_VV = 2048, C_GA = 2560, C_GB = 3584;
constexpr int NEXP = 32, DEXP = 512;
constexpr float EPS = 1e-6f;
constexpr float QSCALE = 0.125f * 1.4426950408889634f;

constexpr size_t MiB = 1u << 20;
constexpr size_t WS_CTL = 0, CTL_ZERO_BYTES = 2 * MiB;
constexpr size_t WS_KSUM = 1 * MiB;
constexpr size_t WS_MODP = 2 * MiB;
constexpr size_t WS_MOD = 3 * MiB + 512 * 1024;
constexpr size_t WS_ROPE = 4 * MiB;
constexpr size_t WS_WST = 4 * MiB + 512 * 1024;
constexpr size_t WS_WRT = 4 * MiB + 768 * 1024;
constexpr size_t WS_SSQ = 5 * MiB;
constexpr size_t WS_ROUTE = 8 * MiB;
constexpr size_t WS_WIN = 24 * MiB;
constexpr size_t WS_WAB = 34 * MiB, WS_WOUT = 36 * MiB;
constexpr size_t WS_WGU = 40 * MiB;
constexpr size_t WS_WD = 104 * MiB;
constexpr size_t WS_XN = 136 * MiB;
constexpr size_t WS_PROJ = 200 * MiB;
constexpr size_t WS_HID = 200 * MiB;
constexpr size_t WS_Y = 272 * MiB;
constexpr size_t WS_X1 = 400 * MiB;
constexpr size_t WS_PO = 40 * MiB;
constexpr size_t WS_PML = 136 * MiB;
constexpr size_t WS_LIST = 488 * MiB;
constexpr size_t WS_END = 504 * MiB;
constexpr int CW_TMO = 0, CW_DIFF = 2, CW_BAR = 4096, CW_CURSOR = 32768, CW_CNT = 65536, CW_READY = 131072, CW_QHEAD = 160000, CW_GQ = 161024;

constexpr int RING_BYTES = 131072;
constexpr int LDS_BYTES = 147456;
constexpr int MISC_OFF = LDS_BYTES - 1024;
constexpr int NWAVES = 8;

#define LDS_WAIT() asm volatile("s_waitcnt lgkmcnt(0)" ::: "memory")
#define VM_WAIT() asm volatile("s_waitcnt vmcnt(0)" ::: "memory")
#define RLX_AGENT __ATOMIC_RELAXED, __HIP_MEMORY_SCOPE_AGENT

__device__ __forceinline__ unsigned cvt_pk_bf16(float lo, float hi) { unsigned r; asm volatile("v_cvt_pk_bf16_f32 %0, %1, %2" : "=v"(r) : "v"(lo), "v"(hi)); return r; }
__device__ __forceinline__ float bflo(unsigned u) { return __uint_as_float(u << 16); }
__device__ __forceinline__ float bfhi(unsigned u) { return __uint_as_float(u & 0xffff0000u); }
__device__ __forceinline__ float sigmoidf_(float x) { return __builtin_amdgcn_rcpf(1.0f + __builtin_amdgcn_exp2f(-1.4426950408889634f * x)); }
__device__ __forceinline__ float gelu_tanh(float x) { const float u = x + 0.044715f * x * x * x; return x * __builtin_amdgcn_rcpf(1.0f + __builtin_amdgcn_exp2f(-2.3022081985f * u)); }
__device__ __forceinline__ float wave_sum(float v) {
#pragma unroll
    for (int o = 1; o < 64; o <<= 1) v += __shfl_xor(v, o);
    return v;
}

namespace pg8 {
constexpr int BM = 256, BK = 64, HALF = 128, HTB = HALF * BK * 2, STAGE_BYTES = 8 * HTB, NXCD = 8, WGM = 8;
__host__ __device__ __forceinline__ int lds_byte(int r, int c) { const int st = (r >> 4) * 2 + (c >> 5), rr = r & 15, cc = c & 31, ob = rr * 64 + cc * 2; return st * 1024 + (ob ^ (((ob >> 9) & 1) << 5)); }
__host__ __device__ __forceinline__ void stage_rc(int b, int& R, int& C) { const int st = b / 1024, sb = b % 1024, swz = sb ^ (((sb >> 9) & 1) << 5); R = (st >> 1) * 16 + swz / 64; C = (st & 1) * 32 + (swz % 64) / 2; }
__host__ __device__ __forceinline__ int perm32(int rho) { const int n = rho >> 4, i = rho & 15; return 8 * (i >> 2) + 4 * n + (i & 3); }

struct Unit { int pm, pn, e, lt, nvalid; };

struct DenseSched {
    const char* A; const char* Bt; int lda, K; int nM, nN, nwg, G, c; int ksplit; unsigned kgap;
    __device__ void init(const void* A_, int lda_, const void* Bt_, int K_, int M, int N, int G_, int c_) { A = (const char*)A_; Bt = (const char*)Bt_; lda = lda_; K = K_; nM = M / BM; nN = N / BM; nwg = nM * nN; G = G_; c = c_; ksplit = 1 << 20; kgap = 0u; }
    __device__ __forceinline__ bool next(int i, Unit& u) const {
        const long L = (long)i * G + c; if (L >= nwg) return false;
        int wgid = (int)L; { const int q = nwg / NXCD, r = nwg % NXCD, xcd = wgid % NXCD, off = wgid / NXCD; wgid = (xcd < r ? xcd * (q + 1) : r * (q + 1) + (xcd - r) * q) + off; }
        const int nig = WGM * nN, gid = wgid / nig, fm = gid * WGM, gsz = (nM - fm) < WGM ? (nM - fm) : WGM;
        u.pm = fm + ((wgid % nig) % gsz); u.pn = (wgid % nig) / gsz; u.e = 0; u.lt = 0; u.nvalid = 256; return true;
    }
    __device__ __forceinline__ const char* a_base(const Unit& u) const { return A + (size_t)u.pm * BM * lda * 2; }
    __device__ __forceinline__ const char* b_base(const Unit& u) const { return Bt + (size_t)u.pn * BM * K * 2; }
    __device__ __forceinline__ unsigned gather_off(const Unit&, int, int) const { return 0u; }
    __device__ __forceinline__ void a_ready(const Unit&) const {}
    __device__ __forceinline__ void done(const Unit&) const {}
};
struct MoeSched {
    const char* A; const char* Bt; int lda, K; size_t bstride;
    const unsigned long long* route; bool gather;
    const volatile LAS int* tab;
    int start, end, j; static constexpr int ksplit = 1 << 20; static constexpr unsigned kgap = 0u;
    unsigned* ready; int mode;
    __device__ __forceinline__ void done(const Unit& u) const {
        if (mode == 1) { asm volatile("s_waitcnt vmcnt(0)" ::: "memory");
            if ((threadIdx.x & 63) == 0) __hip_atomic_fetch_add(ready + 64 * u.pm, 1u, __ATOMIC_RELAXED, __HIP_MEMORY_SCOPE_AGENT); } }
    __device__ __forceinline__ void a_ready(const Unit& u) const {
        if (mode == 2) {
            if (threadIdx.x < 64) { unsigned sp = 0;
                while ((unsigned)__builtin_amdgcn_readfirstlane(__hip_atomic_load(ready + 64 * u.pm, __ATOMIC_RELAXED, __HIP_MEMORY_SCOPE_AGENT)) < 32u) { __builtin_amdgcn_s_sleep(2); if (++sp > (1u << 22)) break; }
                __builtin_amdgcn_fence(__ATOMIC_ACQUIRE, "agent");
                asm volatile("s_waitcnt vmcnt(0)" ::: "memory"); }
            asm volatile("" ::: "memory"); __builtin_amdgcn_s_barrier(); asm volatile("" ::: "memory"); } }
    unsigned* qhead; volatile LAS int* qslot;
    __device__ __forceinline__ bool next(int i, Unit& u) const {
        int idx;
        if (mode == 2) {
            if (threadIdx.x == 0) qslot[i & 1] = start + (int)__hip_atomic_fetch_add(qhead, 1u, __ATOMIC_RELAXED, __HIP_MEMORY_SCOPE_AGENT);
            asm volatile("s_waitcnt vmcnt(0) lgkmcnt(0)" ::: "memory"); __builtin_amdgcn_s_barrier(); asm volatile("" ::: "memory");
            idx = __builtin_amdgcn_readfirstlane(qslot[i & 1]);
        } else idx = start + i * 32 + j;
        if (idx >= end) return false;
        const int tile = idx >> 2; u.pn = idx & 3; u.pm = tile;
        int e = 0;
        for (int k = 1; k < 32; ++k) e += (__builtin_amdgcn_readfirstlane(tab[32 + k]) <= tile) ? 1 : 0;
        u.e = e; u.lt = tile - __builtin_amdgcn_readfirstlane(tab[32 + e]);
        const int rem = __builtin_amdgcn_readfirstlane(tab[e]) - 256 * u.lt; u.nvalid = rem < 256 ? rem : 256; return true;
    }
    __device__ __forceinline__ const char* a_base(const Unit& u) const { return gather ? A : A + (size_t)u.pm * BM * lda * 2; }
    __device__ __forceinline__ const char* b_base(const Unit& u) const { return Bt + (size_t)u.e * bstride + (size_t)u.pn * BM * K * 2; }
    __device__ __forceinline__ unsigned gather_off(const Unit& u, int r, int C) const {
        unsigned tok = 0u;
        if (r < u.nvalid) tok = (unsigned)(route[(size_t)u.e * 32768 + (size_t)u.lt * 256 + r] & 0xffffffffull) >> 1;
        return (tok * (unsigned)lda + (unsigned)C) * 2u;
    }
};

template <class Epi, class Sched, bool GATHER>
__device__ __forceinline__ void gemm_phase(LAS unsigned char* lds, const Sched& S, const Epi& E) {
    const int tid = threadIdx.x, wid = __builtin_amdgcn_readfirstlane(tid >> 6), lane = tid & 63, wr = wid >> 2, wc = wid & 3, fr = lane & 15, fq = lane >> 4;
    const int K = S.K, lda = S.lda, nt = K / BK;
    unsigned voffA[2], voffB[2]; int RA[2], CA[2];
#pragma unroll
    for (int i = 0; i < 2; ++i) { int R, C; stage_rc(tid * 16 + i * 8192, R, C); const int Rb = Epi::PERM ? ((R & ~31) + perm32(R & 31)) : R;
        RA[i] = R; CA[i] = C; voffA[i] = (unsigned)(R * lda + C) * 2u; voffB[i] = (unsigned)(Rb * K + C) * 2u; }
    const size_t kstep = (size_t)(BK * 2);
    const unsigned hstepA = (unsigned)HALF * (unsigned)lda * 2u;
    const size_t hstepB = (size_t)HALF * K * 2;
    const unsigned ldsw = (unsigned)wid * 1024u;
    const int aoff = lds_byte(wr * 64 + fr, fq * 8), boff = lds_byte(wc * 32 + fr, fq * 8);
    unsigned og[2][2] = {{0u, 0u}, {0u, 0u}}, ogn[2][2] = {{0u, 0u}, {0u, 0u}};
#define PG8_SA(b, h) (((b) * 2 + (h)) * HTB)
#define PG8_SB(b, h) ((4 + (b) * 2 + (h)) * HTB)
#define PG8_STAGE_B(bufoff, gbase) do { _Pragma("unroll") for (int _i = 0; _i < 2; ++_i) \
        __builtin_amdgcn_global_load_lds((const unsigned*)((const char*)(gbase) + voffB[_i]), (LAS unsigned*)(lds + (bufoff) + ldsw + _i * 8192), 16, 0, 0); } while (0)
#define PG8_STAGE_A(bufoff, gbase, h) do { _Pragma("unroll") for (int _i = 0; _i < 2; ++_i) \
        __builtin_amdgcn_global_load_lds((const unsigned*)((const char*)(gbase) + (GATHER ? og[h][_i] : voffA[_i] + (h) * hstepA)), (LAS unsigned*)(lds + (bufoff) + ldsw + _i * 8192), 16, 0, 0); } while (0)
#define PG8_LDA(dst, b, h) do { _Pragma("unroll") for (int m = 0; m < 4; ++m) _Pragma("unroll") for (int k = 0; k < 2; ++k) dst[m][k] = *(const LAS bf16x8*)(lds + PG8_SA(b, h) + aoff + m * 2048 + k * 1024); } while (0)
#define PG8_LDB(dst, b, h) do { _Pragma("unroll") for (int n = 0; n < 2; ++n) _Pragma("unroll") for (int k = 0; k < 2; ++k) dst[n][k] = *(const LAS bf16x8*)(lds + PG8_SB(b, h) + boff + n * 2048 + k * 1024); } while (0)
#define PG8_MMA(ai, bj, At, Bt) do { __builtin_amdgcn_s_setprio(1); _Pragma("unroll") for (int m = 0; m < 4; ++m) _Pragma("unroll") for (int n = 0; n < 2; ++n) _Pragma("unroll") for (int k = 0; k < 2; ++k) \
        acc[ai][bj][m][n] = __builtin_amdgcn_mfma_f32_16x16x32_bf16(Bt[n][k], At[m][k], acc[ai][bj][m][n], 0, 0, 0); __builtin_amdgcn_s_setprio(0); } while (0)
#define PG8_WAIT_V(n) asm volatile("s_waitcnt vmcnt(" #n ")" ::: "memory")
#define PG8_WAIT_L(n) asm volatile("s_waitcnt lgkmcnt(" #n ")" ::: "memory")
#define PG8_BAR __builtin_amdgcn_s_barrier()
#define PG8_SCHED __builtin_amdgcn_sched_barrier(0)
    Unit cur, nxt; int ui = 0;
    if (!S.next(0, cur)) return;
    f32x4 acc[2][2][4][2];
#pragma unroll
    for (int a = 0; a < 2; ++a)
#pragma unroll
        for (int b = 0; b < 2; ++b)
#pragma unroll
            for (int m = 0; m < 4; ++m)
#pragma unroll
                for (int n = 0; n < 2; ++n) acc[a][b][m][n] = (f32x4){0.f, 0.f, 0.f, 0.f};
    bf16x8 At[4][2], B0[2][2], B1[2][2];
    const char* cA = S.a_base(cur); const char* cB = S.b_base(cur);
    S.a_ready(cur);
    if constexpr (GATHER) {
#pragma unroll
        for (int h = 0; h < 2; ++h)
#pragma unroll
            for (int i = 0; i < 2; ++i) og[h][i] = S.gather_off(cur, h * HALF + RA[i], CA[i]);
    }
    PG8_STAGE_B(PG8_SB(0, 0), cB); PG8_STAGE_B(PG8_SB(0, 1), cB + hstepB); PG8_STAGE_A(PG8_SA(0, 0), cA, 0); PG8_STAGE_A(PG8_SA(0, 1), cA, 1);
    if (wr == 1) PG8_BAR;
    PG8_WAIT_V(2); PG8_BAR;
    PG8_STAGE_B(PG8_SB(1, 0), cB + kstep); PG8_STAGE_A(PG8_SA(1, 0), cA + kstep, 0); PG8_STAGE_B(PG8_SB(1, 1), cB + hstepB + kstep);
    PG8_WAIT_V(6); PG8_BAR;
    unsigned long long t3_ = 0;
    for (;;) {
        const bool has_next = S.next(ui + 1, nxt);
        const char* nA = has_next ? S.a_base(nxt) : cA; const char* nB = has_next ? S.b_base(nxt) : cB;
        if constexpr (GATHER) {
            if (has_next) {
#pragma unroll
                for (int h = 0; h < 2; ++h)
#pragma unroll
                    for (int i = 0; i < 2; ++i) ogn[h][i] = S.gather_off(nxt, h * HALF + RA[i], CA[i]);
            }
        }
        for (int t = 0; t < nt; t += 2) {
            const bool last = (t == nt - 2);
            const char* a1 = cA + (size_t)(t + 1) * kstep + ((t + 1) >= S.ksplit ? S.kgap : 0u);
            const char* a2 = last ? nA : cA + (size_t)(t + 2) * kstep + ((t + 2) >= S.ksplit ? S.kgap : 0u); const char* b2 = last ? nB : cB + (size_t)(t + 2) * kstep;
            const char* a3 = last ? nA + kstep : cA + (size_t)(t + 3) * kstep + ((t + 3) >= S.ksplit ? S.kgap : 0u); const char* b3 = b2 + kstep;
            if (last && has_next) S.a_ready(nxt);
            if constexpr (Epi::HAS_MID) { if (t == S.ksplit) E.mid(acc, cur, wr, wc, fr, fq); }
            PG8_LDB(B0, 0, 0); PG8_LDB(B1, 0, 1); PG8_SCHED; PG8_LDA(At, 0, 0); PG8_STAGE_A(PG8_SA(1, 1), a1, 1);
            if constexpr (GATHER) { if (last && has_next) {
#pragma unroll
                for (int h = 0; h < 2; ++h)
#pragma unroll
                    for (int i = 0; i < 2; ++i) og[h][i] = ogn[h][i]; } }
            PG8_WAIT_V(8); PG8_WAIT_L(0); PG8_BAR;
            if (TSEL == 3) { if (t == 0 && t3_ != 0 && T_ON(3)) { g_tacc += __builtin_amdgcn_s_memrealtime() - t3_; t3_ = 0; } }
            PG8_MMA(0, 0, At, B0); PG8_MMA(0, 1, At, B1); PG8_BAR; PG8_SCHED;
            PG8_LDA(At, 0, 1); PG8_STAGE_B(PG8_SB(0, 0), b2); PG8_STAGE_B(PG8_SB(0, 1), b2 + hstepB); PG8_STAGE_A(PG8_SA(0, 0), a2, 0);
            PG8_WAIT_V(8); PG8_WAIT_L(0); PG8_BAR; PG8_MMA(1, 0, At, B0); PG8_MMA(1, 1, At, B1); PG8_BAR; PG8_SCHED;
            PG8_LDB(B0, 1, 0); PG8_LDB(B1, 1, 1); PG8_SCHED; PG8_LDA(At, 1, 0); PG8_STAGE_A(PG8_SA(0, 1), a2, 1);
            PG8_WAIT_V(8); PG8_WAIT_L(0); PG8_BAR; PG8_MMA(0, 0, At, B0); PG8_MMA(0, 1, At, B1); PG8_BAR; PG8_SCHED;
            PG8_LDA(At, 1, 1); PG8_STAGE_B(PG8_SB(1, 0), b3); PG8_STAGE_B(PG8_SB(1, 1), b3 + hstepB); PG8_STAGE_A(PG8_SA(1, 0), a3, 0);
            PG8_WAIT_V(8); PG8_WAIT_L(0); PG8_BAR; PG8_MMA(1, 0, At, B0); PG8_MMA(1, 1, At, B1); PG8_BAR; PG8_SCHED;
        }
        if (wr == 0) PG8_BAR;
        { T_BEGIN(2, t2_) E(acc, cur, wr, wc, fr, fq); S.done(cur); T_END(2, t2_); }
        if (!has_next) break;
        if (TSEL == 3 && T_ON(3)) t3_ = __builtin_amdgcn_s_memrealtime();
#pragma unroll
        for (int a = 0; a < 2; ++a)
#pragma unroll
            for (int b = 0; b < 2; ++b)
#pragma unroll
                for (int m = 0; m < 4; ++m)
#pragma unroll
                    for (int n = 0; n < 2; ++n) acc[a][b][m][n] = (f32x4){0.f, 0.f, 0.f, 0.f};
        cur = nxt; cA = nA; cB = nB; ++ui;
        if (wr == 1) PG8_BAR;
    }
    PG8_WAIT_V(0);
    PG8_BAR;
#undef PG8_SA
#undef PG8_SB
#undef PG8_STAGE_A
#undef PG8_STAGE_B
#undef PG8_LDA
#undef PG8_LDB
#undef PG8_MMA
#undef PG8_WAIT_V
#undef PG8_WAIT_L
#undef PG8_BAR
#undef PG8_SCHED
}

struct EpiProj {
    static constexpr bool PERM = true; static constexpr bool HAS_MID = false;
    bf16_t* P; const float* rope; float* ksum;
    __device__ __forceinline__ void operator()(const f32x4 (&acc)[2][2][4][2], const Unit& u, int wr, int wc, int fr_in, int fq) const {
        int fr = fr_in; asm volatile("" : "+v"(fr));
        const int pn = u.pn, row0 = u.pm * BM + wr * 64 + fr, cl = wc * 32 + 8 * fq;
        if (pn < 4 || pn >= 8) {
#pragma unroll
            for (int gi = 0; gi < 8; ++gi) { const int ai = gi >> 2, m = gi & 3; bf16_t* rowp = P + (size_t)(row0 + ai * HALF + m * 16) * PC + pn * BM + cl;
#pragma unroll
                for (int bj = 0; bj < 2; ++bj) { const f32x4 v0 = acc[ai][bj][m][0], v1 = acc[ai][bj][m][1];
                    u32x4 w; w.x = cvt_pk_bf16(v0[0], v0[1]); w.y = cvt_pk_bf16(v0[2], v0[3]); w.z = cvt_pk_bf16(v1[0], v1[1]); w.w = cvt_pk_bf16(v1[2], v1[3]);
                    *(u32x4*)(rowp + bj * HALF) = w; }
                asm volatile("" ::: "memory"); }
            return;
        }
        const int mode = pn < 6 ? 1 : 2;
        const bool rot = (mode == 1 || mode == 2) && ((wc & 1) == 0);
        float ks[2][8];
#pragma unroll
        for (int bj = 0; bj < 2; ++bj)
#pragma unroll
            for (int j = 0; j < 8; ++j) ks[bj][j] = 0.f;
        f32x4 rq[2][4];
#define RP_LOAD(gi, slot) do { const int pos_ = (row0 + ((gi) >> 2) * HALF + ((gi) & 3) * 16) & (SEQ - 1); \
            rq[slot][0] = *(const f32x4*)(rope + pos_ * 8); rq[slot][1] = *(const f32x4*)(rope + pos_ * 8 + 4); rq[slot][2] = *(const f32x4*)(rope + 65536 + pos_ * 8); rq[slot][3] = *(const f32x4*)(rope + 65536 + pos_ * 8 + 4); } while (0)
        RP_LOAD(0, 0);
#pragma unroll
        for (int ai = 0; ai < 2; ++ai)
#pragma unroll
            for (int m = 0; m < 4; ++m) {
                const int gi_ = ai * 4 + m;
                if (gi_ + 1 < 8) RP_LOAD(gi_ + 1, (gi_ + 1) & 1);
                const int row = row0 + ai * HALF + m * 16;
                float cs[8], sn[8];
#pragma unroll
                for (int j = 0; j < 4; ++j) { cs[j] = rq[gi_ & 1][0][j]; cs[4 + j] = rq[gi_ & 1][1][j]; sn[j] = rq[gi_ & 1][2][j]; sn[4 + j] = rq[gi_ & 1][3][j]; }
#pragma unroll
                for (int bj = 0; bj < 2; ++bj) {
                    float v[8];
#pragma unroll
                    for (int j = 0; j < 4; ++j) { v[j] = acc[ai][bj][m][0][j]; v[4 + j] = acc[ai][bj][m][1][j]; }
                    if (mode == 1 || mode == 2) {
                        if (rot) {
                            const float sg = (fq == 0) ? -1.f : 1.f; const bool ap = fq < 2;
#pragma unroll
                            for (int j = 0; j < 8; ++j) {
                                const auto sw = __builtin_amdgcn_permlane16_swap(__float_as_uint(v[j]), __float_as_uint(v[j]), false, false);
                                const float o = __uint_as_float((fq & 1) ? sw[0] : sw[1]); const float r = v[j] * cs[j] + sg * o * sn[j]; v[j] = ap ? r : v[j]; }
                        }
                        if (mode == 1) {
#pragma unroll
                            for (int j = 0; j < 8; ++j) v[j] *= QSCALE;
                        } else {
#pragma unroll
                            for (int j = 0; j < 8; ++j) ks[bj][j] += v[j];
                        }
                    }
                    u32x4 w; w.x = cvt_pk_bf16(v[0], v[1]); w.y = cvt_pk_bf16(v[2], v[3]); w.z = cvt_pk_bf16(v[4], v[5]); w.w = cvt_pk_bf16(v[6], v[7]);
                    *(u32x4*)(P + (size_t)row * PC + pn * BM + bj * HALF + cl) = w;
                }
            }
        if (mode == 2) {
#pragma unroll
            for (int bj = 0; bj < 2; ++bj)
#pragma unroll
                for (int j = 0; j < 8; ++j) { float s = ks[bj][j]; s += __shfl_xor(s, 1); s += __shfl_xor(s, 2); s += __shfl_xor(s, 4); s += __shfl_xor(s, 8); ks[bj][j] = s; }
            if (fr == 0) {
                const int b = u.pm >> 5, kb = u.pm & 31;
#pragma unroll
                for (int bj = 0; bj < 2; ++bj) { const int ck = (pn - 6) * BM + bj * HALF + cl; const int h = ck >> 6, d = ck & 63;
                    float* dst = ksum + ((size_t)((b * 8 + h) * 32 + kb)) * 64 + d;
#pragma unroll
                    for (int j = 0; j < 8; ++j) atomicAdd(dst + j, ks[bj][j]); }
            }
        }
    }
};
struct EpiMergeF {
    static constexpr bool PERM = true; static constexpr bool HAS_MID = true;
    const bf16_t* P; bf16_t* MG;
    __device__ __forceinline__ void mid(f32x4 (&acc)[2][2][4][2], const Unit& u, int wr, int wc, int fr_in, int fq) const {
        int fr = fr_in; asm volatile("" : "+v"(fr));
        const int row0 = u.pm * BM + wr * 64 + fr, col0 = u.pn * BM + wc * 32 + 8 * fq;
#pragma unroll
        for (int g4 = 0; g4 < 8; g4 += 4) {
            u32x4 ga[4][2], gb[4][2];
#pragma unroll
            for (int k = 0; k < 4; ++k) { const int gi = g4 + k, row = row0 + (gi >> 2) * HALF + (gi & 3) * 16;
#pragma unroll
                for (int bj = 0; bj < 2; ++bj) { ga[k][bj] = *(const u32x4*)(P + (size_t)row * PC + C_GA + col0 + bj * HALF); gb[k][bj] = *(const u32x4*)(P + (size_t)row * PC + C_GB + col0 + bj * HALF); } }
#pragma unroll
            for (int k = 0; k < 4; ++k) { const int gi = g4 + k, ai = gi >> 2, m = gi & 3;
#pragma unroll
                for (int bj = 0; bj < 2; ++bj) {
#define RHO(a_, b_) ((1.0f + __builtin_amdgcn_exp2f(-1.4426950408889634f * fmaxf(b_, -60.f))) * sigmoidf_(a_))
                    const u32x4 A_ = ga[k][bj], B_ = gb[k][bj];
                    acc[ai][bj][m][0][0] *= RHO(bflo(A_.x), bflo(B_.x)); acc[ai][bj][m][0][1] *= RHO(bfhi(A_.x), bfhi(B_.x)); acc[ai][bj][m][0][2] *= RHO(bflo(A_.y), bflo(B_.y)); acc[ai][bj][m][0][3] *= RHO(bfhi(A_.y), bfhi(B_.y));
                    acc[ai][bj][m][1][0] *= RHO(bflo(A_.z), bflo(B_.z)); acc[ai][bj][m][1][1] *= RHO(bfhi(A_.z), bfhi(B_.z)); acc[ai][bj][m][1][2] *= RHO(bflo(A_.w), bflo(B_.w)); acc[ai][bj][m][1][3] *= RHO(bfhi(A_.w), bfhi(B_.w));
#undef RHO
                } }
        }
    }
    __device__ __forceinline__ void operator()(const f32x4 (&acc)[2][2][4][2], const Unit& u, int wr, int wc, int fr_in, int fq) const {
        int fr = fr_in; asm volatile("" : "+v"(fr));
        const int row0 = u.pm * BM + wr * 64 + fr, col0 = u.pn * BM + wc * 32 + 8 * fq;
        u32x4 gq[3][2];
#define EM_LOAD(gi, slot) do { const int row_ = row0 + ((gi) >> 2) * HALF + ((gi) & 3) * 16; \
            _Pragma("unroll") for (int bj = 0; bj < 2; ++bj) gq[slot][bj] = *(const u32x4*)(P + (size_t)row_ * PC + C_GB + col0 + bj * HALF); } while (0)
        EM_LOAD(0, 0); EM_LOAD(1, 1);
#pragma unroll
        for (int gi = 0; gi < 8; ++gi) {
            if (gi + 2 < 8) EM_LOAD(gi + 2, (gi + 2) % 3);
            asm volatile("" ::: "memory");
            const int ai = gi >> 2, m = gi & 3, row = row0 + ai * HALF + m * 16;
#pragma unroll
            for (int bj = 0; bj < 2; ++bj) { const u32x4 g = gq[gi % 3][bj];
                float v[8];
#pragma unroll
                for (int j = 0; j < 4; ++j) { v[j] = acc[ai][bj][m][0][j]; v[4 + j] = acc[ai][bj][m][1][j]; }
#define SGB(x_) sigmoidf_(fmaxf(x_, -60.f))
                v[0] *= SGB(bflo(g.x)); v[1] *= SGB(bfhi(g.x)); v[2] *= SGB(bflo(g.y)); v[3] *= SGB(bfhi(g.y)); v[4] *= SGB(bflo(g.z)); v[5] *= SGB(bfhi(g.z)); v[6] *= SGB(bflo(g.w)); v[7] *= SGB(bfhi(g.w));
#undef SGB
                u32x4 w; w.x = cvt_pk_bf16(v[0], v[1]); w.y = cvt_pk_bf16(v[2], v[3]); w.z = cvt_pk_bf16(v[4], v[5]); w.w = cvt_pk_bf16(v[6], v[7]);
                *(u32x4*)(MG + (size_t)row * DM + col0 + bj * HALF) = w; }
        }
#undef EM_LOAD
    }
};
struct EpiOut {
    static constexpr bool PERM = false; static constexpr bool HAS_MID = false;
    const float* x; bf16_t* x1; const float* mod; float* ssq;
    __device__ __forceinline__ void operator()(const f32x4 (&acc)[2][2][4][2], const Unit& u, int wr, int wc, int fr_in, int fq) const {
        int fr = fr_in; asm volatile("" : "+v"(fr));
        const int row0 = u.pm * BM + wr * 64 + fr, col0 = u.pn * BM + wc * 32 + 4 * fq, b = u.pm >> 5;
        f32x4 xq[3][2][2];
#define EO_LOAD(gi, slot) do { const size_t off_ = (size_t)(row0 + ((gi) >> 2) * HALF + ((gi) & 3) * 16) * DM + col0; \
            _Pragma("unroll") for (int bj = 0; bj < 2; ++bj) _Pragma("unroll") for (int n = 0; n < 2; ++n) xq[slot][bj][n] = *(const f32x4*)(x + off_ + bj * HALF + n * 16); } while (0)
        EO_LOAD(0, 0); EO_LOAD(1, 1);
        f32x4 g1[2][2];
#pragma unroll
        for (int bj = 0; bj < 2; ++bj)
#pragma unroll
            for (int n = 0; n < 2; ++n) g1[bj][n] = *(const f32x4*)(mod + b * 6144 + 2048 + col0 + bj * HALF + n * 16);
#pragma unroll
        for (int gi = 0; gi < 8; ++gi) {
            if (gi + 2 < 8) EO_LOAD(gi + 2, (gi + 2) % 3);
            asm volatile("" ::: "memory");
            const int ai = gi >> 2, m = gi & 3, row = row0 + ai * HALF + m * 16; const size_t off = (size_t)row * DM + col0; float s = 0.f;
#pragma unroll
            for (int bj = 0; bj < 2; ++bj)
#pragma unroll
                for (int n = 0; n < 2; ++n) { const f32x4 o = xq[gi % 3][bj][n] + g1[bj][n] * acc[ai][bj][m][n];
                    u32x2 w; w.x = cvt_pk_bf16(o[0], o[1]); w.y = cvt_pk_bf16(o[2], o[3]);
                    const float r0 = bflo(w.x), r1 = bfhi(w.x), r2 = bflo(w.y), r3 = bfhi(w.y);
                    s += (r0 * r0 + r1 * r1) + (r2 * r2 + r3 * r3); *(u32x2*)(x1 + off + bj * HALF + n * 16) = w; }
            s += __shfl_xor(s, 16); s += __shfl_xor(s, 32);
            if (fq == 0) ssq[(size_t)row * 16 + u.pn * 4 + wc] = s;
        }
#undef EO_LOAD
    }
};
struct EpiGU {
    static constexpr bool PERM = true; static constexpr bool HAS_MID = false;
    bf16_t* H;
    __device__ __forceinline__ void operator()(const f32x4 (&acc)[2][2][4][2], const Unit& u, int wr, int wc, int fr_in, int fq) const {
        int fr = fr_in; asm volatile("" : "+v"(fr));
        const int r0 = wr * 64 + fr, cl = wc * 32 + 8 * fq;
#pragma unroll
        for (int ai = 0; ai < 2; ++ai)
#pragma unroll
            for (int m = 0; m < 4; ++m) { const int r = r0 + ai * HALF + m * 16;
                float v[8];
#pragma unroll
                for (int j = 0; j < 4; ++j) { const float g0 = acc[ai][0][m][0][j], g1 = acc[ai][0][m][1][j]; v[j] = g0 * sigmoidf_(g0) * acc[ai][1][m][0][j]; v[4 + j] = g1 * sigmoidf_(g1) * acc[ai][1][m][1][j]; }
                u32x4 w; w.x = cvt_pk_bf16(v[0], v[1]); w.y = cvt_pk_bf16(v[2], v[3]); w.z = cvt_pk_bf16(v[4], v[5]); w.w = cvt_pk_bf16(v[6], v[7]);
                bf16_t* dst = H + ((size_t)u.pm * BM + r) * DEXP + u.pn * HALF + cl;
                asm volatile("global_store_dwordx4 %0, %1, off sc1\n\ts_nop 1" :: "v"(dst), "v"(w) : "memory"); }
    }
};
struct EpiDown {
    static constexpr bool PERM = true; static constexpr bool HAS_MID = false;
    bf16_t* Y; const unsigned long long* route;
    __device__ __forceinline__ void operator()(const f32x4 (&acc)[2][2][4][2], const Unit& u, int wr, int wc, int fr_in, int fq) const {
        int fr = fr_in; asm volatile("" : "+v"(fr));
        const int r0 = wr * 64 + fr, col0 = u.pn * BM + wc * 32 + 8 * fq;
        const unsigned long long* rt = route + (size_t)u.e * 32768 + (size_t)u.lt * 256;
        unsigned long long ent[8];
#pragma unroll
        for (int gi = 0; gi < 8; ++gi) { const int r = r0 + (gi >> 2) * HALF + (gi & 3) * 16; ent[gi] = (r < u.nvalid) ? rt[r] : 0ull; }
#pragma unroll
        for (int gi = 0; gi < 8; ++gi) { const int ai = gi >> 2, m = gi & 3, r = r0 + ai * HALF + m * 16;
            if (r < u.nvalid) { const unsigned slot = (unsigned)(ent[gi] & 0xffffffffull); const float wt = __uint_as_float((unsigned)(ent[gi] >> 32));
#pragma unroll
                for (int bj = 0; bj < 2; ++bj) { const f32x4 a0 = acc[ai][bj][m][0] * wt, a1 = acc[ai][bj][m][1] * wt;
                    u32x4 w; w.x = cvt_pk_bf16(a0[0], a0[1]); w.y = cvt_pk_bf16(a0[2], a0[3]); w.z = cvt_pk_bf16(a1[0], a1[1]); w.w = cvt_pk_bf16(a1[2], a1[3]);
                    *(u32x4*)(Y + (size_t)slot * DM + col0 + bj * HALF) = w; } } }
    }
};
}

namespace attn_body {
using bf16 = __hip_bfloat16;
constexpr int NHEAD = 8, D = 64, PITCH = PC;
constexpr int NW = 8, QBLK = 32, QB = QBLK * NW, KVBLK = 64;
__device__ __forceinline__ int crow(int r, int hi) { return (r & 3) + 8 * (r >> 2) + 4 * hi; }
#define SBAR() __builtin_amdgcn_sched_barrier(0)
__device__ __forceinline__ void cmask(f32x16& p0, f32x16& p1, int jb, int qrel, int hi) {
    const float NEG = -INFINITY; int kb = 64 * jb + 4 * hi;
#pragma unroll
    for (int r = 0; r < 16; ++r) { int kv = kb + (r & 3) + 8 * (r >> 2); if (kv > qrel) p0[r] = NEG; if (kv + 32 > qrel) p1[r] = NEG; }
}
__device__ __forceinline__ void selapply(f32x16& p0, f32x16& p1, bool ok) {
    const float NEG = -INFINITY;
#pragma unroll
    for (int r = 0; r < 16; ++r) { p0[r] = ok ? p0[r] : NEG; p1[r] = ok ? p1[r] : NEG; }
}
constexpr int NSLOT = 3, SLOTB = 8192;
constexpr int LDS_K = 0, LDS_V = NSLOT * SLOTB, LDS_WS = 2 * NSLOT * SLOTB, LDS_OST = LDS_WS + NW * 64 * 4, LDS_BYTES_A = LDS_OST + NW * 4096;
__device__ __forceinline__ void glds16(const void* gsrc, unsigned lds_dst) { unsigned keep;
    asm volatile("s_mov_b32 %0, m0\n\ts_mov_b32 m0, %2\n\ts_nop 0\n\tglobal_load_lds_dwordx4 %1, off\n\ts_mov_b32 m0, %0" : "=&s"(keep) : "v"(gsrc), "s"(lds_dst) : "memory"); }
__device__ __forceinline__ float max3f(float a, float b, float c) { float r; asm("v_max3_f32 %0, %1, %2, %3" : "=v"(r) : "v"(a), "v"(b), "v"(c)); return r; }
__device__ __forceinline__ float max2f(float a, float b) { float r; asm("v_max_f32_e32 %0, %1, %2" : "=v"(r) : "v"(a), "v"(b)); return r; }
__device__ __forceinline__ float fadd_s(float a, float b) { float r; asm("v_add_f32_e32 %0, %1, %2" : "=v"(r) : "v"(a), "v"(b)); return r; }
__device__ __forceinline__ float fsub_s(float a, float b) { float r; asm("v_sub_f32_e32 %0, %1, %2" : "=v"(r) : "v"(a), "v"(b)); return r; }
typedef __bf16 bf16x2_t __attribute__((ext_vector_type(2)));
__device__ __forceinline__ unsigned cvtpk_s(float lo, float hi) { f32x2 v = {lo, hi}; bf16x2_t b = __builtin_convertvector(v, bf16x2_t); return __builtin_bit_cast(unsigned, b); }
#define WAIT_BAR(N) asm volatile("s_waitcnt vmcnt(" #N ") lgkmcnt(0)\n\ts_barrier" ::: "memory")

__device__ __forceinline__ void qkt(f32x16& p0, f32x16& p1, const char* Kslot, const bf16x8* qr, const f32x16& negm, int r32, int hi) {
    const char* kb = Kslot + hi * 1024 + r32 * 16;
#pragma unroll
    for (int d0 = 0; d0 < 4; ++d0) {
        const bf16x8 b0 = *reinterpret_cast<const bf16x8*>(kb + d0 * 2048);
        const bf16x8 b1 = *reinterpret_cast<const bf16x8*>(kb + d0 * 2048 + 512);
        if (d0 == 0) { p0 = __builtin_amdgcn_mfma_f32_32x32x16_bf16(b0, qr[0], negm, 0, 0, 0); p1 = __builtin_amdgcn_mfma_f32_32x32x16_bf16(b1, qr[0], negm, 0, 0, 0); }
        else { p0 = __builtin_amdgcn_mfma_f32_32x32x16_bf16(b0, qr[d0], p0, 0, 0, 0); p1 = __builtin_amdgcn_mfma_f32_32x32x16_bf16(b1, qr[d0], p1, 0, 0, 0); } }
}
typedef LAS const char* lds_cptr;
typedef short v4i16_t __attribute__((ext_vector_type(4)));
__device__ __forceinline__ void kload8(bf16x8* kf, lds_cptr kp) {
    kf[0] = *(const LAS bf16x8*)(kp);        kf[1] = *(const LAS bf16x8*)(kp + 512);
    kf[2] = *(const LAS bf16x8*)(kp + 2048); kf[3] = *(const LAS bf16x8*)(kp + 2560);
    kf[4] = *(const LAS bf16x8*)(kp + 4096); kf[5] = *(const LAS bf16x8*)(kp + 4608);
    kf[6] = *(const LAS bf16x8*)(kp + 6144); kf[7] = *(const LAS bf16x8*)(kp + 6656);
}
__device__ __forceinline__ void kload2(bf16x8* kf, lds_cptr kp, int j) { kf[2 * j] = *(const LAS bf16x8*)(kp + j * 2048); kf[2 * j + 1] = *(const LAS bf16x8*)(kp + j * 2048 + 512); }
__device__ __forceinline__ s16x4 vtr(lds_cptr p) { return __builtin_bit_cast(s16x4, __builtin_amdgcn_ds_read_tr16_b64_v4i16((LAS v4i16_t*)p)); }
__device__ __forceinline__ float rowmax(const f32x16& p0, const f32x16& p1) {
    float a = max3f(p0[0], p0[1], p1[0]), b = max3f(p0[2], p0[3], p1[1]); a = max3f(a, p1[2], p1[3]);
#pragma unroll
    for (int r = 4; r < 16; r += 4) { a = max3f(a, p0[r], p0[r + 1]); b = max3f(b, p0[r + 2], p0[r + 3]); a = max3f(a, p1[r], p1[r + 1]); b = max3f(b, p1[r + 2], p1[r + 3]); }
    const float m = max2f(a, b);
    auto rr = __builtin_amdgcn_permlane32_swap(__float_as_uint(m), __float_as_uint(m), false, false);
    return max2f(__uint_as_float(rr[0]), __uint_as_float(rr[1]));
}
__device__ __forceinline__ void pv(f32x16* o, int vb, bf16x8 pa0, bf16x8 pa1, bf16x8 pa2, bf16x8 pa3) {
#pragma unroll
    for (int d0 = 0; d0 < 2; ++d0) { s16x4 lo[4], hi[4];
#pragma unroll
        for (int ks = 0; ks < 4; ++ks) {
            asm volatile("ds_read_b64_tr_b16 %0,%1 offset:%c2" : "=&v"(lo[ks]) : "v"(vb), "i"(d0 * 4096 + ks * 1024) : "memory");
            asm volatile("ds_read_b64_tr_b16 %0,%1 offset:%c2" : "=&v"(hi[ks]) : "v"(vb), "i"(d0 * 4096 + ks * 1024 + 512) : "memory"); }
        asm volatile("s_waitcnt lgkmcnt(0)" ::: "memory"); SBAR();
#define PK(k) (bf16x8){lo[k][0], lo[k][1], lo[k][2], lo[k][3], hi[k][0], hi[k][1], hi[k][2], hi[k][3]}
        o[d0] = __builtin_amdgcn_mfma_f32_32x32x16_bf16(pa0, PK(0), o[d0], 0, 0, 0);
        o[d0] = __builtin_amdgcn_mfma_f32_32x32x16_bf16(pa1, PK(1), o[d0], 0, 0, 0);
        o[d0] = __builtin_amdgcn_mfma_f32_32x32x16_bf16(pa2, PK(2), o[d0], 0, 0, 0);
        o[d0] = __builtin_amdgcn_mfma_f32_32x32x16_bf16(pa3, PK(3), o[d0], 0, 0, 0);
#undef PK
    }
}

__device__ __forceinline__ void gate_top3(const float* ksum_bh, const bf16x8* qr, int qb, int r32, int hi, int (&kbs)[3]) {
    const float* km = ksum_bh + (size_t)r32 * 64 + hi * 8;
    f32x16 g = f32x16{};
#pragma unroll
    for (int d0 = 0; d0 < 4; ++d0) { const f32x4 a = *(const f32x4*)(km + d0 * 16), c = *(const f32x4*)(km + d0 * 16 + 4);
        u32x4 w; w.x = cvtpk_s(a[0], a[1]); w.y = cvtpk_s(a[2], a[3]); w.z = cvtpk_s(c[0], c[1]); w.w = cvtpk_s(c[2], c[3]);
        g = __builtin_amdgcn_mfma_f32_32x32x16_bf16(__builtin_bit_cast(bf16x8, w), qr[d0], g, 0, 0, 0); }
#pragma unroll
    for (int r = 0; r < 16; ++r) if (crow(r, hi) >= qb) g[r] = -INFINITY;
#pragma unroll
    for (int round = 0; round < 3; ++round) {
        float m = g[0];
#pragma unroll
        for (int r = 1; r < 16; ++r) m = fmaxf(m, g[r]);
        int idx = 64;
#pragma unroll
        for (int r = 15; r >= 0; --r) if (g[r] == m) idx = crow(r, hi);
        const float pm = __shfl_xor(m, 32); const int pidx = __shfl_xor(idx, 32);
        const bool mine = (m > pm) || (m == pm && idx < pidx);
        kbs[round] = (mine ? idx : pidx) & 31;
#pragma unroll
        for (int r = 0; r < 16; ++r) if (mine && crow(r, hi) == idx) g[r] = -INFINITY;
    }
}

template <int THRL, bool OWN> __device__ __forceinline__ void attn_unit(int b, int h, int qb, const bf16* Q, const bf16* __restrict__ K, const bf16* __restrict__ V, bf16* O, const float* ksum, char* shm, bool do_store, const bf16_t* PO, const float* PML) {
    const int tid = threadIdx.x, lane = tid & 63, r32 = lane & 31, hi = lane >> 5; const int wid = __builtin_amdgcn_readfirstlane(tid >> 6);
    const long rowbase = (long)b * SEQ; const int q0 = qb * QB;
    const bf16* Qw = Q + (rowbase + q0 + wid * QBLK) * PITCH + h * D;
    const bf16* Kh = K + rowbase * PITCH + h * D, *Vh = V + rowbase * PITCH + h * D;
    const unsigned lds0 = (unsigned)(uintptr_t)shm;
    float* wsf = (float*)(shm + LDS_WS) + wid * 64;
    const bf16* ksrc = Kh + (long)lane * PITCH + wid * 8;
    const bf16* vsrc = Vh + (long)(16 * (wid & 3) + (lane >> 2)) * PITCH + (wid >> 2) * 32 + (lane & 3) * 8;
    const unsigned kdst = lds0 + LDS_K + wid * 1024, vdst = lds0 + LDS_V + wid * 1024;
    const int NT = OWN ? 4 : (q0 + QB) / KVBLK;
    const int TBASE = OWN ? 4 * qb : 0;
#define TM(t) (OWN ? (t) : (((t) == 0) ? (NT - 4) : (((t) <= NT - 4) ? ((t) - 1) : (t))))
#define DMA_K(t, slot) glds16(ksrc + (long)(TBASE + TM(t)) * KVBLK * PITCH, (unsigned)__builtin_amdgcn_readfirstlane(kdst + (slot)))
#define DMA_V(t, slot) glds16(vsrc + (long)(TBASE + TM(t)) * KVBLK * PITCH, (unsigned)__builtin_amdgcn_readfirstlane(vdst + (slot)))
    const int vb0 = (int)(lds0 + LDS_V) + ((lane >> 4) & 1) * 32 + (lane & 3) * 8 + (4 * hi + ((lane & 15) >> 2)) * 64;
    const char* Kbase = shm + LDS_K; bf16x8 kf[8];
    const lds_cptr shm3 = (lds_cptr)shm; const lds_cptr kp0 = shm3 + LDS_K + hi * 1024 + r32 * 16; const lds_cptr vp0 = shm3 + LDS_V + ((lane >> 4) & 1) * 32 + (lane & 3) * 8 + (4 * hi + ((lane & 15) >> 2)) * 64;
    DMA_K(0, 0); DMA_V(0, 0); DMA_K(1, SLOTB);
    bf16x8 qr[4];
#pragma unroll
    for (int d0 = 0; d0 < 4; ++d0) qr[d0] = *reinterpret_cast<const bf16x8*>(&Qw[(long)r32 * PITCH + d0 * 16 + hi * 8]);
    unsigned selmask = 0u;
    if constexpr (!OWN) {
    if (qb > 0) {
        if (qb <= 3) selmask = (1u << qb) - 1u;
        else { int kbs[3]; gate_top3(ksum + ((size_t)(b * NHEAD + h) * 32) * 64, qr, qb, r32, hi, kbs); selmask = (1u << kbs[0]) | (1u << kbs[1]) | (1u << kbs[2]); }
    } }
    float zf_; asm volatile("v_mov_b32 %0, 0" : "=v"(zf_));
    float mhat = 0.f, l_reg = 0.f; f32x16 o[2]; f32x16 negm;
#pragma unroll
    for (int r = 0; r < 16; ++r) { o[0][r] = zf_; o[1][r] = zf_; negm[r] = zf_; }
    asm volatile("" : "+v"(negm));
    const int qrel = wid * QBLK + r32;
#define MASKT(P0, P1, t) do { const int a_ = TM(t); const int jb_ = a_ - (NT - 4); if (jb_ >= 0) cmask(P0, P1, jb_, qrel, hi); else selapply(P0, P1, ((selmask >> (a_ >> 2)) & 1u) != 0u); } while (0)
    bool resc = false;
#define START(P0, P1) do { const float rm = rowmax(P0, P1); resc = false; \
    { const float dl = rm; mhat = fadd_s(mhat, dl); \
      _Pragma("unroll") for (int r = 0; r < 16; ++r) { P0[r] = fsub_s(P0[r], dl); P1[r] = fsub_s(P1[r], dl); } \
      _Pragma("unroll") for (int r = 0; r < 16; ++r) negm[r] = -mhat; asm volatile("" : "+v"(negm)); } \
    _Pragma("unroll") for (int r = 0; r < 16; ++r) P0[r] = __builtin_amdgcn_exp2f(P0[r]); } while (0)
#define RESC() do { if (resc) { asm volatile("s_waitcnt lgkmcnt(0)" ::: "memory"); \
      _Pragma("unroll") for (int d_ = 0; d_ < 2; ++d_) _Pragma("unroll") for (int r = 0; r < 16; ++r) o[d_][r] *= wsf[crow(r, hi)]; } } while (0)
    f32x16 pA0, pA1, pB0, pB1;
    int sl_prev = 0, sl_cur = 0, sl_next = SLOTB;
#define ROT() do { sl_prev = sl_cur; sl_cur = sl_next; sl_next = (sl_next == (NSLOT - 1) * SLOTB) ? 0 : sl_next + SLOTB; } while (0)
    DMA_K(2, 2 * SLOTB);
    WAIT_BAR(3);
    qkt(pA0, pA1, Kbase, qr, negm, r32, hi); asm volatile("s_nop 15\n\ts_nop 7" : "+v"(pA0), "+v"(pA1)); MASKT(pA0, pA1, 0);
    START(pA0, pA1);
    _Pragma("unroll") for (int r = 0; r < 16; ++r) pA1[r] = __builtin_amdgcn_exp2f(pA1[r]);
    WAIT_BAR(0);
    DMA_K(3, 0); DMA_V(1, SLOTB);
    ROT();
    kload8(kf, kp0 + sl_cur);
    WAIT_BAR(2);
    s16x4 vlo[8], vhi[8]; u32x4 pw0, pw1, pw2, pw3;
#define PKW(P, B) cvtpk_s(P[B], P[B + 1])
#define PAF(k) __builtin_bit_cast(bf16x8, pw##k)
#define VFR(i) (bf16x8){vlo[i][0], vlo[i][1], vlo[i][2], vlo[i][3], vhi[i][0], vhi[i][1], vhi[i][2], vhi[i][3]}
#define PIN(x) asm volatile("" : "+v"(x))
#define MX3(a, b, c) __builtin_fmaxf(__builtin_fmaxf((a), (b)), (c))
#define GAPA(MF, A0, A1, A2, A3, W0, W1, PW) do { MF; sacc += A0; sacc += A1; sacc += A2; sacc += A3; PIN(sacc); W0; W1; PIN(PW); SBAR(); } while (0)
#define EX(v) __builtin_amdgcn_exp2f(v)
#define GAPB(MF, X, B) do { MF; X[B] = EX(X[B]); X[B + 1] = EX(X[B + 1]); X[B + 2] = EX(X[B + 2]); X[B + 3] = EX(X[B + 3]); PIN(X); SBAR(); } while (0)
#define VRD(i) do { vlo[i] = vtr(vp_ + (((i) >> 2) * 4096 + ((i) & 3) * 1024)); vhi[i] = vtr(vp_ + (((i) >> 2) * 4096 + ((i) & 3) * 1024 + 512)); } while (0)
#define KRD(G, j) do { if (G) { kload2(kf, kp0 + sl_next, j); SBAR(); } } while (0)
#define STEP(C0, C1, P0, P1, t, GK, GV, GL) do { SBAR(); \
    const lds_cptr vp_ = vp0 + sl_prev; \
    VRD(0); SBAR(); float sacc = (P0[0] + P0[1]); \
    GAPA(C0 = __builtin_amdgcn_mfma_f32_32x32x16_bf16(kf[0], qr[0], negm, 0, 0, 0), P0[2], P0[3], P0[4], P0[5],     pw0[0] = PKW(P0, 0), pw0[1] = PKW(P0, 2), pw0); \
    VRD(4); SBAR(); GAPA(C1 = __builtin_amdgcn_mfma_f32_32x32x16_bf16(kf[1], qr[0], negm, 0, 0, 0), P0[6], P0[7], P0[8], P0[9],     pw0[2] = PKW(P0, 4), pw0[3] = PKW(P0, 6), pw0); \
    VRD(1); SBAR(); GAPA(C0 = __builtin_amdgcn_mfma_f32_32x32x16_bf16(kf[2], qr[1], C0, 0, 0, 0),   P0[10], P0[11], P0[12], P0[13], pw1[0] = PKW(P0, 8), pw1[1] = PKW(P0, 10), pw1); \
    VRD(5); SBAR(); GAPA(C1 = __builtin_amdgcn_mfma_f32_32x32x16_bf16(kf[3], qr[1], C1, 0, 0, 0),   P0[14], P0[15], P1[0], P1[1],   pw1[2] = PKW(P0, 12), pw1[3] = PKW(P0, 14), pw1); \
    VRD(2); SBAR(); GAPA(C0 = __builtin_amdgcn_mfma_f32_32x32x16_bf16(kf[4], qr[2], C0, 0, 0, 0),   P1[2], P1[3], P1[4], P1[5],     pw2[0] = PKW(P1, 0), pw2[1] = PKW(P1, 2), pw2); \
    VRD(6); SBAR(); GAPA(C1 = __builtin_amdgcn_mfma_f32_32x32x16_bf16(kf[5], qr[2], C1, 0, 0, 0),   P1[6], P1[7], P1[8], P1[9],     pw2[2] = PKW(P1, 4), pw2[3] = PKW(P1, 6), pw2); \
    VRD(3); SBAR(); GAPA(C0 = __builtin_amdgcn_mfma_f32_32x32x16_bf16(kf[6], qr[3], C0, 0, 0, 0),   P1[10], P1[11], P1[12], P1[13], pw3[0] = PKW(P1, 8), pw3[1] = PKW(P1, 10), pw3); \
    VRD(7); SBAR(); GAPA(C1 = __builtin_amdgcn_mfma_f32_32x32x16_bf16(kf[7], qr[3], C1, 0, 0, 0),   P1[14], P1[15], 0.f, 0.f,       pw3[2] = PKW(P1, 12), pw3[3] = PKW(P1, 14), pw3); \
    l_reg += sacc; \
    if (GK) { DMA_K((t) + 3, sl_cur); } if (GV) { DMA_V((t) + 1, sl_next); } \
    MASKT(C0, C1, t); \
    { float a = MX3(C0[0], C0[1], C1[0]), b = MX3(C0[2], C0[3], C1[1]); a = MX3(a, C1[2], C1[3]); \
      _Pragma("unroll") for (int r = 4; r < 16; r += 4) { a = MX3(a, C0[r], C0[r + 1]); b = MX3(b, C0[r + 2], C0[r + 3]); a = MX3(a, C1[r], C1[r + 1]); b = MX3(b, C1[r + 2], C1[r + 3]); } \
      float rm = __builtin_fmaxf(a, b); { auto rr = __builtin_amdgcn_permlane32_swap(__float_as_uint(rm), __float_as_uint(rm), false, false); rm = __builtin_fmaxf(__uint_as_float(rr[0]), __uint_as_float(rr[1])); } \
      resc = false; \
      if (__builtin_expect(__any(rm > (float)THRL), 0)) { const float dl = __builtin_fmaxf(rm, 0.f); mhat += dl; \
        _Pragma("unroll") for (int r = 0; r < 16; ++r) { C0[r] -= dl; C1[r] -= dl; } \
        _Pragma("unroll") for (int r = 0; r < 16; ++r) negm[r] = -mhat; asm volatile("" : "+v"(negm)); \
        const float f = __builtin_amdgcn_exp2f(-dl); l_reg *= f; if (hi == 0) wsf[r32] = f; resc = true; } } \
    SBAR(); \
    GAPB(o[0] = __builtin_amdgcn_mfma_f32_32x32x16_bf16(PAF(0), VFR(0), o[0], 0, 0, 0), C0, 0); \
    GAPB(o[1] = __builtin_amdgcn_mfma_f32_32x32x16_bf16(PAF(0), VFR(4), o[1], 0, 0, 0), C0, 4); \
    KRD(GL, 0); GAPB(o[0] = __builtin_amdgcn_mfma_f32_32x32x16_bf16(PAF(1), VFR(1), o[0], 0, 0, 0), C0, 8); \
    KRD(GL, 1); GAPB(o[1] = __builtin_amdgcn_mfma_f32_32x32x16_bf16(PAF(1), VFR(5), o[1], 0, 0, 0), C0, 12); \
    KRD(GL, 2); GAPB(o[0] = __builtin_amdgcn_mfma_f32_32x32x16_bf16(PAF(2), VFR(2), o[0], 0, 0, 0), C1, 0); \
    KRD(GL, 3); GAPB(o[1] = __builtin_amdgcn_mfma_f32_32x32x16_bf16(PAF(2), VFR(6), o[1], 0, 0, 0), C1, 4); \
    GAPB(o[0] = __builtin_amdgcn_mfma_f32_32x32x16_bf16(PAF(3), VFR(3), o[0], 0, 0, 0), C1, 8); \
    GAPB(o[1] = __builtin_amdgcn_mfma_f32_32x32x16_bf16(PAF(3), VFR(7), o[1], 0, 0, 0), C1, 12); \
    } while (0)
    int t = 1;
    for (; t + 5 < NT; t += 2) {
        STEP(pB0, pB1, pA0, pA1, t, true, true, true);     WAIT_BAR(2); RESC(); ROT();
        STEP(pA0, pA1, pB0, pB1, t + 1, true, true, true); WAIT_BAR(2); RESC(); ROT();
    }
#define ENDW(tt) do { if ((tt) + 3 < NT) { WAIT_BAR(2); } else if ((tt) + 2 < NT) { WAIT_BAR(1); } else { WAIT_BAR(0); } } while (0)
    for (; t + 1 < NT; t += 2) {
        STEP(pB0, pB1, pA0, pA1, t, (t + 3 < NT), (t + 1 < NT), (t + 1 < NT));       ENDW(t);     RESC(); ROT();
        STEP(pA0, pA1, pB0, pB1, t + 1, (t + 4 < NT), (t + 2 < NT), (t + 2 < NT));   ENDW(t + 1); RESC(); ROT();
    }
    STEP(pB0, pB1, pA0, pA1, NT - 1, false, false, false); RESC();
    { float sacc = pB0[0] + pB0[1]; _Pragma("unroll") for (int r = 2; r < 16; ++r) sacc += pB0[r]; _Pragma("unroll") for (int r = 0; r < 16; ++r) sacc += pB1[r]; l_reg += sacc;
      pw0 = (u32x4){PKW(pB0, 0), PKW(pB0, 2), PKW(pB0, 4), PKW(pB0, 6)}; pw1 = (u32x4){PKW(pB0, 8), PKW(pB0, 10), PKW(pB0, 12), PKW(pB0, 14)}; pw2 = (u32x4){PKW(pB1, 0), PKW(pB1, 2), PKW(pB1, 4), PKW(pB1, 6)}; pw3 = (u32x4){PKW(pB1, 8), PKW(pB1, 10), PKW(pB1, 12), PKW(pB1, 14)};
      SBAR(); pv(o, vb0 + sl_cur, PAF(0), PAF(1), PAF(2), PAF(3)); }
#undef PKW
#undef PAF
#undef VFR
#undef PIN
#undef MX3
#undef GAPA
#undef GAPB
#undef EX
#undef VRD
#undef KRD
#undef STEP
#undef ENDW
    { auto rr = __builtin_amdgcn_permlane32_swap(__float_as_uint(l_reg), __float_as_uint(l_reg), false, false); l_reg = __uint_as_float(rr[0]) + __uint_as_float(rr[1]); }
    if (hi == 0) { wsf[32 + r32] = l_reg; if (OWN) wsf[r32] = mhat; } asm volatile("s_waitcnt lgkmcnt(0)" ::: "memory");
    float rli[16];
#pragma unroll
    for (int r = 0; r < 16; ++r) rli[r] = __builtin_amdgcn_rcpf(wsf[32 + crow(r, hi)]);
    bf16* Ow = O + (rowbase + q0 + wid * QBLK) * PITCH + h * D;
    { bf16* stg = (bf16*)(shm + LDS_OST) + wid * 2048;
#pragma unroll
      for (int r = 0; r < 16; ++r) { const int orow = crow(r, hi);
#pragma unroll
        for (int d0 = 0; d0 < 2; ++d0) stg[orow * 64 + d0 * 32 + r32] = __float2bfloat16(o[d0][r] * rli[r]); }
      asm volatile("s_waitcnt lgkmcnt(0)" ::: "memory");
      const int nsel = qb < 3 ? qb : 3;
#pragma unroll
      for (int i = 0; i < 4; ++i) { const int row = i * 8 + (lane >> 3), ch = lane & 7; u32x4 v = *(const u32x4*)(stg + row * 64 + ch * 8);
        if constexpr (OWN) {
          if (nsel > 0) {
            const float mo = wsf[row], lo = wsf[32 + row];
            const size_t e0 = (((size_t)(b * NHEAD + h)) * SEQ + q0 + wid * QBLK + row) * 3;
            float ms[3], ls[3]; u32x4 pp[3]; float M = mo;
#pragma unroll
            for (int s_ = 0; s_ < 3; ++s_) { ms[s_] = -INFINITY; ls[s_] = 0.f; pp[s_] = (u32x4){0u, 0u, 0u, 0u};
              if (s_ < nsel) { const f32x2 ml = *(const f32x2*)(PML + (e0 + s_) * 2); ms[s_] = ml.x; ls[s_] = ml.y; pp[s_] = *(const u32x4*)(PO + (e0 + s_) * 64 + ch * 8); M = fmaxf(M, ml.x); } }
            const float wo = lo * __builtin_amdgcn_exp2f(mo - M); float W = wo;
            float a[8] = {bflo(v.x) * wo, bfhi(v.x) * wo, bflo(v.y) * wo, bfhi(v.y) * wo, bflo(v.z) * wo, bfhi(v.z) * wo, bflo(v.w) * wo, bfhi(v.w) * wo};
#pragma unroll
            for (int s_ = 0; s_ < 3; ++s_) { const float w_ = (s_ < nsel) ? ls[s_] * __builtin_amdgcn_exp2f(ms[s_] - M) : 0.f; W += w_;
              a[0] += w_ * bflo(pp[s_].x); a[1] += w_ * bfhi(pp[s_].x); a[2] += w_ * bflo(pp[s_].y); a[3] += w_ * bfhi(pp[s_].y); a[4] += w_ * bflo(pp[s_].z); a[5] += w_ * bfhi(pp[s_].z); a[6] += w_ * bflo(pp[s_].w); a[7] += w_ * bfhi(pp[s_].w); }
            const float iw = 1.0f / W;
            v.x = cvtpk_s(a[0] * iw, a[1] * iw); v.y = cvtpk_s(a[2] * iw, a[3] * iw); v.z = cvtpk_s(a[4] * iw, a[5] * iw); v.w = cvtpk_s(a[6] * iw, a[7] * iw);
          } }
        if (do_store) *(u32x4*)(Ow + (long)row * PITCH + ch * 8) = v; } }
    asm volatile("s_waitcnt lgkmcnt(0)\n\ts_barrier" ::: "memory");
#undef DMA_K
#undef DMA_V
#undef TM
#undef MASKT
#undef START
#undef RESC
#undef ROT
}

__device__ __forceinline__ void select_unit(int b, int h, int qb, const bf16* Q, const float* ksum, unsigned short* LIST, unsigned* CNT, char* shm) {
    if (qb == 0) return;
    const int tid = threadIdx.x, lane = tid & 63, r32 = lane & 31, hi = lane >> 5; const int wid = __builtin_amdgcn_readfirstlane(tid >> 6);
    LAS unsigned* hist = (LAS unsigned*)shm; LAS unsigned* basev = hist + 32;
    if (tid < 32) hist[tid] = 0u;
    __syncthreads();
    int kbs[3] = {0, 1, 2}; const int ns = qb < 3 ? qb : 3;
    if (qb > 3) {
        const bf16* Qw = Q + ((long)b * SEQ + qb * QB + wid * QBLK) * PITCH + h * D;
        bf16x8 qr[4];
#pragma unroll
        for (int d0 = 0; d0 < 4; ++d0) qr[d0] = *reinterpret_cast<const bf16x8*>(&Qw[(long)r32 * PITCH + d0 * 16 + hi * 8]);
        gate_top3(ksum + ((size_t)(b * NHEAD + h) * 32) * 64, qr, qb, r32, hi, kbs);
    }
    unsigned pos[3] = {0u, 0u, 0u};
    if (hi == 0) {
#pragma unroll
        for (int s_ = 0; s_ < 3; ++s_) if (s_ < ns) pos[s_] = __hip_atomic_fetch_add(hist + kbs[s_], 1u, __ATOMIC_RELAXED, __HIP_MEMORY_SCOPE_WORKGROUP);
    }
    __syncthreads();
    const int bh = b * NHEAD + h;
    if (tid < 32) { const unsigned n = hist[tid]; basev[tid] = n ? __hip_atomic_fetch_add(CNT + bh * 32 + tid, n, __ATOMIC_RELAXED, __HIP_MEMORY_SCOPE_AGENT) : 0u; }
    __syncthreads();
    if (hi == 0) { const unsigned qv = (unsigned)(qb * QB + wid * QBLK + r32) << 2;
#pragma unroll
        for (int s_ = 0; s_ < 3; ++s_) if (s_ < ns) LIST[(size_t)(bh * 32 + kbs[s_]) * 8192 + basev[kbs[s_]] + pos[s_]] = (unsigned short)(qv | (unsigned)s_); }
    __syncthreads();
}

constexpr int G_K = 0, G_V = 32768, G_WS = 65536, G_OST = G_WS + NW * 512, G_TAB = G_OST + NW * 4096, G_BYTES = G_TAB + 8256 + 4096 + 4104;
template <int THRL> __device__ __forceinline__ void gather_phase(char* shm, const bf16* Q, const bf16* __restrict__ K, const bf16* __restrict__ V, const unsigned short* LIST, unsigned* CNT, bf16_t* PO, float* PML, int vcu, int G, bool do_store) {
    const int tid = threadIdx.x, lane = tid & 63, r32 = lane & 31, hi = lane >> 5; const int wid = __builtin_amdgcn_readfirstlane(tid >> 6);
    LAS int* pre = (LAS int*)(shm + G_TAB); LAS int* wtot = pre + 1032; LAS int* cntl = (LAS int*)(shm + G_TAB + 8256); LAS int* prw = (LAS int*)(shm + G_TAB + 8256 + 4096);
    constexpr int WL = 24, WP = 20;
    {
        const int c0 = (int)__hip_atomic_load(CNT + 2 * tid, __ATOMIC_RELAXED, __HIP_MEMORY_SCOPE_AGENT), c1 = (int)__hip_atomic_load(CNT + 2 * tid + 1, __ATOMIC_RELAXED, __HIP_MEMORY_SCOPE_AGENT);
        const int n0 = (c0 + 255) >> 8, n1 = (c1 + 255) >> 8, sm = n0 + n1;
        const int w0 = c0 ? WL + (n0 - 1) * WP + 12 + ((c0 - 256 * (n0 - 1) + 31) >> 5) : 0, w1 = c1 ? WL + (n1 - 1) * WP + 12 + ((c1 - 256 * (n1 - 1) + 31) >> 5) : 0, sw = w0 + w1;
        int v = sm, vw = sw;
#pragma unroll
        for (int o_ = 1; o_ < 64; o_ <<= 1) { const int t_ = __shfl_up(v, o_), tw_ = __shfl_up(vw, o_); if (lane >= o_) { v += t_; vw += tw_; } }
        if (lane == 63) { wtot[wid] = v; wtot[8 + wid] = vw; }
        cntl[2 * tid] = c0; cntl[2 * tid + 1] = c1;
        __syncthreads();
        int off = 0, offw = 0;
        for (int w_ = 0; w_ < wid; ++w_) { off += wtot[w_]; offw += wtot[8 + w_]; }
        const int excl = off + v - sm, exclw = offw + vw - sw;
        pre[2 * tid] = excl; pre[2 * tid + 1] = excl + n0; prw[2 * tid] = exclw; prw[2 * tid + 1] = exclw + w0;
        if (tid == NW * 64 - 1) { pre[1024] = excl + sm; prw[1024] = exclw + sw; }
        __syncthreads();
    }
    const int Wtot = __builtin_amdgcn_readfirstlane(prw[1024]);
    int ub[2], istart = 0;
#pragma unroll
    for (int e_ = 0; e_ < 2; ++e_) { const int tgt = (int)(((long)Wtot * (vcu + e_)) / G);
        int lo_ = 0, hi_ = 1024;
        while (hi_ - lo_ > 1) { const int mid = (lo_ + hi_) >> 1; if (__builtin_amdgcn_readfirstlane(prw[mid]) <= tgt) lo_ = mid; else hi_ = mid; }
        const int npi = __builtin_amdgcn_readfirstlane(pre[lo_ + 1]) - __builtin_amdgcn_readfirstlane(pre[lo_]);
        int p_ = (tgt - __builtin_amdgcn_readfirstlane(prw[lo_]) - WL + WP / 2) / WP; p_ = p_ < 0 ? 0 : (p_ > npi ? npi : p_);
        ub[e_] = (vcu + e_ >= G) ? __builtin_amdgcn_readfirstlane(pre[1024]) : __builtin_amdgcn_readfirstlane(pre[lo_]) + p_;
        if (e_ == 0 && vcu != 0) istart = lo_; }
    const int ulo = (vcu == 0) ? 0 : ub[0], uhi = ub[1];
    const unsigned lds0 = (unsigned)(uintptr_t)shm;
    float* wsf = (float*)(shm + G_WS) + wid * 128; int* ent = (int*)(wsf + 64);
    const unsigned kdst = lds0 + G_K + wid * 1024, vdst = lds0 + G_V + wid * 1024;
    const int vb0 = (int)(lds0 + G_V) + ((lane >> 4) & 1) * 32 + (lane & 3) * 8 + (4 * hi + ((lane & 15) >> 2)) * 64;
    int it0 = istart, it1 = istart, it2 = istart, cur = -1;
#define G_ITEM(itv, uu) do { while ((uu) < uhi && __builtin_amdgcn_readfirstlane(pre[(itv) + 1]) <= (uu)) ++(itv); } while (0)
#define G_ENTRY(itv, uu) ({ const int ps_ = (uu) - __builtin_amdgcn_readfirstlane(pre[itv]), cn_ = __builtin_amdgcn_readfirstlane(cntl[itv]); const int li_ = ps_ * 256 + wid * QBLK + r32; \
        (unsigned)LIST[(size_t)(itv) * 8192 + (li_ < cn_ ? li_ : 0)] | ((li_ < cn_) ? 0x10000u : 0u); })
#define G_QLOAD(dst, itv, ee) do { const int bh_ = (itv) >> 5; const bf16* Qrow_ = Q + ((long)(bh_ >> 3) * SEQ + (int)(((ee) & 0xffffu) >> 2)) * PITCH + (bh_ & 7) * D; \
        _Pragma("unroll") for (int d0 = 0; d0 < 4; ++d0) dst[d0] = *reinterpret_cast<const bf16x8*>(Qrow_ + d0 * 16 + hi * 8); } while (0)
    unsigned e0 = 0u, e1 = 0u, e2 = 0u; bf16x8 qr[4], qn[4];
    if (ulo < uhi) { G_ITEM(it0, ulo); e0 = G_ENTRY(it0, ulo); it1 = it0; { const int u1_ = (ulo + 1 < uhi) ? ulo + 1 : uhi - 1; G_ITEM(it1, u1_); e1 = G_ENTRY(it1, u1_); } G_QLOAD(qr, it0, e0); }
    it2 = it1;
    for (int u = ulo; u < uhi; ++u) {
        { const int u2_ = (u + 2 < uhi) ? u + 2 : uhi - 1; G_ITEM(it2, u2_); e2 = G_ENTRY(it2, u2_); }
        const int item = it0;
        const int bh = item >> 5, kb = item & 31, b = bh >> 3, h = bh & 7;
        if (item != cur) {
            asm volatile("s_waitcnt lgkmcnt(0)\n\ts_barrier" ::: "memory");
            const bf16* Kh = K + (long)b * SEQ * PITCH + h * D, *Vh = V + (long)b * SEQ * PITCH + h * D;
            const bf16* ksrc = Kh + (long)lane * PITCH + wid * 8;
            const bf16* vsrc = Vh + (long)(16 * (wid & 3) + (lane >> 2)) * PITCH + (wid >> 2) * 32 + (lane & 3) * 8;
#pragma unroll
            for (int t = 0; t < 4; ++t) { glds16(ksrc + (long)(4 * kb + t) * KVBLK * PITCH, (unsigned)__builtin_amdgcn_readfirstlane(kdst + t * 8192)); glds16(vsrc + (long)(4 * kb + t) * KVBLK * PITCH, (unsigned)__builtin_amdgcn_readfirstlane(vdst + t * 8192)); }
            asm volatile("s_waitcnt vmcnt(0)\n\ts_barrier" ::: "memory");
            cur = item;
            if (wid >= 4) __builtin_amdgcn_s_sleep(10);
        }
        G_QLOAD(qn, it1, e1);
        const bool valid = (e0 & 0x10000u) != 0u;
        const int q = (int)((e0 & 0xffffu) >> 2), slot = (int)(e0 & 3u);
        const bool wave_has_rows = __builtin_amdgcn_readfirstlane((int)(e0 >> 16) & 1) != 0 || __any(valid);
        if (wave_has_rows) {
        float mhat = 0.f, l_reg = 0.f; f32x16 o[2]; f32x16 negm;
#pragma unroll
        for (int r = 0; r < 16; ++r) { o[0][r] = 0.f; o[1][r] = 0.f; negm[r] = 0.f; }
        const lds_cptr kp0 = (lds_cptr)shm + G_K + hi * 1024 + r32 * 16; const lds_cptr vp0 = (lds_cptr)shm + G_V + ((lane >> 4) & 1) * 32 + (lane & 3) * 8 + (4 * hi + ((lane & 15) >> 2)) * 64;
        bf16x8 kf[8]; f32x16 p0, p1, s0, s1;
#define G_QK(D0, D1) do { D0 = __builtin_amdgcn_mfma_f32_32x32x16_bf16(kf[0], qr[0], negm, 0, 0, 0); D1 = __builtin_amdgcn_mfma_f32_32x32x16_bf16(kf[1], qr[0], negm, 0, 0, 0); \
            D0 = __builtin_amdgcn_mfma_f32_32x32x16_bf16(kf[2], qr[1], D0, 0, 0, 0); D1 = __builtin_amdgcn_mfma_f32_32x32x16_bf16(kf[3], qr[1], D1, 0, 0, 0); \
            D0 = __builtin_amdgcn_mfma_f32_32x32x16_bf16(kf[4], qr[2], D0, 0, 0, 0); D1 = __builtin_amdgcn_mfma_f32_32x32x16_bf16(kf[5], qr[2], D1, 0, 0, 0); \
            D0 = __builtin_amdgcn_mfma_f32_32x32x16_bf16(kf[6], qr[3], D0, 0, 0, 0); D1 = __builtin_amdgcn_mfma_f32_32x32x16_bf16(kf[7], qr[3], D1, 0, 0, 0); } while (0)
#define G_MX(D0, D1, FIRST) do { float a_ = fmaxf(fmaxf(D0[0], D0[1]), D1[0]), c_ = fmaxf(fmaxf(D0[2], D0[3]), D1[1]); a_ = fmaxf(fmaxf(a_, D1[2]), D1[3]); \
            _Pragma("unroll") for (int r = 4; r < 16; r += 4) { a_ = fmaxf(fmaxf(a_, D0[r]), D0[r + 1]); c_ = fmaxf(fmaxf(c_, D0[r + 2]), D0[r + 3]); a_ = fmaxf(fmaxf(a_, D1[r]), D1[r + 1]); c_ = fmaxf(fmaxf(c_, D1[r + 2]), D1[r + 3]); } \
            float rm_ = fmaxf(a_, c_); { auto rr_ = __builtin_amdgcn_permlane32_swap(__float_as_uint(rm_), __float_as_uint(rm_), false, false); rm_ = fmaxf(__uint_as_float(rr_[0]), __uint_as_float(rr_[1])); } \
            if (FIRST) { mhat = rm_; _Pragma("unroll") for (int r = 0; r < 16; ++r) { D0[r] -= rm_; D1[r] -= rm_; negm[r] = -mhat; } } \
            else if (__any(rm_ > (float)THRL)) { const float dl_ = fmaxf(rm_, 0.f); mhat += dl_; \
                _Pragma("unroll") for (int r = 0; r < 16; ++r) { D0[r] -= dl_; D1[r] -= dl_; negm[r] = -mhat; } \
                const float f_ = __builtin_amdgcn_exp2f(-dl_); l_reg *= f_; if (hi == 0) wsf[r32] = f_; \
                asm volatile("s_waitcnt lgkmcnt(0)" ::: "memory"); \
                _Pragma("unroll") for (int d_ = 0; d_ < 2; ++d_) _Pragma("unroll") for (int r = 0; r < 16; ++r) o[d_][r] *= wsf[crow(r, hi)]; } } while (0)
        const bool run_tiles = (GPROBE == 1) ? do_store : true;
        if (run_tiles) {
        kload8(kf, kp0);
        G_QK(p0, p1);
        kload8(kf, kp0 + 8192);
        G_MX(p0, p1, true);
#pragma unroll
        for (int t = 0; t < 4; ++t) {
            if (t < 3) { __builtin_amdgcn_sched_barrier(0); G_QK(s0, s1); if (t < 2) kload8(kf, kp0 + (t + 2) * 8192); }
            s16x4 vlo[8], vhi[8];
            const lds_cptr vp_ = vp0 + t * 8192;
#pragma unroll
            for (int i = 0; i < 8; ++i) { vlo[i] = vtr(vp_ + ((i >> 2) * 4096 + (i & 3) * 1024)); vhi[i] = vtr(vp_ + ((i >> 2) * 4096 + (i & 3) * 1024 + 512)); }
            __builtin_amdgcn_sched_barrier(0);
            float sacc = 0.f;
#pragma unroll
            for (int r = 0; r < 16; ++r) { p0[r] = __builtin_amdgcn_exp2f(p0[r]); p1[r] = __builtin_amdgcn_exp2f(p1[r]); sacc += p0[r] + p1[r]; }
            l_reg += sacc;
            const u32x4 pw0 = {cvtpk_s(p0[0], p0[1]), cvtpk_s(p0[2], p0[3]), cvtpk_s(p0[4], p0[5]), cvtpk_s(p0[6], p0[7])}, pw1 = {cvtpk_s(p0[8], p0[9]), cvtpk_s(p0[10], p0[11]), cvtpk_s(p0[12], p0[13]), cvtpk_s(p0[14], p0[15])};
            const u32x4 pw2 = {cvtpk_s(p1[0], p1[1]), cvtpk_s(p1[2], p1[3]), cvtpk_s(p1[4], p1[5]), cvtpk_s(p1[6], p1[7])}, pw3 = {cvtpk_s(p1[8], p1[9]), cvtpk_s(p1[10], p1[11]), cvtpk_s(p1[12], p1[13]), cvtpk_s(p1[14], p1[15])};
            __builtin_amdgcn_sched_barrier(0);
#define G_VF(i) (bf16x8){vlo[i][0], vlo[i][1], vlo[i][2], vlo[i][3], vhi[i][0], vhi[i][1], vhi[i][2], vhi[i][3]}
            if (GPROBE == 2 && !do_store) { asm volatile("" :: "v"(pw0), "v"(pw1), "v"(pw2), "v"(pw3)); } else {
            o[0] = __builtin_amdgcn_mfma_f32_32x32x16_bf16(__builtin_bit_cast(bf16x8, pw0), G_VF(0), o[0], 0, 0, 0); o[1] = __builtin_amdgcn_mfma_f32_32x32x16_bf16(__builtin_bit_cast(bf16x8, pw0), G_VF(4), o[1], 0, 0, 0);
            o[0] = __builtin_amdgcn_mfma_f32_32x32x16_bf16(__builtin_bit_cast(bf16x8, pw1), G_VF(1), o[0], 0, 0, 0); o[1] = __builtin_amdgcn_mfma_f32_32x32x16_bf16(__builtin_bit_cast(bf16x8, pw1), G_VF(5), o[1], 0, 0, 0);
            o[0] = __builtin_amdgcn_mfma_f32_32x32x16_bf16(__builtin_bit_cast(bf16x8, pw2), G_VF(2), o[0], 0, 0, 0); o[1] = __builtin_amdgcn_mfma_f32_32x32x16_bf16(__builtin_bit_cast(bf16x8, pw2), G_VF(6), o[1], 0, 0, 0);
            o[0] = __builtin_amdgcn_mfma_f32_32x32x16_bf16(__builtin_bit_cast(bf16x8, pw3), G_VF(3), o[0], 0, 0, 0); o[1] = __builtin_amdgcn_mfma_f32_32x32x16_bf16(__builtin_bit_cast(bf16x8, pw3), G_VF(7), o[1], 0, 0, 0);
            }
#undef G_VF
            if (t < 3) { G_MX(s0, s1, false); p0 = s0; p1 = s1; }
        }
        }
#undef G_QK
#undef G_MX
        { auto rr = __builtin_amdgcn_permlane32_swap(__float_as_uint(l_reg), __float_as_uint(l_reg), false, false); l_reg = __uint_as_float(rr[0]) + __uint_as_float(rr[1]); }
        const int er = valid ? (q * 3 + slot) : -1;
        if (hi == 0) { wsf[32 + r32] = l_reg; ent[r32] = er; } asm volatile("s_waitcnt lgkmcnt(0)" ::: "memory");
        float rli[16];
#pragma unroll
        for (int r = 0; r < 16; ++r) rli[r] = __builtin_amdgcn_rcpf(wsf[32 + crow(r, hi)]);
        bf16* stg = (bf16*)(shm + G_OST) + wid * 2048;
#pragma unroll
        for (int r = 0; r < 16; ++r) { const int orow = crow(r, hi);
#pragma unroll
            for (int d0 = 0; d0 < 2; ++d0) stg[orow * 64 + d0 * 32 + r32] = __float2bfloat16(o[d0][r] * rli[r]); }
        asm volatile("s_waitcnt lgkmcnt(0)" ::: "memory");
        const size_t ebase = (size_t)bh * SEQ * 3;
#pragma unroll
        for (int i = 0; i < 4; ++i) { const int row = i * 8 + (lane >> 3), ch = lane & 7; const u32x4 v = *(const u32x4*)(stg + row * 64 + ch * 8); const int er_ = ent[row];
            if (er_ >= 0 && do_store) *(u32x4*)(PO + (ebase + er_) * 64 + ch * 8) = v; }
        if (hi == 0 && valid && do_store) *(f32x2*)(PML + (ebase + er) * 2) = (f32x2){mhat, l_reg};
        asm volatile("s_waitcnt lgkmcnt(0)" ::: "memory");
        }
        e0 = e1; e1 = e2; it0 = it1; it1 = it2;
#pragma unroll
        for (int d0 = 0; d0 < 4; ++d0) qr[d0] = qn[d0];
    }
    asm volatile("s_waitcnt vmcnt(0) lgkmcnt(0)\n\ts_barrier" ::: "memory");
#undef G_ITEM
#undef G_ENTRY
#undef G_QLOAD
}
#undef SBAR
#undef WAIT_BAR
}

#define XB_TMO      128
#define XB_XCNT(j)  (256  + 64 * (j))
#define XB_XSUB(j)  (1280 + 64 * (j))
#define XB_XGEN(j)  (2304 + 64 * (j))
#define XB_TOP      3328
#define XB_TOPGEN   3392
#define XCD_BAR_WORDS 3456
#define XB_SPIN_CAP (1u << 18)
__device__ __forceinline__ unsigned xb_ld(unsigned* p)              { return __hip_atomic_load(p, __ATOMIC_RELAXED, __HIP_MEMORY_SCOPE_AGENT); }
__device__ __forceinline__ unsigned xb_add(unsigned* p, unsigned v) { return __hip_atomic_fetch_add(p, v, __ATOMIC_RELAXED, __HIP_MEMORY_SCOPE_AGENT); }
__device__ __forceinline__ unsigned xb_xcc_id() { return (unsigned)__builtin_amdgcn_s_getreg((3 << 11) | 20) & 0xFu; }
#define XB_SPIN(cond, bar) do { unsigned _sp = 0; while (cond) { __builtin_amdgcn_s_sleep(1); \
    if ((++_sp & 255u) == 0u) { if (xb_ld(&(bar)[XB_TMO])) break; if (_sp > XB_SPIN_CAP) { atomicAdd(&(bar)[XB_TMO], 1u); break; } } } } while (0)
struct XcdBarrier { unsigned* bar; unsigned x; volatile LAS unsigned* st; };
__device__ __forceinline__ XcdBarrier xcd_barrier_post(unsigned* bar, volatile LAS unsigned* st) {
    XcdBarrier b; b.bar = bar; b.x = xb_xcc_id(); b.st = st;
    if (threadIdx.x == 0) (void)xb_add(&bar[XB_XCNT(b.x)], 1u);
    return b;
}
__device__ __forceinline__ void xcd_barrier_complete(unsigned* bar, unsigned x, unsigned& nloc, unsigned& nx) {
    const unsigned G = gridDim.x * gridDim.y * gridDim.z;
    unsigned sum, cnt, mine, sp = 0u;
    for (;;) {
        sum = 0u; cnt = 0u; mine = 0u;
#pragma unroll
        for (unsigned j = 0; j < 16; ++j) { const unsigned c = xb_ld(&bar[XB_XCNT(j)]); sum += c; cnt += (c > 0u) ? 1u : 0u; mine = (j == x) ? c : mine; }
        if (sum == G) break;
        __builtin_amdgcn_s_sleep(1);
        if ((++sp & 255u) == 0u) { if (xb_ld(&bar[XB_TMO])) break; if (sp > XB_SPIN_CAP) { atomicAdd(&bar[XB_TMO], 1u); break; } }
    }
    nloc = mine > 0u ? mine : 1u; nx = cnt > 0u ? cnt : 1u;
}
__device__ __forceinline__ void xcd_barrier_(const XcdBarrier& b);
__device__ __forceinline__ void xcd_barrier(const XcdBarrier& b) { T_BEGIN(1, t1_) xcd_barrier_(b); T_END(1, t1_); }
__device__ __forceinline__ void xcd_barrier_(const XcdBarrier& b) {
    asm volatile("s_waitcnt vmcnt(0)" ::: "memory");
    __syncthreads();
    if (threadIdx.x == 0) {
        unsigned* bar = b.bar;
        __builtin_amdgcn_s_waitcnt(0);
        unsigned nloc = b.st[0], nx = b.st[1];
        if (nloc == 0u) { xcd_barrier_complete(bar, b.x, nloc, nx); b.st[0] = nloc; b.st[1] = nx; }
        const unsigned old = xb_add(&bar[XB_XSUB(b.x)], 1u);
        const unsigned gen = old / nloc;
        if (old + 1u == (gen + 1u) * nloc) {
            __builtin_amdgcn_fence(__ATOMIC_RELEASE, "agent");
            asm volatile("s_waitcnt vmcnt(0)" ::: "memory");
            const unsigned og = xb_add(&bar[XB_TOP], 1u);
            const unsigned tg = og / nx;
            if (og + 1u == (tg + 1u) * nx) xb_add(&bar[XB_TOPGEN], 1u);
            else XB_SPIN(xb_ld(&bar[XB_TOPGEN]) == tg, bar);
            __builtin_amdgcn_fence(__ATOMIC_ACQUIRE, "agent");
            xb_add(&bar[XB_XGEN(b.x)], 1u);
            asm volatile("s_waitcnt vmcnt(0)" ::: "memory");
        } else {
            XB_SPIN(xb_ld(&bar[XB_XGEN(b.x)]) == gen, bar);
            __builtin_amdgcn_fence(__ATOMIC_ACQUIRE, "agent");
            asm volatile("s_waitcnt vmcnt(0)" ::: "memory");
        }
    }
    __syncthreads();
}

struct Args { const float* in[22]; float* out; unsigned char* ws; int ph_lo, ph_hi, li, flags; };
struct Frame {
    LAS unsigned char* lds; volatile LAS unsigned* MISC; gu32* ctl;
    int tid, lane, wave, vcu, G;
};
#ifndef SKEW_P2
#define SKEW_P2 0
#endif
#ifndef SKEW_P45
#define SKEW_P45 0
#endif
__device__ __forceinline__ void phase_skew(int vcu, unsigned ticks) {
    if (ticks) { const unsigned long long t0 = __builtin_amdgcn_s_memrealtime(), d = (unsigned long long)(vcu & 7) * ticks;
        while (__builtin_amdgcn_s_memrealtime() - t0 < d) __builtin_amdgcn_s_sleep(8); }
}
__device__ __forceinline__ int fresh_tid() { int t = threadIdx.x; asm volatile("" : "+v"(t)); return t; }
#define PHASE_IDS() do { F.tid = fresh_tid(); F.lane = F.tid & 63; F.wave = __builtin_amdgcn_readfirstlane(F.tid >> 6); } while (0)

__device__ __forceinline__ void transpose_item(const float* W, int ldw, int k0, int n0, bf16_t* WT, size_t row_off, int Kd, LAS float* scr, int lane) {
    const int qr_ = lane >> 4, j4 = 4 * (lane & 15);
#pragma unroll 8
    for (int i = 0; i < 16; ++i) { const int kk = 4 * i + qr_; const f32x4 v = *(const f32x4*)(W + (size_t)(k0 + kk) * ldw + n0 + j4); LAS float* d = scr + kk * 65 + j4; d[0] = v.x; d[1] = v.y; d[2] = v.z; d[3] = v.w; }
    LDS_WAIT(); asm volatile("" ::: "memory");
    const int c = lane & 7;
#pragma unroll
    for (int j = 0; j < 8; ++j) { const int n = (lane >> 3) + 8 * j; const LAS float* s = scr + (8 * c) * 65 + n;
        u32x4 o; o.x = cvt_pk_bf16(s[0 * 65], s[1 * 65]); o.y = cvt_pk_bf16(s[2 * 65], s[3 * 65]); o.z = cvt_pk_bf16(s[4 * 65], s[5 * 65]); o.w = cvt_pk_bf16(s[6 * 65], s[7 * 65]);
        *(u32x4*)(WT + (row_off + n0 + n) * (size_t)Kd + k0 + 8 * c) = o; }
    LDS_WAIT(); asm volatile("" ::: "memory");
}

__global__ void __launch_bounds__(NWAVES * 64, 2) hybrid_fwd(Args args) {
    extern __shared__ __attribute__((aligned(16))) unsigned char lds_raw[];
    Frame F;
    F.lds = (LAS unsigned char*)lds_raw;
    F.MISC = (volatile LAS unsigned*)(F.lds + MISC_OFF);
    F.tid = threadIdx.x; F.lane = F.tid & 63; F.wave = __builtin_amdgcn_readfirstlane(F.tid >> 6);
    F.G = gridDim.x; { const int bx = blockIdx.x; F.vcu = (F.G % 8 == 0) ? (bx % 8) * (F.G / 8) + bx / 8 : bx; }
    unsigned char* ws = args.ws;
    F.ctl = (gu32*)(ws + WS_CTL);
    const float* x = args.in[0]; const float* cvec = args.in[1]; const float* ada_w = args.in[2]; const float* ada_b = args.in[3];
    const float* norm1_g = args.in[4]; const float* norm2_g = args.in[5]; const float* w_in = args.in[6]; const float* gmlp_ln_g = args.in[7]; const float* gmlp_ln_b = args.in[8];
    const float* w_spatial = args.in[9]; const float* b_spatial = args.in[10]; const float* w_branch_a = args.in[11]; const float* w_branch_b = args.in[12]; const float* w_out = args.in[13];
    const float* w_rg = args.in[14]; const float* b_rg = args.in[15]; const float* w_re = args.in[16]; const float* b_re = args.in[17];
    const float* w_gate = args.in[18]; const float* w_up = args.in[19]; const float* w_down = args.in[20]; const float* final_g = args.in[21];
    float* out = args.out;
    float* KSUM = (float*)(ws + WS_KSUM); float* MODP = (float*)(ws + WS_MODP); float* MOD = (float*)(ws + WS_MOD); float* ROPE = (float*)(ws + WS_ROPE);
    bf16_t* WST = (bf16_t*)(ws + WS_WST); bf16_t* WRT = (bf16_t*)(ws + WS_WRT); float* SSQ = (float*)(ws + WS_SSQ);
    unsigned long long* ROUTE = (unsigned long long*)(ws + WS_ROUTE);
    bf16_t* WIN = (bf16_t*)(ws + WS_WIN); bf16_t* WAB = (bf16_t*)(ws + WS_WAB); bf16_t* WOUT = (bf16_t*)(ws + WS_WOUT);
    bf16_t* WGU = (bf16_t*)(ws + WS_WGU); bf16_t* WD = (bf16_t*)(ws + WS_WD);
    bf16_t* XN = (bf16_t*)(ws + WS_XN); bf16_t* PROJ = (bf16_t*)(ws + WS_PROJ); bf16_t* HID = (bf16_t*)(ws + WS_HID); bf16_t* YB = (bf16_t*)(ws + WS_Y); bf16_t* X1 = (bf16_t*)(ws + WS_X1);
    bf16_t* PO = (bf16_t*)(ws + WS_PO); float* PML = (float*)(ws + WS_PML); unsigned short* LIST = (unsigned short*)(ws + WS_LIST); unsigned* CNT = (unsigned*)(F.ctl + CW_CNT);

    for (int u = F.tid; u < 256; u += NWAVES * 64) ((LAS unsigned*)(F.lds + MISC_OFF))[u] = 0u;
    __syncthreads();
    XcdBarrier bar; bar.bar = (unsigned*)(F.ctl + CW_BAR) + args.li * XCD_BAR_WORDS; bar.x = 0; bar.st = nullptr;
    if (!MK_PER_PHASE) bar = xcd_barrier_post((unsigned*)(F.ctl + CW_BAR) + args.li * XCD_BAR_WORDS, F.MISC + 8);
    const int lo = args.ph_lo, hi = args.ph_hi;
#define IN(k) (lo <= (k) && (k) < hi)
#define PH_SET(k) do { if (TSEL != 0 && blockIdx.x == TBLK && threadIdx.x == 0) g_tphase = (k); } while (0)
    if (TSEL != 0 && blockIdx.x == TBLK && threadIdx.x == 0) { g_tacc = 0; g_tphase = -2; }
#define SEAM(k) do { if (IN(k) && IN((k) + 1)) xcd_barrier(bar); } while (0)

    PH_SET(0); TP_BEGIN(0, tp0_) if (IN(0)) { PHASE_IDS();
        const int gw = F.vcu * NWAVES + F.wave, NGW = F.G * NWAVES;
        const int gtid = F.vcu * (NWAVES * 64) + F.tid, NGT = F.G * NWAVES * 64;
        LAS float* scr = (LAS float*)(F.lds + F.wave * 16640);
        constexpr int I_MOD = 16 * 24, I_IN = 16 * 72, I_A = 8 * 16, I_O = 16 * 16;
        constexpr int NITEMS = I_MOD + I_IN + 2 * I_A + I_O;
        for (int it = gw; it < NITEMS; it += NGW) {
            int r = it;
            if (r < I_MOD) {
                const int s = r / 24, nc = r % 24, n = nc * 256 + 4 * F.lane;
                f32x4 a0 = {0.f, 0.f, 0.f, 0.f}, a1 = a0, a2 = a0, a3 = a0;
#pragma unroll 8
                for (int kk = 0; kk < 64; ++kk) { const int k = 64 * s + kk; const f32x4 w = *(const f32x4*)(ada_w + (size_t)k * 6144 + n);
                    a0 += w * cvec[k]; a1 += w * cvec[1024 + k]; a2 += w * cvec[2048 + k]; a3 += w * cvec[3072 + k]; }
                float* dst = MODP + (size_t)s * 24576 + n;
                *(f32x4*)(dst) = a0; *(f32x4*)(dst + 6144) = a1; *(f32x4*)(dst + 12288) = a2; *(f32x4*)(dst + 18432) = a3;
                continue; }
            r -= I_MOD;
            if (r < I_IN) { transpose_item(w_in, PC, 64 * (r / 72), 64 * (r % 72), WIN, 0, 1024, scr, F.lane); continue; } r -= I_IN;
            if (r < I_A) { transpose_item(w_branch_a, 1024, 64 * (r / 16), 64 * (r % 16), WAB, 0, 1024, scr, F.lane); continue; } r -= I_A;
            if (r < I_A) { transpose_item(w_branch_b, 1024, 64 * (r / 16), 64 * (r % 16), WAB + 512, 0, 1024, scr, F.lane); continue; } r -= I_A;
            transpose_item(w_out, 1024, 64 * (r / 16), 64 * (r % 16), WOUT, 0, 1024, scr, F.lane);
        }
        for (int i = gtid; i < 65536; i += NGT) {
            const int pos = i >> 3, j = i & 7; const float inv = powf(500000.0f, -(float)j * 2.0f / 16.0f); const float ang = (float)pos * inv;
            ROPE[i] = cosf(ang); ROPE[65536 + i] = sinf(ang); }
        for (int i = gtid; i < 65536; i += NGT) {
            const int s = i & 127, t_ = (i >> 7) & 127; const float v = (s <= t_) ? w_spatial[i] : 0.f; WST[i] = (bf16_t)(cvt_pk_bf16(v, 0.f) & 0xffffu); }
        for (int i = gtid; i < 48 * 1024; i += NGT) {
            const int j = i >> 10, k = i & 1023; float v = 0.f; if (j < 4) v = w_rg[k * 4 + j]; else if (j < 36) v = w_re[k * 32 + (j - 4)];
            const unsigned hb = cvt_pk_bf16(v, 0.f) & 0xffffu; const float lo = v - bflo(hb);
            WRT[i] = (bf16_t)hb; WRT[48 * 1024 + i] = (bf16_t)(cvt_pk_bf16(lo, 0.f) & 0xffffu); }
    }
    TP_END(0, tp0_); SEAM(0);

    PH_SET(1); TP_BEGIN(1, tp1_) if (IN(1)) { PHASE_IDS();
        const int c = F.vcu, b = c >> 6;
        LAS float* f = (LAS float*)F.lds;
        for (int v = F.tid; v < 2048; v += NWAVES * 64) { float s = ada_b[v];
#pragma unroll
            for (int sl = 0; sl < 16; ++sl) s += MODP[(size_t)sl * 24576 + b * 6144 + v];
            f[v] = s; }
        if (F.tid < 96) { const int idx = 96 * c + F.tid; float s = ada_b[idx % 6144];
#pragma unroll
            for (int sl = 0; sl < 16; ++sl) s += MODP[(size_t)sl * 24576 + idx];
            MOD[idx] = s; }
        __syncthreads();
        f32x4 A1[4], B1[4];
#pragma unroll
        for (int j = 0; j < 4; ++j) { const int k = 4 * F.lane + 256 * j; const f32x4 g = *(const f32x4*)(norm1_g + k);
#pragma unroll
            for (int i = 0; i < 4; ++i) { A1[j][i] = g[i] * (1.0f + f[1024 + k + i]); B1[j][i] = f[k + i]; } }
        for (int i0 = 0; i0 < 16; i0 += 4) {
            f32x4 v[4][4]; float ss[4];
#pragma unroll
            for (int u_ = 0; u_ < 4; ++u_) { const size_t row = (size_t)c * 128 + F.wave * 16 + i0 + u_; const f32x4* xr = (const f32x4*)(x + row * DM) + F.lane;
#pragma unroll
                for (int j = 0; j < 4; ++j) v[u_][j] = xr[64 * j]; }
#pragma unroll
            for (int u_ = 0; u_ < 4; ++u_) { float s = 0.f;
#pragma unroll
                for (int j = 0; j < 4; ++j) s += (v[u_][j].x * v[u_][j].x + v[u_][j].y * v[u_][j].y) + (v[u_][j].z * v[u_][j].z + v[u_][j].w * v[u_][j].w);
                ss[u_] = s; }
#pragma unroll
            for (int o_ = 1; o_ < 64; o_ <<= 1) {
#pragma unroll
                for (int u_ = 0; u_ < 4; ++u_) ss[u_] += __shfl_xor(ss[u_], o_); }
#pragma unroll
            for (int u_ = 0; u_ < 4; ++u_) { const size_t row = (size_t)c * 128 + F.wave * 16 + i0 + u_; const float rstd = 1.0f / sqrtf(ss[u_] * (1.0f / DM) + EPS);
                u32x2* o8 = (u32x2*)(XN + row * DM) + F.lane;
#pragma unroll
                for (int j = 0; j < 4; ++j) { const f32x4 hv = v[u_][j] * rstd * A1[j] + B1[j]; u32x2 w; w.x = cvt_pk_bf16(hv.x, hv.y); w.y = cvt_pk_bf16(hv.z, hv.w); o8[64 * j] = w; } } }
        __syncthreads();
    }
    TP_END(1, tp1_); SEAM(1);

    PH_SET(2); TP_BEGIN(2, tp2_) if (IN(2)) {
        pg8::DenseSched S; S.init(XN, DM, WIN, DM, T, PC, F.G, (int)blockIdx.x);
        pg8::EpiProj E{PROJ, ROPE, KSUM};
        phase_skew(F.vcu, SKEW_P2);
        pg8::gemm_phase<pg8::EpiProj, pg8::DenseSched, false>(F.lds, S, E);
    }
    TP_END(2, tp2_); SEAM(2);

    PH_SET(3); TP_BEGIN(3, tp3_) if (IN(3)) { PHASE_IDS();
        for (int chunk = F.vcu; chunk < ((args.flags & 2) ? 0 : T / 128); chunk += F.G) {
            const int lane = F.lane, w = F.wave, q = lane >> 4, l15 = lane & 15;
            const size_t row0 = (size_t)chunk * 128;
            float lg[8], lb[8];
            { const f32x4 g0 = *(const f32x4*)(gmlp_ln_g + 8 * lane), g1 = *(const f32x4*)(gmlp_ln_g + 8 * lane + 4), b0 = *(const f32x4*)(gmlp_ln_b + 8 * lane), b1 = *(const f32x4*)(gmlp_ln_b + 8 * lane + 4);
#pragma unroll
              for (int j = 0; j < 4; ++j) { lg[j] = g0[j]; lg[4 + j] = g1[j]; lb[j] = b0[j]; lb[4 + j] = b1[j]; } }
            u32x4 vn[16];
#pragma unroll
            for (int i = 0; i < 16; ++i) vn[i] = *(const u32x4*)(PROJ + (row0 + 16 * w + i) * PC + C_V + 8 * lane);
#pragma unroll
            for (int hb = 0; hb < 16; hb += 8) {
                float s1[8], s2[8];
#pragma unroll
                for (int i = 0; i < 8; ++i) { const u32x4 raw = vn[hb + i];
                    u32x4 gv; gv.x = cvt_pk_bf16(gelu_tanh(bflo(raw.x)), gelu_tanh(bfhi(raw.x))); gv.y = cvt_pk_bf16(gelu_tanh(bflo(raw.y)), gelu_tanh(bfhi(raw.y)));
                    gv.z = cvt_pk_bf16(gelu_tanh(bflo(raw.z)), gelu_tanh(bfhi(raw.z))); gv.w = cvt_pk_bf16(gelu_tanh(bflo(raw.w)), gelu_tanh(bfhi(raw.w)));
                    const float v0 = bflo(gv.x), v1 = bfhi(gv.x), v2 = bflo(gv.y), v3 = bfhi(gv.y), v4 = bflo(gv.z), v5 = bfhi(gv.z), v6 = bflo(gv.w), v7 = bfhi(gv.w);
                    s1[i] = ((v0 + v1) + (v2 + v3)) + ((v4 + v5) + (v6 + v7)); s2[i] = ((v0 * v0 + v1 * v1) + (v2 * v2 + v3 * v3)) + ((v4 * v4 + v5 * v5) + (v6 * v6 + v7 * v7));
                    vn[hb + i] = gv; }
#pragma unroll
                for (int o_ = 1; o_ < 64; o_ <<= 1) {
#pragma unroll
                    for (int i = 0; i < 8; ++i) { s1[i] += __shfl_xor(s1[i], o_); s2[i] += __shfl_xor(s2[i], o_); } }
#pragma unroll
                for (int i = 0; i < 8; ++i) { const float mean = s1[i] * (1.0f / 512.0f); const float var = fmaxf(s2[i] * (1.0f / 512.0f) - mean * mean, 0.f); const float rstd = 1.0f / sqrtf(var + EPS);
                    const u32x4 gv = vn[hb + i]; float v[8] = {bflo(gv.x), bfhi(gv.x), bflo(gv.y), bfhi(gv.y), bflo(gv.z), bfhi(gv.z), bflo(gv.w), bfhi(gv.w)};
#pragma unroll
                    for (int j = 0; j < 8; ++j) v[j] = (v[j] - mean) * rstd * lg[j] + lb[j];
                    vn[hb + i].x = cvt_pk_bf16(v[0], v[1]); vn[hb + i].y = cvt_pk_bf16(v[2], v[3]); vn[hb + i].z = cvt_pk_bf16(v[4], v[5]); vn[hb + i].w = cvt_pk_bf16(v[6], v[7]); }
            }
            const int tt = 16 * w + l15;
            u32x2 wfr[4][2]; u32x4 uq[4];
#define GM_LOAD(WF, UQ, g_) do { const bf16_t* wp_ = WST + ((size_t)((g_) * 128 + tt)) * 128 + 4 * q; \
                _Pragma("unroll") for (int ks = 0; ks < 4; ++ks) { WF[ks][0] = *(const u32x2*)(wp_ + 32 * ks); WF[ks][1] = *(const u32x2*)(wp_ + 32 * ks + 16); } \
                _Pragma("unroll") for (int i = 0; i < 4; ++i) UQ[i] = *(const u32x4*)(PROJ + (row0 + 16 * w + 4 * i + q) * PC + C_U + 128 * (g_) + 8 * l15); } while (0)
            GM_LOAD(wfr, uq, 0);
#pragma unroll
            for (int g = 0; g < 4; ++g) {
                __syncthreads();
                if (q == g) {
#pragma unroll
                    for (int i = 0; i < 16; ++i) *(LAS u32x4*)(F.lds + (16 * w + i) * 288 + l15 * 16) = vn[i];
                }
                __syncthreads();
                u32x2 wfn[4][2]; u32x4 uqn[4];
                if (g < 3) GM_LOAD(wfn, uqn, g + 1);
                f32x4 acc[8];
#pragma unroll
                for (int it = 0; it < 8; ++it) acc[it] = (f32x4){0.f, 0.f, 0.f, 0.f};
                const int nks = (16 * w + 16 + 31) / 32;
#pragma unroll
                for (int ks = 0; ks < 4; ++ks) { if (ks < nks) {
                    const bf16x8 bw = __builtin_bit_cast(bf16x8, (u32x4){wfr[ks][0].x, wfr[ks][0].y, wfr[ks][1].x, wfr[ks][1].y});
                    const attn_body::lds_cptr base = (attn_body::lds_cptr)F.lds + (32 * ks + 4 * q + (l15 >> 2)) * 288 + (l15 & 3) * 8;
#pragma unroll
                    for (int it = 0; it < 8; ++it) {
                        const s16x4 lo = attn_body::vtr(base + it * 32), hi_ = attn_body::vtr(base + 16 * 288 + it * 32);
                        const bf16x8 a = (bf16x8){lo[0], lo[1], lo[2], lo[3], hi_[0], hi_[1], hi_[2], hi_[3]};
                        acc[it] = __builtin_amdgcn_mfma_f32_16x16x32_bf16(a, bw, acc[it], 0, 0, 0);
                    } } }
                const float bs = b_spatial[g * 128 + tt];
                LAS unsigned char* svb = F.lds + 36864;
#pragma unroll
                for (int it = 0; it < 8; ++it) { u32x2 o; o.x = cvt_pk_bf16(acc[it][0] + bs, acc[it][1] + bs); o.y = cvt_pk_bf16(acc[it][2] + bs, acc[it][3] + bs);
                    *(LAS u32x2*)(svb + tt * 272 + (16 * it + 4 * q) * 2) = o; }
                LDS_WAIT(); asm volatile("" ::: "memory");
#pragma unroll
                for (int i = 0; i < 4; ++i) { const int tr_ = 16 * w + 4 * i + q; bf16_t* pp = PROJ + (row0 + tr_) * PC + C_U + 128 * g + 8 * l15;
                    const u32x4 uu = uq[i]; const u32x4 sv = *(const LAS u32x4*)(svb + tr_ * 272 + l15 * 16);
                    u32x4 o; o.x = cvt_pk_bf16(gelu_tanh(bflo(uu.x)) * bflo(sv.x), gelu_tanh(bfhi(uu.x)) * bfhi(sv.x)); o.y = cvt_pk_bf16(gelu_tanh(bflo(uu.y)) * bflo(sv.y), gelu_tanh(bfhi(uu.y)) * bfhi(sv.y));
                    o.z = cvt_pk_bf16(gelu_tanh(bflo(uu.z)) * bflo(sv.z), gelu_tanh(bfhi(uu.z)) * bfhi(sv.z)); o.w = cvt_pk_bf16(gelu_tanh(bflo(uu.w)) * bflo(sv.w), gelu_tanh(bfhi(uu.w)) * bfhi(sv.w));
                    *(u32x4*)pp = o; }
                LDS_WAIT(); asm volatile("" ::: "memory");
                if (g < 3) {
#pragma unroll
                    for (int ks = 0; ks < 4; ++ks) { wfr[ks][0] = wfn[ks][0]; wfr[ks][1] = wfn[ks][1]; }
#pragma unroll
                    for (int i = 0; i < 4; ++i) uq[i] = uqn[i]; }
            }
            __syncthreads();
        }
        {
            using namespace attn_body;
            const int s = F.vcu & 7, bh = F.vcu >> 3;
            const bf16* Qp = (const bf16*)(PROJ + C_Q); const bf16* Kp = (const bf16*)(PROJ + C_K); const bf16* Vp = (const bf16*)(PROJ + C_VV);
#define QBI(i) (((i) == 0) ? s : ((i) == 1) ? 15 - s : ((i) == 2) ? 16 + s : 31 - s)
            if (ATTN_MODE != 0) {
                if (bh < NB * 8 && !(args.flags & 4)) for (int i = 0; i < 4; ++i) select_unit(bh >> 3, bh & 7, QBI(i), Qp, KSUM, LIST, CNT, (char*)lds_raw + 40960);
                TP_END(3, tp3_);
                if (!MK_PER_PHASE) xcd_barrier(bar);
                PH_SET(31); TP_BEGIN(31, tp31_)
                unsigned long long tg0_ = 0; if (TSEL >= 5 && TSEL <= 7) tg0_ = __builtin_amdgcn_s_memrealtime();
                if (!(args.flags & 8)) gather_phase<8>((char*)lds_raw, Qp, Kp, Vp, LIST, CNT, PO, PML, F.vcu, F.G, (args.flags & 1) == 0);
                TP_END(31, tp31_);
                if (TSEL >= 5 && TSEL <= 7) { if (threadIdx.x == 0) __hip_atomic_store(&g_tw[F.vcu], (unsigned)(__builtin_amdgcn_s_memrealtime() - tg0_), __ATOMIC_RELAXED, __HIP_MEMORY_SCOPE_AGENT); }
                if (!MK_PER_PHASE) xcd_barrier(bar);
                if (TSEL == 5 || TSEL == 6) { if (blockIdx.x == TBLK && threadIdx.x == 0) { unsigned mx = 0, am = 0; for (int i = 0; i < 256; ++i) { const unsigned t_ = __hip_atomic_load(&g_tw[i], __ATOMIC_RELAXED, __HIP_MEMORY_SCOPE_AGENT); if (t_ > mx) { mx = t_; am = i; } }
                    g_tacc += (TSEL == 5) ? mx : am * 100u; } }
                if (TSEL == 7) { if (blockIdx.x == 0 && threadIdx.x == 0) g_tacc += __hip_atomic_load(&g_tw[TVCU], __ATOMIC_RELAXED, __HIP_MEMORY_SCOPE_AGENT); }
                PH_SET(32);
                bf16* Op = (bf16*)(PROJ + (ATTN_MODE == 2 ? C_V : C_Q));
                TP_BEGIN(32, tp32_)
                if (bh < NB * 8 && !(args.flags & 16)) for (int i = 0; i < 4; ++i) attn_unit<8, true>(bh >> 3, bh & 7, QBI(i), Qp, Kp, Vp, Op, KSUM, (char*)lds_raw, (args.flags & 1) == 0, PO, PML);
                TP_END(32, tp32_);
            }
            if (ATTN_MODE == 0) {
                if (bh < NB * 8) for (int i = 0; i < 4; ++i) attn_unit<8, false>(bh >> 3, bh & 7, QBI(i), Qp, Kp, Vp, (bf16*)(PROJ + C_Q), KSUM, (char*)lds_raw, (args.flags & 1) == 0, PO, PML);
            }
#undef QBI
#undef GM_LOAD
        }
        VM_WAIT(); __syncthreads();
    }
    SEAM(3);

    PH_SET(4); TP_BEGIN(4, tp4_) if (IN(4)) {
        pg8::DenseSched S; S.init(PROJ + C_U, PC, WAB, 1024, T, DM, F.G, (int)blockIdx.x); S.ksplit = 8; S.kgap = (unsigned)(C_Q - C_U - 512) * 2u;
        pg8::EpiMergeF E{PROJ, XN};
        phase_skew(F.vcu, SKEW_P45);
        pg8::gemm_phase<pg8::EpiMergeF, pg8::DenseSched, false>(F.lds, S, E);
    }
    TP_END(4, tp4_); SEAM(4);

    PH_SET(5); TP_BEGIN(5, tp5_) if (IN(5)) {
        pg8::DenseSched S; S.init(XN, DM, WOUT, DM, T, DM, F.G, (int)blockIdx.x); pg8::EpiOut E{x, X1, MOD, SSQ};
        phase_skew(F.vcu, SKEW_P45);
        pg8::gemm_phase<pg8::EpiOut, pg8::DenseSched, false>(F.lds, S, E);
    }
    TP_END(5, tp5_); SEAM(5);

    PH_SET(6); TP_BEGIN(6, tp6_) if (IN(6)) { PHASE_IDS();
        {
            LAS float* scr = (LAS float*)(F.lds + F.wave * 16640);
            const int gw = F.vcu * NWAVES + F.wave, NGW = F.G * NWAVES;
            constexpr int I_G = 32 * 16 * 8, I_D = 32 * 8 * 16;
            for (int it = gw; it < 2 * I_G + I_D; it += NGW) { int r = it;
                if (r < 2 * I_G) { const bool up = r >= I_G; if (up) r -= I_G; const int e = r / 128, kb = (r % 128) / 8, nb = r % 8, n0 = 64 * nb;
                    const size_t row_off = (size_t)e * 1024 + (size_t)(n0 / 128) * 256 + (up ? 128 : 0) + (n0 % 128) - n0;
                    transpose_item((up ? w_up : w_gate) + (size_t)e * 1024 * 512, 512, 64 * kb, n0, WGU, row_off, 1024, scr, F.lane); continue; }
                r -= 2 * I_G;
                { const int e = r / 128, kb = (r % 128) / 16, nb = r % 16; transpose_item(w_down + (size_t)e * 512 * 1024, 1024, 64 * kb, 64 * nb, WD, (size_t)e * 1024, 512, scr, F.lane); } }
            __syncthreads();
        }
        TP_END(6, tp6_);
        TP_BEGIN(61, tp61_)
        const int c = F.vcu, b = c >> 6, lane = F.lane, w = F.wave, r = lane & 15, q = lane >> 4;
        constexpr int WPITCH = 1056, WPLANE = 48 * WPITCH, WL_OFF = 8192, LG_OFF = WL_OFF + 2 * WPLANE, HI_OFF = LG_OFF + 8 * 3072;
        static_assert(HI_OFF + 512 <= MISC_OFF, "P6 LDS map");
        LAS float* A2 = (LAS float*)F.lds; LAS float* B2 = A2 + 1024; LAS float* LG = (LAS float*)(F.lds + LG_OFF) + w * 768;
        LAS unsigned* hist = (LAS unsigned*)(F.lds + HI_OFF); LAS unsigned* basev = hist + 32;
        for (int k = F.tid; k < 1024; k += NWAVES * 64) { A2[k] = norm2_g[k] * (1.0f + MOD[b * 6144 + 4096 + k]); B2[k] = MOD[b * 6144 + 3072 + k]; }
        if (F.tid < 32) hist[F.tid] = 0u;
        const size_t row = (size_t)c * 128 + w * 16 + r;
        float rs;
        { const f32x4* sp = (const f32x4*)(SSQ + row * 16); const f32x4 s0 = sp[0], s1 = sp[1], s2 = sp[2], s3 = sp[3];
          const float ss = ((s0[0] + s0[1]) + (s0[2] + s0[3])) + ((s1[0] + s1[1]) + (s1[2] + s1[3])) + ((s2[0] + s2[1]) + (s2[2] + s2[3])) + ((s3[0] + s3[1]) + (s3[2] + s3[3]));
          rs = 1.0f / sqrtf(ss * (1.0f / DM) + EPS); }
        f32x4 acc[3];
#pragma unroll
        for (int jt = 0; jt < 3; ++jt) acc[jt] = (f32x4){0.f, 0.f, 0.f, 0.f};
        const bf16_t* xrow = X1 + row * DM;
        for (int hf = 0; hf < 2; ++hf) {
            __syncthreads();
#pragma unroll
            for (int ps = 0; ps < 12; ++ps) { const int idx = ps * 512 + F.tid, rw = idx >> 6, c16 = idx & 63;
                const u32x4 v = *(const u32x4*)(WRT + (size_t)rw * 1024 + hf * 512 + c16 * 8);
                *(LAS u32x4*)(F.lds + WL_OFF + (rw / 48) * WPLANE + (rw % 48) * WPITCH + c16 * 16) = v; }
            __syncthreads();
#pragma unroll 4
            for (int s_ = 0; s_ < 16; ++s_) { const int k0 = 512 * hf + 32 * s_ + 8 * q;
                const u32x4 xr = *(const u32x4*)(xrow + k0);
                const f32x4 x0 = {bflo(xr.x), bfhi(xr.x), bflo(xr.y), bfhi(xr.y)}, x1v = {bflo(xr.z), bfhi(xr.z), bflo(xr.w), bfhi(xr.w)};
                const f32x4 a0 = *(const LAS f32x4*)(A2 + k0), a1 = *(const LAS f32x4*)(A2 + k0 + 4), b0 = *(const LAS f32x4*)(B2 + k0), b1 = *(const LAS f32x4*)(B2 + k0 + 4);
                const f32x4 h0 = x0 * rs * a0 + b0, h1 = x1v * rs * a1 + b1;
                u32x4 hw; hw.x = cvt_pk_bf16(h0[0], h0[1]); hw.y = cvt_pk_bf16(h0[2], h0[3]); hw.z = cvt_pk_bf16(h1[0], h1[1]); hw.w = cvt_pk_bf16(h1[2], h1[3]);
                *(u32x4*)(XN + row * DM + k0) = hw;
                u32x4 lw; lw.x = cvt_pk_bf16(h0[0] - bflo(hw.x), h0[1] - bfhi(hw.x)); lw.y = cvt_pk_bf16(h0[2] - bflo(hw.y), h0[3] - bfhi(hw.y));
                lw.z = cvt_pk_bf16(h1[0] - bflo(hw.z), h1[1] - bfhi(hw.z)); lw.w = cvt_pk_bf16(h1[2] - bflo(hw.w), h1[3] - bfhi(hw.w));
                const bf16x8 hb = __builtin_bit_cast(bf16x8, hw), hl = __builtin_bit_cast(bf16x8, lw);
#pragma unroll
                for (int jt = 0; jt < 3; ++jt) { const LAS unsigned char* wp = F.lds + WL_OFF + (16 * jt + r) * WPITCH + (32 * s_ + 8 * q) * 2;
                    const bf16x8 wf = *(const LAS bf16x8*)wp, wl = *(const LAS bf16x8*)(wp + WPLANE);
                    acc[jt] = __builtin_amdgcn_mfma_f32_16x16x32_bf16(wf, hb, acc[jt], 0, 0, 0);
                    acc[jt] = __builtin_amdgcn_mfma_f32_16x16x32_bf16(wf, hl, acc[jt], 0, 0, 0);
                    acc[jt] = __builtin_amdgcn_mfma_f32_16x16x32_bf16(wl, hb, acc[jt], 0, 0, 0); } }
        }
#pragma unroll
        for (int jt = 0; jt < 3; ++jt) *(LAS f32x4*)(LG + r * 48 + 16 * jt + 4 * q) = acc[jt];
        LDS_WAIT(); asm volatile("" ::: "memory");
        int E0 = 0, E1 = 0; float w0 = 0.f, w1 = 0.f; unsigned lp0 = 0u, lp1 = 0u;
        if (lane < 16) {
            const LAS float* lgp = LG + lane * 48;
            float gl[4];
#pragma unroll
            for (int j = 0; j < 4; ++j) gl[j] = lgp[j] + b_rg[j];
            int g = 0; float gm = gl[0];
#pragma unroll
            for (int j = 1; j < 4; ++j) if (gl[j] > gm) { gm = gl[j]; g = j; }
            float gs = 0.f;
#pragma unroll
            for (int j = 0; j < 4; ++j) gs += __expf(gl[j] - gm);
            const float gp = 1.0f / gs;
            float m0 = -INFINITY, m1 = -INFINITY; int i0 = 0, i1 = 0;
#pragma unroll
            for (int j = 0; j < 8; ++j) { const float el = lgp[4 + 8 * g + j] + b_re[g * 8 + j];
                if (el > m0) { m1 = m0; i1 = i0; m0 = el; i0 = j; } else if (el > m1) { m1 = el; i1 = j; } }
            const float d = __expf(m1 - m0), inv = 1.0f / (1.0f + d);
            w0 = gp * inv; w1 = gp * d * inv; E0 = 8 * g + i0; E1 = 8 * g + i1;
            lp0 = __hip_atomic_fetch_add(hist + E0, 1u, __ATOMIC_RELAXED, __HIP_MEMORY_SCOPE_WORKGROUP);
            lp1 = __hip_atomic_fetch_add(hist + E1, 1u, __ATOMIC_RELAXED, __HIP_MEMORY_SCOPE_WORKGROUP);
        }
        __syncthreads();
        if (F.tid < 32) { const unsigned n = hist[F.tid]; basev[F.tid] = n ? __hip_atomic_fetch_add((unsigned*)(F.ctl + CW_CURSOR + 64 * F.tid), n, RLX_AGENT) : 0u; }
        __syncthreads();
        if (lane < 16) { const unsigned tok = (unsigned)(c * 128 + w * 16 + lane);
            ROUTE[(size_t)E0 * 32768 + basev[E0] + lp0] = ((unsigned long long)__float_as_uint(w0) << 32) | (unsigned long long)(2u * tok);
            ROUTE[(size_t)E1 * 32768 + basev[E1] + lp1] = ((unsigned long long)__float_as_uint(w1) << 32) | (unsigned long long)(2u * tok + 1u); }
        __syncthreads();
        TP_END(61, tp61_);
    }
    SEAM(6);

    PH_SET(7); TP_BEGIN(7, tp7_) if (IN(7) || IN(8)) { PHASE_IDS();
        volatile LAS int* tab = (volatile LAS int*)(F.lds + MISC_OFF + 256);
        if (F.tid < 32) tab[F.tid] = (int)__hip_atomic_load((unsigned*)(F.ctl + CW_CURSOR + 64 * F.tid), RLX_AGENT);
        __syncthreads();
        if (F.tid == 0) { int o = 0; for (int e = 0; e < 32; ++e) { tab[32 + e] = o; o += (tab[e] + 255) >> 8; } tab[64] = o; }
        __syncthreads();
        const int U = 4 * __builtin_amdgcn_readfirstlane(tab[64]);
        const int xq = F.vcu >> 5, jj = F.vcu & 31;
        pg8::MoeSched S; S.tab = tab; S.start = (int)(((long)U * xq) / 8); S.end = (int)(((long)U * (xq + 1)) / 8); S.j = jj; S.route = ROUTE; S.ready = (unsigned*)(F.ctl + CW_READY);
        if (IN(7)) {
            S.A = (const char*)XN; S.lda = DM; S.K = DM; S.Bt = (const char*)WGU; S.bstride = (size_t)1024 * 1024 * 2; S.gather = true; S.mode = 1;
            pg8::EpiGU E{HID};
            pg8::gemm_phase<pg8::EpiGU, pg8::MoeSched, true>(F.lds, S, E);
        }
        TP_END(7, tp7_);
        PH_SET(8); TP_BEGIN(8, tp8_) if (IN(8)) {
            S.A = (const char*)HID; S.lda = DEXP; S.K = DEXP; S.Bt = (const char*)WD; S.bstride = (size_t)1024 * 512 * 2; S.gather = false; S.mode = 2; S.j = (jj + 24) & 31; S.qhead = (unsigned*)(F.ctl + CW_QHEAD + 64 * xq); S.qslot = (volatile LAS int*)(F.lds + MISC_OFF + 640);
            pg8::EpiDown E{YB, ROUTE};
            pg8::gemm_phase<pg8::EpiDown, pg8::MoeSched, false>(F.lds, S, E);
        }
        TP_END(8, tp8_);
    }
    SEAM(8);

    PH_SET(9); TP_BEGIN(9, tp9_) if (IN(9)) { PHASE_IDS();
        const int c = F.vcu, b = c >> 6;
        f32x4 G2[4], FG[4];
#pragma unroll
        for (int j = 0; j < 4; ++j) { const int k = 4 * F.lane + 256 * j; G2[j] = *(const f32x4*)(MOD + b * 6144 + 5120 + k); FG[j] = *(const f32x4*)(final_g + k); }
        for (int i0 = 0; i0 < 16; i0 += 4) {
            u32x2 ya[4][4], yb[4][4], xx[4][4]; f32x4 v[4][4]; float ss[4];
#pragma unroll
            for (int u_ = 0; u_ < 4; ++u_) { const size_t row = (size_t)c * 128 + F.wave * 16 + i0 + u_;
                const u32x2* xb = (const u32x2*)(X1 + row * DM) + F.lane; const u32x2* y0 = (const u32x2*)(YB + (2 * row) * DM) + F.lane; const u32x2* y1 = (const u32x2*)(YB + (2 * row + 1) * DM) + F.lane;
#pragma unroll
                for (int j = 0; j < 4; ++j) { ya[u_][j] = y0[64 * j]; yb[u_][j] = y1[64 * j]; xx[u_][j] = xb[64 * j]; } }
#pragma unroll
            for (int u_ = 0; u_ < 4; ++u_) { float s = 0.f;
#pragma unroll
                for (int j = 0; j < 4; ++j) { const u32x2 a = ya[u_][j], bb = yb[u_][j], x_ = xx[u_][j]; const f32x4 ys = {bflo(a.x) + bflo(bb.x), bfhi(a.x) + bfhi(bb.x), bflo(a.y) + bflo(bb.y), bfhi(a.y) + bfhi(bb.y)};
                    const f32x4 xv = {bflo(x_.x), bfhi(x_.x), bflo(x_.y), bfhi(x_.y)};
                    v[u_][j] = xv + G2[j] * ys; s += (v[u_][j].x * v[u_][j].x + v[u_][j].y * v[u_][j].y) + (v[u_][j].z * v[u_][j].z + v[u_][j].w * v[u_][j].w); }
                ss[u_] = s; }
#pragma unroll
            for (int o_ = 1; o_ < 64; o_ <<= 1) {
#pragma unroll
                for (int u_ = 0; u_ < 4; ++u_) ss[u_] += __shfl_xor(ss[u_], o_); }
#pragma unroll
            for (int u_ = 0; u_ < 4; ++u_) { const size_t row = (size_t)c * 128 + F.wave * 16 + i0 + u_; f32x4* xr = (f32x4*)(out + row * DM) + F.lane;
                const float rstd = 1.0f / sqrtf(ss[u_] * (1.0f / DM) + EPS);
#pragma unroll
                for (int j = 0; j < 4; ++j) xr[64 * j] = v[u_][j] * rstd * FG[j]; } }
    }
    TP_END(9, tp9_);
    if (TSEL >= 10 && TSEL <= 12 && blockIdx.x == TBLK && threadIdx.x == 0) { unsigned mx = 0, am = 0; unsigned long long sm = 0;
        for (int i = 0; i < 256; ++i) { const unsigned t_ = __hip_atomic_load(&g_tw[i], __ATOMIC_RELAXED, __HIP_MEMORY_SCOPE_AGENT); sm += t_; if (t_ > mx) { mx = t_; am = i; } }
        g_tacc += (TSEL == 10) ? mx : (TSEL == 11) ? am * 100u : (unsigned)(sm / 256); }
    if (TSEL != 0 && blockIdx.x == TBLK && threadIdx.x == 0) { const unsigned long long t0 = __builtin_amdgcn_s_memrealtime(), d = g_tacc * TMULT; while (__builtin_amdgcn_s_memrealtime() - t0 < d) __builtin_amdgcn_s_sleep(16); }
#undef IN
#undef SEAM
}


#if ATTN_MODE == 2
__global__ void __launch_bounds__(NWAVES * 64, 2) dbg_dense(Args args, int stage) {
    extern __shared__ __attribute__((aligned(16))) unsigned char lds_raw[];
    using namespace attn_body;
    unsigned char* ws = args.ws; bf16_t* PROJ = (bf16_t*)(ws + WS_PROJ); float* KSUM = (float*)(ws + WS_KSUM); gu32* ctl = (gu32*)(ws + WS_CTL);
    const int G = gridDim.x, bx = blockIdx.x, vcu = (bx % 8) * (G / 8) + bx / 8, tid = threadIdx.x, lane = tid & 63, wave = tid >> 6;
    if (stage == 0) {
        const int s = vcu & 7, bh = vcu >> 3;
        for (int i = 0; i < 4; ++i) { const int qb = (i == 0) ? s : (i == 1) ? 15 - s : (i == 2) ? 16 + s : 31 - s;
            attn_unit<8, false>(bh >> 3, bh & 7, qb, (const bf16*)(PROJ + C_Q), (const bf16*)(PROJ + C_K), (const bf16*)(PROJ + C_VV), (bf16*)(PROJ + C_Q), KSUM, (char*)lds_raw, true, nullptr, nullptr); }
    } else {
        float md = 0.f;
        for (int i = 0; i < 16; ++i) { const size_t row = (size_t)vcu * 128 + wave * 16 + i;
            const u32x4 a = *(const u32x4*)(PROJ + row * PC + C_V + 8 * lane), bq = *(const u32x4*)(PROJ + row * PC + C_Q + 8 * lane);
            md = fmaxf(md, fmaxf(fmaxf(fabsf(bflo(a.x) - bflo(bq.x)), fabsf(bfhi(a.x) - bfhi(bq.x))), fmaxf(fabsf(bflo(a.y) - bflo(bq.y)), fabsf(bfhi(a.y) - bfhi(bq.y)))));
            md = fmaxf(md, fmaxf(fmaxf(fabsf(bflo(a.z) - bflo(bq.z)), fabsf(bfhi(a.z) - bfhi(bq.z))), fmaxf(fabsf(bflo(a.w) - bflo(bq.w)), fabsf(bfhi(a.w) - bfhi(bq.w))))); }
#pragma unroll
        for (int o_ = 1; o_ < 64; o_ <<= 1) md = fmaxf(md, __shfl_xor(md, o_));
        if (lane == 0) atomicMax((unsigned*)(ctl + CW_DIFF), __float_as_uint(md));
    }
}
#endif
extern "C" void kernel_launch(void* const* d_in, const int* in_sizes, int n_in, void* d_out, int out_size, void* d_ws, size_t ws_size, hipStream_t stream) {
    static int grid = 0;
    if (grid == 0) {
        if (n_in != 22 || in_sizes[0] != T * DM || out_size != T * DM || ws_size < WS_END) { fprintf(stderr, "kernel_launch: unexpected shapes (n_in %d, in0 %d, out %d, ws %zu); nothing launched\n", n_in, n_in > 0 ? in_sizes[0] : -1, out_size, ws_size); grid = -1; return; }
        int dev = 0, cus = 0, per_cu = 0;
        if (hipGetDevice(&dev) != hipSuccess || hipDeviceGetAttribute(&cus, hipDeviceAttributeMultiprocessorCount, dev) != hipSuccess) { fprintf(stderr, "kernel_launch: device query failed\n"); grid = -1; return; }
        if (hipFuncSetAttribute((const void*)hybrid_fwd, hipFuncAttributeMaxDynamicSharedMemorySize, LDS_BYTES) != hipSuccess) { fprintf(stderr, "kernel_launch: hipFuncSetAttribute failed\n"); grid = -1; return; }
        if (hipOccupancyMaxActiveBlocksPerMultiprocessor(&per_cu, (const void*)hybrid_fwd, NWAVES * 64, LDS_BYTES) != hipSuccess || per_cu < 1) { fprintf(stderr, "kernel_launch: occupancy query reports %d blocks per CU\n", per_cu); }
        (void)hipGetLastError();
        if (cus != 256) { fprintf(stderr, "kernel_launch: built for 256 CUs, device has %d; nothing launched\n", cus); grid = -1; return; }
        grid = cus;
    }
    if (grid < 0) return;
    (void)hipMemsetAsync((char*)d_ws + WS_CTL, 0, CTL_ZERO_BYTES, stream);
    Args a{};
    for (int i = 0; i < 22; ++i) a.in[i] = (const float*)d_in[i];
    a.out = (float*)d_out; a.ws = (unsigned char*)d_ws;
    struct Spec { int lo, hi, flags; };
#if MK_PER_PHASE
    const Spec specs[10] = {{0,1,0},{1,2,0},{2,3,0},{3,4,0},{4,5,0},{5,6,0},{6,7,0},{7,8,0},{8,9,0},{9,10,0}}; const int nspec = 10;
#elif PROBE_ID == 1
    const Spec specs[2] = {{0,10,0},{0,2,0}}; const int nspec = 2;
#elif PROBE_ID == 2
    const Spec specs[2] = {{0,10,0},{2,3,0}}; const int nspec = 2;
#elif PROBE_ID == 3
    const Spec specs[3] = {{0,4,0},{3,4,1|2|4|16},{4,10,0}}; const int nspec = 3;
#elif PROBE_ID == 10
    const Spec specs[3] = {{0,4,0},{3,4,1|2|4|8},{4,10,0}}; const int nspec = 3;
#elif PROBE_ID == 11
    const Spec specs[3] = {{0,4,0},{3,4,1|2|8|16},{4,10,0}}; const int nspec = 3;
#elif PROBE_ID == 12
    const Spec specs[3] = {{0,4,0},{3,4,1|2|4|8|16},{4,10,0}}; const int nspec = 3;
#elif PROBE_ID == 13
    const Spec specs[2] = {{0,10,0},{3,4,1|4|8|16}}; const int nspec = 2;
#elif PROBE_ID == 4
    const Spec specs[3] = {{0,4,0},{4,5,0},{4,10,0}}; const int nspec = 3;
#elif PROBE_ID == 5
    const Spec specs[3] = {{0,5,0},{5,6,0},{5,10,0}}; const int nspec = 3;
#elif PROBE_ID == 6
    const Spec specs[2] = {{0,10,0},{7,8,0}}; const int nspec = 2;
#elif PROBE_ID == 7
    const Spec specs[2] = {{0,10,0},{8,9,0}}; const int nspec = 2;
#elif PROBE_ID == 14
    const Spec specs[2] = {{0,10,0},{7,9,0}}; const int nspec = 2;
#elif PROBE_ID == 15
    const Spec specs[2] = {{0,10,0},{9,10,0}}; const int nspec = 2;
#elif PROBE_ID == 16
    const Spec specs[2] = {{0,10,0},{6,7,0}}; const int nspec = 2;
#elif PROBE_ID == 8
    const Spec specs[2] = {{0,5,0},{5,10,0}}; const int nspec = 2;
#elif PROBE_ID == 9
    const Spec specs[2] = {{0,10,0},{0,1,0}}; const int nspec = 2;
#else
    const Spec specs[1] = {{0,10,0}}; const int nspec = 1;
#endif
#if ATTN_MODE == 2
    (void)hipFuncSetAttribute((const void*)dbg_dense, hipFuncAttributeMaxDynamicSharedMemorySize, LDS_BYTES);
    a.ph_lo = 0; a.ph_hi = 4; a.flags = 0; a.li = 0; hipLaunchKernelGGL(hybrid_fwd, dim3(grid), dim3(NWAVES * 64), LDS_BYTES, stream, a);
    hipLaunchKernelGGL(dbg_dense, dim3(grid), dim3(NWAVES * 64), LDS_BYTES, stream, a, 0);
    hipLaunchKernelGGL(dbg_dense, dim3(grid), dim3(NWAVES * 64), LDS_BYTES, stream, a, 1);
    a.ph_lo = 4; a.ph_hi = 10; a.li = 1; hipLaunchKernelGGL(hybrid_fwd, dim3(grid), dim3(NWAVES * 64), LDS_BYTES, stream, a);
    (void)nspec; (void)specs;
#else
    for (int li = 0; li < nspec; ++li) { a.ph_lo = specs[li].lo; a.ph_hi = specs[li].hi; a.flags = specs[li].flags; a.li = MK_PER_PHASE ? 0 : li;
        hipLaunchKernelGGL(hybrid_fwd, dim3(grid), dim3(NWAVES * 64), LDS_BYTES, stream, a); }
#endif
    const hipError_t le = hipPeekAtLastError();
    if (le != hipSuccess) fprintf(stderr, "kernel_launch: launch failed: %s\n", hipGetErrorName(le));
}
```

```cpp
#include <hip/hip_runtime.h>
#include <hip/hip_bf16.h>
#include <cstdio>
#include <cstdint>
#include <cmath>

#ifndef PROBE_ID
#define PROBE_ID 0
#endif
#ifndef ATTN_MODE
#define ATTN_MODE 1
#endif
#ifndef GPROBE
#define GPROBE 0
#endif
#ifndef TSEL
#define TSEL 0
#endif
#ifndef TPH
#define TPH -1
#endif
#ifndef TBLK
#define TBLK 0
#endif
#ifndef TVCU
#define TVCU 255
#endif
#define TMULT 8
#ifndef PADN
#define PADN 6
#endif
#define CODE_PAD() do { _Pragma("unroll") for (int p_ = 0; p_ < PADN; ++p_) asm volatile("s_nop 0"); } while (0)
__device__ unsigned long long g_tacc; __device__ int g_tphase; __device__ unsigned g_tw[256];
#define T_ON(k) (TSEL == (k) && blockIdx.x == TBLK && threadIdx.x == 0 && (TPH < 0 || g_tphase == TPH))
#define T_BEGIN(k, var) unsigned long long var = 0; if (TSEL == (k)) { if (T_ON(k)) var = __builtin_amdgcn_s_memrealtime(); }
#define T_END(k, var) do { if (TSEL == (k)) { if (T_ON(k)) g_tacc += __builtin_amdgcn_s_memrealtime() - var; } } while (0)
#define TP_BEGIN(ph, var) unsigned long long var = 0; if (TSEL == 4 && TPH == (ph)) { if (blockIdx.x == TBLK && threadIdx.x == 0) var = __builtin_amdgcn_s_memrealtime(); } \
        if (TSEL >= 10 && TSEL <= 12 && TPH == (ph)) { if (threadIdx.x == 0) var = __builtin_amdgcn_s_memrealtime(); }
#define TP_END(ph, var) do { if (TSEL == 4 && TPH == (ph)) { if (blockIdx.x == TBLK && threadIdx.x == 0) g_tacc += __builtin_amdgcn_s_memrealtime() - var; } \
        if (TSEL >= 10 && TSEL <= 12 && TPH == (ph)) { if (threadIdx.x == 0) __hip_atomic_store(&g_tw[(blockIdx.x % 8) * 32 + blockIdx.x / 8], (unsigned)(__builtin_amdgcn_s_memrealtime() - var), __ATOMIC_RELAXED, __HIP_MEMORY_SCOPE_AGENT); } } while (0)
#ifndef MK_PER_PHASE
#define MK_PER_PHASE 0
#endif

#define LAS __attribute__((address_space(3)))
#define GAS __attribute__((address_space(1)))
typedef unsigned short bf16_t;
typedef short bf16x8 __attribute__((ext_vector_type(8)));
typedef short s16x4 __attribute__((ext_vector_type(4)));
typedef float f32x2 __attribute__((ext_vector_type(2)));
typedef float f32x4 __attribute__((ext_vector_type(4)));
typedef float f32x16 __attribute__((ext_vector_type(16)));
typedef unsigned u32x2 __attribute__((ext_vector_type(2)));
typedef unsigned u32x4 __attribute__((ext_vector_type(4)));
typedef GAS unsigned gu32;

constexpr int NB = 4, SEQ = 8192, DM = 1024, T = NB * SEQ;
constexpr int PC = 4608;
constexpr int C_U = 0, C_V = 512, C_Q = 1024, C_K = 1536, C_VV = 2048, C_GA = 2560, C_GB = 3584;
constexpr int NEXP = 32, DEXP = 512;
constexpr float EPS = 1e-6f;
constexpr float QSCALE = 0.125f * 1.4426950408889634f;

constexpr size_t MiB = 1u << 20;
constexpr size_t WS_CTL = 0, CTL_ZERO_BYTES = 2 * MiB;
constexpr size_t WS_KSUM = 1 * MiB;
constexpr size_t WS_MODP = 2 * MiB;
constexpr size_t WS_MOD = 3 * MiB + 512 * 1024;
constexpr size_t WS_ROPE = 4 * MiB;
constexpr size_t WS_WST = 4 * MiB + 512 * 1024;
constexpr size_t WS_WRT = 4 * MiB + 768 * 1024;
constexpr size_t WS_SSQ = 5 * MiB;
constexpr size_t WS_ROUTE = 8 * MiB;
constexpr size_t WS_WIN = 24 * MiB;
constexpr size_t WS_WAB = 34 * MiB, WS_WOUT = 36 * MiB;
constexpr size_t WS_WGU = 40 * MiB;
constexpr size_t WS_WD = 104 * MiB;
constexpr size_t WS_XN = 136 * MiB;
constexpr size_t WS_PROJ = 200 * MiB;
constexpr size_t WS_HID = 200 * MiB;
constexpr size_t WS_Y = 272 * MiB;
constexpr size_t WS_X1 = 400 * MiB;
constexpr size_t WS_PO = 40 * MiB;
constexpr size_t WS_PML = 136 * MiB;
constexpr size_t WS_LIST = 488 * MiB;
constexpr size_t WS_END = 504 * MiB;
constexpr int CW_TMO = 0, CW_DIFF = 2, CW_BAR = 4096, CW_CURSOR = 32768, CW_CNT = 65536, CW_READY = 131072, CW_QHEAD = 160000, CW_GQ = 161024;

constexpr int RING_BYTES = 131072;
constexpr int LDS_BYTES = 147456;
constexpr int MISC_OFF = LDS_BYTES - 1024;
constexpr int NWAVES = 8;

#define LDS_WAIT() asm volatile("s_waitcnt lgkmcnt(0)" ::: "memory")
#define VM_WAIT() asm volatile("s_waitcnt vmcnt(0)" ::: "memory")
#define RLX_AGENT __ATOMIC_RELAXED, __HIP_MEMORY_SCOPE_AGENT

__device__ __forceinline__ unsigned cvt_pk_bf16(float lo, float hi) { unsigned r; asm volatile("v_cvt_pk_bf16_f32 %0, %1, %2" : "=v"(r) : "v"(lo), "v"(hi)); return r; }
__device__ __forceinline__ float bflo(unsigned u) { return __uint_as_float(u << 16); }
__device__ __forceinline__ float bfhi(unsigned u) { return __uint_as_float(u & 0xffff0000u); }
__device__ __forceinline__ float sigmoidf_(float x) { return __builtin_amdgcn_rcpf(1.0f + __builtin_amdgcn_exp2f(-1.4426950408889634f * x)); }
__device__ __forceinline__ float gelu_tanh(float x) { const float u = x + 0.044715f * x * x * x; return x * __builtin_amdgcn_rcpf(1.0f + __builtin_amdgcn_exp2f(-2.3022081985f * u)); }
__device__ __forceinline__ float wave_sum(float v) {
#pragma unroll
    for (int o = 1; o < 64; o <<= 1) v += __shfl_xor(v, o);
    return v;
}

namespace pg8 {
constexpr int BM = 256, BK = 64, HALF = 128, HTB = HALF * BK * 2, STAGE_BYTES = 8 * HTB, NXCD = 8, WGM = 4;
__host__ __device__ __forceinline__ int lds_byte(int r, int c) { const int st = (r >> 4) * 2 + (c >> 5), rr = r & 15, cc = c & 31, ob = rr * 64 + cc * 2; return st * 1024 + (ob ^ (((ob >> 9) & 1) << 5)); }
__host__ __device__ __forceinline__ void stage_rc(int b, int& R, int& C) { const int st = b / 1024, sb = b % 1024, swz = sb ^ (((sb >> 9) & 1) << 5); R = (st >> 1) * 16 + swz / 64; C = (st & 1) * 32 + (swz % 64) / 2; }
__host__ __device__ __forceinline__ int perm32(int rho) { const int n = rho >> 4, i = rho & 15; return 8 * (i >> 2) + 4 * n + (i & 3); }

struct Unit { int pm, pn, e, lt, nvalid; };

struct DenseSched {
    const char* A; const char* Bt; int lda, K; int nM, nN, nwg, G, c; int ksplit; unsigned kgap;
    __device__ void init(const void* A_, int lda_, const void* Bt_, int K_, int M, int N, int G_, int c_) { A = (const char*)A_; Bt = (const char*)Bt_; lda = lda_; K = K_; nM = M / BM; nN = N / BM; nwg = nM * nN; G = G_; c = c_; ksplit = 1 << 20; kgap = 0u; }
    __device__ __forceinline__ bool next(int i, Unit& u) const {
        const long L = (long)i * G + c; if (L >= nwg) return false;
        int wgid = (int)L; { const int q = nwg / NXCD, r = nwg % NXCD, xcd = wgid % NXCD, off = wgid / NXCD; wgid = (xcd < r ? xcd * (q + 1) : r * (q + 1) + (xcd - r) * q) + off; }
        const int nig = WGM * nN, gid = wgid / nig, fm = gid * WGM, gsz = (nM - fm) < WGM ? (nM - fm) : WGM;
        u.pm = fm + ((wgid % nig) % gsz); u.pn = (wgid % nig) / gsz; u.e = 0; u.lt = 0; u.nvalid = 256; return true;
    }
    __device__ __forceinline__ const char* a_base(const Unit& u) const { return A + (size_t)u.pm * BM * lda * 2; }
    __device__ __forceinline__ const char* b_base(const Unit& u) const { return Bt + (size_t)u.pn * BM * K * 2; }
    __device__ __forceinline__ unsigned gather_off(const Unit&, int, int) const { return 0u; }
    __device__ __forceinline__ void a_ready(const Unit&) const {}
    __device__ __forceinline__ void done(const Unit&) const {}
};
struct MoeSched {
    const char* A; const char* Bt; int lda, K; size_t bstride;
    const unsigned long long* route; bool gather;
    const volatile LAS int* tab;
    int start, end, j; static constexpr int ksplit = 1 << 20; static constexpr unsigned kgap = 0u;
    unsigned* ready; int mode;
    __device__ __forceinline__ void done(const Unit& u) const {
        if (mode == 1) { asm volatile("s_waitcnt vmcnt(0)" ::: "memory");
            if ((threadIdx.x & 63) == 0) __hip_atomic_fetch_add(ready + 64 * u.pm, 1u, __ATOMIC_RELAXED, __HIP_MEMORY_SCOPE_AGENT); } }
    __device__ __forceinline__ void a_ready(const Unit& u) const {
        if (mode == 2) {
            if (threadIdx.x < 64) {
                const int ln = threadIdx.x, d = u.pm - rdy[0]; const unsigned mk = (unsigned)rdy[1];
                const bool have = (d >= 0) && (d < 32) && (((mk >> (d & 31)) & 1u) != 0u);
                if (!have) { unsigned sp = 0;
                    while ((unsigned)__builtin_amdgcn_readfirstlane(__hip_atomic_load(ready + 64 * u.pm, __ATOMIC_RELAXED, __HIP_MEMORY_SCOPE_AGENT)) < 32u) { __builtin_amdgcn_s_sleep(2); if (++sp > (1u << 22)) break; }
                    const unsigned v = __hip_atomic_load(ready + 64 * (u.pm + (ln & 31)), __ATOMIC_RELAXED, __HIP_MEMORY_SCOPE_AGENT);
                    const unsigned m = (unsigned)__ballot((ln < 32) && (v >= 32u));
                    __builtin_amdgcn_fence(__ATOMIC_ACQUIRE, "agent");
                    asm volatile("s_waitcnt vmcnt(0)" ::: "memory");
                    if (ln == 0) { rdy[0] = u.pm; rdy[1] = (int)m; } } }
            asm volatile("" ::: "memory"); __builtin_amdgcn_s_barrier(); asm volatile("" ::: "memory"); } }
    volatile LAS int* rdy;
    static constexpr int NSTATIC = 3;
    unsigned* qhead; volatile LAS int* qslot;
    __device__ __forceinline__ bool next(int i, Unit& u) const {
        int idx;
        if (mode == 2 && i < NSTATIC) idx = start + i * 32 + j;
        else if (mode == 2) {
            if (threadIdx.x == 0) qslot[i & 1] = start + NSTATIC * 32 + (int)__hip_atomic_fetch_add(qhead, 1u, __ATOMIC_RELAXED, __HIP_MEMORY_SCOPE_AGENT);
            asm volatile("s_waitcnt vmcnt(0) lgkmcnt(0)" ::: "memory"); __builtin_amdgcn_s_barrier(); asm volatile("" ::: "memory");
            idx = __builtin_amdgcn_readfirstlane(qslot[i & 1]);
        } else idx = start + i * 32 + j;
        if (idx >= end) return false;
        const int tile = idx >> 2; u.pn = idx & 3; u.pm = tile;
        const int l_ = threadIdx.x & 63;
        const int offv = tab[32 + (l_ & 31)], cntv = tab[l_ & 31];
        const int e = (int)__popcll(__ballot((l_ >= 1) && (l_ < 32) && (offv <= tile)));
        u.e = e; u.lt = tile - __builtin_amdgcn_readlane(offv, e);
        const int rem = __builtin_amdgcn_readlane(cntv, e) - 256 * u.lt; u.nvalid = rem < 256 ? rem : 256; return true;
    }
    __device__ __forceinline__ const char* a_base(const Unit& u) const { return gather ? A : A + (size_t)u.pm * BM * lda * 2; }
    __device__ __forceinline__ const char* b_base(const Unit& u) const { return Bt + (size_t)u.e * bstride + (size_t)u.pn * BM * K * 2; }
    __device__ __forceinline__ unsigned gather_off(const Unit& u, int r, int C) const {
        const bool ok = r < u.nvalid;
        unsigned tok = (unsigned)(route[(size_t)u.e * 32768 + (size_t)u.lt * 256 + (ok ? r : 0)] & 0xffffffffull) >> 1;
        tok = ok ? tok : 0u;
        return (tok * (unsigned)lda + (unsigned)C) * 2u;
    }
};

template <class Epi, class Sched, bool GATHER>
__device__ __forceinline__ void gemm_phase(LAS unsigned char* lds, const Sched& S, const Epi& E) {
    const int tid = threadIdx.x, wid = __builtin_amdgcn_readfirstlane(tid >> 6), lane = tid & 63, wr = wid >> 2, wc = wid & 3, fr = lane & 15, fq = lane >> 4;
    const int K = S.K, lda = S.lda, nt = K / BK;
    unsigned voffA[2], voffB[2]; int RA[2], CA[2];
#pragma unroll
    for (int i = 0; i < 2; ++i) { int R, C; stage_rc(tid * 16 + i * 8192, R, C); const int Rb = Epi::PERM ? ((R & ~31) + perm32(R & 31)) : R;
        RA[i] = R; CA[i] = C; voffA[i] = (unsigned)(R * lda + C) * 2u; voffB[i] = (unsigned)(Rb * K + C) * 2u; }
    const size_t kstep = (size_t)(BK * 2);
    const unsigned hstepA = (unsigned)HALF * (unsigned)lda * 2u;
    const size_t hstepB = (size_t)HALF * K * 2;
    const unsigned ldsw = (unsigned)wid * 1024u;
    const int aoff = lds_byte(wr * 64 + fr, fq * 8), boff = lds_byte(wc * 32 + fr, fq * 8);
    unsigned og[2][2] = {{0u, 0u}, {0u, 0u}}, ogn[2][2] = {{0u, 0u}, {0u, 0u}};
#define PG8_SA(b, h) (((b) * 2 + (h)) * HTB)
#define PG8_SB(b, h) ((4 + (b) * 2 + (h)) * HTB)
#define PG8_STAGE_B(bufoff, gbase) do { _Pragma("unroll") for (int _i = 0; _i < 2; ++_i) \
        __builtin_amdgcn_global_load_lds((const unsigned*)((const char*)(gbase) + voffB[_i]), (LAS unsigned*)(lds + (bufoff) + ldsw + _i * 8192), 16, 0, 0); } while (0)
#define PG8_STAGE_A(bufoff, gbase, h) do { _Pragma("unroll") for (int _i = 0; _i < 2; ++_i) \
        __builtin_amdgcn_global_load_lds((const unsigned*)((const char*)(gbase) + (GATHER ? og[h][_i] : voffA[_i] + (h) * hstepA)), (LAS unsigned*)(lds + (bufoff) + ldsw + _i * 8192), 16, 0, 0); } while (0)
#define PG8_LDA(dst, b, h) do { _Pragma("unroll") for (int m = 0; m < 4; ++m) _Pragma("unroll") for (int k = 0; k < 2; ++k) dst[m][k] = *(const LAS bf16x8*)(lds + PG8_SA(b, h) + aoff + m * 2048 + k * 1024); } while (0)
#define PG8_LDB(dst, b, h) do { _Pragma("unroll") for (int n = 0; n < 2; ++n) _Pragma("unroll") for (int k = 0; k < 2; ++k) dst[n][k] = *(const LAS bf16x8*)(lds + PG8_SB(b, h) + boff + n * 2048 + k * 1024); } while (0)
#define PG8_MMA(ai, bj, At, Bt) do { __builtin_amdgcn_s_setprio(1); _Pragma("unroll") for (int m = 0; m < 4; ++m) _Pragma("unroll") for (int n = 0; n < 2; ++n) _Pragma("unroll") for (int k = 0; k < 2; ++k) \
        acc[ai][bj][m][n] = __builtin_amdgcn_mfma_f32_16x16x32_bf16(Bt[n][k], At[m][k], acc[ai][bj][m][n], 0, 0, 0); __builtin_amdgcn_s_setprio(0); } while (0)
#define PG8_WAIT_V(n) asm volatile("s_waitcnt vmcnt(" #n ")" ::: "memory")
#define PG8_WAIT_L(n) asm volatile("s_waitcnt lgkmcnt(" #n ")" ::: "memory")
#define PG8_BAR __builtin_amdgcn_s_barrier()
#define PG8_SCHED __builtin_amdgcn_sched_barrier(0)
    Unit cur, nxt; int ui = 0;
    if (!S.next(0, cur)) return;
    f32x4 acc[2][2][4][2];
#pragma unroll
    for (int a = 0; a < 2; ++a)
#pragma unroll
        for (int b = 0; b < 2; ++b)
#pragma unroll
            for (int m = 0; m < 4; ++m)
#pragma unroll
                for (int n = 0; n < 2; ++n) acc[a][b][m][n] = (f32x4){0.f, 0.f, 0.f, 0.f};
    bf16x8 At[4][2], B0[2][2], B1[2][2];
    const char* cA = S.a_base(cur); const char* cB = S.b_base(cur);
    S.a_ready(cur);
    PG8_STAGE_B(PG8_SB(0, 0), cB); PG8_STAGE_B(PG8_SB(0, 1), cB + hstepB);
    if constexpr (GATHER) {
#pragma unroll
        for (int h = 0; h < 2; ++h)
#pragma unroll
            for (int i = 0; i < 2; ++i) og[h][i] = S.gather_off(cur, h * HALF + RA[i], CA[i]);
    }
    PG8_STAGE_A(PG8_SA(0, 0), cA, 0); PG8_STAGE_A(PG8_SA(0, 1), cA, 1);
    if (wr == 1) PG8_BAR;
    PG8_WAIT_V(2); PG8_BAR;
    PG8_STAGE_B(PG8_SB(1, 0), cB + kstep); PG8_STAGE_A(PG8_SA(1, 0), cA + kstep, 0); PG8_STAGE_B(PG8_SB(1, 1), cB + hstepB + kstep);
    PG8_WAIT_V(6); PG8_BAR;
    unsigned long long t3_ = 0;
    for (;;) {
        const bool has_next = S.next(ui + 1, nxt);
        const char* nA = has_next ? S.a_base(nxt) : cA; const char* nB = has_next ? S.b_base(nxt) : cB;
        if constexpr (GATHER) {
            const Unit gu = has_next ? nxt : cur;
#pragma unroll
            for (int h = 0; h < 2; ++h)
#pragma unroll
                for (int i = 0; i < 2; ++i) ogn[h][i] = S.gather_off(gu, h * HALF + RA[i], CA[i]);
        }
        for (int t = 0; t < nt; t += 2) {
            const bool last = (t == nt - 2);
            const char* a1 = cA + (size_t)(t + 1) * kstep + ((t + 1) >= S.ksplit ? S.kgap : 0u);
            const char* a2 = last ? nA : cA + (size_t)(t + 2) * kstep + ((t + 2) >= S.ksplit ? S.kgap : 0u); const char* b2 = last ? nB : cB + (size_t)(t + 2) * kstep;
            const char* a3 = last ? nA + kstep : cA + (size_t)(t + 3) * kstep + ((t + 3) >= S.ksplit ? S.kgap : 0u); const char* b3 = b2 + kstep;
            if (last && has_next) S.a_ready(nxt);
            if constexpr (Epi::HAS_MID) { if (t == S.ksplit) E.mid(acc, cur, wr, wc, fr, fq); }
            PG8_LDB(B0, 0, 0); PG8_LDB(B1, 0, 1); PG8_SCHED; PG8_LDA(At, 0, 0); PG8_STAGE_A(PG8_SA(1, 1), a1, 1);
            if constexpr (GATHER) { if (last && has_next) {
#pragma unroll
                for (int h = 0; h < 2; ++h)
#pragma unroll
                    for (int i = 0; i < 2; ++i) og[h][i] = ogn[h][i]; } }
            PG8_WAIT_V(8); PG8_WAIT_L(0); PG8_BAR;
            if (TSEL == 3) { if (t == 0 && t3_ != 0 && T_ON(3)) { g_tacc += __builtin_amdgcn_s_memrealtime() - t3_; t3_ = 0; } }
            PG8_MMA(0, 0, At, B0); PG8_MMA(0, 1, At, B1); PG8_BAR; PG8_SCHED;
            PG8_LDA(At, 0, 1); PG8_STAGE_B(PG8_SB(0, 0), b2); PG8_STAGE_B(PG8_SB(0, 1), b2 + hstepB); PG8_STAGE_A(PG8_SA(0, 0), a2, 0);
            PG8_WAIT_V(8); PG8_WAIT_L(0); PG8_BAR; PG8_MMA(1, 0, At, B0); PG8_MMA(1, 1, At, B1); PG8_BAR; PG8_SCHED;
            PG8_LDB(B0, 1, 0); PG8_LDB(B1, 1, 1); PG8_SCHED; PG8_LDA(At, 1, 0); PG8_STAGE_A(PG8_SA(0, 1), a2, 1);
            PG8_WAIT_V(8); PG8_WAIT_L(0); PG8_BAR; PG8_MMA(0, 0, At, B0); PG8_MMA(0, 1, At, B1); PG8_BAR; PG8_SCHED;
            PG8_LDA(At, 1, 1); PG8_STAGE_B(PG8_SB(1, 0), b3); PG8_STAGE_B(PG8_SB(1, 1), b3 + hstepB); PG8_STAGE_A(PG8_SA(1, 0), a3, 0);
            PG8_WAIT_V(8); PG8_WAIT_L(0); PG8_BAR; PG8_MMA(1, 0, At, B0); PG8_MMA(1, 1, At, B1); PG8_BAR; PG8_SCHED;
        }
        if (wr == 0) PG8_BAR;
        { T_BEGIN(2, t2_) E(acc, cur, wr, wc, fr, fq); S.done(cur); T_END(2, t2_); }
        if (!has_next) break;
        if (TSEL == 3 && T_ON(3)) t3_ = __builtin_amdgcn_s_memrealtime();
#pragma unroll
        for (int a = 0; a < 2; ++a)
#pragma unroll
            for (int b = 0; b < 2; ++b)
#pragma unroll
                for (int m = 0; m < 4; ++m)
#pragma unroll
                    for (int n = 0; n < 2; ++n) acc[a][b][m][n] = (f32x4){0.f, 0.f, 0.f, 0.f};
        cur = nxt; cA = nA; cB = nB; ++ui;
        if (wr == 1) PG8_BAR;
    }
    PG8_WAIT_V(0);
    PG8_BAR;
#undef PG8_SA
#undef PG8_SB
#undef PG8_STAGE_A
#undef PG8_STAGE_B
#undef PG8_LDA
#undef PG8_LDB
#undef PG8_MMA
#undef PG8_WAIT_V
#undef PG8_WAIT_L
#undef PG8_BAR
#undef PG8_SCHED
}

struct EpiProj {
    static constexpr bool PERM = true; static constexpr bool HAS_MID = false;
    bf16_t* P; const float* rope; float* ksum;
    __device__ __forceinline__ void operator()(const f32x4 (&acc)[2][2][4][2], const Unit& u, int wr, int wc, int fr_in, int fq) const {
        int fr = fr_in; asm volatile("" : "+v"(fr));
        const int pn = u.pn, row0 = u.pm * BM + wr * 64 + fr, cl = wc * 32 + 8 * fq;
        if (pn < 4 || pn >= 8) {
#pragma unroll
            for (int gi = 0; gi < 8; ++gi) { const int ai = gi >> 2, m = gi & 3; bf16_t* rowp = P + (size_t)(row0 + ai * HALF + m * 16) * PC + pn * BM + cl;
#pragma unroll
                for (int bj = 0; bj < 2; ++bj) { const f32x4 v0 = acc[ai][bj][m][0], v1 = acc[ai][bj][m][1];
                    u32x4 w; w.x = cvt_pk_bf16(v0[0], v0[1]); w.y = cvt_pk_bf16(v0[2], v0[3]); w.z = cvt_pk_bf16(v1[0], v1[1]); w.w = cvt_pk_bf16(v1[2], v1[3]);
                    __builtin_nontemporal_store(w, (u32x4*)(rowp + bj * HALF)); }
                asm volatile("" ::: "memory"); }
            return;
        }
        const int mode = pn < 6 ? 1 : 2;
        const bool rot = (mode == 1 || mode == 2) && ((wc & 1) == 0);
        float ks[2][8];
#pragma unroll
        for (int bj = 0; bj < 2; ++bj)
#pragma unroll
            for (int j = 0; j < 8; ++j) ks[bj][j] = 0.f;
        f32x4 rq[2][4];
#define RP_LOAD(gi, slot) do { const int pos_ = (row0 + ((gi) >> 2) * HALF + ((gi) & 3) * 16) & (SEQ - 1); \
            rq[slot][0] = *(const f32x4*)(rope + pos_ * 8); rq[slot][1] = *(const f32x4*)(rope + pos_ * 8 + 4); rq[slot][2] = *(const f32x4*)(rope + 65536 + pos_ * 8); rq[slot][3] = *(const f32x4*)(rope + 65536 + pos_ * 8 + 4); } while (0)
        RP_LOAD(0, 0);
#pragma unroll
        for (int ai = 0; ai < 2; ++ai)
#pragma unroll
            for (int m = 0; m < 4; ++m) {
                const int gi_ = ai * 4 + m;
                if (gi_ + 1 < 8) RP_LOAD(gi_ + 1, (gi_ + 1) & 1);
                const int row = row0 + ai * HALF + m * 16;
                float cs[8], sn[8];
#pragma unroll
                for (int j = 0; j < 4; ++j) { cs[j] = rq[gi_ & 1][0][j]; cs[4 + j] = rq[gi_ & 1][1][j]; sn[j] = rq[gi_ & 1][2][j]; sn[4 + j] = rq[gi_ & 1][3][j]; }
#pragma unroll
                for (int bj = 0; bj < 2; ++bj) {
                    float v[8];
#pragma unroll
                    for (int j = 0; j < 4; ++j) { v[j] = acc[ai][bj][m][0][j]; v[4 + j] = acc[ai][bj][m][1][j]; }
                    if (mode == 1 || mode == 2) {
                        if (rot) {
                            const float sg = (fq == 0) ? -1.f : 1.f; const bool ap = fq < 2;
#pragma unroll
                            for (int j = 0; j < 8; ++j) {
                                const auto sw = __builtin_amdgcn_permlane16_swap(__float_as_uint(v[j]), __float_as_uint(v[j]), false, false);
                                const float o = __uint_as_float((fq & 1) ? sw[0] : sw[1]); const float r = v[j] * cs[j] + sg * o * sn[j]; v[j] = ap ? r : v[j]; }
                        }
                        if (mode == 1) {
#pragma unroll
                            for (int j = 0; j < 8; ++j) v[j] *= QSCALE;
                        } else {
#pragma unroll
                            for (int j = 0; j < 8; ++j) ks[bj][j] += v[j];
                        }
                    }
                    u32x4 w; w.x = cvt_pk_bf16(v[0], v[1]); w.y = cvt_pk_bf16(v[2], v[3]); w.z = cvt_pk_bf16(v[4], v[5]); w.w = cvt_pk_bf16(v[6], v[7]);
                    *(u32x4*)(P + (size_t)row * PC + pn * BM + bj * HALF + cl) = w;
                }
            }
        asm volatile("" :: "v"(rq[0][0]), "v"(rq[0][1]), "v"(rq[0][2]), "v"(rq[0][3]), "v"(rq[1][0]), "v"(rq[1][1]), "v"(rq[1][2]), "v"(rq[1][3]));
        if (mode == 2) {
#pragma unroll
            for (int bj = 0; bj < 2; ++bj)
#pragma unroll
                for (int j = 0; j < 8; ++j) { float s = ks[bj][j]; s += __shfl_xor(s, 1); s += __shfl_xor(s, 2); s += __shfl_xor(s, 4); s += __shfl_xor(s, 8); ks[bj][j] = s; }
            if (fr == 0) {
                const int b = u.pm >> 5, kb = u.pm & 31;
#pragma unroll
                for (int bj = 0; bj < 2; ++bj) { const int ck = (pn - 6) * BM + bj * HALF + cl; const int h = ck >> 6, d = ck & 63;
                    float* dst = ksum + ((size_t)((b * 8 + h) * 32 + kb)) * 64 + d;
#pragma unroll
                    for (int j = 0; j < 8; ++j) atomicAdd(dst + j, ks[bj][j]); }
            }
        }
    }
};
struct EpiMergeF {
    static constexpr bool PERM = true; static constexpr bool HAS_MID = true;
    const bf16_t* P; bf16_t* MG;
    __device__ __forceinline__ void mid(f32x4 (&acc)[2][2][4][2], const Unit& u, int wr, int wc, int fr_in, int fq) const {
        int fr = fr_in; asm volatile("" : "+v"(fr));
        const int row0 = u.pm * BM + wr * 64 + fr, col0 = u.pn * BM + wc * 32 + 8 * fq;
#pragma unroll
        for (int g4 = 0; g4 < 8; g4 += 4) {
            u32x4 ga[4][2], gb[4][2];
#pragma unroll
            for (int k = 0; k < 4; ++k) { const int gi = g4 + k, row = row0 + (gi >> 2) * HALF + (gi & 3) * 16;
#pragma unroll
                for (int bj = 0; bj < 2; ++bj) { ga[k][bj] = *(const u32x4*)(P + (size_t)row * PC + C_GA + col0 + bj * HALF); gb[k][bj] = *(const u32x4*)(P + (size_t)row * PC + C_GB + col0 + bj * HALF); } }
#pragma unroll
            for (int k = 0; k < 4; ++k) { const int gi = g4 + k, ai = gi >> 2, m = gi & 3;
#pragma unroll
                for (int bj = 0; bj < 2; ++bj) {
#define RHO(a_, b_) ((1.0f + __builtin_amdgcn_exp2f(-1.4426950408889634f * fmaxf(b_, -60.f))) * sigmoidf_(a_))
                    const u32x4 A_ = ga[k][bj], B_ = gb[k][bj];
                    acc[ai][bj][m][0][0] *= RHO(bflo(A_.x), bflo(B_.x)); acc[ai][bj][m][0][1] *= RHO(bfhi(A_.x), bfhi(B_.x)); acc[ai][bj][m][0][2] *= RHO(bflo(A_.y), bflo(B_.y)); acc[ai][bj][m][0][3] *= RHO(bfhi(A_.y), bfhi(B_.y));
                    acc[ai][bj][m][1][0] *= RHO(bflo(A_.z), bflo(B_.z)); acc[ai][bj][m][1][1] *= RHO(bfhi(A_.z), bfhi(B_.z)); acc[ai][bj][m][1][2] *= RHO(bflo(A_.w), bflo(B_.w)); acc[ai][bj][m][1][3] *= RHO(bfhi(A_.w), bfhi(B_.w));
#undef RHO
                } }
        }
    }
    __device__ __forceinline__ void operator()(const f32x4 (&acc)[2][2][4][2], const Unit& u, int wr, int wc, int fr_in, int fq) const {
        int fr = fr_in; asm volatile("" : "+v"(fr));
        const int row0 = u.pm * BM + wr * 64 + fr, col0 = u.pn * BM + wc * 32 + 8 * fq;
        u32x4 gq[3][2];
#define EM_LOAD(gi, slot) do { const int row_ = row0 + ((gi) >> 2) * HALF + ((gi) & 3) * 16; \
            _Pragma("unroll") for (int bj = 0; bj < 2; ++bj) gq[slot][bj] = *(const u32x4*)(P + (size_t)row_ * PC + C_GB + col0 + bj * HALF); } while (0)
        EM_LOAD(0, 0); EM_LOAD(1, 1);
#pragma unroll
        for (int gi = 0; gi < 8; ++gi) {
            if (gi + 2 < 8) EM_LOAD(gi + 2, (gi + 2) % 3);
            asm volatile("" ::: "memory");
            const int ai = gi >> 2, m = gi & 3, row = row0 + ai * HALF + m * 16;
#pragma unroll
            for (int bj = 0; bj < 2; ++bj) { const u32x4 g = gq[gi % 3][bj];
                float v[8];
#pragma unroll
                for (int j = 0; j < 4; ++j) { v[j] = acc[ai][bj][m][0][j]; v[4 + j] = acc[ai][bj][m][1][j]; }
#define SGB(x_) sigmoidf_(fmaxf(x_, -60.f))
                v[0] *= SGB(bflo(g.x)); v[1] *= SGB(bfhi(g.x)); v[2] *= SGB(bflo(g.y)); v[3] *= SGB(bfhi(g.y)); v[4] *= SGB(bflo(g.z)); v[5] *= SGB(bfhi(g.z)); v[6] *= SGB(bflo(g.w)); v[7] *= SGB(bfhi(g.w));
#undef SGB
                u32x4 w; w.x = cvt_pk_bf16(v[0], v[1]); w.y = cvt_pk_bf16(v[2], v[3]); w.z = cvt_pk_bf16(v[4], v[5]); w.w = cvt_pk_bf16(v[6], v[7]);
                *(u32x4*)(MG + (size_t)row * DM + col0 + bj * HALF) = w; }
        }
#undef EM_LOAD
    }
};
struct EpiOut {
    static constexpr bool PERM = false; static constexpr bool HAS_MID = false;
    const float* x; bf16_t* x1; const float* mod; float* ssq;
    __device__ __forceinline__ void operator()(const f32x4 (&acc)[2][2][4][2], const Unit& u, int wr, int wc, int fr_in, int fq) const {
        int fr = fr_in; asm volatile("" : "+v"(fr));
        const int row0 = u.pm * BM + wr * 64 + fr, col0 = u.pn * BM + wc * 32 + 4 * fq, b = u.pm >> 5;
        f32x4 xq[3][2][2];
#define EO_LOAD(gi, slot) do { const size_t off_ = (size_t)(row0 + ((gi) >> 2) * HALF + ((gi) & 3) * 16) * DM + col0; \
            _Pragma("unroll") for (int bj = 0; bj < 2; ++bj) _Pragma("unroll") for (int n = 0; n < 2; ++n) xq[slot][bj][n] = *(const f32x4*)(x + off_ + bj * HALF + n * 16); } while (0)
        EO_LOAD(0, 0); EO_LOAD(1, 1);
        f32x4 g1[2][2];
#pragma unroll
        for (int bj = 0; bj < 2; ++bj)
#pragma unroll
            for (int n = 0; n < 2; ++n) g1[bj][n] = *(const f32x4*)(mod + b * 6144 + 2048 + col0 + bj * HALF + n * 16);
#pragma unroll
        for (int gi = 0; gi < 8; ++gi) {
            if (gi + 2 < 8) EO_LOAD(gi + 2, (gi + 2) % 3);
            asm volatile("" ::: "memory");
            const int ai = gi >> 2, m = gi & 3, row = row0 + ai * HALF + m * 16; const size_t off = (size_t)row * DM + col0; float s = 0.f;
#pragma unroll
            for (int bj = 0; bj < 2; ++bj)
#pragma unroll
                for (int n = 0; n < 2; ++n) { const f32x4 o = xq[gi % 3][bj][n] + g1[bj][n] * acc[ai][bj][m][n];
                    u32x2 w; w.x = cvt_pk_bf16(o[0], o[1]); w.y = cvt_pk_bf16(o[2], o[3]);
                    const float r0 = bflo(w.x), r1 = bfhi(w.x), r2 = bflo(w.y), r3 = bfhi(w.y);
                    s += (r0 * r0 + r1 * r1) + (r2 * r2 + r3 * r3); *(u32x2*)(x1 + off + bj * HALF + n * 16) = w; }
            s += __shfl_xor(s, 16); s += __shfl_xor(s, 32);
            if (fq == 0) ssq[(size_t)row * 16 + u.pn * 4 + wc] = s;
        }
#undef EO_LOAD
    }
};
struct EpiGU {
    static constexpr bool PERM = true; static constexpr bool HAS_MID = false;
    bf16_t* H;
    __device__ __forceinline__ void operator()(const f32x4 (&acc)[2][2][4][2], const Unit& u, int wr, int wc, int fr_in, int fq) const {
        int fr = fr_in; asm volatile("" : "+v"(fr));
        const int r0 = wr * 64 + fr, cl = wc * 32 + 8 * fq;
#pragma unroll
        for (int ai = 0; ai < 2; ++ai)
#pragma unroll
            for (int m = 0; m < 4; ++m) { const int r = r0 + ai * HALF + m * 16;
                float v[8];
#pragma unroll
                for (int j = 0; j < 4; ++j) { const float g0 = acc[ai][0][m][0][j], g1 = acc[ai][0][m][1][j]; v[j] = g0 * sigmoidf_(g0) * acc[ai][1][m][0][j]; v[4 + j] = g1 * sigmoidf_(g1) * acc[ai][1][m][1][j]; }
                u32x4 w; w.x = cvt_pk_bf16(v[0], v[1]); w.y = cvt_pk_bf16(v[2], v[3]); w.z = cvt_pk_bf16(v[4], v[5]); w.w = cvt_pk_bf16(v[6], v[7]);
                bf16_t* dst = H + ((size_t)u.pm * BM + r) * DEXP + u.pn * HALF + cl;
                asm volatile("global_store_dwordx4 %0, %1, off sc1\n\ts_nop 1" :: "v"(dst), "v"(w) : "memory"); }
    }
};
struct EpiDown {
    static constexpr bool PERM = true; static constexpr bool HAS_MID = false;
    bf16_t* Y; const unsigned long long* route;
    __device__ __forceinline__ void operator()(const f32x4 (&acc)[2][2][4][2], const Unit& u, int wr, int wc, int fr_in, int fq) const {
        int fr = fr_in; asm volatile("" : "+v"(fr));
        const int r0 = wr * 64 + fr, col0 = u.pn * BM + wc * 32 + 8 * fq;
        const unsigned long long* rt = route + (size_t)u.e * 32768 + (size_t)u.lt * 256;
        unsigned long long ent[8];
#pragma unroll
        for (int gi = 0; gi < 8; ++gi) { const int r = r0 + (gi >> 2) * HALF + (gi & 3) * 16; ent[gi] = (r < u.nvalid) ? rt[r] : 0ull; }
#pragma unroll
        for (int gi = 0; gi < 8; ++gi) { const int ai = gi >> 2, m = gi & 3, r = r0 + ai * HALF + m * 16;
            if (r < u.nvalid) { const unsigned slot = (unsigned)(ent[gi] & 0xffffffffull); const float wt = __uint_as_float((unsigned)(ent[gi] >> 32));
#pragma unroll
                for (int bj = 0; bj < 2; ++bj) { const f32x4 a0 = acc[ai][bj][m][0] * wt, a1 = acc[ai][bj][m][1] * wt;
                    u32x4 w; w.x = cvt_pk_bf16(a0[0], a0[1]); w.y = cvt_pk_bf16(a0[2], a0[3]); w.z = cvt_pk_bf16(a1[0], a1[1]); w.w = cvt_pk_bf16(a1[2], a1[3]);
                    *(u32x4*)(Y + (size_t)slot * DM + col0 + bj * HALF) = w; } } }
    }
};
}

namespace attn_body {
using bf16 = __hip_bfloat16;
constexpr int NHEAD = 8, D = 64, PITCH = PC;
constexpr int NW = 8, QBLK = 32, QB = QBLK * NW, KVBLK = 64;
__device__ __forceinline__ int crow(int r, int hi) { return (r & 3) + 8 * (r >> 2) + 4 * hi; }
#define SBAR() __builtin_amdgcn_sched_barrier(0)
__device__ __forceinline__ void cmask(f32x16& p0, f32x16& p1, int jb, int qrel, int hi) {
    const float NEG = -INFINITY; int kb = 64 * jb + 4 * hi;
#pragma unroll
    for (int r = 0; r < 16; ++r) { int kv = kb + (r & 3) + 8 * (r >> 2); if (kv > qrel) p0[r] = NEG; if (kv + 32 > qrel) p1[r] = NEG; }
}
__device__ __forceinline__ void selapply(f32x16& p0, f32x16& p1, bool ok) {
    const float NEG = -INFINITY;
#pragma unroll
    for (int r = 0; r < 16; ++r) { p0[r] = ok ? p0[r] : NEG; p1[r] = ok ? p1[r] : NEG; }
}
constexpr int NSLOT = 3, SLOTB = 8192;
constexpr int LDS_K = 0, LDS_V = NSLOT * SLOTB, LDS_WS = 2 * NSLOT * SLOTB, LDS_OST = LDS_WS + NW * 64 * 4, LDS_BYTES_A = LDS_OST + NW * 4096;
__device__ __forceinline__ void glds16(const void* gsrc, unsigned lds_dst) { unsigned keep;
    asm volatile("s_mov_b32 %0, m0\n\ts_mov_b32 m0, %2\n\ts_nop 0\n\tglobal_load_lds_dwordx4 %1, off\n\ts_mov_b32 m0, %0" : "=&s"(keep) : "v"(gsrc), "s"(lds_dst) : "memory"); }
__device__ __forceinline__ float max3f(float a, float b, float c) { float r; asm("v_max3_f32 %0, %1, %2, %3" : "=v"(r) : "v"(a), "v"(b), "v"(c)); return r; }
__device__ __forceinline__ float max2f(float a, float b) { float r; asm("v_max_f32_e32 %0, %1, %2" : "=v"(r) : "v"(a), "v"(b)); return r; }
__device__ __forceinline__ float fadd_s(float a, float b) { float r; asm("v_add_f32_e32 %0, %1, %2" : "=v"(r) : "v"(a), "v"(b)); return r; }
__device__ __forceinline__ float fsub_s(float a, float b) { float r; asm("v_sub_f32_e32 %0, %1, %2" : "=v"(r) : "v"(a), "v"(b)); return r; }
typedef __bf16 bf16x2_t __attribute__((ext_vector_type(2)));
__device__ __forceinline__ unsigned cvtpk_s(float lo, float hi) { f32x2 v = {lo, hi}; bf16x2_t b = __builtin_convertvector(v, bf16x2_t); return __builtin_bit_cast(unsigned, b); }
#define WAIT_BAR(N) asm volatile("s_waitcnt vmcnt(" #N ") lgkmcnt(0)\n\ts_barrier" ::: "memory")

__device__ __forceinline__ void qkt(f32x16& p0, f32x16& p1, const char* Kslot, const bf16x8* qr, const f32x16& negm, int r32, int hi) {
    const char* kb = Kslot + hi * 1024 + r32 * 16;
#pragma unroll
    for (int d0 = 0; d0 < 4; ++d0) {
        const bf16x8 b0 = *reinterpret_cast<const bf16x8*>(kb + d0 * 2048);
        const bf16x8 b1 = *reinterpret_cast<const bf16x8*>(kb + d0 * 2048 + 512);
        if (d0 == 0) { p0 = __builtin_amdgcn_mfma_f32_32x32x16_bf16(b0, qr[0], negm, 0, 0, 0); p1 = __builtin_amdgcn_mfma_f32_32x32x16_bf16(b1, qr[0], negm, 0, 0, 0); }
        else { p0 = __builtin_amdgcn_mfma_f32_32x32x16_bf16(b0, qr[d0], p0, 0, 0, 0); p1 = __builtin_amdgcn_mfma_f32_32x32x16_bf16(b1, qr[d0], p1, 0, 0, 0); } }
}
typedef LAS const char* lds_cptr;
typedef short v4i16_t __attribute__((ext_vector_type(4)));
__device__ __forceinline__ void kload8(bf16x8* kf, lds_cptr kp) {
    kf[0] = *(const LAS bf16x8*)(kp);        kf[1] = *(const LAS bf16x8*)(kp + 512);
    kf[2] = *(const LAS bf16x8*)(kp + 2048); kf[3] = *(const LAS bf16x8*)(kp + 2560);
    kf[4] = *(const LAS bf16x8*)(kp + 4096); kf[5] = *(const LAS bf16x8*)(kp + 4608);
    kf[6] = *(const LAS bf16x8*)(kp + 6144); kf[7] = *(const LAS bf16x8*)(kp + 6656);
}
__device__ __forceinline__ void kload2(bf16x8* kf, lds_cptr kp, int j) { kf[2 * j] = *(const LAS bf16x8*)(kp + j * 2048); kf[2 * j + 1] = *(const LAS bf16x8*)(kp + j * 2048 + 512); }
__device__ __forceinline__ s16x4 vtr(lds_cptr p) { return __builtin_bit_cast(s16x4, __builtin_amdgcn_ds_read_tr16_b64_v4i16((LAS v4i16_t*)p)); }
__device__ __forceinline__ float rowmax(const f32x16& p0, const f32x16& p1) {
    float a = max3f(p0[0], p0[1], p1[0]), b = max3f(p0[2], p0[3], p1[1]); a = max3f(a, p1[2], p1[3]);
#pragma unroll
    for (int r = 4; r < 16; r += 4) { a = max3f(a, p0[r], p0[r + 1]); b = max3f(b, p0[r + 2], p0[r + 3]); a = max3f(a, p1[r], p1[r + 1]); b = max3f(b, p1[r + 2], p1[r + 3]); }
    const float m = max2f(a, b);
    auto rr = __builtin_amdgcn_permlane32_swap(__float_as_uint(m), __float_as_uint(m), false, false);
    return max2f(__uint_as_float(rr[0]), __uint_as_float(rr[1]));
}
__device__ __forceinline__ void pv(f32x16* o, int vb, bf16x8 pa0, bf16x8 pa1, bf16x8 pa2, bf16x8 pa3) {
#pragma unroll
    for (int d0 = 0; d0 < 2; ++d0) { s16x4 lo[4], hi[4];
#pragma unroll
        for (int ks = 0; ks < 4; ++ks) {
            asm volatile("ds_read_b64_tr_b16 %0,%1 offset:%c2" : "=&v"(lo[ks]) : "v"(vb), "i"(d0 * 4096 + ks * 1024) : "memory");
            asm volatile("ds_read_b64_tr_b16 %0,%1 offset:%c2" : "=&v"(hi[ks]) : "v"(vb), "i"(d0 * 4096 + ks * 1024 + 512) : "memory"); }
        asm volatile("s_waitcnt lgkmcnt(0)" ::: "memory"); SBAR();
#define PK(k) (bf16x8){lo[k][0], lo[k][1], lo[k][2], lo[k][3], hi[k][0], hi[k][1], hi[k][2], hi[k][3]}
        o[d0] = __builtin_amdgcn_mfma_f32_32x32x16_bf16(pa0, PK(0), o[d0], 0, 0, 0);
        o[d0] = __builtin_amdgcn_mfma_f32_32x32x16_bf16(pa1, PK(1), o[d0], 0, 0, 0);
        o[d0] = __builtin_amdgcn_mfma_f32_32x32x16_bf16(pa2, PK(2), o[d0], 0, 0, 0);
        o[d0] = __builtin_amdgcn_mfma_f32_32x32x16_bf16(pa3, PK(3), o[d0], 0, 0, 0);
#undef PK
    }
}

__device__ __forceinline__ void gate_top3(const float* ksum_bh, const bf16x8* qr, int qb, int r32, int hi, int (&kbs)[3]) {
    const float* km = ksum_bh + (size_t)r32 * 64 + hi * 8;
    f32x16 g = f32x16{};
#pragma unroll
    for (int d0 = 0; d0 < 4; ++d0) { const f32x4 a = *(const f32x4*)(km + d0 * 16), c = *(const f32x4*)(km + d0 * 16 + 4);
        u32x4 w; w.x = cvtpk_s(a[0], a[1]); w.y = cvtpk_s(a[2], a[3]); w.z = cvtpk_s(c[0], c[1]); w.w = cvtpk_s(c[2], c[3]);
        g = __builtin_amdgcn_mfma_f32_32x32x16_bf16(__builtin_bit_cast(bf16x8, w), qr[d0], g, 0, 0, 0); }
#pragma unroll
    for (int r = 0; r < 16; ++r) if (crow(r, hi) >= qb) g[r] = -INFINITY;
#pragma unroll
    for (int round = 0; round < 3; ++round) {
        float m = g[0];
#pragma unroll
        for (int r = 1; r < 16; ++r) m = fmaxf(m, g[r]);
        int idx = 64;
#pragma unroll
        for (int r = 15; r >= 0; --r) if (g[r] == m) idx = crow(r, hi);
        const float pm = __shfl_xor(m, 32); const int pidx = __shfl_xor(idx, 32);
        const bool mine = (m > pm) || (m == pm && idx < pidx);
        kbs[round] = (mine ? idx : pidx) & 31;
#pragma unroll
        for (int r = 0; r < 16; ++r) if (mine && crow(r, hi) == idx) g[r] = -INFINITY;
    }
}

__device__ __forceinline__ void gate_top3w(const u32x4 (&kw)[4], const bf16x8* qr, int qb, int r32, int hi, int (&kbs)[3]) {
    f32x16 g = f32x16{};
#pragma unroll
    for (int d0 = 0; d0 < 4; ++d0) g = __builtin_amdgcn_mfma_f32_32x32x16_bf16(__builtin_bit_cast(bf16x8, kw[d0]), qr[d0], g, 0, 0, 0);
#pragma unroll
    for (int r = 0; r < 16; ++r) if (crow(r, hi) >= qb) g[r] = -INFINITY;
#pragma unroll
    for (int round = 0; round < 3; ++round) {
        float m = g[0];
#pragma unroll
        for (int r = 1; r < 16; ++r) m = fmaxf(m, g[r]);
        int idx = 64;
#pragma unroll
        for (int r = 15; r >= 0; --r) if (g[r] == m) idx = crow(r, hi);
        const float pm = __shfl_xor(m, 32); const int pidx = __shfl_xor(idx, 32);
        const bool mine = (m > pm) || (m == pm && idx < pidx);
        kbs[round] = (mine ? idx : pidx) & 31;
#pragma unroll
        for (int r = 0; r < 16; ++r) if (mine && crow(r, hi) == idx) g[r] = -INFINITY;
    }
}

template <int THRL, bool OWN> __device__ __forceinline__ void attn_unit(int b, int h, int qb, const bf16* Q, const bf16* __restrict__ K, const bf16* __restrict__ V, bf16* O, const float* ksum, char* shm, bool do_store, const bf16_t* PO, const float* PML) {
    const int tid = threadIdx.x, lane = tid & 63, r32 = lane & 31, hi = lane >> 5; const int wid = __builtin_amdgcn_readfirstlane(tid >> 6);
    const long rowbase = (long)b * SEQ; const int q0 = qb * QB;
    const bf16* Qw = Q + (rowbase + q0 + wid * QBLK) * PITCH + h * D;
    const bf16* Kh = K + rowbase * PITCH + h * D, *Vh = V + rowbase * PITCH + h * D;
    const unsigned lds0 = (unsigned)(uintptr_t)shm;
    float* wsf = (float*)(shm + LDS_WS) + wid * 64;
    const bf16* ksrc = Kh + (long)lane * PITCH + wid * 8;
    const bf16* vsrc = Vh + (long)(16 * (wid & 3) + (lane >> 2)) * PITCH + (wid >> 2) * 32 + (lane & 3) * 8;
    const unsigned kdst = lds0 + LDS_K + wid * 1024, vdst = lds0 + LDS_V + wid * 1024;
    const int NT = OWN ? 4 : (q0 + QB) / KVBLK;
    const int TBASE = OWN ? 4 * qb : 0;
#define TM(t) (OWN ? (t) : (((t) == 0) ? (NT - 4) : (((t) <= NT - 4) ? ((t) - 1) : (t))))
#define DMA_K(t, slot) glds16(ksrc + (long)(TBASE + TM(t)) * KVBLK * PITCH, (unsigned)__builtin_amdgcn_readfirstlane(kdst + (slot)))
#define DMA_V(t, slot) glds16(vsrc + (long)(TBASE + TM(t)) * KVBLK * PITCH, (unsigned)__builtin_amdgcn_readfirstlane(vdst + (slot)))
    const int vb0 = (int)(lds0 + LDS_V) + ((lane >> 4) & 1) * 32 + (lane & 3) * 8 + (4 * hi + ((lane & 15) >> 2)) * 64;
    const char* Kbase = shm + LDS_K; bf16x8 kf[8];
    const lds_cptr shm3 = (lds_cptr)shm; const lds_cptr kp0 = shm3 + LDS_K + hi * 1024 + r32 * 16; const lds_cptr vp0 = shm3 + LDS_V + ((lane >> 4) & 1) * 32 + (lane & 3) * 8 + (4 * hi + ((lane & 15) >> 2)) * 64;
    DMA_K(0, 0); DMA_V(0, 0); DMA_K(1, SLOTB);
    bf16x8 qr[4];
#pragma unroll
    for (int d0 = 0; d0 < 4; ++d0) qr[d0] = *reinterpret_cast<const bf16x8*>(&Qw[(long)r32 * PITCH + d0 * 16 + hi * 8]);
    unsigned selmask = 0u;
    if constexpr (!OWN) {
    if (qb > 0) {
        if (qb <= 3) selmask = (1u << qb) - 1u;
        else { int kbs[3]; gate_top3(ksum + ((size_t)(b * NHEAD + h) * 32) * 64, qr, qb, r32, hi, kbs); selmask = (1u << kbs[0]) | (1u << kbs[1]) | (1u << kbs[2]); }
    } }
    float zf_; asm volatile("v_mov_b32 %0, 0" : "=v"(zf_));
    float mhat = 0.f, l_reg = 0.f; f32x16 o[2]; f32x16 negm;
#pragma unroll
    for (int r = 0; r < 16; ++r) { o[0][r] = zf_; o[1][r] = zf_; negm[r] = zf_; }
    asm volatile("" : "+v"(negm));
    const int qrel = wid * QBLK + r32;
#define MASKT(P0, P1, t) do { const int a_ = TM(t); const int jb_ = a_ - (NT - 4); if (jb_ >= 0) cmask(P0, P1, jb_, qrel, hi); else selapply(P0, P1, ((selmask >> (a_ >> 2)) & 1u) != 0u); } while (0)
    bool resc = false;
#define START(P0, P1) do { const float rm = rowmax(P0, P1); resc = false; \
    { const float dl = rm; mhat = fadd_s(mhat, dl); \
      _Pragma("unroll") for (int r = 0; r < 16; ++r) { P0[r] = fsub_s(P0[r], dl); P1[r] = fsub_s(P1[r], dl); } \
      _Pragma("unroll") for (int r = 0; r < 16; ++r) negm[r] = -mhat; asm volatile("" : "+v"(negm)); } \
    _Pragma("unroll") for (int r = 0; r < 16; ++r) P0[r] = __builtin_amdgcn_exp2f(P0[r]); } while (0)
#define RESC() do { if (resc) { asm volatile("s_waitcnt lgkmcnt(0)" ::: "memory"); \
      _Pragma("unroll") for (int d_ = 0; d_ < 2; ++d_) _Pragma("unroll") for (int r = 0; r < 16; ++r) o[d_][r] *= wsf[crow(r, hi)]; } } while (0)
    f32x16 pA0, pA1, pB0, pB1;
    int sl_prev = 0, sl_cur = 0, sl_next = SLOTB;
#define ROT() do { sl_prev = sl_cur; sl_cur = sl_next; sl_next = (sl_next == (NSLOT - 1) * SLOTB) ? 0 : sl_next + SLOTB; } while (0)
    DMA_K(2, 2 * SLOTB);
    WAIT_BAR(3);
    qkt(pA0, pA1, Kbase, qr, negm, r32, hi); asm volatile("s_nop 15\n\ts_nop 7" : "+v"(pA0), "+v"(pA1)); MASKT(pA0, pA1, 0);
    START(pA0, pA1);
    _Pragma("unroll") for (int r = 0; r < 16; ++r) pA1[r] = __builtin_amdgcn_exp2f(pA1[r]);
    WAIT_BAR(0);
    DMA_K(3, 0); DMA_V(1, SLOTB);
    ROT();
    kload8(kf, kp0 + sl_cur);
    WAIT_BAR(2);
    s16x4 vlo[8], vhi[8]; u32x4 pw0, pw1, pw2, pw3;
#define PKW(P, B) cvtpk_s(P[B], P[B + 1])
#define PAF(k) __builtin_bit_cast(bf16x8, pw##k)
#define VFR(i) (bf16x8){vlo[i][0], vlo[i][1], vlo[i][2], vlo[i][3], vhi[i][0], vhi[i][1], vhi[i][2], vhi[i][3]}
#define PIN(x) asm volatile("" : "+v"(x))
#define MX3(a, b, c) __builtin_fmaxf(__builtin_fmaxf((a), (b)), (c))
#define GAPA(MF, A0, A1, A2, A3, W0, W1, PW) do { MF; sacc += A0; sacc += A1; sacc += A2; sacc += A3; PIN(sacc); W0; W1; PIN(PW); SBAR(); } while (0)
#define EX(v) __builtin_amdgcn_exp2f(v)
#define GAPB(MF, X, B) do { MF; X[B] = EX(X[B]); X[B + 1] = EX(X[B + 1]); X[B + 2] = EX(X[B + 2]); X[B + 3] = EX(X[B + 3]); PIN(X); SBAR(); } while (0)
#define VRD(i) do { vlo[i] = vtr(vp_ + (((i) >> 2) * 4096 + ((i) & 3) * 1024)); vhi[i] = vtr(vp_ + (((i) >> 2) * 4096 + ((i) & 3) * 1024 + 512)); } while (0)
#define KRD(G, j) do { if (G) { kload2(kf, kp0 + sl_next, j); SBAR(); } } while (0)
#define STEP(C0, C1, P0, P1, t, GK, GV, GL) do { SBAR(); \
    const lds_cptr vp_ = vp0 + sl_prev; \
    VRD(0); SBAR(); float sacc = (P0[0] + P0[1]); \
    GAPA(C0 = __builtin_amdgcn_mfma_f32_32x32x16_bf16(kf[0], qr[0], negm, 0, 0, 0), P0[2], P0[3], P0[4], P0[5],     pw0[0] = PKW(P0, 0), pw0[1] = PKW(P0, 2), pw0); \
    VRD(4); SBAR(); GAPA(C1 = __builtin_amdgcn_mfma_f32_32x32x16_bf16(kf[1], qr[0], negm, 0, 0, 0), P0[6], P0[7], P0[8], P0[9],     pw0[2] = PKW(P0, 4), pw0[3] = PKW(P0, 6), pw0); \
    VRD(1); SBAR(); GAPA(C0 = __builtin_amdgcn_mfma_f32_32x32x16_bf16(kf[2], qr[1], C0, 0, 0, 0),   P0[10], P0[11], P0[12], P0[13], pw1[0] = PKW(P0, 8), pw1[1] = PKW(P0, 10), pw1); \
    VRD(5); SBAR(); GAPA(C1 = __builtin_amdgcn_mfma_f32_32x32x16_bf16(kf[3], qr[1], C1, 0, 0, 0),   P0[14], P0[15], P1[0], P1[1],   pw1[2] = PKW(P0, 12), pw1[3] = PKW(P0, 14), pw1); \
    VRD(2); SBAR(); GAPA(C0 = __builtin_amdgcn_mfma_f32_32x32x16_bf16(kf[4], qr[2], C0, 0, 0, 0),   P1[2], P1[3], P1[4], P1[5],     pw2[0] = PKW(P1, 0), pw2[1] = PKW(P1, 2), pw2); \
    VRD(6); SBAR(); GAPA(C1 = __builtin_amdgcn_mfma_f32_32x32x16_bf16(kf[5], qr[2], C1, 0, 0, 0),   P1[6], P1[7], P1[8], P1[9],     pw2[2] = PKW(P1, 4), pw2[3] = PKW(P1, 6), pw2); \
    VRD(3); SBAR(); GAPA(C0 = __builtin_amdgcn_mfma_f32_32x32x16_bf16(kf[6], qr[3], C0, 0, 0, 0),   P1[10], P1[11], P1[12], P1[13], pw3[0] = PKW(P1, 8), pw3[1] = PKW(P1, 10), pw3); \
    VRD(7); SBAR(); GAPA(C1 = __builtin_amdgcn_mfma_f32_32x32x16_bf16(kf[7], qr[3], C1, 0, 0, 0),   P1[14], P1[15], 0.f, 0.f,       pw3[2] = PKW(P1, 12), pw3[3] = PKW(P1, 14), pw3); \
    l_reg += sacc; \
    if (GK) { DMA_K((t) + 3, sl_cur); } if (GV) { DMA_V((t) + 1, sl_next); } \
    MASKT(C0, C1, t); \
    { float a = MX3(C0[0], C0[1], C1[0]), b = MX3(C0[2], C0[3], C1[1]); a = MX3(a, C1[2], C1[3]); \
      _Pragma("unroll") for (int r = 4; r < 16; r += 4) { a = MX3(a, C0[r], C0[r + 1]); b = MX3(b, C0[r + 2], C0[r + 3]); a = MX3(a, C1[r], C1[r + 1]); b = MX3(b, C1[r + 2], C1[r + 3]); } \
      float rm = __builtin_fmaxf(a, b); { auto rr = __builtin_amdgcn_permlane32_swap(__float_as_uint(rm), __float_as_uint(rm), false, false); rm = __builtin_fmaxf(__uint_as_float(rr[0]), __uint_as_float(rr[1])); } \
      resc = false; \
      if (__builtin_expect(__any(rm > (float)THRL), 0)) { const float dl = __builtin_fmaxf(rm, 0.f); mhat += dl; \
        _Pragma("unroll") for (int r = 0; r < 16; ++r) { C0[r] -= dl; C1[r] -= dl; } \
        _Pragma("unroll") for (int r = 0; r < 16; ++r) negm[r] = -mhat; asm volatile("" : "+v"(negm)); \
        const float f = __builtin_amdgcn_exp2f(-dl); l_reg *= f; if (hi == 0) wsf[r32] = f; resc = true; } } \
    SBAR(); \
    GAPB(o[0] = __builtin_amdgcn_mfma_f32_32x32x16_bf16(PAF(0), VFR(0), o[0], 0, 0, 0), C0, 0); \
    GAPB(o[1] = __builtin_amdgcn_mfma_f32_32x32x16_bf16(PAF(0), VFR(4), o[1], 0, 0, 0), C0, 4); \
    KRD(GL, 0); GAPB(o[0] = __builtin_amdgcn_mfma_f32_32x32x16_bf16(PAF(1), VFR(1), o[0], 0, 0, 0), C0, 8); \
    KRD(GL, 1); GAPB(o[1] = __builtin_amdgcn_mfma_f32_32x32x16_bf16(PAF(1), VFR(5), o[1], 0, 0, 0), C0, 12); \
    KRD(GL, 2); GAPB(o[0] = __builtin_amdgcn_mfma_f32_32x32x16_bf16(PAF(2), VFR(2), o[0], 0, 0, 0), C1, 0); \
    KRD(GL, 3); GAPB(o[1] = __builtin_amdgcn_mfma_f32_32x32x16_bf16(PAF(2), VFR(6), o[1], 0, 0, 0), C1, 4); \
    GAPB(o[0] = __builtin_amdgcn_mfma_f32_32x32x16_bf16(PAF(3), VFR(3), o[0], 0, 0, 0), C1, 8); \
    GAPB(o[1] = __builtin_amdgcn_mfma_f32_32x32x16_bf16(PAF(3), VFR(7), o[1], 0, 0, 0), C1, 12); \
    } while (0)
    int t = 1;
    for (; t + 5 < NT; t += 2) {
        STEP(pB0, pB1, pA0, pA1, t, true, true, true);     WAIT_BAR(2); RESC(); ROT();
        STEP(pA0, pA1, pB0, pB1, t + 1, true, true, true); WAIT_BAR(2); RESC(); ROT();
    }
#define ENDW(tt) do { if ((tt) + 3 < NT) { WAIT_BAR(2); } else if ((tt) + 2 < NT) { WAIT_BAR(1); } else { WAIT_BAR(0); } } while (0)
    for (; t + 1 < NT; t += 2) {
        STEP(pB0, pB1, pA0, pA1, t, (t + 3 < NT), (t + 1 < NT), (t + 1 < NT));       ENDW(t);     RESC(); ROT();
        STEP(pA0, pA1, pB0, pB1, t + 1, (t + 4 < NT), (t + 2 < NT), (t + 2 < NT));   ENDW(t + 1); RESC(); ROT();
    }
    STEP(pB0, pB1, pA0, pA1, NT - 1, false, false, false); RESC();
    { float sacc = pB0[0] + pB0[1]; _Pragma("unroll") for (int r = 2; r < 16; ++r) sacc += pB0[r]; _Pragma("unroll") for (int r = 0; r < 16; ++r) sacc += pB1[r]; l_reg += sacc;
      pw0 = (u32x4){PKW(pB0, 0), PKW(pB0, 2), PKW(pB0, 4), PKW(pB0, 6)}; pw1 = (u32x4){PKW(pB0, 8), PKW(pB0, 10), PKW(pB0, 12), PKW(pB0, 14)}; pw2 = (u32x4){PKW(pB1, 0), PKW(pB1, 2), PKW(pB1, 4), PKW(pB1, 6)}; pw3 = (u32x4){PKW(pB1, 8), PKW(pB1, 10), PKW(pB1, 12), PKW(pB1, 14)};
      SBAR(); pv(o, vb0 + sl_cur, PAF(0), PAF(1), PAF(2), PAF(3)); }
#undef PKW
#undef PAF
#undef VFR
#undef PIN
#undef MX3
#undef GAPA
#undef GAPB
#undef EX
#undef VRD
#undef KRD
#undef STEP
#undef ENDW
    { auto rr = __builtin_amdgcn_permlane32_swap(__float_as_uint(l_reg), __float_as_uint(l_reg), false, false); l_reg = __uint_as_float(rr[0]) + __uint_as_float(rr[1]); }
    if (hi == 0) { wsf[32 + r32] = l_reg; if (OWN) wsf[r32] = mhat; } asm volatile("s_waitcnt lgkmcnt(0)" ::: "memory");
    float rli[16];
#pragma unroll
    for (int r = 0; r < 16; ++r) rli[r] = __builtin_amdgcn_rcpf(wsf[32 + crow(r, hi)]);
    bf16* Ow = O + (rowbase + q0 + wid * QBLK) * PITCH + h * D;
    { bf16* stg = (bf16*)(shm + LDS_OST) + wid * 2048;
#pragma unroll
      for (int r = 0; r < 16; ++r) { const int orow = crow(r, hi);
#pragma unroll
        for (int d0 = 0; d0 < 2; ++d0) stg[orow * 64 + d0 * 32 + r32] = __float2bfloat16(o[d0][r] * rli[r]); }
      asm volatile("s_waitcnt lgkmcnt(0)" ::: "memory");
      const int nsel = qb < 3 ? qb : 3;
      f32x2 mlq[4][3]; u32x4 ppq[4][3];
      if constexpr (OWN) { if (nsel > 0) {
#pragma unroll
        for (int i = 0; i < 4; ++i) { const int row = i * 8 + (lane >> 3), ch = lane & 7; const size_t e0 = (((size_t)(b * NHEAD + h)) * SEQ + q0 + wid * QBLK + row) * 3;
#pragma unroll
          for (int s_ = 0; s_ < 3; ++s_) { const size_t e_ = e0 + (s_ < nsel ? s_ : 0); mlq[i][s_] = *(const f32x2*)(PML + e_ * 2); ppq[i][s_] = *(const u32x4*)(PO + e_ * 64 + ch * 8); } } } }
#pragma unroll
      for (int i = 0; i < 4; ++i) { const int row = i * 8 + (lane >> 3), ch = lane & 7; u32x4 v = *(const u32x4*)(stg + row * 64 + ch * 8);
        if constexpr (OWN) {
          if (nsel > 0) {
            const float mo = wsf[row], lo = wsf[32 + row];
            float ms[3], ls[3]; u32x4 pp[3]; float M = mo;
#pragma unroll
            for (int s_ = 0; s_ < 3; ++s_) { const bool ok_ = s_ < nsel; ms[s_] = ok_ ? mlq[i][s_].x : -INFINITY; ls[s_] = ok_ ? mlq[i][s_].y : 0.f; pp[s_] = ppq[i][s_]; M = fmaxf(M, ms[s_]); }
            const float wo = lo * __builtin_amdgcn_exp2f(mo - M); float W = wo;
            float a[8] = {bflo(v.x) * wo, bfhi(v.x) * wo, bflo(v.y) * wo, bfhi(v.y) * wo, bflo(v.z) * wo, bfhi(v.z) * wo, bflo(v.w) * wo, bfhi(v.w) * wo};
#pragma unroll
            for (int s_ = 0; s_ < 3; ++s_) { const float w_ = (s_ < nsel) ? ls[s_] * __builtin_amdgcn_exp2f(ms[s_] - M) : 0.f; W += w_;
              a[0] += w_ * bflo(pp[s_].x); a[1] += w_ * bfhi(pp[s_].x); a[2] += w_ * bflo(pp[s_].y); a[3] += w_ * bfhi(pp[s_].y); a[4] += w_ * bflo(pp[s_].z); a[5] += w_ * bfhi(pp[s_].z); a[6] += w_ * bflo(pp[s_].w); a[7] += w_ * bfhi(pp[s_].w); }
            const float iw = 1.0f / W;
            v.x = cvtpk_s(a[0] * iw, a[1] * iw); v.y = cvtpk_s(a[2] * iw, a[3] * iw); v.z = cvtpk_s(a[4] * iw, a[5] * iw); v.w = cvtpk_s(a[6] * iw, a[7] * iw);
          } }
        if (do_store) *(u32x4*)(Ow + (long)row * PITCH + ch * 8) = v; } }
    asm volatile("s_waitcnt lgkmcnt(0)\n\ts_barrier" ::: "memory");
#undef DMA_K
#undef DMA_V
#undef TM
#undef MASKT
#undef START
#undef RESC
#undef ROT
}

__device__ __forceinline__ void select_units(int b, int h, const int (&qbs)[4], const bf16* Q, const float* ksum, unsigned short* LIST, unsigned* CNT, char* shm) {
    const int tid = threadIdx.x, lane = tid & 63, r32 = lane & 31, hi = lane >> 5; const int wid = __builtin_amdgcn_readfirstlane(tid >> 6);
    LAS unsigned* hist = (LAS unsigned*)shm; LAS unsigned* basev = hist + 128;
    if (tid < 128) hist[tid] = 0u;
    __syncthreads();
    int kbs[4][3]; unsigned pos[4][3];
    bf16x8 qrs[4][4]; u32x4 kw[4];
#pragma unroll
    for (int u = 0; u < 4; ++u) { const bf16* Qw = Q + ((long)b * SEQ + qbs[u] * QB + wid * QBLK) * PITCH + h * D;
#pragma unroll
        for (int d0 = 0; d0 < 4; ++d0) qrs[u][d0] = *reinterpret_cast<const bf16x8*>(&Qw[(long)r32 * PITCH + d0 * 16 + hi * 8]); }
    { const float* km = ksum + ((size_t)(b * NHEAD + h) * 32) * 64 + (size_t)r32 * 64 + hi * 8;
#pragma unroll
      for (int d0 = 0; d0 < 4; ++d0) { const f32x4 a = *(const f32x4*)(km + d0 * 16), c = *(const f32x4*)(km + d0 * 16 + 4);
          kw[d0].x = cvtpk_s(a[0], a[1]); kw[d0].y = cvtpk_s(a[2], a[3]); kw[d0].z = cvtpk_s(c[0], c[1]); kw[d0].w = cvtpk_s(c[2], c[3]); } }
#pragma unroll
    for (int u = 0; u < 4; ++u) { const int qb = qbs[u]; kbs[u][0] = 0; kbs[u][1] = 1; kbs[u][2] = 2; pos[u][0] = pos[u][1] = pos[u][2] = 0u;
        const int ns = qb < 3 ? qb : 3;
        if (qb > 3) gate_top3w(kw, qrs[u], qb, r32, hi, kbs[u]);
        if (hi == 0) {
#pragma unroll
            for (int s_ = 0; s_ < 3; ++s_) if (s_ < ns) pos[u][s_] = __hip_atomic_fetch_add(hist + u * 32 + kbs[u][s_], 1u, __ATOMIC_RELAXED, __HIP_MEMORY_SCOPE_WORKGROUP);
        }
    }
    __syncthreads();
    const int bh = b * NHEAD + h;
    if (tid < 32) { const unsigned n0 = hist[tid], n1 = hist[32 + tid], n2 = hist[64 + tid], n3 = hist[96 + tid], n = n0 + n1 + n2 + n3;
        const unsigned base = n ? __hip_atomic_fetch_add(CNT + bh * 32 + tid, n, __ATOMIC_RELAXED, __HIP_MEMORY_SCOPE_AGENT) : 0u;
        basev[tid] = base; basev[32 + tid] = base + n0; basev[64 + tid] = base + n0 + n1; basev[96 + tid] = base + n0 + n1 + n2; }
    __syncthreads();
    if (hi == 0) {
#pragma unroll
        for (int u = 0; u < 4; ++u) { const int qb = qbs[u]; const int ns = qb < 3 ? qb : 3; const unsigned qv = (unsigned)(qb * QB + wid * QBLK + r32) << 2;
#pragma unroll
            for (int s_ = 0; s_ < 3; ++s_) if (s_ < ns) LIST[(size_t)(bh * 32 + kbs[u][s_]) * 8192 + basev[u * 32 + kbs[u][s_]] + pos[u][s_]] = (unsigned short)(qv | (unsigned)s_); } }
    __syncthreads();
}

constexpr int G_K = 0, G_V = 32768, G_WS = 65536, G_OST = G_WS + NW * 512, G_TAB = G_OST + NW * 4096, G_BYTES = G_TAB + 8256 + 4096 + 4104;
template <int THRL> __device__ __forceinline__ void gather_phase(char* shm, const bf16* Q, const bf16* __restrict__ K, const bf16* __restrict__ V, const unsigned short* LIST, unsigned* CNT, bf16_t* PO, float* PML, int vcu, int G, bool do_store) {
    const int tid = threadIdx.x, lane = tid & 63, r32 = lane & 31, hi = lane >> 5; const int wid = __builtin_amdgcn_readfirstlane(tid >> 6);
    LAS int* pre = (LAS int*)(shm + G_TAB); LAS int* wtot = pre + 1032; LAS int* cntl = (LAS int*)(shm + G_TAB + 8256); LAS int* prw = (LAS int*)(shm + G_TAB + 8256 + 4096);
    constexpr int WL = 24, WP = 20;
    {
        const int c0 = (int)__hip_atomic_load(CNT + 2 * tid, __ATOMIC_RELAXED, __HIP_MEMORY_SCOPE_AGENT), c1 = (int)__hip_atomic_load(CNT + 2 * tid + 1, __ATOMIC_RELAXED, __HIP_MEMORY_SCOPE_AGENT);
        const int n0 = (c0 + 255) >> 8, n1 = (c1 + 255) >> 8, sm = n0 + n1;
        const int w0 = c0 ? WL + (n0 - 1) * WP + 12 + ((c0 - 256 * (n0 - 1) + 31) >> 5) : 0, w1 = c1 ? WL + (n1 - 1) * WP + 12 + ((c1 - 256 * (n1 - 1) + 31) >> 5) : 0, sw = w0 + w1;
        int v = sm, vw = sw;
#pragma unroll
        for (int o_ = 1; o_ < 64; o_ <<= 1) { const int t_ = __shfl_up(v, o_), tw_ = __shfl_up(vw, o_); if (lane >= o_) { v += t_; vw += tw_; } }
        if (lane == 63) { wtot[wid] = v; wtot[8 + wid] = vw; }
        cntl[2 * tid] = c0; cntl[2 * tid + 1] = c1;
        __syncthreads();
        int off = 0, offw = 0;
        for (int w_ = 0; w_ < wid; ++w_) { off += wtot[w_]; offw += wtot[8 + w_]; }
        const int excl = off + v - sm, exclw = offw + vw - sw;
        pre[2 * tid] = excl; pre[2 * tid + 1] = excl + n0; prw[2 * tid] = exclw; prw[2 * tid + 1] = exclw + w0;
        if (tid == NW * 64 - 1) { pre[1024] = excl + sm; prw[1024] = exclw + sw; }
        __syncthreads();
    }
    const int Wtot = __builtin_amdgcn_readfirstlane(prw[1024]);
    int ub[2], istart = 0;
#pragma unroll
    for (int e_ = 0; e_ < 2; ++e_) { const int tgt = (int)(((long)Wtot * (vcu + e_)) / G);
        int lo_ = 0, hi_ = 1024;
        while (hi_ - lo_ > 1) { const int mid = (lo_ + hi_) >> 1; if (__builtin_amdgcn_readfirstlane(prw[mid]) <= tgt) lo_ = mid; else hi_ = mid; }
        const int npi = __builtin_amdgcn_readfirstlane(pre[lo_ + 1]) - __builtin_amdgcn_readfirstlane(pre[lo_]);
        int p_ = (tgt - __builtin_amdgcn_readfirstlane(prw[lo_]) - WL + WP / 2) / WP; p_ = p_ < 0 ? 0 : (p_ > npi ? npi : p_);
        ub[e_] = (vcu + e_ >= G) ? __builtin_amdgcn_readfirstlane(pre[1024]) : __builtin_amdgcn_readfirstlane(pre[lo_]) + p_;
        if (e_ == 0 && vcu != 0) istart = lo_; }
    const int ulo = (vcu == 0) ? 0 : ub[0], uhi = ub[1];
    const unsigned lds0 = (unsigned)(uintptr_t)shm;
    float* wsf = (float*)(shm + G_WS) + wid * 128; int* ent = (int*)(wsf + 64);
    const unsigned kdst = lds0 + G_K + wid * 1024, vdst = lds0 + G_V + wid * 1024;
    const int vb0 = (int)(lds0 + G_V) + ((lane >> 4) & 1) * 32 + (lane & 3) * 8 + (4 * hi + ((lane & 15) >> 2)) * 64;
    int it0 = istart, it1 = istart, it2 = istart, cur = -1;
#define G_ITEM(itv, uu) do { while ((uu) < uhi && __builtin_amdgcn_readfirstlane(pre[(itv) + 1]) <= (uu)) ++(itv); } while (0)
#define G_ENTRY(itv, uu) ({ const int ps_ = (uu) - __builtin_amdgcn_readfirstlane(pre[itv]), cn_ = __builtin_amdgcn_readfirstlane(cntl[itv]); const int li_ = ps_ * 256 + wid * QBLK + r32; \
        (unsigned)LIST[(size_t)(itv) * 8192 + (li_ < cn_ ? li_ : 0)] | ((li_ < cn_) ? 0x10000u : 0u); })
#define G_QLOAD(dst, itv, ee) do { const int bh_ = (itv) >> 5; const bf16* Qrow_ = Q + ((long)(bh_ >> 3) * SEQ + (int)(((ee) & 0xffffu) >> 2)) * PITCH + (bh_ & 7) * D; \
        _Pragma("unroll") for (int d0 = 0; d0 < 4; ++d0) dst[d0] = *reinterpret_cast<const bf16x8*>(Qrow_ + d0 * 16 + hi * 8); } while (0)
    unsigned e0 = 0u, e1 = 0u, e2 = 0u; bf16x8 qr[4], qn[4];
    if (ulo < uhi) { G_ITEM(it0, ulo); e0 = G_ENTRY(it0, ulo); it1 = it0; { const int u1_ = (ulo + 1 < uhi) ? ulo + 1 : uhi - 1; G_ITEM(it1, u1_); e1 = G_ENTRY(it1, u1_); } G_QLOAD(qr, it0, e0); }
    it2 = it1;
    for (int u = ulo; u < uhi; ++u) {
        { const int u2_ = (u + 2 < uhi) ? u + 2 : uhi - 1; G_ITEM(it2, u2_); e2 = G_ENTRY(it2, u2_); }
        const int item = it0;
        const int bh = item >> 5, kb = item & 31, b = bh >> 3, h = bh & 7;
        if (item != cur) {
            asm volatile("s_waitcnt lgkmcnt(0)\n\ts_barrier" ::: "memory");
            const bf16* Kh = K + (long)b * SEQ * PITCH + h * D, *Vh = V + (long)b * SEQ * PITCH + h * D;
            const bf16* ksrc = Kh + (long)lane * PITCH + wid * 8;
            const bf16* vsrc = Vh + (long)(16 * (wid & 3) + (lane >> 2)) * PITCH + (wid >> 2) * 32 + (lane & 3) * 8;
#pragma unroll
            for (int t = 0; t < 4; ++t) { glds16(ksrc + (long)(4 * kb + t) * KVBLK * PITCH, (unsigned)__builtin_amdgcn_readfirstlane(kdst + t * 8192)); glds16(vsrc + (long)(4 * kb + t) * KVBLK * PITCH, (unsigned)__builtin_amdgcn_readfirstlane(vdst + t * 8192)); }
            asm volatile("s_waitcnt vmcnt(0)\n\ts_barrier" ::: "memory");
            cur = item;
            if (wid >= 4) __builtin_amdgcn_s_sleep(10);
        }
        G_QLOAD(qn, it1, e1);
        const bool valid = (e0 & 0x10000u) != 0u;
        const int q = (int)((e0 & 0xffffu) >> 2), slot = (int)(e0 & 3u);
        const bool wave_has_rows = __builtin_amdgcn_readfirstlane((int)(e0 >> 16) & 1) != 0 || __any(valid);
        if (wave_has_rows) {
        float mhat = 0.f, l_reg = 0.f; f32x16 o[2]; f32x16 negm;
#pragma unroll
        for (int r = 0; r < 16; ++r) { o[0][r] = 0.f; o[1][r] = 0.f; negm[r] = 0.f; }
        const lds_cptr kp0 = (lds_cptr)shm + G_K + hi * 1024 + r32 * 16; const lds_cptr vp0 = (lds_cptr)shm + G_V + ((lane >> 4) & 1) * 32 + (lane & 3) * 8 + (4 * hi + ((lane & 15) >> 2)) * 64;
        bf16x8 kf[8]; f32x16 p0, p1, s0, s1;
#define G_QK(D0, D1) do { D0 = __builtin_amdgcn_mfma_f32_32x32x16_bf16(kf[0], qr[0], negm, 0, 0, 0); D1 = __builtin_amdgcn_mfma_f32_32x32x16_bf16(kf[1], qr[0], negm, 0, 0, 0); \
            D0 = __builtin_amdgcn_mfma_f32_32x32x16_bf16(kf[2], qr[1], D0, 0, 0, 0); D1 = __builtin_amdgcn_mfma_f32_32x32x16_bf16(kf[3], qr[1], D1, 0, 0, 0); \
            D0 = __builtin_amdgcn_mfma_f32_32x32x16_bf16(kf[4], qr[2], D0, 0, 0, 0); D1 = __builtin_amdgcn_mfma_f32_32x32x16_bf16(kf[5], qr[2], D1, 0, 0, 0); \
            D0 = __builtin_amdgcn_mfma_f32_32x32x16_bf16(kf[6], qr[3], D0, 0, 0, 0); D1 = __builtin_amdgcn_mfma_f32_32x32x16_bf16(kf[7], qr[3], D1, 0, 0, 0); } while (0)
#define G_MX(D0, D1, FIRST) do { float a_ = fmaxf(fmaxf(D0[0], D0[1]), D1[0]), c_ = fmaxf(fmaxf(D0[2], D0[3]), D1[1]); a_ = fmaxf(fmaxf(a_, D1[2]), D1[3]); \
            _Pragma("unroll") for (int r = 4; r < 16; r += 4) { a_ = fmaxf(fmaxf(a_, D0[r]), D0[r + 1]); c_ = fmaxf(fmaxf(c_, D0[r + 2]), D0[r + 3]); a_ = fmaxf(fmaxf(a_, D1[r]), D1[r + 1]); c_ = fmaxf(fmaxf(c_, D1[r + 2]), D1[r + 3]); } \
            float rm_ = fmaxf(a_, c_); { auto rr_ = __builtin_amdgcn_permlane32_swap(__float_as_uint(rm_), __float_as_uint(rm_), false, false); rm_ = fmaxf(__uint_as_float(rr_[0]), __uint_as_float(rr_[1])); } \
            if (FIRST) { mhat = rm_; _Pragma("unroll") for (int r = 0; r < 16; ++r) { D0[r] -= rm_; D1[r] -= rm_; negm[r] = -mhat; } } \
            else if (__any(rm_ > (float)THRL)) { const float dl_ = fmaxf(rm_, 0.f); mhat += dl_; \
                _Pragma("unroll") for (int r = 0; r < 16; ++r) { D0[r] -= dl_; D1[r] -= dl_; negm[r] = -mhat; } \
                const float f_ = __builtin_amdgcn_exp2f(-dl_); l_reg *= f_; if (hi == 0) wsf[r32] = f_; \
                asm volatile("s_waitcnt lgkmcnt(0)" ::: "memory"); \
                _Pragma("unroll") for (int d_ = 0; d_ < 2; ++d_) _Pragma("unroll") for (int r = 0; r < 16; ++r) o[d_][r] *= wsf[crow(r, hi)]; } } while (0)
        const bool run_tiles = (GPROBE == 1) ? do_store : true;
        if (run_tiles) {
        kload8(kf, kp0);
        G_QK(p0, p1);
        kload8(kf, kp0 + 8192);
        G_MX(p0, p1, true);
#pragma unroll
        for (int t = 0; t < 4; ++t) {
            if (t < 3) { __builtin_amdgcn_sched_barrier(0); G_QK(s0, s1); if (t < 2) kload8(kf, kp0 + (t + 2) * 8192); }
            s16x4 vlo[8], vhi[8];
            const lds_cptr vp_ = vp0 + t * 8192;
#pragma unroll
            for (int i = 0; i < 8; ++i) { vlo[i] = vtr(vp_ + ((i >> 2) * 4096 + (i & 3) * 1024)); vhi[i] = vtr(vp_ + ((i >> 2) * 4096 + (i & 3) * 1024 + 512)); }
            __builtin_amdgcn_sched_barrier(0);
            float sacc = 0.f;
#pragma unroll
            for (int r = 0; r < 16; ++r) { p0[r] = __builtin_amdgcn_exp2f(p0[r]); p1[r] = __builtin_amdgcn_exp2f(p1[r]); sacc += p0[r] + p1[r]; }
            l_reg += sacc;
            const u32x4 pw0 = {cvtpk_s(p0[0], p0[1]), cvtpk_s(p0[2], p0[3]), cvtpk_s(p0[4], p0[5]), cvtpk_s(p0[6], p0[7])}, pw1 = {cvtpk_s(p0[8], p0[9]), cvtpk_s(p0[10], p0[11]), cvtpk_s(p0[12], p0[13]), cvtpk_s(p0[14], p0[15])};
            const u32x4 pw2 = {cvtpk_s(p1[0], p1[1]), cvtpk_s(p1[2], p1[3]), cvtpk_s(p1[4], p1[5]), cvtpk_s(p1[6], p1[7])}, pw3 = {cvtpk_s(p1[8], p1[9]), cvtpk_s(p1[10], p1[11]), cvtpk_s(p1[12], p1[13]), cvtpk_s(p1[14], p1[15])};
            __builtin_amdgcn_sched_barrier(0);
#define G_VF(i) (bf16x8){vlo[i][0], vlo[i][1], vlo[i][2], vlo[i][3], vhi[i][0], vhi[i][1], vhi[i][2], vhi[i][3]}
            if (GPROBE == 2 && !do_store) { asm volatile("" :: "v"(pw0), "v"(pw1), "v"(pw2), "v"(pw3)); } else {
            o[0] = __builtin_amdgcn_mfma_f32_32x32x16_bf16(__builtin_bit_cast(bf16x8, pw0), G_VF(0), o[0], 0, 0, 0); o[1] = __builtin_amdgcn_mfma_f32_32x32x16_bf16(__builtin_bit_cast(bf16x8, pw0), G_VF(4), o[1], 0, 0, 0);
            o[0] = __builtin_amdgcn_mfma_f32_32x32x16_bf16(__builtin_bit_cast(bf16x8, pw1), G_VF(1), o[0], 0, 0, 0); o[1] = __builtin_amdgcn_mfma_f32_32x32x16_bf16(__builtin_bit_cast(bf16x8, pw1), G_VF(5), o[1], 0, 0, 0);
            o[0] = __builtin_amdgcn_mfma_f32_32x32x16_bf16(__builtin_bit_cast(bf16x8, pw2), G_VF(2), o[0], 0, 0, 0); o[1] = __builtin_amdgcn_mfma_f32_32x32x16_bf16(__builtin_bit_cast(bf16x8, pw2), G_VF(6), o[1], 0, 0, 0);
            o[0] = __builtin_amdgcn_mfma_f32_32x32x16_bf16(__builtin_bit_cast(bf16x8, pw3), G_VF(3), o[0], 0, 0, 0); o[1] = __builtin_amdgcn_mfma_f32_32x32x16_bf16(__builtin_bit_cast(bf16x8, pw3), G_VF(7), o[1], 0, 0, 0);
            }
#undef G_VF
            if (t < 3) { G_MX(s0, s1, false); p0 = s0; p1 = s1; }
        }
        }
#undef G_QK
#undef G_MX
        { auto rr = __builtin_amdgcn_permlane32_swap(__float_as_uint(l_reg), __float_as_uint(l_reg), false, false); l_reg = __uint_as_float(rr[0]) + __uint_as_float(rr[1]); }
        const int er = valid ? (q * 3 + slot) : -1;
        if (hi == 0) { wsf[32 + r32] = l_reg; ent[r32] = er; } asm volatile("s_waitcnt lgkmcnt(0)" ::: "memory");
        float rli[16];
#pragma unroll
        for (int r = 0; r < 16; ++r) rli[r] = __builtin_amdgcn_rcpf(wsf[32 + crow(r, hi)]);
        bf16* stg = (bf16*)(shm + G_OST) + wid * 2048;
#pragma unroll
        for (int r = 0; r < 16; ++r) { const int orow = crow(r, hi);
#pragma unroll
            for (int d0 = 0; d0 < 2; ++d0) stg[orow * 64 + d0 * 32 + r32] = __float2bfloat16(o[d0][r] * rli[r]); }
        asm volatile("s_waitcnt lgkmcnt(0)" ::: "memory");
        const size_t ebase = (size_t)bh * SEQ * 3;
#pragma unroll
        for (int i = 0; i < 4; ++i) { const int row = i * 8 + (lane >> 3), ch = lane & 7; const u32x4 v = *(const u32x4*)(stg + row * 64 + ch * 8); const int er_ = ent[row];
            if (er_ >= 0 && do_store) *(u32x4*)(PO + (ebase + er_) * 64 + ch * 8) = v; }
        if (hi == 0 && valid && do_store) *(f32x2*)(PML + (ebase + er) * 2) = (f32x2){mhat, l_reg};
        asm volatile("s_waitcnt lgkmcnt(0)" ::: "memory");
        }
        e0 = e1; e1 = e2; it0 = it1; it1 = it2;
#pragma unroll
        for (int d0 = 0; d0 < 4; ++d0) qr[d0] = qn[d0];
    }
    asm volatile("s_waitcnt vmcnt(0) lgkmcnt(0)\n\ts_barrier" ::: "memory");
#undef G_ITEM
#undef G_ENTRY
#undef G_QLOAD
}
#undef SBAR
#undef WAIT_BAR
}

#define XB_TMO      128
#define XB_XCNT(j)  (256  + 64 * (j))
#define XB_XSUB(j)  (1280 + 64 * (j))
#define XB_XGEN(j)  (2304 + 64 * (j))
#define XB_TOP      3328
#define XB_TOPGEN   3392
#define XCD_BAR_WORDS 3456
#define XB_SPIN_CAP (1u << 18)
__device__ __forceinline__ unsigned xb_ld(unsigned* p)              { return __hip_atomic_load(p, __ATOMIC_RELAXED, __HIP_MEMORY_SCOPE_AGENT); }
__device__ __forceinline__ unsigned xb_add(unsigned* p, unsigned v) { return __hip_atomic_fetch_add(p, v, __ATOMIC_RELAXED, __HIP_MEMORY_SCOPE_AGENT); }
__device__ __forceinline__ unsigned xb_xcc_id() { return (unsigned)__builtin_amdgcn_s_getreg((3 << 11) | 20) & 0xFu; }
#define XB_SPIN(cond, bar) do { unsigned _sp = 0; while (cond) { __builtin_amdgcn_s_sleep(1); \
    if ((++_sp & 255u) == 0u) { if (xb_ld(&(bar)[XB_TMO])) break; if (_sp > XB_SPIN_CAP) { atomicAdd(&(bar)[XB_TMO], 1u); break; } } } } while (0)
struct XcdBarrier { unsigned* bar; unsigned x; volatile LAS unsigned* st; };
__device__ __forceinline__ XcdBarrier xcd_barrier_post(unsigned* bar, volatile LAS unsigned* st) {
    XcdBarrier b; b.bar = bar; b.x = xb_xcc_id(); b.st = st;
    if (threadIdx.x == 0) (void)xb_add(&bar[XB_XCNT(b.x)], 1u);
    return b;
}
__device__ __forceinline__ void xcd_barrier_complete(unsigned* bar, unsigned x, unsigned& nloc, unsigned& nx) {
    const unsigned G = gridDim.x * gridDim.y * gridDim.z;
    unsigned sum, cnt, mine, sp = 0u;
    for (;;) {
        sum = 0u; cnt = 0u; mine = 0u;
#pragma unroll
        for (unsigned j = 0; j < 16; ++j) { const unsigned c = xb_ld(&bar[XB_XCNT(j)]); sum += c; cnt += (c > 0u) ? 1u : 0u; mine = (j == x) ? c : mine; }
        if (sum == G) break;
        __builtin_amdgcn_s_sleep(1);
        if ((++sp & 255u) == 0u) { if (xb_ld(&bar[XB_TMO])) break; if (sp > XB_SPIN_CAP) { atomicAdd(&bar[XB_TMO], 1u); break; } }
    }
    nloc = mine > 0u ? mine : 1u; nx = cnt > 0u ? cnt : 1u;
}
__device__ __forceinline__ void xcd_barrier_(const XcdBarrier& b);
__device__ __forceinline__ void xcd_barrier(const XcdBarrier& b) { T_BEGIN(1, t1_) xcd_barrier_(b); T_END(1, t1_); }
__device__ __forceinline__ void xcd_barrier_(const XcdBarrier& b) {
    asm volatile("s_waitcnt vmcnt(0)" ::: "memory");
    __syncthreads();
    if (threadIdx.x == 0) {
        unsigned* bar = b.bar;
        __builtin_amdgcn_s_waitcnt(0);
        unsigned nloc = b.st[0], nx = b.st[1];
        if (nloc == 0u) { xcd_barrier_complete(bar, b.x, nloc, nx); b.st[0] = nloc; b.st[1] = nx; }
        const unsigned old = xb_add(&bar[XB_XSUB(b.x)], 1u);
        const unsigned gen = old / nloc;
        if (old + 1u == (gen + 1u) * nloc) {
            __builtin_amdgcn_fence(__ATOMIC_RELEASE, "agent");
            asm volatile("s_waitcnt vmcnt(0)" ::: "memory");
            const unsigned og = xb_add(&bar[XB_TOP], 1u);
            const unsigned tg = og / nx;
            if (og + 1u == (tg + 1u) * nx) xb_add(&bar[XB_TOPGEN], 1u);
            else XB_SPIN(xb_ld(&bar[XB_TOPGEN]) == tg, bar);
            __builtin_amdgcn_fence(__ATOMIC_ACQUIRE, "agent");
            xb_add(&bar[XB_XGEN(b.x)], 1u);
            asm volatile("s_waitcnt vmcnt(0)" ::: "memory");
        } else {
            XB_SPIN(xb_ld(&bar[XB_XGEN(b.x)]) == gen, bar);
            __builtin_amdgcn_fence(__ATOMIC_ACQUIRE, "agent");
            asm volatile("s_waitcnt vmcnt(0)" ::: "memory");
        }
    }
    __syncthreads();
}

struct Args { const float* in[22]; float* out; unsigned char* ws; int ph_lo, ph_hi, li, flags; };
struct Frame {
    LAS unsigned char* lds; volatile LAS unsigned* MISC; gu32* ctl;
    int tid, lane, wave, vcu, G;
};
#ifndef SKEW_P2
#define SKEW_P2 0
#endif
#ifndef SKEW_P45
#define SKEW_P45 0
#endif
__device__ __forceinline__ void phase_skew(int vcu, unsigned ticks) {
    if (ticks) { const unsigned long long t0 = __builtin_amdgcn_s_memrealtime(), d = (unsigned long long)(vcu & 7) * ticks;
        while (__builtin_amdgcn_s_memrealtime() - t0 < d) __builtin_amdgcn_s_sleep(8); }
}
__device__ __forceinline__ void st_wt16(void* p, u32x4 v) { asm volatile("global_store_dwordx4 %0, %1, off sc1\n\ts_nop 1" :: "v"(p), "v"(v) : "memory"); }
__device__ __forceinline__ void st_wt8(void* p, u32x2 v) { asm volatile("global_store_dwordx2 %0, %1, off sc1\n\ts_nop 1" :: "v"(p), "v"(v) : "memory"); }
__device__ __forceinline__ int fresh_tid() { int t = threadIdx.x; asm volatile("" : "+v"(t)); return t; }
#define PHASE_IDS() do { F.tid = fresh_tid(); F.lane = F.tid & 63; F.wave = __builtin_amdgcn_readfirstlane(F.tid >> 6); } while (0)

template <bool NT = false>
__device__ __forceinline__ void transpose_item(const float* W, int ldw, int k0, int n0, bf16_t* WT, size_t row_off, int Kd, LAS float* scr, int lane) {
    const int qr_ = lane >> 4, j4 = 4 * (lane & 15);
#pragma unroll
    for (int i = 0; i < 16; ++i) { const int kk = 4 * i + qr_; const f32x4* gp_ = (const f32x4*)(W + (size_t)(k0 + kk) * ldw + n0 + j4); const f32x4 v = NT ? __builtin_nontemporal_load(gp_) : *gp_; LAS float* d = scr + kk * 65 + j4; d[0] = v.x; d[1] = v.y; d[2] = v.z; d[3] = v.w; }
    LDS_WAIT(); asm volatile("" ::: "memory");
    const int c = lane & 7;
#pragma unroll
    for (int j = 0; j < 8; ++j) { const int n = (lane >> 3) + 8 * j; const LAS float* s = scr + (8 * c) * 65 + n;
        u32x4 o; o.x = cvt_pk_bf16(s[0 * 65], s[1 * 65]); o.y = cvt_pk_bf16(s[2 * 65], s[3 * 65]); o.z = cvt_pk_bf16(s[4 * 65], s[5 * 65]); o.w = cvt_pk_bf16(s[6 * 65], s[7 * 65]);
        *(u32x4*)(WT + (row_off + n0 + n) * (size_t)Kd + k0 + 8 * c) = o; }
    LDS_WAIT(); asm volatile("" ::: "memory");
}

__global__ void __launch_bounds__(NWAVES * 64, 2) hybrid_fwd(Args args) {
    extern __shared__ __attribute__((aligned(16))) unsigned char lds_raw[];
    CODE_PAD();
    Frame F;
    F.lds = (LAS unsigned char*)lds_raw;
    F.MISC = (volatile LAS unsigned*)(F.lds + MISC_OFF);
    F.tid = threadIdx.x; F.lane = F.tid & 63; F.wave = __builtin_amdgcn_readfirstlane(F.tid >> 6);
    F.G = gridDim.x; { const int bx = blockIdx.x; F.vcu = (F.G % 8 == 0) ? (bx % 8) * (F.G / 8) + bx / 8 : bx; }
    unsigned char* ws = args.ws;
    F.ctl = (gu32*)(ws + WS_CTL);
    const float* x = args.in[0]; const float* cvec = args.in[1]; const float* ada_w = args.in[2]; const float* ada_b = args.in[3];
    const float* norm1_g = args.in[4]; const float* norm2_g = args.in[5]; const float* w_in = args.in[6]; const float* gmlp_ln_g = args.in[7]; const float* gmlp_ln_b = args.in[8];
    const float* w_spatial = args.in[9]; const float* b_spatial = args.in[10]; const float* w_branch_a = args.in[11]; const float* w_branch_b = args.in[12]; const float* w_out = args.in[13];
    const float* w_rg = args.in[14]; const float* b_rg = args.in[15]; const float* w_re = args.in[16]; const float* b_re = args.in[17];
    const float* w_gate = args.in[18]; const float* w_up = args.in[19]; const float* w_down = args.in[20]; const float* final_g = args.in[21];
    float* out = args.out;
    float* KSUM = (float*)(ws + WS_KSUM); float* MODP = (float*)(ws + WS_MODP); float* MOD = (float*)(ws + WS_MOD); float* ROPE = (float*)(ws + WS_ROPE);
    bf16_t* WST = (bf16_t*)(ws + WS_WST); bf16_t* WRT = (bf16_t*)(ws + WS_WRT); float* SSQ = (float*)(ws + WS_SSQ);
    unsigned long long* ROUTE = (unsigned long long*)(ws + WS_ROUTE);
    bf16_t* WIN = (bf16_t*)(ws + WS_WIN); bf16_t* WAB = (bf16_t*)(ws + WS_WAB); bf16_t* WOUT = (bf16_t*)(ws + WS_WOUT);
    bf16_t* WGU = (bf16_t*)(ws + WS_WGU); bf16_t* WD = (bf16_t*)(ws + WS_WD);
    bf16_t* XN = (bf16_t*)(ws + WS_XN); bf16_t* PROJ = (bf16_t*)(ws + WS_PROJ); bf16_t* HID = (bf16_t*)(ws + WS_HID); bf16_t* YB = (bf16_t*)(ws + WS_Y); bf16_t* X1 = (bf16_t*)(ws + WS_X1);
    bf16_t* PO = (bf16_t*)(ws + WS_PO); float* PML = (float*)(ws + WS_PML); unsigned short* LIST = (unsigned short*)(ws + WS_LIST); unsigned* CNT = (unsigned*)(F.ctl + CW_CNT);

    for (int u = F.tid; u < 256; u += NWAVES * 64) ((LAS unsigned*)(F.lds + MISC_OFF))[u] = 0u;
    __syncthreads();
    XcdBarrier bar; bar.bar = (unsigned*)(F.ctl + CW_BAR) + args.li * XCD_BAR_WORDS; bar.x = 0; bar.st = nullptr;
    if (!MK_PER_PHASE) bar = xcd_barrier_post((unsigned*)(F.ctl + CW_BAR) + args.li * XCD_BAR_WORDS, F.MISC + 8);
    const int lo = args.ph_lo, hi = args.ph_hi;
#define IN(k) (lo <= (k) && (k) < hi)
#define PH_SET(k) do { if (TSEL != 0 && blockIdx.x == TBLK && threadIdx.x == 0) g_tphase = (k); } while (0)
    if (TSEL != 0 && blockIdx.x == TBLK && threadIdx.x == 0) { g_tacc = 0; g_tphase = -2; }
#define SEAM(k) do { if (IN(k) && IN((k) + 1)) xcd_barrier(bar); } while (0)

    PH_SET(0); TP_BEGIN(0, tp0_) if (IN(0)) { PHASE_IDS();
        const int gw = F.vcu * NWAVES + F.wave, NGW = F.G * NWAVES;
        const int gtid = F.vcu * (NWAVES * 64) + F.tid, NGT = F.G * NWAVES * 64;
        LAS float* scr = (LAS float*)(F.lds + F.wave * 16640);
        constexpr int I_MOD = 16 * 24, I_IN = 16 * 72, I_A = 8 * 16, I_O = 16 * 16;
        constexpr int NITEMS = I_MOD + I_IN + 2 * I_A + I_O;
        for (int it = gw; it < NITEMS; it += NGW) {
            int r = (it & 7) * 256 + (it >> 3);
            if (r < I_MOD) {
                const int s = r / 24, nc = r % 24, n = nc * 256 + 4 * F.lane;
                f32x4 a0 = {0.f, 0.f, 0.f, 0.f}, a1 = a0, a2 = a0, a3 = a0;
#pragma unroll 16
                for (int kk = 0; kk < 64; ++kk) { const int k = 64 * s + kk; const f32x4 w = __builtin_nontemporal_load((const f32x4*)(ada_w + (size_t)k * 6144 + n));
                    a0 += w * cvec[k]; a1 += w * cvec[1024 + k]; a2 += w * cvec[2048 + k]; a3 += w * cvec[3072 + k]; }
                float* dst = MODP + (size_t)s * 24576 + n;
                *(f32x4*)(dst) = a0; *(f32x4*)(dst + 6144) = a1; *(f32x4*)(dst + 12288) = a2; *(f32x4*)(dst + 18432) = a3;
                continue; }
            r -= I_MOD;
            if (r < I_IN) { transpose_item<true>(w_in, PC, 64 * (r / 72), 64 * (r % 72), WIN, 0, 1024, scr, F.lane); continue; } r -= I_IN;
            if (r < I_A) { transpose_item<true>(w_branch_a, 1024, 64 * (r / 16), 64 * (r % 16), WAB, 0, 1024, scr, F.lane); continue; } r -= I_A;
            if (r < I_A) { transpose_item<true>(w_branch_b, 1024, 64 * (r / 16), 64 * (r % 16), WAB + 512, 0, 1024, scr, F.lane); continue; } r -= I_A;
            transpose_item<true>(w_out, 1024, 64 * (r / 16), 64 * (r % 16), WOUT, 0, 1024, scr, F.lane);
        }
        for (int i = gtid; i < 65536; i += NGT) {
            const int pos = i >> 3, j = i & 7; const float inv = powf(500000.0f, -(float)j * 2.0f / 16.0f); const float ang = (float)pos * inv;
            ROPE[i] = cosf(ang); ROPE[65536 + i] = sinf(ang); }
        for (int i = gtid; i < 65536; i += NGT) {
            const int s = i & 127, t_ = (i >> 7) & 127; const float v = (s <= t_) ? w_spatial[i] : 0.f; WST[i] = (bf16_t)(cvt_pk_bf16(v, 0.f) & 0xffffu); }
        for (int i = gtid; i < 48 * 1024; i += NGT) {
            const int j = i >> 10, k = i & 1023; float v = 0.f; if (j < 4) v = w_rg[k * 4 + j]; else if (j < 36) v = w_re[k * 32 + (j - 4)];
            const unsigned hb = cvt_pk_bf16(v, 0.f) & 0xffffu; const float lo = v - bflo(hb);
            WRT[i] = (bf16_t)hb; WRT[48 * 1024 + i] = (bf16_t)(cvt_pk_bf16(lo, 0.f) & 0xffffu); }
    }
    TP_END(0, tp0_); SEAM(0);

    PH_SET(1); TP_BEGIN(1, tp1_) if (IN(1)) { PHASE_IDS();
        const int c = F.vcu, b = c >> 6;
        LAS float* f = (LAS float*)F.lds;
        for (int v = F.tid; v < 2048; v += NWAVES * 64) { float s = ada_b[v];
#pragma unroll
            for (int sl = 0; sl < 16; ++sl) s += MODP[(size_t)sl * 24576 + b * 6144 + v];
            f[v] = s; }
        if (F.tid < 96) { const int idx = 96 * c + F.tid; float s = ada_b[idx % 6144];
#pragma unroll
            for (int sl = 0; sl < 16; ++sl) s += MODP[(size_t)sl * 24576 + idx];
            MOD[idx] = s; }
        __syncthreads();
        f32x4 A1[4], B1[4];
#pragma unroll
        for (int j = 0; j < 4; ++j) { const int k = 4 * F.lane + 256 * j; const f32x4 g = *(const f32x4*)(norm1_g + k);
#pragma unroll
            for (int i = 0; i < 4; ++i) { A1[j][i] = g[i] * (1.0f + f[1024 + k + i]); B1[j][i] = f[k + i]; } }
        for (int i0 = 0; i0 < 16; i0 += 4) {
            f32x4 v[4][4]; float ss[4];
#pragma unroll
            for (int u_ = 0; u_ < 4; ++u_) { const size_t row = (size_t)c * 128 + F.wave * 16 + i0 + u_; const f32x4* xr = (const f32x4*)(x + row * DM) + F.lane;
#pragma unroll
                for (int j = 0; j < 4; ++j) v[u_][j] = __builtin_nontemporal_load(xr + 64 * j); }
#pragma unroll
            for (int u_ = 0; u_ < 4; ++u_) { float s = 0.f;
#pragma unroll
                for (int j = 0; j < 4; ++j) s += (v[u_][j].x * v[u_][j].x + v[u_][j].y * v[u_][j].y) + (v[u_][j].z * v[u_][j].z + v[u_][j].w * v[u_][j].w);
                ss[u_] = s; }
#pragma unroll
            for (int o_ = 1; o_ < 64; o_ <<= 1) {
#pragma unroll
                for (int u_ = 0; u_ < 4; ++u_) ss[u_] += __shfl_xor(ss[u_], o_); }
#pragma unroll
            for (int u_ = 0; u_ < 4; ++u_) { const size_t row = (size_t)c * 128 + F.wave * 16 + i0 + u_; const float rstd = 1.0f / sqrtf(ss[u_] * (1.0f / DM) + EPS);
                u32x2* o8 = (u32x2*)(XN + row * DM) + F.lane;
#pragma unroll
                for (int j = 0; j < 4; ++j) { const f32x4 hv = v[u_][j] * rstd * A1[j] + B1[j]; u32x2 w; w.x = cvt_pk_bf16(hv.x, hv.y); w.y = cvt_pk_bf16(hv.z, hv.w); st_wt8(o8 + 64 * j, w); } } }
        __syncthreads();
    }
    TP_END(1, tp1_); SEAM(1);

    PH_SET(2); TP_BEGIN(2, tp2_) if (IN(2)) {
        pg8::DenseSched S; S.init(XN, DM, WIN, DM, T, PC, F.G, (int)blockIdx.x);
        pg8::EpiProj E{PROJ, ROPE, KSUM};
        phase_skew(F.vcu, SKEW_P2);
        pg8::gemm_phase<pg8::EpiProj, pg8::DenseSched, false>(F.lds, S, E);
    }
    TP_END(2, tp2_); SEAM(2);

    PH_SET(3); TP_BEGIN(3, tp3_) if (IN(3)) { PHASE_IDS();
        for (int chunk = F.vcu; chunk < ((args.flags & 2) ? 0 : T / 128); chunk += F.G) {
            const int lane = F.lane, w = F.wave, q = lane >> 4, l15 = lane & 15;
            const size_t row0 = (size_t)chunk * 128;
            float lg[8], lb[8];
            { const f32x4 g0 = *(const f32x4*)(gmlp_ln_g + 8 * lane), g1 = *(const f32x4*)(gmlp_ln_g + 8 * lane + 4), b0 = *(const f32x4*)(gmlp_ln_b + 8 * lane), b1 = *(const f32x4*)(gmlp_ln_b + 8 * lane + 4);
#pragma unroll
              for (int j = 0; j < 4; ++j) { lg[j] = g0[j]; lg[4 + j] = g1[j]; lb[j] = b0[j]; lb[4 + j] = b1[j]; } }
            u32x4 vn[16];
#pragma unroll
            for (int i = 0; i < 16; ++i) vn[i] = __builtin_nontemporal_load((const u32x4*)(PROJ + (row0 + 16 * w + i) * PC + C_V + 8 * lane));
#pragma unroll
            for (int hb = 0; hb < 16; hb += 8) {
                float s1[8], s2[8];
#pragma unroll
                for (int i = 0; i < 8; ++i) { const u32x4 raw = vn[hb + i];
                    u32x4 gv; gv.x = cvt_pk_bf16(gelu_tanh(bflo(raw.x)), gelu_tanh(bfhi(raw.x))); gv.y = cvt_pk_bf16(gelu_tanh(bflo(raw.y)), gelu_tanh(bfhi(raw.y)));
                    gv.z = cvt_pk_bf16(gelu_tanh(bflo(raw.z)), gelu_tanh(bfhi(raw.z))); gv.w = cvt_pk_bf16(gelu_tanh(bflo(raw.w)), gelu_tanh(bfhi(raw.w)));
                    const float v0 = bflo(gv.x), v1 = bfhi(gv.x), v2 = bflo(gv.y), v3 = bfhi(gv.y), v4 = bflo(gv.z), v5 = bfhi(gv.z), v6 = bflo(gv.w), v7 = bfhi(gv.w);
                    s1[i] = ((v0 + v1) + (v2 + v3)) + ((v4 + v5) + (v6 + v7)); s2[i] = ((v0 * v0 + v1 * v1) + (v2 * v2 + v3 * v3)) + ((v4 * v4 + v5 * v5) + (v6 * v6 + v7 * v7));
                    vn[hb + i] = gv; }
#pragma unroll
                for (int o_ = 1; o_ < 64; o_ <<= 1) {
#pragma unroll
                    for (int i = 0; i < 8; ++i) { s1[i] += __shfl_xor(s1[i], o_); s2[i] += __shfl_xor(s2[i], o_); } }
#pragma unroll
                for (int i = 0; i < 8; ++i) { const float mean = s1[i] * (1.0f / 512.0f); const float var = fmaxf(s2[i] * (1.0f / 512.0f) - mean * mean, 0.f); const float rstd = 1.0f / sqrtf(var + EPS);
                    const u32x4 gv = vn[hb + i]; float v[8] = {bflo(gv.x), bfhi(gv.x), bflo(gv.y), bfhi(gv.y), bflo(gv.z), bfhi(gv.z), bflo(gv.w), bfhi(gv.w)};
#pragma unroll
                    for (int j = 0; j < 8; ++j) v[j] = (v[j] - mean) * rstd * lg[j] + lb[j];
                    vn[hb + i].x = cvt_pk_bf16(v[0], v[1]); vn[hb + i].y = cvt_pk_bf16(v[2], v[3]); vn[hb + i].z = cvt_pk_bf16(v[4], v[5]); vn[hb + i].w = cvt_pk_bf16(v[6], v[7]); }
            }
            const int tt = 16 * w + l15;
            u32x2 wfr[4][2]; u32x4 uq[4];
#define GM_LOAD(WF, UQ, g_) do { const bf16_t* wp_ = WST + ((size_t)((g_) * 128 + tt)) * 128 + 4 * q; \
                _Pragma("unroll") for (int ks = 0; ks < 4; ++ks) { WF[ks][0] = *(const u32x2*)(wp_ + 32 * ks); WF[ks][1] = *(const u32x2*)(wp_ + 32 * ks + 16); } \
                _Pragma("unroll") for (int i = 0; i < 4; ++i) UQ[i] = __builtin_nontemporal_load((const u32x4*)(PROJ + (row0 + 16 * w + 4 * i + q) * PC + C_U + 128 * (g_) + 8 * l15)); } while (0)
            GM_LOAD(wfr, uq, 0);
            float bsv[4];
#pragma unroll
            for (int g_ = 0; g_ < 4; ++g_) bsv[g_] = b_spatial[g_ * 128 + tt];
#pragma unroll
            for (int g = 0; g < 4; ++g) {
                __syncthreads();
                if (q == g) {
#pragma unroll
                    for (int i = 0; i < 16; ++i) *(LAS u32x4*)(F.lds + (16 * w + i) * 288 + l15 * 16) = vn[i];
                }
                __syncthreads();
                u32x2 wfn[4][2]; u32x4 uqn[4];
                if (g < 3) GM_LOAD(wfn, uqn, g + 1);
                f32x4 acc[8];
#pragma unroll
                for (int it = 0; it < 8; ++it) acc[it] = (f32x4){0.f, 0.f, 0.f, 0.f};
                const int nks = (16 * w + 16 + 31) / 32;
#pragma unroll
                for (int ks = 0; ks < 4; ++ks) { if (ks < nks) {
                    const bf16x8 bw = __builtin_bit_cast(bf16x8, (u32x4){wfr[ks][0].x, wfr[ks][0].y, wfr[ks][1].x, wfr[ks][1].y});
                    const attn_body::lds_cptr base = (attn_body::lds_cptr)F.lds + (32 * ks + 4 * q + (l15 >> 2)) * 288 + (l15 & 3) * 8;
#pragma unroll
                    for (int it = 0; it < 8; ++it) {
                        const s16x4 lo = attn_body::vtr(base + it * 32), hi_ = attn_body::vtr(base + 16 * 288 + it * 32);
                        const bf16x8 a = (bf16x8){lo[0], lo[1], lo[2], lo[3], hi_[0], hi_[1], hi_[2], hi_[3]};
                        acc[it] = __builtin_amdgcn_mfma_f32_16x16x32_bf16(a, bw, acc[it], 0, 0, 0);
                    } } }
                const float bs = bsv[g];
                LAS unsigned char* svb = F.lds + 36864;
#pragma unroll
                for (int it = 0; it < 8; ++it) { u32x2 o; o.x = cvt_pk_bf16(acc[it][0] + bs, acc[it][1] + bs); o.y = cvt_pk_bf16(acc[it][2] + bs, acc[it][3] + bs);
                    *(LAS u32x2*)(svb + tt * 272 + (16 * it + 4 * q) * 2) = o; }
                LDS_WAIT(); asm volatile("" ::: "memory");
#pragma unroll
                for (int i = 0; i < 4; ++i) { const int tr_ = 16 * w + 4 * i + q; bf16_t* pp = PROJ + (row0 + tr_) * PC + C_U + 128 * g + 8 * l15;
                    const u32x4 uu = uq[i]; const u32x4 sv = *(const LAS u32x4*)(svb + tr_ * 272 + l15 * 16);
                    u32x4 o; o.x = cvt_pk_bf16(gelu_tanh(bflo(uu.x)) * bflo(sv.x), gelu_tanh(bfhi(uu.x)) * bfhi(sv.x)); o.y = cvt_pk_bf16(gelu_tanh(bflo(uu.y)) * bflo(sv.y), gelu_tanh(bfhi(uu.y)) * bfhi(sv.y));
                    o.z = cvt_pk_bf16(gelu_tanh(bflo(uu.z)) * bflo(sv.z), gelu_tanh(bfhi(uu.z)) * bfhi(sv.z)); o.w = cvt_pk_bf16(gelu_tanh(bflo(uu.w)) * bflo(sv.w), gelu_tanh(bfhi(uu.w)) * bfhi(sv.w));
                    *(u32x4*)pp = o; }
                LDS_WAIT(); asm volatile("" ::: "memory");
                if (g < 3) {
#pragma unroll
                    for (int ks = 0; ks < 4; ++ks) { wfr[ks][0] = wfn[ks][0]; wfr[ks][1] = wfn[ks][1]; }
#pragma unroll
                    for (int i = 0; i < 4; ++i) uq[i] = uqn[i]; }
            }
            __syncthreads();
        }
        {
            using namespace attn_body;
            const int s = F.vcu & 7, bh = F.vcu >> 3;
            const bf16* Qp = (const bf16*)(PROJ + C_Q); const bf16* Kp = (const bf16*)(PROJ + C_K); const bf16* Vp = (const bf16*)(PROJ + C_VV);
#define QBI(i) (((i) == 0) ? s : ((i) == 1) ? 15 - s : ((i) == 2) ? 16 + s : 31 - s)
            if (ATTN_MODE != 0) {
                if (bh < NB * 8 && !(args.flags & 4)) { const int qbs[4] = {QBI(0), QBI(1), QBI(2), QBI(3)}; select_units(bh >> 3, bh & 7, qbs, Qp, KSUM, LIST, CNT, (char*)lds_raw + 40960); }
                TP_END(3, tp3_);
                if (!MK_PER_PHASE) xcd_barrier(bar);
                PH_SET(31); TP_BEGIN(31, tp31_)
                unsigned long long tg0_ = 0; if (TSEL >= 5 && TSEL <= 7) tg0_ = __builtin_amdgcn_s_memrealtime();
                if (!(args.flags & 8)) gather_phase<8>((char*)lds_raw, Qp, Kp, Vp, LIST, CNT, PO, PML, F.vcu, F.G, (args.flags & 1) == 0);
                TP_END(31, tp31_);
                if (TSEL >= 5 && TSEL <= 7) { if (threadIdx.x == 0) __hip_atomic_store(&g_tw[F.vcu], (unsigned)(__builtin_amdgcn_s_memrealtime() - tg0_), __ATOMIC_RELAXED, __HIP_MEMORY_SCOPE_AGENT); }
                if (!MK_PER_PHASE) xcd_barrier(bar);
                if (TSEL == 5 || TSEL == 6) { if (blockIdx.x == TBLK && threadIdx.x == 0) { unsigned mx = 0, am = 0; for (int i = 0; i < 256; ++i) { const unsigned t_ = __hip_atomic_load(&g_tw[i], __ATOMIC_RELAXED, __HIP_MEMORY_SCOPE_AGENT); if (t_ > mx) { mx = t_; am = i; } }
                    g_tacc += (TSEL == 5) ? mx : am * 100u; } }
                if (TSEL == 7) { if (blockIdx.x == 0 && threadIdx.x == 0) g_tacc += __hip_atomic_load(&g_tw[TVCU], __ATOMIC_RELAXED, __HIP_MEMORY_SCOPE_AGENT); }
                PH_SET(32);
                bf16* Op = (bf16*)(PROJ + (ATTN_MODE == 2 ? C_V : C_Q));
                TP_BEGIN(32, tp32_)
                if (bh < NB * 8 && !(args.flags & 16)) for (int i = 0; i < 4; ++i) attn_unit<8, true>(bh >> 3, bh & 7, QBI(i), Qp, Kp, Vp, Op, KSUM, (char*)lds_raw, (args.flags & 1) == 0, PO, PML);
                TP_END(32, tp32_);
            }
            if (ATTN_MODE == 0) {
                if (bh < NB * 8) for (int i = 0; i < 4; ++i) attn_unit<8, false>(bh >> 3, bh & 7, QBI(i), Qp, Kp, Vp, (bf16*)(PROJ + C_Q), KSUM, (char*)lds_raw, (args.flags & 1) == 0, PO, PML);
            }
#undef QBI
#undef GM_LOAD
        }
        VM_WAIT(); __syncthreads();
    }
    SEAM(3);

    PH_SET(4); TP_BEGIN(4, tp4_) if (IN(4)) {
        pg8::DenseSched S; S.init(PROJ + C_U, PC, WAB, 1024, T, DM, F.G, (int)blockIdx.x); S.ksplit = 8; S.kgap = (unsigned)(C_Q - C_U - 512) * 2u;
        pg8::EpiMergeF E{PROJ, XN};
        phase_skew(F.vcu, SKEW_P45);
        pg8::gemm_phase<pg8::EpiMergeF, pg8::DenseSched, false>(F.lds, S, E);
    }
    TP_END(4, tp4_); SEAM(4);

    PH_SET(5); TP_BEGIN(5, tp5_) if (IN(5)) {
        pg8::DenseSched S; S.init(XN, DM, WOUT, DM, T, DM, F.G, (int)blockIdx.x); pg8::EpiOut E{x, X1, MOD, SSQ};
        phase_skew(F.vcu, SKEW_P45);
        pg8::gemm_phase<pg8::EpiOut, pg8::DenseSched, false>(F.lds, S, E);
    }
    TP_END(5, tp5_); SEAM(5);

    PH_SET(6); TP_BEGIN(6, tp6_) if (IN(6)) { PHASE_IDS();
        {
            LAS float* scr = (LAS float*)(F.lds + F.wave * 16640);
            const int gw = F.vcu * NWAVES + F.wave, NGW = F.G * NWAVES;
            constexpr int I_G = 32 * 16 * 8, I_D = 32 * 8 * 16;
            for (int it = gw; it < 2 * I_G + I_D; it += NGW) { int r = it;
                if (r < 2 * I_G) { const bool up = r >= I_G; if (up) r -= I_G; const int e = r / 128, kb = (r % 128) / 8, nb = r % 8, n0 = 64 * nb;
                    const size_t row_off = (size_t)e * 1024 + (size_t)(n0 / 128) * 256 + (up ? 128 : 0) + (n0 % 128) - n0;
                    transpose_item((up ? w_up : w_gate) + (size_t)e * 1024 * 512, 512, 64 * kb, n0, WGU, row_off, 1024, scr, F.lane); continue; }
                r -= 2 * I_G;
                { const int e = r / 128, kb = (r % 128) / 16, nb = r % 16; transpose_item(w_down + (size_t)e * 512 * 1024, 1024, 64 * kb, 64 * nb, WD, (size_t)e * 1024, 512, scr, F.lane); } }
            __syncthreads();
        }
        TP_END(6, tp6_);
        TP_BEGIN(61, tp61_)
        const int c = F.vcu, b = c >> 6, lane = F.lane, w = F.wave, r = lane & 15, q = lane >> 4;
        constexpr int WPITCH = 1056, WPLANE = 48 * WPITCH, WL_OFF = 8192, LG_OFF = WL_OFF + 2 * WPLANE, HI_OFF = LG_OFF + 8 * 3072;
        static_assert(HI_OFF + 512 <= MISC_OFF, "P6 LDS map");
        LAS float* A2 = (LAS float*)F.lds; LAS float* B2 = A2 + 1024; LAS float* LG = (LAS float*)(F.lds + LG_OFF) + w * 768;
        LAS unsigned* hist = (LAS unsigned*)(F.lds + HI_OFF); LAS unsigned* basev = hist + 32;
        for (int k = F.tid; k < 1024; k += NWAVES * 64) { A2[k] = norm2_g[k] * (1.0f + MOD[b * 6144 + 4096 + k]); B2[k] = MOD[b * 6144 + 3072 + k]; }
        LAS float* bre = (LAS float*)(hist + 64); LAS float* brg = bre + 32;
        if (F.tid < 32) { hist[F.tid] = 0u; bre[F.tid] = b_re[F.tid]; if (F.tid < 4) brg[F.tid] = b_rg[F.tid]; }
        const size_t row = (size_t)c * 128 + w * 16 + r;
        float rs;
        { const f32x4* sp = (const f32x4*)(SSQ + row * 16); const f32x4 s0 = sp[0], s1 = sp[1], s2 = sp[2], s3 = sp[3];
          const float ss = ((s0[0] + s0[1]) + (s0[2] + s0[3])) + ((s1[0] + s1[1]) + (s1[2] + s1[3])) + ((s2[0] + s2[1]) + (s2[2] + s2[3])) + ((s3[0] + s3[1]) + (s3[2] + s3[3]));
          rs = 1.0f / sqrtf(ss * (1.0f / DM) + EPS); }
        f32x4 acc[3];
#pragma unroll
        for (int jt = 0; jt < 3; ++jt) acc[jt] = (f32x4){0.f, 0.f, 0.f, 0.f};
        const bf16_t* xrow = X1 + row * DM;
        for (int hf = 0; hf < 2; ++hf) {
            __syncthreads();
#pragma unroll
            for (int ps = 0; ps < 12; ++ps) { const int idx = ps * 512 + F.tid, rw = idx >> 6, c16 = idx & 63;
                const u32x4 v = *(const u32x4*)(WRT + (size_t)rw * 1024 + hf * 512 + c16 * 8);
                *(LAS u32x4*)(F.lds + WL_OFF + (rw / 48) * WPLANE + (rw % 48) * WPITCH + c16 * 16) = v; }
            __syncthreads();
#pragma unroll 4
            for (int s_ = 0; s_ < 16; ++s_) { const int k0 = 512 * hf + 32 * s_ + 8 * q;
                const u32x4 xr = *(const u32x4*)(xrow + k0);
                const f32x4 x0 = {bflo(xr.x), bfhi(xr.x), bflo(xr.y), bfhi(xr.y)}, x1v = {bflo(xr.z), bfhi(xr.z), bflo(xr.w), bfhi(xr.w)};
                const f32x4 a0 = *(const LAS f32x4*)(A2 + k0), a1 = *(const LAS f32x4*)(A2 + k0 + 4), b0 = *(const LAS f32x4*)(B2 + k0), b1 = *(const LAS f32x4*)(B2 + k0 + 4);
                const f32x4 h0 = x0 * rs * a0 + b0, h1 = x1v * rs * a1 + b1;
                u32x4 hw; hw.x = cvt_pk_bf16(h0[0], h0[1]); hw.y = cvt_pk_bf16(h0[2], h0[3]); hw.z = cvt_pk_bf16(h1[0], h1[1]); hw.w = cvt_pk_bf16(h1[2], h1[3]);
                *(u32x4*)(XN + row * DM + k0) = hw;
                u32x4 lw; lw.x = cvt_pk_bf16(h0[0] - bflo(hw.x), h0[1] - bfhi(hw.x)); lw.y = cvt_pk_bf16(h0[2] - bflo(hw.y), h0[3] - bfhi(hw.y));
                lw.z = cvt_pk_bf16(h1[0] - bflo(hw.z), h1[1] - bfhi(hw.z)); lw.w = cvt_pk_bf16(h1[2] - bflo(hw.w), h1[3] - bfhi(hw.w));
                const bf16x8 hb = __builtin_bit_cast(bf16x8, hw), hl = __builtin_bit_cast(bf16x8, lw);
#pragma unroll
                for (int jt = 0; jt < 3; ++jt) { const LAS unsigned char* wp = F.lds + WL_OFF + (16 * jt + r) * WPITCH + (32 * s_ + 8 * q) * 2;
                    const bf16x8 wf = *(const LAS bf16x8*)wp, wl = *(const LAS bf16x8*)(wp + WPLANE);
                    acc[jt] = __builtin_amdgcn_mfma_f32_16x16x32_bf16(wf, hb, acc[jt], 0, 0, 0);
                    acc[jt] = __builtin_amdgcn_mfma_f32_16x16x32_bf16(wf, hl, acc[jt], 0, 0, 0);
                    acc[jt] = __builtin_amdgcn_mfma_f32_16x16x32_bf16(wl, hb, acc[jt], 0, 0, 0); } }
        }
#pragma unroll
        for (int jt = 0; jt < 3; ++jt) *(LAS f32x4*)(LG + r * 48 + 16 * jt + 4 * q) = acc[jt];
        LDS_WAIT(); asm volatile("" ::: "memory");
        int E0 = 0, E1 = 0; float w0 = 0.f, w1 = 0.f; unsigned lp0 = 0u, lp1 = 0u;
        if (lane < 16) {
            const LAS float* lgp = LG + lane * 48;
            float gl[4];
#pragma unroll
            for (int j = 0; j < 4; ++j) gl[j] = lgp[j] + brg[j];
            int g = 0; float gm = gl[0];
#pragma unroll
            for (int j = 1; j < 4; ++j) if (gl[j] > gm) { gm = gl[j]; g = j; }
            float gs = 0.f;
#pragma unroll
            for (int j = 0; j < 4; ++j) gs += __expf(gl[j] - gm);
            const float gp = 1.0f / gs;
            float m0 = -INFINITY, m1 = -INFINITY; int i0 = 0, i1 = 0;
#pragma unroll
            for (int j = 0; j < 8; ++j) { const float el = lgp[4 + 8 * g + j] + bre[g * 8 + j];
                if (el > m0) { m1 = m0; i1 = i0; m0 = el; i0 = j; } else if (el > m1) { m1 = el; i1 = j; } }
            const float d = __expf(m1 - m0), inv = 1.0f / (1.0f + d);
            w0 = gp * inv; w1 = gp * d * inv; E0 = 8 * g + i0; E1 = 8 * g + i1;
            lp0 = __hip_atomic_fetch_add(hist + E0, 1u, __ATOMIC_RELAXED, __HIP_MEMORY_SCOPE_WORKGROUP);
            lp1 = __hip_atomic_fetch_add(hist + E1, 1u, __ATOMIC_RELAXED, __HIP_MEMORY_SCOPE_WORKGROUP);
        }
        __syncthreads();
        if (F.tid < 32) { const unsigned n = hist[F.tid]; basev[F.tid] = n ? __hip_atomic_fetch_add((unsigned*)(F.ctl + CW_CURSOR + 64 * F.tid), n, RLX_AGENT) : 0u; }
        __syncthreads();
        if (lane < 16) { const unsigned tok = (unsigned)(c * 128 + w * 16 + lane);
            ROUTE[(size_t)E0 * 32768 + basev[E0] + lp0] = ((unsigned long long)__float_as_uint(w0) << 32) | (unsigned long long)(2u * tok);
            ROUTE[(size_t)E1 * 32768 + basev[E1] + lp1] = ((unsigned long long)__float_as_uint(w1) << 32) | (unsigned long long)(2u * tok + 1u); }
        __syncthreads();
        TP_END(61, tp61_);
    }
    SEAM(6);

    PH_SET(7); TP_BEGIN(7, tp7_) if (IN(7) || IN(8)) { PHASE_IDS();
        volatile LAS int* tab = (volatile LAS int*)(F.lds + MISC_OFF + 256);
        if (F.tid < 32) tab[F.tid] = (int)__hip_atomic_load((unsigned*)(F.ctl + CW_CURSOR + 64 * F.tid), RLX_AGENT);
        __syncthreads();
        if (F.tid < 64) {
            const int l_ = F.tid; const int n_ = (l_ < 32) ? ((tab[l_ & 31] + 255) >> 8) : 0; int v_ = n_;
#pragma unroll
            for (int o_ = 1; o_ < 32; o_ <<= 1) { const int t_ = __shfl_up(v_, o_); if (l_ >= o_) v_ += t_; }
            if (l_ < 32) tab[32 + l_] = v_ - n_;
            if (l_ == 31) tab[64] = v_; }
        __syncthreads();
        const int U = 4 * __builtin_amdgcn_readfirstlane(tab[64]);
        const int xq = F.vcu >> 5, jj = F.vcu & 31;
        pg8::MoeSched S; S.tab = tab; S.start = (int)(((long)U * xq) / 8); S.end = (int)(((long)U * (xq + 1)) / 8); S.j = jj; S.route = ROUTE; S.ready = (unsigned*)(F.ctl + CW_READY); S.rdy = (volatile LAS int*)(F.lds + MISC_OFF + 704);
        if (IN(7)) {
            S.A = (const char*)XN; S.lda = DM; S.K = DM; S.Bt = (const char*)WGU; S.bstride = (size_t)1024 * 1024 * 2; S.gather = true; S.mode = 1;
            pg8::EpiGU E{HID};
            pg8::gemm_phase<pg8::EpiGU, pg8::MoeSched, true>(F.lds, S, E);
        }
        TP_END(7, tp7_);
        PH_SET(8); TP_BEGIN(8, tp8_) if (IN(8)) {
            S.A = (const char*)HID; S.lda = DEXP; S.K = DEXP; S.Bt = (const char*)WD; S.bstride = (size_t)1024 * 512 * 2; S.gather = false; S.mode = 2; S.j = (jj + 24) & 31; S.qhead = (unsigned*)(F.ctl + CW_QHEAD + 64 * xq); S.qslot = (volatile LAS int*)(F.lds + MISC_OFF + 640); S.rdy = (volatile LAS int*)(F.lds + MISC_OFF + 704);
            if (threadIdx.x == 0) { S.rdy[0] = 0; S.rdy[1] = 0; }
            __syncthreads();
            pg8::EpiDown E{YB, ROUTE};
            pg8::gemm_phase<pg8::EpiDown, pg8::MoeSched, false>(F.lds, S, E);
        }
        TP_END(8, tp8_);
    }
    SEAM(8);

    PH_SET(9); TP_BEGIN(9, tp9_) if (IN(9)) { PHASE_IDS();
        const int c = F.vcu, b = c >> 6;
        f32x4 G2[4], FG[4];
#pragma unroll
        for (int j = 0; j < 4; ++j) { const int k = 4 * F.lane + 256 * j; G2[j] = *(const f32x4*)(MOD + b * 6144 + 5120 + k); FG[j] = *(const f32x4*)(final_g + k); }
        for (int i0 = 0; i0 < 16; i0 += 4) {
            u32x2 ya[4][4], yb[4][4], xx[4][4]; f32x4 v[4][4]; float ss[4];
#pragma unroll
            for (int u_ = 0; u_ < 4; ++u_) { const size_t row = (size_t)c * 128 + F.wave * 16 + i0 + u_;
                const u32x2* xb = (const u32x2*)(X1 + row * DM) + F.lane; const u32x2* y0 = (const u32x2*)(YB + (2 * row) * DM) + F.lane; const u32x2* y1 = (const u32x2*)(YB + (2 * row + 1) * DM) + F.lane;
#pragma unroll
                for (int j = 0; j < 4; ++j) { ya[u_][j] = y0[64 * j]; yb[u_][j] = y1[64 * j]; xx[u_][j] = xb[64 * j]; } }
#pragma unroll
            for (int u_ = 0; u_ < 4; ++u_) { float s = 0.f;
#pragma unroll
                for (int j = 0; j < 4; ++j) { const u32x2 a = ya[u_][j], bb = yb[u_][j], x_ = xx[u_][j]; const f32x4 ys = {bflo(a.x) + bflo(bb.x), bfhi(a.x) + bfhi(bb.x), bflo(a.y) + bflo(bb.y), bfhi(a.y) + bfhi(bb.y)};
                    const f32x4 xv = {bflo(x_.x), bfhi(x_.x), bflo(x_.y), bfhi(x_.y)};
                    v[u_][j] = xv + G2[j] * ys; s += (v[u_][j].x * v[u_][j].x + v[u_][j].y * v[u_][j].y) + (v[u_][j].z * v[u_][j].z + v[u_][j].w * v[u_][j].w); }
                ss[u_] = s; }
#pragma unroll
            for (int o_ = 1; o_ < 64; o_ <<= 1) {
#pragma unroll
                for (int u_ = 0; u_ < 4; ++u_) ss[u_] += __shfl_xor(ss[u_], o_); }
#pragma unroll
            for (int u_ = 0; u_ < 4; ++u_) { const size_t row = (size_t)c * 128 + F.wave * 16 + i0 + u_; f32x4* xr = (f32x4*)(out + row * DM) + F.lane;
                const float rstd = 1.0f / sqrtf(ss[u_] * (1.0f / DM) + EPS);
#pragma unroll
                for (int j = 0; j < 4; ++j) { const f32x4 o_ = v[u_][j] * rstd * FG[j]; st_wt16(xr + 64 * j, __builtin_bit_cast(u32x4, o_)); } } }
    }
    TP_END(9, tp9_);
    if (TSEL >= 10 && TSEL <= 12 && blockIdx.x == TBLK && threadIdx.x == 0) { unsigned mx = 0, am = 0; unsigned long long sm = 0;
        for (int i = 0; i < 256; ++i) { const unsigned t_ = __hip_atomic_load(&g_tw[i], __ATOMIC_RELAXED, __HIP_MEMORY_SCOPE_AGENT); sm += t_; if (t_ > mx) { mx = t_; am = i; } }
        g_tacc += (TSEL == 10) ? mx : (TSEL == 11) ? am * 100u : (unsigned)(sm / 256); }
    if (TSEL != 0 && blockIdx.x == TBLK && threadIdx.x == 0) { const unsigned long long t0 = __builtin_amdgcn_s_memrealtime(), d = g_tacc * TMULT; while (__builtin_amdgcn_s_memrealtime() - t0 < d) __builtin_amdgcn_s_sleep(16); }
#undef IN
#undef SEAM
}


#if ATTN_MODE == 2
__global__ void __launch_bounds__(NWAVES * 64, 2) dbg_dense(Args args, int stage) {
    extern __shared__ __attribute__((aligned(16))) unsigned char lds_raw[];
    using namespace attn_body;
    unsigned char* ws = args.ws; bf16_t* PROJ = (bf16_t*)(ws + WS_PROJ); float* KSUM = (float*)(ws + WS_KSUM); gu32* ctl = (gu32*)(ws + WS_CTL);
    const int G = gridDim.x, bx = blockIdx.x, vcu = (bx % 8) * (G / 8) + bx / 8, tid = threadIdx.x, lane = tid & 63, wave = tid >> 6;
    if (stage == 0) {
        const int s = vcu & 7, bh = vcu >> 3;
        for (int i = 0; i < 4; ++i) { const int qb = (i == 0) ? s : (i == 1) ? 15 - s : (i == 2) ? 16 + s : 31 - s;
            attn_unit<8, false>(bh >> 3, bh & 7, qb, (const bf16*)(PROJ + C_Q), (const bf16*)(PROJ + C_K), (const bf16*)(PROJ + C_VV), (bf16*)(PROJ + C_Q), KSUM, (char*)lds_raw, true, nullptr, nullptr); }
    } else {
        float md = 0.f;
        for (int i = 0; i < 16; ++i) { const size_t row = (size_t)vcu * 128 + wave * 16 + i;
            const u32x4 a = *(const u32x4*)(PROJ + row * PC + C_V + 8 * lane), bq = *(const u32x4*)(PROJ + row * PC + C_Q + 8 * lane);
            md = fmaxf(md, fmaxf(fmaxf(fabsf(bflo(a.x) - bflo(bq.x)), fabsf(bfhi(a.x) - bfhi(bq.x))), fmaxf(fabsf(bflo(a.y) - bflo(bq.y)), fabsf(bfhi(a.y) - bfhi(bq.y)))));
            md = fmaxf(md, fmaxf(fmaxf(fabsf(bflo(a.z) - bflo(bq.z)), fabsf(bfhi(a.z) - bfhi(bq.z))), fmaxf(fabsf(bflo(a.w) - bflo(bq.w)), fabsf(bfhi(a.w) - bfhi(bq.w))))); }
#pragma unroll
        for (int o_ = 1; o_ < 64; o_ <<= 1) md = fmaxf(md, __shfl_xor(md, o_));
        if (lane == 0) atomicMax((unsigned*)(ctl + CW_DIFF), __float_as_uint(md));
    }
}
#endif
extern "C" void kernel_launch(void* const* d_in, const int* in_sizes, int n_in, void* d_out, int out_size, void* d_ws, size_t ws_size, hipStream_t stream) {
    static int grid = 0;
    if (grid == 0) {
        if (n_in != 22 || in_sizes[0] != T * DM || out_size != T * DM || ws_size < WS_END) { fprintf(stderr, "kernel_launch: unexpected shapes (n_in %d, in0 %d, out %d, ws %zu); nothing launched\n", n_in, n_in > 0 ? in_sizes[0] : -1, out_size, ws_size); grid = -1; return; }
        int dev = 0, cus = 0, per_cu = 0;
        if (hipGetDevice(&dev) != hipSuccess || hipDeviceGetAttribute(&cus, hipDeviceAttributeMultiprocessorCount, dev) != hipSuccess) { fprintf(stderr, "kernel_launch: device query failed\n"); grid = -1; return; }
        if (hipFuncSetAttribute((const void*)hybrid_fwd, hipFuncAttributeMaxDynamicSharedMemorySize, LDS_BYTES) != hipSuccess) { fprintf(stderr, "kernel_launch: hipFuncSetAttribute failed\n"); grid = -1; return; }
        if (hipOccupancyMaxActiveBlocksPerMultiprocessor(&per_cu, (const void*)hybrid_fwd, NWAVES * 64, LDS_BYTES) != hipSuccess || per_cu < 1) { fprintf(stderr, "kernel_launch: occupancy query reports %d blocks per CU\n", per_cu); }
        (void)hipGetLastError();
        if (cus != 256) { fprintf(stderr, "kernel_launch: built for 256 CUs, device has %d; nothing launched\n", cus); grid = -1; return; }
        grid = cus;
    }
    if (grid < 0) return;
    (void)hipMemsetAsync((char*)d_ws + WS_CTL, 0, CTL_ZERO_BYTES, stream);
    Args a{};
    for (int i = 0; i < 22; ++i) a.in[i] = (const float*)d_in[i];
    a.out = (float*)d_out; a.ws = (unsigned char*)d_ws;
    struct Spec { int lo, hi, flags; };
#if MK_PER_PHASE
    const Spec specs[10] = {{0,1,0},{1,2,0},{2,3,0},{3,4,0},{4,5,0},{5,6,0},{6,7,0},{7,8,0},{8,9,0},{9,10,0}}; const int nspec = 10;
#elif PROBE_ID == 1
    const Spec specs[2] = {{0,10,0},{0,2,0}}; const int nspec = 2;
#elif PROBE_ID == 2
    const Spec specs[2] = {{0,10,0},{2,3,0}}; const int nspec = 2;
#elif PROBE_ID == 3
    const Spec specs[3] = {{0,4,0},{3,4,1|2|4|16},{4,10,0}}; const int nspec = 3;
#elif PROBE_ID == 10
    const Spec specs[3] = {{0,4,0},{3,4,1|2|4|8},{4,10,0}}; const int nspec = 3;
#elif PROBE_ID == 11
    const Spec specs[3] = {{0,4,0},{3,4,1|2|8|16},{4,10,0}}; const int nspec = 3;
#elif PROBE_ID == 12
    const Spec specs[3] = {{0,4,0},{3,4,1|2|4|8|16},{4,10,0}}; const int nspec = 3;
#elif PROBE_ID == 13
    const Spec specs[2] = {{0,10,0},{3,4,1|4|8|16}}; const int nspec = 2;
#elif PROBE_ID == 4
    const Spec specs[3] = {{0,4,0},{4,5,0},{4,10,0}}; const int nspec = 3;
#elif PROBE_ID == 5
    const Spec specs[3] = {{0,5,0},{5,6,0},{5,10,0}}; const int nspec = 3;
#elif PROBE_ID == 6
    const Spec specs[2] = {{0,10,0},{7,8,0}}; const int nspec = 2;
#elif PROBE_ID == 7
    const Spec specs[2] = {{0,10,0},{8,9,0}}; const int nspec = 2;
#elif PROBE_ID == 14
    const Spec specs[2] = {{0,10,0},{7,9,0}}; const int nspec = 2;
#elif PROBE_ID == 15
    const Spec specs[2] = {{0,10,0},{9,10,0}}; const int nspec = 2;
#elif PROBE_ID == 16
    const Spec specs[2] = {{0,10,0},{6,7,0}}; const int nspec = 2;
#elif PROBE_ID == 8
    const Spec specs[2] = {{0,5,0},{5,10,0}}; const int nspec = 2;
#elif PROBE_ID == 9
    const Spec specs[2] = {{0,10,0},{0,1,0}}; const int nspec = 2;
#else
    const Spec specs[1] = {{0,10,0}}; const int nspec = 1;
#endif
#if ATTN_MODE == 2
    (void)hipFuncSetAttribute((const void*)dbg_dense, hipFuncAttributeMaxDynamicSharedMemorySize, LDS_BYTES);
    a.ph_lo = 0; a.ph_hi = 4; a.flags = 0; a.li = 0; hipLaunchKernelGGL(hybrid_fwd, dim3(grid), dim3(NWAVES * 64), LDS_BYTES, stream, a);
    hipLaunchKernelGGL(dbg_dense, dim3(grid), dim3(NWAVES * 64), LDS_BYTES, stream, a, 0);
    hipLaunchKernelGGL(dbg_dense, dim3(grid), dim3(NWAVES * 64), LDS_BYTES, stream, a, 1);
    a.ph_lo = 4; a.ph_hi = 10; a.li = 1; hipLaunchKernelGGL(hybrid_fwd, dim3(grid), dim3(NWAVES * 64), LDS_BYTES, stream, a);
    (void)nspec; (void)specs;
#else
    for (int li = 0; li < nspec; ++li) { a.ph_lo = specs[li].lo; a.ph_hi = specs[li].hi; a.flags = specs[li].flags; a.li = MK_PER_PHASE ? 0 : li;
        hipLaunchKernelGGL(hybrid_fwd, dim3(grid), dim3(NWAVES * 64), LDS_BYTES, stream, a); }
#endif
    const hipError_t le = hipPeekAtLastError();
    if (le != hipSuccess) fprintf(stderr, "kernel_launch: launch failed: %s\n", hipGetErrorName(le));
}
```
